# Optimizing an MI355X kernel written in HIP

```python
import math
import jax, jax.numpy as jnp
from jax import lax
import numpy as np

D_MODEL = 1024
BATCH = 4
SEQ = 8192
DEPTH = 2

CTX_LEN = 256
GRID_W = 64
ROPE_THETA = 10000.0
EPS = 1e-6
Q_BLOCK = 128

MLA_HEADS = 4
MLA_Q_RANK = 256
MLA_KV_RANK = 128
MLA_NOPE = 64
MLA_ROPE = 32
MLA_V = 64
MLA_QK = MLA_NOPE + MLA_ROPE
DIFF_HEADS = 4
DIFF_DK = 32
DIFF_DV = 2 * DIFF_DK
GQA_HEADS = 8
GQA_KV_HEADS = 2
GQA_DH = 64

MIX_WIDTH = MLA_HEADS * MLA_V + DIFF_HEADS * DIFF_DV + GQA_HEADS * GQA_DH
COL_SIZES = (MLA_Q_RANK, MLA_KV_RANK, MLA_ROPE,
             DIFF_HEADS * 2 * DIFF_DK, DIFF_HEADS * 2 * DIFF_DK, DIFF_HEADS * DIFF_DV,
             GQA_HEADS * GQA_DH, GQA_KV_HEADS * GQA_DH, GQA_KV_HEADS * GQA_DH)
IN_COLS = sum(COL_SIZES)

N_EXPERTS = 16
EXPERT_FF = 2048
CAPACITY_FACTOR = 2

kernel_name = "hybrid_parallel_heads_mla_diff_gqa_ec_moe_dit"


def rms_norm(x, g):
    xf = x.astype(jnp.float32)
    y = xf * lax.rsqrt(jnp.mean(xf * xf, axis=-1, keepdims=True) + EPS)
    return (y * g.astype(jnp.float32)).astype(x.dtype)


def modulate(h, shift, scale):
    return h * (1 + scale[:, None]) + shift[:, None]


def axial_rope_tables(rows, rot_dim):
    r = jnp.broadcast_to(jnp.arange(rows, dtype=jnp.float32)[:, None], (rows, GRID_W)).reshape(-1)
    col = jnp.broadcast_to(jnp.arange(GRID_W, dtype=jnp.float32)[None, :], (rows, GRID_W)).reshape(-1)
    axis_dim = rot_dim // 2
    inv = ROPE_THETA ** (-jnp.arange(0, axis_dim, 2, dtype=jnp.float32) / axis_dim)
    ang = jnp.concatenate([r[:, None] * inv, col[:, None] * inv], axis=-1)
    return jnp.cos(ang), jnp.sin(ang)


def apply_rope(x, tab):
    cos, sin = tab
    shp = (1, cos.shape[0]) + (1,) * (x.ndim - 3) + (cos.shape[1],)
    cos = cos.reshape(shp)
    sin = sin.reshape(shp)
    xf = x.astype(jnp.float32).reshape(x.shape[:-1] + (-1, 2))
    x0, x1 = xf[..., 0], xf[..., 1]
    out = jnp.stack([x0 * cos - x1 * sin, x0 * sin + x1 * cos], axis=-1)
    return out.reshape(x.shape).astype(x.dtype)


def blocked_attention(q, k, v, map_w):
    B, S, M, H, dk = q.shape
    G = k.shape[3]
    R = H // G
    dv = v.shape[-1]
    nb = S // Q_BLOCK
    qb = q.reshape(B, nb, Q_BLOCK, M, G, R, dk).transpose(1, 0, 2, 3, 4, 5, 6)
    scale = dk ** -0.5
    w = map_w.astype(jnp.float32)

    def block(qi):
        s = jnp.einsum("bqmgrd,btmgd->bmgrqt", qi, k).astype(jnp.float32) * scale
        p = jnp.einsum("m,bmgrqt->bgrqt", w, jax.nn.softmax(s, axis=-1))
        return jnp.einsum("bgrqt,btgd->bqgrd", p.astype(v.dtype), v)

    o = lax.map(block, qb)
    return o.transpose(1, 0, 2, 3, 4, 5).reshape(B, S, H, dv)


def project_qkv(h, w_in, g_cq, g_ckv, w_uq, w_ukv, g_mla_q, g_mla_k,
                g_diff_q, g_diff_k, g_gqa_q, g_gqa_k, rope):
    B, n, _ = h.shape
    z = h @ w_in
    offs = [int(o) for o in np.cumsum(COL_SIZES)[:-1]]
    z_cq, z_ckv, z_kr, z_dq, z_dk, z_dv, z_gq, z_gk, z_gv = jnp.split(z, offs, axis=-1)
    q_m = (rms_norm(z_cq, g_cq) @ w_uq).reshape(B, n, MLA_HEADS, MLA_QK)
    kv_m = (rms_norm(z_ckv, g_ckv) @ w_ukv).reshape(B, n, MLA_HEADS, MLA_NOPE + MLA_V)
    k_rope = jnp.broadcast_to(z_kr[:, :, None, :], (B, n, MLA_HEADS, MLA_ROPE))
    k_m = jnp.concatenate([kv_m[..., :MLA_NOPE], k_rope], axis=-1)
    v_m = kv_m[..., MLA_NOPE:]
    q_m = rms_norm(q_m, g_mla_q)
    k_m = rms_norm(k_m, g_mla_k)
    q_d = rms_norm(z_dq.reshape(B, n, DIFF_HEADS, 2, DIFF_DK).transpose(0, 1, 3, 2, 4), g_diff_q)
    k_d = rms_norm(z_dk.reshape(B, n, DIFF_HEADS, 2, DIFF_DK).transpose(0, 1, 3, 2, 4), g_diff_k)
    v_d = z_dv.reshape(B, n, DIFF_HEADS, DIFF_DV)
    q_g = rms_norm(z_gq.reshape(B, n, GQA_HEADS, GQA_DH), g_gqa_q)[:, :, None]
    k_g = rms_norm(z_gk.reshape(B, n, GQA_KV_HEADS, GQA_DH), g_gqa_k)[:, :, None]
    v_g = z_gv.reshape(B, n, GQA_KV_HEADS, GQA_DH)
    if rope is not None:
        tab_m, tab_d, tab_g = rope
        q_m = jnp.concatenate([q_m[..., :MLA_NOPE], apply_rope(q_m[..., MLA_NOPE:], tab_m)], axis=-1)
        k_m = jnp.concatenate([k_m[..., :MLA_NOPE], apply_rope(k_m[..., MLA_NOPE:], tab_m)], axis=-1)
        q_d = apply_rope(q_d, tab_d)
        k_d = apply_rope(k_d, tab_d)
        q_g = apply_rope(q_g, tab_g)
        k_g = apply_rope(k_g, tab_g)
    return ((q_m[:, :, None], k_m[:, :, None], v_m), (q_d, k_d, v_d), (q_g, k_g, v_g))


def mixer_outputs(q_src, kv_srcs, lam, lam_init, g_diff_out):
    def keys(i):
        return jnp.concatenate([s[i][1] for s in kv_srcs], axis=1)

    def vals(i):
        return jnp.concatenate([s[i][2] for s in kv_srcs], axis=1)

    B, n = q_src[0][0].shape[:2]
    one = jnp.ones((1,), jnp.float32)
    o_mla = blocked_attention(q_src[0][0], keys(0), vals(0), one)
    w_diff = jnp.stack([jnp.ones((), jnp.float32), -lam])
    o_diff = blocked_attention(q_src[1][0], keys(1), vals(1), w_diff)
    o_diff = rms_norm(o_diff, g_diff_out) * (1.0 - lam_init)
    o_gqa = blocked_attention(q_src[2][0], keys(2), vals(2), one)
    return jnp.concatenate([o_mla.reshape(B, n, -1), o_diff.reshape(B, n, -1),
                            o_gqa.reshape(B, n, -1)], axis=-1)


def expert_choice_ffn(h, w_router, w_gate, w_up, w_down):
    B, n, D = h.shape
    cap = CAPACITY_FACTOR * n // N_EXPERTS
    aff = jax.nn.softmax((h @ w_router).astype(jnp.float32), axis=-1)
    g, idx = lax.top_k(aff.transpose(0, 2, 1), cap)
    xe = jax.vmap(lambda hb, ib: hb[ib])(h, idx)
    hid = jax.nn.silu(jnp.einsum("becd,edf->becf", xe, w_gate)) * jnp.einsum("becd,edf->becf", xe, w_up)
    ye = jnp.einsum("becf,efd->becd", hid, w_down) * g[..., None].astype(h.dtype)
    return jax.vmap(lambda hb, ib, yb: jnp.zeros_like(hb).at[ib.reshape(-1)].add(yb.reshape(-1, D)))(h, idx, ye)


def setup_inputs(seed: int = 0) -> dict:
    key = jax.random.key(seed)
    ks = iter(jax.random.split(key, 40))

    def nrm(shape, scale):
        return jax.random.normal(next(ks), shape, jnp.float32) * scale

    def gain(shape):
        return 1.0 + nrm(shape, 0.05)

    L, D = DEPTH, D_MODEL
    return {
        "x": nrm((BATCH, SEQ, D), 1.0),
        "c": nrm((BATCH, D), 1.0),
        "ctx": nrm((BATCH, CTX_LEN, D), 1.0),
        "c_ctx": nrm((D,), 1.0),
        "w_ada": nrm((L, D, 6 * D), 0.5 * D ** -0.5),
        "b_ada": nrm((L, 6 * D), 0.02),
        "g_norm1": gain((L, D)),
        "w_in": nrm((L, D, IN_COLS), D ** -0.5),
        "g_cq": gain((L, MLA_Q_RANK)),
        "g_ckv": gain((L, MLA_KV_RANK)),
        "w_uq": nrm((L, MLA_Q_RANK, MLA_HEADS * MLA_QK), MLA_Q_RANK ** -0.5),
        "w_ukv": nrm((L, MLA_KV_RANK, MLA_HEADS * (MLA_NOPE + MLA_V)), MLA_KV_RANK ** -0.5),
        "g_mla_q": gain((L, MLA_QK)),
        "g_mla_k": gain((L, MLA_QK)),
        "g_diff_q": gain((L, DIFF_DK)),
        "g_diff_k": gain((L, DIFF_DK)),
        "lam_q1": nrm((L, DIFF_DK), 0.1),
        "lam_k1": nrm((L, DIFF_DK), 0.1),
        "lam_q2": nrm((L, DIFF_DK), 0.1),
        "lam_k2": nrm((L, DIFF_DK), 0.1),
        "g_diff_out": gain((L, DIFF_DV)),
        "g_gqa_q": gain((L, GQA_DH)),
        "g_gqa_k": gain((L, GQA_DH)),
        "w_o": nrm((L, MIX_WIDTH, D), MIX_WIDTH ** -0.5),
        "g_norm2": gain((L, D)),
        "w_router": nrm((L, D, N_EXPERTS), D ** -0.5),
        "w_gate": nrm((L, N_EXPERTS, D, EXPERT_FF), D ** -0.5),
        "w_up": nrm((L, N_EXPERTS, D, EXPERT_FF), D ** -0.5),
        "w_down": nrm((L, N_EXPERTS, EXPERT_FF, D), EXPERT_FF ** -0.5),
    }


def reference(x, c, ctx, c_ctx, w_ada, b_ada, g_norm1, w_in, g_cq, g_ckv, w_uq, w_ukv,
              g_mla_q, g_mla_k, g_diff_q, g_diff_k, lam_q1, lam_k1, lam_q2, lam_k2,
              g_diff_out, g_gqa_q, g_gqa_k, w_o, g_norm2, w_router, w_gate, w_up, w_down):
    ROWS = x.shape[1] // GRID_W
    rope = (axial_rope_tables(ROWS, MLA_ROPE), axial_rope_tables(ROWS, DIFF_DK),
            axial_rope_tables(ROWS, GQA_DH))
    c_ctx_row = c_ctx[None, :]
    for l in range(DEPTH):
        last = l == DEPTH - 1
        sh1, sc1, ga1, sh2, sc2, ga2 = jnp.split(jax.nn.silu(c) @ w_ada[l] + b_ada[l], 6, axis=-1)
        csh1, csc1, cga1, csh2, csc2, cga2 = jnp.split(
            jax.nn.silu(c_ctx_row) @ w_ada[l] + b_ada[l], 6, axis=-1)

        def proj(h, tabs):
            return project_qkv(h, w_in[l], g_cq[l], g_ckv[l], w_uq[l], w_ukv[l], g_mla_q[l], g_mla_k[l],
                               g_diff_q[l], g_diff_k[l], g_gqa_q[l], g_gqa_k[l], tabs)

        def moe(h):
            return expert_choice_ffn(h, w_router[l], w_gate[l], w_up[l], w_down[l])

        lam_init = 0.8 - 0.6 * math.exp(-0.3 * l)
        lam = (jnp.exp(jnp.sum(lam_q1[l].astype(jnp.float32) * lam_k1[l].astype(jnp.float32)))
               - jnp.exp(jnp.sum(lam_q2[l].astype(jnp.float32) * lam_k2[l].astype(jnp.float32)))
               + lam_init)

        qkv_x = proj(modulate(rms_norm(x, g_norm1[l]), sh1, sc1), rope)
        qkv_c = proj(modulate(rms_norm(ctx, g_norm1[l]), csh1, csc1), None)

        att_x = mixer_outputs(qkv_x, [qkv_x, qkv_c], lam, lam_init, g_diff_out[l])
        x = x + ga1[:, None] * (att_x @ w_o[l])
        x = x + ga2[:, None] * moe(modulate(rms_norm(x, g_norm2[l]), sh2, sc2))

        if not last:
            att_c = mixer_outputs(qkv_c, [qkv_c], lam, lam_init, g_diff_out[l])
            ctx = ctx + cga1[:, None] * (att_c @ w_o[l])
            ctx = ctx + cga2[:, None] * moe(modulate(rms_norm(ctx, g_norm2[l]), csh2, csc2))
    return x
```

```cpp
#include <hip/hip_runtime.h>
#include <hip/hip_bf16.h>
#include <cstdio>
#include <cstdint>
#ifndef MK_SPLIT
#define MK_SPLIT 1
#endif
#ifndef MK_NAIVE_ATTN
#define MK_NAIVE_ATTN 0
#endif
namespace pg8 {
#define PG8_LAS __attribute__((address_space(3)))
typedef unsigned short bf16_t;
typedef short bf16x8 __attribute__((ext_vector_type(8)));
typedef float f32x4 __attribute__((ext_vector_type(4)));
typedef unsigned u32x4 __attribute__((ext_vector_type(4)));
constexpr int BM = 256, BK = 64, HALF = 128, HTB = HALF * BK * 2  , STAGE_BYTES = 8 * HTB, NXCD = 8, WGM = 8;

__host__ __device__ __forceinline__ int lds_byte(int r, int c) { const int st = (r >> 4) * 2 + (c >> 5), rr = r & 15, cc = c & 31, ob = rr * 64 + cc * 2; return st * 1024 + (ob ^ (((ob >> 9) & 1) << 5)); }
__host__ __device__ __forceinline__ void stage_rc(int b, int& R, int& C) { const int st = b / 1024, sb = b % 1024, swz = sb ^ (((sb >> 9) & 1) << 5); R = (st >> 1) * 16 + swz / 64; C = (st & 1) * 32 + (swz % 64) / 2; }
__host__ __device__ __forceinline__ int perm32(int rho) { const int n = rho >> 4, i = rho & 15; return 8 * (i >> 2) + 4 * n + (i & 3); }

struct Unit { int pm, pn; };
struct Gemm { const bf16_t* A; const bf16_t* Bt; int M, N, K; int tpe; size_t bgs; };

struct StaticOrder {
    int nM, nN, nwg, G, c;
    __host__ __device__ void init(int M, int N, int G_, int c_) { nM = M / BM; nN = N / BM; nwg = nM * nN; G = G_; c = c_; }
    __host__ __device__ bool next(int i, Unit& u) const {
        const long L = (long)i * G + c; if (L >= nwg) return false;
        int wgid = (int)L; { const int q = nwg / NXCD, r = nwg % NXCD, xcd = wgid % NXCD, off = wgid / NXCD; wgid = (xcd < r ? xcd * (q + 1) : r * (q + 1) + (xcd - r) * q) + off; }
        const int nig = WGM * nN, gid = wgid / nig, fm = gid * WGM, gsz = (nM - fm) < WGM ? (nM - fm) : WGM;
        u.pm = fm + ((wgid % nig) % gsz); u.pn = (wgid % nig) / gsz; return true;
    }
    __device__ __forceinline__ void a_ready(const Unit&) const {}
    __device__ __forceinline__ void done(const Unit&) const {}
};
__device__ __forceinline__ unsigned cvt_pk_bf16(float lo, float hi) { unsigned r; asm volatile("v_cvt_pk_bf16_f32 %0, %1, %2" : "=v"(r) : "v"(lo), "v"(hi)); return r; }
struct EpiStoreBf16 {
    static constexpr bool PERM = true, AFTER_DRAIN = false;
    bf16_t* O; int ldc;
    __device__ __forceinline__ void operator()(const f32x4 (&acc)[2][2][4][2], const Unit& u, int wr, int wc, int fr, int fq) const {
        const int row0 = u.pm * BM + wr * 64 + fr, col0 = u.pn * BM + wc * 32 + 8 * fq;
#pragma unroll
        for (int ai = 0; ai < 2; ++ai)
#pragma unroll
            for (int m = 0; m < 4; ++m) { bf16_t* rowp = O + (size_t)(row0 + ai * HALF + m * 16) * ldc + col0;
#pragma unroll
                for (int bj = 0; bj < 2; ++bj) { const f32x4 v0 = acc[ai][bj][m][0], v1 = acc[ai][bj][m][1];
                    u32x4 w; w.x = cvt_pk_bf16(v0[0], v0[1]); w.y = cvt_pk_bf16(v0[2], v0[3]); w.z = cvt_pk_bf16(v1[0], v1[1]); w.w = cvt_pk_bf16(v1[2], v1[3]);
                    *(u32x4*)(rowp + bj * HALF) = w; } }
    }
};
struct EpiGatedResidual {
    static constexpr bool PERM = false, AFTER_DRAIN = false;
    float* xl; float* xc; const float* mod; int lrows;
    __device__ __forceinline__ void operator()(const f32x4 (&acc)[2][2][4][2], const Unit& u, int wr, int wc, int fr, int fq) const {
        const int R0 = u.pm * BM; const bool isc = R0 >= lrows; const int v = isc ? 4 : (R0 >> 13);
        float* xb = isc ? xc + (size_t)(R0 - lrows) * 1024 : xl + (size_t)R0 * 1024;
        const float* ga = mod + v * 6144 + 2 * 1024;
        const int col0 = u.pn * BM + wc * 32 + 4 * fq;
#pragma unroll
        for (int bj = 0; bj < 2; ++bj)
#pragma unroll
            for (int n = 0; n < 2; ++n) { const f32x4 g = *(const f32x4*)(ga + col0 + bj * HALF + n * 16);
#pragma unroll
                for (int ai = 0; ai < 2; ++ai)
#pragma unroll
                    for (int m = 0; m < 4; ++m) { float* p = xb + (size_t)(ai * HALF + wr * 64 + m * 16 + fr) * 1024 + col0 + bj * HALF + n * 16;
                        const f32x4 xv = *(const f32x4*)p; *(f32x4*)p = xv + g * acc[ai][bj][m][n]; } }
    }
};
__device__ __forceinline__ float silu_mul(float g, float u) { return g * __builtin_amdgcn_rcpf(1.0f + __builtin_amdgcn_exp2f(-1.4426950408889634f * g)) * u; }
struct EpiSwiGLU {
    static constexpr bool PERM = true, AFTER_DRAIN = false;
    bf16_t* O; int ldc;
    __device__ __forceinline__ void operator()(const f32x4 (&acc)[2][2][4][2], const Unit& u, int wr, int wc, int fr, int fq) const {
        const int row0 = u.pm * BM + wr * 64 + fr, col0 = u.pn * HALF + wc * 32 + 8 * fq;
#pragma unroll
        for (int ai = 0; ai < 2; ++ai)
#pragma unroll
            for (int m = 0; m < 4; ++m) { const f32x4 g0 = acc[ai][0][m][0], g1 = acc[ai][0][m][1], u0 = acc[ai][1][m][0], u1 = acc[ai][1][m][1];
                u32x4 w; w.x = cvt_pk_bf16(silu_mul(g0[0], u0[0]), silu_mul(g0[1], u0[1])); w.y = cvt_pk_bf16(silu_mul(g0[2], u0[2]), silu_mul(g0[3], u0[3]));
                w.z = cvt_pk_bf16(silu_mul(g1[0], u1[0]), silu_mul(g1[1], u1[1])); w.w = cvt_pk_bf16(silu_mul(g1[2], u1[2]), silu_mul(g1[3], u1[3]));
                *(u32x4*)(O + (size_t)(row0 + ai * HALF + m * 16) * ldc + col0) = w; }
    }
};
struct EpiRowScaleBf16 {
    static constexpr bool PERM = true, AFTER_DRAIN = false;
    bf16_t* O; int ldc; const float* rs;
    __device__ __forceinline__ void operator()(const f32x4 (&acc)[2][2][4][2], const Unit& u, int wr, int wc, int fr, int fq) const {
        const int row0 = u.pm * BM + wr * 64 + fr, col0 = u.pn * BM + wc * 32 + 8 * fq;
#pragma unroll
        for (int ai = 0; ai < 2; ++ai)
#pragma unroll
            for (int m = 0; m < 4; ++m) { const int row = row0 + ai * HALF + m * 16; const float s = rs[row]; bf16_t* rowp = O + (size_t)row * ldc + col0;
#pragma unroll
                for (int bj = 0; bj < 2; ++bj) { const f32x4 v0 = acc[ai][bj][m][0] * s, v1 = acc[ai][bj][m][1] * s;
                    u32x4 w; w.x = cvt_pk_bf16(v0[0], v0[1]); w.y = cvt_pk_bf16(v0[2], v0[3]); w.z = cvt_pk_bf16(v1[0], v1[1]); w.w = cvt_pk_bf16(v1[2], v1[3]);
                    *(u32x4*)(rowp + bj * HALF) = w; } }
    }
};
template <class Epi, class Sched, bool ALIGN_EPI = false, bool SP2 = false>
__device__ __forceinline__ void gemm_phase(PG8_LAS unsigned char* lds, const Gemm g, const Sched& S, const Epi& E) {
    int tid_l = threadIdx.x; asm volatile("" : "+v"(tid_l));
    const int tid = tid_l, wid = __builtin_amdgcn_readfirstlane(tid >> 6), lane = tid & 63, wr = wid >> 2, wc = wid & 3, fr = lane & 15, fq = lane >> 4;
    const int K = g.K, nt = K / BK;
    unsigned voffA[2], voffB[2];
#pragma unroll
    for (int i = 0; i < 2; ++i) { int R, C; stage_rc(tid * 16 + i * 8192, R, C); const int Rb = Epi::PERM ? ((R & ~31) + perm32(R & 31)) : R;
        voffA[i] = (unsigned)(R * K + C) * 2u; voffB[i] = (unsigned)(Rb * K + C) * 2u; }
    const size_t kstep = (size_t)(BK * 2);
    const size_t hstep = (size_t)HALF * K * 2;
    const size_t tstep = 2 * hstep;
    const unsigned ldsw = (unsigned)wid * 1024u;
    const int aoff = lds_byte(wr * 64 + fr, fq * 8), boff = lds_byte(wc * 32 + fr, fq * 8);
#define PG8_SA(b, h) (((b) * 2 + (h)) * HTB)
#define PG8_SB(b, h) ((4 + (b) * 2 + (h)) * HTB)
#define PG8_STAGE(bufoff, gbase, voff) do { _Pragma("unroll") for (int _i = 0; _i < 2; ++_i) \
        __builtin_amdgcn_global_load_lds((const unsigned*)((const char*)(gbase) + (voff)[_i]), (PG8_LAS unsigned*)(lds + (bufoff) + ldsw + _i * 8192), 16, 0, 0); } while (0)
#define PG8_LDA(dst, b, h) do { _Pragma("unroll") for (int m = 0; m < 4; ++m) _Pragma("unroll") for (int k = 0; k < 2; ++k) dst[m][k] = *(const PG8_LAS bf16x8*)(lds + PG8_SA(b, h) + aoff + m * 2048 + k * 1024); } while (0)
#define PG8_LDB(dst, b, h) do { _Pragma("unroll") for (int n = 0; n < 2; ++n) _Pragma("unroll") for (int k = 0; k < 2; ++k) dst[n][k] = *(const PG8_LAS bf16x8*)(lds + PG8_SB(b, h) + boff + n * 2048 + k * 1024); } while (0)
#define PG8_MMA(ai, bj, At, Bt) do { __builtin_amdgcn_s_setprio(1); _Pragma("unroll") for (int m = 0; m < 4; ++m) _Pragma("unroll") for (int n = 0; n < 2; ++n) _Pragma("unroll") for (int k = 0; k < 2; ++k) \
        acc[ai][bj][m][n] = __builtin_amdgcn_mfma_f32_16x16x32_bf16(Bt[n][k], At[m][k], acc[ai][bj][m][n], 0, 0, 0); __builtin_amdgcn_s_setprio(0); } while (0)
#define PG8_WAIT_V(n) asm volatile("s_waitcnt vmcnt(" #n ")" ::: "memory")
#define PG8_WAIT_L(n) asm volatile("s_waitcnt lgkmcnt(" #n ")" ::: "memory")
#define PG8_BAR __builtin_amdgcn_s_barrier()
#define PG8_SCHED __builtin_amdgcn_sched_barrier(0)
    Unit cur, nxt; int ui = 0;
    if (!S.next(0, cur)) return;
    f32x4 acc[2][2][4][2];
#pragma unroll
    for (int a = 0; a < 2; ++a)
#pragma unroll
        for (int b = 0; b < 2; ++b)
#pragma unroll
            for (int m = 0; m < 4; ++m)
#pragma unroll
                for (int n = 0; n < 2; ++n) acc[a][b][m][n] = (f32x4){0.f, 0.f, 0.f, 0.f};
    bf16x8 At[4][2], B0[2][2], B1[2][2];
    const char* cA = (const char*)g.A + (size_t)cur.pm * tstep; const char* cB = (const char*)g.Bt + (size_t)(cur.pm / g.tpe) * g.bgs + (size_t)cur.pn * tstep;
    S.a_ready(cur);
    if constexpr (SP2) {
        PG8_STAGE(PG8_SB(0, 0), cB, voffB); PG8_STAGE(PG8_SB(0, 1), cB + hstep, voffB); PG8_STAGE(PG8_SA(0, 0), cA, voffA); PG8_STAGE(PG8_SA(0, 1), cA + hstep, voffA);
        if (wr == 1) PG8_BAR;
        PG8_WAIT_V(2); PG8_BAR;
        PG8_STAGE(PG8_SB(1, 0), cB + kstep, voffB); PG8_STAGE(PG8_SA(1, 0), cA + kstep, voffA); PG8_STAGE(PG8_SB(1, 1), cB + hstep + kstep, voffB);
        PG8_WAIT_V(6); PG8_BAR;
    } else {
        PG8_STAGE(PG8_SB(0, 0), cB, voffB); PG8_STAGE(PG8_SA(0, 0), cA, voffA); PG8_STAGE(PG8_SB(0, 1), cB + hstep, voffB); PG8_STAGE(PG8_SA(0, 1), cA + hstep, voffA);
        if (wr == 1) PG8_BAR;
        PG8_WAIT_V(4); PG8_BAR;
        PG8_STAGE(PG8_SB(1, 0), cB + kstep, voffB); PG8_STAGE(PG8_SA(1, 0), cA + kstep, voffA); PG8_STAGE(PG8_SB(1, 1), cB + hstep + kstep, voffB);
        PG8_WAIT_V(6); PG8_BAR;
    }
    for (;;) {
        const bool has_next = S.next(ui + 1, nxt);
        const char* nA = has_next ? (const char*)g.A + (size_t)nxt.pm * tstep : cA; const char* nB = has_next ? (const char*)g.Bt + (size_t)(nxt.pm / g.tpe) * g.bgs + (size_t)nxt.pn * tstep : cB;
        for (int t = 0; t < nt; t += 2) {
            const bool last = (t == nt - 2);
            const char* a1 = cA + (size_t)(t + 1) * kstep;
            const char* a2 = last ? nA : cA + (size_t)(t + 2) * kstep; const char* b2 = last ? nB : cB + (size_t)(t + 2) * kstep;
            const char* a3 = a2 + kstep; const char* b3 = b2 + kstep;
            if (last && has_next) S.a_ready(nxt);
            if constexpr (SP2) {
            PG8_LDB(B0, 0, 0); PG8_LDB(B1, 0, 1); PG8_SCHED; PG8_LDA(At, 0, 0); PG8_STAGE(PG8_SA(1, 1), a1 + hstep, voffA);
            PG8_WAIT_V(8); PG8_WAIT_L(0); PG8_BAR; PG8_MMA(0, 0, At, B0); PG8_MMA(0, 1, At, B1); PG8_BAR; PG8_SCHED;
            PG8_LDA(At, 0, 1); PG8_STAGE(PG8_SB(0, 0), b2, voffB); PG8_STAGE(PG8_SB(0, 1), b2 + hstep, voffB); PG8_STAGE(PG8_SA(0, 0), a2, voffA);
            PG8_WAIT_V(8); PG8_WAIT_L(0); PG8_BAR; PG8_MMA(1, 0, At, B0); PG8_MMA(1, 1, At, B1); PG8_BAR; PG8_SCHED;
            PG8_LDB(B0, 1, 0); PG8_LDB(B1, 1, 1); PG8_SCHED; PG8_LDA(At, 1, 0); PG8_STAGE(PG8_SA(0, 1), a2 + hstep, voffA);
            PG8_WAIT_V(8); PG8_WAIT_L(0); PG8_BAR; PG8_MMA(0, 0, At, B0); PG8_MMA(0, 1, At, B1); PG8_BAR; PG8_SCHED;
            PG8_LDA(At, 1, 1); PG8_STAGE(PG8_SB(1, 0), b3, voffB); PG8_STAGE(PG8_SB(1, 1), b3 + hstep, voffB); PG8_STAGE(PG8_SA(1, 0), a3, voffA);
            PG8_WAIT_V(8); PG8_WAIT_L(0); PG8_BAR; PG8_MMA(1, 0, At, B0); PG8_MMA(1, 1, At, B1); PG8_BAR; PG8_SCHED;
            } else {
            PG8_LDB(B0, 0, 0); PG8_SCHED; PG8_LDA(At, 0, 0); PG8_STAGE(PG8_SA(1, 1), a1 + hstep, voffA);
            PG8_WAIT_L(8); PG8_BAR; PG8_WAIT_L(0); PG8_MMA(0, 0, At, B0); PG8_BAR; PG8_SCHED;
            PG8_LDB(B1, 0, 1); PG8_STAGE(PG8_SB(0, 0), b2, voffB);
            PG8_BAR; PG8_WAIT_L(0); PG8_MMA(0, 1, At, B1); PG8_BAR;
            PG8_LDA(At, 0, 1); PG8_STAGE(PG8_SA(0, 0), a2, voffA);
            PG8_BAR; PG8_WAIT_L(0); PG8_MMA(1, 0, At, B0); PG8_BAR; PG8_SCHED;
            PG8_STAGE(PG8_SB(0, 1), b2 + hstep, voffB);
            PG8_WAIT_V(6); PG8_BAR; PG8_MMA(1, 1, At, B1); PG8_BAR;
            PG8_LDB(B0, 1, 0); PG8_SCHED; PG8_LDA(At, 1, 0); PG8_STAGE(PG8_SA(0, 1), a2 + hstep, voffA);
            PG8_WAIT_L(8); PG8_BAR; PG8_WAIT_L(0); PG8_MMA(0, 0, At, B0); PG8_BAR; PG8_SCHED;
            PG8_LDB(B1, 1, 1); PG8_STAGE(PG8_SB(1, 0), b3, voffB);
            PG8_BAR; PG8_WAIT_L(0); PG8_MMA(0, 1, At, B1); PG8_BAR;
            PG8_LDA(At, 1, 1); PG8_STAGE(PG8_SA(1, 0), a3, voffA);
            PG8_BAR; PG8_WAIT_L(0); PG8_MMA(1, 0, At, B0); PG8_BAR; PG8_SCHED;
            PG8_STAGE(PG8_SB(1, 1), b3 + hstep, voffB);
            PG8_WAIT_V(6); PG8_BAR; PG8_MMA(1, 1, At, B1); PG8_BAR;
            }
        }
        if constexpr (ALIGN_EPI) { if (wr == 0) PG8_BAR; }
        if constexpr (!Epi::AFTER_DRAIN) { E(acc, cur, wr, wc, fr, fq); S.done(cur); }
        if (!has_next) break;
#pragma unroll
        for (int a = 0; a < 2; ++a)
#pragma unroll
            for (int b = 0; b < 2; ++b)
#pragma unroll
                for (int m = 0; m < 4; ++m)
#pragma unroll
                    for (int n = 0; n < 2; ++n) acc[a][b][m][n] = (f32x4){0.f, 0.f, 0.f, 0.f};
        cur = nxt; cA = nA; cB = nB; ++ui;
        if constexpr (ALIGN_EPI) { if (wr == 1) PG8_BAR; }
    }
    PG8_WAIT_V(0);
    if constexpr (!ALIGN_EPI) { if (wr == 0) PG8_BAR; }
    PG8_BAR;
    if constexpr (Epi::AFTER_DRAIN) { E.fused(acc, cur, wr, wc, fr, fq, lds, wid, lane); S.done(cur); }
#undef PG8_SA
#undef PG8_SB
#undef PG8_STAGE
#undef PG8_LDA
#undef PG8_LDB
#undef PG8_MMA
#undef PG8_WAIT_V
#undef PG8_WAIT_L
#undef PG8_BAR
#undef PG8_SCHED
}
}
namespace att {
typedef unsigned short bf16_t;
typedef short bf16x8 __attribute__((ext_vector_type(8)));
typedef short s16x4 __attribute__((ext_vector_type(4)));
typedef float f32x16 __attribute__((ext_vector_type(16)));
typedef float f32x4 __attribute__((ext_vector_type(4)));
typedef unsigned u32x4 __attribute__((ext_vector_type(4)));
typedef unsigned u32x2 __attribute__((ext_vector_type(2)));
#define ALDS __attribute__((address_space(3)))
typedef float f32x2_t __attribute__((ext_vector_type(2))); typedef __bf16 bf16x2_t __attribute__((ext_vector_type(2)));
__device__ __forceinline__ unsigned cvtpk(float lo, float hi) { f32x2_t v = {lo, hi}; bf16x2_t b = __builtin_convertvector(v, bf16x2_t); return __builtin_bit_cast(unsigned, b); }
__device__ __forceinline__ float bf2f(unsigned short u) { return __uint_as_float((unsigned)u << 16); }
template <int S> __device__ __forceinline__ bf16x8 pack8(const f32x16& x) {
    u32x4 p; p.x = cvtpk(x[8 * S + 0], x[8 * S + 1]); p.y = cvtpk(x[8 * S + 2], x[8 * S + 3]); p.z = cvtpk(x[8 * S + 4], x[8 * S + 5]); p.w = cvtpk(x[8 * S + 6], x[8 * S + 7]);
    return __builtin_bit_cast(bf16x8, p);
}
typedef short v4i16_t __attribute__((ext_vector_type(4)));
__device__ __forceinline__ s16x4 vtr(const ALDS char* p) { return __builtin_bit_cast(s16x4, __builtin_amdgcn_ds_read_tr16_b64_v4i16((ALDS v4i16_t*)p)); }
__device__ __forceinline__ int crow(int r, int hi) { return (r & 3) + 8 * (r >> 2) + 4 * hi; }
constexpr int ATT_LDS_BYTES = 2 * 12288 + 2 * 8192;

template <int KD, int NMAP>
__device__ __forceinline__ void attn_unit(const bf16_t* __restrict__ Qb, const char* __restrict__ Kt, const char* __restrict__ Vt, int t0, int t1,
                                          bf16_t* __restrict__ Ob, ALDS char* lds, float lam, const float* __restrict__ gout, float oml) {
    constexpr int KTB = KD * 128;
    constexpr int KS = KD / 16 / NMAP;
    int tid_l = threadIdx.x; asm volatile("" : "+v"(tid_l));
    const int tid = tid_l, lane = tid & 63, r32 = lane & 31, hi = lane >> 5, wid = tid >> 6;
    bf16x8 qf[NMAP * KS];
    { const bf16_t* qrow = Qb + (size_t)(wid * 32 + r32) * KD + hi * 8;
#pragma unroll
      for (int ks = 0; ks < NMAP * KS; ++ks) qf[ks] = *(const bf16x8*)(qrow + ks * 16); }
    f32x16 o[NMAP][2]; float l[NMAP];
#pragma unroll
    for (int m = 0; m < NMAP; ++m) { l[m] = 0.f;
#pragma unroll
        for (int d = 0; d < 2; ++d)
#pragma unroll
            for (int r = 0; r < 16; ++r) o[m][d][r] = 0.f; }
    u32x4 kst0, kst1, vst; kst1 = (u32x4){0u, 0u, 0u, 0u};
#define ATT_GLOAD(t) do { const char* kp_ = Kt + (size_t)(t) * KTB; kst0 = *(const u32x4*)(kp_ + tid * 16); if (KD == 96 && tid < 256) kst1 = *(const u32x4*)(kp_ + 8192 + tid * 16); \
        vst = *(const u32x4*)(Vt + (size_t)(t) * 8192 + tid * 16); } while (0)
#define ATT_LSTORE(buf) do { *(ALDS u32x4*)(lds + (buf) * KTB + tid * 16) = kst0; if (KD == 96 && tid < 256) *(ALDS u32x4*)(lds + (buf) * KTB + 8192 + tid * 16) = kst1; \
        *(ALDS u32x4*)(lds + 2 * KTB + (buf) * 8192 + tid * 16) = vst; } while (0)
    ATT_GLOAD(t0); ATT_LSTORE(0); __syncthreads();
    const int voff = (4 * hi + ((lane & 15) >> 2)) * 64 + ((lane >> 4) & 1) * 32 + (lane & 3) * 8;
    for (int t = t0; t < t1; ++t) {
        const int cur = (t - t0) & 1;
        if (t + 1 < t1) ATT_GLOAD(t + 1);
        const ALDS char* kb = lds + cur * KTB + hi * 1024 + r32 * 16;
        const ALDS char* vb = lds + 2 * KTB + cur * 8192 + voff;
        bf16x8 p[NMAP][4];
#pragma unroll
        for (int m = 0; m < NMAP; ++m) {
            f32x16 s0, s1;
#pragma unroll
            for (int r = 0; r < 16; ++r) { s0[r] = 0.f; s1[r] = 0.f; }
#pragma unroll
            for (int s = 0; s < KS; ++s) { const int ks = m * KS + s;
                const bf16x8 a0 = *(const ALDS bf16x8*)(kb + ks * 2048), a1 = *(const ALDS bf16x8*)(kb + ks * 2048 + 512);
                s0 = __builtin_amdgcn_mfma_f32_32x32x16_bf16(a0, qf[ks], s0, 0, 0, 0);
                s1 = __builtin_amdgcn_mfma_f32_32x32x16_bf16(a1, qf[ks], s1, 0, 0, 0); }
            float rs = 0.f;
#pragma unroll
            for (int r = 0; r < 16; ++r) { s0[r] = __builtin_amdgcn_exp2f(s0[r]); s1[r] = __builtin_amdgcn_exp2f(s1[r]); rs += s0[r] + s1[r]; }
            l[m] += rs;
            p[m][0] = pack8<0>(s0); p[m][1] = pack8<1>(s0); p[m][2] = pack8<0>(s1); p[m][3] = pack8<1>(s1);
        }
#pragma unroll
        for (int d = 0; d < 2; ++d)
#pragma unroll
            for (int kk = 0; kk < 4; ++kk) {
                const s16x4 lo = vtr(vb + d * 4096 + kk * 1024), h4 = vtr(vb + d * 4096 + kk * 1024 + 512);
                const bf16x8 vf = (bf16x8){lo[0], lo[1], lo[2], lo[3], h4[0], h4[1], h4[2], h4[3]};
#pragma unroll
                for (int m = 0; m < NMAP; ++m) o[m][d] = __builtin_amdgcn_mfma_f32_32x32x16_bf16(vf, p[m][kk], o[m][d], 0, 0, 0);
            }
        if (t + 1 < t1) ATT_LSTORE(cur ^ 1);
        __syncthreads();
    }
#undef ATT_GLOAD
#undef ATT_LSTORE
    float li[NMAP];
#pragma unroll
    for (int m = 0; m < NMAP; ++m) { const float lt = l[m] + __shfl_xor(l[m], 32); li[m] = 1.0f / lt; }
    float val[2][16];
    if (NMAP == 1) {
#pragma unroll
        for (int d = 0; d < 2; ++d)
#pragma unroll
            for (int r = 0; r < 16; ++r) val[d][r] = o[0][d][r] * li[0];
    } else {
        float ss = 0.f; const float l2 = lam * li[NMAP - 1];
#pragma unroll
        for (int d = 0; d < 2; ++d)
#pragma unroll
            for (int r = 0; r < 16; ++r) { const float v = o[0][d][r] * li[0] - o[NMAP - 1][d][r] * l2; val[d][r] = v; ss += v * v; }
        ss += __shfl_xor(ss, 32);
        const float rstd = rsqrtf(ss * (1.0f / 64.0f) + 1e-6f) * oml;
#pragma unroll
        for (int d = 0; d < 2; ++d)
#pragma unroll
            for (int g = 0; g < 4; ++g) { const f32x4 gv = *(const f32x4*)(gout + 32 * d + 8 * g + 4 * hi);
#pragma unroll
                for (int i = 0; i < 4; ++i) val[d][4 * g + i] *= rstd * gv[i]; }
    }
    bf16_t* orow = Ob + (size_t)(wid * 32 + r32) * 1024 + 4 * hi;
#pragma unroll
    for (int d = 0; d < 2; ++d)
#pragma unroll
        for (int g = 0; g < 4; ++g) { u32x2 w; w.x = cvtpk(val[d][4 * g], val[d][4 * g + 1]); w.y = cvtpk(val[d][4 * g + 2], val[d][4 * g + 3]);
            *(u32x2*)(orow + 32 * d + 8 * g) = w; }
}

template <int KD, int NMAP>
__device__ __forceinline__ void attn_unit_naive(const bf16_t* __restrict__ Qb, const char* __restrict__ Kt, const char* __restrict__ Vt, int t0, int t1,
                                                bf16_t* __restrict__ Ob, ALDS char* lds, float lam, const float* __restrict__ gout, float oml) {
    constexpr int KTB = KD * 128, DMAP = KD / NMAP;
    int tid_l = threadIdx.x; asm volatile("" : "+v"(tid_l));
    const int tid = tid_l, q = tid & 255, dh = tid >> 8;
    float qv[KD];
#pragma unroll
    for (int c = 0; c < KD / 8; ++c) { const u32x4 w = *(const u32x4*)(Qb + (size_t)q * KD + c * 8);
#pragma unroll
        for (int i = 0; i < 4; ++i) { qv[c * 8 + 2 * i] = __uint_as_float(w[i] << 16); qv[c * 8 + 2 * i + 1] = __uint_as_float(w[i] & 0xffff0000u); } }
    float o[NMAP][32], l[NMAP];
#pragma unroll
    for (int m = 0; m < NMAP; ++m) { l[m] = 0.f;
#pragma unroll
        for (int i = 0; i < 32; ++i) o[m][i] = 0.f; }
    for (int t = t0; t < t1; ++t) {
        const char* kt = Kt + (size_t)t * KTB; const char* vt = Vt + (size_t)t * 8192 + dh * 4096;
        for (int key = 0; key < 64; ++key) {
            float pm[NMAP];
#pragma unroll
            for (int m = 0; m < NMAP; ++m) { float s = 0.f;
#pragma unroll
                for (int c = 0; c < DMAP / 8; ++c) { const u32x4 w = *(const u32x4*)(kt + (m * (DMAP / 8) + c) * 1024 + key * 16);
#pragma unroll
                    for (int i = 0; i < 4; ++i) { s += qv[m * DMAP + c * 8 + 2 * i] * __uint_as_float(w[i] << 16); s += qv[m * DMAP + c * 8 + 2 * i + 1] * __uint_as_float(w[i] & 0xffff0000u); } }
                pm[m] = __builtin_amdgcn_exp2f(s); l[m] += pm[m]; }
            const char* vr = vt + (key >> 4) * 1024 + ((key >> 3) & 1) * 512 + (key & 7) * 64;
#pragma unroll
            for (int c = 0; c < 4; ++c) { const u32x4 w = *(const u32x4*)(vr + c * 16);
#pragma unroll
                for (int i = 0; i < 4; ++i) { const float v0 = __uint_as_float(w[i] << 16), v1 = __uint_as_float(w[i] & 0xffff0000u);
#pragma unroll
                    for (int m = 0; m < NMAP; ++m) { o[m][c * 8 + 2 * i] += pm[m] * v0; o[m][c * 8 + 2 * i + 1] += pm[m] * v1; } } }
        }
    }
    float val[32];
    if (NMAP == 1) {
        const float li = 1.0f / l[0];
#pragma unroll
        for (int i = 0; i < 32; ++i) val[i] = o[0][i] * li;
    } else {
        const float l1 = 1.0f / l[0], l2 = lam / l[NMAP - 1]; float ss = 0.f;
#pragma unroll
        for (int i = 0; i < 32; ++i) { val[i] = o[0][i] * l1 - o[NMAP - 1][i] * l2; ss += val[i] * val[i]; }
        ALDS float* ex = (ALDS float*)lds;
        __syncthreads(); ex[tid] = ss; __syncthreads();
        ss += ex[tid ^ 256];
        __syncthreads();
        const float rstd = rsqrtf(ss * (1.0f / 64.0f) + 1e-6f) * oml;
#pragma unroll
        for (int i = 0; i < 32; ++i) val[i] *= rstd * gout[dh * 32 + i];
    }
    bf16_t* orow = Ob + (size_t)q * 1024 + dh * 32;
#pragma unroll
    for (int c = 0; c < 4; ++c) { u32x4 w;
#pragma unroll
        for (int i = 0; i < 4; ++i) w[i] = cvtpk(val[c * 8 + 2 * i], val[c * 8 + 2 * i + 1]);
        *(u32x4*)(orow + c * 8) = w; }
}
}
constexpr int NWAVES = 8;
constexpr int DM = 1024, NB = 4, SEQ = 8192, CL = 256, NTOKB = SEQ + CL, LROWS = NB * SEQ, MROWS = LROWS + NB * CL;
constexpr int NLAYER = 2, INC = 1952, ZP = 3072, NE = 16, FFD = 2048, CAPL = 1024, CAPC = 32, NKT = NTOKB / 64;
constexpr int ZQ = 1952, ZKV = 2336, ZEND = 2848;
constexpr float EPSF = 1e-6f, LOG2E = 1.4426950408889634f;
constexpr int N_PHASES = 22;
enum { I_X = 0, I_C, I_CTX, I_CCTX, I_WADA, I_BADA, I_GN1, I_WIN, I_GCQ, I_GCKV, I_WUQ, I_WUKV, I_GMQ, I_GMK, I_GDQ, I_GDK, I_LQ1, I_LK1, I_LQ2, I_LK2, I_GDO, I_GGQ, I_GGK, I_WO, I_GN2, I_WR, I_WG, I_WU, I_WD, N_IN };
constexpr size_t MiB = 1u << 20;
constexpr size_t WS_CTL = 0, CTL_ZERO_BYTES = 1 * MiB;
constexpr size_t WS_MOD = 1 * MiB;
constexpr size_t WS_LAM = WS_MOD + 256 * 1024;
constexpr size_t WS_TAB = WS_MOD + 320 * 1024;
constexpr size_t TAB_AROW = 0, TAB_ACOL = 128 * 8 * 8, TAB_GROW = TAB_ACOL + 64 * 8 * 8, TAB_GCOL = TAB_GROW + 128 * 16 * 8;
constexpr size_t WS_AFF = 2 * MiB, WS_AFFC = 4 * MiB;
constexpr size_t WS_IDX = 5 * MiB, WS_GATE = 6 * MiB;
constexpr size_t WS_INV = 7 * MiB;
constexpr size_t WS_WCAT = 16 * MiB;
constexpr size_t WS_WO = 28 * MiB;
constexpr size_t WS_CTXW = 32 * MiB;
constexpr size_t WS_H = 36 * MiB;
constexpr size_t WS_WGU = 102 * MiB;
constexpr size_t WS_WD = 230 * MiB;
constexpr size_t WS_YE = 294 * MiB;
constexpr size_t WS_Z = 430 * MiB;
constexpr size_t WS_QKV = 628 * MiB;
constexpr size_t WS_ATT = 793 * MiB;
constexpr size_t WS_XE = 430 * MiB;
constexpr size_t WS_HID = 566 * MiB;
constexpr size_t WS_END = 859 * MiB;
constexpr size_t QO_QM = 0, QO_QD = 25952256, QO_QG = 43253760, QO_KM = 77856768, QO_KD = 103809024, QO_KG = 121110528, QO_VM = 129761280, QO_VD = 147062784, QO_VG = 164364288;
static_assert(QO_VG + 8650752 == 173015040 && WS_QKV + 173015040 <= WS_ATT && WS_HID + (size_t)16 * 4352 * 2048 * 2 <= WS_END, "ws map");
constexpr int CW_BAR = 4096, CW_Q = 16384;
constexpr int RING_BYTES = 131072, LDSCTL_OFF = RING_BYTES, MISC_OFF = LDSCTL_OFF + 320, LDS_BYTES = 147456;

#define GAS __attribute__((address_space(1)))
#define LAS __attribute__((address_space(3)))
typedef unsigned short bf16;
typedef unsigned v4u __attribute__((ext_vector_type(4)));
typedef unsigned v2u __attribute__((ext_vector_type(2)));
typedef float f32x4 __attribute__((ext_vector_type(4)));
typedef float f32x2 __attribute__((ext_vector_type(2)));
typedef GAS unsigned gu32;
#define RLX_AGENT __ATOMIC_RELAXED, __HIP_MEMORY_SCOPE_AGENT
#define LDS_WAIT() asm volatile("s_waitcnt lgkmcnt(0)" ::: "memory")
__device__ __forceinline__ unsigned pk2(float lo, float hi) { return att::cvtpk(lo, hi); }
__device__ __forceinline__ float bflo(unsigned w) { return __uint_as_float(w << 16); }
__device__ __forceinline__ float bfhi(unsigned w) { return __uint_as_float(w & 0xffff0000u); }
#define XB_TMO      128
#define XB_XCNT(j)  (256  + 64 * (j))
#define XB_XSUB(j)  (1280 + 64 * (j))
#define XB_XGEN(j)  (2304 + 64 * (j))
#define XB_TOP      3328
#define XB_TOPGEN   3392
#define XCD_BAR_WORDS 3456
#define XB_SPIN_CAP (1u << 18)

__device__ __forceinline__ unsigned xb_ld(unsigned* p)              { return __hip_atomic_load(p, __ATOMIC_RELAXED, __HIP_MEMORY_SCOPE_AGENT); }
__device__ __forceinline__ unsigned xb_add(unsigned* p, unsigned v) { return __hip_atomic_fetch_add(p, v, __ATOMIC_RELAXED, __HIP_MEMORY_SCOPE_AGENT); }
__device__ __forceinline__ unsigned xb_xcc_id() { return (unsigned)__builtin_amdgcn_s_getreg((3 << 11) | 20) & 0xFu; }
#define XB_SPIN(cond, bar) do { unsigned _sp = 0; while (cond) { __builtin_amdgcn_s_sleep(1); \
    if ((++_sp & 255u) == 0u) { if (xb_ld(&(bar)[XB_TMO])) break; if (_sp > XB_SPIN_CAP) { atomicAdd(&(bar)[XB_TMO], 1u); break; } } } } while (0)

struct XcdBarrier {
    unsigned* bar; unsigned x;
    volatile LAS unsigned* st;
};

__device__ __forceinline__ XcdBarrier xcd_barrier_post(unsigned* bar, volatile LAS unsigned* st) {
    XcdBarrier b; b.bar = bar; b.x = xb_xcc_id(); b.st = st;
    if (threadIdx.x == 0) (void)xb_add(&bar[XB_XCNT(b.x)], 1u);
    return b;
}
__device__ __forceinline__ void xcd_barrier_complete(unsigned* bar, unsigned x, unsigned& nloc, unsigned& nx) {
    const unsigned G = gridDim.x * gridDim.y * gridDim.z;
    unsigned sum, cnt, mine, sp = 0u;
    for (;;) {
        sum = 0u; cnt = 0u; mine = 0u;
#pragma unroll
        for (unsigned j = 0; j < 16; ++j) { const unsigned c = xb_ld(&bar[XB_XCNT(j)]); sum += c; cnt += (c > 0u) ? 1u : 0u; mine = (j == x) ? c : mine; }
        if (sum == G) break;
        __builtin_amdgcn_s_sleep(1);
        if ((++sp & 255u) == 0u) { if (xb_ld(&bar[XB_TMO])) break; if (sp > XB_SPIN_CAP) { atomicAdd(&bar[XB_TMO], 1u); break; } }
    }
    nloc = mine > 0u ? mine : 1u; nx = cnt > 0u ? cnt : 1u;
}

__device__ __forceinline__ void xcd_barrier(const XcdBarrier& b) {
    asm volatile("s_waitcnt vmcnt(0)" ::: "memory");
    __syncthreads();
    if (threadIdx.x == 0) {
        unsigned* bar = b.bar;
        __builtin_amdgcn_s_waitcnt(0);
        unsigned nloc = b.st[0], nx = b.st[1];
        if (nloc == 0u) { xcd_barrier_complete(bar, b.x, nloc, nx); b.st[0] = nloc; b.st[1] = nx; }
        const unsigned old = xb_add(&bar[XB_XSUB(b.x)], 1u);
        const unsigned gen = old / nloc;
        if (old + 1u == (gen + 1u) * nloc) {
            __builtin_amdgcn_fence(__ATOMIC_RELEASE, "agent");
            asm volatile("s_waitcnt vmcnt(0)" ::: "memory");
            const unsigned og = xb_add(&bar[XB_TOP], 1u);
            const unsigned tg = og / nx;
            if (og + 1u == (tg + 1u) * nx) xb_add(&bar[XB_TOPGEN], 1u);
            else XB_SPIN(xb_ld(&bar[XB_TOPGEN]) == tg, bar);
            __builtin_amdgcn_fence(__ATOMIC_ACQUIRE, "agent");
            xb_add(&bar[XB_XGEN(b.x)], 1u);
            asm volatile("s_waitcnt vmcnt(0)" ::: "memory");
        } else {
            XB_SPIN(xb_ld(&bar[XB_XGEN(b.x)]) == gen, bar);
            __builtin_amdgcn_fence(__ATOMIC_ACQUIRE, "agent");
            asm volatile("s_waitcnt vmcnt(0)" ::: "memory");
        }
    }
    __syncthreads();
}
struct Args { const float* in[N_IN]; float* out; unsigned char* ws; int ph_lo, ph_hi; };
static_assert(sizeof(Args) == 256, "Args has no padding bytes");
typedef const __attribute__((address_space(4))) Args* KA;
__device__ __forceinline__ KA kargs() { KA p = (KA)__builtin_amdgcn_kernarg_segment_ptr(); asm volatile("" : "+s"(p)); return p; }
struct Frame {
    LAS unsigned char* lds;
    volatile LAS unsigned* MISC;
    gu32* ctl;
    int tid, lane, wave, vcu, G;
};
__device__ __forceinline__ void relane(Frame& F) { int t = threadIdx.x; asm volatile("" : "+v"(t)); F.tid = t; F.lane = t & 63; F.wave = __builtin_amdgcn_readfirstlane(t >> 6); }
__device__ __forceinline__ float wave_sum(float v) {
#pragma unroll
    for (int o = 1; o < 64; o <<= 1) v += __shfl_xor(v, o);
    return v;
}
__device__ __forceinline__ float silu_f(float x) { return x / (1.0f + __expf(-x)); }

__device__ __forceinline__ void transpose_item(const float* __restrict__ W, int N, bf16* __restrict__ WT, int ldt, int k0, int n0, int rowbase, LAS float* scr, int lane) {
#pragma unroll 8
    for (int i = 0; i < 32; ++i) { const int kk = 2 * i + (lane >> 5); scr[kk * 33 + (lane & 31)] = W[(size_t)(k0 + kk) * N + n0 + (lane & 31)]; }
    LDS_WAIT(); asm volatile("" ::: "memory");
    const int c = lane & 7;
#pragma unroll
    for (int j = 0; j < 4; ++j) { const int n = (lane >> 3) + 8 * j; const LAS float* s = scr + (8 * c) * 33 + n;
        v4u o; o.x = pk2(s[0 * 33], s[1 * 33]); o.y = pk2(s[2 * 33], s[3 * 33]); o.z = pk2(s[4 * 33], s[5 * 33]); o.w = pk2(s[6 * 33], s[7 * 33]);
        *(v4u*)(WT + (size_t)(rowbase + n) * ldt + k0 + 8 * c) = o; }
    LDS_WAIT(); asm volatile("" ::: "memory");
}

__device__ __forceinline__ void sincos_d(float af, float& c, float& s) {
    const double a = (double)af;
    const double q = __builtin_rint(a * 0.63661977236758134308);
    double r = __builtin_fma(-q, 1.57079632679489655800e+00, a); r = __builtin_fma(-q, 6.12323399573676603587e-17, r);
    const double r2 = r * r;
    double sp = -7.6471637318198164759e-13; sp = sp * r2 + 1.6059043836821614599e-10; sp = sp * r2 - 2.5052108385441718775e-08; sp = sp * r2 + 2.7557319223985890653e-06;
    sp = sp * r2 - 1.9841269841269841270e-04; sp = sp * r2 + 8.3333333333333333333e-03; sp = sp * r2 - 1.6666666666666666667e-01; const double sn = r + r * r2 * sp;
    double cp = 4.7794773323873852974e-14; cp = cp * r2 - 1.1470745597729724714e-11; cp = cp * r2 + 2.0876756987868098979e-09; cp = cp * r2 - 2.7557319223985890653e-07;
    cp = cp * r2 + 2.4801587301587301587e-05; cp = cp * r2 - 1.3888888888888888889e-03; cp = cp * r2 + 4.1666666666666666667e-02; cp = cp * r2 - 0.5; const double cs = 1.0 + r2 * cp;
    const int qi = (int)q & 3;
    const double cc = (qi == 0) ? cs : (qi == 1) ? -sn : (qi == 2) ? -cs : sn;
    const double ss = (qi == 0) ? sn : (qi == 1) ? cs : (qi == 2) ? -sn : -cs;
    c = (float)cc; s = (float)ss;
}

#define MEMFENCE() asm volatile("" ::: "memory")
__device__ __forceinline__ void p0_prologue(KA a, Frame& F) {
    relane(F);
    unsigned char* ws = a->ws;
    float* MOD = (float*)(ws + WS_MOD);
    for (int it = blockIdx.x; it < 192; it += F.G) {
        const int l = it / 96, col = (it % 96) * 64 + F.lane;
        const float* W = a->in[I_WADA] + (size_t)l * 1024 * 6144;
        float acc[5] = {0.f, 0.f, 0.f, 0.f, 0.f};
        for (int kk = 0; kk < 128; ++kk) { const int k = F.wave * 128 + kk; const float w = W[(size_t)k * 6144 + col];
#pragma unroll
            for (int v = 0; v < 5; ++v) { const float cv = (v < 4) ? a->in[I_C][v * 1024 + k] : a->in[I_CCTX][k]; acc[v] += silu_f(cv) * w; } }
        LAS float* red = (LAS float*)F.lds;
#pragma unroll
        for (int v = 0; v < 5; ++v) red[(F.wave * 5 + v) * 64 + F.lane] = acc[v];
        __syncthreads();
        if (F.wave < 5) { float s = a->in[I_BADA][l * 6144 + col];
#pragma unroll
            for (int w = 0; w < 8; ++w) s += red[(w * 5 + F.wave) * 64 + F.lane];
            MOD[(l * 5 + F.wave) * 6144 + col] = s; }
        __syncthreads();
    }
    if ((int)blockIdx.x == 192 % F.G && F.wave == 0) {
        float* LAM = (float*)(ws + WS_LAM);
        for (int l = 0; l < NLAYER; ++l) {
            const float p1 = F.lane < 32 ? a->in[I_LQ1][l * 32 + F.lane] * a->in[I_LK1][l * 32 + F.lane] : 0.f;
            const float p2 = F.lane < 32 ? a->in[I_LQ2][l * 32 + F.lane] * a->in[I_LK2][l * 32 + F.lane] : 0.f;
            const float s1 = wave_sum(p1), s2 = wave_sum(p2);
            const float li = 0.8f - 0.6f * expf(-0.3f * (float)l);
            if (F.lane == 0) { LAM[2 * l] = expf(s1) - expf(s2) + li; LAM[2 * l + 1] = li; }
        }
    }
    if ((int)blockIdx.x == 193 % F.G) {
        f32x2* TA_R = (f32x2*)(ws + WS_TAB + TAB_AROW); f32x2* TA_C = (f32x2*)(ws + WS_TAB + TAB_ACOL); f32x2* TG_R = (f32x2*)(ws + WS_TAB + TAB_GROW); f32x2* TG_C = (f32x2*)(ws + WS_TAB + TAB_GCOL);
        const double b8 = 1.0 / __builtin_sqrt(__builtin_sqrt(__builtin_sqrt(10000.0))), b16 = 1.0 / __builtin_sqrt(__builtin_sqrt(__builtin_sqrt(__builtin_sqrt(10000.0))));
        for (int e = F.tid; e < 4608; e += NWAVES * 64) {
            int pos, i, nf; f32x2* dst;
            if (e < 1024) { pos = e >> 3; i = e & 7; nf = 8; dst = TA_R + e; }
            else if (e < 1536) { const int r = e - 1024; pos = r >> 3; i = r & 7; nf = 8; dst = TA_C + r; }
            else if (e < 3584) { const int r = e - 1536; pos = r >> 4; i = r & 15; nf = 16; dst = TG_R + r; }
            else { const int r = e - 3584; pos = r >> 4; i = r & 15; nf = 16; dst = TG_C + r; }
            double inv = 1.0; const double bb = (nf == 8) ? b8 : b16;
            for (int j = 0; j < i; ++j) inv *= bb;
            const float ang = (float)pos * (float)inv;
            float c, s; sincos_d(ang, c, s);
            *dst = (f32x2){c, s};
        }
    }
    for (int it = blockIdx.x; it < 896; it += F.G) {
        const int l = it / 448; int r = it % 448;
        int kb, nb, R, roff, ncols, orow0; const float *Wu, *gg;
        if (r < 192) { kb = r / 6; nb = r % 6; R = 256; roff = 0; ncols = 384; orow0 = ZQ + nb * 64; Wu = a->in[I_WUQ] + (size_t)l * 256 * 384; gg = a->in[I_GCQ] + l * 256; }
        else { r -= 192; kb = r / 8; nb = r % 8; R = 128; roff = 256; ncols = 512; orow0 = ZKV + nb * 64; Wu = a->in[I_WUKV] + (size_t)l * 128 * 512; gg = a->in[I_GCKV] + l * 128; }
        const float* Win = a->in[I_WIN] + (size_t)l * 1024 * INC;
        LAS float* As = (LAS float*)F.lds; LAS float* Bs = As + 32 * 257;
        for (int idx = F.tid; idx < 32 * R; idx += NWAVES * 64) { const int kk = idx / R, rr = idx % R; As[kk * 257 + rr] = Win[(size_t)(kb * 32 + kk) * INC + roff + rr]; }
        for (int idx = F.tid; idx < R * 64; idx += NWAVES * 64) { const int rr = idx >> 6, n = idx & 63; Bs[rr * 64 + n] = gg[rr] * Wu[(size_t)rr * ncols + nb * 64 + n]; }
        __syncthreads();
        const int kk = F.tid & 31, ng = F.tid >> 5;
        f32x4 acc = (f32x4){0.f, 0.f, 0.f, 0.f};
        for (int rr = 0; rr < R; ++rr) { const float av = As[kk * 257 + rr]; const f32x4 bv = *(const LAS f32x4*)(Bs + rr * 64 + ng * 4); acc += av * bv; }
        bf16* Wc = (bf16*)(ws + WS_WCAT) + (size_t)l * ZP * 1024;
#pragma unroll
        for (int j = 0; j < 4; ++j) Wc[(size_t)(orow0 + ng * 4 + j) * 1024 + kb * 32 + kk] = (bf16)(pk2(acc[j], 0.f) & 0xffffu);
        __syncthreads();
    }
    {
        LAS float* scr = (LAS float*)(F.lds + F.wave * 16384);
        const int gw = F.vcu * NWAVES + F.wave, NGW = F.G * NWAVES;
        constexpr int I_IN = 16 * 61, I_O = 16 * 32, PER_L = I_IN + I_O;
        for (int it = gw; it < NLAYER * PER_L; it += NGW) {
            const int l = it / PER_L; int r = it % PER_L;
            if (r < I_IN) { const int kb = r / 61, nb = r % 61; transpose_item(a->in[I_WIN] + (size_t)l * 1024 * INC, INC, (bf16*)(ws + WS_WCAT) + (size_t)l * ZP * 1024, 1024, kb * 64, nb * 32, nb * 32, scr, F.lane); }
            else { r -= I_IN; const int kb = r / 32, nb = r % 32; transpose_item(a->in[I_WO] + (size_t)l * 1024 * 1024, 1024, (bf16*)(ws + WS_WO) + (size_t)l * 1024 * 1024, 1024, kb * 64, nb * 32, nb * 32, scr, F.lane); }
        }
        const int gt = F.vcu * (NWAVES * 64) + F.tid, NGT = F.G * NWAVES * 64;
        constexpr int PADV = (ZP - ZEND) * 1024 * 2 / 16;
        for (int i = gt; i < NLAYER * PADV; i += NGT) { const int l = i / PADV, j = i % PADV; ((v4u*)((bf16*)(ws + WS_WCAT) + ((size_t)l * ZP + ZEND) * 1024))[j] = (v4u){0u, 0u, 0u, 0u}; }
    }
}

__device__ __forceinline__ void phase_a(KA a, Frame& F, int l) {
    relane(F);
    unsigned char* ws = a->ws;
    const float* MOD = (const float*)(ws + WS_MOD);
    const int* INV = (const int*)(ws + WS_INV);
    const bf16* YE = (const bf16*)(ws + WS_YE);
    float* CTXW = (float*)(ws + WS_CTXW);
    bf16* H = (bf16*)(ws + WS_H);
    const bool fin = (l == NLAYER);
    const int nrows = fin ? LROWS : MROWS;
    const int gw = F.vcu * NWAVES + F.wave, NGW = F.G * NWAVES;
    for (int row = gw; row < nrows; row += NGW) {
        const bool isc = row >= LROWS; const int v = isc ? 4 : (row >> 13);
        const float* src = (l == 0) ? (isc ? a->in[I_CTX] + (size_t)(row - LROWS) * 1024 : a->in[I_X] + (size_t)row * 1024)
                                    : (isc ? CTXW + (size_t)(row - LROWS) * 1024 : a->out + (size_t)row * 1024);
        float* dst = isc ? CTXW + (size_t)(row - LROWS) * 1024 : a->out + (size_t)row * 1024;
        f32x4 xv[4];
#pragma unroll
        for (int j = 0; j < 4; ++j) xv[j] = *(const f32x4*)(src + 4 * F.lane + 256 * j);
        if (l > 0) {
            const float* ga2 = MOD + ((l - 1) * 5 + v) * 6144 + 5 * 1024;
            f32x4 acc[4];
#pragma unroll
            for (int j = 0; j < 4; ++j) acc[j] = (f32x4){0.f, 0.f, 0.f, 0.f};
            for (int e = 0; e < NE; ++e) {
                const int s = __builtin_amdgcn_readfirstlane(INV[(size_t)row * 16 + e]);
                if (s >= 0) { const bf16* yr = YE + (size_t)s * 1024 + 4 * F.lane;
#pragma unroll
                    for (int j = 0; j < 4; ++j) { const v2u w = *(const v2u*)(yr + 256 * j); acc[j] += (f32x4){bflo(w.x), bfhi(w.x), bflo(w.y), bfhi(w.y)}; } }
            }
#pragma unroll
            for (int j = 0; j < 4; ++j) { const f32x4 g = *(const f32x4*)(ga2 + 4 * F.lane + 256 * j); xv[j] += g * acc[j]; }
        }
#pragma unroll
        for (int j = 0; j < 4; ++j) *(f32x4*)(dst + 4 * F.lane + 256 * j) = xv[j];
        if (fin) continue;
        float ss = 0.f;
#pragma unroll
        for (int j = 0; j < 4; ++j) ss += (xv[j].x * xv[j].x + xv[j].y * xv[j].y) + (xv[j].z * xv[j].z + xv[j].w * xv[j].w);
        const float rstd = rsqrtf(wave_sum(ss) * (1.0f / 1024.0f) + EPSF);
        const float* g1 = a->in[I_GN1] + l * 1024; const float* sh = MOD + (l * 5 + v) * 6144; const float* sc = sh + 1024;
#pragma unroll
        for (int j = 0; j < 4; ++j) { const int c0 = 4 * F.lane + 256 * j; const f32x4 g = *(const f32x4*)(g1 + c0), s1 = *(const f32x4*)(sc + c0), b1 = *(const f32x4*)(sh + c0);
            const f32x4 h = xv[j] * rstd * g * (1.0f + s1) + b1;
            v2u w; w.x = pk2(h.x, h.y); w.y = pk2(h.z, h.w); *(v2u*)(H + (size_t)row * 1024 + c0) = w; }
    }
}

__device__ __forceinline__ void ld8(const bf16* p, float* f) { const v4u w = *(const v4u*)p; f[0] = bflo(w.x); f[1] = bfhi(w.x); f[2] = bflo(w.y); f[3] = bfhi(w.y); f[4] = bflo(w.z); f[5] = bfhi(w.z); f[6] = bflo(w.w); f[7] = bfhi(w.w); }
__device__ __forceinline__ v4u pk8(const float* f) { v4u w; w.x = pk2(f[0], f[1]); w.y = pk2(f[2], f[3]); w.z = pk2(f[4], f[5]); w.w = pk2(f[6], f[7]); return w; }
template <int N> __device__ __forceinline__ float ssq_row(const bf16* p) { float s = 0.f;
#pragma unroll
    for (int c = 0; c < N / 8; ++c) { float f[8]; ld8(p + 8 * c, f);
#pragma unroll
        for (int i = 0; i < 8; ++i) s += f[i] * f[i];
        if ((c & 7) == 7) MEMFENCE(); }
    return s; }
template <int NP> __device__ __forceinline__ void rope_pairs(float* x, const f32x2* trow, const f32x2* tcol) {
#pragma unroll
    for (int i = 0; i < NP; ++i) { const f32x2 cs = (i < NP / 2) ? trow[i] : tcol[i - NP / 2];
        const float x0 = x[2 * i], x1 = x[2 * i + 1]; x[2 * i] = x0 * cs.x - x1 * cs.y; x[2 * i + 1] = x0 * cs.y + x1 * cs.x; }
}
__device__ __forceinline__ void store_v_tile(char* vt, int lane, const float* v  ) {
    char* p = vt + (lane >> 4) * 1024 + ((lane >> 3) & 1) * 512 + (lane & 7) * 64;
#pragma unroll
    for (int d = 0; d < 2; ++d)
#pragma unroll
        for (int c = 0; c < 4; ++c) *(v4u*)(p + d * 4096 + c * 16) = pk8(v + d * 32 + c * 8);
}
template <bool ROPE> __device__ __forceinline__ v4u proc8(v4u w, float r, const float* g, const f32x2* cs, float qs) {
    float f[8] = {bflo(w.x), bfhi(w.x), bflo(w.y), bfhi(w.y), bflo(w.z), bfhi(w.z), bflo(w.w), bfhi(w.w)};
#pragma unroll
    for (int i = 0; i < 8; ++i) f[i] *= r * g[i];
    if (ROPE) {
#pragma unroll
        for (int i = 0; i < 4; ++i) { const f32x2 t = cs[i]; const float x0 = f[2 * i], x1 = f[2 * i + 1]; f[2 * i] = x0 * t.x - x1 * t.y; f[2 * i + 1] = x0 * t.y + x1 * t.x; }
    }
#pragma unroll
    for (int i = 0; i < 8; ++i) f[i] *= qs;
    return pk8(f);
}
__device__ __forceinline__ float ssq8(v4u w) { const float f[8] = {bflo(w.x), bfhi(w.x), bflo(w.y), bfhi(w.y), bflo(w.z), bfhi(w.z), bflo(w.w), bfhi(w.w)}; float s = 0.f;
#pragma unroll
    for (int i = 0; i < 8; ++i) s += f[i] * f[i];
    return s; }
__device__ __forceinline__ v4u scale8(v4u w, float r) { float f[8] = {bflo(w.x), bfhi(w.x), bflo(w.y), bfhi(w.y), bflo(w.z), bfhi(w.z), bflo(w.w), bfhi(w.w)};
#pragma unroll
    for (int i = 0; i < 8; ++i) f[i] *= r;
    return pk8(f); }
__device__ __forceinline__ void store_v_tile_pk(char* vt, int lane, const v4u* w) {
    char* p = vt + (lane >> 4) * 1024 + ((lane >> 3) & 1) * 512 + (lane & 7) * 64;
#pragma unroll
    for (int c = 0; c < 8; ++c) *(v4u*)(p + (c >> 2) * 4096 + (c & 3) * 16) = w[c];
}
__device__ __forceinline__ void phase_c(KA a, Frame& F, int l) {
    relane(F);
    unsigned char* ws = a->ws;
    const bf16* Z = (const bf16*)(ws + WS_Z);
    unsigned char* qkv = ws + WS_QKV;
    const f32x2* TA_R = (const f32x2*)(ws + WS_TAB + TAB_AROW); const f32x2* TA_C = (const f32x2*)(ws + WS_TAB + TAB_ACOL);
    const f32x2* TG_R = (const f32x2*)(ws + WS_TAB + TAB_GROW); const f32x2* TG_C = (const f32x2*)(ws + WS_TAB + TAB_GCOL);
    const int gw = F.vcu * NWAVES + F.wave, NGW = F.G * NWAVES, lane = F.lane;
    for (int id = gw; id < 528 * 32; id += NGW) {
        const int tile = id % 528, job = id / 528;
        const int b = tile / NKT, tt = tile % NKT; const bool isc = tt >= 128;
        const int zrow = isc ? LROWS + b * CL + (tt - 128) * 64 + lane : b * SEQ + tt * 64 + lane;
        const int tok = tt * 64 + lane;
        const bf16* zr = Z + (size_t)zrow * ZP;
        const f32x2* tar = TA_R + (isc ? 0 : tt) * 8; const f32x2* tac = TA_C + lane * 8;
        const f32x2* tgr = TG_R + (isc ? 0 : tt) * 16; const f32x2* tgc = TG_C + lane * 16;
        MEMFENCE();
        if (job < 4) {
            const int h = job;
            const float r1 = rsqrtf(ssq_row<256>(zr) * (1.0f / 256.0f) + EPSF);
            MEMFENCE();
            v4u w[12]; float ss = 0.f;
#pragma unroll
            for (int c = 0; c < 12; ++c) { w[c] = *(const v4u*)(zr + ZQ + h * 96 + 8 * c); ss += ssq8(w[c]); }
            MEMFENCE();
            const float r = r1 * rsqrtf(ss * r1 * r1 * (1.0f / 96.0f) + EPSF); const float* g = a->in[I_GMQ] + l * 96;
            const float qs = 0.10206207261596575f * LOG2E;
            bf16* q = (bf16*)(qkv + QO_QM) + ((size_t)(b * 4 + h) * NTOKB + tok) * 96;
#pragma unroll
            for (int c = 0; c < 12; ++c) {
                v4u o;
                if (c < 8 || isc) o = proc8<false>(w[c], r, g + 8 * c, nullptr, qs);
                else o = proc8<true>(w[c], r, g + 8 * c, (c < 10) ? tar + 4 * (c - 8) : tac + 4 * (c - 10), qs);
                *(v4u*)(q + 8 * c) = o; MEMFENCE(); }
        } else if (job < 8) {
            const int h = job - 4;
            const float r1 = rsqrtf(ssq_row<128>(zr + 256) * (1.0f / 128.0f) + EPSF);
            MEMFENCE();
            v4u w[12]; float ss = 0.f, s2 = 0.f;
#pragma unroll
            for (int c = 0; c < 8; ++c) { w[c] = *(const v4u*)(zr + ZKV + h * 128 + 8 * c); ss += ssq8(w[c]); }
#pragma unroll
            for (int c = 0; c < 4; ++c) { w[8 + c] = *(const v4u*)(zr + 384 + 8 * c); s2 += ssq8(w[8 + c]); }
            MEMFENCE();
            const float r2 = rsqrtf((ss * r1 * r1 + s2) * (1.0f / 96.0f) + EPSF); const float* g = a->in[I_GMK] + l * 96;
            char* kt = (char*)(qkv + QO_KM) + ((size_t)(b * 4 + h) * NKT + tt) * 12288 + lane * 16;
#pragma unroll
            for (int c = 0; c < 12; ++c) {
                v4u o;
                if (c < 8) o = proc8<false>(w[c], r1 * r2, g + 8 * c, nullptr, 1.0f);
                else if (isc) o = proc8<false>(w[c], r2, g + 8 * c, nullptr, 1.0f);
                else o = proc8<true>(w[c], r2, g + 8 * c, (c < 10) ? tar + 4 * (c - 8) : tac + 4 * (c - 10), 1.0f);
                *(v4u*)(kt + c * 1024) = o; MEMFENCE(); }
            v4u vw[8];
#pragma unroll
            for (int c = 0; c < 8; ++c) vw[c] = scale8(*(const v4u*)(zr + ZKV + h * 128 + 64 + 8 * c), r1);
            store_v_tile_pk((char*)(qkv + QO_VM) + ((size_t)(b * 4 + h) * NKT + tt) * 8192, lane, vw);
        } else if (job < 16) {
            const bool isk = job >= 12; const int h = (job - 8) & 3;
            const bf16* zp = zr + (isk ? 672 : 416) + h * 64; const float* g = (isk ? a->in[I_GDK] : a->in[I_GDQ]) + l * 32;
            const float qs = isk ? 1.0f : 0.17677669529663687f * LOG2E;
            v4u w[8]; float ss[2] = {0.f, 0.f};
#pragma unroll
            for (int c = 0; c < 8; ++c) { w[c] = *(const v4u*)(zp + 8 * c); ss[c >> 2] += ssq8(w[c]); }
            MEMFENCE();
            const float r0 = rsqrtf(ss[0] * (1.0f / 32.0f) + EPSF), r1 = rsqrtf(ss[1] * (1.0f / 32.0f) + EPSF);
            char* kt = (char*)(qkv + QO_KD) + ((size_t)(b * 4 + h) * NKT + tt) * 8192 + lane * 16;
            bf16* q = (bf16*)(qkv + QO_QD) + ((size_t)(b * 4 + h) * NTOKB + tok) * 64;
#pragma unroll
            for (int c = 0; c < 8; ++c) { const int cm = c & 3;
                v4u o;
                if (isc) o = proc8<false>(w[c], (c < 4) ? r0 : r1, g + 8 * cm, nullptr, qs);
                else o = proc8<true>(w[c], (c < 4) ? r0 : r1, g + 8 * cm, (cm < 2) ? tar + 4 * cm : tac + 4 * (cm - 2), qs);
                if (isk) *(v4u*)(kt + c * 1024) = o; else *(v4u*)(q + 8 * c) = o;
                MEMFENCE(); }
        } else if (job < 20) {
            const int h = job - 16; v4u vw[8];
#pragma unroll
            for (int c = 0; c < 8; ++c) vw[c] = *(const v4u*)(zr + 928 + h * 64 + 8 * c);
            store_v_tile_pk((char*)(qkv + QO_VD) + ((size_t)(b * 4 + h) * NKT + tt) * 8192, lane, vw);
        } else if (job < 30) {
            const bool isk = job >= 28; const int h = isk ? job - 28 : job - 20;
            const bf16* zp = zr + (isk ? 1696 : 1184) + h * 64; const float* g = (isk ? a->in[I_GGK] : a->in[I_GGQ]) + l * 64;
            const float qs = isk ? 1.0f : 0.125f * LOG2E;
            v4u w[8]; float ss = 0.f;
#pragma unroll
            for (int c = 0; c < 8; ++c) { w[c] = *(const v4u*)(zp + 8 * c); ss += ssq8(w[c]); }
            MEMFENCE();
            const float r = rsqrtf(ss * (1.0f / 64.0f) + EPSF);
            char* kt = (char*)(qkv + QO_KG) + ((size_t)(b * 2 + h) * NKT + tt) * 8192 + lane * 16;
            bf16* q = (bf16*)(qkv + QO_QG) + ((size_t)(b * 8 + h) * NTOKB + tok) * 64;
#pragma unroll
            for (int c = 0; c < 8; ++c) {
                v4u o;
                if (isc) o = proc8<false>(w[c], r, g + 8 * c, nullptr, qs);
                else o = proc8<true>(w[c], r, g + 8 * c, (c < 4) ? tgr + 4 * c : tgc + 4 * (c - 4), qs);
                if (isk) *(v4u*)(kt + c * 1024) = o; else *(v4u*)(q + 8 * c) = o;
                MEMFENCE(); }
        } else {
            const int h = job - 30; v4u vw[8];
#pragma unroll
            for (int c = 0; c < 8; ++c) vw[c] = *(const v4u*)(zr + 1824 + h * 64 + 8 * c);
            store_v_tile_pk((char*)(qkv + QO_VG) + ((size_t)(b * 2 + h) * NKT + tt) * 8192, lane, vw);
        }
        MEMFENCE();
    }
}

#if MK_NAIVE_ATTN
#define ATT_UNIT att::attn_unit_naive
#else
#define ATT_UNIT att::attn_unit
#endif
__device__ __forceinline__ void phase_d(KA a, Frame& F, int l, bool last) {
    relane(F);
    unsigned char* ws = a->ws; unsigned char* qkv = ws + WS_QKV;
    bf16* ATT = (bf16*)(ws + WS_ATT);
    const float* LAM = (const float*)(ws + WS_LAM);
    const float lam = LAM[2 * l], oml = 1.0f - LAM[2 * l + 1];
    const float* gdo = a->in[I_GDO] + l * 64;
    ALDS char* lds = (ALDS char*)F.lds;
    const int nctx = last ? 0 : 64;
    for (int id = F.vcu; id < 512 + nctx; id += F.G) {
        int b, h, q0, t0, t1; size_t orow;
        if (id < 512) { const int x = (id & 255) >> 5; b = x >> 1; h = 2 * (x & 1) + (id >> 8); q0 = (id & 31) * 256; t0 = 0; t1 = NKT; orow = (size_t)b * SEQ + q0; }
        else { const int c = id - 512; b = c >> 4; h = c & 15; if (h >= 4) continue; q0 = SEQ; t0 = 128; t1 = NKT; orow = (size_t)LROWS + b * CL; }
        ATT_UNIT<96, 1>((const bf16*)(qkv + QO_QM) + ((size_t)(b * 4 + h) * NTOKB + q0) * 96, (const char*)(qkv + QO_KM) + (size_t)(b * 4 + h) * NKT * 12288,
                        (const char*)(qkv + QO_VM) + (size_t)(b * 4 + h) * NKT * 8192, t0, t1, ATT + orow * 1024 + h * 64, lds, 0.f, gdo, 0.f);
    }
    for (int id = 512 + F.vcu; id < 1024 + nctx; id += F.G) {
        int b, h, q0, t0, t1; size_t orow;
        if (id < 1024) { const int x = (id & 255) >> 5; b = x >> 1; h = 2 * (x & 1) + ((id >> 8) - 2); q0 = (id & 31) * 256; t0 = 0; t1 = NKT; orow = (size_t)b * SEQ + q0; }
        else { const int c = id - 1024; b = c >> 4; h = (c & 15) - 4; if (h < 0 || h >= 4) continue; q0 = SEQ; t0 = 128; t1 = NKT; orow = (size_t)LROWS + b * CL; }
        ATT_UNIT<64, 2>((const bf16*)(qkv + QO_QD) + ((size_t)(b * 4 + h) * NTOKB + q0) * 64, (const char*)(qkv + QO_KD) + (size_t)(b * 4 + h) * NKT * 8192,
                        (const char*)(qkv + QO_VD) + (size_t)(b * 4 + h) * NKT * 8192, t0, t1, ATT + orow * 1024 + 256 + h * 64, lds, lam, gdo, oml);
    }
    for (int id = 1024 + F.vcu; id < 2048 + nctx; id += F.G) {
        int b, h, q0, t0, t1; size_t orow;
        if (id < 2048) { const int x = (id & 255) >> 5; b = x >> 1; h = 4 * (x & 1) + ((id >> 8) - 4); q0 = (id & 31) * 256; t0 = 0; t1 = NKT; orow = (size_t)b * SEQ + q0; }
        else { const int c = id - 2048; b = c >> 4; h = (c & 15) - 8; if (h < 0) continue; q0 = SEQ; t0 = 128; t1 = NKT; orow = (size_t)LROWS + b * CL; }
        const int g = h >> 2;
        ATT_UNIT<64, 1>((const bf16*)(qkv + QO_QG) + ((size_t)(b * 8 + h) * NTOKB + q0) * 64, (const char*)(qkv + QO_KG) + (size_t)(b * 2 + g) * NKT * 8192,
                        (const char*)(qkv + QO_VG) + (size_t)(b * 2 + g) * NKT * 8192, t0, t1, ATT + orow * 1024 + 512 + h * 64, lds, 0.f, gdo, 0.f);
    }
}

__device__ __forceinline__ void phase_f(KA a, Frame& F, int l, bool last) {
    relane(F);
    unsigned char* ws = a->ws;
    const float* MOD = (const float*)(ws + WS_MOD);
    float* AFF = (float*)(ws + WS_AFF); float* AFFC = (float*)(ws + WS_AFFC); int* INV = (int*)(ws + WS_INV);
    const float* CTXW = (const float*)(ws + WS_CTXW); bf16* H = (bf16*)(ws + WS_H);
    LAS float* wrT = (LAS float*)F.lds;
    const float* wr = a->in[I_WR] + (size_t)l * 1024 * 16;
    for (int idx = F.tid; idx < 16384; idx += NWAVES * 64) wrT[(idx & 15) * 1024 + (idx >> 4)] = wr[idx];
    __syncthreads();
    const int nrows = last ? LROWS : MROWS;
    const int gw = F.vcu * NWAVES + F.wave, NGW = F.G * NWAVES;
    for (int row = gw; row < nrows; row += NGW) {
        const bool isc = row >= LROWS; const int v = isc ? 4 : (row >> 13);
        const float* src = isc ? CTXW + (size_t)(row - LROWS) * 1024 : a->out + (size_t)row * 1024;
        f32x4 hv[4]; float ss = 0.f;
#pragma unroll
        for (int j = 0; j < 4; ++j) { hv[j] = *(const f32x4*)(src + 4 * F.lane + 256 * j); ss += (hv[j].x * hv[j].x + hv[j].y * hv[j].y) + (hv[j].z * hv[j].z + hv[j].w * hv[j].w); }
        const float rstd = rsqrtf(wave_sum(ss) * (1.0f / 1024.0f) + EPSF);
        const float* g2 = a->in[I_GN2] + l * 1024; const float* sh = MOD + (l * 5 + v) * 6144 + 3 * 1024; const float* sc = sh + 1024;
#pragma unroll
        for (int j = 0; j < 4; ++j) { const int c0 = 4 * F.lane + 256 * j; const f32x4 g = *(const f32x4*)(g2 + c0), s1 = *(const f32x4*)(sc + c0), b1 = *(const f32x4*)(sh + c0);
            hv[j] = hv[j] * rstd * g * (1.0f + s1) + b1;
            v2u w; w.x = pk2(hv[j].x, hv[j].y); w.y = pk2(hv[j].z, hv[j].w); *(v2u*)(H + (size_t)row * 1024 + c0) = w; }
        float lg[16]; float mx = -3.0e38f;
#pragma unroll
        for (int e = 0; e < 16; ++e) { float s = 0.f;
#pragma unroll
            for (int j = 0; j < 4; ++j) { const f32x4 w = *(const LAS f32x4*)(wrT + e * 1024 + 4 * F.lane + 256 * j); s += (hv[j].x * w.x + hv[j].y * w.y) + (hv[j].z * w.z + hv[j].w * w.w); }
            lg[e] = wave_sum(s); mx = fmaxf(mx, lg[e]); MEMFENCE(); }
        float sum = 0.f;
#pragma unroll
        for (int e = 0; e < 16; ++e) { lg[e] = __builtin_amdgcn_exp2f((lg[e] - mx) * LOG2E); sum += lg[e]; }
        const float rs = 1.0f / sum; float mine = 0.f;
#pragma unroll
        for (int e = 0; e < 16; ++e) mine = (F.lane == e) ? lg[e] * rs : mine;
        if (F.lane < 16) {
            if (isc) { const int r = row - LROWS; AFFC[((size_t)((r >> 8) * 16 + F.lane)) * CL + (r & 255)] = mine; }
            else AFF[((size_t)((row >> 13) * 16 + F.lane)) * SEQ + (row & 8191)] = mine;
            INV[(size_t)row * 16 + F.lane] = -1;
        }
    }
}

__device__ __forceinline__ void topk_set(Frame& F, const float* __restrict__ src, int n, int k, int rowbase, int slotbase, int e, int* IDX, float* GATE, int* INV) {
    LAS unsigned* keys = (LAS unsigned*)F.lds; LAS unsigned* hist = keys + 8192; LAS unsigned* sc = hist + 256;
    const int tid = F.tid;
    for (int i = tid; i < n; i += NWAVES * 64) keys[i] = __float_as_uint(src[i]);
    if (tid == 0) { sc[0] = 0u; sc[1] = (unsigned)k; }
    __syncthreads();
    for (int pass = 0; pass < 4; ++pass) {
        const int shift = 24 - 8 * pass; const unsigned mask = (pass == 0) ? 0u : (0xFFFFFFFFu << (shift + 8));
        if (tid < 256) hist[tid] = 0u;
        __syncthreads();
        const unsigned prefix = sc[0];
        for (int i = tid; i < n; i += NWAVES * 64) { const unsigned kv = keys[i]; if ((kv & mask) == prefix) __hip_atomic_fetch_add(&hist[(kv >> shift) & 255u], 1u, __ATOMIC_RELAXED, __HIP_MEMORY_SCOPE_WORKGROUP); }
        __syncthreads();
        if (F.wave == 0) {
            const unsigned need = sc[1]; unsigned h[4]; unsigned tot = 0u;
#pragma unroll
            for (int j = 0; j < 4; ++j) { h[j] = hist[255 - (4 * F.lane + j)]; tot += h[j]; }
            unsigned incl = tot;
#pragma unroll
            for (int d = 1; d < 64; d <<= 1) { const unsigned t = __shfl_up(incl, d); if (F.lane >= d) incl += t; }
            unsigned cum = incl - tot;
#pragma unroll
            for (int j = 0; j < 4; ++j) { if (cum < need && need <= cum + h[j]) { sc[0] = prefix | ((unsigned)(255 - (4 * F.lane + j)) << shift); sc[1] = need - cum; } cum += h[j]; }
        }
        __syncthreads();
    }
    const unsigned T = sc[0], need_eq = sc[1];
    const int per = (n + NWAVES * 64 - 1) / (NWAVES * 64), start = tid * per;
    unsigned cg = 0u, ce = 0u;
    for (int j = 0; j < per; ++j) { const int i = start + j; if (i < n) { const unsigned kv = keys[i]; cg += (kv > T) ? 1u : 0u; ce += (kv == T) ? 1u : 0u; } }
    const unsigned packed = cg | (ce << 16);
    unsigned incl = packed;
#pragma unroll
    for (int d = 1; d < 64; d <<= 1) { const unsigned t = __shfl_up(incl, d); if (F.lane >= d) incl += t; }
    if (F.lane == 63) sc[8 + F.wave] = incl;
    __syncthreads();
    unsigned base = 0u;
    for (int w = 0; w < F.wave; ++w) base += sc[8 + w];
    const unsigned excl = base + incl - packed;
    unsigned gb = excl & 0xFFFFu, eb = excl >> 16;
    for (int j = 0; j < per; ++j) { const int i = start + j; if (i < n) { const unsigned kv = keys[i]; const bool g = kv > T, q = kv == T;
        if (g || (q && eb < need_eq)) { const int slot = slotbase + (int)(gb + (eb < need_eq ? eb : need_eq)); IDX[slot] = rowbase + i; GATE[slot] = __uint_as_float(kv); INV[(size_t)(rowbase + i) * 16 + e] = slot; }
        gb += g ? 1u : 0u; eb += q ? 1u : 0u; } }
    __syncthreads();
}
__device__ __forceinline__ void phase_g(KA a, Frame& F, int l, bool last) {
    relane(F);
    unsigned char* ws = a->ws;
    const float* AFF = (const float*)(ws + WS_AFF); const float* AFFC = (const float*)(ws + WS_AFFC);
    int* IDX = (int*)(ws + WS_IDX); float* GATE = (float*)(ws + WS_GATE); int* INV = (int*)(ws + WS_INV);
    const int RPE = last ? 4096 : 4352, nsets = last ? 64 : 128;
    for (int set = blockIdx.x; set < nsets; set += F.G) {
        if (set < 64) { const int b = set >> 4, e = set & 15; topk_set(F, AFF + (size_t)set * SEQ, SEQ, CAPL, b * SEQ, e * RPE + b * CAPL, e, IDX, GATE, INV); }
        else { const int s2 = set - 64, b = s2 >> 4, e = s2 & 15; topk_set(F, AFFC + (size_t)s2 * CL, CL, CAPC, LROWS + b * CL, e * RPE + 4096 + b * CAPC, e, IDX, GATE, INV);
            if (b == 0 && F.tid < 128) { IDX[e * RPE + 4224 + F.tid] = -1; GATE[e * RPE + 4224 + F.tid] = 0.f; } }
    }
    {
        LAS float* scr = (LAS float*)(F.lds + 40960 + F.wave * 8704);
        gu32* head = F.ctl + CW_Q + 64 * l;
        constexpr int NIT = NE * 3072;
        const float* wg = a->in[I_WG] + (size_t)l * NE * 1024 * 2048; const float* wu = a->in[I_WU] + (size_t)l * NE * 1024 * 2048; const float* wd = a->in[I_WD] + (size_t)l * NE * 2048 * 1024;
        bf16* WGU = (bf16*)(ws + WS_WGU); bf16* WD = (bf16*)(ws + WS_WD);
        for (;;) {
            unsigned basev = 0u;
            if (F.lane == 0) basev = __hip_atomic_fetch_add(head, 8u, RLX_AGENT);
            const int base = __builtin_amdgcn_readfirstlane((int)basev);
            if (base >= NIT) break;
            for (int j = 0; j < 8; ++j) { const int it = base + j; const int e = it / 3072, r = it % 3072, which = r >> 10, ii = r & 1023;
                if (which < 2) { const int kb = ii >> 6, nb = ii & 63, n0 = nb * 32; const int rowbase = (n0 >> 7) * 256 + (n0 & 127) + which * 128;
                    transpose_item((which ? wu : wg) + (size_t)e * 1024 * 2048, 2048, WGU + (size_t)e * 4096 * 1024, 1024, kb * 64, n0, rowbase - 0, scr, F.lane); }
                else { const int kb = ii >> 5, nb = ii & 31, n0 = nb * 32;
                    transpose_item(wd + (size_t)e * 2048 * 1024, 1024, WD + (size_t)e * 1024 * 2048, 2048, kb * 64, n0, n0, scr, F.lane); } }
        }
    }
}

__device__ __forceinline__ void phase_h(KA a, Frame& F, bool last) {
    relane(F);
    unsigned char* ws = a->ws;
    const int* IDX = (const int*)(ws + WS_IDX); const bf16* H = (const bf16*)(ws + WS_H); bf16* XE = (bf16*)(ws + WS_XE);
    const int nrow = NE * (last ? 4096 : 4352);
    const int gw = F.vcu * NWAVES + F.wave, NGW = F.G * NWAVES;
    for (int r = gw; r < nrow; r += NGW) {
        const int s = __builtin_amdgcn_readfirstlane(IDX[r]);
        v4u v0 = (v4u){0u, 0u, 0u, 0u}, v1 = v0;
        if (s >= 0) { const v4u* p = (const v4u*)(H + (size_t)s * 1024); v0 = p[F.lane]; v1 = p[64 + F.lane]; }
        v4u* q = (v4u*)(XE + (size_t)r * 1024); q[F.lane] = v0; q[64 + F.lane] = v1;
    }
}
__global__ void __launch_bounds__(NWAVES * 64, 2) mk_fwd(Args args) {
    extern __shared__ __attribute__((aligned(16))) unsigned char lds[];
    Frame F;
    F.lds = (LAS unsigned char*)lds;
    F.MISC = (volatile LAS unsigned*)(F.lds + MISC_OFF);
    F.tid = threadIdx.x; F.lane = F.tid & 63; F.wave = __builtin_amdgcn_readfirstlane(F.tid >> 6);
    F.G = gridDim.x; { const int bx = blockIdx.x; F.vcu = (F.G % 8 == 0) ? (bx % 8) * (F.G / 8) + bx / 8 : bx; }
    F.ctl = (gu32*)(args.ws + WS_CTL);
    for (int u = F.tid; u < (LDS_BYTES - LDSCTL_OFF) / 4; u += NWAVES * 64) ((LAS unsigned*)(F.lds + LDSCTL_OFF))[u] = 0u;
    __syncthreads();
    const int lo = args.ph_lo, hi = args.ph_hi;
    const bool multi = (hi - lo) > 1;
    XcdBarrier bar; bar.bar = (unsigned*)(F.ctl + CW_BAR); bar.x = 0; bar.st = nullptr;
    if (multi) bar = xcd_barrier_post((unsigned*)(F.ctl + CW_BAR), F.MISC + 8);
#define IN(k) (lo <= (k) && (k) < hi)
#define SEAM(k) do { if (IN((k) + 1)) xcd_barrier(bar); } while (0)

    if (IN(0)) { p0_prologue(kargs(), F); SEAM(0); }

    for (int l = 0; l < NLAYER; ++l) {
        const bool last = (l == NLAYER - 1);
        const int pb = 1 + 10 * l;
        const int RPE = last ? 4096 : 4352;
        if (IN(pb + 0)) { phase_a(kargs(), F, l); SEAM(pb + 0); }
        if (IN(pb + 1)) {
            KA ka = kargs(); unsigned char* ws = ka->ws;
            pg8::Gemm g{(const pg8::bf16_t*)(ws + WS_H), (const pg8::bf16_t*)(ws + WS_WCAT) + (size_t)l * ZP * 1024, MROWS, ZP, DM, 1 << 30, 0};
            pg8::StaticOrder S; S.init(MROWS, ZP, F.G, (int)blockIdx.x);
            pg8::EpiStoreBf16 E{(pg8::bf16_t*)(ws + WS_Z), ZP};
            pg8::gemm_phase<pg8::EpiStoreBf16, pg8::StaticOrder, true, true>(F.lds, g, S, E);
            SEAM(pb + 1);
        }
        if (IN(pb + 2)) { phase_c(kargs(), F, l); SEAM(pb + 2); }
        if (IN(pb + 3)) { phase_d(kargs(), F, l, last); SEAM(pb + 3); }
        if (IN(pb + 4)) {
            KA ka = kargs(); unsigned char* ws = ka->ws; const float* MODL = (const float*)(ws + WS_MOD) + (size_t)l * 5 * 6144;
            const int M = last ? LROWS : MROWS;
            pg8::Gemm g{(const pg8::bf16_t*)(ws + WS_ATT), (const pg8::bf16_t*)(ws + WS_WO) + (size_t)l * 1024 * 1024, M, DM, DM, 1 << 30, 0};
            pg8::StaticOrder S; S.init(M, DM, F.G, (int)blockIdx.x);
            pg8::EpiGatedResidual E{ka->out, (float*)(ws + WS_CTXW), MODL, LROWS};
            pg8::gemm_phase<pg8::EpiGatedResidual, pg8::StaticOrder, true, true>(F.lds, g, S, E);
            SEAM(pb + 4);
        }
        if (IN(pb + 5)) { phase_f(kargs(), F, l, last); SEAM(pb + 5); }
        if (IN(pb + 6)) { phase_g(kargs(), F, l, last); SEAM(pb + 6); }
        if (IN(pb + 7)) { phase_h(kargs(), F, last); SEAM(pb + 7); }
        if (IN(pb + 8)) {
            KA ka = kargs(); unsigned char* ws = ka->ws;
            pg8::Gemm g{(const pg8::bf16_t*)(ws + WS_XE), (const pg8::bf16_t*)(ws + WS_WGU), NE * RPE, 2 * FFD, DM, RPE / 256, (size_t)2 * FFD * DM * 2};
            pg8::StaticOrder S; S.init(NE * RPE, 2 * FFD, F.G, (int)blockIdx.x);
            pg8::EpiSwiGLU E{(pg8::bf16_t*)(ws + WS_HID), FFD};
            pg8::gemm_phase<pg8::EpiSwiGLU, pg8::StaticOrder, true, true>(F.lds, g, S, E);
            SEAM(pb + 8);
        }
        if (IN(pb + 9)) {
            KA ka = kargs(); unsigned char* ws = ka->ws;
            pg8::Gemm g{(const pg8::bf16_t*)(ws + WS_HID), (const pg8::bf16_t*)(ws + WS_WD), NE * RPE, DM, FFD, RPE / 256, (size_t)DM * FFD * 2};
            pg8::StaticOrder S; S.init(NE * RPE, DM, F.G, (int)blockIdx.x);
            pg8::EpiRowScaleBf16 E{(pg8::bf16_t*)(ws + WS_YE), DM, (const float*)(ws + WS_GATE)};
            pg8::gemm_phase<pg8::EpiRowScaleBf16, pg8::StaticOrder, true, true>(F.lds, g, S, E);
            SEAM(pb + 9);
        }
    }
    if (IN(N_PHASES - 1)) phase_a(kargs(), F, NLAYER);
#undef IN
#undef SEAM
}

extern "C" void kernel_launch(void* const* d_in, const int* in_sizes, int n_in, void* d_out, int out_size, void* d_ws, size_t ws_size, hipStream_t stream) {
    static int grid = 0;
    if (grid == 0) {
        if (n_in != N_IN || out_size != LROWS * DM || ws_size < WS_END) { fprintf(stderr, "kernel_launch: unexpected shapes (n_in %d, out %d, ws %zu); nothing launched\n", n_in, out_size, ws_size); grid = -1; return; }
        int dev = 0, cus = 0, per_cu = 0;
        if (hipGetDevice(&dev) != hipSuccess || hipDeviceGetAttribute(&cus, hipDeviceAttributeMultiprocessorCount, dev) != hipSuccess) { grid = -1; return; }
        if (hipFuncSetAttribute((const void*)mk_fwd, hipFuncAttributeMaxDynamicSharedMemorySize, LDS_BYTES) != hipSuccess) { fprintf(stderr, "kernel_launch: hipFuncSetAttribute failed\n"); grid = -1; return; }
        if (hipOccupancyMaxActiveBlocksPerMultiprocessor(&per_cu, (const void*)mk_fwd, NWAVES * 64, LDS_BYTES) != hipSuccess || per_cu < 1) { fprintf(stderr, "kernel_launch: occupancy query reports %d blocks per CU\n", per_cu); }
        (void)hipGetLastError();
        grid = cus;
    }
    if (grid < 0) return;
    if (hipMemsetAsync((char*)d_ws + WS_CTL, 0, CTL_ZERO_BYTES, stream) != hipSuccess) { fprintf(stderr, "kernel_launch: memset failed\n"); return; }
    Args a{};
    for (int i = 0; i < N_IN; ++i) a.in[i] = (const float*)d_in[i];
    a.out = (float*)d_out; a.ws = (unsigned char*)d_ws;
#if MK_SPLIT
    for (int ph = 0; ph < N_PHASES; ++ph) { a.ph_lo = ph; a.ph_hi = ph + 1; hipLaunchKernelGGL(mk_fwd, dim3(grid), dim3(NWAVES * 64), LDS_BYTES, stream, a); }
#else
    a.ph_lo = 0; a.ph_hi = N_PHASES;
    hipLaunchKernelGGL(mk_fwd, dim3(grid), dim3(NWAVES * 64), LDS_BYTES, stream, a);
#endif
    const hipError_t le = hipPeekAtLastError();
    if (le != hipSuccess) fprintf(stderr, "kernel_launch: launch failed: %s\n", hipGetErrorName(le));
}
```

```cpp
#include <hip/hip_runtime.h>
#include <hip/hip_bf16.h>
#include <cstdio>
#include <cstdint>
#ifndef MK_SPLIT
#define MK_SPLIT 0
#endif
#ifndef MK_NAIVE_ATTN
#define MK_NAIVE_ATTN 0
#endif
namespace pg8 {
#define PG8_LAS __attribute__((address_space(3)))
typedef unsigned short bf16_t;
typedef short bf16x8 __attribute__((ext_vector_type(8)));
typedef float f32x4 __attribute__((ext_vector_type(4)));
typedef unsigned u32x4 __attribute__((ext_vector_type(4)));
constexpr int BM = 256, BK = 64, HALF = 128, HTB = HALF * BK * 2  , STAGE_BYTES = 8 * HTB, NXCD = 8, WGM = 8;

__host__ __device__ __forceinline__ int lds_byte(int r, int c) { const int st = (r >> 4) * 2 + (c >> 5), rr = r & 15, cc = c & 31, ob = rr * 64 + cc * 2; return st * 1024 + (ob ^ (((ob >> 9) & 1) << 5)); }
__host__ __device__ __forceinline__ void stage_rc(int b, int& R, int& C) { const int st = b / 1024, sb = b % 1024, swz = sb ^ (((sb >> 9) & 1) << 5); R = (st >> 1) * 16 + swz / 64; C = (st & 1) * 32 + (swz % 64) / 2; }
__host__ __device__ __forceinline__ int perm32(int rho) { const int n = rho >> 4, i = rho & 15; return 8 * (i >> 2) + 4 * n + (i & 3); }

struct Unit { int pm, pn; };
struct Gemm { const bf16_t* A; const bf16_t* Bt; int M, N, K; int tpe; size_t bgs; };

struct StaticOrder {
    int nM, nN, nwg, G, c;
    __host__ __device__ void init(int M, int N, int G_, int c_) { nM = M / BM; nN = N / BM; nwg = nM * nN; G = G_; c = c_; }
    __host__ __device__ bool next(int i, Unit& u) const {
        const long L = (long)i * G + c; if (L >= nwg) return false;
        int wgid = (int)L; { const int q = nwg / NXCD, r = nwg % NXCD, xcd = wgid % NXCD, off = wgid / NXCD; wgid = (xcd < r ? xcd * (q + 1) : r * (q + 1) + (xcd - r) * q) + off; }
        const int nig = WGM * nN, gid = wgid / nig, fm = gid * WGM, gsz = (nM - fm) < WGM ? (nM - fm) : WGM;
        u.pm = fm + ((wgid % nig) % gsz); u.pn = (wgid % nig) / gsz; return true;
    }
    __device__ __forceinline__ void a_ready(const Unit&) const {}
    __device__ __forceinline__ void done(const Unit&) const {}
};
__device__ __forceinline__ unsigned cvt_pk_bf16(float lo, float hi) { unsigned r; asm volatile("v_cvt_pk_bf16_f32 %0, %1, %2" : "=v"(r) : "v"(lo), "v"(hi)); return r; }
struct EpiStoreBf16 {
    static constexpr bool PERM = true, AFTER_DRAIN = false;
    bf16_t* O; int ldc;
    __device__ __forceinline__ void operator()(const f32x4 (&acc)[2][2][4][2], const Unit& u, int wr, int wc, int fr, int fq) const {
        const int row0 = u.pm * BM + wr * 64 + fr, col0 = u.pn * BM + wc * 32 + 8 * fq;
#pragma unroll
        for (int ai = 0; ai < 2; ++ai)
#pragma unroll
            for (int m = 0; m < 4; ++m) { bf16_t* rowp = O + (size_t)(row0 + ai * HALF + m * 16) * ldc + col0;
#pragma unroll
                for (int bj = 0; bj < 2; ++bj) { const f32x4 v0 = acc[ai][bj][m][0], v1 = acc[ai][bj][m][1];
                    u32x4 w; w.x = cvt_pk_bf16(v0[0], v0[1]); w.y = cvt_pk_bf16(v0[2], v0[3]); w.z = cvt_pk_bf16(v1[0], v1[1]); w.w = cvt_pk_bf16(v1[2], v1[3]);
                    *(u32x4*)(rowp + bj * HALF) = w; } }
    }
};
struct EpiGatedResidual {
    static constexpr bool PERM = false, AFTER_DRAIN = false;
    float* xl; float* xc; const float* mod; int lrows;
    __device__ __forceinline__ void operator()(const f32x4 (&acc)[2][2][4][2], const Unit& u, int wr, int wc, int fr, int fq) const {
        const int R0 = u.pm * BM; const bool isc = R0 >= lrows; const int v = isc ? 4 : (R0 >> 13);
        float* xb = isc ? xc + (size_t)(R0 - lrows) * 1024 : xl + (size_t)R0 * 1024;
        const float* ga = mod + v * 6144 + 2 * 1024;
        const int col0 = u.pn * BM + wc * 32 + 4 * fq;
#pragma unroll
        for (int bj = 0; bj < 2; ++bj)
#pragma unroll
            for (int n = 0; n < 2; ++n) { const f32x4 g = *(const f32x4*)(ga + col0 + bj * HALF + n * 16);
#pragma unroll
                for (int ai = 0; ai < 2; ++ai)
#pragma unroll
                    for (int m = 0; m < 4; ++m) { float* p = xb + (size_t)(ai * HALF + wr * 64 + m * 16 + fr) * 1024 + col0 + bj * HALF + n * 16;
                        const f32x4 xv = *(const f32x4*)p; *(f32x4*)p = xv + g * acc[ai][bj][m][n]; } }
    }
};
__device__ __forceinline__ float silu_mul(float g, float u) { return g * __builtin_amdgcn_rcpf(1.0f + __builtin_amdgcn_exp2f(-1.4426950408889634f * g)) * u; }
struct EpiSwiGLU {
    static constexpr bool PERM = true, AFTER_DRAIN = false;
    bf16_t* O; int ldc;
    __device__ __forceinline__ void operator()(const f32x4 (&acc)[2][2][4][2], const Unit& u, int wr, int wc, int fr, int fq) const {
        const int row0 = u.pm * BM + wr * 64 + fr, col0 = u.pn * HALF + wc * 32 + 8 * fq;
#pragma unroll
        for (int ai = 0; ai < 2; ++ai)
#pragma unroll
            for (int m = 0; m < 4; ++m) { const f32x4 g0 = acc[ai][0][m][0], g1 = acc[ai][0][m][1], u0 = acc[ai][1][m][0], u1 = acc[ai][1][m][1];
                u32x4 w; w.x = cvt_pk_bf16(silu_mul(g0[0], u0[0]), silu_mul(g0[1], u0[1])); w.y = cvt_pk_bf16(silu_mul(g0[2], u0[2]), silu_mul(g0[3], u0[3]));
                w.z = cvt_pk_bf16(silu_mul(g1[0], u1[0]), silu_mul(g1[1], u1[1])); w.w = cvt_pk_bf16(silu_mul(g1[2], u1[2]), silu_mul(g1[3], u1[3]));
                *(u32x4*)(O + (size_t)(row0 + ai * HALF + m * 16) * ldc + col0) = w; }
    }
};
struct EpiRowScaleBf16 {
    static constexpr bool PERM = true, AFTER_DRAIN = false;
    bf16_t* O; int ldc; const float* rs;
    __device__ __forceinline__ void operator()(const f32x4 (&acc)[2][2][4][2], const Unit& u, int wr, int wc, int fr, int fq) const {
        const int row0 = u.pm * BM + wr * 64 + fr, col0 = u.pn * BM + wc * 32 + 8 * fq;
#pragma unroll
        for (int ai = 0; ai < 2; ++ai)
#pragma unroll
            for (int m = 0; m < 4; ++m) { const int row = row0 + ai * HALF + m * 16; const float s = rs[row]; bf16_t* rowp = O + (size_t)row * ldc + col0;
#pragma unroll
                for (int bj = 0; bj < 2; ++bj) { const f32x4 v0 = acc[ai][bj][m][0] * s, v1 = acc[ai][bj][m][1] * s;
                    u32x4 w; w.x = cvt_pk_bf16(v0[0], v0[1]); w.y = cvt_pk_bf16(v0[2], v0[3]); w.z = cvt_pk_bf16(v1[0], v1[1]); w.w = cvt_pk_bf16(v1[2], v1[3]);
                    *(u32x4*)(rowp + bj * HALF) = w; } }
    }
};
template <class Epi, class Sched, bool ALIGN_EPI = false, bool SP2 = false>
__device__ __forceinline__ void gemm_phase(PG8_LAS unsigned char* lds, const Gemm g, const Sched& S, const Epi& E) {
    int tid_l = threadIdx.x; asm volatile("" : "+v"(tid_l));
    const int tid = tid_l, wid = __builtin_amdgcn_readfirstlane(tid >> 6), lane = tid & 63, wr = wid >> 2, wc = wid & 3, fr = lane & 15, fq = lane >> 4;
    const int K = g.K, nt = K / BK;
    unsigned voffA[2], voffB[2];
#pragma unroll
    for (int i = 0; i < 2; ++i) { int R, C; stage_rc(tid * 16 + i * 8192, R, C); const int Rb = Epi::PERM ? ((R & ~31) + perm32(R & 31)) : R;
        voffA[i] = (unsigned)(R * K + C) * 2u; voffB[i] = (unsigned)(Rb * K + C) * 2u; }
    const size_t kstep = (size_t)(BK * 2);
    const size_t hstep = (size_t)HALF * K * 2;
    const size_t tstep = 2 * hstep;
    const unsigned ldsw = (unsigned)wid * 1024u;
    const int aoff = lds_byte(wr * 64 + fr, fq * 8), boff = lds_byte(wc * 32 + fr, fq * 8);
#define PG8_SA(b, h) (((b) * 2 + (h)) * HTB)
#define PG8_SB(b, h) ((4 + (b) * 2 + (h)) * HTB)
#define PG8_STAGE(bufoff, gbase, voff) do { _Pragma("unroll") for (int _i = 0; _i < 2; ++_i) \
        __builtin_amdgcn_global_load_lds((const unsigned*)((const char*)(gbase) + (voff)[_i]), (PG8_LAS unsigned*)(lds + (bufoff) + ldsw + _i * 8192), 16, 0, 0); } while (0)
#define PG8_LDA(dst, b, h) do { _Pragma("unroll") for (int m = 0; m < 4; ++m) _Pragma("unroll") for (int k = 0; k < 2; ++k) dst[m][k] = *(const PG8_LAS bf16x8*)(lds + PG8_SA(b, h) + aoff + m * 2048 + k * 1024); } while (0)
#define PG8_LDB(dst, b, h) do { _Pragma("unroll") for (int n = 0; n < 2; ++n) _Pragma("unroll") for (int k = 0; k < 2; ++k) dst[n][k] = *(const PG8_LAS bf16x8*)(lds + PG8_SB(b, h) + boff + n * 2048 + k * 1024); } while (0)
#define PG8_MMA(ai, bj, At, Bt) do { __builtin_amdgcn_s_setprio(1); _Pragma("unroll") for (int m = 0; m < 4; ++m) _Pragma("unroll") for (int n = 0; n < 2; ++n) _Pragma("unroll") for (int k = 0; k < 2; ++k) \
        acc[ai][bj][m][n] = __builtin_amdgcn_mfma_f32_16x16x32_bf16(Bt[n][k], At[m][k], acc[ai][bj][m][n], 0, 0, 0); __builtin_amdgcn_s_setprio(0); } while (0)
#define PG8_WAIT_V(n) asm volatile("s_waitcnt vmcnt(" #n ")" ::: "memory")
#define PG8_WAIT_L(n) asm volatile("s_waitcnt lgkmcnt(" #n ")" ::: "memory")
#define PG8_BAR __builtin_amdgcn_s_barrier()
#define PG8_SCHED __builtin_amdgcn_sched_barrier(0)
    Unit cur, nxt; int ui = 0;
    if (!S.next(0, cur)) return;
    f32x4 acc[2][2][4][2];
#pragma unroll
    for (int a = 0; a < 2; ++a)
#pragma unroll
        for (int b = 0; b < 2; ++b)
#pragma unroll
            for (int m = 0; m < 4; ++m)
#pragma unroll
                for (int n = 0; n < 2; ++n) acc[a][b][m][n] = (f32x4){0.f, 0.f, 0.f, 0.f};
    bf16x8 At[4][2], B0[2][2], B1[2][2];
    const char* cA = (const char*)g.A + (size_t)cur.pm * tstep; const char* cB = (const char*)g.Bt + (size_t)(cur.pm / g.tpe) * g.bgs + (size_t)cur.pn * tstep;
    S.a_ready(cur);
    if constexpr (SP2) {
        PG8_STAGE(PG8_SB(0, 0), cB, voffB); PG8_STAGE(PG8_SB(0, 1), cB + hstep, voffB); PG8_STAGE(PG8_SA(0, 0), cA, voffA); PG8_STAGE(PG8_SA(0, 1), cA + hstep, voffA);
        if (wr == 1) PG8_BAR;
        PG8_WAIT_V(2); PG8_BAR;
        PG8_STAGE(PG8_SB(1, 0), cB + kstep, voffB); PG8_STAGE(PG8_SA(1, 0), cA + kstep, voffA); PG8_STAGE(PG8_SB(1, 1), cB + hstep + kstep, voffB);
        PG8_WAIT_V(6); PG8_BAR;
    } else {
        PG8_STAGE(PG8_SB(0, 0), cB, voffB); PG8_STAGE(PG8_SA(0, 0), cA, voffA); PG8_STAGE(PG8_SB(0, 1), cB + hstep, voffB); PG8_STAGE(PG8_SA(0, 1), cA + hstep, voffA);
        if (wr == 1) PG8_BAR;
        PG8_WAIT_V(4); PG8_BAR;
        PG8_STAGE(PG8_SB(1, 0), cB + kstep, voffB); PG8_STAGE(PG8_SA(1, 0), cA + kstep, voffA); PG8_STAGE(PG8_SB(1, 1), cB + hstep + kstep, voffB);
        PG8_WAIT_V(6); PG8_BAR;
    }
    for (;;) {
        const bool has_next = S.next(ui + 1, nxt);
        const char* nA = has_next ? (const char*)g.A + (size_t)nxt.pm * tstep : cA; const char* nB = has_next ? (const char*)g.Bt + (size_t)(nxt.pm / g.tpe) * g.bgs + (size_t)nxt.pn * tstep : cB;
        for (int t = 0; t < nt; t += 2) {
            const bool last = (t == nt - 2);
            const char* a1 = cA + (size_t)(t + 1) * kstep;
            const char* a2 = last ? nA : cA + (size_t)(t + 2) * kstep; const char* b2 = last ? nB : cB + (size_t)(t + 2) * kstep;
            const char* a3 = a2 + kstep; const char* b3 = b2 + kstep;
            if (last && has_next) S.a_ready(nxt);
            if constexpr (SP2) {
            PG8_LDB(B0, 0, 0); PG8_LDB(B1, 0, 1); PG8_SCHED; PG8_LDA(At, 0, 0); PG8_STAGE(PG8_SA(1, 1), a1 + hstep, voffA);
            PG8_WAIT_V(8); PG8_WAIT_L(0); PG8_BAR; PG8_MMA(0, 0, At, B0); PG8_MMA(0, 1, At, B1); PG8_BAR; PG8_SCHED;
            PG8_LDA(At, 0, 1); PG8_STAGE(PG8_SB(0, 0), b2, voffB); PG8_STAGE(PG8_SB(0, 1), b2 + hstep, voffB); PG8_STAGE(PG8_SA(0, 0), a2, voffA);
            PG8_WAIT_V(8); PG8_WAIT_L(0); PG8_BAR; PG8_MMA(1, 0, At, B0); PG8_MMA(1, 1, At, B1); PG8_BAR; PG8_SCHED;
            PG8_LDB(B0, 1, 0); PG8_LDB(B1, 1, 1); PG8_SCHED; PG8_LDA(At, 1, 0); PG8_STAGE(PG8_SA(0, 1), a2 + hstep, voffA);
            PG8_WAIT_V(8); PG8_WAIT_L(0); PG8_BAR; PG8_MMA(0, 0, At, B0); PG8_MMA(0, 1, At, B1); PG8_BAR; PG8_SCHED;
            PG8_LDA(At, 1, 1); PG8_STAGE(PG8_SB(1, 0), b3, voffB); PG8_STAGE(PG8_SB(1, 1), b3 + hstep, voffB); PG8_STAGE(PG8_SA(1, 0), a3, voffA);
            PG8_WAIT_V(8); PG8_WAIT_L(0); PG8_BAR; PG8_MMA(1, 0, At, B0); PG8_MMA(1, 1, At, B1); PG8_BAR; PG8_SCHED;
            } else {
            PG8_LDB(B0, 0, 0); PG8_SCHED; PG8_LDA(At, 0, 0); PG8_STAGE(PG8_SA(1, 1), a1 + hstep, voffA);
            PG8_WAIT_L(8); PG8_BAR; PG8_WAIT_L(0); PG8_MMA(0, 0, At, B0); PG8_BAR; PG8_SCHED;
            PG8_LDB(B1, 0, 1); PG8_STAGE(PG8_SB(0, 0), b2, voffB);
            PG8_BAR; PG8_WAIT_L(0); PG8_MMA(0, 1, At, B1); PG8_BAR;
            PG8_LDA(At, 0, 1); PG8_STAGE(PG8_SA(0, 0), a2, voffA);
            PG8_BAR; PG8_WAIT_L(0); PG8_MMA(1, 0, At, B0); PG8_BAR; PG8_SCHED;
            PG8_STAGE(PG8_SB(0, 1), b2 + hstep, voffB);
            PG8_WAIT_V(6); PG8_BAR; PG8_MMA(1, 1, At, B1); PG8_BAR;
            PG8_LDB(B0, 1, 0); PG8_SCHED; PG8_LDA(At, 1, 0); PG8_STAGE(PG8_SA(0, 1), a2 + hstep, voffA);
            PG8_WAIT_L(8); PG8_BAR; PG8_WAIT_L(0); PG8_MMA(0, 0, At, B0); PG8_BAR; PG8_SCHED;
            PG8_LDB(B1, 1, 1); PG8_STAGE(PG8_SB(1, 0), b3, voffB);
            PG8_BAR; PG8_WAIT_L(0); PG8_MMA(0, 1, At, B1); PG8_BAR;
            PG8_LDA(At, 1, 1); PG8_STAGE(PG8_SA(1, 0), a3, voffA);
            PG8_BAR; PG8_WAIT_L(0); PG8_MMA(1, 0, At, B0); PG8_BAR; PG8_SCHED;
            PG8_STAGE(PG8_SB(1, 1), b3 + hstep, voffB);
            PG8_WAIT_V(6); PG8_BAR; PG8_MMA(1, 1, At, B1); PG8_BAR;
            }
        }
        if constexpr (ALIGN_EPI) { if (wr == 0) PG8_BAR; }
        if constexpr (!Epi::AFTER_DRAIN) { E(acc, cur, wr, wc, fr, fq); S.done(cur); }
        if (!has_next) break;
#pragma unroll
        for (int a = 0; a < 2; ++a)
#pragma unroll
            for (int b = 0; b < 2; ++b)
#pragma unroll
                for (int m = 0; m < 4; ++m)
#pragma unroll
                    for (int n = 0; n < 2; ++n) acc[a][b][m][n] = (f32x4){0.f, 0.f, 0.f, 0.f};
        cur = nxt; cA = nA; cB = nB; ++ui;
        if constexpr (ALIGN_EPI) { if (wr == 1) PG8_BAR; }
    }
    PG8_WAIT_V(0);
    if constexpr (!ALIGN_EPI) { if (wr == 0) PG8_BAR; }
    PG8_BAR;
    if constexpr (Epi::AFTER_DRAIN) { E.fused(acc, cur, wr, wc, fr, fq, lds, wid, lane); S.done(cur); }
#undef PG8_SA
#undef PG8_SB
#undef PG8_STAGE
#undef PG8_LDA
#undef PG8_LDB
#undef PG8_MMA
#undef PG8_WAIT_V
#undef PG8_WAIT_L
#undef PG8_BAR
#undef PG8_SCHED
}
}
namespace att {
typedef unsigned short bf16_t;
typedef short bf16x8 __attribute__((ext_vector_type(8)));
typedef short s16x4 __attribute__((ext_vector_type(4)));
typedef float f32x16 __attribute__((ext_vector_type(16)));
typedef float f32x4 __attribute__((ext_vector_type(4)));
typedef unsigned u32x4 __attribute__((ext_vector_type(4)));
typedef unsigned u32x2 __attribute__((ext_vector_type(2)));
#define ALDS __attribute__((address_space(3)))
typedef float f32x2_t __attribute__((ext_vector_type(2))); typedef __bf16 bf16x2_t __attribute__((ext_vector_type(2)));
__device__ __forceinline__ unsigned cvtpk(float lo, float hi) { f32x2_t v = {lo, hi}; bf16x2_t b = __builtin_convertvector(v, bf16x2_t); return __builtin_bit_cast(unsigned, b); }
__device__ __forceinline__ float bf2f(unsigned short u) { return __uint_as_float((unsigned)u << 16); }
template <int S> __device__ __forceinline__ bf16x8 pack8(const f32x16& x) {
    u32x4 p; p.x = cvtpk(x[8 * S + 0], x[8 * S + 1]); p.y = cvtpk(x[8 * S + 2], x[8 * S + 3]); p.z = cvtpk(x[8 * S + 4], x[8 * S + 5]); p.w = cvtpk(x[8 * S + 6], x[8 * S + 7]);
    return __builtin_bit_cast(bf16x8, p);
}
typedef short v4i16_t __attribute__((ext_vector_type(4)));
__device__ __forceinline__ s16x4 vtr(const ALDS char* p) { return __builtin_bit_cast(s16x4, __builtin_amdgcn_ds_read_tr16_b64_v4i16((ALDS v4i16_t*)p)); }
__device__ __forceinline__ int crow(int r, int hi) { return (r & 3) + 8 * (r >> 2) + 4 * hi; }
constexpr int ATT_LDS_BYTES = 2 * 12288 + 2 * 8192;

template <int KD, int NMAP>
__device__ __forceinline__ void attn_unit(const bf16_t* __restrict__ Qb, const char* __restrict__ Kt, const char* __restrict__ Vt, int t0, int t1,
                                          bf16_t* __restrict__ Ob, ALDS char* lds, float lam, const float* __restrict__ gout, float oml) {
    constexpr int KTB = KD * 128;
    constexpr int KS = KD / 16 / NMAP;
    int tid_l = threadIdx.x; asm volatile("" : "+v"(tid_l));
    const int tid = tid_l, lane = tid & 63, r32 = lane & 31, hi = lane >> 5, wid = tid >> 6;
    bf16x8 qf[NMAP * KS];
    { const bf16_t* qrow = Qb + (size_t)(wid * 32 + r32) * KD + hi * 8;
#pragma unroll
      for (int ks = 0; ks < NMAP * KS; ++ks) qf[ks] = *(const bf16x8*)(qrow + ks * 16); }
    f32x16 o[NMAP][2]; float l[NMAP];
#pragma unroll
    for (int m = 0; m < NMAP; ++m) { l[m] = 0.f;
#pragma unroll
        for (int d = 0; d < 2; ++d)
#pragma unroll
            for (int r = 0; r < 16; ++r) o[m][d][r] = 0.f; }
    u32x4 kst0, kst1, vst; kst1 = (u32x4){0u, 0u, 0u, 0u};
#define ATT_GLOAD(t) do { const char* kp_ = Kt + (size_t)(t) * KTB; kst0 = *(const u32x4*)(kp_ + tid * 16); if (KD == 96 && tid < 256) kst1 = *(const u32x4*)(kp_ + 8192 + tid * 16); \
        vst = *(const u32x4*)(Vt + (size_t)(t) * 8192 + tid * 16); } while (0)
#define ATT_LSTORE(buf) do { *(ALDS u32x4*)(lds + (buf) * KTB + tid * 16) = kst0; if (KD == 96 && tid < 256) *(ALDS u32x4*)(lds + (buf) * KTB + 8192 + tid * 16) = kst1; \
        *(ALDS u32x4*)(lds + 2 * KTB + (buf) * 8192 + tid * 16) = vst; } while (0)
    ATT_GLOAD(t0); ATT_LSTORE(0); __syncthreads();
    const int voff = (4 * hi + ((lane & 15) >> 2)) * 64 + ((lane >> 4) & 1) * 32 + (lane & 3) * 8;
    for (int t = t0; t < t1; ++t) {
        const int cur = (t - t0) & 1;
        if (t + 1 < t1) ATT_GLOAD(t + 1);
        const ALDS char* kb = lds + cur * KTB + hi * 1024 + r32 * 16;
        const ALDS char* vb = lds + 2 * KTB + cur * 8192 + voff;
        bf16x8 p[NMAP][4];
#pragma unroll
        for (int m = 0; m < NMAP; ++m) {
            f32x16 s0, s1;
#pragma unroll
            for (int r = 0; r < 16; ++r) { s0[r] = 0.f; s1[r] = 0.f; }
#pragma unroll
            for (int s = 0; s < KS; ++s) { const int ks = m * KS + s;
                const bf16x8 a0 = *(const ALDS bf16x8*)(kb + ks * 2048), a1 = *(const ALDS bf16x8*)(kb + ks * 2048 + 512);
                s0 = __builtin_amdgcn_mfma_f32_32x32x16_bf16(a0, qf[ks], s0, 0, 0, 0);
                s1 = __builtin_amdgcn_mfma_f32_32x32x16_bf16(a1, qf[ks], s1, 0, 0, 0); }
            float rs = 0.f;
#pragma unroll
            for (int r = 0; r < 16; ++r) { s0[r] = __builtin_amdgcn_exp2f(s0[r]); s1[r] = __builtin_amdgcn_exp2f(s1[r]); rs += s0[r] + s1[r]; }
            l[m] += rs;
            p[m][0] = pack8<0>(s0); p[m][1] = pack8<1>(s0); p[m][2] = pack8<0>(s1); p[m][3] = pack8<1>(s1);
        }
#pragma unroll
        for (int d = 0; d < 2; ++d)
#pragma unroll
            for (int kk = 0; kk < 4; ++kk) {
                const s16x4 lo = vtr(vb + d * 4096 + kk * 1024), h4 = vtr(vb + d * 4096 + kk * 1024 + 512);
                const bf16x8 vf = (bf16x8){lo[0], lo[1], lo[2], lo[3], h4[0], h4[1], h4[2], h4[3]};
#pragma unroll
                for (int m = 0; m < NMAP; ++m) o[m][d] = __builtin_amdgcn_mfma_f32_32x32x16_bf16(vf, p[m][kk], o[m][d], 0, 0, 0);
            }
        if (t + 1 < t1) ATT_LSTORE(cur ^ 1);
        __syncthreads();
    }
#undef ATT_GLOAD
#undef ATT_LSTORE
    float li[NMAP];
#pragma unroll
    for (int m = 0; m < NMAP; ++m) { const float lt = l[m] + __shfl_xor(l[m], 32); li[m] = 1.0f / lt; }
    float val[2][16];
    if (NMAP == 1) {
#pragma unroll
        for (int d = 0; d < 2; ++d)
#pragma unroll
            for (int r = 0; r < 16; ++r) val[d][r] = o[0][d][r] * li[0];
    } else {
        float ss = 0.f; const float l2 = lam * li[NMAP - 1];
#pragma unroll
        for (int d = 0; d < 2; ++d)
#pragma unroll
            for (int r = 0; r < 16; ++r) { const float v = o[0][d][r] * li[0] - o[NMAP - 1][d][r] * l2; val[d][r] = v; ss += v * v; }
        ss += __shfl_xor(ss, 32);
        const float rstd = rsqrtf(ss * (1.0f / 64.0f) + 1e-6f) * oml;
#pragma unroll
        for (int d = 0; d < 2; ++d)
#pragma unroll
            for (int g = 0; g < 4; ++g) { const f32x4 gv = *(const f32x4*)(gout + 32 * d + 8 * g + 4 * hi);
#pragma unroll
                for (int i = 0; i < 4; ++i) val[d][4 * g + i] *= rstd * gv[i]; }
    }
    bf16_t* orow = Ob + (size_t)(wid * 32 + r32) * 1024 + 4 * hi;
#pragma unroll
    for (int d = 0; d < 2; ++d)
#pragma unroll
        for (int g = 0; g < 4; ++g) { u32x2 w; w.x = cvtpk(val[d][4 * g], val[d][4 * g + 1]); w.y = cvtpk(val[d][4 * g + 2], val[d][4 * g + 3]);
            *(u32x2*)(orow + 32 * d + 8 * g) = w; }
}

template <int KD, int NMAP>
__device__ __forceinline__ void attn_unit_naive(const bf16_t* __restrict__ Qb, const char* __restrict__ Kt, const char* __restrict__ Vt, int t0, int t1,
                                                bf16_t* __restrict__ Ob, ALDS char* lds, float lam, const float* __restrict__ gout, float oml) {
    constexpr int KTB = KD * 128, DMAP = KD / NMAP;
    int tid_l = threadIdx.x; asm volatile("" : "+v"(tid_l));
    const int tid = tid_l, q = tid & 255, dh = tid >> 8;
    float qv[KD];
#pragma unroll
    for (int c = 0; c < KD / 8; ++c) { const u32x4 w = *(const u32x4*)(Qb + (size_t)q * KD + c * 8);
#pragma unroll
        for (int i = 0; i < 4; ++i) { qv[c * 8 + 2 * i] = __uint_as_float(w[i] << 16); qv[c * 8 + 2 * i + 1] = __uint_as_float(w[i] & 0xffff0000u); } }
    float o[NMAP][32], l[NMAP];
#pragma unroll
    for (int m = 0; m < NMAP; ++m) { l[m] = 0.f;
#pragma unroll
        for (int i = 0; i < 32; ++i) o[m][i] = 0.f; }
    for (int t = t0; t < t1; ++t) {
        const char* kt = Kt + (size_t)t * KTB; const char* vt = Vt + (size_t)t * 8192 + dh * 4096;
        for (int key = 0; key < 64; ++key) {
            float pm[NMAP];
#pragma unroll
            for (int m = 0; m < NMAP; ++m) { float s = 0.f;
#pragma unroll
                for (int c = 0; c < DMAP / 8; ++c) { const u32x4 w = *(const u32x4*)(kt + (m * (DMAP / 8) + c) * 1024 + key * 16);
#pragma unroll
                    for (int i = 0; i < 4; ++i) { s += qv[m * DMAP + c * 8 + 2 * i] * __uint_as_float(w[i] << 16); s += qv[m * DMAP + c * 8 + 2 * i + 1] * __uint_as_float(w[i] & 0xffff0000u); } }
                pm[m] = __builtin_amdgcn_exp2f(s); l[m] += pm[m]; }
            const char* vr = vt + (key >> 4) * 1024 + ((key >> 3) & 1) * 512 + (key & 7) * 64;
#pragma unroll
            for (int c = 0; c < 4; ++c) { const u32x4 w = *(const u32x4*)(vr + c * 16);
#pragma unroll
                for (int i = 0; i < 4; ++i) { const float v0 = __uint_as_float(w[i] << 16), v1 = __uint_as_float(w[i] & 0xffff0000u);
#pragma unroll
                    for (int m = 0; m < NMAP; ++m) { o[m][c * 8 + 2 * i] += pm[m] * v0; o[m][c * 8 + 2 * i + 1] += pm[m] * v1; } } }
        }
    }
    float val[32];
    if (NMAP == 1) {
        const float li = 1.0f / l[0];
#pragma unroll
        for (int i = 0; i < 32; ++i) val[i] = o[0][i] * li;
    } else {
        const float l1 = 1.0f / l[0], l2 = lam / l[NMAP - 1]; float ss = 0.f;
#pragma unroll
        for (int i = 0; i < 32; ++i) { val[i] = o[0][i] * l1 - o[NMAP - 1][i] * l2; ss += val[i] * val[i]; }
        ALDS float* ex = (ALDS float*)lds;
        __syncthreads(); ex[tid] = ss; __syncthreads();
        ss += ex[tid ^ 256];
        __syncthreads();
        const float rstd = rsqrtf(ss * (1.0f / 64.0f) + 1e-6f) * oml;
#pragma unroll
        for (int i = 0; i < 32; ++i) val[i] *= rstd * gout[dh * 32 + i];
    }
    bf16_t* orow = Ob + (size_t)q * 1024 + dh * 32;
#pragma unroll
    for (int c = 0; c < 4; ++c) { u32x4 w;
#pragma unroll
        for (int i = 0; i < 4; ++i) w[i] = cvtpk(val[c * 8 + 2 * i], val[c * 8 + 2 * i + 1]);
        *(u32x4*)(orow + c * 8) = w; }
}
}
constexpr int NWAVES = 8;
constexpr int DM = 1024, NB = 4, SEQ = 8192, CL = 256, NTOKB = SEQ + CL, LROWS = NB * SEQ, MROWS = LROWS + NB * CL;
constexpr int NLAYER = 2, INC = 1952, ZP = 3072, NE = 16, FFD = 2048, CAPL = 1024, CAPC = 32, NKT = NTOKB / 64;
constexpr int ZQ = 1952, ZKV = 2336, ZEND = 2848;
constexpr float EPSF = 1e-6f, LOG2E = 1.4426950408889634f;
constexpr int N_PHASES = 22;
enum { I_X = 0, I_C, I_CTX, I_CCTX, I_WADA, I_BADA, I_GN1, I_WIN, I_GCQ, I_GCKV, I_WUQ, I_WUKV, I_GMQ, I_GMK, I_GDQ, I_GDK, I_LQ1, I_LK1, I_LQ2, I_LK2, I_GDO, I_GGQ, I_GGK, I_WO, I_GN2, I_WR, I_WG, I_WU, I_WD, N_IN };
constexpr size_t MiB = 1u << 20;
constexpr size_t WS_CTL = 0, CTL_ZERO_BYTES = 1 * MiB;
constexpr size_t WS_MOD = 1 * MiB;
constexpr size_t WS_LAM = WS_MOD + 256 * 1024;
constexpr size_t WS_TAB = WS_MOD + 320 * 1024;
constexpr size_t TAB_AROW = 0, TAB_ACOL = 128 * 8 * 8, TAB_GROW = TAB_ACOL + 64 * 8 * 8, TAB_GCOL = TAB_GROW + 128 * 16 * 8;
constexpr size_t WS_AFF = 2 * MiB, WS_AFFC = 4 * MiB;
constexpr size_t WS_IDX = 5 * MiB, WS_GATE = 6 * MiB;
constexpr size_t WS_INV = 7 * MiB;
constexpr size_t WS_WCAT = 16 * MiB;
constexpr size_t WS_WO = 28 * MiB;
constexpr size_t WS_CTXW = 32 * MiB;
constexpr size_t WS_H = 36 * MiB;
constexpr size_t WS_WGU = 102 * MiB;
constexpr size_t WS_WD = 230 * MiB;
constexpr size_t WS_YE = 294 * MiB;
constexpr size_t WS_Z = 430 * MiB;
constexpr size_t WS_QKV = 628 * MiB;
constexpr size_t WS_ATT = 793 * MiB;
constexpr size_t WS_XE = 430 * MiB;
constexpr size_t WS_HID = 566 * MiB;
constexpr size_t WS_END = 859 * MiB;
constexpr size_t QO_QM = 0, QO_QD = 25952256, QO_QG = 43253760, QO_KM = 77856768, QO_KD = 103809024, QO_KG = 121110528, QO_VM = 129761280, QO_VD = 147062784, QO_VG = 164364288;
static_assert(QO_VG + 8650752 == 173015040 && WS_QKV + 173015040 <= WS_ATT && WS_HID + (size_t)16 * 4352 * 2048 * 2 <= WS_END, "ws map");
constexpr int CW_BAR = 4096, CW_Q = 16384;
constexpr int RING_BYTES = 131072, LDSCTL_OFF = RING_BYTES, MISC_OFF = LDSCTL_OFF + 320, LDS_BYTES = 147456;

#define GAS __attribute__((address_space(1)))
#define LAS __attribute__((address_space(3)))
typedef unsigned short bf16;
typedef unsigned v4u __attribute__((ext_vector_type(4)));
typedef unsigned v2u __attribute__((ext_vector_type(2)));
typedef float f32x4 __attribute__((ext_vector_type(4)));
typedef float f32x2 __attribute__((ext_vector_type(2)));
typedef GAS unsigned gu32;
#define RLX_AGENT __ATOMIC_RELAXED, __HIP_MEMORY_SCOPE_AGENT
#define LDS_WAIT() asm volatile("s_waitcnt lgkmcnt(0)" ::: "memory")
__device__ __forceinline__ unsigned pk2(float lo, float hi) { return att::cvtpk(lo, hi); }
__device__ __forceinline__ float bflo(unsigned w) { return __uint_as_float(w << 16); }
__device__ __forceinline__ float bfhi(unsigned w) { return __uint_as_float(w & 0xffff0000u); }
#define XB_TMO      128
#define XB_XCNT(j)  (256  + 64 * (j))
#define XB_XSUB(j)  (1280 + 64 * (j))
#define XB_XGEN(j)  (2304 + 64 * (j))
#define XB_TOP      3328
#define XB_TOPGEN   3392
#define XCD_BAR_WORDS 3456
#define XB_SPIN_CAP (1u << 18)

__device__ __forceinline__ unsigned xb_ld(unsigned* p)              { return __hip_atomic_load(p, __ATOMIC_RELAXED, __HIP_MEMORY_SCOPE_AGENT); }
__device__ __forceinline__ unsigned xb_add(unsigned* p, unsigned v) { return __hip_atomic_fetch_add(p, v, __ATOMIC_RELAXED, __HIP_MEMORY_SCOPE_AGENT); }
__device__ __forceinline__ unsigned xb_xcc_id() { return (unsigned)__builtin_amdgcn_s_getreg((3 << 11) | 20) & 0xFu; }
#define XB_SPIN(cond, bar) do { unsigned _sp = 0; while (cond) { __builtin_amdgcn_s_sleep(1); \
    if ((++_sp & 255u) == 0u) { if (xb_ld(&(bar)[XB_TMO])) break; if (_sp > XB_SPIN_CAP) { atomicAdd(&(bar)[XB_TMO], 1u); break; } } } } while (0)

struct XcdBarrier {
    unsigned* bar; unsigned x;
    volatile LAS unsigned* st;
};

__device__ __forceinline__ XcdBarrier xcd_barrier_post(unsigned* bar, volatile LAS unsigned* st) {
    XcdBarrier b; b.bar = bar; b.x = xb_xcc_id(); b.st = st;
    if (threadIdx.x == 0) (void)xb_add(&bar[XB_XCNT(b.x)], 1u);
    return b;
}
__device__ __forceinline__ void xcd_barrier_complete(unsigned* bar, unsigned x, unsigned& nloc, unsigned& nx) {
    const unsigned G = gridDim.x * gridDim.y * gridDim.z;
    unsigned sum, cnt, mine, sp = 0u;
    for (;;) {
        sum = 0u; cnt = 0u; mine = 0u;
#pragma unroll
        for (unsigned j = 0; j < 16; ++j) { const unsigned c = xb_ld(&bar[XB_XCNT(j)]); sum += c; cnt += (c > 0u) ? 1u : 0u; mine = (j == x) ? c : mine; }
        if (sum == G) break;
        __builtin_amdgcn_s_sleep(1);
        if ((++sp & 255u) == 0u) { if (xb_ld(&bar[XB_TMO])) break; if (sp > XB_SPIN_CAP) { atomicAdd(&bar[XB_TMO], 1u); break; } }
    }
    nloc = mine > 0u ? mine : 1u; nx = cnt > 0u ? cnt : 1u;
}

__device__ __forceinline__ void xcd_barrier(const XcdBarrier& b) {
    asm volatile("s_waitcnt vmcnt(0)" ::: "memory");
    __syncthreads();
    if (threadIdx.x == 0) {
        unsigned* bar = b.bar;
        __builtin_amdgcn_s_waitcnt(0);
        unsigned nloc = b.st[0], nx = b.st[1];
        if (nloc == 0u) { xcd_barrier_complete(bar, b.x, nloc, nx); b.st[0] = nloc; b.st[1] = nx; }
        const unsigned old = xb_add(&bar[XB_XSUB(b.x)], 1u);
        const unsigned gen = old / nloc;
        if (old + 1u == (gen + 1u) * nloc) {
            __builtin_amdgcn_fence(__ATOMIC_RELEASE, "agent");
            asm volatile("s_waitcnt vmcnt(0)" ::: "memory");
            const unsigned og = xb_add(&bar[XB_TOP], 1u);
            const unsigned tg = og / nx;
            if (og + 1u == (tg + 1u) * nx) xb_add(&bar[XB_TOPGEN], 1u);
            else XB_SPIN(xb_ld(&bar[XB_TOPGEN]) == tg, bar);
            __builtin_amdgcn_fence(__ATOMIC_ACQUIRE, "agent");
            xb_add(&bar[XB_XGEN(b.x)], 1u);
            asm volatile("s_waitcnt vmcnt(0)" ::: "memory");
        } else {
            XB_SPIN(xb_ld(&bar[XB_XGEN(b.x)]) == gen, bar);
            __builtin_amdgcn_fence(__ATOMIC_ACQUIRE, "agent");
            asm volatile("s_waitcnt vmcnt(0)" ::: "memory");
        }
    }
    __syncthreads();
}
struct Args { const float* in[N_IN]; float* out; unsigned char* ws; int ph_lo, ph_hi; };
static_assert(sizeof(Args) == 256, "Args has no padding bytes");
typedef const __attribute__((address_space(4))) Args* KA;
__device__ __forceinline__ KA kargs() { KA p = (KA)__builtin_amdgcn_kernarg_segment_ptr(); asm volatile("" : "+s"(p)); return p; }
struct Frame {
    LAS unsigned char* lds;
    volatile LAS unsigned* MISC;
    gu32* ctl;
    int tid, lane, wave, vcu, G;
};
__device__ __forceinline__ void relane(Frame& F) { int t = threadIdx.x; asm volatile("" : "+v"(t)); F.tid = t; F.lane = t & 63; F.wave = __builtin_amdgcn_readfirstlane(t >> 6); }
__device__ __forceinline__ float wave_sum(float v) {
#pragma unroll
    for (int o = 1; o < 64; o <<= 1) v += __shfl_xor(v, o);
    return v;
}
__device__ __forceinline__ float silu_f(float x) { return x / (1.0f + __expf(-x)); }

__device__ __forceinline__ void transpose_item(const float* __restrict__ W, int N, bf16* __restrict__ WT, int ldt, int k0, int n0, int rowbase, LAS float* scr, int lane) {
#pragma unroll 8
    for (int i = 0; i < 32; ++i) { const int kk = 2 * i + (lane >> 5); scr[kk * 33 + (lane & 31)] = W[(size_t)(k0 + kk) * N + n0 + (lane & 31)]; }
    LDS_WAIT(); asm volatile("" ::: "memory");
    const int c = lane & 7;
#pragma unroll
    for (int j = 0; j < 4; ++j) { const int n = (lane >> 3) + 8 * j; const LAS float* s = scr + (8 * c) * 33 + n;
        v4u o; o.x = pk2(s[0 * 33], s[1 * 33]); o.y = pk2(s[2 * 33], s[3 * 33]); o.z = pk2(s[4 * 33], s[5 * 33]); o.w = pk2(s[6 * 33], s[7 * 33]);
        *(v4u*)(WT + (size_t)(rowbase + n) * ldt + k0 + 8 * c) = o; }
    LDS_WAIT(); asm volatile("" ::: "memory");
}

__device__ __forceinline__ void sincos_d(float af, float& c, float& s) {
    const double a = (double)af;
    const double q = __builtin_rint(a * 0.63661977236758134308);
    double r = __builtin_fma(-q, 1.57079632679489655800e+00, a); r = __builtin_fma(-q, 6.12323399573676603587e-17, r);
    const double r2 = r * r;
    double sp = -7.6471637318198164759e-13; sp = sp * r2 + 1.6059043836821614599e-10; sp = sp * r2 - 2.5052108385441718775e-08; sp = sp * r2 + 2.7557319223985890653e-06;
    sp = sp * r2 - 1.9841269841269841270e-04; sp = sp * r2 + 8.3333333333333333333e-03; sp = sp * r2 - 1.6666666666666666667e-01; const double sn = r + r * r2 * sp;
    double cp = 4.7794773323873852974e-14; cp = cp * r2 - 1.1470745597729724714e-11; cp = cp * r2 + 2.0876756987868098979e-09; cp = cp * r2 - 2.7557319223985890653e-07;
    cp = cp * r2 + 2.4801587301587301587e-05; cp = cp * r2 - 1.3888888888888888889e-03; cp = cp * r2 + 4.1666666666666666667e-02; cp = cp * r2 - 0.5; const double cs = 1.0 + r2 * cp;
    const int qi = (int)q & 3;
    const double cc = (qi == 0) ? cs : (qi == 1) ? -sn : (qi == 2) ? -cs : sn;
    const double ss = (qi == 0) ? sn : (qi == 1) ? cs : (qi == 2) ? -sn : -cs;
    c = (float)cc; s = (float)ss;
}

#define MEMFENCE() asm volatile("" ::: "memory")
__device__ __forceinline__ void p0_prologue(KA a, Frame& F) {
    relane(F);
    unsigned char* ws = a->ws;
    float* MOD = (float*)(ws + WS_MOD);
    for (int it = blockIdx.x; it < 192; it += F.G) {
        const int l = it / 96, col = (it % 96) * 64 + F.lane;
        const float* W = a->in[I_WADA] + (size_t)l * 1024 * 6144;
        float acc[5] = {0.f, 0.f, 0.f, 0.f, 0.f};
        for (int kk = 0; kk < 128; ++kk) { const int k = F.wave * 128 + kk; const float w = W[(size_t)k * 6144 + col];
#pragma unroll
            for (int v = 0; v < 5; ++v) { const float cv = (v < 4) ? a->in[I_C][v * 1024 + k] : a->in[I_CCTX][k]; acc[v] += silu_f(cv) * w; } }
        LAS float* red = (LAS float*)F.lds;
#pragma unroll
        for (int v = 0; v < 5; ++v) red[(F.wave * 5 + v) * 64 + F.lane] = acc[v];
        __syncthreads();
        if (F.wave < 5) { float s = a->in[I_BADA][l * 6144 + col];
#pragma unroll
            for (int w = 0; w < 8; ++w) s += red[(w * 5 + F.wave) * 64 + F.lane];
            MOD[(l * 5 + F.wave) * 6144 + col] = s; }
        __syncthreads();
    }
    if ((int)blockIdx.x == 192 % F.G && F.wave == 0) {
        float* LAM = (float*)(ws + WS_LAM);
        for (int l = 0; l < NLAYER; ++l) {
            const float p1 = F.lane < 32 ? a->in[I_LQ1][l * 32 + F.lane] * a->in[I_LK1][l * 32 + F.lane] : 0.f;
            const float p2 = F.lane < 32 ? a->in[I_LQ2][l * 32 + F.lane] * a->in[I_LK2][l * 32 + F.lane] : 0.f;
            const float s1 = wave_sum(p1), s2 = wave_sum(p2);
            const float li = 0.8f - 0.6f * expf(-0.3f * (float)l);
            if (F.lane == 0) { LAM[2 * l] = expf(s1) - expf(s2) + li; LAM[2 * l + 1] = li; }
        }
    }
    if ((int)blockIdx.x == 193 % F.G) {
        f32x2* TA_R = (f32x2*)(ws + WS_TAB + TAB_AROW); f32x2* TA_C = (f32x2*)(ws + WS_TAB + TAB_ACOL); f32x2* TG_R = (f32x2*)(ws + WS_TAB + TAB_GROW); f32x2* TG_C = (f32x2*)(ws + WS_TAB + TAB_GCOL);
        const double b8 = 1.0 / __builtin_sqrt(__builtin_sqrt(__builtin_sqrt(10000.0))), b16 = 1.0 / __builtin_sqrt(__builtin_sqrt(__builtin_sqrt(__builtin_sqrt(10000.0))));
        for (int e = F.tid; e < 4608; e += NWAVES * 64) {
            int pos, i, nf; f32x2* dst;
            if (e < 1024) { pos = e >> 3; i = e & 7; nf = 8; dst = TA_R + e; }
            else if (e < 1536) { const int r = e - 1024; pos = r >> 3; i = r & 7; nf = 8; dst = TA_C + r; }
            else if (e < 3584) { const int r = e - 1536; pos = r >> 4; i = r & 15; nf = 16; dst = TG_R + r; }
            else { const int r = e - 3584; pos = r >> 4; i = r & 15; nf = 16; dst = TG_C + r; }
            double inv = 1.0; const double bb = (nf == 8) ? b8 : b16;
            for (int j = 0; j < i; ++j) inv *= bb;
            const float ang = (float)pos * (float)inv;
            float c, s; sincos_d(ang, c, s);
            *dst = (f32x2){c, s};
        }
    }
    for (int it = blockIdx.x; it < 896; it += F.G) {
        const int l = it / 448; int r = it % 448;
        int kb, nb, R, roff, ncols, orow0; const float *Wu, *gg;
        if (r < 192) { kb = r / 6; nb = r % 6; R = 256; roff = 0; ncols = 384; orow0 = ZQ + nb * 64; Wu = a->in[I_WUQ] + (size_t)l * 256 * 384; gg = a->in[I_GCQ] + l * 256; }
        else { r -= 192; kb = r / 8; nb = r % 8; R = 128; roff = 256; ncols = 512; orow0 = ZKV + nb * 64; Wu = a->in[I_WUKV] + (size_t)l * 128 * 512; gg = a->in[I_GCKV] + l * 128; }
        const float* Win = a->in[I_WIN] + (size_t)l * 1024 * INC;
        LAS float* As = (LAS float*)F.lds; LAS float* Bs = As + 32 * 257;
        for (int idx = F.tid; idx < 32 * R; idx += NWAVES * 64) { const int kk = idx / R, rr = idx % R; As[kk * 257 + rr] = Win[(size_t)(kb * 32 + kk) * INC + roff + rr]; }
        for (int idx = F.tid; idx < R * 64; idx += NWAVES * 64) { const int rr = idx >> 6, n = idx & 63; Bs[rr * 64 + n] = gg[rr] * Wu[(size_t)rr * ncols + nb * 64 + n]; }
        __syncthreads();
        const int kk = F.tid & 31, ng = F.tid >> 5;
        f32x4 acc = (f32x4){0.f, 0.f, 0.f, 0.f};
        for (int rr = 0; rr < R; ++rr) { const float av = As[kk * 257 + rr]; const f32x4 bv = *(const LAS f32x4*)(Bs + rr * 64 + ng * 4); acc += av * bv; }
        bf16* Wc = (bf16*)(ws + WS_WCAT) + (size_t)l * ZP * 1024;
#pragma unroll
        for (int j = 0; j < 4; ++j) Wc[(size_t)(orow0 + ng * 4 + j) * 1024 + kb * 32 + kk] = (bf16)(pk2(acc[j], 0.f) & 0xffffu);
        __syncthreads();
    }
    {
        LAS float* scr = (LAS float*)(F.lds + F.wave * 16384);
        const int gw = F.vcu * NWAVES + F.wave, NGW = F.G * NWAVES;
        constexpr int I_IN = 16 * 61, I_O = 16 * 32, PER_L = I_IN + I_O;
        for (int it = gw; it < NLAYER * PER_L; it += NGW) {
            const int l = it / PER_L; int r = it % PER_L;
            if (r < I_IN) { const int kb = r / 61, nb = r % 61; transpose_item(a->in[I_WIN] + (size_t)l * 1024 * INC, INC, (bf16*)(ws + WS_WCAT) + (size_t)l * ZP * 1024, 1024, kb * 64, nb * 32, nb * 32, scr, F.lane); }
            else { r -= I_IN; const int kb = r / 32, nb = r % 32; transpose_item(a->in[I_WO] + (size_t)l * 1024 * 1024, 1024, (bf16*)(ws + WS_WO) + (size_t)l * 1024 * 1024, 1024, kb * 64, nb * 32, nb * 32, scr, F.lane); }
        }
        const int gt = F.vcu * (NWAVES * 64) + F.tid, NGT = F.G * NWAVES * 64;
        constexpr int PADV = (ZP - ZEND) * 1024 * 2 / 16;
        for (int i = gt; i < NLAYER * PADV; i += NGT) { const int l = i / PADV, j = i % PADV; ((v4u*)((bf16*)(ws + WS_WCAT) + ((size_t)l * ZP + ZEND) * 1024))[j] = (v4u){0u, 0u, 0u, 0u}; }
    }
}

__device__ __forceinline__ void phase_a(KA a, Frame& F, int l) {
    relane(F);
    unsigned char* ws = a->ws;
    const float* MOD = (const float*)(ws + WS_MOD);
    const int* INV = (const int*)(ws + WS_INV);
    const bf16* YE = (const bf16*)(ws + WS_YE);
    float* CTXW = (float*)(ws + WS_CTXW);
    bf16* H = (bf16*)(ws + WS_H);
    const bool fin = (l == NLAYER);
    const int nrows = fin ? LROWS : MROWS;
    const int gw = F.vcu * NWAVES + F.wave, NGW = F.G * NWAVES;
    for (int row = gw; row < nrows; row += NGW) {
        const bool isc = row >= LROWS; const int v = isc ? 4 : (row >> 13);
        const float* src = (l == 0) ? (isc ? a->in[I_CTX] + (size_t)(row - LROWS) * 1024 : a->in[I_X] + (size_t)row * 1024)
                                    : (isc ? CTXW + (size_t)(row - LROWS) * 1024 : a->out + (size_t)row * 1024);
        float* dst = isc ? CTXW + (size_t)(row - LROWS) * 1024 : a->out + (size_t)row * 1024;
        f32x4 xv[4];
#pragma unroll
        for (int j = 0; j < 4; ++j) xv[j] = *(const f32x4*)(src + 4 * F.lane + 256 * j);
        if (l > 0) {
            const float* ga2 = MOD + ((l - 1) * 5 + v) * 6144 + 5 * 1024;
            f32x4 acc[4];
#pragma unroll
            for (int j = 0; j < 4; ++j) acc[j] = (f32x4){0.f, 0.f, 0.f, 0.f};
            for (int e = 0; e < NE; ++e) {
                const int s = __builtin_amdgcn_readfirstlane(INV[(size_t)row * 16 + e]);
                if (s >= 0) { const bf16* yr = YE + (size_t)s * 1024 + 4 * F.lane;
#pragma unroll
                    for (int j = 0; j < 4; ++j) { const v2u w = *(const v2u*)(yr + 256 * j); acc[j] += (f32x4){bflo(w.x), bfhi(w.x), bflo(w.y), bfhi(w.y)}; } }
            }
#pragma unroll
            for (int j = 0; j < 4; ++j) { const f32x4 g = *(const f32x4*)(ga2 + 4 * F.lane + 256 * j); xv[j] += g * acc[j]; }
        }
#pragma unroll
        for (int j = 0; j < 4; ++j) *(f32x4*)(dst + 4 * F.lane + 256 * j) = xv[j];
        if (fin) continue;
        float ss = 0.f;
#pragma unroll
        for (int j = 0; j < 4; ++j) ss += (xv[j].x * xv[j].x + xv[j].y * xv[j].y) + (xv[j].z * xv[j].z + xv[j].w * xv[j].w);
        const float rstd = rsqrtf(wave_sum(ss) * (1.0f / 1024.0f) + EPSF);
        const float* g1 = a->in[I_GN1] + l * 1024; const float* sh = MOD + (l * 5 + v) * 6144; const float* sc = sh + 1024;
#pragma unroll
        for (int j = 0; j < 4; ++j) { const int c0 = 4 * F.lane + 256 * j; const f32x4 g = *(const f32x4*)(g1 + c0), s1 = *(const f32x4*)(sc + c0), b1 = *(const f32x4*)(sh + c0);
            const f32x4 h = xv[j] * rstd * g * (1.0f + s1) + b1;
            v2u w; w.x = pk2(h.x, h.y); w.y = pk2(h.z, h.w); *(v2u*)(H + (size_t)row * 1024 + c0) = w; }
    }
}

__device__ __forceinline__ void ld8(const bf16* p, float* f) { const v4u w = *(const v4u*)p; f[0] = bflo(w.x); f[1] = bfhi(w.x); f[2] = bflo(w.y); f[3] = bfhi(w.y); f[4] = bflo(w.z); f[5] = bfhi(w.z); f[6] = bflo(w.w); f[7] = bfhi(w.w); }
__device__ __forceinline__ v4u pk8(const float* f) { v4u w; w.x = pk2(f[0], f[1]); w.y = pk2(f[2], f[3]); w.z = pk2(f[4], f[5]); w.w = pk2(f[6], f[7]); return w; }
template <int N> __device__ __forceinline__ float ssq_row(const bf16* p) { float s = 0.f;
#pragma unroll
    for (int c = 0; c < N / 8; ++c) { float f[8]; ld8(p + 8 * c, f);
#pragma unroll
        for (int i = 0; i < 8; ++i) s += f[i] * f[i];
        if ((c & 7) == 7) MEMFENCE(); }
    return s; }
template <int NP> __device__ __forceinline__ void rope_pairs(float* x, const f32x2* trow, const f32x2* tcol) {
#pragma unroll
    for (int i = 0; i < NP; ++i) { const f32x2 cs = (i < NP / 2) ? trow[i] : tcol[i - NP / 2];
        const float x0 = x[2 * i], x1 = x[2 * i + 1]; x[2 * i] = x0 * cs.x - x1 * cs.y; x[2 * i + 1] = x0 * cs.y + x1 * cs.x; }
}
__device__ __forceinline__ void store_v_tile(char* vt, int lane, const float* v  ) {
    char* p = vt + (lane >> 4) * 1024 + ((lane >> 3) & 1) * 512 + (lane & 7) * 64;
#pragma unroll
    for (int d = 0; d < 2; ++d)
#pragma unroll
        for (int c = 0; c < 4; ++c) *(v4u*)(p + d * 4096 + c * 16) = pk8(v + d * 32 + c * 8);
}
template <bool ROPE> __device__ __forceinline__ v4u proc8(v4u w, float r, const float* g, const f32x2* cs, float qs) {
    float f[8] = {bflo(w.x), bfhi(w.x), bflo(w.y), bfhi(w.y), bflo(w.z), bfhi(w.z), bflo(w.w), bfhi(w.w)};
#pragma unroll
    for (int i = 0; i < 8; ++i) f[i] *= r * g[i];
    if (ROPE) {
#pragma unroll
        for (int i = 0; i < 4; ++i) { const f32x2 t = cs[i]; const float x0 = f[2 * i], x1 = f[2 * i + 1]; f[2 * i] = x0 * t.x - x1 * t.y; f[2 * i + 1] = x0 * t.y + x1 * t.x; }
    }
#pragma unroll
    for (int i = 0; i < 8; ++i) f[i] *= qs;
    return pk8(f);
}
__device__ __forceinline__ float ssq8(v4u w) { const float f[8] = {bflo(w.x), bfhi(w.x), bflo(w.y), bfhi(w.y), bflo(w.z), bfhi(w.z), bflo(w.w), bfhi(w.w)}; float s = 0.f;
#pragma unroll
    for (int i = 0; i < 8; ++i) s += f[i] * f[i];
    return s; }
__device__ __forceinline__ v4u scale8(v4u w, float r) { float f[8] = {bflo(w.x), bfhi(w.x), bflo(w.y), bfhi(w.y), bflo(w.z), bfhi(w.z), bflo(w.w), bfhi(w.w)};
#pragma unroll
    for (int i = 0; i < 8; ++i) f[i] *= r;
    return pk8(f); }
__device__ __forceinline__ void store_v_tile_pk(char* vt, int lane, const v4u* w) {
    char* p = vt + (lane >> 4) * 1024 + ((lane >> 3) & 1) * 512 + (lane & 7) * 64;
#pragma unroll
    for (int c = 0; c < 8; ++c) *(v4u*)(p + (c >> 2) * 4096 + (c & 3) * 16) = w[c];
}
__device__ __forceinline__ void phase_c(KA a, Frame& F, int l) {
    relane(F);
    unsigned char* ws = a->ws;
    const bf16* Z = (const bf16*)(ws + WS_Z);
    unsigned char* qkv = ws + WS_QKV;
    const f32x2* TA_R = (const f32x2*)(ws + WS_TAB + TAB_AROW); const f32x2* TA_C = (const f32x2*)(ws + WS_TAB + TAB_ACOL);
    const f32x2* TG_R = (const f32x2*)(ws + WS_TAB + TAB_GROW); const f32x2* TG_C = (const f32x2*)(ws + WS_TAB + TAB_GCOL);
    const int gw = F.vcu * NWAVES + F.wave, NGW = F.G * NWAVES, lane = F.lane;
    for (int id = gw; id < 528 * 32; id += NGW) {
        const int tile = id % 528, job = id / 528;
        const int b = tile / NKT, tt = tile % NKT; const bool isc = tt >= 128;
        const int zrow = isc ? LROWS + b * CL + (tt - 128) * 64 + lane : b * SEQ + tt * 64 + lane;
        const int tok = tt * 64 + lane;
        const bf16* zr = Z + (size_t)zrow * ZP;
        const f32x2* tar = TA_R + (isc ? 0 : tt) * 8; const f32x2* tac = TA_C + lane * 8;
        const f32x2* tgr = TG_R + (isc ? 0 : tt) * 16; const f32x2* tgc = TG_C + lane * 16;
        MEMFENCE();
        if (job < 4) {
            const int h = job;
            const float r1 = rsqrtf(ssq_row<256>(zr) * (1.0f / 256.0f) + EPSF);
            MEMFENCE();
            v4u w[12]; float ss = 0.f;
#pragma unroll
            for (int c = 0; c < 12; ++c) { w[c] = *(const v4u*)(zr + ZQ + h * 96 + 8 * c); ss += ssq8(w[c]); }
            MEMFENCE();
            const float r = r1 * rsqrtf(ss * r1 * r1 * (1.0f / 96.0f) + EPSF); const float* g = a->in[I_GMQ] + l * 96;
            const float qs = 0.10206207261596575f * LOG2E;
            bf16* q = (bf16*)(qkv + QO_QM) + ((size_t)(b * 4 + h) * NTOKB + tok) * 96;
#pragma unroll
            for (int c = 0; c < 12; ++c) {
                v4u o;
                if (c < 8 || isc) o = proc8<false>(w[c], r, g + 8 * c, nullptr, qs);
                else o = proc8<true>(w[c], r, g + 8 * c, (c < 10) ? tar + 4 * (c - 8) : tac + 4 * (c - 10), qs);
                *(v4u*)(q + 8 * c) = o; MEMFENCE(); }
        } else if (job < 8) {
            const int h = job - 4;
            const float r1 = rsqrtf(ssq_row<128>(zr + 256) * (1.0f / 128.0f) + EPSF);
            MEMFENCE();
            v4u w[12]; float ss = 0.f, s2 = 0.f;
#pragma unroll
            for (int c = 0; c < 8; ++c) { w[c] = *(const v4u*)(zr + ZKV + h * 128 + 8 * c); ss += ssq8(w[c]); }
#pragma unroll
            for (int c = 0; c < 4; ++c) { w[8 + c] = *(const v4u*)(zr + 384 + 8 * c); s2 += ssq8(w[8 + c]); }
            MEMFENCE();
            const float r2 = rsqrtf((ss * r1 * r1 + s2) * (1.0f / 96.0f) + EPSF); const float* g = a->in[I_GMK] + l * 96;
            char* kt = (char*)(qkv + QO_KM) + ((size_t)(b * 4 + h) * NKT + tt) * 12288 + lane * 16;
#pragma unroll
            for (int c = 0; c < 12; ++c) {
                v4u o;
                if (c < 8) o = proc8<false>(w[c], r1 * r2, g + 8 * c, nullptr, 1.0f);
                else if (isc) o = proc8<false>(w[c], r2, g + 8 * c, nullptr, 1.0f);
                else o = proc8<true>(w[c], r2, g + 8 * c, (c < 10) ? tar + 4 * (c - 8) : tac + 4 * (c - 10), 1.0f);
                *(v4u*)(kt + c * 1024) = o; MEMFENCE(); }
            v4u vw[8];
#pragma unroll
            for (int c = 0; c < 8; ++c) vw[c] = scale8(*(const v4u*)(zr + ZKV + h * 128 + 64 + 8 * c), r1);
            store_v_tile_pk((char*)(qkv + QO_VM) + ((size_t)(b * 4 + h) * NKT + tt) * 8192, lane, vw);
        } else if (job < 16) {
            const bool isk = job >= 12; const int h = (job - 8) & 3;
            const bf16* zp = zr + (isk ? 672 : 416) + h * 64; const float* g = (isk ? a->in[I_GDK] : a->in[I_GDQ]) + l * 32;
            const float qs = isk ? 1.0f : 0.17677669529663687f * LOG2E;
            v4u w[8]; float ss[2] = {0.f, 0.f};
#pragma unroll
            for (int c = 0; c < 8; ++c) { w[c] = *(const v4u*)(zp + 8 * c); ss[c >> 2] += ssq8(w[c]); }
            MEMFENCE();
            const float r0 = rsqrtf(ss[0] * (1.0f / 32.0f) + EPSF), r1 = rsqrtf(ss[1] * (1.0f / 32.0f) + EPSF);
            char* kt = (char*)(qkv + QO_KD) + ((size_t)(b * 4 + h) * NKT + tt) * 8192 + lane * 16;
            bf16* q = (bf16*)(qkv + QO_QD) + ((size_t)(b * 4 + h) * NTOKB + tok) * 64;
#pragma unroll
            for (int c = 0; c < 8; ++c) { const int cm = c & 3;
                v4u o;
                if (isc) o = proc8<false>(w[c], (c < 4) ? r0 : r1, g + 8 * cm, nullptr, qs);
                else o = proc8<true>(w[c], (c < 4) ? r0 : r1, g + 8 * cm, (cm < 2) ? tar + 4 * cm : tac + 4 * (cm - 2), qs);
                if (isk) *(v4u*)(kt + c * 1024) = o; else *(v4u*)(q + 8 * c) = o;
                MEMFENCE(); }
        } else if (job < 20) {
            const int h = job - 16; v4u vw[8];
#pragma unroll
            for (int c = 0; c < 8; ++c) vw[c] = *(const v4u*)(zr + 928 + h * 64 + 8 * c);
            store_v_tile_pk((char*)(qkv + QO_VD) + ((size_t)(b * 4 + h) * NKT + tt) * 8192, lane, vw);
        } else if (job < 30) {
            const bool isk = job >= 28; const int h = isk ? job - 28 : job - 20;
            const bf16* zp = zr + (isk ? 1696 : 1184) + h * 64; const float* g = (isk ? a->in[I_GGK] : a->in[I_GGQ]) + l * 64;
            const float qs = isk ? 1.0f : 0.125f * LOG2E;
            v4u w[8]; float ss = 0.f;
#pragma unroll
            for (int c = 0; c < 8; ++c) { w[c] = *(const v4u*)(zp + 8 * c); ss += ssq8(w[c]); }
            MEMFENCE();
            const float r = rsqrtf(ss * (1.0f / 64.0f) + EPSF);
            char* kt = (char*)(qkv + QO_KG) + ((size_t)(b * 2 + h) * NKT + tt) * 8192 + lane * 16;
            bf16* q = (bf16*)(qkv + QO_QG) + ((size_t)(b * 8 + h) * NTOKB + tok) * 64;
#pragma unroll
            for (int c = 0; c < 8; ++c) {
                v4u o;
                if (isc) o = proc8<false>(w[c], r, g + 8 * c, nullptr, qs);
                else o = proc8<true>(w[c], r, g + 8 * c, (c < 4) ? tgr + 4 * c : tgc + 4 * (c - 4), qs);
                if (isk) *(v4u*)(kt + c * 1024) = o; else *(v4u*)(q + 8 * c) = o;
                MEMFENCE(); }
        } else {
            const int h = job - 30; v4u vw[8];
#pragma unroll
            for (int c = 0; c < 8; ++c) vw[c] = *(const v4u*)(zr + 1824 + h * 64 + 8 * c);
            store_v_tile_pk((char*)(qkv + QO_VG) + ((size_t)(b * 2 + h) * NKT + tt) * 8192, lane, vw);
        }
        MEMFENCE();
    }
}

#if MK_NAIVE_ATTN
#define ATT_UNIT att::attn_unit_naive
#else
#define ATT_UNIT att::attn_unit
#endif
__device__ __forceinline__ void phase_d(KA a, Frame& F, int l, bool last) {
    relane(F);
    unsigned char* ws = a->ws; unsigned char* qkv = ws + WS_QKV;
    bf16* ATT = (bf16*)(ws + WS_ATT);
    const float* LAM = (const float*)(ws + WS_LAM);
    const float lam = LAM[2 * l], oml = 1.0f - LAM[2 * l + 1];
    const float* gdo = a->in[I_GDO] + l * 64;
    ALDS char* lds = (ALDS char*)F.lds;
    const int nctx = last ? 0 : 64;
    for (int id = F.vcu; id < 512 + nctx; id += F.G) {
        int b, h, q0, t0, t1; size_t orow;
        if (id < 512) { const int x = (id & 255) >> 5; b = x >> 1; h = 2 * (x & 1) + (id >> 8); q0 = (id & 31) * 256; t0 = 0; t1 = NKT; orow = (size_t)b * SEQ + q0; }
        else { const int c = id - 512; b = c >> 4; h = c & 15; if (h >= 4) continue; q0 = SEQ; t0 = 128; t1 = NKT; orow = (size_t)LROWS + b * CL; }
        ATT_UNIT<96, 1>((const bf16*)(qkv + QO_QM) + ((size_t)(b * 4 + h) * NTOKB + q0) * 96, (const char*)(qkv + QO_KM) + (size_t)(b * 4 + h) * NKT * 12288,
                        (const char*)(qkv + QO_VM) + (size_t)(b * 4 + h) * NKT * 8192, t0, t1, ATT + orow * 1024 + h * 64, lds, 0.f, gdo, 0.f);
    }
    for (int id = 512 + F.vcu; id < 1024 + nctx; id += F.G) {
        int b, h, q0, t0, t1; size_t orow;
        if (id < 1024) { const int x = (id & 255) >> 5; b = x >> 1; h = 2 * (x & 1) + ((id >> 8) - 2); q0 = (id & 31) * 256; t0 = 0; t1 = NKT; orow = (size_t)b * SEQ + q0; }
        else { const int c = id - 1024; b = c >> 4; h = (c & 15) - 4; if (h < 0 || h >= 4) continue; q0 = SEQ; t0 = 128; t1 = NKT; orow = (size_t)LROWS + b * CL; }
        ATT_UNIT<64, 2>((const bf16*)(qkv + QO_QD) + ((size_t)(b * 4 + h) * NTOKB + q0) * 64, (const char*)(qkv + QO_KD) + (size_t)(b * 4 + h) * NKT * 8192,
                        (const char*)(qkv + QO_VD) + (size_t)(b * 4 + h) * NKT * 8192, t0, t1, ATT + orow * 1024 + 256 + h * 64, lds, lam, gdo, oml);
    }
    for (int id = 1024 + F.vcu; id < 2048 + nctx; id += F.G) {
        int b, h, q0, t0, t1; size_t orow;
        if (id < 2048) { const int x = (id & 255) >> 5; b = x >> 1; h = 4 * (x & 1) + ((id >> 8) - 4); q0 = (id & 31) * 256; t0 = 0; t1 = NKT; orow = (size_t)b * SEQ + q0; }
        else { const int c = id - 2048; b = c >> 4; h = (c & 15) - 8; if (h < 0) continue; q0 = SEQ; t0 = 128; t1 = NKT; orow = (size_t)LROWS + b * CL; }
        const int g = h >> 2;
        ATT_UNIT<64, 1>((const bf16*)(qkv + QO_QG) + ((size_t)(b * 8 + h) * NTOKB + q0) * 64, (const char*)(qkv + QO_KG) + (size_t)(b * 2 + g) * NKT * 8192,
                        (const char*)(qkv + QO_VG) + (size_t)(b * 2 + g) * NKT * 8192, t0, t1, ATT + orow * 1024 + 512 + h * 64, lds, 0.f, gdo, 0.f);
    }
}

__device__ __forceinline__ void phase_f(KA a, Frame& F, int l, bool last) {
    relane(F);
    unsigned char* ws = a->ws;
    const float* MOD = (const float*)(ws + WS_MOD);
    float* AFF = (float*)(ws + WS_AFF); float* AFFC = (float*)(ws + WS_AFFC); int* INV = (int*)(ws + WS_INV);
    const float* CTXW = (const float*)(ws + WS_CTXW); bf16* H = (bf16*)(ws + WS_H);
    LAS float* wrT = (LAS float*)F.lds;
    const float* wr = a->in[I_WR] + (size_t)l * 1024 * 16;
    for (int idx = F.tid; idx < 16384; idx += NWAVES * 64) wrT[(idx & 15) * 1024 + (idx >> 4)] = wr[idx];
    __syncthreads();
    const int nrows = last ? LROWS : MROWS;
    const int gw = F.vcu * NWAVES + F.wave, NGW = F.G * NWAVES;
    for (int row = gw; row < nrows; row += NGW) {
        const bool isc = row >= LROWS; const int v = isc ? 4 : (row >> 13);
        const float* src = isc ? CTXW + (size_t)(row - LROWS) * 1024 : a->out + (size_t)row * 1024;
        f32x4 hv[4]; float ss = 0.f;
#pragma unroll
        for (int j = 0; j < 4; ++j) { hv[j] = *(const f32x4*)(src + 4 * F.lane + 256 * j); ss += (hv[j].x * hv[j].x + hv[j].y * hv[j].y) + (hv[j].z * hv[j].z + hv[j].w * hv[j].w); }
        const float rstd = rsqrtf(wave_sum(ss) * (1.0f / 1024.0f) + EPSF);
        const float* g2 = a->in[I_GN2] + l * 1024; const float* sh = MOD + (l * 5 + v) * 6144 + 3 * 1024; const float* sc = sh + 1024;
#pragma unroll
        for (int j = 0; j < 4; ++j) { const int c0 = 4 * F.lane + 256 * j; const f32x4 g = *(const f32x4*)(g2 + c0), s1 = *(const f32x4*)(sc + c0), b1 = *(const f32x4*)(sh + c0);
            hv[j] = hv[j] * rstd * g * (1.0f + s1) + b1;
            v2u w; w.x = pk2(hv[j].x, hv[j].y); w.y = pk2(hv[j].z, hv[j].w); *(v2u*)(H + (size_t)row * 1024 + c0) = w; }
        float lg[16]; float mx = -3.0e38f;
#pragma unroll
        for (int e = 0; e < 16; ++e) { float s = 0.f;
#pragma unroll
            for (int j = 0; j < 4; ++j) { const f32x4 w = *(const LAS f32x4*)(wrT + e * 1024 + 4 * F.lane + 256 * j); s += (hv[j].x * w.x + hv[j].y * w.y) + (hv[j].z * w.z + hv[j].w * w.w); }
            lg[e] = wave_sum(s); mx = fmaxf(mx, lg[e]); MEMFENCE(); }
        float sum = 0.f;
#pragma unroll
        for (int e = 0; e < 16; ++e) { lg[e] = __builtin_amdgcn_exp2f((lg[e] - mx) * LOG2E); sum += lg[e]; }
        const float rs = 1.0f / sum; float mine = 0.f;
#pragma unroll
        for (int e = 0; e < 16; ++e) mine = (F.lane == e) ? lg[e] * rs : mine;
        if (F.lane < 16) {
            if (isc) { const int r = row - LROWS; AFFC[((size_t)((r >> 8) * 16 + F.lane)) * CL + (r & 255)] = mine; }
            else AFF[((size_t)((row >> 13) * 16 + F.lane)) * SEQ + (row & 8191)] = mine;
            INV[(size_t)row * 16 + F.lane] = -1;
        }
    }
}

__device__ __forceinline__ void topk_set(Frame& F, const float* __restrict__ src, int n, int k, int rowbase, int slotbase, int e, int* IDX, float* GATE, int* INV) {
    LAS unsigned* keys = (LAS unsigned*)F.lds; LAS unsigned* hist = keys + 8192; LAS unsigned* sc = hist + 256;
    const int tid = F.tid;
    for (int i = tid; i < n; i += NWAVES * 64) keys[i] = __float_as_uint(src[i]);
    if (tid == 0) { sc[0] = 0u; sc[1] = (unsigned)k; }
    __syncthreads();
    for (int pass = 0; pass < 4; ++pass) {
        const int shift = 24 - 8 * pass; const unsigned mask = (pass == 0) ? 0u : (0xFFFFFFFFu << (shift + 8));
        if (tid < 256) hist[tid] = 0u;
        __syncthreads();
        const unsigned prefix = sc[0];
        for (int i = tid; i < n; i += NWAVES * 64) { const unsigned kv = keys[i]; if ((kv & mask) == prefix) __hip_atomic_fetch_add(&hist[(kv >> shift) & 255u], 1u, __ATOMIC_RELAXED, __HIP_MEMORY_SCOPE_WORKGROUP); }
        __syncthreads();
        if (F.wave == 0) {
            const unsigned need = sc[1]; unsigned h[4]; unsigned tot = 0u;
#pragma unroll
            for (int j = 0; j < 4; ++j) { h[j] = hist[255 - (4 * F.lane + j)]; tot += h[j]; }
            unsigned incl = tot;
#pragma unroll
            for (int d = 1; d < 64; d <<= 1) { const unsigned t = __shfl_up(incl, d); if (F.lane >= d) incl += t; }
            unsigned cum = incl - tot;
#pragma unroll
            for (int j = 0; j < 4; ++j) { if (cum < need && need <= cum + h[j]) { sc[0] = prefix | ((unsigned)(255 - (4 * F.lane + j)) << shift); sc[1] = need - cum; } cum += h[j]; }
        }
        __syncthreads();
    }
    const unsigned T = sc[0], need_eq = sc[1];
    const int per = (n + NWAVES * 64 - 1) / (NWAVES * 64), start = tid * per;
    unsigned cg = 0u, ce = 0u;
    for (int j = 0; j < per; ++j) { const int i = start + j; if (i < n) { const unsigned kv = keys[i]; cg += (kv > T) ? 1u : 0u; ce += (kv == T) ? 1u : 0u; } }
    const unsigned packed = cg | (ce << 16);
    unsigned incl = packed;
#pragma unroll
    for (int d = 1; d < 64; d <<= 1) { const unsigned t = __shfl_up(incl, d); if (F.lane >= d) incl += t; }
    if (F.lane == 63) sc[8 + F.wave] = incl;
    __syncthreads();
    unsigned base = 0u;
    for (int w = 0; w < F.wave; ++w) base += sc[8 + w];
    const unsigned excl = base + incl - packed;
    unsigned gb = excl & 0xFFFFu, eb = excl >> 16;
    for (int j = 0; j < per; ++j) { const int i = start + j; if (i < n) { const unsigned kv = keys[i]; const bool g = kv > T, q = kv == T;
        if (g || (q && eb < need_eq)) { const int slot = slotbase + (int)(gb + (eb < need_eq ? eb : need_eq)); IDX[slot] = rowbase + i; GATE[slot] = __uint_as_float(kv); INV[(size_t)(rowbase + i) * 16 + e] = slot; }
        gb += g ? 1u : 0u; eb += q ? 1u : 0u; } }
    __syncthreads();
}
__device__ __forceinline__ void phase_g(KA a, Frame& F, int l, bool last) {
    relane(F);
    unsigned char* ws = a->ws;
    const float* AFF = (const float*)(ws + WS_AFF); const float* AFFC = (const float*)(ws + WS_AFFC);
    int* IDX = (int*)(ws + WS_IDX); float* GATE = (float*)(ws + WS_GATE); int* INV = (int*)(ws + WS_INV);
    const int RPE = last ? 4096 : 4352, nsets = last ? 64 : 128;
    for (int set = blockIdx.x; set < nsets; set += F.G) {
        if (set < 64) { const int b = set >> 4, e = set & 15; topk_set(F, AFF + (size_t)set * SEQ, SEQ, CAPL, b * SEQ, e * RPE + b * CAPL, e, IDX, GATE, INV); }
        else { const int s2 = set - 64, b = s2 >> 4, e = s2 & 15; topk_set(F, AFFC + (size_t)s2 * CL, CL, CAPC, LROWS + b * CL, e * RPE + 4096 + b * CAPC, e, IDX, GATE, INV);
            if (b == 0 && F.tid < 128) { IDX[e * RPE + 4224 + F.tid] = -1; GATE[e * RPE + 4224 + F.tid] = 0.f; } }
    }
    {
        LAS float* scr = (LAS float*)(F.lds + 40960 + F.wave * 8704);
        gu32* head = F.ctl + CW_Q + 64 * l;
        constexpr int NIT = NE * 3072;
        const float* wg = a->in[I_WG] + (size_t)l * NE * 1024 * 2048; const float* wu = a->in[I_WU] + (size_t)l * NE * 1024 * 2048; const float* wd = a->in[I_WD] + (size_t)l * NE * 2048 * 1024;
        bf16* WGU = (bf16*)(ws + WS_WGU); bf16* WD = (bf16*)(ws + WS_WD);
        for (;;) {
            unsigned basev = 0u;
            if (F.lane == 0) basev = __hip_atomic_fetch_add(head, 8u, RLX_AGENT);
            const int base = __builtin_amdgcn_readfirstlane((int)basev);
            if (base >= NIT) break;
            for (int j = 0; j < 8; ++j) { const int it = base + j; const int e = it / 3072, r = it % 3072, which = r >> 10, ii = r & 1023;
                if (which < 2) { const int kb = ii >> 6, nb = ii & 63, n0 = nb * 32; const int rowbase = (n0 >> 7) * 256 + (n0 & 127) + which * 128;
                    transpose_item((which ? wu : wg) + (size_t)e * 1024 * 2048, 2048, WGU + (size_t)e * 4096 * 1024, 1024, kb * 64, n0, rowbase - 0, scr, F.lane); }
                else { const int kb = ii >> 5, nb = ii & 31, n0 = nb * 32;
                    transpose_item(wd + (size_t)e * 2048 * 1024, 1024, WD + (size_t)e * 1024 * 2048, 2048, kb * 64, n0, n0, scr, F.lane); } }
        }
    }
}

__device__ __forceinline__ void phase_h(KA a, Frame& F, bool last) {
    relane(F);
    unsigned char* ws = a->ws;
    const int* IDX = (const int*)(ws + WS_IDX); const bf16* H = (const bf16*)(ws + WS_H); bf16* XE = (bf16*)(ws + WS_XE);
    const int nrow = NE * (last ? 4096 : 4352);
    const int gw = F.vcu * NWAVES + F.wave, NGW = F.G * NWAVES;
    for (int r = gw; r < nrow; r += NGW) {
        const int s = __builtin_amdgcn_readfirstlane(IDX[r]);
        v4u v0 = (v4u){0u, 0u, 0u, 0u}, v1 = v0;
        if (s >= 0) { const v4u* p = (const v4u*)(H + (size_t)s * 1024); v0 = p[F.lane]; v1 = p[64 + F.lane]; }
        v4u* q = (v4u*)(XE + (size_t)r * 1024); q[F.lane] = v0; q[64 + F.lane] = v1;
    }
}
__global__ void __launch_bounds__(NWAVES * 64, 2) mk_fwd(Args args) {
    extern __shared__ __attribute__((aligned(16))) unsigned char lds[];
    Frame F;
    F.lds = (LAS unsigned char*)lds;
    F.MISC = (volatile LAS unsigned*)(F.lds + MISC_OFF);
    F.tid = threadIdx.x; F.lane = F.tid & 63; F.wave = __builtin_amdgcn_readfirstlane(F.tid >> 6);
    F.G = gridDim.x; { const int bx = blockIdx.x; F.vcu = (F.G % 8 == 0) ? (bx % 8) * (F.G / 8) + bx / 8 : bx; }
    F.ctl = (gu32*)(args.ws + WS_CTL);
    for (int u = F.tid; u < (LDS_BYTES - LDSCTL_OFF) / 4; u += NWAVES * 64) ((LAS unsigned*)(F.lds + LDSCTL_OFF))[u] = 0u;
    __syncthreads();
    const int lo = args.ph_lo, hi = args.ph_hi;
    const bool multi = (hi - lo) > 1;
    XcdBarrier bar; bar.bar = (unsigned*)(F.ctl + CW_BAR); bar.x = 0; bar.st = nullptr;
    if (multi) bar = xcd_barrier_post((unsigned*)(F.ctl + CW_BAR), F.MISC + 8);
#define IN(k) (lo <= (k) && (k) < hi)
#define SEAM(k) do { if (IN((k) + 1)) xcd_barrier(bar); } while (0)

    if (IN(0)) { p0_prologue(kargs(), F); SEAM(0); }

    for (int l = 0; l < NLAYER; ++l) {
        const bool last = (l == NLAYER - 1);
        const int pb = 1 + 10 * l;
        const int RPE = last ? 4096 : 4352;
        if (IN(pb + 0)) { phase_a(kargs(), F, l); SEAM(pb + 0); }
        if (IN(pb + 1)) {
            KA ka = kargs(); unsigned char* ws = ka->ws;
            pg8::Gemm g{(const pg8::bf16_t*)(ws + WS_H), (const pg8::bf16_t*)(ws + WS_WCAT) + (size_t)l * ZP * 1024, MROWS, ZP, DM, 1 << 30, 0};
            pg8::StaticOrder S; S.init(MROWS, ZP, F.G, (int)blockIdx.x);
            pg8::EpiStoreBf16 E{(pg8::bf16_t*)(ws + WS_Z), ZP};
            pg8::gemm_phase<pg8::EpiStoreBf16, pg8::StaticOrder, true, true>(F.lds, g, S, E);
            SEAM(pb + 1);
        }
        if (IN(pb + 2)) { phase_c(kargs(), F, l); SEAM(pb + 2); }
        if (IN(pb + 3)) { phase_d(kargs(), F, l, last); SEAM(pb + 3); }
        if (IN(pb + 4)) {
            KA ka = kargs(); unsigned char* ws = ka->ws; const float* MODL = (const float*)(ws + WS_MOD) + (size_t)l * 5 * 6144;
            const int M = last ? LROWS : MROWS;
            pg8::Gemm g{(const pg8::bf16_t*)(ws + WS_ATT), (const pg8::bf16_t*)(ws + WS_WO) + (size_t)l * 1024 * 1024, M, DM, DM, 1 << 30, 0};
            pg8::StaticOrder S; S.init(M, DM, F.G, (int)blockIdx.x);
            pg8::EpiGatedResidual E{ka->out, (float*)(ws + WS_CTXW), MODL, LROWS};
            pg8::gemm_phase<pg8::EpiGatedResidual, pg8::StaticOrder, true, true>(F.lds, g, S, E);
            SEAM(pb + 4);
        }
        if (IN(pb + 5)) { phase_f(kargs(), F, l, last); SEAM(pb + 5); }
        if (IN(pb + 6)) { phase_g(kargs(), F, l, last); SEAM(pb + 6); }
        if (IN(pb + 7)) { phase_h(kargs(), F, last); SEAM(pb + 7); }
        if (IN(pb + 8)) {
            KA ka = kargs(); unsigned char* ws = ka->ws;
            pg8::Gemm g{(const pg8::bf16_t*)(ws + WS_XE), (const pg8::bf16_t*)(ws + WS_WGU), NE * RPE, 2 * FFD, DM, RPE / 256, (size_t)2 * FFD * DM * 2};
            pg8::StaticOrder S; S.init(NE * RPE, 2 * FFD, F.G, (int)blockIdx.x);
            pg8::EpiSwiGLU E{(pg8::bf16_t*)(ws + WS_HID), FFD};
            pg8::gemm_phase<pg8::EpiSwiGLU, pg8::StaticOrder, true, true>(F.lds, g, S, E);
            SEAM(pb + 8);
        }
        if (IN(pb + 9)) {
            KA ka = kargs(); unsigned char* ws = ka->ws;
            pg8::Gemm g{(const pg8::bf16_t*)(ws + WS_HID), (const pg8::bf16_t*)(ws + WS_WD), NE * RPE, DM, FFD, RPE / 256, (size_t)DM * FFD * 2};
            pg8::StaticOrder S; S.init(NE * RPE, DM, F.G, (int)blockIdx.x);
            pg8::EpiRowScaleBf16 E{(pg8::bf16_t*)(ws + WS_YE), DM, (const float*)(ws + WS_GATE)};
            pg8::gemm_phase<pg8::EpiRowScaleBf16, pg8::StaticOrder, true, true>(F.lds, g, S, E);
            SEAM(pb + 9);
        }
    }
    if (IN(N_PHASES - 1)) phase_a(kargs(), F, NLAYER);
#undef IN
#undef SEAM
}

extern "C" void kernel_launch(void* const* d_in, const int* in_sizes, int n_in, void* d_out, int out_size, void* d_ws, size_t ws_size, hipStream_t stream) {
    static int grid = 0;
    if (grid == 0) {
        if (n_in != N_IN || out_size != LROWS * DM || ws_size < WS_END) { fprintf(stderr, "kernel_launch: unexpected shapes (n_in %d, out %d, ws %zu); nothing launched\n", n_in, out_size, ws_size); grid = -1; return; }
        int dev = 0, cus = 0, per_cu = 0;
        if (hipGetDevice(&dev) != hipSuccess || hipDeviceGetAttribute(&cus, hipDeviceAttributeMultiprocessorCount, dev) != hipSuccess) { grid = -1; return; }
        if (hipFuncSetAttribute((const void*)mk_fwd, hipFuncAttributeMaxDynamicSharedMemorySize, LDS_BYTES) != hipSuccess) { fprintf(stderr, "kernel_launch: hipFuncSetAttribute failed\n"); grid = -1; return; }
        if (hipOccupancyMaxActiveBlocksPerMultiprocessor(&per_cu, (const void*)mk_fwd, NWAVES * 64, LDS_BYTES) != hipSuccess || per_cu < 1) { fprintf(stderr, "kernel_launch: occupancy query reports %d blocks per CU\n", per_cu); }
        (void)hipGetLastError();
        grid = cus;
    }
    if (grid < 0) return;
    if (hipMemsetAsync((char*)d_ws + WS_CTL, 0, CTL_ZERO_BYTES, stream) != hipSuccess) { fprintf(stderr, "kernel_launch: memset failed\n"); return; }
    Args a{};
    for (int i = 0; i < N_IN; ++i) a.in[i] = (const float*)d_in[i];
    a.out = (float*)d_out; a.ws = (unsigned char*)d_ws;
#if MK_SPLIT
    for (int ph = 0; ph < N_PHASES; ++ph) { a.ph_lo = ph; a.ph_hi = ph + 1; hipLaunchKernelGGL(mk_fwd, dim3(grid), dim3(NWAVES * 64), LDS_BYTES, stream, a); }
#else
    a.ph_lo = 0; a.ph_hi = N_PHASES;
    hipLaunchKernelGGL(mk_fwd, dim3(grid), dim3(NWAVES * 64), LDS_BYTES, stream, a);
#endif
    const hipError_t le = hipPeekAtLastError();
    if (le != hipSuccess) fprintf(stderr, "kernel_launch: launch failed: %s\n", hipGetErrorName(le));
}
```

```cpp
#include <hip/hip_runtime.h>
#include <hip/hip_bf16.h>
#include <cstdio>
#include <cstdint>
#ifndef MK_SPLIT
#define MK_SPLIT 0
#endif
#ifndef MK_REP
#define MK_REP 0
#endif
#ifndef MK_ABL
#define MK_ABL 0
#endif
#ifndef MK_ATT_V1
#define MK_ATT_V1 0
#endif
#ifndef MK_NAIVE_ATTN
#define MK_NAIVE_ATTN 0
#endif
namespace pg8 {
#define PG8_LAS __attribute__((address_space(3)))
typedef unsigned short bf16_t;
typedef short bf16x8 __attribute__((ext_vector_type(8)));
typedef float f32x4 __attribute__((ext_vector_type(4)));
typedef unsigned u32x4 __attribute__((ext_vector_type(4)));
constexpr int BM = 256, BK = 64, HALF = 128, HTB = HALF * BK * 2  , STAGE_BYTES = 8 * HTB, NXCD = 8, WGM = 8;

__host__ __device__ __forceinline__ int lds_byte(int r, int c) { const int st = (r >> 4) * 2 + (c >> 5), rr = r & 15, cc = c & 31, ob = rr * 64 + cc * 2; return st * 1024 + (ob ^ (((ob >> 9) & 1) << 5)); }
__host__ __device__ __forceinline__ void stage_rc(int b, int& R, int& C) { const int st = b / 1024, sb = b % 1024, swz = sb ^ (((sb >> 9) & 1) << 5); R = (st >> 1) * 16 + swz / 64; C = (st & 1) * 32 + (swz % 64) / 2; }
__host__ __device__ __forceinline__ int perm32(int rho) { const int n = rho >> 4, i = rho & 15; return 8 * (i >> 2) + 4 * n + (i & 3); }

struct Unit { int pm, pn; };
struct Gemm { const bf16_t* A; const bf16_t* Bt; int M, N, K; int tpe; size_t bgs; };

struct StaticOrder {
    int nM, nN, nwg, G, c;
    __host__ __device__ void init(int M, int N, int G_, int c_) { nM = M / BM; nN = N / BM; nwg = nM * nN; G = G_; c = c_; }
    __host__ __device__ bool next(int i, Unit& u) const {
        const long L = (long)i * G + c; if (L >= nwg) return false;
        int wgid = (int)L; { const int q = nwg / NXCD, r = nwg % NXCD, xcd = wgid % NXCD, off = wgid / NXCD; wgid = (xcd < r ? xcd * (q + 1) : r * (q + 1) + (xcd - r) * q) + off; }
        const int nig = WGM * nN, gid = wgid / nig, fm = gid * WGM, gsz = (nM - fm) < WGM ? (nM - fm) : WGM;
        u.pm = fm + ((wgid % nig) % gsz); u.pn = (wgid % nig) / gsz; return true;
    }
    __device__ __forceinline__ void a_ready(const Unit&) const {}
    __device__ __forceinline__ void done(const Unit&) const {}
};
__device__ __forceinline__ unsigned cvt_pk_bf16(float lo, float hi) { unsigned r; asm volatile("v_cvt_pk_bf16_f32 %0, %1, %2" : "=v"(r) : "v"(lo), "v"(hi)); return r; }
struct EpiStoreBf16 {
    static constexpr bool PERM = true, AFTER_DRAIN = false;
    bf16_t* O; int ldc;
    __device__ __forceinline__ void operator()(const f32x4 (&acc)[2][2][4][2], const Unit& u, int wr, int wc, int fr, int fq) const {
        const int row0 = u.pm * BM + wr * 64 + fr, col0 = u.pn * BM + wc * 32 + 8 * fq;
#pragma unroll
        for (int ai = 0; ai < 2; ++ai)
#pragma unroll
            for (int m = 0; m < 4; ++m) { bf16_t* rowp = O + (size_t)(row0 + ai * HALF + m * 16) * ldc + col0;
#pragma unroll
                for (int bj = 0; bj < 2; ++bj) { const f32x4 v0 = acc[ai][bj][m][0], v1 = acc[ai][bj][m][1];
                    u32x4 w; w.x = cvt_pk_bf16(v0[0], v0[1]); w.y = cvt_pk_bf16(v0[2], v0[3]); w.z = cvt_pk_bf16(v1[0], v1[1]); w.w = cvt_pk_bf16(v1[2], v1[3]);
                    *(u32x4*)(rowp + bj * HALF) = w; } }
    }
};
struct EpiColGateBf16 {
    static constexpr bool PERM = true, AFTER_DRAIN = false;
    bf16_t* O; int ldc; const float* mod; int lrows;
    __device__ __forceinline__ void operator()(const f32x4 (&acc)[2][2][4][2], const Unit& u, int wr, int wc, int fr, int fq) const {
        const int R0 = u.pm * BM; const int v = (R0 >= lrows) ? 4 : (R0 >> 13);
        const float* ga = mod + v * 6144 + 2 * 1024;
        const int row0 = R0 + wr * 64 + fr, col0 = u.pn * BM + wc * 32 + 8 * fq;
        f32x4 g[2][2];
#pragma unroll
        for (int bj = 0; bj < 2; ++bj)
#pragma unroll
            for (int n = 0; n < 2; ++n) g[bj][n] = *(const f32x4*)(ga + col0 + bj * HALF + 4 * n);
#pragma unroll
        for (int ai = 0; ai < 2; ++ai)
#pragma unroll
            for (int m = 0; m < 4; ++m) { bf16_t* rowp = O + (size_t)(row0 + ai * HALF + m * 16) * ldc + col0;
#pragma unroll
                for (int bj = 0; bj < 2; ++bj) { const f32x4 v0 = acc[ai][bj][m][0] * g[bj][0], v1 = acc[ai][bj][m][1] * g[bj][1];
                    u32x4 w; w.x = cvt_pk_bf16(v0[0], v0[1]); w.y = cvt_pk_bf16(v0[2], v0[3]); w.z = cvt_pk_bf16(v1[0], v1[1]); w.w = cvt_pk_bf16(v1[2], v1[3]);
                    *(u32x4*)(rowp + bj * HALF) = w; } }
    }
};
__device__ __forceinline__ float silu_mul(float g, float u) { return g * __builtin_amdgcn_rcpf(1.0f + __builtin_amdgcn_exp2f(-1.4426950408889634f * g)) * u; }
struct EpiSwiGLU {
    static constexpr bool PERM = true, AFTER_DRAIN = false;
    bf16_t* O; int ldc;
    __device__ __forceinline__ void operator()(const f32x4 (&acc)[2][2][4][2], const Unit& u, int wr, int wc, int fr, int fq) const {
        const int row0 = u.pm * BM + wr * 64 + fr, col0 = u.pn * HALF + wc * 32 + 8 * fq;
#pragma unroll
        for (int ai = 0; ai < 2; ++ai)
#pragma unroll
            for (int m = 0; m < 4; ++m) { const f32x4 g0 = acc[ai][0][m][0], g1 = acc[ai][0][m][1], u0 = acc[ai][1][m][0], u1 = acc[ai][1][m][1];
                u32x4 w; w.x = cvt_pk_bf16(silu_mul(g0[0], u0[0]), silu_mul(g0[1], u0[1])); w.y = cvt_pk_bf16(silu_mul(g0[2], u0[2]), silu_mul(g0[3], u0[3]));
                w.z = cvt_pk_bf16(silu_mul(g1[0], u1[0]), silu_mul(g1[1], u1[1])); w.w = cvt_pk_bf16(silu_mul(g1[2], u1[2]), silu_mul(g1[3], u1[3]));
                *(u32x4*)(O + (size_t)(row0 + ai * HALF + m * 16) * ldc + col0) = w; }
    }
};
struct EpiRowScaleBf16 {
    static constexpr bool PERM = true, AFTER_DRAIN = false;
    bf16_t* O; int ldc; const float* rs;
    __device__ __forceinline__ void operator()(const f32x4 (&acc)[2][2][4][2], const Unit& u, int wr, int wc, int fr, int fq) const {
        const int row0 = u.pm * BM + wr * 64 + fr, col0 = u.pn * BM + wc * 32 + 8 * fq;
#pragma unroll
        for (int ai = 0; ai < 2; ++ai)
#pragma unroll
            for (int m = 0; m < 4; ++m) { const int row = row0 + ai * HALF + m * 16; const float s = rs[row]; bf16_t* rowp = O + (size_t)row * ldc + col0;
#pragma unroll
                for (int bj = 0; bj < 2; ++bj) { const f32x4 v0 = acc[ai][bj][m][0] * s, v1 = acc[ai][bj][m][1] * s;
                    u32x4 w; w.x = cvt_pk_bf16(v0[0], v0[1]); w.y = cvt_pk_bf16(v0[2], v0[3]); w.z = cvt_pk_bf16(v1[0], v1[1]); w.w = cvt_pk_bf16(v1[2], v1[3]);
                    *(u32x4*)(rowp + bj * HALF) = w; } }
    }
};
template <class Epi, class Sched, bool ALIGN_EPI = false, bool SP2 = false>
__device__ __forceinline__ void gemm_phase(PG8_LAS unsigned char* lds, const Gemm g, const Sched& S, const Epi& E) {
    int tid_l = threadIdx.x; asm volatile("" : "+v"(tid_l));
    const int tid = tid_l, wid = __builtin_amdgcn_readfirstlane(tid >> 6), lane = tid & 63, wr = wid >> 2, wc = wid & 3, fr = lane & 15, fq = lane >> 4;
    const int K = g.K, nt = K / BK;
    unsigned voffA[2], voffB[2];
#pragma unroll
    for (int i = 0; i < 2; ++i) { int R, C; stage_rc(tid * 16 + i * 8192, R, C); const int Rb = Epi::PERM ? ((R & ~31) + perm32(R & 31)) : R;
        voffA[i] = (unsigned)(R * K + C) * 2u; voffB[i] = (unsigned)(Rb * K + C) * 2u; }
    const size_t kstep = (size_t)(BK * 2);
    const size_t hstep = (size_t)HALF * K * 2;
    const size_t tstep = 2 * hstep;
    const unsigned ldsw = (unsigned)wid * 1024u;
    const int aoff = lds_byte(wr * 64 + fr, fq * 8), boff = lds_byte(wc * 32 + fr, fq * 8);
#define PG8_SA(b, h) (((b) * 2 + (h)) * HTB)
#define PG8_SB(b, h) ((4 + (b) * 2 + (h)) * HTB)
#define PG8_STAGE(bufoff, gbase, voff) do { _Pragma("unroll") for (int _i = 0; _i < 2; ++_i) \
        __builtin_amdgcn_global_load_lds((const unsigned*)((const char*)(gbase) + (voff)[_i]), (PG8_LAS unsigned*)(lds + (bufoff) + ldsw + _i * 8192), 16, 0, 0); } while (0)
#define PG8_LDA(dst, b, h) do { _Pragma("unroll") for (int m = 0; m < 4; ++m) _Pragma("unroll") for (int k = 0; k < 2; ++k) dst[m][k] = *(const PG8_LAS bf16x8*)(lds + PG8_SA(b, h) + aoff + m * 2048 + k * 1024); } while (0)
#define PG8_LDB(dst, b, h) do { _Pragma("unroll") for (int n = 0; n < 2; ++n) _Pragma("unroll") for (int k = 0; k < 2; ++k) dst[n][k] = *(const PG8_LAS bf16x8*)(lds + PG8_SB(b, h) + boff + n * 2048 + k * 1024); } while (0)
#define PG8_MMA(ai, bj, At, Bt) do { __builtin_amdgcn_s_setprio(1); _Pragma("unroll") for (int m = 0; m < 4; ++m) _Pragma("unroll") for (int n = 0; n < 2; ++n) _Pragma("unroll") for (int k = 0; k < 2; ++k) \
        acc[ai][bj][m][n] = __builtin_amdgcn_mfma_f32_16x16x32_bf16(Bt[n][k], At[m][k], acc[ai][bj][m][n], 0, 0, 0); __builtin_amdgcn_s_setprio(0); } while (0)
#define PG8_WAIT_V(n) asm volatile("s_waitcnt vmcnt(" #n ")" ::: "memory")
#define PG8_WAIT_L(n) asm volatile("s_waitcnt lgkmcnt(" #n ")" ::: "memory")
#define PG8_BAR __builtin_amdgcn_s_barrier()
#define PG8_SCHED __builtin_amdgcn_sched_barrier(0)
    Unit cur, nxt; int ui = 0;
    if (!S.next(0, cur)) return;
    f32x4 acc[2][2][4][2];
#pragma unroll
    for (int a = 0; a < 2; ++a)
#pragma unroll
        for (int b = 0; b < 2; ++b)
#pragma unroll
            for (int m = 0; m < 4; ++m)
#pragma unroll
                for (int n = 0; n < 2; ++n) acc[a][b][m][n] = (f32x4){0.f, 0.f, 0.f, 0.f};
    bf16x8 At[4][2], B0[2][2], B1[2][2];
    const char* cA = (const char*)g.A + (size_t)cur.pm * tstep; const char* cB = (const char*)g.Bt + (size_t)(cur.pm / g.tpe) * g.bgs + (size_t)cur.pn * tstep;
    S.a_ready(cur);
    if constexpr (SP2) {
        PG8_STAGE(PG8_SB(0, 0), cB, voffB); PG8_STAGE(PG8_SB(0, 1), cB + hstep, voffB); PG8_STAGE(PG8_SA(0, 0), cA, voffA); PG8_STAGE(PG8_SA(0, 1), cA + hstep, voffA);
        if (wr == 1) PG8_BAR;
        PG8_WAIT_V(2); PG8_BAR;
        PG8_STAGE(PG8_SB(1, 0), cB + kstep, voffB); PG8_STAGE(PG8_SA(1, 0), cA + kstep, voffA); PG8_STAGE(PG8_SB(1, 1), cB + hstep + kstep, voffB);
        PG8_WAIT_V(6); PG8_BAR;
    } else {
        PG8_STAGE(PG8_SB(0, 0), cB, voffB); PG8_STAGE(PG8_SA(0, 0), cA, voffA); PG8_STAGE(PG8_SB(0, 1), cB + hstep, voffB); PG8_STAGE(PG8_SA(0, 1), cA + hstep, voffA);
        if (wr == 1) PG8_BAR;
        PG8_WAIT_V(4); PG8_BAR;
        PG8_STAGE(PG8_SB(1, 0), cB + kstep, voffB); PG8_STAGE(PG8_SA(1, 0), cA + kstep, voffA); PG8_STAGE(PG8_SB(1, 1), cB + hstep + kstep, voffB);
        PG8_WAIT_V(6); PG8_BAR;
    }
    for (;;) {
        const bool has_next = S.next(ui + 1, nxt);
        const char* nA = has_next ? (const char*)g.A + (size_t)nxt.pm * tstep : cA; const char* nB = has_next ? (const char*)g.Bt + (size_t)(nxt.pm / g.tpe) * g.bgs + (size_t)nxt.pn * tstep : cB;
        for (int t = 0; t < nt; t += 2) {
            const bool last = (t == nt - 2);
            const char* a1 = cA + (size_t)(t + 1) * kstep;
            const char* a2 = last ? nA : cA + (size_t)(t + 2) * kstep; const char* b2 = last ? nB : cB + (size_t)(t + 2) * kstep;
            const char* a3 = a2 + kstep; const char* b3 = b2 + kstep;
            if (last && has_next) S.a_ready(nxt);
            if constexpr (SP2) {
            PG8_LDB(B0, 0, 0); PG8_LDB(B1, 0, 1); PG8_SCHED; PG8_LDA(At, 0, 0); PG8_STAGE(PG8_SA(1, 1), a1 + hstep, voffA);
            PG8_WAIT_V(8); PG8_WAIT_L(0); PG8_BAR; PG8_MMA(0, 0, At, B0); PG8_MMA(0, 1, At, B1); PG8_BAR; PG8_SCHED;
            PG8_LDA(At, 0, 1); PG8_STAGE(PG8_SB(0, 0), b2, voffB); PG8_STAGE(PG8_SB(0, 1), b2 + hstep, voffB); PG8_STAGE(PG8_SA(0, 0), a2, voffA);
            PG8_WAIT_V(8); PG8_WAIT_L(0); PG8_BAR; PG8_MMA(1, 0, At, B0); PG8_MMA(1, 1, At, B1); PG8_BAR; PG8_SCHED;
            PG8_LDB(B0, 1, 0); PG8_LDB(B1, 1, 1); PG8_SCHED; PG8_LDA(At, 1, 0); PG8_STAGE(PG8_SA(0, 1), a2 + hstep, voffA);
            PG8_WAIT_V(8); PG8_WAIT_L(0); PG8_BAR; PG8_MMA(0, 0, At, B0); PG8_MMA(0, 1, At, B1); PG8_BAR; PG8_SCHED;
            PG8_LDA(At, 1, 1); PG8_STAGE(PG8_SB(1, 0), b3, voffB); PG8_STAGE(PG8_SB(1, 1), b3 + hstep, voffB); PG8_STAGE(PG8_SA(1, 0), a3, voffA);
            PG8_WAIT_V(8); PG8_WAIT_L(0); PG8_BAR; PG8_MMA(1, 0, At, B0); PG8_MMA(1, 1, At, B1); PG8_BAR; PG8_SCHED;
            } else {
            PG8_LDB(B0, 0, 0); PG8_SCHED; PG8_LDA(At, 0, 0); PG8_STAGE(PG8_SA(1, 1), a1 + hstep, voffA);
            PG8_WAIT_L(8); PG8_BAR; PG8_WAIT_L(0); PG8_MMA(0, 0, At, B0); PG8_BAR; PG8_SCHED;
            PG8_LDB(B1, 0, 1); PG8_STAGE(PG8_SB(0, 0), b2, voffB);
            PG8_BAR; PG8_WAIT_L(0); PG8_MMA(0, 1, At, B1); PG8_BAR;
            PG8_LDA(At, 0, 1); PG8_STAGE(PG8_SA(0, 0), a2, voffA);
            PG8_BAR; PG8_WAIT_L(0); PG8_MMA(1, 0, At, B0); PG8_BAR; PG8_SCHED;
            PG8_STAGE(PG8_SB(0, 1), b2 + hstep, voffB);
            PG8_WAIT_V(6); PG8_BAR; PG8_MMA(1, 1, At, B1); PG8_BAR;
            PG8_LDB(B0, 1, 0); PG8_SCHED; PG8_LDA(At, 1, 0); PG8_STAGE(PG8_SA(0, 1), a2 + hstep, voffA);
            PG8_WAIT_L(8); PG8_BAR; PG8_WAIT_L(0); PG8_MMA(0, 0, At, B0); PG8_BAR; PG8_SCHED;
            PG8_LDB(B1, 1, 1); PG8_STAGE(PG8_SB(1, 0), b3, voffB);
            PG8_BAR; PG8_WAIT_L(0); PG8_MMA(0, 1, At, B1); PG8_BAR;
            PG8_LDA(At, 1, 1); PG8_STAGE(PG8_SA(1, 0), a3, voffA);
            PG8_BAR; PG8_WAIT_L(0); PG8_MMA(1, 0, At, B0); PG8_BAR; PG8_SCHED;
            PG8_STAGE(PG8_SB(1, 1), b3 + hstep, voffB);
            PG8_WAIT_V(6); PG8_BAR; PG8_MMA(1, 1, At, B1); PG8_BAR;
            }
        }
        if constexpr (ALIGN_EPI) { if (wr == 0) PG8_BAR; }
        if constexpr (!Epi::AFTER_DRAIN) { E(acc, cur, wr, wc, fr, fq); S.done(cur); }
        if (!has_next) break;
#pragma unroll
        for (int a = 0; a < 2; ++a)
#pragma unroll
            for (int b = 0; b < 2; ++b)
#pragma unroll
                for (int m = 0; m < 4; ++m)
#pragma unroll
                    for (int n = 0; n < 2; ++n) acc[a][b][m][n] = (f32x4){0.f, 0.f, 0.f, 0.f};
        cur = nxt; cA = nA; cB = nB; ++ui;
        if constexpr (ALIGN_EPI) { if (wr == 1) PG8_BAR; }
    }
    PG8_WAIT_V(0);
    if constexpr (!ALIGN_EPI) { if (wr == 0) PG8_BAR; }
    PG8_BAR;
    if constexpr (Epi::AFTER_DRAIN) { E.fused(acc, cur, wr, wc, fr, fq, lds, wid, lane); S.done(cur); }
#undef PG8_SA
#undef PG8_SB
#undef PG8_STAGE
#undef PG8_LDA
#undef PG8_LDB
#undef PG8_MMA
#undef PG8_WAIT_V
#undef PG8_WAIT_L
#undef PG8_BAR
#undef PG8_SCHED
}
}
namespace att {
typedef unsigned short bf16_t;
typedef short bf16x8 __attribute__((ext_vector_type(8)));
typedef short s16x4 __attribute__((ext_vector_type(4)));
typedef float f32x16 __attribute__((ext_vector_type(16)));
typedef float f32x4 __attribute__((ext_vector_type(4)));
typedef unsigned u32x4 __attribute__((ext_vector_type(4)));
typedef unsigned u32x2 __attribute__((ext_vector_type(2)));
#define ALDS __attribute__((address_space(3)))
typedef float f32x2_t __attribute__((ext_vector_type(2))); typedef __bf16 bf16x2_t __attribute__((ext_vector_type(2)));
__device__ __forceinline__ unsigned cvtpk(float lo, float hi) { f32x2_t v = {lo, hi}; bf16x2_t b = __builtin_convertvector(v, bf16x2_t); return __builtin_bit_cast(unsigned, b); }
__device__ __forceinline__ float bf2f(unsigned short u) { return __uint_as_float((unsigned)u << 16); }
template <int S> __device__ __forceinline__ bf16x8 pack8(const f32x16& x) {
    u32x4 p; p.x = cvtpk(x[8 * S + 0], x[8 * S + 1]); p.y = cvtpk(x[8 * S + 2], x[8 * S + 3]); p.z = cvtpk(x[8 * S + 4], x[8 * S + 5]); p.w = cvtpk(x[8 * S + 6], x[8 * S + 7]);
    return __builtin_bit_cast(bf16x8, p);
}
typedef short v4i16_t __attribute__((ext_vector_type(4)));
__device__ __forceinline__ s16x4 vtr(const ALDS char* p) { return __builtin_bit_cast(s16x4, __builtin_amdgcn_ds_read_tr16_b64_v4i16((ALDS v4i16_t*)p)); }
__device__ __forceinline__ int crow(int r, int hi) { return (r & 3) + 8 * (r >> 2) + 4 * hi; }
constexpr int ATT_LDS_BYTES = 2 * 12288 + 2 * 8192;

template <int KD, int NMAP>
__device__ __forceinline__ void attn_unit(const bf16_t* __restrict__ Qb, const char* __restrict__ Kt, const char* __restrict__ Vt, int t0, int t1,
                                          bf16_t* __restrict__ Ob, ALDS char* lds, float lam, const float* __restrict__ gout, float oml) {
    constexpr int KTB = KD * 128;
    constexpr int KS = KD / 16 / NMAP;
    int tid_l = threadIdx.x; asm volatile("" : "+v"(tid_l));
    const int tid = tid_l, lane = tid & 63, r32 = lane & 31, hi = lane >> 5, wid = tid >> 6;
    bf16x8 qf[NMAP * KS];
    { const bf16_t* qrow = Qb + (size_t)(wid * 32 + r32) * KD + hi * 8;
#pragma unroll
      for (int ks = 0; ks < NMAP * KS; ++ks) qf[ks] = *(const bf16x8*)(qrow + ks * 16); }
    f32x16 o[NMAP][2]; float l[NMAP];
#pragma unroll
    for (int m = 0; m < NMAP; ++m) { l[m] = 0.f;
#pragma unroll
        for (int d = 0; d < 2; ++d)
#pragma unroll
            for (int r = 0; r < 16; ++r) o[m][d][r] = 0.f; }
    u32x4 kst0, kst1, vst; kst1 = (u32x4){0u, 0u, 0u, 0u};
#define ATT_GLOAD(t) do { const char* kp_ = Kt + (size_t)(t) * KTB; kst0 = *(const u32x4*)(kp_ + tid * 16); if (KD == 96 && tid < 256) kst1 = *(const u32x4*)(kp_ + 8192 + tid * 16); \
        vst = *(const u32x4*)(Vt + (size_t)(t) * 8192 + tid * 16); } while (0)
#define ATT_LSTORE(buf) do { *(ALDS u32x4*)(lds + (buf) * KTB + tid * 16) = kst0; if (KD == 96 && tid < 256) *(ALDS u32x4*)(lds + (buf) * KTB + 8192 + tid * 16) = kst1; \
        *(ALDS u32x4*)(lds + 2 * KTB + (buf) * 8192 + tid * 16) = vst; } while (0)
    ATT_GLOAD(t0); ATT_LSTORE(0); __syncthreads();
    const int voff = (4 * hi + ((lane & 15) >> 2)) * 64 + ((lane >> 4) & 1) * 32 + (lane & 3) * 8;
    for (int t = t0; t < t1; ++t) {
        const int cur = (t - t0) & 1;
        if (t + 1 < t1) ATT_GLOAD(t + 1);
        const ALDS char* kb = lds + cur * KTB + hi * 1024 + r32 * 16;
        const ALDS char* vb = lds + 2 * KTB + cur * 8192 + voff;
        bf16x8 p[NMAP][4];
#pragma unroll
        for (int m = 0; m < NMAP; ++m) {
            f32x16 s0, s1;
#pragma unroll
            for (int r = 0; r < 16; ++r) { s0[r] = 0.f; s1[r] = 0.f; }
#pragma unroll
            for (int s = 0; s < KS; ++s) { const int ks = m * KS + s;
                const bf16x8 a0 = *(const ALDS bf16x8*)(kb + ks * 2048), a1 = *(const ALDS bf16x8*)(kb + ks * 2048 + 512);
                s0 = __builtin_amdgcn_mfma_f32_32x32x16_bf16(a0, qf[ks], s0, 0, 0, 0);
                s1 = __builtin_amdgcn_mfma_f32_32x32x16_bf16(a1, qf[ks], s1, 0, 0, 0); }
            float rs = 0.f;
#pragma unroll
            for (int r = 0; r < 16; ++r) { s0[r] = __builtin_amdgcn_exp2f(s0[r]); s1[r] = __builtin_amdgcn_exp2f(s1[r]); rs += s0[r] + s1[r]; }
            l[m] += rs;
            p[m][0] = pack8<0>(s0); p[m][1] = pack8<1>(s0); p[m][2] = pack8<0>(s1); p[m][3] = pack8<1>(s1);
        }
#pragma unroll
        for (int d = 0; d < 2; ++d)
#pragma unroll
            for (int kk = 0; kk < 4; ++kk) {
                const s16x4 lo = vtr(vb + d * 4096 + kk * 1024), h4 = vtr(vb + d * 4096 + kk * 1024 + 512);
                const bf16x8 vf = (bf16x8){lo[0], lo[1], lo[2], lo[3], h4[0], h4[1], h4[2], h4[3]};
#pragma unroll
                for (int m = 0; m < NMAP; ++m) o[m][d] = __builtin_amdgcn_mfma_f32_32x32x16_bf16(vf, p[m][kk], o[m][d], 0, 0, 0);
            }
        if (t + 1 < t1) ATT_LSTORE(cur ^ 1);
        __syncthreads();
    }
#undef ATT_GLOAD
#undef ATT_LSTORE
    float li[NMAP];
#pragma unroll
    for (int m = 0; m < NMAP; ++m) { const float lt = l[m] + __shfl_xor(l[m], 32); li[m] = 1.0f / lt; }
    float val[2][16];
    if (NMAP == 1) {
#pragma unroll
        for (int d = 0; d < 2; ++d)
#pragma unroll
            for (int r = 0; r < 16; ++r) val[d][r] = o[0][d][r] * li[0];
    } else {
        float ss = 0.f; const float l2 = lam * li[NMAP - 1];
#pragma unroll
        for (int d = 0; d < 2; ++d)
#pragma unroll
            for (int r = 0; r < 16; ++r) { const float v = o[0][d][r] * li[0] - o[NMAP - 1][d][r] * l2; val[d][r] = v; ss += v * v; }
        ss += __shfl_xor(ss, 32);
        const float rstd = rsqrtf(ss * (1.0f / 64.0f) + 1e-6f) * oml;
#pragma unroll
        for (int d = 0; d < 2; ++d)
#pragma unroll
            for (int g = 0; g < 4; ++g) { const f32x4 gv = *(const f32x4*)(gout + 32 * d + 8 * g + 4 * hi);
#pragma unroll
                for (int i = 0; i < 4; ++i) val[d][4 * g + i] *= rstd * gv[i]; }
    }
    bf16_t* orow = Ob + (size_t)(wid * 32 + r32) * 1024 + 4 * hi;
#pragma unroll
    for (int d = 0; d < 2; ++d)
#pragma unroll
        for (int g = 0; g < 4; ++g) { u32x2 w; w.x = cvtpk(val[d][4 * g], val[d][4 * g + 1]); w.y = cvtpk(val[d][4 * g + 2], val[d][4 * g + 3]);
            *(u32x2*)(orow + 32 * d + 8 * g) = w; }
}

#define ATT_SBAR() __builtin_amdgcn_sched_barrier(0)
#define ATT_PIN(x) asm volatile("" : "+v"(x))
#define ATT_MFMA(a, b, c) __builtin_amdgcn_mfma_f32_32x32x16_bf16((a), (b), (c), 0, 0, 0)
template <int KS, int ABL = 0>
__device__ __forceinline__ void att_step(f32x16& C0, f32x16& C1, const f32x16& P0, const f32x16& P1, bf16x8 (&kf)[2 * KS], const bf16x8* qf,
                                         f32x16 (&o)[2], float& l, const ALDS char* vprev, const ALDS char* knext) {
    constexpr int NQ = 2 * KS;
    s16x4 vlo[8], vhi[8]; u32x4 pw[4]; float sacc = 0.f;
    f32x16 z;
#pragma unroll
    for (int r = 0; r < 16; ++r) z[r] = 0.f;
    ATT_SBAR();
#pragma unroll
    for (int i = 0; i < NQ; ++i) {
#pragma unroll
        for (int v = 16 * i / NQ; v < 16 * (i + 1) / NQ; ++v) { const int f = v >> 1; const ALDS char* p = vprev + (f & 1) * 4096 + (f >> 1) * 1024 + (v & 1) * 512;
            if (v & 1) vhi[f] = vtr(p); else vlo[f] = vtr(p); }
        ATT_SBAR();
        if (i == 0) C0 = ATT_MFMA(kf[0], qf[0], z); else if (i == 1) C1 = ATT_MFMA(kf[1], qf[0], z);
        else if (i & 1) C1 = ATT_MFMA(kf[i], qf[i >> 1], C1); else C0 = ATT_MFMA(kf[i], qf[i >> 1], C0);
#pragma unroll
        for (int a = 32 * i / NQ; a < 32 * (i + 1) / NQ; ++a) { if (!(ABL & 4)) sacc += (a < 16) ? P0[a & 15] : P1[a & 15]; }
        ATT_PIN(sacc);
#pragma unroll
        for (int c = 16 * i / NQ; c < 16 * (i + 1) / NQ; ++c) { const int e = 2 * c; unsigned w = (ABL & 4) ? __float_as_uint((e < 16) ? P0[e & 15] : P1[e & 15]) : (e < 16) ? cvtpk(P0[e & 15], P0[(e + 1) & 15]) : cvtpk(P1[e & 15], P1[(e + 1) & 15]);
            ATT_PIN(w); pw[c >> 2][c & 3] = w; }
        ATT_SBAR();
    }
    l += sacc;
#pragma unroll
    for (int j = 0; j < 8; ++j) {
#pragma unroll
        for (int k = NQ * j / 8; k < NQ * (j + 1) / 8; ++k) kf[k] = *(const ALDS bf16x8*)(knext + (k >> 1) * 2048 + (k & 1) * 512);
        ATT_SBAR();
        const bf16x8 vf = (bf16x8){vlo[j][0], vlo[j][1], vlo[j][2], vlo[j][3], vhi[j][0], vhi[j][1], vhi[j][2], vhi[j][3]};
        o[j & 1] = ATT_MFMA(vf, __builtin_bit_cast(bf16x8, pw[j >> 1]), o[j & 1]);
        if (j < 4) {
#pragma unroll
            for (int e = 4 * j; e < 4 * j + 4; ++e) { if (!(ABL & 5)) C0[e] = __builtin_amdgcn_exp2f(C0[e]); }
            ATT_PIN(C0);
        } else {
#pragma unroll
            for (int e = 4 * j - 16; e < 4 * j - 12; ++e) { if (!(ABL & 5)) C1[e] = __builtin_amdgcn_exp2f(C1[e]); }
            ATT_PIN(C1);
        }
        ATT_SBAR();
    }
}
template <int DK, int NMAP, int ABL = 0>
__device__ __forceinline__ void attn_unit_p(const bf16_t* __restrict__ Qb, const char* __restrict__ Kt, const char* __restrict__ Vt, int t0, int t1,
                                            bf16_t* __restrict__ Ob, ALDS char* lds, float lam, const float* __restrict__ gout, float oml) {
    constexpr int KD = DK * NMAP, KTB = KD * 128, KS = DK / 16, NQ = 2 * KS, LV = 3 * KTB;
    int tid_l = threadIdx.x; asm volatile("" : "+v"(tid_l));
    const int tid = tid_l, lane = tid & 63, r32 = lane & 31, hi = lane >> 5, wid = tid >> 6;
    bf16x8 qf[NMAP * KS];
    { const bf16_t* qrow = Qb + (size_t)(wid * 32 + r32) * KD + hi * 8;
#pragma unroll
      for (int ks = 0; ks < NMAP * KS; ++ks) qf[ks] = *(const bf16x8*)(qrow + ks * 16); }
    f32x16 o[NMAP][2]; float l[NMAP];
#pragma unroll
    for (int m = 0; m < NMAP; ++m) { l[m] = 0.f;
#pragma unroll
        for (int d = 0; d < 2; ++d)
#pragma unroll
            for (int r = 0; r < 16; ++r) o[m][d][r] = 0.f; }
    u32x4 ka0, ka1, va, kb0, kb1, vb_; ka1 = (u32x4){0u, 0u, 0u, 0u}; kb1 = ka1;
#define ATP_GLOAD(S, tk, tv) do { if (ABL & 2) break; const char* kp_ = Kt + (size_t)(tk) * KTB; k##S##0 = *(const u32x4*)(kp_ + tid * 16); if (KD == 96 && tid < 256) k##S##1 = *(const u32x4*)(kp_ + 8192 + tid * 16); \
        ATP_V##S = *(const u32x4*)(Vt + (size_t)(tv) * 8192 + tid * 16); } while (0)
#define ATP_Va va
#define ATP_Vb vb_
#define ATP_LSTORE(S, tk, tv) do { if (ABL & 2) break; ALDS char* d_ = lds + ((tk) % 3) * KTB; *(ALDS u32x4*)(d_ + tid * 16) = k##S##0; if (KD == 96 && tid < 256) *(ALDS u32x4*)(d_ + 8192 + tid * 16) = k##S##1; \
        *(ALDS u32x4*)(lds + LV + ((tv) % 3) * 8192 + tid * 16) = ATP_V##S; } while (0)
#define ATP_SYNC() do { if (!(ABL & 2)) __syncthreads(); } while (0)
#define ATP_KB(t, m) (lds + ((t) % 3) * KTB + (m) * (DK * 128) + klane)
#define ATP_VB(t) (lds + LV + ((t) % 3) * 8192 + voff)
#define ATP_KLOAD(base) do { const ALDS char* b_ = (base); _Pragma("unroll") for (int k = 0; k < NQ; ++k) kf[k] = *(const ALDS bf16x8*)(b_ + (k >> 1) * 2048 + (k & 1) * 512); } while (0)
    const int klane = hi * 1024 + r32 * 16;
    const int voff = (4 * hi + ((lane & 15) >> 2)) * 64 + ((lane >> 4) & 1) * 32 + (lane & 3) * 8;
    ATP_GLOAD(a, t0, t0); ATP_GLOAD(b, t0 + 1, t0 + 1); ATP_LSTORE(a, t0, t0);
    { ALDS char* d_ = lds + ((t0 + 1) % 3) * KTB; *(ALDS u32x4*)(d_ + tid * 16) = kb0; if (KD == 96 && tid < 256) *(ALDS u32x4*)(d_ + 8192 + tid * 16) = kb1; }
    __syncthreads();
    ATP_GLOAD(b, t0 + 2, t0 + 1); ATP_GLOAD(a, t0 + 3, t0 + 2);
    bf16x8 kf[NQ];
    f32x16 sA0, sA1, sB0, sB1;
    ATP_KLOAD(ATP_KB(t0, 0));
#pragma unroll
    for (int r = 0; r < 16; ++r) { sA0[r] = 0.f; sA1[r] = 0.f; }
#pragma unroll
    for (int i = 0; i < NQ; ++i) { if (i & 1) sA1 = ATT_MFMA(kf[i], qf[i >> 1], sA1); else sA0 = ATT_MFMA(kf[i], qf[i >> 1], sA0); }
    if (NMAP == 1) ATP_KLOAD(ATP_KB(t0 + 1, 0)); else ATP_KLOAD(ATP_KB(t0, 1));
#pragma unroll
    for (int r = 0; r < 16; ++r) { sA0[r] = __builtin_amdgcn_exp2f(sA0[r]); sA1[r] = __builtin_amdgcn_exp2f(sA1[r]); }
    if (NMAP == 1) {
        ATP_LSTORE(b, t0 + 2, t0 + 1); ATP_SYNC();
        ATP_GLOAD(b, t0 + 4, t0 + 3);
        att_step<KS, ABL>(sB0, sB1, sA0, sA1, kf, qf, o[0], l[0], ATP_VB(t0), ATP_KB(t0 + 2, 0));
        ATP_LSTORE(a, t0 + 3, t0 + 2); ATP_SYNC();
        for (int t = t0 + 2; t < t1; t += 2) {
            ATP_GLOAD(a, t + 3, t + 2);
            att_step<KS, ABL>(sA0, sA1, sB0, sB1, kf, qf, o[0], l[0], ATP_VB(t - 1), ATP_KB(t + 1, 0));
            ATP_LSTORE(b, t + 2, t + 1); ATP_SYNC();
            ATP_GLOAD(b, t + 4, t + 3);
            att_step<KS, ABL>(sB0, sB1, sA0, sA1, kf, qf, o[0], l[0], ATP_VB(t), ATP_KB(t + 2, 0));
            ATP_LSTORE(a, t + 3, t + 2); ATP_SYNC();
        }
    } else {
        att_step<KS, ABL>(sB0, sB1, sA0, sA1, kf, qf + KS, o[0], l[0], ATP_VB(t0), ATP_KB(t0 + 1, 0));
        ATP_LSTORE(b, t0 + 2, t0 + 1); ATP_SYNC();
#define ATP_TILE(t, SL, SS) do { ATP_GLOAD(SL, (t) + 3, (t) + 2); \
            att_step<KS, ABL>(sA0, sA1, sB0, sB1, kf, qf, o[NMAP - 1], l[NMAP - 1], ATP_VB((t) - 1), ATP_KB((t), 1)); \
            att_step<KS, ABL>(sB0, sB1, sA0, sA1, kf, qf + KS, o[0], l[0], ATP_VB((t)), ATP_KB((t) + 1, 0)); \
            ATP_LSTORE(SS, (t) + 2, (t) + 1); ATP_SYNC(); } while (0)
        int t = t0 + 1;
        for (; t + 1 < t1; t += 2) { ATP_TILE(t, b, a); ATP_TILE(t + 1, a, b); }
        ATP_TILE(t, b, a);
#undef ATP_TILE
    }
    {
        float sacc = 0.f;
#pragma unroll
        for (int r = 0; r < 16; ++r) sacc += sB0[r] + sB1[r];
        l[NMAP - 1] += sacc;
        const bf16x8 p0 = pack8<0>(sB0), p1 = pack8<1>(sB0), p2 = pack8<0>(sB1), p3 = pack8<1>(sB1);
        const ALDS char* vb = ATP_VB(t1 - 1);
#pragma unroll
        for (int j = 0; j < 8; ++j) { const s16x4 lo = vtr(vb + (j & 1) * 4096 + (j >> 1) * 1024), h4 = vtr(vb + (j & 1) * 4096 + (j >> 1) * 1024 + 512);
            const bf16x8 vf = (bf16x8){lo[0], lo[1], lo[2], lo[3], h4[0], h4[1], h4[2], h4[3]};
            const bf16x8 pp = (j >> 1) == 0 ? p0 : (j >> 1) == 1 ? p1 : (j >> 1) == 2 ? p2 : p3;
            o[NMAP - 1][j & 1] = ATT_MFMA(vf, pp, o[NMAP - 1][j & 1]); }
    }
    __syncthreads();
#undef ATP_GLOAD
#undef ATP_SYNC
#undef ATP_LSTORE
#undef ATP_Va
#undef ATP_Vb
#undef ATP_KB
#undef ATP_VB
#undef ATP_KLOAD
    float li[NMAP];
#pragma unroll
    for (int m = 0; m < NMAP; ++m) { const float lt = l[m] + __shfl_xor(l[m], 32); li[m] = 1.0f / lt; }
    float val[2][16];
    if (NMAP == 1) {
#pragma unroll
        for (int d = 0; d < 2; ++d)
#pragma unroll
            for (int r = 0; r < 16; ++r) val[d][r] = o[0][d][r] * li[0];
    } else {
        float ss = 0.f; const float l2 = lam * li[NMAP - 1];
#pragma unroll
        for (int d = 0; d < 2; ++d)
#pragma unroll
            for (int r = 0; r < 16; ++r) { const float v = o[0][d][r] * li[0] - o[NMAP - 1][d][r] * l2; val[d][r] = v; ss += v * v; }
        ss += __shfl_xor(ss, 32);
        const float rstd = rsqrtf(ss * (1.0f / 64.0f) + 1e-6f) * oml;
#pragma unroll
        for (int d = 0; d < 2; ++d)
#pragma unroll
            for (int g = 0; g < 4; ++g) { const f32x4 gv = *(const f32x4*)(gout + 32 * d + 8 * g + 4 * hi);
#pragma unroll
                for (int i = 0; i < 4; ++i) val[d][4 * g + i] *= rstd * gv[i]; }
    }
    bf16_t* orow = Ob + (size_t)(wid * 32 + r32) * 1024 + 4 * hi;
#pragma unroll
    for (int d = 0; d < 2; ++d)
#pragma unroll
        for (int g = 0; g < 4; ++g) { u32x2 w; w.x = cvtpk(val[d][4 * g], val[d][4 * g + 1]); w.y = cvtpk(val[d][4 * g + 2], val[d][4 * g + 3]);
            *(u32x2*)(orow + 32 * d + 8 * g) = w; }
}

template <int KD, int NMAP>
__device__ __forceinline__ void attn_unit_naive(const bf16_t* __restrict__ Qb, const char* __restrict__ Kt, const char* __restrict__ Vt, int t0, int t1,
                                                bf16_t* __restrict__ Ob, ALDS char* lds, float lam, const float* __restrict__ gout, float oml) {
    constexpr int KTB = KD * 128, DMAP = KD / NMAP;
    int tid_l = threadIdx.x; asm volatile("" : "+v"(tid_l));
    const int tid = tid_l, q = tid & 255, dh = tid >> 8;
    float qv[KD];
#pragma unroll
    for (int c = 0; c < KD / 8; ++c) { const u32x4 w = *(const u32x4*)(Qb + (size_t)q * KD + c * 8);
#pragma unroll
        for (int i = 0; i < 4; ++i) { qv[c * 8 + 2 * i] = __uint_as_float(w[i] << 16); qv[c * 8 + 2 * i + 1] = __uint_as_float(w[i] & 0xffff0000u); } }
    float o[NMAP][32], l[NMAP];
#pragma unroll
    for (int m = 0; m < NMAP; ++m) { l[m] = 0.f;
#pragma unroll
        for (int i = 0; i < 32; ++i) o[m][i] = 0.f; }
    for (int t = t0; t < t1; ++t) {
        const char* kt = Kt + (size_t)t * KTB; const char* vt = Vt + (size_t)t * 8192 + dh * 4096;
        for (int key = 0; key < 64; ++key) {
            float pm[NMAP];
#pragma unroll
            for (int m = 0; m < NMAP; ++m) { float s = 0.f;
#pragma unroll
                for (int c = 0; c < DMAP / 8; ++c) { const u32x4 w = *(const u32x4*)(kt + (m * (DMAP / 8) + c) * 1024 + key * 16);
#pragma unroll
                    for (int i = 0; i < 4; ++i) { s += qv[m * DMAP + c * 8 + 2 * i] * __uint_as_float(w[i] << 16); s += qv[m * DMAP + c * 8 + 2 * i + 1] * __uint_as_float(w[i] & 0xffff0000u); } }
                pm[m] = __builtin_amdgcn_exp2f(s); l[m] += pm[m]; }
            const char* vr = vt + (key >> 4) * 1024 + ((key >> 3) & 1) * 512 + (key & 7) * 64;
#pragma unroll
            for (int c = 0; c < 4; ++c) { const u32x4 w = *(const u32x4*)(vr + c * 16);
#pragma unroll
                for (int i = 0; i < 4; ++i) { const float v0 = __uint_as_float(w[i] << 16), v1 = __uint_as_float(w[i] & 0xffff0000u);
#pragma unroll
                    for (int m = 0; m < NMAP; ++m) { o[m][c * 8 + 2 * i] += pm[m] * v0; o[m][c * 8 + 2 * i + 1] += pm[m] * v1; } } }
        }
    }
    float val[32];
    if (NMAP == 1) {
        const float li = 1.0f / l[0];
#pragma unroll
        for (int i = 0; i < 32; ++i) val[i] = o[0][i] * li;
    } else {
        const float l1 = 1.0f / l[0], l2 = lam / l[NMAP - 1]; float ss = 0.f;
#pragma unroll
        for (int i = 0; i < 32; ++i) { val[i] = o[0][i] * l1 - o[NMAP - 1][i] * l2; ss += val[i] * val[i]; }
        ALDS float* ex = (ALDS float*)lds;
        __syncthreads(); ex[tid] = ss; __syncthreads();
        ss += ex[tid ^ 256];
        __syncthreads();
        const float rstd = rsqrtf(ss * (1.0f / 64.0f) + 1e-6f) * oml;
#pragma unroll
        for (int i = 0; i < 32; ++i) val[i] *= rstd * gout[dh * 32 + i];
    }
    bf16_t* orow = Ob + (size_t)q * 1024 + dh * 32;
#pragma unroll
    for (int c = 0; c < 4; ++c) { u32x4 w;
#pragma unroll
        for (int i = 0; i < 4; ++i) w[i] = cvtpk(val[c * 8 + 2 * i], val[c * 8 + 2 * i + 1]);
        *(u32x4*)(orow + c * 8) = w; }
}
}
constexpr int NWAVES = 8;
constexpr int DM = 1024, NB = 4, SEQ = 8192, CL = 256, NTOKB = SEQ + CL, LROWS = NB * SEQ, MROWS = LROWS + NB * CL;
constexpr int NLAYER = 2, INC = 1952, ZP = 3072, NE = 16, FFD = 2048, CAPL = 1024, CAPC = 32, NKT = NTOKB / 64;
constexpr int ZQ = 1952, ZKV = 2336, ZEND = 2848;
constexpr float EPSF = 1e-6f, LOG2E = 1.4426950408889634f;
constexpr int N_PHASES = 22;
enum { I_X = 0, I_C, I_CTX, I_CCTX, I_WADA, I_BADA, I_GN1, I_WIN, I_GCQ, I_GCKV, I_WUQ, I_WUKV, I_GMQ, I_GMK, I_GDQ, I_GDK, I_LQ1, I_LK1, I_LQ2, I_LK2, I_GDO, I_GGQ, I_GGK, I_WO, I_GN2, I_WR, I_WG, I_WU, I_WD, N_IN };
constexpr size_t MiB = 1u << 20;
constexpr size_t WS_CTL = 0, CTL_ZERO_BYTES = 1 * MiB;
constexpr size_t WS_MOD = 1 * MiB;
constexpr size_t WS_LAM = WS_MOD + 256 * 1024;
constexpr size_t WS_TAB = WS_MOD + 320 * 1024;
constexpr size_t TAB_AROW = 0, TAB_ACOL = 128 * 8 * 8, TAB_GROW = TAB_ACOL + 64 * 8 * 8, TAB_GCOL = TAB_GROW + 128 * 16 * 8;
constexpr size_t WS_AFF = 2 * MiB, WS_AFFC = 4 * MiB;
constexpr size_t WS_IDX = 5 * MiB, WS_GATE = 6 * MiB;
constexpr size_t WS_INV = 7 * MiB;
constexpr size_t WS_WCAT = 16 * MiB;
constexpr size_t WS_WO = 28 * MiB;
constexpr size_t WS_CTXW = 32 * MiB;
constexpr size_t WS_H = 36 * MiB;
constexpr size_t WS_WGU = 102 * MiB;
constexpr size_t WS_WD = 230 * MiB;
constexpr size_t WS_YE = 294 * MiB;
constexpr size_t WS_Z = 430 * MiB;
constexpr size_t WS_QKV = 628 * MiB;
constexpr size_t WS_ATT = 793 * MiB;
constexpr size_t WS_DELTA = 430 * MiB;
constexpr size_t WS_XE = 430 * MiB;
constexpr size_t WS_HID = 566 * MiB;
constexpr size_t WS_END = 859 * MiB;
constexpr size_t QO_QM = 0, QO_QD = 25952256, QO_QG = 43253760, QO_KM = 77856768, QO_KD = 103809024, QO_KG = 121110528, QO_VM = 129761280, QO_VD = 147062784, QO_VG = 164364288;
static_assert(QO_VG + 8650752 == 173015040 && WS_QKV + 173015040 <= WS_ATT && WS_HID + (size_t)16 * 4352 * 2048 * 2 <= WS_END, "ws map");
constexpr int CW_BAR = 4096, CW_Q = 16384;
constexpr int RING_BYTES = 131072, LDSCTL_OFF = RING_BYTES, MISC_OFF = LDSCTL_OFF + 320, LDS_BYTES = 147456;

#define GAS __attribute__((address_space(1)))
#define LAS __attribute__((address_space(3)))
typedef unsigned short bf16;
typedef unsigned v4u __attribute__((ext_vector_type(4)));
typedef unsigned v2u __attribute__((ext_vector_type(2)));
typedef float f32x4 __attribute__((ext_vector_type(4)));
typedef float f32x2 __attribute__((ext_vector_type(2)));
typedef GAS unsigned gu32;
#define RLX_AGENT __ATOMIC_RELAXED, __HIP_MEMORY_SCOPE_AGENT
#define LDS_WAIT() asm volatile("s_waitcnt lgkmcnt(0)" ::: "memory")
__device__ __forceinline__ unsigned pk2(float lo, float hi) { return att::cvtpk(lo, hi); }
__device__ __forceinline__ float bflo(unsigned w) { return __uint_as_float(w << 16); }
__device__ __forceinline__ float bfhi(unsigned w) { return __uint_as_float(w & 0xffff0000u); }
#define XB_TMO      128
#define XB_XCNT(j)  (256  + 64 * (j))
#define XB_XSUB(j)  (1280 + 64 * (j))
#define XB_XGEN(j)  (2304 + 64 * (j))
#define XB_TOP      3328
#define XB_TOPGEN   3392
#define XCD_BAR_WORDS 3456
#define XB_SPIN_CAP (1u << 18)

__device__ __forceinline__ unsigned xb_ld(unsigned* p)              { return __hip_atomic_load(p, __ATOMIC_RELAXED, __HIP_MEMORY_SCOPE_AGENT); }
__device__ __forceinline__ unsigned xb_add(unsigned* p, unsigned v) { return __hip_atomic_fetch_add(p, v, __ATOMIC_RELAXED, __HIP_MEMORY_SCOPE_AGENT); }
__device__ __forceinline__ unsigned xb_xcc_id() { return (unsigned)__builtin_amdgcn_s_getreg((3 << 11) | 20) & 0xFu; }
#define XB_SPIN(cond, bar) do { unsigned _sp = 0; while (cond) { __builtin_amdgcn_s_sleep(1); \
    if ((++_sp & 255u) == 0u) { if (xb_ld(&(bar)[XB_TMO])) break; if (_sp > XB_SPIN_CAP) { atomicAdd(&(bar)[XB_TMO], 1u); break; } } } } while (0)

struct XcdBarrier {
    unsigned* bar; unsigned x;
    volatile LAS unsigned* st;
};

__device__ __forceinline__ XcdBarrier xcd_barrier_post(unsigned* bar, volatile LAS unsigned* st) {
    XcdBarrier b; b.bar = bar; b.x = xb_xcc_id(); b.st = st;
    if (threadIdx.x == 0) (void)xb_add(&bar[XB_XCNT(b.x)], 1u);
    return b;
}
__device__ __forceinline__ void xcd_barrier_complete(unsigned* bar, unsigned x, unsigned& nloc, unsigned& nx) {
    const unsigned G = gridDim.x * gridDim.y * gridDim.z;
    unsigned sum, cnt, mine, sp = 0u;
    for (;;) {
        sum = 0u; cnt = 0u; mine = 0u;
#pragma unroll
        for (unsigned j = 0; j < 16; ++j) { const unsigned c = xb_ld(&bar[XB_XCNT(j)]); sum += c; cnt += (c > 0u) ? 1u : 0u; mine = (j == x) ? c : mine; }
        if (sum == G) break;
        __builtin_amdgcn_s_sleep(1);
        if ((++sp & 255u) == 0u) { if (xb_ld(&bar[XB_TMO])) break; if (sp > XB_SPIN_CAP) { atomicAdd(&bar[XB_TMO], 1u); break; } }
    }
    nloc = mine > 0u ? mine : 1u; nx = cnt > 0u ? cnt : 1u;
}

__device__ __forceinline__ void xcd_barrier(const XcdBarrier& b) {
    asm volatile("s_waitcnt vmcnt(0)" ::: "memory");
    __syncthreads();
    if (threadIdx.x == 0) {
        unsigned* bar = b.bar;
        __builtin_amdgcn_s_waitcnt(0);
        unsigned nloc = b.st[0], nx = b.st[1];
        if (nloc == 0u) { xcd_barrier_complete(bar, b.x, nloc, nx); b.st[0] = nloc; b.st[1] = nx; }
        const unsigned old = xb_add(&bar[XB_XSUB(b.x)], 1u);
        const unsigned gen = old / nloc;
        if (old + 1u == (gen + 1u) * nloc) {
            __builtin_amdgcn_fence(__ATOMIC_RELEASE, "agent");
            asm volatile("s_waitcnt vmcnt(0)" ::: "memory");
            const unsigned og = xb_add(&bar[XB_TOP], 1u);
            const unsigned tg = og / nx;
            if (og + 1u == (tg + 1u) * nx) xb_add(&bar[XB_TOPGEN], 1u);
            else XB_SPIN(xb_ld(&bar[XB_TOPGEN]) == tg, bar);
            __builtin_amdgcn_fence(__ATOMIC_ACQUIRE, "agent");
            xb_add(&bar[XB_XGEN(b.x)], 1u);
            asm volatile("s_waitcnt vmcnt(0)" ::: "memory");
        } else {
            XB_SPIN(xb_ld(&bar[XB_XGEN(b.x)]) == gen, bar);
            __builtin_amdgcn_fence(__ATOMIC_ACQUIRE, "agent");
            asm volatile("s_waitcnt vmcnt(0)" ::: "memory");
        }
    }
    __syncthreads();
}
struct Args { const float* in[N_IN]; float* out; unsigned char* ws; int ph_lo, ph_hi; };
static_assert(sizeof(Args) == 256, "Args has no padding bytes");
typedef const __attribute__((address_space(4))) Args* KA;
__device__ __forceinline__ KA kargs() { KA p = (KA)__builtin_amdgcn_kernarg_segment_ptr(); asm volatile("" : "+s"(p)); return p; }
struct Frame {
    LAS unsigned char* lds;
    volatile LAS unsigned* MISC;
    gu32* ctl;
    int tid, lane, wave, vcu, G;
};
__device__ __forceinline__ void relane(Frame& F) { int t = threadIdx.x; asm volatile("" : "+v"(t)); F.tid = t; F.lane = t & 63; F.wave = __builtin_amdgcn_readfirstlane(t >> 6); }
__device__ __forceinline__ float wave_sum(float v) {
#pragma unroll
    for (int o = 1; o < 64; o <<= 1) v += __shfl_xor(v, o);
    return v;
}
__device__ __forceinline__ float silu_f(float x) { return x / (1.0f + __expf(-x)); }

__device__ __forceinline__ void transpose_item(const float* __restrict__ W, int N, bf16* __restrict__ WT, int ldt, int k0, int n0, int rowbase, LAS float* scr, int lane) {
    float tv[32];
    { const float* wp = W + (size_t)(k0 + (lane >> 5)) * N + n0 + (lane & 31);
#pragma unroll
      for (int i = 0; i < 32; ++i) tv[i] = __builtin_nontemporal_load(wp + (size_t)(2 * i) * N); }
#pragma unroll
    for (int i = 0; i < 32; ++i) scr[(2 * i + (lane >> 5)) * 33 + (lane & 31)] = tv[i];
    LDS_WAIT(); asm volatile("" ::: "memory");
    const int c = lane & 7;
#pragma unroll
    for (int j = 0; j < 4; ++j) { const int n = (lane >> 3) + 8 * j; const LAS float* s = scr + (8 * c) * 33 + n;
        v4u o; o.x = pk2(s[0 * 33], s[1 * 33]); o.y = pk2(s[2 * 33], s[3 * 33]); o.z = pk2(s[4 * 33], s[5 * 33]); o.w = pk2(s[6 * 33], s[7 * 33]);
        *(v4u*)(WT + (size_t)(rowbase + n) * ldt + k0 + 8 * c) = o; }
    LDS_WAIT(); asm volatile("" ::: "memory");
}

__device__ __forceinline__ void sincos_d(float af, float& c, float& s) {
    const double a = (double)af;
    const double q = __builtin_rint(a * 0.63661977236758134308);
    double r = __builtin_fma(-q, 1.57079632679489655800e+00, a); r = __builtin_fma(-q, 6.12323399573676603587e-17, r);
    const double r2 = r * r;
    double sp = -7.6471637318198164759e-13; sp = sp * r2 + 1.6059043836821614599e-10; sp = sp * r2 - 2.5052108385441718775e-08; sp = sp * r2 + 2.7557319223985890653e-06;
    sp = sp * r2 - 1.9841269841269841270e-04; sp = sp * r2 + 8.3333333333333333333e-03; sp = sp * r2 - 1.6666666666666666667e-01; const double sn = r + r * r2 * sp;
    double cp = 4.7794773323873852974e-14; cp = cp * r2 - 1.1470745597729724714e-11; cp = cp * r2 + 2.0876756987868098979e-09; cp = cp * r2 - 2.7557319223985890653e-07;
    cp = cp * r2 + 2.4801587301587301587e-05; cp = cp * r2 - 1.3888888888888888889e-03; cp = cp * r2 + 4.1666666666666666667e-02; cp = cp * r2 - 0.5; const double cs = 1.0 + r2 * cp;
    const int qi = (int)q & 3;
    const double cc = (qi == 0) ? cs : (qi == 1) ? -sn : (qi == 2) ? -cs : sn;
    const double ss = (qi == 0) ? sn : (qi == 1) ? cs : (qi == 2) ? -sn : -cs;
    c = (float)cc; s = (float)ss;
}

#define MEMFENCE() asm volatile("" ::: "memory")
__device__ __forceinline__ void p0_prologue(KA a, Frame& F) {
    relane(F);
    unsigned char* ws = a->ws;
    float* MOD = (float*)(ws + WS_MOD);
    for (int it = blockIdx.x; it < 192; it += F.G) {
        const int l = it / 96, col = (it % 96) * 64 + F.lane;
        const float* W = a->in[I_WADA] + (size_t)l * 1024 * 6144;
        float acc[5] = {0.f, 0.f, 0.f, 0.f, 0.f};
        for (int kk = 0; kk < 128; ++kk) { const int k = F.wave * 128 + kk; const float w = W[(size_t)k * 6144 + col];
#pragma unroll
            for (int v = 0; v < 5; ++v) { const float cv = (v < 4) ? a->in[I_C][v * 1024 + k] : a->in[I_CCTX][k]; acc[v] += silu_f(cv) * w; } }
        LAS float* red = (LAS float*)F.lds;
#pragma unroll
        for (int v = 0; v < 5; ++v) red[(F.wave * 5 + v) * 64 + F.lane] = acc[v];
        __syncthreads();
        if (F.wave < 5) { float s = a->in[I_BADA][l * 6144 + col];
#pragma unroll
            for (int w = 0; w < 8; ++w) s += red[(w * 5 + F.wave) * 64 + F.lane];
            MOD[(l * 5 + F.wave) * 6144 + col] = s; }
        __syncthreads();
    }
    if ((int)blockIdx.x == 192 % F.G && F.wave == 0) {
        float* LAM = (float*)(ws + WS_LAM);
        for (int l = 0; l < NLAYER; ++l) {
            const float p1 = F.lane < 32 ? a->in[I_LQ1][l * 32 + F.lane] * a->in[I_LK1][l * 32 + F.lane] : 0.f;
            const float p2 = F.lane < 32 ? a->in[I_LQ2][l * 32 + F.lane] * a->in[I_LK2][l * 32 + F.lane] : 0.f;
            const float s1 = wave_sum(p1), s2 = wave_sum(p2);
            const float li = 0.8f - 0.6f * expf(-0.3f * (float)l);
            if (F.lane == 0) { LAM[2 * l] = expf(s1) - expf(s2) + li; LAM[2 * l + 1] = li; }
        }
    }
    if ((int)blockIdx.x == 193 % F.G) {
        f32x2* TA_R = (f32x2*)(ws + WS_TAB + TAB_AROW); f32x2* TA_C = (f32x2*)(ws + WS_TAB + TAB_ACOL); f32x2* TG_R = (f32x2*)(ws + WS_TAB + TAB_GROW); f32x2* TG_C = (f32x2*)(ws + WS_TAB + TAB_GCOL);
        const double b8 = 1.0 / __builtin_sqrt(__builtin_sqrt(__builtin_sqrt(10000.0))), b16 = 1.0 / __builtin_sqrt(__builtin_sqrt(__builtin_sqrt(__builtin_sqrt(10000.0))));
        for (int e = F.tid; e < 4608; e += NWAVES * 64) {
            int pos, i, nf; f32x2* dst;
            if (e < 1024) { pos = e >> 3; i = e & 7; nf = 8; dst = TA_R + e; }
            else if (e < 1536) { const int r = e - 1024; pos = r >> 3; i = r & 7; nf = 8; dst = TA_C + r; }
            else if (e < 3584) { const int r = e - 1536; pos = r >> 4; i = r & 15; nf = 16; dst = TG_R + r; }
            else { const int r = e - 3584; pos = r >> 4; i = r & 15; nf = 16; dst = TG_C + r; }
            double inv = 1.0; const double bb = (nf == 8) ? b8 : b16;
            for (int j = 0; j < i; ++j) inv *= bb;
            const float ang = (float)pos * (float)inv;
            float c, s; sincos_d(ang, c, s);
            *dst = (f32x2){c, s};
        }
    }
    for (int it = blockIdx.x; it < 896; it += F.G) {
        const int l = it / 448; int r = it % 448;
        int kb, nb, R, roff, ncols, orow0; const float *Wu, *gg;
        if (r < 192) { kb = r / 6; nb = r % 6; R = 256; roff = 0; ncols = 384; orow0 = ZQ + nb * 64; Wu = a->in[I_WUQ] + (size_t)l * 256 * 384; gg = a->in[I_GCQ] + l * 256; }
        else { r -= 192; kb = r / 8; nb = r % 8; R = 128; roff = 256; ncols = 512; orow0 = ZKV + nb * 64; Wu = a->in[I_WUKV] + (size_t)l * 128 * 512; gg = a->in[I_GCKV] + l * 128; }
        const float* Win = a->in[I_WIN] + (size_t)l * 1024 * INC;
        LAS float* As = (LAS float*)F.lds; LAS float* Bs = As + 32 * 257;
        for (int idx = F.tid; idx < 32 * R; idx += NWAVES * 64) { const int kk = idx / R, rr = idx % R; As[kk * 257 + rr] = Win[(size_t)(kb * 32 + kk) * INC + roff + rr]; }
        for (int idx = F.tid; idx < R * 64; idx += NWAVES * 64) { const int rr = idx >> 6, n = idx & 63; Bs[rr * 64 + n] = gg[rr] * Wu[(size_t)rr * ncols + nb * 64 + n]; }
        __syncthreads();
        const int kk = F.tid & 31, ng = F.tid >> 5;
        f32x4 acc = (f32x4){0.f, 0.f, 0.f, 0.f};
        for (int rr = 0; rr < R; ++rr) { const float av = As[kk * 257 + rr]; const f32x4 bv = *(const LAS f32x4*)(Bs + rr * 64 + ng * 4); acc += av * bv; }
        bf16* Wc = (bf16*)(ws + WS_WCAT) + (size_t)l * ZP * 1024;
#pragma unroll
        for (int j = 0; j < 4; ++j) Wc[(size_t)(orow0 + ng * 4 + j) * 1024 + kb * 32 + kk] = (bf16)(pk2(acc[j], 0.f) & 0xffffu);
        __syncthreads();
    }
    {
        LAS float* scr = (LAS float*)(F.lds + F.wave * 16384);
        const int gw = F.vcu * NWAVES + F.wave, NGW = F.G * NWAVES;
        constexpr int I_IN = 16 * 61, I_O = 16 * 32, PER_L = I_IN + I_O;
        for (int it = gw; it < NLAYER * PER_L; it += NGW) {
            const int l = it / PER_L; int r = it % PER_L;
            if (r < I_IN) { const int kb = r / 61, nb = r % 61; transpose_item(a->in[I_WIN] + (size_t)l * 1024 * INC, INC, (bf16*)(ws + WS_WCAT) + (size_t)l * ZP * 1024, 1024, kb * 64, nb * 32, nb * 32, scr, F.lane); }
            else { r -= I_IN; const int kb = r / 32, nb = r % 32; transpose_item(a->in[I_WO] + (size_t)l * 1024 * 1024, 1024, (bf16*)(ws + WS_WO) + (size_t)l * 1024 * 1024, 1024, kb * 64, nb * 32, nb * 32, scr, F.lane); }
        }
        const int gt = F.vcu * (NWAVES * 64) + F.tid, NGT = F.G * NWAVES * 64;
        constexpr int PADV = (ZP - ZEND) * 1024 * 2 / 16;
        for (int i = gt; i < NLAYER * PADV; i += NGT) { const int l = i / PADV, j = i % PADV; ((v4u*)((bf16*)(ws + WS_WCAT) + ((size_t)l * ZP + ZEND) * 1024))[j] = (v4u){0u, 0u, 0u, 0u}; }
    }
}

__device__ __forceinline__ void phase_a(KA a, Frame& F, int l) {
    relane(F);
    unsigned char* ws = a->ws;
    const float* MOD = (const float*)(ws + WS_MOD);
    const int* INV = (const int*)(ws + WS_INV);
    const bf16* YE = (const bf16*)(ws + WS_YE);
    float* CTXW = (float*)(ws + WS_CTXW);
    bf16* H = (bf16*)(ws + WS_H);
    const bool fin = (l == NLAYER);
    const int nrows = fin ? LROWS : MROWS;
    const int gw = F.vcu * NWAVES + F.wave, NGW = F.G * NWAVES;
    for (int row = gw; row < nrows; row += NGW) {
        const bool isc = row >= LROWS; const int v = isc ? 4 : (row >> 13);
        const float* src = (l == 0) ? (isc ? a->in[I_CTX] + (size_t)(row - LROWS) * 1024 : a->in[I_X] + (size_t)row * 1024)
                                    : (isc ? CTXW + (size_t)(row - LROWS) * 1024 : a->out + (size_t)row * 1024);
        float* dst = isc ? CTXW + (size_t)(row - LROWS) * 1024 : a->out + (size_t)row * 1024;
        f32x4 xv[4];
#pragma unroll
        for (int j = 0; j < 4; ++j) xv[j] = *(const f32x4*)(src + 4 * F.lane + 256 * j);
        if (l > 0) {
            const float* ga2 = MOD + ((l - 1) * 5 + v) * 6144 + 5 * 1024;
            f32x4 acc[4];
#pragma unroll
            for (int j = 0; j < 4; ++j) acc[j] = (f32x4){0.f, 0.f, 0.f, 0.f};
            for (int e = 0; e < NE; ++e) {
                const int s = __builtin_amdgcn_readfirstlane(INV[(size_t)row * 16 + e]);
                if (s >= 0) { const bf16* yr = YE + (size_t)s * 1024 + 4 * F.lane;
#pragma unroll
                    for (int j = 0; j < 4; ++j) { const v2u w = *(const v2u*)(yr + 256 * j); acc[j] += (f32x4){bflo(w.x), bfhi(w.x), bflo(w.y), bfhi(w.y)}; } }
            }
#pragma unroll
            for (int j = 0; j < 4; ++j) { const f32x4 g = *(const f32x4*)(ga2 + 4 * F.lane + 256 * j); xv[j] += g * acc[j]; }
        }
#pragma unroll
        for (int j = 0; j < 4; ++j) *(f32x4*)(dst + 4 * F.lane + 256 * j) = xv[j];
        if (fin) continue;
        float ss = 0.f;
#pragma unroll
        for (int j = 0; j < 4; ++j) ss += (xv[j].x * xv[j].x + xv[j].y * xv[j].y) + (xv[j].z * xv[j].z + xv[j].w * xv[j].w);
        const float rstd = rsqrtf(wave_sum(ss) * (1.0f / 1024.0f) + EPSF);
        const float* g1 = a->in[I_GN1] + l * 1024; const float* sh = MOD + (l * 5 + v) * 6144; const float* sc = sh + 1024;
#pragma unroll
        for (int j = 0; j < 4; ++j) { const int c0 = 4 * F.lane + 256 * j; const f32x4 g = *(const f32x4*)(g1 + c0), s1 = *(const f32x4*)(sc + c0), b1 = *(const f32x4*)(sh + c0);
            const f32x4 h = xv[j] * rstd * g * (1.0f + s1) + b1;
            v2u w; w.x = pk2(h.x, h.y); w.y = pk2(h.z, h.w); *(v2u*)(H + (size_t)row * 1024 + c0) = w; }
    }
}

__device__ __forceinline__ void ld8(const bf16* p, float* f) { const v4u w = *(const v4u*)p; f[0] = bflo(w.x); f[1] = bfhi(w.x); f[2] = bflo(w.y); f[3] = bfhi(w.y); f[4] = bflo(w.z); f[5] = bfhi(w.z); f[6] = bflo(w.w); f[7] = bfhi(w.w); }
__device__ __forceinline__ v4u pk8(const float* f) { v4u w; w.x = pk2(f[0], f[1]); w.y = pk2(f[2], f[3]); w.z = pk2(f[4], f[5]); w.w = pk2(f[6], f[7]); return w; }
template <int N> __device__ __forceinline__ float ssq_row(const bf16* p) { float s = 0.f;
#pragma unroll
    for (int c = 0; c < N / 8; ++c) { float f[8]; ld8(p + 8 * c, f);
#pragma unroll
        for (int i = 0; i < 8; ++i) s += f[i] * f[i];
        if ((c & 7) == 7) MEMFENCE(); }
    return s; }
template <int NP> __device__ __forceinline__ void rope_pairs(float* x, const f32x2* trow, const f32x2* tcol) {
#pragma unroll
    for (int i = 0; i < NP; ++i) { const f32x2 cs = (i < NP / 2) ? trow[i] : tcol[i - NP / 2];
        const float x0 = x[2 * i], x1 = x[2 * i + 1]; x[2 * i] = x0 * cs.x - x1 * cs.y; x[2 * i + 1] = x0 * cs.y + x1 * cs.x; }
}
__device__ __forceinline__ void store_v_tile(char* vt, int lane, const float* v  ) {
    char* p = vt + (lane >> 4) * 1024 + ((lane >> 3) & 1) * 512 + (lane & 7) * 64;
#pragma unroll
    for (int d = 0; d < 2; ++d)
#pragma unroll
        for (int c = 0; c < 4; ++c) *(v4u*)(p + d * 4096 + c * 16) = pk8(v + d * 32 + c * 8);
}
template <bool ROPE> __device__ __forceinline__ v4u proc8(v4u w, float r, const float* g, const f32x2* cs, float qs) {
    float f[8] = {bflo(w.x), bfhi(w.x), bflo(w.y), bfhi(w.y), bflo(w.z), bfhi(w.z), bflo(w.w), bfhi(w.w)};
#pragma unroll
    for (int i = 0; i < 8; ++i) f[i] *= r * g[i];
    if (ROPE) {
#pragma unroll
        for (int i = 0; i < 4; ++i) { const f32x2 t = cs[i]; const float x0 = f[2 * i], x1 = f[2 * i + 1]; f[2 * i] = x0 * t.x - x1 * t.y; f[2 * i + 1] = x0 * t.y + x1 * t.x; }
    }
#pragma unroll
    for (int i = 0; i < 8; ++i) f[i] *= qs;
    return pk8(f);
}
__device__ __forceinline__ float ssq8(v4u w) { const float f[8] = {bflo(w.x), bfhi(w.x), bflo(w.y), bfhi(w.y), bflo(w.z), bfhi(w.z), bflo(w.w), bfhi(w.w)}; float s = 0.f;
#pragma unroll
    for (int i = 0; i < 8; ++i) s += f[i] * f[i];
    return s; }
__device__ __forceinline__ v4u scale8(v4u w, float r) { float f[8] = {bflo(w.x), bfhi(w.x), bflo(w.y), bfhi(w.y), bflo(w.z), bfhi(w.z), bflo(w.w), bfhi(w.w)};
#pragma unroll
    for (int i = 0; i < 8; ++i) f[i] *= r;
    return pk8(f); }
__device__ __forceinline__ void store_v_tile_pk(char* vt, int lane, const v4u* w) {
    char* p = vt + (lane >> 4) * 1024 + ((lane >> 3) & 1) * 512 + (lane & 7) * 64;
#pragma unroll
    for (int c = 0; c < 8; ++c) *(v4u*)(p + (c >> 2) * 4096 + (c & 3) * 16) = w[c];
}
__device__ __forceinline__ void phase_c(KA a, Frame& F, int l) {
    relane(F);
    unsigned char* ws = a->ws;
    const bf16* Z = (const bf16*)(ws + WS_Z);
    unsigned char* qkv = ws + WS_QKV;
    const f32x2* TA_R = (const f32x2*)(ws + WS_TAB + TAB_AROW); const f32x2* TA_C = (const f32x2*)(ws + WS_TAB + TAB_ACOL);
    const f32x2* TG_R = (const f32x2*)(ws + WS_TAB + TAB_GROW); const f32x2* TG_C = (const f32x2*)(ws + WS_TAB + TAB_GCOL);
    const int gw = F.vcu * NWAVES + F.wave, NGW = F.G * NWAVES, lane = F.lane;
    for (int id = gw; id < 528 * 32; id += NGW) {
        const int tile = id % 528, job = id / 528;
        const int b = tile / NKT, tt = tile % NKT; const bool isc = tt >= 128;
        const int zrow = isc ? LROWS + b * CL + (tt - 128) * 64 + lane : b * SEQ + tt * 64 + lane;
        const int tok = tt * 64 + lane;
        const bf16* zr = Z + (size_t)zrow * ZP;
        const f32x2* tar = TA_R + (isc ? 0 : tt) * 8; const f32x2* tac = TA_C + lane * 8;
        const f32x2* tgr = TG_R + (isc ? 0 : tt) * 16; const f32x2* tgc = TG_C + lane * 16;
        MEMFENCE();
        if (job < 4) {
            const int h = job;
            const float r1 = rsqrtf(ssq_row<256>(zr) * (1.0f / 256.0f) + EPSF);
            MEMFENCE();
            v4u w[12]; float ss = 0.f;
#pragma unroll
            for (int c = 0; c < 12; ++c) { w[c] = *(const v4u*)(zr + ZQ + h * 96 + 8 * c); ss += ssq8(w[c]); }
            MEMFENCE();
            const float r = r1 * rsqrtf(ss * r1 * r1 * (1.0f / 96.0f) + EPSF); const float* g = a->in[I_GMQ] + l * 96;
            const float qs = 0.10206207261596575f * LOG2E;
            bf16* q = (bf16*)(qkv + QO_QM) + ((size_t)(b * 4 + h) * NTOKB + tok) * 96;
#pragma unroll
            for (int c = 0; c < 12; ++c) {
                v4u o;
                if (c < 8 || isc) o = proc8<false>(w[c], r, g + 8 * c, nullptr, qs);
                else o = proc8<true>(w[c], r, g + 8 * c, (c < 10) ? tar + 4 * (c - 8) : tac + 4 * (c - 10), qs);
                *(v4u*)(q + 8 * c) = o; MEMFENCE(); }
        } else if (job < 8) {
            const int h = job - 4;
            const float r1 = rsqrtf(ssq_row<128>(zr + 256) * (1.0f / 128.0f) + EPSF);
            MEMFENCE();
            v4u w[12]; float ss = 0.f, s2 = 0.f;
#pragma unroll
            for (int c = 0; c < 8; ++c) { w[c] = *(const v4u*)(zr + ZKV + h * 128 + 8 * c); ss += ssq8(w[c]); }
#pragma unroll
            for (int c = 0; c < 4; ++c) { w[8 + c] = *(const v4u*)(zr + 384 + 8 * c); s2 += ssq8(w[8 + c]); }
            MEMFENCE();
            const float r2 = rsqrtf((ss * r1 * r1 + s2) * (1.0f / 96.0f) + EPSF); const float* g = a->in[I_GMK] + l * 96;
            char* kt = (char*)(qkv + QO_KM) + ((size_t)(b * 4 + h) * NKT + tt) * 12288 + lane * 16;
#pragma unroll
            for (int c = 0; c < 12; ++c) {
                v4u o;
                if (c < 8) o = proc8<false>(w[c], r1 * r2, g + 8 * c, nullptr, 1.0f);
                else if (isc) o = proc8<false>(w[c], r2, g + 8 * c, nullptr, 1.0f);
                else o = proc8<true>(w[c], r2, g + 8 * c, (c < 10) ? tar + 4 * (c - 8) : tac + 4 * (c - 10), 1.0f);
                *(v4u*)(kt + c * 1024) = o; MEMFENCE(); }
            v4u vw[8];
#pragma unroll
            for (int c = 0; c < 8; ++c) vw[c] = scale8(*(const v4u*)(zr + ZKV + h * 128 + 64 + 8 * c), r1);
            store_v_tile_pk((char*)(qkv + QO_VM) + ((size_t)(b * 4 + h) * NKT + tt) * 8192, lane, vw);
        } else if (job < 16) {
            const bool isk = job >= 12; const int h = (job - 8) & 3;
            const bf16* zp = zr + (isk ? 672 : 416) + h * 64; const float* g = (isk ? a->in[I_GDK] : a->in[I_GDQ]) + l * 32;
            const float qs = isk ? 1.0f : 0.17677669529663687f * LOG2E;
            v4u w[8]; float ss[2] = {0.f, 0.f};
#pragma unroll
            for (int c = 0; c < 8; ++c) { w[c] = *(const v4u*)(zp + 8 * c); ss[c >> 2] += ssq8(w[c]); }
            MEMFENCE();
            const float r0 = rsqrtf(ss[0] * (1.0f / 32.0f) + EPSF), r1 = rsqrtf(ss[1] * (1.0f / 32.0f) + EPSF);
            char* kt = (char*)(qkv + QO_KD) + ((size_t)(b * 4 + h) * NKT + tt) * 8192 + lane * 16;
            bf16* q = (bf16*)(qkv + QO_QD) + ((size_t)(b * 4 + h) * NTOKB + tok) * 64;
#pragma unroll
            for (int c = 0; c < 8; ++c) { const int cm = c & 3;
                v4u o;
                if (isc) o = proc8<false>(w[c], (c < 4) ? r0 : r1, g + 8 * cm, nullptr, qs);
                else o = proc8<true>(w[c], (c < 4) ? r0 : r1, g + 8 * cm, (cm < 2) ? tar + 4 * cm : tac + 4 * (cm - 2), qs);
                if (isk) *(v4u*)(kt + c * 1024) = o; else *(v4u*)(q + 8 * c) = o;
                MEMFENCE(); }
        } else if (job < 20) {
            const int h = job - 16; v4u vw[8];
#pragma unroll
            for (int c = 0; c < 8; ++c) vw[c] = *(const v4u*)(zr + 928 + h * 64 + 8 * c);
            store_v_tile_pk((char*)(qkv + QO_VD) + ((size_t)(b * 4 + h) * NKT + tt) * 8192, lane, vw);
        } else if (job < 30) {
            const bool isk = job >= 28; const int h = isk ? job - 28 : job - 20;
            const bf16* zp = zr + (isk ? 1696 : 1184) + h * 64; const float* g = (isk ? a->in[I_GGK] : a->in[I_GGQ]) + l * 64;
            const float qs = isk ? 1.0f : 0.125f * LOG2E;
            v4u w[8]; float ss = 0.f;
#pragma unroll
            for (int c = 0; c < 8; ++c) { w[c] = *(const v4u*)(zp + 8 * c); ss += ssq8(w[c]); }
            MEMFENCE();
            const float r = rsqrtf(ss * (1.0f / 64.0f) + EPSF);
            char* kt = (char*)(qkv + QO_KG) + ((size_t)(b * 2 + h) * NKT + tt) * 8192 + lane * 16;
            bf16* q = (bf16*)(qkv + QO_QG) + ((size_t)(b * 8 + h) * NTOKB + tok) * 64;
#pragma unroll
            for (int c = 0; c < 8; ++c) {
                v4u o;
                if (isc) o = proc8<false>(w[c], r, g + 8 * c, nullptr, qs);
                else o = proc8<true>(w[c], r, g + 8 * c, (c < 4) ? tgr + 4 * c : tgc + 4 * (c - 4), qs);
                if (isk) *(v4u*)(kt + c * 1024) = o; else *(v4u*)(q + 8 * c) = o;
                MEMFENCE(); }
        } else {
            const int h = job - 30; v4u vw[8];
#pragma unroll
            for (int c = 0; c < 8; ++c) vw[c] = *(const v4u*)(zr + 1824 + h * 64 + 8 * c);
            store_v_tile_pk((char*)(qkv + QO_VG) + ((size_t)(b * 2 + h) * NKT + tt) * 8192, lane, vw);
        }
        MEMFENCE();
    }
}

#if MK_NAIVE_ATTN
#define ATT_UNIT(KD, NM) att::attn_unit_naive<KD, NM>
#define ATT_DIFF att::attn_unit_naive<64, 2>
#elif MK_ATT_V1
#define ATT_UNIT(KD, NM) att::attn_unit<KD, NM>
#define ATT_DIFF att::attn_unit<64, 2>
#else
#define ATT_UNIT(KD, NM) att::attn_unit_p<KD, NM, ABL>
#define ATT_DIFF att::attn_unit_p<32, 2, ABL>
#endif
template <int ABL>
__device__ __forceinline__ void phase_d(KA a, Frame& F, int l, bool last) {
    relane(F);
    unsigned char* ws = a->ws; unsigned char* qkv = ws + WS_QKV;
    bf16* ATT = (bf16*)(ws + (ABL ? WS_Z : WS_ATT));
    const float* LAM = (const float*)(ws + WS_LAM);
    const float lam = LAM[2 * l], oml = 1.0f - LAM[2 * l + 1];
    const float* gdo = a->in[I_GDO] + l * 64;
    ALDS char* lds = (ALDS char*)F.lds;
    const int nctx = last ? 0 : 64;
    for (int id = F.vcu; id < 512 + nctx; id += F.G) {
        int b, h, q0, t0, t1; size_t orow;
        if (id < 512) { const int x = (id & 255) >> 5; b = x >> 1; h = 2 * (x & 1) + (id >> 8); q0 = (id & 31) * 256; t0 = 0; t1 = NKT; orow = (size_t)b * SEQ + q0; }
        else { const int c = id - 512; b = c >> 4; h = c & 15; if (h >= 4) continue; q0 = SEQ; t0 = 128; t1 = NKT; orow = (size_t)LROWS + b * CL; }
        ATT_UNIT(96, 1)((const bf16*)(qkv + QO_QM) + ((size_t)(b * 4 + h) * NTOKB + q0) * 96, (const char*)(qkv + QO_KM) + (size_t)(b * 4 + h) * NKT * 12288,
                        (const char*)(qkv + QO_VM) + (size_t)(b * 4 + h) * NKT * 8192, t0, t1, ATT + orow * 1024 + h * 64, lds, 0.f, gdo, 0.f);
    }
    for (int id = 512 + F.vcu; id < 1024 + nctx; id += F.G) {
        int b, h, q0, t0, t1; size_t orow;
        if (id < 1024) { const int x = (id & 255) >> 5; b = x >> 1; h = 2 * (x & 1) + ((id >> 8) - 2); q0 = (id & 31) * 256; t0 = 0; t1 = NKT; orow = (size_t)b * SEQ + q0; }
        else { const int c = id - 1024; b = c >> 4; h = (c & 15) - 4; if (h < 0 || h >= 4) continue; q0 = SEQ; t0 = 128; t1 = NKT; orow = (size_t)LROWS + b * CL; }
        ATT_DIFF((const bf16*)(qkv + QO_QD) + ((size_t)(b * 4 + h) * NTOKB + q0) * 64, (const char*)(qkv + QO_KD) + (size_t)(b * 4 + h) * NKT * 8192,
                        (const char*)(qkv + QO_VD) + (size_t)(b * 4 + h) * NKT * 8192, t0, t1, ATT + orow * 1024 + 256 + h * 64, lds, lam, gdo, oml);
    }
    for (int id = 1024 + F.vcu; id < 2048 + nctx; id += F.G) {
        int b, h, q0, t0, t1; size_t orow;
        if (id < 2048) { const int x = (id & 255) >> 5; b = x >> 1; h = 4 * (x & 1) + ((id >> 8) - 4); q0 = (id & 31) * 256; t0 = 0; t1 = NKT; orow = (size_t)b * SEQ + q0; }
        else { const int c = id - 2048; b = c >> 4; h = (c & 15) - 8; if (h < 0) continue; q0 = SEQ; t0 = 128; t1 = NKT; orow = (size_t)LROWS + b * CL; }
        const int g = h >> 2;
        ATT_UNIT(64, 1)((const bf16*)(qkv + QO_QG) + ((size_t)(b * 8 + h) * NTOKB + q0) * 64, (const char*)(qkv + QO_KG) + (size_t)(b * 2 + g) * NKT * 8192,
                        (const char*)(qkv + QO_VG) + (size_t)(b * 2 + g) * NKT * 8192, t0, t1, ATT + orow * 1024 + 512 + h * 64, lds, 0.f, gdo, 0.f);
    }
}

__device__ __forceinline__ void phase_f(KA a, Frame& F, int l, bool last) {
    relane(F);
    unsigned char* ws = a->ws;
    const float* MOD = (const float*)(ws + WS_MOD);
    float* AFF = (float*)(ws + WS_AFF); float* AFFC = (float*)(ws + WS_AFFC); int* INV = (int*)(ws + WS_INV);
    const float* CTXW = (const float*)(ws + WS_CTXW); bf16* H = (bf16*)(ws + WS_H);
    LAS float* wrT = (LAS float*)F.lds;
    const float* wr = a->in[I_WR] + (size_t)l * 1024 * 16;
    for (int idx = F.tid; idx < 16384; idx += NWAVES * 64) wrT[(idx & 15) * 1024 + (idx >> 4)] = wr[idx];
    __syncthreads();
    const int nrows = last ? LROWS : MROWS;
    const int gw = F.vcu * NWAVES + F.wave, NGW = F.G * NWAVES;
    for (int row = gw; row < nrows; row += NGW) {
        const bool isc = row >= LROWS; const int v = isc ? 4 : (row >> 13);
        const float* src = isc ? CTXW + (size_t)(row - LROWS) * 1024 : a->out + (size_t)row * 1024;
        f32x4 hv[4]; float ss = 0.f;
        float* xdst = isc ? (float*)(ws + WS_CTXW) + (size_t)(row - LROWS) * 1024 : a->out + (size_t)row * 1024;
        const bf16* dl = (const bf16*)(ws + WS_DELTA) + (size_t)row * 1024;
#pragma unroll
        for (int j = 0; j < 4; ++j) { const int c0 = 4 * F.lane + 256 * j; const v2u w = *(const v2u*)(dl + c0);
            hv[j] = *(const f32x4*)(src + c0) + (f32x4){bflo(w.x), bfhi(w.x), bflo(w.y), bfhi(w.y)};
            *(f32x4*)(xdst + c0) = hv[j];
            ss += (hv[j].x * hv[j].x + hv[j].y * hv[j].y) + (hv[j].z * hv[j].z + hv[j].w * hv[j].w); }
        const float rstd = rsqrtf(wave_sum(ss) * (1.0f / 1024.0f) + EPSF);
        const float* g2 = a->in[I_GN2] + l * 1024; const float* sh = MOD + (l * 5 + v) * 6144 + 3 * 1024; const float* sc = sh + 1024;
#pragma unroll
        for (int j = 0; j < 4; ++j) { const int c0 = 4 * F.lane + 256 * j; const f32x4 g = *(const f32x4*)(g2 + c0), s1 = *(const f32x4*)(sc + c0), b1 = *(const f32x4*)(sh + c0);
            hv[j] = hv[j] * rstd * g * (1.0f + s1) + b1;
            v2u w; w.x = pk2(hv[j].x, hv[j].y); w.y = pk2(hv[j].z, hv[j].w); *(v2u*)(H + (size_t)row * 1024 + c0) = w; }
        float p[16];
#pragma unroll
        for (int e = 0; e < 16; ++e) { float s = 0.f;
#pragma unroll
            for (int j = 0; j < 4; ++j) { const f32x4 w = *(const LAS f32x4*)(wrT + e * 1024 + 4 * F.lane + 256 * j); s += (hv[j].x * w.x + hv[j].y * w.y) + (hv[j].z * w.z + hv[j].w * w.w); }
            p[e] = s; if ((e & 3) == 3) MEMFENCE(); }
        float r8[8], r4[4], r2[2], lgt;
        { const bool hb = (F.lane & 32) != 0;
#pragma unroll
          for (int j = 0; j < 8; ++j) { const float keep = hb ? p[8 + j] : p[j], send = hb ? p[j] : p[8 + j]; r8[j] = keep + __shfl_xor(send, 32); } }
        { const bool hb = (F.lane & 16) != 0;
#pragma unroll
          for (int j = 0; j < 4; ++j) { const float keep = hb ? r8[4 + j] : r8[j], send = hb ? r8[j] : r8[4 + j]; r4[j] = keep + __shfl_xor(send, 16); } }
        { const bool hb = (F.lane & 8) != 0;
#pragma unroll
          for (int j = 0; j < 2; ++j) { const float keep = hb ? r4[2 + j] : r4[j], send = hb ? r4[j] : r4[2 + j]; r2[j] = keep + __shfl_xor(send, 8); } }
        { const bool hb = (F.lane & 4) != 0; const float keep = hb ? r2[1] : r2[0], send = hb ? r2[0] : r2[1]; lgt = keep + __shfl_xor(send, 4); }
        lgt += __shfl_xor(lgt, 1); lgt += __shfl_xor(lgt, 2);
        float mx = lgt;
#pragma unroll
        for (int o = 4; o < 64; o <<= 1) mx = fmaxf(mx, __shfl_xor(mx, o));
        const float ex = __builtin_amdgcn_exp2f((lgt - mx) * LOG2E);
        float sum = ex;
#pragma unroll
        for (int o = 4; o < 64; o <<= 1) sum += __shfl_xor(sum, o);
        const float mine = ex / sum;
        const int ee = ((F.lane >> 5) & 1) * 8 + ((F.lane >> 4) & 1) * 4 + ((F.lane >> 3) & 1) * 2 + ((F.lane >> 2) & 1);
        if ((F.lane & 3) == 0) {
            if (isc) { const int r = row - LROWS; AFFC[((size_t)((r >> 8) * 16 + ee)) * CL + (r & 255)] = mine; }
            else AFF[((size_t)((row >> 13) * 16 + ee)) * SEQ + (row & 8191)] = mine;
            INV[(size_t)row * 16 + ee] = -1;
        }
    }
}

__device__ __forceinline__ void topk_set(Frame& F, const float* __restrict__ src, int n, int k, int rowbase, int slotbase, int e, int* IDX, float* GATE, int* INV) {
    LAS unsigned* keys = (LAS unsigned*)F.lds; LAS unsigned* hist = keys + 8192; LAS unsigned* sc = hist + 256;
    const int tid = F.tid;
    for (int i = tid; i < n; i += NWAVES * 64) keys[i] = __float_as_uint(src[i]);
    if (tid == 0) { sc[0] = 0u; sc[1] = (unsigned)k; }
    __syncthreads();
    for (int pass = 0; pass < 4; ++pass) {
        const int shift = 24 - 8 * pass; const unsigned mask = (pass == 0) ? 0u : (0xFFFFFFFFu << (shift + 8));
        if (tid < 256) hist[tid] = 0u;
        __syncthreads();
        const unsigned prefix = sc[0];
        for (int i = tid; i < n; i += NWAVES * 64) { const unsigned kv = keys[i]; if ((kv & mask) == prefix) __hip_atomic_fetch_add(&hist[(kv >> shift) & 255u], 1u, __ATOMIC_RELAXED, __HIP_MEMORY_SCOPE_WORKGROUP); }
        __syncthreads();
        if (F.wave == 0) {
            const unsigned need = sc[1]; unsigned h[4]; unsigned tot = 0u;
#pragma unroll
            for (int j = 0; j < 4; ++j) { h[j] = hist[255 - (4 * F.lane + j)]; tot += h[j]; }
            unsigned incl = tot;
#pragma unroll
            for (int d = 1; d < 64; d <<= 1) { const unsigned t = __shfl_up(incl, d); if (F.lane >= d) incl += t; }
            unsigned cum = incl - tot;
#pragma unroll
            for (int j = 0; j < 4; ++j) { if (cum < need && need <= cum + h[j]) { sc[0] = prefix | ((unsigned)(255 - (4 * F.lane + j)) << shift); sc[1] = need - cum; } cum += h[j]; }
        }
        __syncthreads();
    }
    const unsigned T = sc[0], need_eq = sc[1];
    const int per = (n + NWAVES * 64 - 1) / (NWAVES * 64), start = tid * per;
    unsigned cg = 0u, ce = 0u;
    for (int j = 0; j < per; ++j) { const int i = start + j; if (i < n) { const unsigned kv = keys[i]; cg += (kv > T) ? 1u : 0u; ce += (kv == T) ? 1u : 0u; } }
    const unsigned packed = cg | (ce << 16);
    unsigned incl = packed;
#pragma unroll
    for (int d = 1; d < 64; d <<= 1) { const unsigned t = __shfl_up(incl, d); if (F.lane >= d) incl += t; }
    if (F.lane == 63) sc[8 + F.wave] = incl;
    __syncthreads();
    unsigned base = 0u;
    for (int w = 0; w < F.wave; ++w) base += sc[8 + w];
    const unsigned excl = base + incl - packed;
    unsigned gb = excl & 0xFFFFu, eb = excl >> 16;
    for (int j = 0; j < per; ++j) { const int i = start + j; if (i < n) { const unsigned kv = keys[i]; const bool g = kv > T, q = kv == T;
        if (g || (q && eb < need_eq)) { const int slot = slotbase + (int)(gb + (eb < need_eq ? eb : need_eq)); IDX[slot] = rowbase + i; GATE[slot] = __uint_as_float(kv); INV[(size_t)(rowbase + i) * 16 + e] = slot; }
        gb += g ? 1u : 0u; eb += q ? 1u : 0u; } }
    __syncthreads();
}
__device__ __forceinline__ void phase_g(KA a, Frame& F, int l, bool last, int rep) {
    relane(F);
    unsigned char* ws = a->ws;
    const float* AFF = (const float*)(ws + WS_AFF); const float* AFFC = (const float*)(ws + WS_AFFC);
    int* IDX = (int*)(ws + WS_IDX); float* GATE = (float*)(ws + WS_GATE); int* INV = (int*)(ws + WS_INV);
    const int RPE = last ? 4096 : 4352, nsets = last ? 64 : 128;
    for (int set = blockIdx.x; set < nsets; set += F.G) {
        if (set < 64) { const int b = set >> 4, e = set & 15; topk_set(F, AFF + (size_t)set * SEQ, SEQ, CAPL, b * SEQ, e * RPE + b * CAPL, e, IDX, GATE, INV); }
        else { const int s2 = set - 64, b = s2 >> 4, e = s2 & 15; topk_set(F, AFFC + (size_t)s2 * CL, CL, CAPC, LROWS + b * CL, e * RPE + 4096 + b * CAPC, e, IDX, GATE, INV);
            if (b == 0 && F.tid < 128) { IDX[e * RPE + 4224 + F.tid] = -1; GATE[e * RPE + 4224 + F.tid] = 0.f; } }
    }
    {
        LAS float* scr = (LAS float*)(F.lds + 40960 + F.wave * 8704);
        gu32* head = F.ctl + CW_Q + 64 * l + 128 * rep;
        constexpr int NIT = NE * 3072;
        const float* wg = a->in[I_WG] + (size_t)l * NE * 1024 * 2048; const float* wu = a->in[I_WU] + (size_t)l * NE * 1024 * 2048; const float* wd = a->in[I_WD] + (size_t)l * NE * 2048 * 1024;
        bf16* WGU = (bf16*)(ws + WS_WGU); bf16* WD = (bf16*)(ws + WS_WD);
        for (;;) {
            unsigned basev = 0u;
            if (F.lane == 0) basev = __hip_atomic_fetch_add(head, 8u, RLX_AGENT);
            const int base = __builtin_amdgcn_readfirstlane((int)basev);
            if (base >= NIT) break;
            for (int j = 0; j < 8; ++j) { const int it = base + j; const int e = it / 3072, r = it % 3072, which = r >> 10, ii = r & 1023;
                if (which < 2) { const int kb = ii >> 6, nb = ii & 63, n0 = nb * 32; const int rowbase = (n0 >> 7) * 256 + (n0 & 127) + which * 128;
                    transpose_item((which ? wu : wg) + (size_t)e * 1024 * 2048, 2048, WGU + (size_t)e * 4096 * 1024, 1024, kb * 64, n0, rowbase - 0, scr, F.lane); }
                else { const int kb = ii >> 5, nb = ii & 31, n0 = nb * 32;
                    transpose_item(wd + (size_t)e * 2048 * 1024, 1024, WD + (size_t)e * 1024 * 2048, 2048, kb * 64, n0, n0, scr, F.lane); } }
        }
    }
}

__device__ __forceinline__ void phase_h(KA a, Frame& F, bool last) {
    relane(F);
    unsigned char* ws = a->ws;
    const int* IDX = (const int*)(ws + WS_IDX); const bf16* H = (const bf16*)(ws + WS_H); bf16* XE = (bf16*)(ws + WS_XE);
    const int nrow = NE * (last ? 4096 : 4352);
    const int gw = F.vcu * NWAVES + F.wave, NGW = F.G * NWAVES;
    for (int r = gw; r < nrow; r += NGW) {
        const int s = __builtin_amdgcn_readfirstlane(IDX[r]);
        v4u v0 = (v4u){0u, 0u, 0u, 0u}, v1 = v0;
        if (s >= 0) { const v4u* p = (const v4u*)(H + (size_t)s * 1024); v0 = p[F.lane]; v1 = p[64 + F.lane]; }
        v4u* q = (v4u*)(XE + (size_t)r * 1024); q[F.lane] = v0; q[64 + F.lane] = v1;
    }
}
__global__ void __launch_bounds__(NWAVES * 64, 2) mk_fwd(Args args) {
    extern __shared__ __attribute__((aligned(16))) unsigned char lds[];
    Frame F;
    F.lds = (LAS unsigned char*)lds;
    F.MISC = (volatile LAS unsigned*)(F.lds + MISC_OFF);
    F.tid = threadIdx.x; F.lane = F.tid & 63; F.wave = __builtin_amdgcn_readfirstlane(F.tid >> 6);
    F.G = gridDim.x; { const int bx = blockIdx.x; F.vcu = (F.G % 8 == 0) ? (bx % 8) * (F.G / 8) + bx / 8 : bx; }
    F.ctl = (gu32*)(args.ws + WS_CTL);
    for (int u = F.tid; u < (LDS_BYTES - LDSCTL_OFF) / 4; u += NWAVES * 64) ((LAS unsigned*)(F.lds + LDSCTL_OFF))[u] = 0u;
    __syncthreads();
    const int lo = args.ph_lo, hi = args.ph_hi;
    const bool multi = (hi - lo) > 1;
    XcdBarrier bar; bar.bar = (unsigned*)(F.ctl + CW_BAR); bar.x = 0; bar.st = nullptr;
    if (multi) bar = xcd_barrier_post((unsigned*)(F.ctl + CW_BAR), F.MISC + 8);
#define IN(k) (lo <= (k) && (k) < hi)
#define SEAM(k) do { if (IN((k) + 1)) xcd_barrier(bar); } while (0)
#define REP(kind) (((MK_REP) >> (kind)) & 1)
#define RUNPH(kind, k, ...) do { if (IN(k)) { for (int rep_ = 0; rep_ <= REP(kind); ++rep_) { __VA_ARGS__; if (rep_ < REP(kind)) xcd_barrier(bar); } SEAM(k); } } while (0)

    RUNPH(0, 0, p0_prologue(kargs(), F));

    for (int l = 0; l < NLAYER; ++l) {
        const bool last = (l == NLAYER - 1);
        const int pb = 1 + 10 * l;
        const int RPE = last ? 4096 : 4352;
        if (IN(pb + 0)) { for (int rep_ = 0; rep_ <= (l == 0 ? REP(1) : 0); ++rep_) { phase_a(kargs(), F, l); if (rep_ < REP(1) && l == 0) xcd_barrier(bar); } SEAM(pb + 0); }
        if (IN(pb + 1)) { for (int rep_ = 0; rep_ <= REP(2); ++rep_) {
            KA ka = kargs(); unsigned char* ws = ka->ws;
            pg8::Gemm g{(const pg8::bf16_t*)(ws + WS_H), (const pg8::bf16_t*)(ws + WS_WCAT) + (size_t)l * ZP * 1024, MROWS, ZP, DM, 1 << 30, 0};
            pg8::StaticOrder S; S.init(MROWS, ZP, F.G, (int)blockIdx.x);
            pg8::EpiStoreBf16 E{(pg8::bf16_t*)(ws + WS_Z), ZP};
            pg8::gemm_phase<pg8::EpiStoreBf16, pg8::StaticOrder, true, true>(F.lds, g, S, E);
            if (rep_ < REP(2)) xcd_barrier(bar); }
            SEAM(pb + 1);
        }
        RUNPH(3, pb + 2, phase_c(kargs(), F, l));
        RUNPH(4, pb + 3, phase_d<0>(kargs(), F, l, last); if (MK_ABL) { xcd_barrier(bar); phase_d<MK_ABL>(kargs(), F, l, last); });
        if (IN(pb + 4)) { for (int rep_ = 0; rep_ <= REP(5); ++rep_) {
            KA ka = kargs(); unsigned char* ws = ka->ws; const float* MODL = (const float*)(ws + WS_MOD) + (size_t)l * 5 * 6144;
            const int M = last ? LROWS : MROWS;
            pg8::Gemm g{(const pg8::bf16_t*)(ws + WS_ATT), (const pg8::bf16_t*)(ws + WS_WO) + (size_t)l * 1024 * 1024, M, DM, DM, 1 << 30, 0};
            pg8::StaticOrder S; S.init(M, DM, F.G, (int)blockIdx.x);
            pg8::EpiColGateBf16 E{(pg8::bf16_t*)(ws + WS_DELTA), DM, MODL, LROWS};
            pg8::gemm_phase<pg8::EpiColGateBf16, pg8::StaticOrder, true, true>(F.lds, g, S, E);
            if (rep_ < REP(5)) xcd_barrier(bar); }
            SEAM(pb + 4);
        }
        RUNPH(6, pb + 5, phase_f(kargs(), F, l, last));
        RUNPH(7, pb + 6, phase_g(kargs(), F, l, last, rep_));
        RUNPH(8, pb + 7, phase_h(kargs(), F, last));
        if (IN(pb + 8)) { for (int rep_ = 0; rep_ <= REP(9); ++rep_) {
            KA ka = kargs(); unsigned char* ws = ka->ws;
            pg8::Gemm g{(const pg8::bf16_t*)(ws + WS_XE), (const pg8::bf16_t*)(ws + WS_WGU), NE * RPE, 2 * FFD, DM, RPE / 256, (size_t)2 * FFD * DM * 2};
            pg8::StaticOrder S; S.init(NE * RPE, 2 * FFD, F.G, (int)blockIdx.x);
            pg8::EpiSwiGLU E{(pg8::bf16_t*)(ws + WS_HID), FFD};
            pg8::gemm_phase<pg8::EpiSwiGLU, pg8::StaticOrder, true, true>(F.lds, g, S, E);
            if (rep_ < REP(9)) xcd_barrier(bar); }
            SEAM(pb + 8);
        }
        if (IN(pb + 9)) { for (int rep_ = 0; rep_ <= REP(10); ++rep_) {
            KA ka = kargs(); unsigned char* ws = ka->ws;
            pg8::Gemm g{(const pg8::bf16_t*)(ws + WS_HID), (const pg8::bf16_t*)(ws + WS_WD), NE * RPE, DM, FFD, RPE / 256, (size_t)DM * FFD * 2};
            pg8::StaticOrder S; S.init(NE * RPE, DM, F.G, (int)blockIdx.x);
            pg8::EpiRowScaleBf16 E{(pg8::bf16_t*)(ws + WS_YE), DM, (const float*)(ws + WS_GATE)};
            pg8::gemm_phase<pg8::EpiRowScaleBf16, pg8::StaticOrder, true, true>(F.lds, g, S, E);
            if (rep_ < REP(10)) xcd_barrier(bar); }
            SEAM(pb + 9);
        }
    }
    if (IN(N_PHASES - 1)) phase_a(kargs(), F, NLAYER);
#undef IN
#undef SEAM
}

extern "C" void kernel_launch(void* const* d_in, const int* in_sizes, int n_in, void* d_out, int out_size, void* d_ws, size_t ws_size, hipStream_t stream) {
    static int grid = 0;
    if (grid == 0) {
        if (n_in != N_IN || out_size != LROWS * DM || ws_size < WS_END) { fprintf(stderr, "kernel_launch: unexpected shapes (n_in %d, out %d, ws %zu); nothing launched\n", n_in, out_size, ws_size); grid = -1; return; }
        int dev = 0, cus = 0, per_cu = 0;
        if (hipGetDevice(&dev) != hipSuccess || hipDeviceGetAttribute(&cus, hipDeviceAttributeMultiprocessorCount, dev) != hipSuccess) { grid = -1; return; }
        if (hipFuncSetAttribute((const void*)mk_fwd, hipFuncAttributeMaxDynamicSharedMemorySize, LDS_BYTES) != hipSuccess) { fprintf(stderr, "kernel_launch: hipFuncSetAttribute failed\n"); grid = -1; return; }
        if (hipOccupancyMaxActiveBlocksPerMultiprocessor(&per_cu, (const void*)mk_fwd, NWAVES * 64, LDS_BYTES) != hipSuccess || per_cu < 1) { fprintf(stderr, "kernel_launch: occupancy query reports %d blocks per CU\n", per_cu); }
        (void)hipGetLastError();
        grid = cus;
    }
    if (grid < 0) return;
    if (hipMemsetAsync((char*)d_ws + WS_CTL, 0, CTL_ZERO_BYTES, stream) != hipSuccess) { fprintf(stderr, "kernel_launch: memset failed\n"); return; }
    Args a{};
    for (int i = 0; i < N_IN; ++i) a.in[i] = (const float*)d_in[i];
    a.out = (float*)d_out; a.ws = (unsigned char*)d_ws;
#if MK_SPLIT
    for (int ph = 0; ph < N_PHASES; ++ph) { a.ph_lo = ph; a.ph_hi = ph + 1; hipLaunchKernelGGL(mk_fwd, dim3(grid), dim3(NWAVES * 64), LDS_BYTES, stream, a); }
#else
    a.ph_lo = 0; a.ph_hi = N_PHASES;
    hipLaunchKernelGGL(mk_fwd, dim3(grid), dim3(NWAVES * 64), LDS_BYTES, stream, a);
#endif
    const hipError_t le = hipPeekAtLastError();
    if (le != hipSuccess) fprintf(stderr, "kernel_launch: launch failed: %s\n", hipGetErrorName(le));
}
```

```cpp
#include <hip/hip_runtime.h>
#include <hip/hip_bf16.h>
#include <cstdio>
#include <cstdint>
#ifndef MK_SPLIT
#define MK_SPLIT 0
#endif
#ifndef MK_REP
#define MK_REP 0
#endif
#ifndef MK_ABL
#define MK_ABL 0
#endif
#ifndef MK_ATT_V1
#define MK_ATT_V1 0
#endif
#ifndef MK_NAIVE_ATTN
#define MK_NAIVE_ATTN 0
#endif
namespace pg8 {
#define PG8_LAS __attribute__((address_space(3)))
typedef unsigned short bf16_t;
typedef short bf16x8 __attribute__((ext_vector_type(8)));
typedef float f32x4 __attribute__((ext_vector_type(4)));
typedef unsigned u32x4 __attribute__((ext_vector_type(4)));
constexpr int BM = 256, BK = 64, HALF = 128, HTB = HALF * BK * 2  , STAGE_BYTES = 8 * HTB, NXCD = 8, WGM = 8;

__host__ __device__ __forceinline__ int lds_byte(int r, int c) { const int st = (r >> 4) * 2 + (c >> 5), rr = r & 15, cc = c & 31, ob = rr * 64 + cc * 2; return st * 1024 + (ob ^ (((ob >> 9) & 1) << 5)); }
__host__ __device__ __forceinline__ void stage_rc(int b, int& R, int& C) { const int st = b / 1024, sb = b % 1024, swz = sb ^ (((sb >> 9) & 1) << 5); R = (st >> 1) * 16 + swz / 64; C = (st & 1) * 32 + (swz % 64) / 2; }
__host__ __device__ __forceinline__ int perm32(int rho) { const int n = rho >> 4, i = rho & 15; return 8 * (i >> 2) + 4 * n + (i & 3); }

struct Unit { int pm, pn; };
struct Gemm { const bf16_t* A; const bf16_t* Bt; int M, N, K; int tpe; size_t bgs; };

struct StaticOrder {
    int nM, nN, nwg, G, c;
    __host__ __device__ void init(int M, int N, int G_, int c_) { nM = M / BM; nN = N / BM; nwg = nM * nN; G = G_; c = c_; }
    __host__ __device__ bool next(int i, Unit& u) const {
        const long L = (long)i * G + c; if (L >= nwg) return false;
        int wgid = (int)L; { const int q = nwg / NXCD, r = nwg % NXCD, xcd = wgid % NXCD, off = wgid / NXCD; wgid = (xcd < r ? xcd * (q + 1) : r * (q + 1) + (xcd - r) * q) + off; }
        const int nig = WGM * nN, gid = wgid / nig, fm = gid * WGM, gsz = (nM - fm) < WGM ? (nM - fm) : WGM;
        u.pm = fm + ((wgid % nig) % gsz); u.pn = (wgid % nig) / gsz; return true;
    }
    __device__ __forceinline__ void a_ready(const Unit&) const {}
    __device__ __forceinline__ void done(const Unit&) const {}
};
typedef int i32x4 __attribute__((ext_vector_type(4)));
__device__ __forceinline__ unsigned cvt_pk_bf16(float lo, float hi) { unsigned r; asm volatile("v_cvt_pk_bf16_f32 %0, %1, %2" : "=v"(r) : "v"(lo), "v"(hi)); return r; }
struct EpiStoreBf16 {
    static constexpr bool PERM = true, AFTER_DRAIN = false;
    bf16_t* O; int ldc;
    __device__ __forceinline__ void operator()(const f32x4 (&acc)[2][2][4][2], const Unit& u, int wr, int wc, int fr, int fq) const {
        const int row0 = u.pm * BM + wr * 64 + fr, col0 = u.pn * BM + wc * 32 + 8 * fq;
#pragma unroll
        for (int ai = 0; ai < 2; ++ai)
#pragma unroll
            for (int m = 0; m < 4; ++m) { bf16_t* rowp = O + (size_t)(row0 + ai * HALF + m * 16) * ldc + col0;
#pragma unroll
                for (int bj = 0; bj < 2; ++bj) { const f32x4 v0 = acc[ai][bj][m][0], v1 = acc[ai][bj][m][1];
                    u32x4 w; w.x = cvt_pk_bf16(v0[0], v0[1]); w.y = cvt_pk_bf16(v0[2], v0[3]); w.z = cvt_pk_bf16(v1[0], v1[1]); w.w = cvt_pk_bf16(v1[2], v1[3]);
                    *(u32x4*)(rowp + bj * HALF) = w; } }
    }
};
struct EpiColGateBf16 {
    static constexpr bool PERM = true, AFTER_DRAIN = false;
    bf16_t* O; int ldc; const float* mod; int lrows;
    __device__ __forceinline__ void operator()(const f32x4 (&acc)[2][2][4][2], const Unit& u, int wr, int wc, int fr, int fq) const {
        const int R0 = u.pm * BM; const int v = (R0 >= lrows) ? 4 : (R0 >> 13);
        const float* ga = mod + v * 6144 + 2 * 1024;
        const int row0 = R0 + wr * 64 + fr, col0 = u.pn * BM + wc * 32 + 8 * fq;
        f32x4 g[2][2];
#pragma unroll
        for (int bj = 0; bj < 2; ++bj)
#pragma unroll
            for (int n = 0; n < 2; ++n) g[bj][n] = *(const f32x4*)(ga + col0 + bj * HALF + 4 * n);
#pragma unroll
        for (int ai = 0; ai < 2; ++ai)
#pragma unroll
            for (int m = 0; m < 4; ++m) { bf16_t* rowp = O + (size_t)(row0 + ai * HALF + m * 16) * ldc + col0;
#pragma unroll
                for (int bj = 0; bj < 2; ++bj) { const f32x4 v0 = acc[ai][bj][m][0] * g[bj][0], v1 = acc[ai][bj][m][1] * g[bj][1];
                    u32x4 w; w.x = cvt_pk_bf16(v0[0], v0[1]); w.y = cvt_pk_bf16(v0[2], v0[3]); w.z = cvt_pk_bf16(v1[0], v1[1]); w.w = cvt_pk_bf16(v1[2], v1[3]);
                    *(u32x4*)(rowp + bj * HALF) = w; } }
    }
};
__device__ __forceinline__ float silu_mul(float g, float u) { return g * __builtin_amdgcn_rcpf(1.0f + __builtin_amdgcn_exp2f(-1.4426950408889634f * g)) * u; }
struct EpiSwiGLU {
    static constexpr bool PERM = true, AFTER_DRAIN = false;
    bf16_t* O; int ldc;
    __device__ __forceinline__ void operator()(const f32x4 (&acc)[2][2][4][2], const Unit& u, int wr, int wc, int fr, int fq) const {
        const int row0 = u.pm * BM + wr * 64 + fr, col0 = u.pn * HALF + wc * 32 + 8 * fq;
#pragma unroll
        for (int ai = 0; ai < 2; ++ai)
#pragma unroll
            for (int m = 0; m < 4; ++m) { const f32x4 g0 = acc[ai][0][m][0], g1 = acc[ai][0][m][1], u0 = acc[ai][1][m][0], u1 = acc[ai][1][m][1];
                u32x4 w; w.x = cvt_pk_bf16(silu_mul(g0[0], u0[0]), silu_mul(g0[1], u0[1])); w.y = cvt_pk_bf16(silu_mul(g0[2], u0[2]), silu_mul(g0[3], u0[3]));
                w.z = cvt_pk_bf16(silu_mul(g1[0], u1[0]), silu_mul(g1[1], u1[1])); w.w = cvt_pk_bf16(silu_mul(g1[2], u1[2]), silu_mul(g1[3], u1[3]));
                *(u32x4*)(O + (size_t)(row0 + ai * HALF + m * 16) * ldc + col0) = w; }
    }
};
struct EpiSwiGLUI8 {
    static constexpr bool PERM = true, AFTER_DRAIN = false;
    bf16_t* O; int ldc; const float* sa; const float* sw; int tpe;
    __device__ __forceinline__ void operator()(const i32x4 (&acc)[2][2][4][2], const Unit& u, int wr, int wc, int fr, int fq) const {
        const int row0 = u.pm * BM + wr * 64 + fr, col0 = u.pn * HALF + wc * 32 + 8 * fq; const int e = u.pm / tpe;
        const float sg = sw[2 * e], su = sw[2 * e + 1];
#pragma unroll
        for (int ai = 0; ai < 2; ++ai)
#pragma unroll
            for (int m = 0; m < 4; ++m) { const int row = row0 + ai * HALF + m * 16; const float rs = sa[row], fg = rs * sg, fu = rs * su;
                const i32x4 g0 = acc[ai][0][m][0], g1 = acc[ai][0][m][1], u0 = acc[ai][1][m][0], u1 = acc[ai][1][m][1];
                u32x4 w;
                w.x = cvt_pk_bf16(silu_mul((float)g0[0] * fg, (float)u0[0] * fu), silu_mul((float)g0[1] * fg, (float)u0[1] * fu));
                w.y = cvt_pk_bf16(silu_mul((float)g0[2] * fg, (float)u0[2] * fu), silu_mul((float)g0[3] * fg, (float)u0[3] * fu));
                w.z = cvt_pk_bf16(silu_mul((float)g1[0] * fg, (float)u1[0] * fu), silu_mul((float)g1[1] * fg, (float)u1[1] * fu));
                w.w = cvt_pk_bf16(silu_mul((float)g1[2] * fg, (float)u1[2] * fu), silu_mul((float)g1[3] * fg, (float)u1[3] * fu));
                *(u32x4*)(O + (size_t)row * ldc + col0) = w; }
    }
};
struct EpiRowScaleBf16 {
    static constexpr bool PERM = true, AFTER_DRAIN = false;
    bf16_t* O; int ldc; const float* rs;
    __device__ __forceinline__ void operator()(const f32x4 (&acc)[2][2][4][2], const Unit& u, int wr, int wc, int fr, int fq) const {
        const int row0 = u.pm * BM + wr * 64 + fr, col0 = u.pn * BM + wc * 32 + 8 * fq;
#pragma unroll
        for (int ai = 0; ai < 2; ++ai)
#pragma unroll
            for (int m = 0; m < 4; ++m) { const int row = row0 + ai * HALF + m * 16; const float s = rs[row]; bf16_t* rowp = O + (size_t)row * ldc + col0;
#pragma unroll
                for (int bj = 0; bj < 2; ++bj) { const f32x4 v0 = acc[ai][bj][m][0] * s, v1 = acc[ai][bj][m][1] * s;
                    u32x4 w; w.x = cvt_pk_bf16(v0[0], v0[1]); w.y = cvt_pk_bf16(v0[2], v0[3]); w.z = cvt_pk_bf16(v1[0], v1[1]); w.w = cvt_pk_bf16(v1[2], v1[3]);
                    *(u32x4*)(rowp + bj * HALF) = w; } }
    }
};
typedef int i32x4 __attribute__((ext_vector_type(4)));
template <bool I8> struct AccSel { typedef f32x4 type; };
template <> struct AccSel<true> { typedef i32x4 type; };
template <class Epi, class Sched, bool ALIGN_EPI = false, bool SP2 = false, bool I8 = false>
__device__ __forceinline__ void gemm_phase(PG8_LAS unsigned char* lds, const Gemm g, const Sched& S, const Epi& E) {
    int tid_l = threadIdx.x; asm volatile("" : "+v"(tid_l));
    const int tid = tid_l, wid = __builtin_amdgcn_readfirstlane(tid >> 6), lane = tid & 63, wr = wid >> 2, wc = wid & 3, fr = lane & 15, fq = lane >> 4;
    const int K = g.K, nt = K / BK;
    unsigned voffA[2], voffB[2];
#pragma unroll
    for (int i = 0; i < 2; ++i) { int R, C; stage_rc(tid * 16 + i * 8192, R, C); const int Rb = Epi::PERM ? ((R & ~31) + perm32(R & 31)) : R;
        voffA[i] = (unsigned)(R * K + C) * 2u; voffB[i] = (unsigned)(Rb * K + C) * 2u; }
    const size_t kstep = (size_t)(BK * 2);
    const size_t hstep = (size_t)HALF * K * 2;
    const size_t tstep = 2 * hstep;
    const unsigned ldsw = (unsigned)wid * 1024u;
    const int aoff = lds_byte(wr * 64 + fr, fq * 8), boff = lds_byte(wc * 32 + fr, fq * 8);
#define PG8_SA(b, h) (((b) * 2 + (h)) * HTB)
#define PG8_SB(b, h) ((4 + (b) * 2 + (h)) * HTB)
#define PG8_STAGE(bufoff, gbase, voff) do { _Pragma("unroll") for (int _i = 0; _i < 2; ++_i) \
        __builtin_amdgcn_global_load_lds((const unsigned*)((const char*)(gbase) + (voff)[_i]), (PG8_LAS unsigned*)(lds + (bufoff) + ldsw + _i * 8192), 16, 0, 0); } while (0)
#define PG8_LDA(dst, b, h) do { _Pragma("unroll") for (int m = 0; m < 4; ++m) _Pragma("unroll") for (int k = 0; k < 2; ++k) dst[m][k] = *(const PG8_LAS bf16x8*)(lds + PG8_SA(b, h) + aoff + m * 2048 + k * 1024); } while (0)
#define PG8_LDB(dst, b, h) do { _Pragma("unroll") for (int n = 0; n < 2; ++n) _Pragma("unroll") for (int k = 0; k < 2; ++k) dst[n][k] = *(const PG8_LAS bf16x8*)(lds + PG8_SB(b, h) + boff + n * 2048 + k * 1024); } while (0)
#define PG8_MMA(ai, bj, At, Bt) do { __builtin_amdgcn_s_setprio(1); _Pragma("unroll") for (int m = 0; m < 4; ++m) _Pragma("unroll") for (int n = 0; n < 2; ++n) _Pragma("unroll") for (int k = 0; k < 2; ++k) \
        { if constexpr (I8) acc[ai][bj][m][n] = __builtin_amdgcn_mfma_i32_16x16x64_i8(__builtin_bit_cast(i32x4, Bt[n][k]), __builtin_bit_cast(i32x4, At[m][k]), acc[ai][bj][m][n], 0, 0, 0); \
          else acc[ai][bj][m][n] = __builtin_amdgcn_mfma_f32_16x16x32_bf16(Bt[n][k], At[m][k], acc[ai][bj][m][n], 0, 0, 0); } __builtin_amdgcn_s_setprio(0); } while (0)
#define PG8_WAIT_V(n) asm volatile("s_waitcnt vmcnt(" #n ")" ::: "memory")
#define PG8_WAIT_L(n) asm volatile("s_waitcnt lgkmcnt(" #n ")" ::: "memory")
#define PG8_BAR __builtin_amdgcn_s_barrier()
#define PG8_SCHED __builtin_amdgcn_sched_barrier(0)
    Unit cur, nxt; int ui = 0;
    if (!S.next(0, cur)) return;
    typedef typename AccSel<I8>::type acc_t; const acc_t acc_zero = {};
    acc_t acc[2][2][4][2];
#pragma unroll
    for (int a = 0; a < 2; ++a)
#pragma unroll
        for (int b = 0; b < 2; ++b)
#pragma unroll
            for (int m = 0; m < 4; ++m)
#pragma unroll
                for (int n = 0; n < 2; ++n) acc[a][b][m][n] = acc_zero;
    bf16x8 At[4][2], B0[2][2], B1[2][2];
    const char* cA = (const char*)g.A + (size_t)cur.pm * tstep; const char* cB = (const char*)g.Bt + (size_t)(cur.pm / g.tpe) * g.bgs + (size_t)cur.pn * tstep;
    S.a_ready(cur);
    if constexpr (SP2) {
        PG8_STAGE(PG8_SB(0, 0), cB, voffB); PG8_STAGE(PG8_SB(0, 1), cB + hstep, voffB); PG8_STAGE(PG8_SA(0, 0), cA, voffA); PG8_STAGE(PG8_SA(0, 1), cA + hstep, voffA);
        if (wr == 1) PG8_BAR;
        PG8_WAIT_V(2); PG8_BAR;
        PG8_STAGE(PG8_SB(1, 0), cB + kstep, voffB); PG8_STAGE(PG8_SA(1, 0), cA + kstep, voffA); PG8_STAGE(PG8_SB(1, 1), cB + hstep + kstep, voffB);
        PG8_WAIT_V(6); PG8_BAR;
    } else {
        PG8_STAGE(PG8_SB(0, 0), cB, voffB); PG8_STAGE(PG8_SA(0, 0), cA, voffA); PG8_STAGE(PG8_SB(0, 1), cB + hstep, voffB); PG8_STAGE(PG8_SA(0, 1), cA + hstep, voffA);
        if (wr == 1) PG8_BAR;
        PG8_WAIT_V(4); PG8_BAR;
        PG8_STAGE(PG8_SB(1, 0), cB + kstep, voffB); PG8_STAGE(PG8_SA(1, 0), cA + kstep, voffA); PG8_STAGE(PG8_SB(1, 1), cB + hstep + kstep, voffB);
        PG8_WAIT_V(6); PG8_BAR;
    }
    for (;;) {
        const bool has_next = S.next(ui + 1, nxt);
        const char* nA = has_next ? (const char*)g.A + (size_t)nxt.pm * tstep : cA; const char* nB = has_next ? (const char*)g.Bt + (size_t)(nxt.pm / g.tpe) * g.bgs + (size_t)nxt.pn * tstep : cB;
        for (int t = 0; t < nt; t += 2) {
            const bool last = (t == nt - 2);
            const char* a1 = cA + (size_t)(t + 1) * kstep;
            const char* a2 = last ? nA : cA + (size_t)(t + 2) * kstep; const char* b2 = last ? nB : cB + (size_t)(t + 2) * kstep;
            const char* a3 = a2 + kstep; const char* b3 = b2 + kstep;
            if (last && has_next) S.a_ready(nxt);
            if constexpr (SP2) {
            PG8_LDB(B0, 0, 0); PG8_LDB(B1, 0, 1); PG8_SCHED; PG8_LDA(At, 0, 0); PG8_STAGE(PG8_SA(1, 1), a1 + hstep, voffA);
            PG8_WAIT_V(8); PG8_WAIT_L(0); PG8_BAR; PG8_MMA(0, 0, At, B0); PG8_MMA(0, 1, At, B1); PG8_BAR; PG8_SCHED;
            PG8_LDA(At, 0, 1); PG8_STAGE(PG8_SB(0, 0), b2, voffB); PG8_STAGE(PG8_SB(0, 1), b2 + hstep, voffB); PG8_STAGE(PG8_SA(0, 0), a2, voffA);
            PG8_WAIT_V(8); PG8_WAIT_L(0); PG8_BAR; PG8_MMA(1, 0, At, B0); PG8_MMA(1, 1, At, B1); PG8_BAR; PG8_SCHED;
            PG8_LDB(B0, 1, 0); PG8_LDB(B1, 1, 1); PG8_SCHED; PG8_LDA(At, 1, 0); PG8_STAGE(PG8_SA(0, 1), a2 + hstep, voffA);
            PG8_WAIT_V(8); PG8_WAIT_L(0); PG8_BAR; PG8_MMA(0, 0, At, B0); PG8_MMA(0, 1, At, B1); PG8_BAR; PG8_SCHED;
            PG8_LDA(At, 1, 1); PG8_STAGE(PG8_SB(1, 0), b3, voffB); PG8_STAGE(PG8_SB(1, 1), b3 + hstep, voffB); PG8_STAGE(PG8_SA(1, 0), a3, voffA);
            PG8_WAIT_V(8); PG8_WAIT_L(0); PG8_BAR; PG8_MMA(1, 0, At, B0); PG8_MMA(1, 1, At, B1); PG8_BAR; PG8_SCHED;
            } else {
            PG8_LDB(B0, 0, 0); PG8_SCHED; PG8_LDA(At, 0, 0); PG8_STAGE(PG8_SA(1, 1), a1 + hstep, voffA);
            PG8_WAIT_L(8); PG8_BAR; PG8_WAIT_L(0); PG8_MMA(0, 0, At, B0); PG8_BAR; PG8_SCHED;
            PG8_LDB(B1, 0, 1); PG8_STAGE(PG8_SB(0, 0), b2, voffB);
            PG8_BAR; PG8_WAIT_L(0); PG8_MMA(0, 1, At, B1); PG8_BAR;
            PG8_LDA(At, 0, 1); PG8_STAGE(PG8_SA(0, 0), a2, voffA);
            PG8_BAR; PG8_WAIT_L(0); PG8_MMA(1, 0, At, B0); PG8_BAR; PG8_SCHED;
            PG8_STAGE(PG8_SB(0, 1), b2 + hstep, voffB);
            PG8_WAIT_V(6); PG8_BAR; PG8_MMA(1, 1, At, B1); PG8_BAR;
            PG8_LDB(B0, 1, 0); PG8_SCHED; PG8_LDA(At, 1, 0); PG8_STAGE(PG8_SA(0, 1), a2 + hstep, voffA);
            PG8_WAIT_L(8); PG8_BAR; PG8_WAIT_L(0); PG8_MMA(0, 0, At, B0); PG8_BAR; PG8_SCHED;
            PG8_LDB(B1, 1, 1); PG8_STAGE(PG8_SB(1, 0), b3, voffB);
            PG8_BAR; PG8_WAIT_L(0); PG8_MMA(0, 1, At, B1); PG8_BAR;
            PG8_LDA(At, 1, 1); PG8_STAGE(PG8_SA(1, 0), a3, voffA);
            PG8_BAR; PG8_WAIT_L(0); PG8_MMA(1, 0, At, B0); PG8_BAR; PG8_SCHED;
            PG8_STAGE(PG8_SB(1, 1), b3 + hstep, voffB);
            PG8_WAIT_V(6); PG8_BAR; PG8_MMA(1, 1, At, B1); PG8_BAR;
            }
        }
        if constexpr (ALIGN_EPI) { if (wr == 0) PG8_BAR; }
        if constexpr (!Epi::AFTER_DRAIN) { E(acc, cur, wr, wc, fr, fq); S.done(cur); }
        if (!has_next) break;
#pragma unroll
        for (int a = 0; a < 2; ++a)
#pragma unroll
            for (int b = 0; b < 2; ++b)
#pragma unroll
                for (int m = 0; m < 4; ++m)
#pragma unroll
                    for (int n = 0; n < 2; ++n) acc[a][b][m][n] = acc_zero;
        cur = nxt; cA = nA; cB = nB; ++ui;
        if constexpr (ALIGN_EPI) { if (wr == 1) PG8_BAR; }
    }
    PG8_WAIT_V(0);
    if constexpr (!ALIGN_EPI) { if (wr == 0) PG8_BAR; }
    PG8_BAR;
    if constexpr (Epi::AFTER_DRAIN) { E.fused(acc, cur, wr, wc, fr, fq, lds, wid, lane); S.done(cur); }
#undef PG8_SA
#undef PG8_SB
#undef PG8_STAGE
#undef PG8_LDA
#undef PG8_LDB
#undef PG8_MMA
#undef PG8_WAIT_V
#undef PG8_WAIT_L
#undef PG8_BAR
#undef PG8_SCHED
}
}
namespace att {
typedef unsigned short bf16_t;
typedef short bf16x8 __attribute__((ext_vector_type(8)));
typedef short s16x4 __attribute__((ext_vector_type(4)));
typedef float f32x16 __attribute__((ext_vector_type(16)));
typedef float f32x4 __attribute__((ext_vector_type(4)));
typedef unsigned u32x4 __attribute__((ext_vector_type(4)));
typedef unsigned u32x2 __attribute__((ext_vector_type(2)));
#define ALDS __attribute__((address_space(3)))
typedef float f32x2_t __attribute__((ext_vector_type(2))); typedef __bf16 bf16x2_t __attribute__((ext_vector_type(2)));
__device__ __forceinline__ unsigned cvtpk(float lo, float hi) { f32x2_t v = {lo, hi}; bf16x2_t b = __builtin_convertvector(v, bf16x2_t); return __builtin_bit_cast(unsigned, b); }
__device__ __forceinline__ float bf2f(unsigned short u) { return __uint_as_float((unsigned)u << 16); }
template <int S> __device__ __forceinline__ bf16x8 pack8(const f32x16& x) {
    u32x4 p; p.x = cvtpk(x[8 * S + 0], x[8 * S + 1]); p.y = cvtpk(x[8 * S + 2], x[8 * S + 3]); p.z = cvtpk(x[8 * S + 4], x[8 * S + 5]); p.w = cvtpk(x[8 * S + 6], x[8 * S + 7]);
    return __builtin_bit_cast(bf16x8, p);
}
typedef short v4i16_t __attribute__((ext_vector_type(4)));
__device__ __forceinline__ s16x4 vtr(const ALDS char* p) { return __builtin_bit_cast(s16x4, __builtin_amdgcn_ds_read_tr16_b64_v4i16((ALDS v4i16_t*)p)); }
__device__ __forceinline__ int crow(int r, int hi) { return (r & 3) + 8 * (r >> 2) + 4 * hi; }
constexpr int ATT_LDS_BYTES = 2 * 12288 + 2 * 8192;

template <int KD, int NMAP>
__device__ __forceinline__ void attn_unit(const bf16_t* __restrict__ Qb, const char* __restrict__ Kt, const char* __restrict__ Vt, int t0, int t1,
                                          bf16_t* __restrict__ Ob, ALDS char* lds, float lam, const float* __restrict__ gout, float oml) {
    constexpr int KTB = KD * 128;
    constexpr int KS = KD / 16 / NMAP;
    int tid_l = threadIdx.x; asm volatile("" : "+v"(tid_l));
    const int tid = tid_l, lane = tid & 63, r32 = lane & 31, hi = lane >> 5, wid = tid >> 6;
    bf16x8 qf[NMAP * KS];
    { const bf16_t* qrow = Qb + (size_t)(wid * 32 + r32) * KD + hi * 8;
#pragma unroll
      for (int ks = 0; ks < NMAP * KS; ++ks) qf[ks] = *(const bf16x8*)(qrow + ks * 16); }
    f32x16 o[NMAP][2]; float l[NMAP];
#pragma unroll
    for (int m = 0; m < NMAP; ++m) { l[m] = 0.f;
#pragma unroll
        for (int d = 0; d < 2; ++d)
#pragma unroll
            for (int r = 0; r < 16; ++r) o[m][d][r] = 0.f; }
    u32x4 kst0, kst1, vst; kst1 = (u32x4){0u, 0u, 0u, 0u};
#define ATT_GLOAD(t) do { const char* kp_ = Kt + (size_t)(t) * KTB; kst0 = *(const u32x4*)(kp_ + tid * 16); if (KD == 96 && tid < 256) kst1 = *(const u32x4*)(kp_ + 8192 + tid * 16); \
        vst = *(const u32x4*)(Vt + (size_t)(t) * 8192 + tid * 16); } while (0)
#define ATT_LSTORE(buf) do { *(ALDS u32x4*)(lds + (buf) * KTB + tid * 16) = kst0; if (KD == 96 && tid < 256) *(ALDS u32x4*)(lds + (buf) * KTB + 8192 + tid * 16) = kst1; \
        *(ALDS u32x4*)(lds + 2 * KTB + (buf) * 8192 + tid * 16) = vst; } while (0)
    ATT_GLOAD(t0); ATT_LSTORE(0); __syncthreads();
    const int voff = (4 * hi + ((lane & 15) >> 2)) * 64 + ((lane >> 4) & 1) * 32 + (lane & 3) * 8;
    for (int t = t0; t < t1; ++t) {
        const int cur = (t - t0) & 1;
        if (t + 1 < t1) ATT_GLOAD(t + 1);
        const ALDS char* kb = lds + cur * KTB + hi * 1024 + r32 * 16;
        const ALDS char* vb = lds + 2 * KTB + cur * 8192 + voff;
        bf16x8 p[NMAP][4];
#pragma unroll
        for (int m = 0; m < NMAP; ++m) {
            f32x16 s0, s1;
#pragma unroll
            for (int r = 0; r < 16; ++r) { s0[r] = 0.f; s1[r] = 0.f; }
#pragma unroll
            for (int s = 0; s < KS; ++s) { const int ks = m * KS + s;
                const bf16x8 a0 = *(const ALDS bf16x8*)(kb + ks * 2048), a1 = *(const ALDS bf16x8*)(kb + ks * 2048 + 512);
                s0 = __builtin_amdgcn_mfma_f32_32x32x16_bf16(a0, qf[ks], s0, 0, 0, 0);
                s1 = __builtin_amdgcn_mfma_f32_32x32x16_bf16(a1, qf[ks], s1, 0, 0, 0); }
            float rs = 0.f;
#pragma unroll
            for (int r = 0; r < 16; ++r) { s0[r] = __builtin_amdgcn_exp2f(s0[r]); s1[r] = __builtin_amdgcn_exp2f(s1[r]); rs += s0[r] + s1[r]; }
            l[m] += rs;
            p[m][0] = pack8<0>(s0); p[m][1] = pack8<1>(s0); p[m][2] = pack8<0>(s1); p[m][3] = pack8<1>(s1);
        }
#pragma unroll
        for (int d = 0; d < 2; ++d)
#pragma unroll
            for (int kk = 0; kk < 4; ++kk) {
                const s16x4 lo = vtr(vb + d * 4096 + kk * 1024), h4 = vtr(vb + d * 4096 + kk * 1024 + 512);
                const bf16x8 vf = (bf16x8){lo[0], lo[1], lo[2], lo[3], h4[0], h4[1], h4[2], h4[3]};
#pragma unroll
                for (int m = 0; m < NMAP; ++m) o[m][d] = __builtin_amdgcn_mfma_f32_32x32x16_bf16(vf, p[m][kk], o[m][d], 0, 0, 0);
            }
        if (t + 1 < t1) ATT_LSTORE(cur ^ 1);
        __syncthreads();
    }
#undef ATT_GLOAD
#undef ATT_LSTORE
    float li[NMAP];
#pragma unroll
    for (int m = 0; m < NMAP; ++m) { const float lt = l[m] + __shfl_xor(l[m], 32); li[m] = 1.0f / lt; }
    float val[2][16];
    if (NMAP == 1) {
#pragma unroll
        for (int d = 0; d < 2; ++d)
#pragma unroll
            for (int r = 0; r < 16; ++r) val[d][r] = o[0][d][r] * li[0];
    } else {
        float ss = 0.f; const float l2 = lam * li[NMAP - 1];
#pragma unroll
        for (int d = 0; d < 2; ++d)
#pragma unroll
            for (int r = 0; r < 16; ++r) { const float v = o[0][d][r] * li[0] - o[NMAP - 1][d][r] * l2; val[d][r] = v; ss += v * v; }
        ss += __shfl_xor(ss, 32);
        const float rstd = rsqrtf(ss * (1.0f / 64.0f) + 1e-6f) * oml;
#pragma unroll
        for (int d = 0; d < 2; ++d)
#pragma unroll
            for (int g = 0; g < 4; ++g) { const f32x4 gv = *(const f32x4*)(gout + 32 * d + 8 * g + 4 * hi);
#pragma unroll
                for (int i = 0; i < 4; ++i) val[d][4 * g + i] *= rstd * gv[i]; }
    }
    bf16_t* orow = Ob + (size_t)(wid * 32 + r32) * 1024 + 4 * hi;
#pragma unroll
    for (int d = 0; d < 2; ++d)
#pragma unroll
        for (int g = 0; g < 4; ++g) { u32x2 w; w.x = cvtpk(val[d][4 * g], val[d][4 * g + 1]); w.y = cvtpk(val[d][4 * g + 2], val[d][4 * g + 3]);
            *(u32x2*)(orow + 32 * d + 8 * g) = w; }
}

__device__ __forceinline__ void glds16(const void* gsrc, unsigned lds_dst) { unsigned keep;
    asm volatile("s_mov_b32 %0, m0\n\ts_mov_b32 m0, %2\n\ts_nop 0\n\tglobal_load_lds_dwordx4 %1, off\n\ts_mov_b32 m0, %0" : "=&s"(keep) : "v"(gsrc), "s"(lds_dst) : "memory"); }
#define ATT_SBAR() __builtin_amdgcn_sched_barrier(0)
#define ATT_PIN(x) asm volatile("" : "+v"(x))
#define ATT_MFMA(a, b, c) __builtin_amdgcn_mfma_f32_32x32x16_bf16((a), (b), (c), 0, 0, 0)
template <int KS, int ABL = 0>
__device__ __forceinline__ void att_step(f32x16& C0, f32x16& C1, const f32x16& P0, const f32x16& P1, bf16x8 (&kf)[2 * KS], const bf16x8* qf,
                                         f32x16 (&o)[2], float& l, const ALDS char* vprev, const ALDS char* knext) {
    constexpr int NQ = 2 * KS;
    s16x4 vlo[8], vhi[8]; u32x4 pw[4]; float sacc = 0.f;
    f32x16 z;
#pragma unroll
    for (int r = 0; r < 16; ++r) z[r] = 0.f;
    ATT_SBAR();
#pragma unroll
    for (int i = 0; i < NQ; ++i) {
#pragma unroll
        for (int v = 16 * i / NQ; v < 16 * (i + 1) / NQ; ++v) { const int f = v >> 1; const ALDS char* p = vprev + (f & 1) * 4096 + (f >> 1) * 1024 + (v & 1) * 512;
            if (v & 1) vhi[f] = vtr(p); else vlo[f] = vtr(p); }
        ATT_SBAR();
        if (i == 0) C0 = ATT_MFMA(kf[0], qf[0], z); else if (i == 1) C1 = ATT_MFMA(kf[1], qf[0], z);
        else if (i & 1) C1 = ATT_MFMA(kf[i], qf[i >> 1], C1); else C0 = ATT_MFMA(kf[i], qf[i >> 1], C0);
#pragma unroll
        for (int a = 32 * i / NQ; a < 32 * (i + 1) / NQ; ++a) { if (!(ABL & 4)) sacc += (a < 16) ? P0[a & 15] : P1[a & 15]; }
        ATT_PIN(sacc);
#pragma unroll
        for (int c = 16 * i / NQ; c < 16 * (i + 1) / NQ; ++c) { const int e = 2 * c; unsigned w = (ABL & 4) ? __float_as_uint((e < 16) ? P0[e & 15] : P1[e & 15]) : (e < 16) ? cvtpk(P0[e & 15], P0[(e + 1) & 15]) : cvtpk(P1[e & 15], P1[(e + 1) & 15]);
            ATT_PIN(w); pw[c >> 2][c & 3] = w; }
        ATT_SBAR();
    }
    l += sacc;
#pragma unroll
    for (int j = 0; j < 8; ++j) {
#pragma unroll
        for (int k = NQ * j / 8; k < NQ * (j + 1) / 8; ++k) kf[k] = *(const ALDS bf16x8*)(knext + (k >> 1) * 2048 + (k & 1) * 512);
        ATT_SBAR();
        const bf16x8 vf = (bf16x8){vlo[j][0], vlo[j][1], vlo[j][2], vlo[j][3], vhi[j][0], vhi[j][1], vhi[j][2], vhi[j][3]};
        o[j & 1] = ATT_MFMA(vf, __builtin_bit_cast(bf16x8, pw[j >> 1]), o[j & 1]);
        if (j < 4) {
#pragma unroll
            for (int e = 4 * j; e < 4 * j + 4; ++e) { if (!(ABL & 5)) C0[e] = __builtin_amdgcn_exp2f(C0[e]); }
            ATT_PIN(C0);
        } else {
#pragma unroll
            for (int e = 4 * j - 16; e < 4 * j - 12; ++e) { if (!(ABL & 5)) C1[e] = __builtin_amdgcn_exp2f(C1[e]); }
            ATT_PIN(C1);
        }
        ATT_SBAR();
    }
}
template <int DK, int NMAP, int ABL = 0>
__device__ __forceinline__ void attn_unit_p(const bf16_t* __restrict__ Qb, const char* __restrict__ Kt, const char* __restrict__ Vt, int t0, int t1,
                                            bf16_t* __restrict__ Ob, ALDS char* lds, float lam, const float* __restrict__ gout, float oml) {
    constexpr int KD = DK * NMAP, KTB = KD * 128, KS = DK / 16, NQ = 2 * KS, LV = 4 * KTB;
    int tid_l = threadIdx.x; asm volatile("" : "+v"(tid_l));
    const int tid = tid_l, lane = tid & 63, r32 = lane & 31, hi = lane >> 5, wid = tid >> 6;
    bf16x8 qf[NMAP * KS];
    { const bf16_t* qrow = Qb + (size_t)(wid * 32 + r32) * KD + hi * 8;
#pragma unroll
      for (int ks = 0; ks < NMAP * KS; ++ks) qf[ks] = *(const bf16x8*)(qrow + ks * 16); }
    f32x16 o[NMAP][2]; float l[NMAP];
#pragma unroll
    for (int m = 0; m < NMAP; ++m) { l[m] = 0.f;
#pragma unroll
        for (int d = 0; d < 2; ++d)
#pragma unroll
            for (int r = 0; r < 16; ++r) o[m][d][r] = 0.f; }
    constexpr int NDMA = (KD == 96) ? 3 : 2;
    const unsigned lds0 = (unsigned)(size_t)lds;
    const char* ksrc = Kt + wid * 1024 + lane * 16; const char* vsrc = Vt + wid * 1024 + lane * 16;
#define ATP_DMA(tk, tv) do { if (ABL & 2) break; \
        glds16(ksrc + (size_t)(tk) * KTB, (unsigned)__builtin_amdgcn_readfirstlane(lds0 + ((tk) & 3) * KTB + wid * 1024)); \
        if (KD == 96) glds16(ksrc + (size_t)(tk) * KTB + (8 + (wid & 3) - wid) * 1024, (unsigned)__builtin_amdgcn_readfirstlane(lds0 + ((tk) & 3) * KTB + (8 + (wid & 3)) * 1024)); \
        glds16(vsrc + (size_t)(tv) * 8192, (unsigned)__builtin_amdgcn_readfirstlane(lds0 + LV + ((tv) & 3) * 8192 + wid * 1024)); } while (0)
#define ATP_SYNC() do { if (ABL & 2) break; asm volatile("s_waitcnt vmcnt(%0) lgkmcnt(0)\n\ts_barrier" :: "n"(NDMA) : "memory"); } while (0)
#define ATP_KB(t, m) (lds + ((t) & 3) * KTB + (m) * (DK * 128) + klane)
#define ATP_VB(t) (lds + LV + ((t) & 3) * 8192 + voff)
#define ATP_KLOAD(base) do { const ALDS char* b_ = (base); _Pragma("unroll") for (int k = 0; k < NQ; ++k) kf[k] = *(const ALDS bf16x8*)(b_ + (k >> 1) * 2048 + (k & 1) * 512); } while (0)
    const int klane = hi * 1024 + r32 * 16;
    const int voff = (4 * hi + ((lane & 15) >> 2)) * 64 + ((lane >> 4) & 1) * 32 + (lane & 3) * 8;
    { glds16(ksrc + (size_t)t0 * KTB, (unsigned)__builtin_amdgcn_readfirstlane(lds0 + (t0 & 3) * KTB + wid * 1024));
      if (KD == 96) glds16(ksrc + (size_t)t0 * KTB + (8 + (wid & 3) - wid) * 1024, (unsigned)__builtin_amdgcn_readfirstlane(lds0 + (t0 & 3) * KTB + (8 + (wid & 3)) * 1024));
      glds16(vsrc + (size_t)t0 * 8192, (unsigned)__builtin_amdgcn_readfirstlane(lds0 + LV + (t0 & 3) * 8192 + wid * 1024));
      glds16(ksrc + (size_t)(t0 + 1) * KTB, (unsigned)__builtin_amdgcn_readfirstlane(lds0 + ((t0 + 1) & 3) * KTB + wid * 1024));
      if (KD == 96) glds16(ksrc + (size_t)(t0 + 1) * KTB + (8 + (wid & 3) - wid) * 1024, (unsigned)__builtin_amdgcn_readfirstlane(lds0 + ((t0 + 1) & 3) * KTB + (8 + (wid & 3)) * 1024));
      asm volatile("s_waitcnt vmcnt(0) lgkmcnt(0)\n\ts_barrier" ::: "memory"); }
    ATP_DMA(t0 + 2, t0 + 1); ATP_DMA(t0 + 3, t0 + 2);
    bf16x8 kf[NQ];
    f32x16 sA0, sA1, sB0, sB1;
    ATP_KLOAD(ATP_KB(t0, 0));
#pragma unroll
    for (int r = 0; r < 16; ++r) { sA0[r] = 0.f; sA1[r] = 0.f; }
#pragma unroll
    for (int i = 0; i < NQ; ++i) { if (i & 1) sA1 = ATT_MFMA(kf[i], qf[i >> 1], sA1); else sA0 = ATT_MFMA(kf[i], qf[i >> 1], sA0); }
    if (NMAP == 1) ATP_KLOAD(ATP_KB(t0 + 1, 0)); else ATP_KLOAD(ATP_KB(t0, 1));
#pragma unroll
    for (int r = 0; r < 16; ++r) { sA0[r] = __builtin_amdgcn_exp2f(sA0[r]); sA1[r] = __builtin_amdgcn_exp2f(sA1[r]); }
    if (NMAP == 1) {
        ATP_SYNC();
        ATP_DMA(t0 + 4, t0 + 3);
        att_step<KS, ABL>(sB0, sB1, sA0, sA1, kf, qf, o[0], l[0], ATP_VB(t0), ATP_KB(t0 + 2, 0));
        ATP_SYNC();
        for (int t = t0 + 2; t < t1; t += 2) {
            ATP_DMA(t + 3, t + 2);
            att_step<KS, ABL>(sA0, sA1, sB0, sB1, kf, qf, o[0], l[0], ATP_VB(t - 1), ATP_KB(t + 1, 0));
            ATP_SYNC();
            ATP_DMA(t + 4, t + 3);
            att_step<KS, ABL>(sB0, sB1, sA0, sA1, kf, qf, o[0], l[0], ATP_VB(t), ATP_KB(t + 2, 0));
            ATP_SYNC();
        }
    } else {
        att_step<KS, ABL>(sB0, sB1, sA0, sA1, kf, qf + KS, o[0], l[0], ATP_VB(t0), ATP_KB(t0 + 1, 0));
        ATP_SYNC();
        for (int t = t0 + 1; t < t1; ++t) {
            ATP_DMA(t + 3, t + 2);
            att_step<KS, ABL>(sA0, sA1, sB0, sB1, kf, qf, o[NMAP - 1], l[NMAP - 1], ATP_VB(t - 1), ATP_KB(t, 1));
            att_step<KS, ABL>(sB0, sB1, sA0, sA1, kf, qf + KS, o[0], l[0], ATP_VB(t), ATP_KB(t + 1, 0));
            ATP_SYNC();
        }
    }
    {
        float sacc = 0.f;
#pragma unroll
        for (int r = 0; r < 16; ++r) sacc += sB0[r] + sB1[r];
        l[NMAP - 1] += sacc;
        const bf16x8 p0 = pack8<0>(sB0), p1 = pack8<1>(sB0), p2 = pack8<0>(sB1), p3 = pack8<1>(sB1);
        const ALDS char* vb = ATP_VB(t1 - 1);
#pragma unroll
        for (int j = 0; j < 8; ++j) { const s16x4 lo = vtr(vb + (j & 1) * 4096 + (j >> 1) * 1024), h4 = vtr(vb + (j & 1) * 4096 + (j >> 1) * 1024 + 512);
            const bf16x8 vf = (bf16x8){lo[0], lo[1], lo[2], lo[3], h4[0], h4[1], h4[2], h4[3]};
            const bf16x8 pp = (j >> 1) == 0 ? p0 : (j >> 1) == 1 ? p1 : (j >> 1) == 2 ? p2 : p3;
            o[NMAP - 1][j & 1] = ATT_MFMA(vf, pp, o[NMAP - 1][j & 1]); }
    }
    asm volatile("s_waitcnt vmcnt(0) lgkmcnt(0)\n\ts_barrier" ::: "memory");
#undef ATP_DMA
#undef ATP_SYNC
#undef ATP_KB
#undef ATP_VB
#undef ATP_KLOAD
    float li[NMAP];
#pragma unroll
    for (int m = 0; m < NMAP; ++m) { const float lt = l[m] + __shfl_xor(l[m], 32); li[m] = 1.0f / lt; }
    float val[2][16];
    if (NMAP == 1) {
#pragma unroll
        for (int d = 0; d < 2; ++d)
#pragma unroll
            for (int r = 0; r < 16; ++r) val[d][r] = o[0][d][r] * li[0];
    } else {
        float ss = 0.f; const float l2 = lam * li[NMAP - 1];
#pragma unroll
        for (int d = 0; d < 2; ++d)
#pragma unroll
            for (int r = 0; r < 16; ++r) { const float v = o[0][d][r] * li[0] - o[NMAP - 1][d][r] * l2; val[d][r] = v; ss += v * v; }
        ss += __shfl_xor(ss, 32);
        const float rstd = rsqrtf(ss * (1.0f / 64.0f) + 1e-6f) * oml;
#pragma unroll
        for (int d = 0; d < 2; ++d)
#pragma unroll
            for (int g = 0; g < 4; ++g) { const f32x4 gv = *(const f32x4*)(gout + 32 * d + 8 * g + 4 * hi);
#pragma unroll
                for (int i = 0; i < 4; ++i) val[d][4 * g + i] *= rstd * gv[i]; }
    }
    bf16_t* orow = Ob + (size_t)(wid * 32 + r32) * 1024 + 4 * hi;
#pragma unroll
    for (int d = 0; d < 2; ++d)
#pragma unroll
        for (int g = 0; g < 4; ++g) { u32x2 w; w.x = cvtpk(val[d][4 * g], val[d][4 * g + 1]); w.y = cvtpk(val[d][4 * g + 2], val[d][4 * g + 3]);
            *(u32x2*)(orow + 32 * d + 8 * g) = w; }
}

template <int KD, int NMAP>
__device__ __forceinline__ void attn_unit_naive(const bf16_t* __restrict__ Qb, const char* __restrict__ Kt, const char* __restrict__ Vt, int t0, int t1,
                                                bf16_t* __restrict__ Ob, ALDS char* lds, float lam, const float* __restrict__ gout, float oml) {
    constexpr int KTB = KD * 128, DMAP = KD / NMAP;
    int tid_l = threadIdx.x; asm volatile("" : "+v"(tid_l));
    const int tid = tid_l, q = tid & 255, dh = tid >> 8;
    float qv[KD];
#pragma unroll
    for (int c = 0; c < KD / 8; ++c) { const u32x4 w = *(const u32x4*)(Qb + (size_t)q * KD + c * 8);
#pragma unroll
        for (int i = 0; i < 4; ++i) { qv[c * 8 + 2 * i] = __uint_as_float(w[i] << 16); qv[c * 8 + 2 * i + 1] = __uint_as_float(w[i] & 0xffff0000u); } }
    float o[NMAP][32], l[NMAP];
#pragma unroll
    for (int m = 0; m < NMAP; ++m) { l[m] = 0.f;
#pragma unroll
        for (int i = 0; i < 32; ++i) o[m][i] = 0.f; }
    for (int t = t0; t < t1; ++t) {
        const char* kt = Kt + (size_t)t * KTB; const char* vt = Vt + (size_t)t * 8192 + dh * 4096;
        for (int key = 0; key < 64; ++key) {
            float pm[NMAP];
#pragma unroll
            for (int m = 0; m < NMAP; ++m) { float s = 0.f;
#pragma unroll
                for (int c = 0; c < DMAP / 8; ++c) { const u32x4 w = *(const u32x4*)(kt + (m * (DMAP / 8) + c) * 1024 + key * 16);
#pragma unroll
                    for (int i = 0; i < 4; ++i) { s += qv[m * DMAP + c * 8 + 2 * i] * __uint_as_float(w[i] << 16); s += qv[m * DMAP + c * 8 + 2 * i + 1] * __uint_as_float(w[i] & 0xffff0000u); } }
                pm[m] = __builtin_amdgcn_exp2f(s); l[m] += pm[m]; }
            const char* vr = vt + (key >> 4) * 1024 + ((key >> 3) & 1) * 512 + (key & 7) * 64;
#pragma unroll
            for (int c = 0; c < 4; ++c) { const u32x4 w = *(const u32x4*)(vr + c * 16);
#pragma unroll
                for (int i = 0; i < 4; ++i) { const float v0 = __uint_as_float(w[i] << 16), v1 = __uint_as_float(w[i] & 0xffff0000u);
#pragma unroll
                    for (int m = 0; m < NMAP; ++m) { o[m][c * 8 + 2 * i] += pm[m] * v0; o[m][c * 8 + 2 * i + 1] += pm[m] * v1; } } }
        }
    }
    float val[32];
    if (NMAP == 1) {
        const float li = 1.0f / l[0];
#pragma unroll
        for (int i = 0; i < 32; ++i) val[i] = o[0][i] * li;
    } else {
        const float l1 = 1.0f / l[0], l2 = lam / l[NMAP - 1]; float ss = 0.f;
#pragma unroll
        for (int i = 0; i < 32; ++i) { val[i] = o[0][i] * l1 - o[NMAP - 1][i] * l2; ss += val[i] * val[i]; }
        ALDS float* ex = (ALDS float*)lds;
        __syncthreads(); ex[tid] = ss; __syncthreads();
        ss += ex[tid ^ 256];
        __syncthreads();
        const float rstd = rsqrtf(ss * (1.0f / 64.0f) + 1e-6f) * oml;
#pragma unroll
        for (int i = 0; i < 32; ++i) val[i] *= rstd * gout[dh * 32 + i];
    }
    bf16_t* orow = Ob + (size_t)q * 1024 + dh * 32;
#pragma unroll
    for (int c = 0; c < 4; ++c) { u32x4 w;
#pragma unroll
        for (int i = 0; i < 4; ++i) w[i] = cvtpk(val[c * 8 + 2 * i], val[c * 8 + 2 * i + 1]);
        *(u32x4*)(orow + c * 8) = w; }
}
}
constexpr int NWAVES = 8;
constexpr int DM = 1024, NB = 4, SEQ = 8192, CL = 256, NTOKB = SEQ + CL, LROWS = NB * SEQ, MROWS = LROWS + NB * CL;
constexpr int NLAYER = 2, INC = 1952, ZP = 3072, NE = 16, FFD = 2048, CAPL = 1024, CAPC = 32, NKT = NTOKB / 64;
constexpr int ZQ = 1952, ZKV = 2336, ZEND = 2848;
constexpr float EPSF = 1e-6f, LOG2E = 1.4426950408889634f;
constexpr int N_PHASES = 22;
enum { I_X = 0, I_C, I_CTX, I_CCTX, I_WADA, I_BADA, I_GN1, I_WIN, I_GCQ, I_GCKV, I_WUQ, I_WUKV, I_GMQ, I_GMK, I_GDQ, I_GDK, I_LQ1, I_LK1, I_LQ2, I_LK2, I_GDO, I_GGQ, I_GGK, I_WO, I_GN2, I_WR, I_WG, I_WU, I_WD, N_IN };
constexpr size_t MiB = 1u << 20;
constexpr size_t WS_CTL = 0, CTL_ZERO_BYTES = 1 * MiB;
constexpr size_t WS_MOD = 1 * MiB;
constexpr size_t WS_LAM = WS_MOD + 256 * 1024;
constexpr size_t WS_TAB = WS_MOD + 320 * 1024;
constexpr size_t TAB_AROW = 0, TAB_ACOL = 128 * 8 * 8, TAB_GROW = TAB_ACOL + 64 * 8 * 8, TAB_GCOL = TAB_GROW + 128 * 16 * 8;
constexpr size_t WS_AFF = 2 * MiB, WS_AFFC = 4 * MiB;
constexpr size_t WS_IDX = 5 * MiB, WS_GATE = 6 * MiB;
constexpr size_t WS_INV = 7 * MiB;
constexpr size_t WS_SA = 10 * MiB, WS_SAE = 11 * MiB, WS_SW = 12 * MiB;
constexpr size_t WS_WCAT = 16 * MiB;
constexpr size_t WS_WO = 28 * MiB;
constexpr size_t WS_CTXW = 32 * MiB;
constexpr size_t WS_H = 36 * MiB;
constexpr size_t WS_WGU = 102 * MiB;
constexpr size_t WS_WD = 230 * MiB;
constexpr size_t WS_YE = 294 * MiB;
constexpr size_t WS_Z = 430 * MiB;
constexpr size_t WS_QKV = 628 * MiB;
constexpr size_t WS_ATT = 793 * MiB;
constexpr size_t WS_DELTA = 430 * MiB;
constexpr size_t WS_XE = 430 * MiB;
constexpr size_t WS_HID = 566 * MiB;
constexpr size_t WS_XB = 859 * MiB;
constexpr size_t WS_END = 925 * MiB;
constexpr size_t QO_QM = 0, QO_QD = 25952256, QO_QG = 43253760, QO_KM = 77856768, QO_KD = 103809024, QO_KG = 121110528, QO_VM = 129761280, QO_VD = 147062784, QO_VG = 164364288;
static_assert(QO_VG + 8650752 == 173015040 && WS_QKV + 173015040 <= WS_ATT && WS_HID + (size_t)16 * 4352 * 2048 * 2 <= WS_XB, "ws map");
constexpr int CW_BAR = 4096, CW_Q = 16384;
constexpr int RING_BYTES = 131072, LDSCTL_OFF = RING_BYTES, MISC_OFF = LDSCTL_OFF + 320, LDS_BYTES = 147456;

#define GAS __attribute__((address_space(1)))
#define LAS __attribute__((address_space(3)))
typedef unsigned short bf16;
typedef unsigned v4u __attribute__((ext_vector_type(4)));
typedef unsigned v2u __attribute__((ext_vector_type(2)));
typedef float f32x4 __attribute__((ext_vector_type(4)));
typedef float f32x2 __attribute__((ext_vector_type(2)));
typedef GAS unsigned gu32;
#define RLX_AGENT __ATOMIC_RELAXED, __HIP_MEMORY_SCOPE_AGENT
#define LDS_WAIT() asm volatile("s_waitcnt lgkmcnt(0)" ::: "memory")
__device__ __forceinline__ unsigned pk2(float lo, float hi) { return att::cvtpk(lo, hi); }
__device__ __forceinline__ float bflo(unsigned w) { return __uint_as_float(w << 16); }
__device__ __forceinline__ float bfhi(unsigned w) { return __uint_as_float(w & 0xffff0000u); }
#define XB_TMO      128
#define XB_XCNT(j)  (256  + 64 * (j))
#define XB_XSUB(j)  (1280 + 64 * (j))
#define XB_XGEN(j)  (2304 + 64 * (j))
#define XB_TOP      3328
#define XB_TOPGEN   3392
#define XCD_BAR_WORDS 3456
#define XB_SPIN_CAP (1u << 18)

__device__ __forceinline__ unsigned xb_ld(unsigned* p)              { return __hip_atomic_load(p, __ATOMIC_RELAXED, __HIP_MEMORY_SCOPE_AGENT); }
__device__ __forceinline__ unsigned xb_add(unsigned* p, unsigned v) { return __hip_atomic_fetch_add(p, v, __ATOMIC_RELAXED, __HIP_MEMORY_SCOPE_AGENT); }
__device__ __forceinline__ unsigned xb_xcc_id() { return (unsigned)__builtin_amdgcn_s_getreg((3 << 11) | 20) & 0xFu; }
#define XB_SPIN(cond, bar) do { unsigned _sp = 0; while (cond) { __builtin_amdgcn_s_sleep(1); \
    if ((++_sp & 255u) == 0u) { if (xb_ld(&(bar)[XB_TMO])) break; if (_sp > XB_SPIN_CAP) { atomicAdd(&(bar)[XB_TMO], 1u); break; } } } } while (0)

struct XcdBarrier {
    unsigned* bar; unsigned x;
    volatile LAS unsigned* st;
};

__device__ __forceinline__ XcdBarrier xcd_barrier_post(unsigned* bar, volatile LAS unsigned* st) {
    XcdBarrier b; b.bar = bar; b.x = xb_xcc_id(); b.st = st;
    if (threadIdx.x == 0) (void)xb_add(&bar[XB_XCNT(b.x)], 1u);
    return b;
}
__device__ __forceinline__ void xcd_barrier_complete(unsigned* bar, unsigned x, unsigned& nloc, unsigned& nx) {
    const unsigned G = gridDim.x * gridDim.y * gridDim.z;
    unsigned sum, cnt, mine, sp = 0u;
    for (;;) {
        sum = 0u; cnt = 0u; mine = 0u;
#pragma unroll
        for (unsigned j = 0; j < 16; ++j) { const unsigned c = xb_ld(&bar[XB_XCNT(j)]); sum += c; cnt += (c > 0u) ? 1u : 0u; mine = (j == x) ? c : mine; }
        if (sum == G) break;
        __builtin_amdgcn_s_sleep(1);
        if ((++sp & 255u) == 0u) { if (xb_ld(&bar[XB_TMO])) break; if (sp > XB_SPIN_CAP) { atomicAdd(&bar[XB_TMO], 1u); break; } }
    }
    nloc = mine > 0u ? mine : 1u; nx = cnt > 0u ? cnt : 1u;
}

__device__ __forceinline__ void xcd_barrier(const XcdBarrier& b) {
    asm volatile("s_waitcnt vmcnt(0)" ::: "memory");
    __syncthreads();
    if (threadIdx.x == 0) {
        unsigned* bar = b.bar;
        __builtin_amdgcn_s_waitcnt(0);
        unsigned nloc = b.st[0], nx = b.st[1];
        if (nloc == 0u) { xcd_barrier_complete(bar, b.x, nloc, nx); b.st[0] = nloc; b.st[1] = nx; }
        const unsigned old = xb_add(&bar[XB_XSUB(b.x)], 1u);
        const unsigned gen = old / nloc;
        if (old + 1u == (gen + 1u) * nloc) {
            __builtin_amdgcn_fence(__ATOMIC_RELEASE, "agent");
            asm volatile("s_waitcnt vmcnt(0)" ::: "memory");
            const unsigned og = xb_add(&bar[XB_TOP], 1u);
            const unsigned tg = og / nx;
            if (og + 1u == (tg + 1u) * nx) xb_add(&bar[XB_TOPGEN], 1u);
            else XB_SPIN(xb_ld(&bar[XB_TOPGEN]) == tg, bar);
            __builtin_amdgcn_fence(__ATOMIC_ACQUIRE, "agent");
            xb_add(&bar[XB_XGEN(b.x)], 1u);
            asm volatile("s_waitcnt vmcnt(0)" ::: "memory");
        } else {
            XB_SPIN(xb_ld(&bar[XB_XGEN(b.x)]) == gen, bar);
            __builtin_amdgcn_fence(__ATOMIC_ACQUIRE, "agent");
            asm volatile("s_waitcnt vmcnt(0)" ::: "memory");
        }
    }
    __syncthreads();
}
struct Args { const float* in[N_IN]; float* out; unsigned char* ws; int ph_lo, ph_hi; };
static_assert(sizeof(Args) == 256, "Args has no padding bytes");
typedef const __attribute__((address_space(4))) Args* KA;
__device__ __forceinline__ KA kargs() { KA p = (KA)__builtin_amdgcn_kernarg_segment_ptr(); asm volatile("" : "+s"(p)); return p; }
struct Frame {
    LAS unsigned char* lds;
    volatile LAS unsigned* MISC;
    gu32* ctl;
    int tid, lane, wave, vcu, G;
};
__device__ __forceinline__ void relane(Frame& F) { int t = threadIdx.x; asm volatile("" : "+v"(t)); F.tid = t; F.lane = t & 63; F.wave = __builtin_amdgcn_readfirstlane(t >> 6); }
__device__ __forceinline__ float wave_sum(float v) {
#pragma unroll
    for (int o = 1; o < 64; o <<= 1) v += __shfl_xor(v, o);
    return v;
}
__device__ __forceinline__ float silu_f(float x) { return x / (1.0f + __expf(-x)); }

__device__ __forceinline__ void transpose_item(const float* __restrict__ W, int N, bf16* __restrict__ WT, int ldt, int k0, int n0, int rowbase, LAS float* scr, int lane) {
    float tv[32];
    { const float* wp = W + (size_t)(k0 + (lane >> 5)) * N + n0 + (lane & 31);
#pragma unroll
      for (int i = 0; i < 32; ++i) tv[i] = __builtin_nontemporal_load(wp + (size_t)(2 * i) * N); }
#pragma unroll
    for (int i = 0; i < 32; ++i) scr[(2 * i + (lane >> 5)) * 33 + (lane & 31)] = tv[i];
    LDS_WAIT(); asm volatile("" ::: "memory");
    const int c = lane & 7;
#pragma unroll
    for (int j = 0; j < 4; ++j) { const int n = (lane >> 3) + 8 * j; const LAS float* s = scr + (8 * c) * 33 + n;
        v4u o; o.x = pk2(s[0 * 33], s[1 * 33]); o.y = pk2(s[2 * 33], s[3 * 33]); o.z = pk2(s[4 * 33], s[5 * 33]); o.w = pk2(s[6 * 33], s[7 * 33]);
        *(v4u*)(WT + (size_t)(rowbase + n) * ldt + k0 + 8 * c) = o; }
    LDS_WAIT(); asm volatile("" ::: "memory");
}

__device__ __forceinline__ void transpose_item_i8(const float* __restrict__ W, int N, signed char* __restrict__ WT, int ldt, int k0, int n0, int rowbase, float qs, LAS float* scr, int lane) {
    float tv[32];
    { const float* wp = W + (size_t)(k0 + (lane >> 5)) * N + n0 + (lane & 31);
#pragma unroll
      for (int i = 0; i < 32; ++i) tv[i] = __builtin_nontemporal_load(wp + (size_t)(2 * i) * N); }
#pragma unroll
    for (int i = 0; i < 32; ++i) scr[(2 * i + (lane >> 5)) * 33 + (lane & 31)] = tv[i];
    LDS_WAIT(); asm volatile("" ::: "memory");
    const int c = lane & 3;
#pragma unroll
    for (int j = 0; j < 2; ++j) { const int n = (lane >> 2) + 16 * j; const LAS float* s = scr + (16 * c) * 33 + n; v4u o;
#pragma unroll
        for (int d = 0; d < 4; ++d) { unsigned w = 0u;
#pragma unroll
            for (int i = 0; i < 4; ++i) { const float f = fminf(fmaxf(s[(4 * d + i) * 33] * qs, -127.0f), 127.0f); w |= ((unsigned)((int)__builtin_rintf(f)) & 255u) << (8 * i); }
            o[d] = w; }
        *(v4u*)(WT + (size_t)(rowbase + n) * ldt + k0 + 16 * c) = o; }
    LDS_WAIT(); asm volatile("" ::: "memory");
}

__device__ __forceinline__ void sincos_d(float af, float& c, float& s) {
    const double a = (double)af;
    const double q = __builtin_rint(a * 0.63661977236758134308);
    double r = __builtin_fma(-q, 1.57079632679489655800e+00, a); r = __builtin_fma(-q, 6.12323399573676603587e-17, r);
    const double r2 = r * r;
    double sp = -7.6471637318198164759e-13; sp = sp * r2 + 1.6059043836821614599e-10; sp = sp * r2 - 2.5052108385441718775e-08; sp = sp * r2 + 2.7557319223985890653e-06;
    sp = sp * r2 - 1.9841269841269841270e-04; sp = sp * r2 + 8.3333333333333333333e-03; sp = sp * r2 - 1.6666666666666666667e-01; const double sn = r + r * r2 * sp;
    double cp = 4.7794773323873852974e-14; cp = cp * r2 - 1.1470745597729724714e-11; cp = cp * r2 + 2.0876756987868098979e-09; cp = cp * r2 - 2.7557319223985890653e-07;
    cp = cp * r2 + 2.4801587301587301587e-05; cp = cp * r2 - 1.3888888888888888889e-03; cp = cp * r2 + 4.1666666666666666667e-02; cp = cp * r2 - 0.5; const double cs = 1.0 + r2 * cp;
    const int qi = (int)q & 3;
    const double cc = (qi == 0) ? cs : (qi == 1) ? -sn : (qi == 2) ? -cs : sn;
    const double ss = (qi == 0) ? sn : (qi == 1) ? cs : (qi == 2) ? -sn : -cs;
    c = (float)cc; s = (float)ss;
}

#define MEMFENCE() asm volatile("" ::: "memory")
__device__ __forceinline__ void p0_prologue(KA a, Frame& F) {
    relane(F);
    unsigned char* ws = a->ws;
    float* MOD = (float*)(ws + WS_MOD);
    for (int it = blockIdx.x; it < 192; it += F.G) {
        const int l = it / 96, col = (it % 96) * 64 + F.lane;
        const float* W = a->in[I_WADA] + (size_t)l * 1024 * 6144;
        float acc[5] = {0.f, 0.f, 0.f, 0.f, 0.f};
        for (int kk = 0; kk < 128; ++kk) { const int k = F.wave * 128 + kk; const float w = W[(size_t)k * 6144 + col];
#pragma unroll
            for (int v = 0; v < 5; ++v) { const float cv = (v < 4) ? a->in[I_C][v * 1024 + k] : a->in[I_CCTX][k]; acc[v] += silu_f(cv) * w; } }
        LAS float* red = (LAS float*)F.lds;
#pragma unroll
        for (int v = 0; v < 5; ++v) red[(F.wave * 5 + v) * 64 + F.lane] = acc[v];
        __syncthreads();
        if (F.wave < 5) { float s = a->in[I_BADA][l * 6144 + col];
#pragma unroll
            for (int w = 0; w < 8; ++w) s += red[(w * 5 + F.wave) * 64 + F.lane];
            MOD[(l * 5 + F.wave) * 6144 + col] = s; }
        __syncthreads();
    }
    for (int it = blockIdx.x; it < 64; it += F.G) {
        const int l = it >> 5, e = (it >> 1) & 15, which = it & 1;
        const float* W = (which ? a->in[I_WU] : a->in[I_WG]) + ((size_t)l * NE + e) * 1024 * 2048;
        float ss = 0.f;
        for (int i = 0; i < 32; ++i) { const f32x4 v = *(const f32x4*)(W + (size_t)(32 * i) * 2048 + 4 * F.tid); ss += (v.x * v.x + v.y * v.y) + (v.z * v.z + v.w * v.w); }
        ss = wave_sum(ss);
        LAS float* red = (LAS float*)F.lds;
        if (F.lane == 0) red[F.wave] = ss;
        __syncthreads();
        if (F.tid == 0) { float t = 0.f; for (int w = 0; w < NWAVES; ++w) t += red[w]; const float rms = sqrtf(t * (1.0f / 65536.0f)); ((float*)(ws + WS_SW))[l * 32 + 2 * e + which] = fmaxf(5.0f * rms, 1e-20f) * (1.0f / 127.0f); }
        __syncthreads();
    }
    if ((int)blockIdx.x == 192 % F.G && F.wave == 0) {
        float* LAM = (float*)(ws + WS_LAM);
        for (int l = 0; l < NLAYER; ++l) {
            const float p1 = F.lane < 32 ? a->in[I_LQ1][l * 32 + F.lane] * a->in[I_LK1][l * 32 + F.lane] : 0.f;
            const float p2 = F.lane < 32 ? a->in[I_LQ2][l * 32 + F.lane] * a->in[I_LK2][l * 32 + F.lane] : 0.f;
            const float s1 = wave_sum(p1), s2 = wave_sum(p2);
            const float li = 0.8f - 0.6f * expf(-0.3f * (float)l);
            if (F.lane == 0) { LAM[2 * l] = expf(s1) - expf(s2) + li; LAM[2 * l + 1] = li; }
        }
    }
    if ((int)blockIdx.x == 193 % F.G) {
        f32x2* TA_R = (f32x2*)(ws + WS_TAB + TAB_AROW); f32x2* TA_C = (f32x2*)(ws + WS_TAB + TAB_ACOL); f32x2* TG_R = (f32x2*)(ws + WS_TAB + TAB_GROW); f32x2* TG_C = (f32x2*)(ws + WS_TAB + TAB_GCOL);
        const double b8 = 1.0 / __builtin_sqrt(__builtin_sqrt(__builtin_sqrt(10000.0))), b16 = 1.0 / __builtin_sqrt(__builtin_sqrt(__builtin_sqrt(__builtin_sqrt(10000.0))));
        for (int e = F.tid; e < 4608; e += NWAVES * 64) {
            int pos, i, nf; f32x2* dst;
            if (e < 1024) { pos = e >> 3; i = e & 7; nf = 8; dst = TA_R + e; }
            else if (e < 1536) { const int r = e - 1024; pos = r >> 3; i = r & 7; nf = 8; dst = TA_C + r; }
            else if (e < 3584) { const int r = e - 1536; pos = r >> 4; i = r & 15; nf = 16; dst = TG_R + r; }
            else { const int r = e - 3584; pos = r >> 4; i = r & 15; nf = 16; dst = TG_C + r; }
            double inv = 1.0; const double bb = (nf == 8) ? b8 : b16;
            for (int j = 0; j < i; ++j) inv *= bb;
            const float ang = (float)pos * (float)inv;
            float c, s; sincos_d(ang, c, s);
            *dst = (f32x2){c, s};
        }
    }
    for (int it = blockIdx.x; it < 896; it += F.G) {
        const int l = it / 448; int r = it % 448;
        int kb, nb, R, roff, ncols, orow0; const float *Wu, *gg;
        if (r < 192) { kb = r / 6; nb = r % 6; R = 256; roff = 0; ncols = 384; orow0 = ZQ + nb * 64; Wu = a->in[I_WUQ] + (size_t)l * 256 * 384; gg = a->in[I_GCQ] + l * 256; }
        else { r -= 192; kb = r / 8; nb = r % 8; R = 128; roff = 256; ncols = 512; orow0 = ZKV + nb * 64; Wu = a->in[I_WUKV] + (size_t)l * 128 * 512; gg = a->in[I_GCKV] + l * 128; }
        const float* Win = a->in[I_WIN] + (size_t)l * 1024 * INC;
        LAS float* As = (LAS float*)F.lds; LAS float* Bs = As + 32 * 257;
        for (int idx = F.tid; idx < 32 * R; idx += NWAVES * 64) { const int kk = idx / R, rr = idx % R; As[kk * 257 + rr] = Win[(size_t)(kb * 32 + kk) * INC + roff + rr]; }
        for (int idx = F.tid; idx < R * 64; idx += NWAVES * 64) { const int rr = idx >> 6, n = idx & 63; Bs[rr * 64 + n] = gg[rr] * Wu[(size_t)rr * ncols + nb * 64 + n]; }
        __syncthreads();
        const int kk = F.tid & 31, ng = F.tid >> 5;
        f32x4 acc = (f32x4){0.f, 0.f, 0.f, 0.f};
        for (int rr = 0; rr < R; ++rr) { const float av = As[kk * 257 + rr]; const f32x4 bv = *(const LAS f32x4*)(Bs + rr * 64 + ng * 4); acc += av * bv; }
        bf16* Wc = (bf16*)(ws + WS_WCAT) + (size_t)l * ZP * 1024;
#pragma unroll
        for (int j = 0; j < 4; ++j) Wc[(size_t)(orow0 + ng * 4 + j) * 1024 + kb * 32 + kk] = (bf16)(pk2(acc[j], 0.f) & 0xffffu);
        __syncthreads();
    }
    {
        LAS float* scr = (LAS float*)(F.lds + F.wave * 16384);
        const int gw = F.vcu * NWAVES + F.wave, NGW = F.G * NWAVES;
        constexpr int I_IN = 16 * 61, I_O = 16 * 32, PER_L = I_IN + I_O;
        for (int it = gw; it < NLAYER * PER_L; it += NGW) {
            const int l = it / PER_L; int r = it % PER_L;
            if (r < I_IN) { const int kb = r / 61, nb = r % 61; transpose_item(a->in[I_WIN] + (size_t)l * 1024 * INC, INC, (bf16*)(ws + WS_WCAT) + (size_t)l * ZP * 1024, 1024, kb * 64, nb * 32, nb * 32, scr, F.lane); }
            else { r -= I_IN; const int kb = r / 32, nb = r % 32; transpose_item(a->in[I_WO] + (size_t)l * 1024 * 1024, 1024, (bf16*)(ws + WS_WO) + (size_t)l * 1024 * 1024, 1024, kb * 64, nb * 32, nb * 32, scr, F.lane); }
        }
        const int gt = F.vcu * (NWAVES * 64) + F.tid, NGT = F.G * NWAVES * 64;
        constexpr int PADV = (ZP - ZEND) * 1024 * 2 / 16;
        for (int i = gt; i < NLAYER * PADV; i += NGT) { const int l = i / PADV, j = i % PADV; ((v4u*)((bf16*)(ws + WS_WCAT) + ((size_t)l * ZP + ZEND) * 1024))[j] = (v4u){0u, 0u, 0u, 0u}; }
    }
}

__device__ __forceinline__ void phase_a(KA a, Frame& F, int l) {
    relane(F);
    unsigned char* ws = a->ws;
    const float* MOD = (const float*)(ws + WS_MOD);
    const int* INV = (const int*)(ws + WS_INV);
    const bf16* YE = (const bf16*)(ws + WS_YE);
    bf16* H = (bf16*)(ws + WS_H);
    const bool fin = (l == NLAYER);
    const int nrows = fin ? LROWS : MROWS;
    const int gw = F.vcu * NWAVES + F.wave, NGW = F.G * NWAVES;
    for (int row = gw; row < nrows; row += NGW) {
        const bool isc = row >= LROWS; const int v = isc ? 4 : (row >> 13);
        bf16* xb = (bf16*)(ws + WS_XB) + (size_t)row * 1024;
        f32x4 xv[4];
        if (l == 0) { const float* src = isc ? a->in[I_CTX] + (size_t)(row - LROWS) * 1024 : a->in[I_X] + (size_t)row * 1024;
#pragma unroll
            for (int j = 0; j < 4; ++j) xv[j] = *(const f32x4*)(src + 4 * F.lane + 256 * j); }
        else {
#pragma unroll
            for (int j = 0; j < 4; ++j) { const v2u w = *(const v2u*)(xb + 4 * F.lane + 256 * j); xv[j] = (f32x4){bflo(w.x), bfhi(w.x), bflo(w.y), bfhi(w.y)}; } }
        if (l > 0) {
            const float* ga2 = MOD + ((l - 1) * 5 + v) * 6144 + 5 * 1024;
            f32x4 acc[4];
#pragma unroll
            for (int j = 0; j < 4; ++j) acc[j] = (f32x4){0.f, 0.f, 0.f, 0.f};
            for (int e = 0; e < NE; ++e) {
                const int s = __builtin_amdgcn_readfirstlane(INV[(size_t)row * 16 + e]);
                if (s >= 0) { const bf16* yr = YE + (size_t)s * 1024 + 4 * F.lane;
#pragma unroll
                    for (int j = 0; j < 4; ++j) { const v2u w = *(const v2u*)(yr + 256 * j); acc[j] += (f32x4){bflo(w.x), bfhi(w.x), bflo(w.y), bfhi(w.y)}; } }
            }
#pragma unroll
            for (int j = 0; j < 4; ++j) { const f32x4 g = *(const f32x4*)(ga2 + 4 * F.lane + 256 * j); xv[j] += g * acc[j]; }
        }
        if (fin) {
#pragma unroll
            for (int j = 0; j < 4; ++j) *(f32x4*)(a->out + (size_t)row * 1024 + 4 * F.lane + 256 * j) = xv[j];
            continue; }
#pragma unroll
        for (int j = 0; j < 4; ++j) { v2u w; w.x = pk2(xv[j].x, xv[j].y); w.y = pk2(xv[j].z, xv[j].w); *(v2u*)(xb + 4 * F.lane + 256 * j) = w; }
        float ss = 0.f;
#pragma unroll
        for (int j = 0; j < 4; ++j) ss += (xv[j].x * xv[j].x + xv[j].y * xv[j].y) + (xv[j].z * xv[j].z + xv[j].w * xv[j].w);
        const float rstd = rsqrtf(wave_sum(ss) * (1.0f / 1024.0f) + EPSF);
        const float* g1 = a->in[I_GN1] + l * 1024; const float* sh = MOD + (l * 5 + v) * 6144; const float* sc = sh + 1024;
#pragma unroll
        for (int j = 0; j < 4; ++j) { const int c0 = 4 * F.lane + 256 * j; const f32x4 g = *(const f32x4*)(g1 + c0), s1 = *(const f32x4*)(sc + c0), b1 = *(const f32x4*)(sh + c0);
            const f32x4 h = xv[j] * rstd * g * (1.0f + s1) + b1;
            v2u w; w.x = pk2(h.x, h.y); w.y = pk2(h.z, h.w); *(v2u*)(H + (size_t)row * 1024 + c0) = w; }
    }
}

__device__ __forceinline__ void ld8(const bf16* p, float* f) { const v4u w = *(const v4u*)p; f[0] = bflo(w.x); f[1] = bfhi(w.x); f[2] = bflo(w.y); f[3] = bfhi(w.y); f[4] = bflo(w.z); f[5] = bfhi(w.z); f[6] = bflo(w.w); f[7] = bfhi(w.w); }
__device__ __forceinline__ v4u pk8(const float* f) { v4u w; w.x = pk2(f[0], f[1]); w.y = pk2(f[2], f[3]); w.z = pk2(f[4], f[5]); w.w = pk2(f[6], f[7]); return w; }
template <int N> __device__ __forceinline__ float ssq_row(const bf16* p) { float s = 0.f;
#pragma unroll
    for (int c = 0; c < N / 8; ++c) { float f[8]; ld8(p + 8 * c, f);
#pragma unroll
        for (int i = 0; i < 8; ++i) s += f[i] * f[i];
        if ((c & 7) == 7) MEMFENCE(); }
    return s; }
template <int NP> __device__ __forceinline__ void rope_pairs(float* x, const f32x2* trow, const f32x2* tcol) {
#pragma unroll
    for (int i = 0; i < NP; ++i) { const f32x2 cs = (i < NP / 2) ? trow[i] : tcol[i - NP / 2];
        const float x0 = x[2 * i], x1 = x[2 * i + 1]; x[2 * i] = x0 * cs.x - x1 * cs.y; x[2 * i + 1] = x0 * cs.y + x1 * cs.x; }
}
__device__ __forceinline__ void store_v_tile(char* vt, int lane, const float* v  ) {
    char* p = vt + (lane >> 4) * 1024 + ((lane >> 3) & 1) * 512 + (lane & 7) * 64;
#pragma unroll
    for (int d = 0; d < 2; ++d)
#pragma unroll
        for (int c = 0; c < 4; ++c) *(v4u*)(p + d * 4096 + c * 16) = pk8(v + d * 32 + c * 8);
}
template <bool ROPE> __device__ __forceinline__ v4u proc8(v4u w, float r, const float* g, const f32x2* cs, float qs) {
    float f[8] = {bflo(w.x), bfhi(w.x), bflo(w.y), bfhi(w.y), bflo(w.z), bfhi(w.z), bflo(w.w), bfhi(w.w)};
#pragma unroll
    for (int i = 0; i < 8; ++i) f[i] *= r * g[i];
    if (ROPE) {
#pragma unroll
        for (int i = 0; i < 4; ++i) { const f32x2 t = cs[i]; const float x0 = f[2 * i], x1 = f[2 * i + 1]; f[2 * i] = x0 * t.x - x1 * t.y; f[2 * i + 1] = x0 * t.y + x1 * t.x; }
    }
#pragma unroll
    for (int i = 0; i < 8; ++i) f[i] *= qs;
    return pk8(f);
}
__device__ __forceinline__ float ssq8(v4u w) { const float f[8] = {bflo(w.x), bfhi(w.x), bflo(w.y), bfhi(w.y), bflo(w.z), bfhi(w.z), bflo(w.w), bfhi(w.w)}; float s = 0.f;
#pragma unroll
    for (int i = 0; i < 8; ++i) s += f[i] * f[i];
    return s; }
__device__ __forceinline__ v4u scale8(v4u w, float r) { float f[8] = {bflo(w.x), bfhi(w.x), bflo(w.y), bfhi(w.y), bflo(w.z), bfhi(w.z), bflo(w.w), bfhi(w.w)};
#pragma unroll
    for (int i = 0; i < 8; ++i) f[i] *= r;
    return pk8(f); }
__device__ __forceinline__ void store_v_tile_pk(char* vt, int lane, const v4u* w) {
    char* p = vt + (lane >> 4) * 1024 + ((lane >> 3) & 1) * 512 + (lane & 7) * 64;
#pragma unroll
    for (int c = 0; c < 8; ++c) *(v4u*)(p + (c >> 2) * 4096 + (c & 3) * 16) = w[c];
}
__device__ __forceinline__ void phase_c(KA a, Frame& F, int l) {
    relane(F);
    unsigned char* ws = a->ws;
    const bf16* Z = (const bf16*)(ws + WS_Z);
    unsigned char* qkv = ws + WS_QKV;
    const f32x2* TA_R = (const f32x2*)(ws + WS_TAB + TAB_AROW); const f32x2* TA_C = (const f32x2*)(ws + WS_TAB + TAB_ACOL);
    const f32x2* TG_R = (const f32x2*)(ws + WS_TAB + TAB_GROW); const f32x2* TG_C = (const f32x2*)(ws + WS_TAB + TAB_GCOL);
    const int gw = F.vcu * NWAVES + F.wave, NGW = F.G * NWAVES, lane = F.lane;
    for (int id = gw; id < 528 * 32; id += NGW) {
        const int tile = id % 528, job = id / 528;
        const int b = tile / NKT, tt = tile % NKT; const bool isc = tt >= 128;
        const int zrow = isc ? LROWS + b * CL + (tt - 128) * 64 + lane : b * SEQ + tt * 64 + lane;
        const int tok = tt * 64 + lane;
        const bf16* zr = Z + (size_t)zrow * ZP;
        const f32x2* tar = TA_R + (isc ? 0 : tt) * 8; const f32x2* tac = TA_C + lane * 8;
        const f32x2* tgr = TG_R + (isc ? 0 : tt) * 16; const f32x2* tgc = TG_C + lane * 16;
        MEMFENCE();
        if (job < 4) {
            const int h = job;
            const float r1 = rsqrtf(ssq_row<256>(zr) * (1.0f / 256.0f) + EPSF);
            MEMFENCE();
            v4u w[12]; float ss = 0.f;
#pragma unroll
            for (int c = 0; c < 12; ++c) { w[c] = *(const v4u*)(zr + ZQ + h * 96 + 8 * c); ss += ssq8(w[c]); }
            MEMFENCE();
            const float r = r1 * rsqrtf(ss * r1 * r1 * (1.0f / 96.0f) + EPSF); const float* g = a->in[I_GMQ] + l * 96;
            const float qs = 0.10206207261596575f * LOG2E;
            bf16* q = (bf16*)(qkv + QO_QM) + ((size_t)(b * 4 + h) * NTOKB + tok) * 96;
#pragma unroll
            for (int c = 0; c < 12; ++c) {
                v4u o;
                if (c < 8 || isc) o = proc8<false>(w[c], r, g + 8 * c, nullptr, qs);
                else o = proc8<true>(w[c], r, g + 8 * c, (c < 10) ? tar + 4 * (c - 8) : tac + 4 * (c - 10), qs);
                *(v4u*)(q + 8 * c) = o; MEMFENCE(); }
        } else if (job < 8) {
            const int h = job - 4;
            const float r1 = rsqrtf(ssq_row<128>(zr + 256) * (1.0f / 128.0f) + EPSF);
            MEMFENCE();
            v4u w[12]; float ss = 0.f, s2 = 0.f;
#pragma unroll
            for (int c = 0; c < 8; ++c) { w[c] = *(const v4u*)(zr + ZKV + h * 128 + 8 * c); ss += ssq8(w[c]); }
#pragma unroll
            for (int c = 0; c < 4; ++c) { w[8 + c] = *(const v4u*)(zr + 384 + 8 * c); s2 += ssq8(w[8 + c]); }
            MEMFENCE();
            const float r2 = rsqrtf((ss * r1 * r1 + s2) * (1.0f / 96.0f) + EPSF); const float* g = a->in[I_GMK] + l * 96;
            char* kt = (char*)(qkv + QO_KM) + ((size_t)(b * 4 + h) * NKT + tt) * 12288 + lane * 16;
#pragma unroll
            for (int c = 0; c < 12; ++c) {
                v4u o;
                if (c < 8) o = proc8<false>(w[c], r1 * r2, g + 8 * c, nullptr, 1.0f);
                else if (isc) o = proc8<false>(w[c], r2, g + 8 * c, nullptr, 1.0f);
                else o = proc8<true>(w[c], r2, g + 8 * c, (c < 10) ? tar + 4 * (c - 8) : tac + 4 * (c - 10), 1.0f);
                *(v4u*)(kt + c * 1024) = o; MEMFENCE(); }
            v4u vw[8];
#pragma unroll
            for (int c = 0; c < 8; ++c) vw[c] = scale8(*(const v4u*)(zr + ZKV + h * 128 + 64 + 8 * c), r1);
            store_v_tile_pk((char*)(qkv + QO_VM) + ((size_t)(b * 4 + h) * NKT + tt) * 8192, lane, vw);
        } else if (job < 16) {
            const bool isk = job >= 12; const int h = (job - 8) & 3;
            const bf16* zp = zr + (isk ? 672 : 416) + h * 64; const float* g = (isk ? a->in[I_GDK] : a->in[I_GDQ]) + l * 32;
            const float qs = isk ? 1.0f : 0.17677669529663687f * LOG2E;
            v4u w[8]; float ss[2] = {0.f, 0.f};
#pragma unroll
            for (int c = 0; c < 8; ++c) { w[c] = *(const v4u*)(zp + 8 * c); ss[c >> 2] += ssq8(w[c]); }
            MEMFENCE();
            const float r0 = rsqrtf(ss[0] * (1.0f / 32.0f) + EPSF), r1 = rsqrtf(ss[1] * (1.0f / 32.0f) + EPSF);
            char* kt = (char*)(qkv + QO_KD) + ((size_t)(b * 4 + h) * NKT + tt) * 8192 + lane * 16;
            bf16* q = (bf16*)(qkv + QO_QD) + ((size_t)(b * 4 + h) * NTOKB + tok) * 64;
#pragma unroll
            for (int c = 0; c < 8; ++c) { const int cm = c & 3;
                v4u o;
                if (isc) o = proc8<false>(w[c], (c < 4) ? r0 : r1, g + 8 * cm, nullptr, qs);
                else o = proc8<true>(w[c], (c < 4) ? r0 : r1, g + 8 * cm, (cm < 2) ? tar + 4 * cm : tac + 4 * (cm - 2), qs);
                if (isk) *(v4u*)(kt + c * 1024) = o; else *(v4u*)(q + 8 * c) = o;
                MEMFENCE(); }
        } else if (job < 20) {
            const int h = job - 16; v4u vw[8];
#pragma unroll
            for (int c = 0; c < 8; ++c) vw[c] = *(const v4u*)(zr + 928 + h * 64 + 8 * c);
            store_v_tile_pk((char*)(qkv + QO_VD) + ((size_t)(b * 4 + h) * NKT + tt) * 8192, lane, vw);
        } else if (job < 30) {
            const bool isk = job >= 28; const int h = isk ? job - 28 : job - 20;
            const bf16* zp = zr + (isk ? 1696 : 1184) + h * 64; const float* g = (isk ? a->in[I_GGK] : a->in[I_GGQ]) + l * 64;
            const float qs = isk ? 1.0f : 0.125f * LOG2E;
            v4u w[8]; float ss = 0.f;
#pragma unroll
            for (int c = 0; c < 8; ++c) { w[c] = *(const v4u*)(zp + 8 * c); ss += ssq8(w[c]); }
            MEMFENCE();
            const float r = rsqrtf(ss * (1.0f / 64.0f) + EPSF);
            char* kt = (char*)(qkv + QO_KG) + ((size_t)(b * 2 + h) * NKT + tt) * 8192 + lane * 16;
            bf16* q = (bf16*)(qkv + QO_QG) + ((size_t)(b * 8 + h) * NTOKB + tok) * 64;
#pragma unroll
            for (int c = 0; c < 8; ++c) {
                v4u o;
                if (isc) o = proc8<false>(w[c], r, g + 8 * c, nullptr, qs);
                else o = proc8<true>(w[c], r, g + 8 * c, (c < 4) ? tgr + 4 * c : tgc + 4 * (c - 4), qs);
                if (isk) *(v4u*)(kt + c * 1024) = o; else *(v4u*)(q + 8 * c) = o;
                MEMFENCE(); }
        } else {
            const int h = job - 30; v4u vw[8];
#pragma unroll
            for (int c = 0; c < 8; ++c) vw[c] = *(const v4u*)(zr + 1824 + h * 64 + 8 * c);
            store_v_tile_pk((char*)(qkv + QO_VG) + ((size_t)(b * 2 + h) * NKT + tt) * 8192, lane, vw);
        }
        MEMFENCE();
    }
}

#if MK_NAIVE_ATTN
#define ATT_UNIT(KD, NM) att::attn_unit_naive<KD, NM>
#define ATT_DIFF att::attn_unit_naive<64, 2>
#elif MK_ATT_V1
#define ATT_UNIT(KD, NM) att::attn_unit<KD, NM>
#define ATT_DIFF att::attn_unit<64, 2>
#else
#define ATT_UNIT(KD, NM) att::attn_unit_p<KD, NM, ABL>
#define ATT_DIFF att::attn_unit_p<32, 2, ABL>
#endif
template <int ABL>
__device__ __forceinline__ void phase_d(KA a, Frame& F, int l, bool last) {
    relane(F);
    unsigned char* ws = a->ws; unsigned char* qkv = ws + WS_QKV;
    bf16* ATT = (bf16*)(ws + (ABL ? WS_Z : WS_ATT));
    const float* LAM = (const float*)(ws + WS_LAM);
    const float lam = LAM[2 * l], oml = 1.0f - LAM[2 * l + 1];
    const float* gdo = a->in[I_GDO] + l * 64;
    ALDS char* lds = (ALDS char*)F.lds;
    const int nctx = last ? 0 : 64;
    for (int id = F.vcu; id < 512 + nctx; id += F.G) {
        int b, h, q0, t0, t1; size_t orow;
        if (id < 512) { const int x = (id & 255) >> 5; b = x >> 1; h = 2 * (x & 1) + (id >> 8); q0 = (id & 31) * 256; t0 = 0; t1 = NKT; orow = (size_t)b * SEQ + q0; }
        else { const int c = id - 512; b = c >> 4; h = c & 15; if (h >= 4) continue; q0 = SEQ; t0 = 128; t1 = NKT; orow = (size_t)LROWS + b * CL; }
        ATT_UNIT(96, 1)((const bf16*)(qkv + QO_QM) + ((size_t)(b * 4 + h) * NTOKB + q0) * 96, (const char*)(qkv + QO_KM) + (size_t)(b * 4 + h) * NKT * 12288,
                        (const char*)(qkv + QO_VM) + (size_t)(b * 4 + h) * NKT * 8192, t0, t1, ATT + orow * 1024 + h * 64, lds, 0.f, gdo, 0.f);
    }
    for (int id = 512 + F.vcu; id < 1024 + nctx; id += F.G) {
        int b, h, q0, t0, t1; size_t orow;
        if (id < 1024) { const int x = (id & 255) >> 5; b = x >> 1; h = 2 * (x & 1) + ((id >> 8) - 2); q0 = (id & 31) * 256; t0 = 0; t1 = NKT; orow = (size_t)b * SEQ + q0; }
        else { const int c = id - 1024; b = c >> 4; h = (c & 15) - 4; if (h < 0 || h >= 4) continue; q0 = SEQ; t0 = 128; t1 = NKT; orow = (size_t)LROWS + b * CL; }
        ATT_DIFF((const bf16*)(qkv + QO_QD) + ((size_t)(b * 4 + h) * NTOKB + q0) * 64, (const char*)(qkv + QO_KD) + (size_t)(b * 4 + h) * NKT * 8192,
                        (const char*)(qkv + QO_VD) + (size_t)(b * 4 + h) * NKT * 8192, t0, t1, ATT + orow * 1024 + 256 + h * 64, lds, lam, gdo, oml);
    }
    for (int id = 1024 + F.vcu; id < 2048 + nctx; id += F.G) {
        int b, h, q0, t0, t1; size_t orow;
        if (id < 2048) { const int x = (id & 255) >> 5; b = x >> 1; h = 4 * (x & 1) + ((id >> 8) - 4); q0 = (id & 31) * 256; t0 = 0; t1 = NKT; orow = (size_t)b * SEQ + q0; }
        else { const int c = id - 2048; b = c >> 4; h = (c & 15) - 8; if (h < 0) continue; q0 = SEQ; t0 = 128; t1 = NKT; orow = (size_t)LROWS + b * CL; }
        const int g = h >> 2;
        ATT_UNIT(64, 1)((const bf16*)(qkv + QO_QG) + ((size_t)(b * 8 + h) * NTOKB + q0) * 64, (const char*)(qkv + QO_KG) + (size_t)(b * 2 + g) * NKT * 8192,
                        (const char*)(qkv + QO_VG) + (size_t)(b * 2 + g) * NKT * 8192, t0, t1, ATT + orow * 1024 + 512 + h * 64, lds, 0.f, gdo, 0.f);
    }
}

__device__ __forceinline__ void phase_f(KA a, Frame& F, int l, bool last) {
    relane(F);
    unsigned char* ws = a->ws;
    const float* MOD = (const float*)(ws + WS_MOD);
    float* AFF = (float*)(ws + WS_AFF); float* AFFC = (float*)(ws + WS_AFFC); int* INV = (int*)(ws + WS_INV);
    LAS float* wrT = (LAS float*)F.lds;
    const float* wr = a->in[I_WR] + (size_t)l * 1024 * 16;
    for (int idx = F.tid; idx < 16384; idx += NWAVES * 64) wrT[(idx & 15) * 1024 + (idx >> 4)] = wr[idx];
    __syncthreads();
    const int nrows = last ? LROWS : MROWS;
    const int gw = F.vcu * NWAVES + F.wave, NGW = F.G * NWAVES;
    for (int row = gw; row < nrows; row += NGW) {
        const bool isc = row >= LROWS; const int v = isc ? 4 : (row >> 13);
        f32x4 hv[4]; float ss = 0.f;
        bf16* xb = (bf16*)(ws + WS_XB) + (size_t)row * 1024;
        const bf16* dl = (const bf16*)(ws + WS_DELTA) + (size_t)row * 1024;
#pragma unroll
        for (int j = 0; j < 4; ++j) { const int c0 = 4 * F.lane + 256 * j; const v2u w = *(const v2u*)(dl + c0), xw = *(const v2u*)(xb + c0);
            hv[j] = (f32x4){bflo(xw.x), bfhi(xw.x), bflo(xw.y), bfhi(xw.y)} + (f32x4){bflo(w.x), bfhi(w.x), bflo(w.y), bfhi(w.y)};
            v2u o; o.x = pk2(hv[j].x, hv[j].y); o.y = pk2(hv[j].z, hv[j].w); *(v2u*)(xb + c0) = o;
            ss += (hv[j].x * hv[j].x + hv[j].y * hv[j].y) + (hv[j].z * hv[j].z + hv[j].w * hv[j].w); }
        const float rstd = rsqrtf(wave_sum(ss) * (1.0f / 1024.0f) + EPSF);
        const float* g2 = a->in[I_GN2] + l * 1024; const float* sh = MOD + (l * 5 + v) * 6144 + 3 * 1024; const float* sc = sh + 1024;
#pragma unroll
        for (int j = 0; j < 4; ++j) { const int c0 = 4 * F.lane + 256 * j; const f32x4 g = *(const f32x4*)(g2 + c0), s1 = *(const f32x4*)(sc + c0), b1 = *(const f32x4*)(sh + c0);
            hv[j] = hv[j] * rstd * g * (1.0f + s1) + b1; }
        {
            float am = 0.f;
#pragma unroll
            for (int j = 0; j < 4; ++j) am = fmaxf(fmaxf(am, fmaxf(fabsf(hv[j].x), fabsf(hv[j].y))), fmaxf(fabsf(hv[j].z), fabsf(hv[j].w)));
#pragma unroll
            for (int o = 1; o < 64; o <<= 1) am = fmaxf(am, __shfl_xor(am, o));
            const float qs = am > 0.f ? 127.0f / am : 0.f;
            signed char* h8 = (signed char*)(ws + WS_H) + (size_t)row * 1024;
#pragma unroll
            for (int j = 0; j < 4; ++j) { const int q0 = (int)__builtin_rintf(hv[j].x * qs), q1 = (int)__builtin_rintf(hv[j].y * qs), q2 = (int)__builtin_rintf(hv[j].z * qs), q3 = (int)__builtin_rintf(hv[j].w * qs);
                *(unsigned*)(h8 + 4 * F.lane + 256 * j) = (unsigned)(q0 & 255) | ((unsigned)(q1 & 255) << 8) | ((unsigned)(q2 & 255) << 16) | ((unsigned)(q3 & 255) << 24); }
            if (F.lane == 0) ((float*)(ws + WS_SA))[row] = am * (1.0f / 127.0f);
        }
        float p[16];
#pragma unroll
        for (int e = 0; e < 16; ++e) { float s = 0.f;
#pragma unroll
            for (int j = 0; j < 4; ++j) { const f32x4 w = *(const LAS f32x4*)(wrT + e * 1024 + 4 * F.lane + 256 * j); s += (hv[j].x * w.x + hv[j].y * w.y) + (hv[j].z * w.z + hv[j].w * w.w); }
            p[e] = s; if ((e & 3) == 3) MEMFENCE(); }
        float r8[8], r4[4], r2[2], lgt;
        { const bool hb = (F.lane & 32) != 0;
#pragma unroll
          for (int j = 0; j < 8; ++j) { const float keep = hb ? p[8 + j] : p[j], send = hb ? p[j] : p[8 + j]; r8[j] = keep + __shfl_xor(send, 32); } }
        { const bool hb = (F.lane & 16) != 0;
#pragma unroll
          for (int j = 0; j < 4; ++j) { const float keep = hb ? r8[4 + j] : r8[j], send = hb ? r8[j] : r8[4 + j]; r4[j] = keep + __shfl_xor(send, 16); } }
        { const bool hb = (F.lane & 8) != 0;
#pragma unroll
          for (int j = 0; j < 2; ++j) { const float keep = hb ? r4[2 + j] : r4[j], send = hb ? r4[j] : r4[2 + j]; r2[j] = keep + __shfl_xor(send, 8); } }
        { const bool hb = (F.lane & 4) != 0; const float keep = hb ? r2[1] : r2[0], send = hb ? r2[0] : r2[1]; lgt = keep + __shfl_xor(send, 4); }
        lgt += __shfl_xor(lgt, 1); lgt += __shfl_xor(lgt, 2);
        float mx = lgt;
#pragma unroll
        for (int o = 4; o < 64; o <<= 1) mx = fmaxf(mx, __shfl_xor(mx, o));
        const float ex = __builtin_amdgcn_exp2f((lgt - mx) * LOG2E);
        float sum = ex;
#pragma unroll
        for (int o = 4; o < 64; o <<= 1) sum += __shfl_xor(sum, o);
        const float mine = ex / sum;
        const int ee = ((F.lane >> 5) & 1) * 8 + ((F.lane >> 4) & 1) * 4 + ((F.lane >> 3) & 1) * 2 + ((F.lane >> 2) & 1);
        if ((F.lane & 3) == 0) {
            if (isc) { const int r = row - LROWS; AFFC[((size_t)((r >> 8) * 16 + ee)) * CL + (r & 255)] = mine; }
            else AFF[((size_t)((row >> 13) * 16 + ee)) * SEQ + (row & 8191)] = mine;
            INV[(size_t)row * 16 + ee] = -1;
        }
    }
}

__device__ __forceinline__ void topk_set(Frame& F, const float* __restrict__ src, int n, int k, int rowbase, int slotbase, int e, int* IDX, float* GATE, int* INV) {
    LAS unsigned* keys = (LAS unsigned*)F.lds; LAS unsigned* hist = keys + 8192; LAS unsigned* sc = hist + 256;
    const int tid = F.tid;
    for (int i = tid; i < n; i += NWAVES * 64) keys[i] = __float_as_uint(src[i]);
    if (tid == 0) { sc[0] = 0u; sc[1] = (unsigned)k; }
    __syncthreads();
    for (int pass = 0; pass < 4; ++pass) {
        const int shift = 24 - 8 * pass; const unsigned mask = (pass == 0) ? 0u : (0xFFFFFFFFu << (shift + 8));
        if (tid < 256) hist[tid] = 0u;
        __syncthreads();
        const unsigned prefix = sc[0];
        for (int i = tid; i < n; i += NWAVES * 64) { const unsigned kv = keys[i]; if ((kv & mask) == prefix) __hip_atomic_fetch_add(&hist[(kv >> shift) & 255u], 1u, __ATOMIC_RELAXED, __HIP_MEMORY_SCOPE_WORKGROUP); }
        __syncthreads();
        if (F.wave == 0) {
            const unsigned need = sc[1]; unsigned h[4]; unsigned tot = 0u;
#pragma unroll
            for (int j = 0; j < 4; ++j) { h[j] = hist[255 - (4 * F.lane + j)]; tot += h[j]; }
            unsigned incl = tot;
#pragma unroll
            for (int d = 1; d < 64; d <<= 1) { const unsigned t = __shfl_up(incl, d); if (F.lane >= d) incl += t; }
            unsigned cum = incl - tot;
#pragma unroll
            for (int j = 0; j < 4; ++j) { if (cum < need && need <= cum + h[j]) { sc[0] = prefix | ((unsigned)(255 - (4 * F.lane + j)) << shift); sc[1] = need - cum; } cum += h[j]; }
        }
        __syncthreads();
    }
    const unsigned T = sc[0], need_eq = sc[1];
    const int per = (n + NWAVES * 64 - 1) / (NWAVES * 64), start = tid * per;
    unsigned cg = 0u, ce = 0u;
    for (int j = 0; j < per; ++j) { const int i = start + j; if (i < n) { const unsigned kv = keys[i]; cg += (kv > T) ? 1u : 0u; ce += (kv == T) ? 1u : 0u; } }
    const unsigned packed = cg | (ce << 16);
    unsigned incl = packed;
#pragma unroll
    for (int d = 1; d < 64; d <<= 1) { const unsigned t = __shfl_up(incl, d); if (F.lane >= d) incl += t; }
    if (F.lane == 63) sc[8 + F.wave] = incl;
    __syncthreads();
    unsigned base = 0u;
    for (int w = 0; w < F.wave; ++w) base += sc[8 + w];
    const unsigned excl = base + incl - packed;
    unsigned gb = excl & 0xFFFFu, eb = excl >> 16;
    for (int j = 0; j < per; ++j) { const int i = start + j; if (i < n) { const unsigned kv = keys[i]; const bool g = kv > T, q = kv == T;
        if (g || (q && eb < need_eq)) { const int slot = slotbase + (int)(gb + (eb < need_eq ? eb : need_eq)); IDX[slot] = rowbase + i; GATE[slot] = __uint_as_float(kv); INV[(size_t)(rowbase + i) * 16 + e] = slot; }
        gb += g ? 1u : 0u; eb += q ? 1u : 0u; } }
    __syncthreads();
}
__device__ __forceinline__ void phase_g(KA a, Frame& F, int l, bool last, int rep) {
    relane(F);
    unsigned char* ws = a->ws;
    const float* AFF = (const float*)(ws + WS_AFF); const float* AFFC = (const float*)(ws + WS_AFFC);
    int* IDX = (int*)(ws + WS_IDX); float* GATE = (float*)(ws + WS_GATE); int* INV = (int*)(ws + WS_INV);
    const int RPE = last ? 4096 : 4352, nsets = last ? 64 : 128;
    for (int set = blockIdx.x; set < nsets; set += F.G) {
        if (set < 64) { const int b = set >> 4, e = set & 15; topk_set(F, AFF + (size_t)set * SEQ, SEQ, CAPL, b * SEQ, e * RPE + b * CAPL, e, IDX, GATE, INV); }
        else { const int s2 = set - 64, b = s2 >> 4, e = s2 & 15; topk_set(F, AFFC + (size_t)s2 * CL, CL, CAPC, LROWS + b * CL, e * RPE + 4096 + b * CAPC, e, IDX, GATE, INV);
            if (b == 0 && F.tid < 128) { IDX[e * RPE + 4224 + F.tid] = -1; GATE[e * RPE + 4224 + F.tid] = 0.f; } }
    }
    {
        LAS float* scr = (LAS float*)(F.lds + 40960 + F.wave * 8704);
        gu32* head = F.ctl + CW_Q + 64 * l + 128 * rep;
        constexpr int NIT = NE * 3072;
        const float* wg = a->in[I_WG] + (size_t)l * NE * 1024 * 2048; const float* wu = a->in[I_WU] + (size_t)l * NE * 1024 * 2048; const float* wd = a->in[I_WD] + (size_t)l * NE * 2048 * 1024;
        bf16* WD = (bf16*)(ws + WS_WD); const float* SWL = (const float*)(ws + WS_SW) + l * 32;
        for (;;) {
            unsigned basev = 0u;
            if (F.lane == 0) basev = __hip_atomic_fetch_add(head, 8u, RLX_AGENT);
            const int base = __builtin_amdgcn_readfirstlane((int)basev);
            if (base >= NIT) break;
            for (int j = 0; j < 8; ++j) { const int it = base + j; const int e = it / 3072, r = it % 3072, which = r >> 10, ii = r & 1023;
                if (which < 2) { const int kb = ii >> 6, nb = ii & 63, n0 = nb * 32; const int rowbase = (n0 >> 7) * 256 + (n0 & 127) + which * 128;
                    transpose_item_i8((which ? wu : wg) + (size_t)e * 1024 * 2048, 2048, (signed char*)(ws + WS_WGU) + (size_t)e * 4096 * 1024, 1024, kb * 64, n0, rowbase, 1.0f / SWL[2 * e + which], scr, F.lane); }
                else { const int kb = ii >> 5, nb = ii & 31, n0 = nb * 32;
                    transpose_item(wd + (size_t)e * 2048 * 1024, 1024, WD + (size_t)e * 1024 * 2048, 2048, kb * 64, n0, n0, scr, F.lane); } }
        }
    }
}

__device__ __forceinline__ void phase_h(KA a, Frame& F, bool last) {
    relane(F);
    unsigned char* ws = a->ws;
    const int* IDX = (const int*)(ws + WS_IDX); const unsigned char* H8 = (const unsigned char*)(ws + WS_H); unsigned char* XE = (unsigned char*)(ws + WS_XE);
    const float* SA = (const float*)(ws + WS_SA); float* SAE = (float*)(ws + WS_SAE);
    const int nrow = NE * (last ? 4096 : 4352);
    const int gw = F.vcu * NWAVES + F.wave, NGW = F.G * NWAVES;
    for (int r = gw; r < nrow; r += NGW) {
        const int s = __builtin_amdgcn_readfirstlane(IDX[r]);
        v4u v0 = (v4u){0u, 0u, 0u, 0u}; float sc = 0.f;
        if (s >= 0) { v0 = ((const v4u*)(H8 + (size_t)s * 1024))[F.lane]; sc = SA[s]; }
        ((v4u*)(XE + (size_t)r * 1024))[F.lane] = v0;
        if (F.lane == 0) SAE[r] = sc;
    }
}
__global__ void __launch_bounds__(NWAVES * 64, 2) mk_fwd(Args args) {
    extern __shared__ __attribute__((aligned(16))) unsigned char lds[];
    Frame F;
    F.lds = (LAS unsigned char*)lds;
    F.MISC = (volatile LAS unsigned*)(F.lds + MISC_OFF);
    F.tid = threadIdx.x; F.lane = F.tid & 63; F.wave = __builtin_amdgcn_readfirstlane(F.tid >> 6);
    F.G = gridDim.x; { const int bx = blockIdx.x; F.vcu = (F.G % 8 == 0) ? (bx % 8) * (F.G / 8) + bx / 8 : bx; }
    F.ctl = (gu32*)(args.ws + WS_CTL);
    for (int u = F.tid; u < (LDS_BYTES - LDSCTL_OFF) / 4; u += NWAVES * 64) ((LAS unsigned*)(F.lds + LDSCTL_OFF))[u] = 0u;
    __syncthreads();
    const int lo = args.ph_lo, hi = args.ph_hi;
    const bool multi = (hi - lo) > 1;
    XcdBarrier bar; bar.bar = (unsigned*)(F.ctl + CW_BAR); bar.x = 0; bar.st = nullptr;
    if (multi) bar = xcd_barrier_post((unsigned*)(F.ctl + CW_BAR), F.MISC + 8);
#define IN(k) (lo <= (k) && (k) < hi)
#define SEAM(k) do { if (IN((k) + 1)) xcd_barrier(bar); } while (0)
#define REP(kind) (((MK_REP) >> (kind)) & 1)
#define RUNPH(kind, k, ...) do { if (IN(k)) { for (int rep_ = 0; rep_ <= REP(kind); ++rep_) { __VA_ARGS__; if (rep_ < REP(kind)) xcd_barrier(bar); } SEAM(k); } } while (0)

    RUNPH(0, 0, p0_prologue(kargs(), F));

    for (int l = 0; l < NLAYER; ++l) {
        const bool last = (l == NLAYER - 1);
        const int pb = 1 + 10 * l;
        const int RPE = last ? 4096 : 4352;
        if (IN(pb + 0)) { for (int rep_ = 0; rep_ <= (l == 0 ? REP(1) : 0); ++rep_) { phase_a(kargs(), F, l); if (rep_ < REP(1) && l == 0) xcd_barrier(bar); } SEAM(pb + 0); }
        if (IN(pb + 1)) { for (int rep_ = 0; rep_ <= REP(2); ++rep_) {
            KA ka = kargs(); unsigned char* ws = ka->ws;
            pg8::Gemm g{(const pg8::bf16_t*)(ws + WS_H), (const pg8::bf16_t*)(ws + WS_WCAT) + (size_t)l * ZP * 1024, MROWS, ZP, DM, 1 << 30, 0};
            pg8::StaticOrder S; S.init(MROWS, ZP, F.G, (int)blockIdx.x);
            pg8::EpiStoreBf16 E{(pg8::bf16_t*)(ws + WS_Z), ZP};
            pg8::gemm_phase<pg8::EpiStoreBf16, pg8::StaticOrder, true, true>(F.lds, g, S, E);
            if (rep_ < REP(2)) xcd_barrier(bar); }
            SEAM(pb + 1);
        }
        RUNPH(3, pb + 2, phase_c(kargs(), F, l));
        RUNPH(4, pb + 3, phase_d<0>(kargs(), F, l, last); if (MK_ABL) { xcd_barrier(bar); phase_d<MK_ABL>(kargs(), F, l, last); });
        if (IN(pb + 4)) { for (int rep_ = 0; rep_ <= REP(5); ++rep_) {
            KA ka = kargs(); unsigned char* ws = ka->ws; const float* MODL = (const float*)(ws + WS_MOD) + (size_t)l * 5 * 6144;
            const int M = last ? LROWS : MROWS;
            pg8::Gemm g{(const pg8::bf16_t*)(ws + WS_ATT), (const pg8::bf16_t*)(ws + WS_WO) + (size_t)l * 1024 * 1024, M, DM, DM, 1 << 30, 0};
            pg8::StaticOrder S; S.init(M, DM, F.G, (int)blockIdx.x);
            pg8::EpiColGateBf16 E{(pg8::bf16_t*)(ws + WS_DELTA), DM, MODL, LROWS};
            pg8::gemm_phase<pg8::EpiColGateBf16, pg8::StaticOrder, true, true>(F.lds, g, S, E);
            if (rep_ < REP(5)) xcd_barrier(bar); }
            SEAM(pb + 4);
        }
        RUNPH(6, pb + 5, phase_f(kargs(), F, l, last));
        RUNPH(7, pb + 6, phase_g(kargs(), F, l, last, rep_));
        RUNPH(8, pb + 7, phase_h(kargs(), F, last));
        if (IN(pb + 8)) { for (int rep_ = 0; rep_ <= REP(9); ++rep_) {
            KA ka = kargs(); unsigned char* ws = ka->ws;
            pg8::Gemm g{(const pg8::bf16_t*)(ws + WS_XE), (const pg8::bf16_t*)(ws + WS_WGU), NE * RPE, 2 * FFD, DM / 2, RPE / 256, (size_t)2 * FFD * DM};
            pg8::StaticOrder S; S.init(NE * RPE, 2 * FFD, F.G, (int)blockIdx.x);
            pg8::EpiSwiGLUI8 E{(pg8::bf16_t*)(ws + WS_HID), FFD, (const float*)(ws + WS_SAE), (const float*)(ws + WS_SW) + l * 32, RPE / 256};
            pg8::gemm_phase<pg8::EpiSwiGLUI8, pg8::StaticOrder, true, true, true>(F.lds, g, S, E);
            if (rep_ < REP(9)) xcd_barrier(bar); }
            SEAM(pb + 8);
        }
        if (IN(pb + 9)) { for (int rep_ = 0; rep_ <= REP(10); ++rep_) {
            KA ka = kargs(); unsigned char* ws = ka->ws;
            pg8::Gemm g{(const pg8::bf16_t*)(ws + WS_HID), (const pg8::bf16_t*)(ws + WS_WD), NE * RPE, DM, FFD, RPE / 256, (size_t)DM * FFD * 2};
            pg8::StaticOrder S; S.init(NE * RPE, DM, F.G, (int)blockIdx.x);
            pg8::EpiRowScaleBf16 E{(pg8::bf16_t*)(ws + WS_YE), DM, (const float*)(ws + WS_GATE)};
            pg8::gemm_phase<pg8::EpiRowScaleBf16, pg8::StaticOrder, true, true>(F.lds, g, S, E);
            if (rep_ < REP(10)) xcd_barrier(bar); }
            SEAM(pb + 9);
        }
    }
    if (IN(N_PHASES - 1)) phase_a(kargs(), F, NLAYER);
#undef IN
#undef SEAM
}

extern "C" void kernel_launch(void* const* d_in, const int* in_sizes, int n_in, void* d_out, int out_size, void* d_ws, size_t ws_size, hipStream_t stream) {
    static int grid = 0;
    if (grid == 0) {
        if (n_in != N_IN || out_size != LROWS * DM || ws_size < WS_END) { fprintf(stderr, "kernel_launch: unexpected shapes (n_in %d, out %d, ws %zu); nothing launched\n", n_in, out_size, ws_size); grid = -1; return; }
        int dev = 0, cus = 0, per_cu = 0;
        if (hipGetDevice(&dev) != hipSuccess || hipDeviceGetAttribute(&cus, hipDeviceAttributeMultiprocessorCount, dev) != hipSuccess) { grid = -1; return; }
        if (hipFuncSetAttribute((const void*)mk_fwd, hipFuncAttributeMaxDynamicSharedMemorySize, LDS_BYTES) != hipSuccess) { fprintf(stderr, "kernel_launch: hipFuncSetAttribute failed\n"); grid = -1; return; }
        if (hipOccupancyMaxActiveBlocksPerMultiprocessor(&per_cu, (const void*)mk_fwd, NWAVES * 64, LDS_BYTES) != hipSuccess || per_cu < 1) { fprintf(stderr, "kernel_launch: occupancy query reports %d blocks per CU\n", per_cu); }
        (void)hipGetLastError();
        grid = cus;
    }
    if (grid < 0) return;
    if (hipMemsetAsync((char*)d_ws + WS_CTL, 0, CTL_ZERO_BYTES, stream) != hipSuccess) { fprintf(stderr, "kernel_launch: memset failed\n"); return; }
    Args a{};
    for (int i = 0; i < N_IN; ++i) a.in[i] = (const float*)d_in[i];
    a.out = (float*)d_out; a.ws = (unsigned char*)d_ws;
#if MK_SPLIT
    for (int ph = 0; ph < N_PHASES; ++ph) { a.ph_lo = ph; a.ph_hi = ph + 1; hipLaunchKernelGGL(mk_fwd, dim3(grid), dim3(NWAVES * 64), LDS_BYTES, stream, a); }
#else
    a.ph_lo = 0; a.ph_hi = N_PHASES;
    hipLaunchKernelGGL(mk_fwd, dim3(grid), dim3(NWAVES * 64), LDS_BYTES, stream, a);
#endif
    const hipError_t le = hipPeekAtLastError();
    if (le != hipSuccess) fprintf(stderr, "kernel_launch: launch failed: %s\n", hipGetErrorName(le));
}
```

```cpp
#include <hip/hip_runtime.h>
#include <hip/hip_bf16.h>
#include <cstdio>
#include <cstdint>
#ifndef MK_SPLIT
#define MK_SPLIT 0
#endif
#ifndef MK_REP
#define MK_REP 0
#endif
#ifndef MK_NOEPI
#define MK_NOEPI 0
#endif
#ifndef MK_ABL
#define MK_ABL 0
#endif
namespace pg8 {
#define PG8_LAS __attribute__((address_space(3)))
typedef unsigned short bf16_t;
typedef short bf16x8 __attribute__((ext_vector_type(8)));
typedef float f32x4 __attribute__((ext_vector_type(4)));
typedef unsigned u32x4 __attribute__((ext_vector_type(4)));
constexpr int BM = 256, BK = 64, HALF = 128, HTB = HALF * BK * 2  , STAGE_BYTES = 8 * HTB, NXCD = 8, WGM = 8;

__host__ __device__ __forceinline__ int lds_byte(int r, int c) { const int st = (r >> 4) * 2 + (c >> 5), rr = r & 15, cc = c & 31, ob = rr * 64 + cc * 2; return st * 1024 + (ob ^ (((ob >> 9) & 1) << 5)); }
__host__ __device__ __forceinline__ void stage_rc(int b, int& R, int& C) { const int st = b / 1024, sb = b % 1024, swz = sb ^ (((sb >> 9) & 1) << 5); R = (st >> 1) * 16 + swz / 64; C = (st & 1) * 32 + (swz % 64) / 2; }
__host__ __device__ __forceinline__ int perm32(int rho) { const int n = rho >> 4, i = rho & 15; return 8 * (i >> 2) + 4 * n + (i & 3); }

struct Unit { int pm, pn, li; };
struct Gemm { const bf16_t* A; const bf16_t* Bt; int M, N, K; int tpe; size_t bgs; const int* gidx = nullptr; };

struct StaticOrder {
    int nM, nN, nwg, G, c;
    __host__ __device__ void init(int M, int N, int G_, int c_) { nM = M / BM; nN = N / BM; nwg = nM * nN; G = G_; c = c_; }
    __host__ __device__ bool next(int i, Unit& u) const {
        const long L = (long)i * G + c; if (L >= nwg) return false;
        int wgid = (int)L; { const int q = nwg / NXCD, r = nwg % NXCD, xcd = wgid % NXCD, off = wgid / NXCD; wgid = (xcd < r ? xcd * (q + 1) : r * (q + 1) + (xcd - r) * q) + off; }
        const int nig = WGM * nN, gid = wgid / nig, fm = gid * WGM, gsz = (nM - fm) < WGM ? (nM - fm) : WGM;
        u.pm = fm + ((wgid % nig) % gsz); u.pn = (wgid % nig) / gsz; u.li = i; return true;
    }
    __device__ __forceinline__ void a_ready(const Unit&) const {}
    __device__ __forceinline__ void done(const Unit&) const {}
};
typedef int i32x4 __attribute__((ext_vector_type(4)));
__device__ __forceinline__ unsigned cvt_pk_bf16(float lo, float hi) { unsigned r; asm volatile("v_cvt_pk_bf16_f32 %0, %1, %2" : "=v"(r) : "v"(lo), "v"(hi)); return r; }
constexpr int GTAB_OFF = STAGE_BYTES + 2048, RTAB_OFF = GTAB_OFF + 17 * BM * 2, TAB_UNITS = 17;
template <class Sched> __device__ __forceinline__ void fill_rtab(PG8_LAS unsigned char* lds, const Sched& S, const float* rowv, int tid) {
    PG8_LAS float* rt = (PG8_LAS float*)(lds + RTAB_OFF); Unit uu;
    for (int i = 0; i < TAB_UNITS && S.next(i, uu); ++i) { if (tid < BM) rt[i * BM + tid] = rowv[uu.pm * BM + tid]; } }
struct EpiStoreBf16 {
    static constexpr bool PERM = true, AFTER_DRAIN = false;
    bf16_t* O; int ldc;
    template <class Sched> __device__ __forceinline__ void prefill(PG8_LAS unsigned char*, const Sched&, int) const {}
    __device__ __forceinline__ void operator()(const f32x4 (&acc)[2][2][4][2], const Unit& u, int wr, int wc, int fr, int fq, PG8_LAS unsigned char* lds) const {
        const int row0 = u.pm * BM + wr * 64 + fr, col0 = u.pn * BM + wc * 32 + 8 * fq;
#pragma unroll
        for (int ai = 0; ai < 2; ++ai)
#pragma unroll
            for (int m = 0; m < 4; ++m) { bf16_t* rowp = O + (size_t)(row0 + ai * HALF + m * 16) * ldc + col0;
#pragma unroll
                for (int bj = 0; bj < 2; ++bj) { const f32x4 v0 = acc[ai][bj][m][0], v1 = acc[ai][bj][m][1];
                    u32x4 w; w.x = cvt_pk_bf16(v0[0], v0[1]); w.y = cvt_pk_bf16(v0[2], v0[3]); w.z = cvt_pk_bf16(v1[0], v1[1]); w.w = cvt_pk_bf16(v1[2], v1[3]);
                    *(u32x4*)(rowp + bj * HALF) = w; } }
    }
};
struct EpiStoreBf16I8 {
    static constexpr bool PERM = true, AFTER_DRAIN = false;
    bf16_t* O; int ldc; const float* sa; const float* sw; float* ssq;
    template <class Sched> __device__ __forceinline__ void prefill(PG8_LAS unsigned char* lds, const Sched& S, int tid) const { fill_rtab(lds, S, sa, tid); }
    __device__ __forceinline__ void operator()(const i32x4 (&acc)[2][2][4][2], const Unit& u, int wr, int wc, int fr, int fq, PG8_LAS unsigned char* lds) const {
        const int row0 = u.pm * BM + wr * 64 + fr, col0 = u.pn * BM + wc * 32 + 8 * fq;
        f32x4 cs[2][2];
#pragma unroll
        for (int bj = 0; bj < 2; ++bj)
#pragma unroll
            for (int n = 0; n < 2; ++n) cs[bj][n] = *(const f32x4*)(sw + col0 + bj * HALF + 4 * n);
#pragma unroll
        for (int ai = 0; ai < 2; ++ai)
#pragma unroll
            for (int m = 0; m < 4; ++m) { const int row = row0 + ai * HALF + m * 16; const float rs = (u.li < TAB_UNITS) ? ((const PG8_LAS float*)(lds + RTAB_OFF))[u.li * BM + (row - u.pm * BM)] : sa[row]; bf16_t* rowp = O + (size_t)row * ldc + col0;
#pragma unroll
                for (int bj = 0; bj < 2; ++bj) { const i32x4 a0 = acc[ai][bj][m][0], a1 = acc[ai][bj][m][1]; const f32x4 c0 = cs[bj][0] * rs, c1 = cs[bj][1] * rs;
                    const float z0 = (float)a0[0] * c0[0], z1 = (float)a0[1] * c0[1], z2 = (float)a0[2] * c0[2], z3 = (float)a0[3] * c0[3];
                    const float z4 = (float)a1[0] * c1[0], z5 = (float)a1[1] * c1[1], z6 = (float)a1[2] * c1[2], z7 = (float)a1[3] * c1[3];
                    u32x4 w; w.x = cvt_pk_bf16(z0, z1); w.y = cvt_pk_bf16(z2, z3); w.z = cvt_pk_bf16(z4, z5); w.w = cvt_pk_bf16(z6, z7);
                    *(u32x4*)(rowp + bj * HALF) = w;
                    if (u.pn == 0 || (u.pn == 1 && bj == 0)) {
                        float q = ((z0 * z0 + z1 * z1) + (z2 * z2 + z3 * z3)) + ((z4 * z4 + z5 * z5) + (z6 * z6 + z7 * z7));
                        q += __shfl_xor(q, 16); q += __shfl_xor(q, 32);
                        if (fq == 0) ssq[(size_t)row * 12 + (u.pn == 0 ? bj * 4 + wc : 8 + wc)] = q; } } }
    }
};
struct EpiColGateBf16 {
    static constexpr bool PERM = true, AFTER_DRAIN = false;
    bf16_t* O; int ldc; const float* mod; int lrows;
    template <class Sched> __device__ __forceinline__ void prefill(PG8_LAS unsigned char*, const Sched&, int) const {}
    __device__ __forceinline__ void operator()(const f32x4 (&acc)[2][2][4][2], const Unit& u, int wr, int wc, int fr, int fq, PG8_LAS unsigned char* lds) const {
        const int R0 = u.pm * BM; const int v = (R0 >= lrows) ? 4 : (R0 >> 13);
        const float* ga = mod + v * 6144 + 2 * 1024;
        const int row0 = R0 + wr * 64 + fr, col0 = u.pn * BM + wc * 32 + 8 * fq;
        f32x4 g[2][2];
#pragma unroll
        for (int bj = 0; bj < 2; ++bj)
#pragma unroll
            for (int n = 0; n < 2; ++n) g[bj][n] = *(const f32x4*)(ga + col0 + bj * HALF + 4 * n);
#pragma unroll
        for (int ai = 0; ai < 2; ++ai)
#pragma unroll
            for (int m = 0; m < 4; ++m) { bf16_t* rowp = O + (size_t)(row0 + ai * HALF + m * 16) * ldc + col0;
#pragma unroll
                for (int bj = 0; bj < 2; ++bj) { const f32x4 v0 = acc[ai][bj][m][0] * g[bj][0], v1 = acc[ai][bj][m][1] * g[bj][1];
                    u32x4 w; w.x = cvt_pk_bf16(v0[0], v0[1]); w.y = cvt_pk_bf16(v0[2], v0[3]); w.z = cvt_pk_bf16(v1[0], v1[1]); w.w = cvt_pk_bf16(v1[2], v1[3]);
                    *(u32x4*)(rowp + bj * HALF) = w; } }
    }
};
__device__ __forceinline__ float silu_mul(float g, float u) { return g * __builtin_amdgcn_rcpf(1.0f + __builtin_amdgcn_exp2f(-1.4426950408889634f * g)) * u; }
struct EpiSwiGLU {
    static constexpr bool PERM = true, AFTER_DRAIN = false;
    bf16_t* O; int ldc;
    template <class Sched> __device__ __forceinline__ void prefill(PG8_LAS unsigned char*, const Sched&, int) const {}
    __device__ __forceinline__ void operator()(const f32x4 (&acc)[2][2][4][2], const Unit& u, int wr, int wc, int fr, int fq, PG8_LAS unsigned char* lds) const {
        const int row0 = u.pm * BM + wr * 64 + fr, col0 = u.pn * HALF + wc * 32 + 8 * fq;
#pragma unroll
        for (int ai = 0; ai < 2; ++ai)
#pragma unroll
            for (int m = 0; m < 4; ++m) { const f32x4 g0 = acc[ai][0][m][0], g1 = acc[ai][0][m][1], u0 = acc[ai][1][m][0], u1 = acc[ai][1][m][1];
                u32x4 w; w.x = cvt_pk_bf16(silu_mul(g0[0], u0[0]), silu_mul(g0[1], u0[1])); w.y = cvt_pk_bf16(silu_mul(g0[2], u0[2]), silu_mul(g0[3], u0[3]));
                w.z = cvt_pk_bf16(silu_mul(g1[0], u1[0]), silu_mul(g1[1], u1[1])); w.w = cvt_pk_bf16(silu_mul(g1[2], u1[2]), silu_mul(g1[3], u1[3]));
                *(u32x4*)(O + (size_t)(row0 + ai * HALF + m * 16) * ldc + col0) = w; }
    }
};
__device__ __forceinline__ float clamp448(float x) { return fminf(fmaxf(x, -448.0f), 448.0f); }
struct EpiSwiGLUI8 {
    static constexpr bool PERM = true, AFTER_DRAIN = false;
    unsigned char* O; int ldc; const float* sa; const float* sw; int tpe; float hs;
    template <class Sched> __device__ __forceinline__ void prefill(PG8_LAS unsigned char* lds, const Sched& S, int tid) const { fill_rtab(lds, S, sa, tid); }
    __device__ __forceinline__ void operator()(const i32x4 (&acc)[2][2][4][2], const Unit& u, int wr, int wc, int fr, int fq, PG8_LAS unsigned char* lds) const {
        const int row0 = u.pm * BM + wr * 64 + fr, col0 = u.pn * HALF + wc * 32 + 8 * fq; const int e = u.pm / tpe;
        const float sg = sw[3 * e], su = sw[3 * e + 1] * hs;
#pragma unroll
        for (int ai = 0; ai < 2; ++ai)
#pragma unroll
            for (int m = 0; m < 4; ++m) { const int row = row0 + ai * HALF + m * 16; const float rs = (u.li < TAB_UNITS) ? ((const PG8_LAS float*)(lds + RTAB_OFF))[u.li * BM + (row - u.pm * BM)] : sa[row], fg = rs * sg, fu = rs * su;
                const i32x4 g0 = acc[ai][0][m][0], g1 = acc[ai][0][m][1], u0 = acc[ai][1][m][0], u1 = acc[ai][1][m][1];
                typedef float f32x2 __attribute__((ext_vector_type(2)));
                float h[8]; f32x2 gi[4], gu[4], ev[4];
                const float tg = -1.4426950408889634f * fg, fgu = fg * fu;
#pragma unroll
                for (int i = 0; i < 2; ++i) { gi[i] = (f32x2){(float)g0[2 * i], (float)g0[2 * i + 1]}; gi[2 + i] = (f32x2){(float)g1[2 * i], (float)g1[2 * i + 1]};
                    gu[i] = gi[i] * (f32x2){(float)u0[2 * i], (float)u0[2 * i + 1]}; gu[2 + i] = gi[2 + i] * (f32x2){(float)u1[2 * i], (float)u1[2 * i + 1]}; }
                __builtin_amdgcn_sched_barrier(0);
#pragma unroll
                for (int i = 0; i < 4; ++i) { const f32x2 t = gi[i] * tg; ev[i] = (f32x2){__builtin_amdgcn_exp2f(t.x), __builtin_amdgcn_exp2f(t.y)}; }
                __builtin_amdgcn_sched_barrier(0);
#pragma unroll
                for (int i = 0; i < 4; ++i) { const f32x2 d = ev[i] + 1.0f; ev[i] = (f32x2){__builtin_amdgcn_rcpf(d.x), __builtin_amdgcn_rcpf(d.y)}; }
                __builtin_amdgcn_sched_barrier(0);
#pragma unroll
                for (int i = 0; i < 4; ++i) { const f32x2 hv = gu[i] * ev[i] * fgu; h[2 * i] = clamp448(hv.x); h[2 * i + 1] = clamp448(hv.y); }
                int w0 = __builtin_amdgcn_cvt_pk_fp8_f32(h[0], h[1], 0, false); w0 = __builtin_amdgcn_cvt_pk_fp8_f32(h[2], h[3], w0, true);
                int w1 = __builtin_amdgcn_cvt_pk_fp8_f32(h[4], h[5], 0, false); w1 = __builtin_amdgcn_cvt_pk_fp8_f32(h[6], h[7], w1, true);
                typedef unsigned u32x2 __attribute__((ext_vector_type(2)));
                *(u32x2*)(O + (size_t)row * ldc + col0) = (u32x2){(unsigned)w0, (unsigned)w1}; }
    }
};
struct EpiNullI8 {
    static constexpr bool PERM = true, AFTER_DRAIN = false;
    template <class Sched> __device__ __forceinline__ void prefill(PG8_LAS unsigned char*, const Sched&, int) const {}
    __device__ __forceinline__ void operator()(const i32x4 (&acc)[2][2][4][2], const Unit& u, int wr, int wc, int fr, int fq, PG8_LAS unsigned char* lds) const {
#pragma unroll
        for (int ai = 0; ai < 2; ++ai)
#pragma unroll
            for (int bj = 0; bj < 2; ++bj)
#pragma unroll
                for (int m = 0; m < 4; ++m) { asm volatile("" :: "v"(acc[ai][bj][m][0]), "v"(acc[ai][bj][m][1])); }
    }
};
struct EpiRowScaleBf16 {
    static constexpr bool PERM = true, AFTER_DRAIN = false;
    bf16_t* O; int ldc; const float* rs; const float* es; int tpe; float cs;
    template <class Sched> __device__ __forceinline__ void prefill(PG8_LAS unsigned char* lds, const Sched& S, int tid) const { fill_rtab(lds, S, rs, tid); }
    __device__ __forceinline__ void operator()(const f32x4 (&acc)[2][2][4][2], const Unit& u, int wr, int wc, int fr, int fq, PG8_LAS unsigned char* lds) const {
        const int row0 = u.pm * BM + wr * 64 + fr, col0 = u.pn * BM + wc * 32 + 8 * fq;
#pragma unroll
        for (int ai = 0; ai < 2; ++ai)
#pragma unroll
            for (int m = 0; m < 4; ++m) { const int row = row0 + ai * HALF + m * 16; const float s = ((u.li < TAB_UNITS) ? ((const PG8_LAS float*)(lds + RTAB_OFF))[u.li * BM + (row - u.pm * BM)] : rs[row]) * (es[3 * (u.pm / tpe) + 2] * cs); bf16_t* rowp = O + (size_t)row * ldc + col0;
#pragma unroll
                for (int bj = 0; bj < 2; ++bj) { const f32x4 v0 = acc[ai][bj][m][0] * s, v1 = acc[ai][bj][m][1] * s;
                    u32x4 w; w.x = cvt_pk_bf16(v0[0], v0[1]); w.y = cvt_pk_bf16(v0[2], v0[3]); w.z = cvt_pk_bf16(v1[0], v1[1]); w.w = cvt_pk_bf16(v1[2], v1[3]);
                    *(u32x4*)(rowp + bj * HALF) = w; } }
    }
};
typedef int i32x4 __attribute__((ext_vector_type(4)));
typedef int i32x8 __attribute__((ext_vector_type(8)));
template <int MODE> struct AccSel { typedef f32x4 type; };
template <> struct AccSel<1> { typedef i32x4 type; };
template <int MODE> struct Frag { bf16x8 v[2]; __device__ __forceinline__ void set(int k, bf16x8 x) { v[k] = x; } };
template <> struct Frag<2> { i32x8 w; __device__ __forceinline__ void set(int k, bf16x8 x) { const i32x4 y = __builtin_bit_cast(i32x4, x); if (k == 0) w.lo = y; else w.hi = y; } };
template <class Epi, class Sched, bool ALIGN_EPI = false, bool SP2 = false, int MODE = 0, bool GATHER = false>
__device__ __forceinline__ void gemm_phase(PG8_LAS unsigned char* lds, const Gemm g, const Sched& S, const Epi& E) {
    int tid_l = threadIdx.x; asm volatile("" : "+v"(tid_l));
    const int tid = tid_l, wid = __builtin_amdgcn_readfirstlane(tid >> 6), lane = tid & 63, wr = wid >> 2, wc = wid & 3, fr = lane & 15, fq = lane >> 4;
    const int K = g.K, nt = K / BK;
    unsigned voffA[2], voffB[2];
#pragma unroll
    for (int i = 0; i < 2; ++i) { int R, C; stage_rc(tid * 16 + i * 8192, R, C); const int Rb = Epi::PERM ? ((R & ~31) + perm32(R & 31)) : R;
        voffA[i] = (unsigned)(R * K + C) * 2u; voffB[i] = (unsigned)(Rb * K + C) * 2u; }
    static_assert(!GATHER || SP2, "the gathered A operand is wired into the SP2 schedule only");
    unsigned gvc[2][2] = {{0u, 0u}, {0u, 0u}};
    PG8_LAS unsigned short* gtab = (PG8_LAS unsigned short*)(lds + GTAB_OFF);
    if constexpr (GATHER) { Unit uu_;
        for (int i_ = 0; i_ < TAB_UNITS && S.next(i_, uu_); ++i_) { if (tid < BM) { const int ix_ = g.gidx[uu_.pm * BM + tid]; gtab[i_ * BM + tid] = (unsigned short)(ix_ < 0 ? 0 : ix_); } }
    }
    E.prefill(lds, S, tid);
    __syncthreads();
#define PG8_GOFF(ui_, gv_) do { if constexpr (GATHER) { _Pragma("unroll") for (int h_ = 0; h_ < 2; ++h_) _Pragma("unroll") for (int i_ = 0; i_ < 2; ++i_) { int R_, C_; stage_rc(tid * 16 + i_ * 8192, R_, C_); \
        unsigned ix_; if ((ui_) < TAB_UNITS) ix_ = gtab[(ui_) * BM + h_ * HALF + R_]; else { Unit uq_; S.next((ui_), uq_); const int iq_ = g.gidx[uq_.pm * BM + h_ * HALF + R_]; ix_ = iq_ < 0 ? 0u : (unsigned)iq_; } \
        gv_[h_][i_] = ix_ * (unsigned)(K * 2) + (unsigned)C_ * 2u; } } } while (0)
    const size_t kstep = (size_t)(BK * 2);
    const size_t hstep = (size_t)HALF * K * 2;
    const size_t tstep = 2 * hstep;
    const unsigned ldsw = (unsigned)wid * 1024u;
    const int aoff = lds_byte(wr * 64 + fr, fq * 8), boff = lds_byte(wc * 32 + fr, fq * 8);
#define PG8_SA(b, h) (((b) * 2 + (h)) * HTB)
#define PG8_SB(b, h) ((4 + (b) * 2 + (h)) * HTB)
#define PG8_STAGE(bufoff, gbase, voff) do { _Pragma("unroll") for (int _i = 0; _i < 2; ++_i) \
        __builtin_amdgcn_global_load_lds((const unsigned*)((const char*)(gbase) + (voff)[_i]), (PG8_LAS unsigned*)(lds + (bufoff) + ldsw + _i * 8192), 16, 0, 0); } while (0)
#define PG8_STAGE_A(bufoff, gbase, h_, nx_) do { if constexpr (GATHER) PG8_STAGE(bufoff, gbase, gvc[h_]); else PG8_STAGE(bufoff, (gbase) + (h_) * hstep, voffA); } while (0)
#define PG8_LDA(dst, b, h) do { _Pragma("unroll") for (int m = 0; m < 4; ++m) _Pragma("unroll") for (int k = 0; k < 2; ++k) dst[m].set(k, *(const PG8_LAS bf16x8*)(lds + PG8_SA(b, h) + aoff + m * 2048 + k * 1024)); } while (0)
#define PG8_LDB(dst, b, h) do { _Pragma("unroll") for (int n = 0; n < 2; ++n) _Pragma("unroll") for (int k = 0; k < 2; ++k) dst[n].set(k, *(const PG8_LAS bf16x8*)(lds + PG8_SB(b, h) + boff + n * 2048 + k * 1024)); } while (0)
#define PG8_MMA(ai, bj, At, Bt) do { __builtin_amdgcn_s_setprio(1); _Pragma("unroll") for (int m = 0; m < 4; ++m) _Pragma("unroll") for (int n = 0; n < 2; ++n) { \
        if constexpr (MODE == 2) { asm volatile("v_mfma_f32_16x16x128_f8f6f4 %0, %1, %2, %0" : "+v"(acc[ai][bj][m][n]) : "v"(Bt[n].w), "v"(At[m].w)); }     \
        else { _Pragma("unroll") for (int k = 0; k < 2; ++k) { \
          if constexpr (MODE == 1) acc[ai][bj][m][n] = __builtin_amdgcn_mfma_i32_16x16x64_i8(__builtin_bit_cast(i32x4, Bt[n].v[k]), __builtin_bit_cast(i32x4, At[m].v[k]), acc[ai][bj][m][n], 0, 0, 0); \
          else acc[ai][bj][m][n] = __builtin_amdgcn_mfma_f32_16x16x32_bf16(Bt[n].v[k], At[m].v[k], acc[ai][bj][m][n], 0, 0, 0); } } } __builtin_amdgcn_s_setprio(0); } while (0)
#define PG8_WAIT_V(n) asm volatile("s_waitcnt vmcnt(" #n ")" ::: "memory")
#define PG8_WAIT_L(n) asm volatile("s_waitcnt lgkmcnt(" #n ")" ::: "memory")
#define PG8_BAR __builtin_amdgcn_s_barrier()
#define PG8_SCHED __builtin_amdgcn_sched_barrier(0)
    Unit cur, nxt; int ui = 0;
    if (!S.next(0, cur)) return;
    typedef typename AccSel<MODE>::type acc_t; const acc_t acc_zero = {};
    acc_t acc[2][2][4][2];
#pragma unroll
    for (int a = 0; a < 2; ++a)
#pragma unroll
        for (int b = 0; b < 2; ++b)
#pragma unroll
            for (int m = 0; m < 4; ++m)
#pragma unroll
                for (int n = 0; n < 2; ++n) acc[a][b][m][n] = acc_zero;
    Frag<MODE> At[4], B0[2], B1[2];
    const char* cA = (const char*)g.A + (GATHER ? (size_t)0 : (size_t)cur.pm * tstep); PG8_GOFF(0, gvc); const char* cB = (const char*)g.Bt + (size_t)(cur.pm / g.tpe) * g.bgs + (size_t)cur.pn * tstep;
    S.a_ready(cur);
    if constexpr (SP2) {
        PG8_STAGE(PG8_SB(0, 0), cB, voffB); PG8_STAGE(PG8_SB(0, 1), cB + hstep, voffB); PG8_STAGE_A(PG8_SA(0, 0), cA, 0, false); PG8_STAGE_A(PG8_SA(0, 1), cA, 1, false);
        if (wr == 1) PG8_BAR;
        PG8_WAIT_V(2); PG8_BAR;
        PG8_STAGE(PG8_SB(1, 0), cB + kstep, voffB); PG8_STAGE_A(PG8_SA(1, 0), cA + kstep, 0, false); PG8_STAGE(PG8_SB(1, 1), cB + hstep + kstep, voffB);
        PG8_WAIT_V(6); PG8_BAR;
    } else {
        PG8_STAGE(PG8_SB(0, 0), cB, voffB); PG8_STAGE(PG8_SA(0, 0), cA, voffA); PG8_STAGE(PG8_SB(0, 1), cB + hstep, voffB); PG8_STAGE(PG8_SA(0, 1), cA + hstep, voffA);
        if (wr == 1) PG8_BAR;
        PG8_WAIT_V(4); PG8_BAR;
        PG8_STAGE(PG8_SB(1, 0), cB + kstep, voffB); PG8_STAGE(PG8_SA(1, 0), cA + kstep, voffA); PG8_STAGE(PG8_SB(1, 1), cB + hstep + kstep, voffB);
        PG8_WAIT_V(6); PG8_BAR;
    }
    for (;;) {
        const bool has_next = S.next(ui + 1, nxt);
        const char* nA = (has_next && !GATHER) ? (const char*)g.A + (size_t)nxt.pm * tstep : cA; const char* nB = has_next ? (const char*)g.Bt + (size_t)(nxt.pm / g.tpe) * g.bgs + (size_t)nxt.pn * tstep : cB;
        for (int t = 0; t < nt; t += 2) {
            const bool last = (t == nt - 2); const bool nxu = last && has_next;
            const char* a1 = cA + (size_t)(t + 1) * kstep;
            const char* a2 = last ? nA : cA + (size_t)(t + 2) * kstep; const char* b2 = last ? nB : cB + (size_t)(t + 2) * kstep;
            const char* a3 = a2 + kstep; const char* b3 = b2 + kstep;
            if (last && has_next) S.a_ready(nxt);
            if constexpr (SP2) {
            PG8_LDB(B0, 0, 0); PG8_LDB(B1, 0, 1); PG8_SCHED; PG8_LDA(At, 0, 0); PG8_STAGE_A(PG8_SA(1, 1), a1, 1, false); if (nxu) PG8_GOFF(ui + 1, gvc);
            PG8_WAIT_V(8); PG8_WAIT_L(0); PG8_BAR; PG8_MMA(0, 0, At, B0); PG8_MMA(0, 1, At, B1); PG8_BAR; PG8_SCHED;
            PG8_LDA(At, 0, 1); PG8_STAGE(PG8_SB(0, 0), b2, voffB); PG8_STAGE(PG8_SB(0, 1), b2 + hstep, voffB); PG8_STAGE_A(PG8_SA(0, 0), a2, 0, nxu);
            PG8_WAIT_V(8); PG8_WAIT_L(0); PG8_BAR; PG8_MMA(1, 0, At, B0); PG8_MMA(1, 1, At, B1); PG8_BAR; PG8_SCHED;
            PG8_LDB(B0, 1, 0); PG8_LDB(B1, 1, 1); PG8_SCHED; PG8_LDA(At, 1, 0); PG8_STAGE_A(PG8_SA(0, 1), a2, 1, nxu);
            PG8_WAIT_V(8); PG8_WAIT_L(0); PG8_BAR; PG8_MMA(0, 0, At, B0); PG8_MMA(0, 1, At, B1); PG8_BAR; PG8_SCHED;
            PG8_LDA(At, 1, 1); PG8_STAGE(PG8_SB(1, 0), b3, voffB); PG8_STAGE(PG8_SB(1, 1), b3 + hstep, voffB); PG8_STAGE_A(PG8_SA(1, 0), a3, 0, nxu);
            PG8_WAIT_V(8); PG8_WAIT_L(0); PG8_BAR; PG8_MMA(1, 0, At, B0); PG8_MMA(1, 1, At, B1); PG8_BAR; PG8_SCHED;
            } else {
            PG8_LDB(B0, 0, 0); PG8_SCHED; PG8_LDA(At, 0, 0); PG8_STAGE(PG8_SA(1, 1), a1 + hstep, voffA);
            PG8_WAIT_L(8); PG8_BAR; PG8_WAIT_L(0); PG8_MMA(0, 0, At, B0); PG8_BAR; PG8_SCHED;
            PG8_LDB(B1, 0, 1); PG8_STAGE(PG8_SB(0, 0), b2, voffB);
            PG8_BAR; PG8_WAIT_L(0); PG8_MMA(0, 1, At, B1); PG8_BAR;
            PG8_LDA(At, 0, 1); PG8_STAGE(PG8_SA(0, 0), a2, voffA);
            PG8_BAR; PG8_WAIT_L(0); PG8_MMA(1, 0, At, B0); PG8_BAR; PG8_SCHED;
            PG8_STAGE(PG8_SB(0, 1), b2 + hstep, voffB);
            PG8_WAIT_V(6); PG8_BAR; PG8_MMA(1, 1, At, B1); PG8_BAR;
            PG8_LDB(B0, 1, 0); PG8_SCHED; PG8_LDA(At, 1, 0); PG8_STAGE(PG8_SA(0, 1), a2 + hstep, voffA);
            PG8_WAIT_L(8); PG8_BAR; PG8_WAIT_L(0); PG8_MMA(0, 0, At, B0); PG8_BAR; PG8_SCHED;
            PG8_LDB(B1, 1, 1); PG8_STAGE(PG8_SB(1, 0), b3, voffB);
            PG8_BAR; PG8_WAIT_L(0); PG8_MMA(0, 1, At, B1); PG8_BAR;
            PG8_LDA(At, 1, 1); PG8_STAGE(PG8_SA(1, 0), a3, voffA);
            PG8_BAR; PG8_WAIT_L(0); PG8_MMA(1, 0, At, B0); PG8_BAR; PG8_SCHED;
            PG8_STAGE(PG8_SB(1, 1), b3 + hstep, voffB);
            PG8_WAIT_V(6); PG8_BAR; PG8_MMA(1, 1, At, B1); PG8_BAR;
            }
        }
        if constexpr (ALIGN_EPI) { if (wr == 0) PG8_BAR; }
        if constexpr (!Epi::AFTER_DRAIN) { E(acc, cur, wr, wc, fr, fq, lds); S.done(cur); }
        if (!has_next) break;
#pragma unroll
        for (int a = 0; a < 2; ++a)
#pragma unroll
            for (int b = 0; b < 2; ++b)
#pragma unroll
                for (int m = 0; m < 4; ++m)
#pragma unroll
                    for (int n = 0; n < 2; ++n) acc[a][b][m][n] = acc_zero;
        cur = nxt; cA = nA; cB = nB; ++ui;
        if constexpr (ALIGN_EPI) { if (wr == 1) PG8_BAR; }
    }
    PG8_WAIT_V(0);
    if constexpr (!ALIGN_EPI) { if (wr == 0) PG8_BAR; }
    PG8_BAR;
    if constexpr (Epi::AFTER_DRAIN) { E.fused(acc, cur, wr, wc, fr, fq, lds, wid, lane); S.done(cur); }
#undef PG8_SA
#undef PG8_SB
#undef PG8_STAGE
#undef PG8_STAGE_A
#undef PG8_GOFF
#undef PG8_LDA
#undef PG8_LDB
#undef PG8_MMA
#undef PG8_WAIT_V
#undef PG8_WAIT_L
#undef PG8_BAR
#undef PG8_SCHED
}
}
namespace att {
typedef unsigned short bf16_t;
typedef short bf16x8 __attribute__((ext_vector_type(8)));
typedef short s16x4 __attribute__((ext_vector_type(4)));
typedef float f32x16 __attribute__((ext_vector_type(16)));
typedef float f32x4 __attribute__((ext_vector_type(4)));
typedef unsigned u32x4 __attribute__((ext_vector_type(4)));
typedef unsigned u32x2 __attribute__((ext_vector_type(2)));
#define ALDS __attribute__((address_space(3)))
typedef float f32x2_t __attribute__((ext_vector_type(2))); typedef __bf16 bf16x2_t __attribute__((ext_vector_type(2)));
__device__ __forceinline__ unsigned cvtpk(float lo, float hi) { f32x2_t v = {lo, hi}; bf16x2_t b = __builtin_convertvector(v, bf16x2_t); return __builtin_bit_cast(unsigned, b); }
__device__ __forceinline__ float bf2f(unsigned short u) { return __uint_as_float((unsigned)u << 16); }
template <int S> __device__ __forceinline__ bf16x8 pack8(const f32x16& x) {
    u32x4 p; p.x = cvtpk(x[8 * S + 0], x[8 * S + 1]); p.y = cvtpk(x[8 * S + 2], x[8 * S + 3]); p.z = cvtpk(x[8 * S + 4], x[8 * S + 5]); p.w = cvtpk(x[8 * S + 6], x[8 * S + 7]);
    return __builtin_bit_cast(bf16x8, p);
}
typedef short v4i16_t __attribute__((ext_vector_type(4)));
__device__ __forceinline__ s16x4 vtr(const ALDS char* p) { return __builtin_bit_cast(s16x4, __builtin_amdgcn_ds_read_tr16_b64_v4i16((ALDS v4i16_t*)p)); }
__device__ __forceinline__ int crow(int r, int hi) { return (r & 3) + 8 * (r >> 2) + 4 * hi; }
constexpr int ATT_LDS_BYTES = 2 * 12288 + 2 * 8192;

__device__ __forceinline__ void glds16(const void* gsrc, unsigned lds_dst) { unsigned keep;
    asm volatile("s_mov_b32 %0, m0\n\ts_mov_b32 m0, %2\n\ts_nop 0\n\tglobal_load_lds_dwordx4 %1, off\n\ts_mov_b32 m0, %0" : "=&s"(keep) : "v"(gsrc), "s"(lds_dst) : "memory"); }
__device__ __forceinline__ void glds16s(const char* sbase, unsigned voff, unsigned lds_dst) { unsigned keep;
    asm volatile("s_mov_b32 %0, m0\n\ts_mov_b32 m0, %3\n\ts_nop 0\n\tglobal_load_lds_dwordx4 %1, %2\n\ts_mov_b32 m0, %0" : "=&s"(keep) : "v"(voff), "s"(sbase), "s"(lds_dst) : "memory"); }
#define ATT_SBAR() __builtin_amdgcn_sched_barrier(0)
#define ATT_PIN(x) asm volatile("" : "+v"(x))
typedef int i32x2a __attribute__((ext_vector_type(2)));
typedef int i32x4a __attribute__((ext_vector_type(4)));
typedef int i32x6a __attribute__((ext_vector_type(6)));
typedef int i32x8a __attribute__((ext_vector_type(8)));
typedef unsigned u32x16 __attribute__((ext_vector_type(16)));
typedef __bf16 bf16x32_t __attribute__((ext_vector_type(32)));
__device__ __forceinline__ i32x6a cvt_fp6x32(const u32x16& w) { return __builtin_bit_cast(i32x6a, __builtin_amdgcn_cvt_scalef32_pk32_fp6_bf16(__builtin_bit_cast(bf16x32_t, w), 1.0f)); }
#define ATT_MF6_Z(C, A, B, SA, SB) asm volatile("v_mfma_scale_f32_32x32x64_f8f6f4 %0, %1, %2, 0, %3, %4 op_sel:[0,0,0] op_sel_hi:[0,0,0] cbsz:2 blgp:2" : "=&v"(C) : "v"(A), "v"(B), "v"(SA), "v"(SB))
#define ATT_MF6_A(C, A, B, SA, SB) asm volatile("v_mfma_scale_f32_32x32x64_f8f6f4 %0, %1, %2, %0, %3, %4 op_sel:[0,0,0] op_sel_hi:[0,0,0] cbsz:2 blgp:2" : "+v"(C) : "v"(A), "v"(B), "v"(SA), "v"(SB))
#define ATT_MF6_C(C, A, B, C0, SA, SB) asm volatile("v_mfma_scale_f32_32x32x64_f8f6f4 %0, %1, %2, %3, %4, %5 op_sel:[0,0,0] op_sel_hi:[0,0,0] cbsz:2 blgp:2" : "=&v"(C) : "v"(A), "v"(B), "v"(C0), "v"(SA), "v"(SB))
template <int DK> struct KCfg { static constexpr int NG = (DK == 96) ? 3 : 2, KTB = (DK == 96) ? 5120 : 3072, QRB = 24 * NG, NF = (DK == 96) ? 2 : 1, NRD = 4 * NF, PB = NG * 1024,
                                                      SCL = (DK == 32) ? 0x77777777 : 0x76767676, NB = (DK == 32) ? 2 : 4; };
constexpr float FQ96 = 4.0f * 1.4426950408889634f * 0.10206207261596575f * 2.0f, FQ32 = 4.0f * 1.4426950408889634f * 0.17677669529663687f, FQ64 = 4.0f * 1.4426950408889634f * 0.125f * 2.0f;
constexpr float P_BIAS = 44.0f / 256.0f;
constexpr int KC_A = 0, KC_B = 1024;
template <int DK>
__device__ __forceinline__ void kread6(i32x6a (&kf)[2][KCfg<DK>::NF], const ALDS char* pA0, const ALDS char* pB0, const ALDS char* pA1, const ALDS char* pB1, int idx) {
    constexpr int NF = KCfg<DK>::NF;
    const int mt = idx / (2 * NF), f = (idx / 2) % NF, part = idx & 1;
    const ALDS char* pA = f ? pA1 : pA0; const ALDS char* pB = f ? pB1 : pB0;
    if (part == 0) { const i32x4a v = *(const ALDS i32x4a*)(pA + mt * 512); kf[mt][f][0] = v.x; kf[mt][f][1] = v.y; kf[mt][f][2] = v.z; kf[mt][f][3] = v.w; }
    else { const i32x2a v = *(const ALDS i32x2a*)(pB + mt * 256); kf[mt][f][4] = v.x; kf[mt][f][5] = v.y; }
}
#define ATT_PV8(C, A, B) asm volatile("s_nop 3\n\tv_mfma_f32_32x32x64_f8f6f4 %0, %1, %2, %0 cbsz:0 blgp:1" : "+v"(C) : "v"(A), "v"(B))
#define ATT_L8(C, A, B) asm volatile("s_nop 3\n\tv_mfma_f32_16x16x128_f8f6f4 %0, %1, %2, %0 cbsz:0 blgp:1" : "+v"(C) : "v"(A), "v"(B))
#define ATT_L8N(C, A, B) asm volatile("v_mfma_f32_16x16x128_f8f6f4 %0, %1, %2, %0 cbsz:0 blgp:1" : "+v"(C) : "v"(A), "v"(B))
#define ATT_PV8N(C, A, B) asm volatile("v_mfma_f32_32x32x64_f8f6f4 %0, %1, %2, %0 cbsz:0 blgp:1" : "+v"(C) : "v"(A), "v"(B))
typedef unsigned short u16x2 __attribute__((ext_vector_type(2)));
__device__ __forceinline__ unsigned pk4_bf8(float a, float b, float c, float d) {
    const u16x2 x = __builtin_amdgcn_cvt_pknorm_u16(a, b), y = __builtin_amdgcn_cvt_pknorm_u16(c, d);
    return __builtin_amdgcn_perm(__builtin_bit_cast(unsigned, y), __builtin_bit_cast(unsigned, x), 0x07050301u); }
struct KPtr { const ALDS char *a0, *b0, *a1, *b1; };
template <int DK, int VLOAD, int ABL = 0, class DF>
__device__ __forceinline__ void att_step9(f32x16& N0, f32x16& N1, const f32x16& P0, const f32x16& P1, i32x6a (&kf)[2][KCfg<DK>::NF], const i32x6a* qfn,
                                          f32x16 (&o)[2], f32x4& L, const i32x8a& pwP, i32x8a& pwC, i32x8a (&vf)[2], const i32x8a& ones, const f32x16& cb, const int& sa, const int& sb,
                                          const ALDS char* vcur, const KPtr k1, const KPtr k0, DF&& dmaf) {
    constexpr int NF = KCfg<DK>::NF;
#define ATP_PACK(i) do { if (!(ABL & 4)) { const int e = 4 * (i); \
        int w = (int)((e < 16) ? pk4_bf8(P0[e & 15], P0[(e + 1) & 15], P0[(e + 2) & 15], P0[(e + 3) & 15]) : pk4_bf8(P1[e & 15], P1[(e + 1) & 15], P1[(e + 2) & 15], P1[(e + 3) & 15])); \
        ATT_PIN(w); pwC[i] = w; } } while (0)
    ATT_SBAR();
    ATT_PV8N(o[0], vf[0], pwP);
    dmaf();
#pragma unroll
    for (int k = 2 * NF; k < 4 * NF; ++k) { if (!(ABL & 8)) kread6<DK>(kf, k1.a0, k1.b0, k1.a1, k1.b1, k); }
#pragma unroll
    for (int i = 0; i < 4; ++i) ATP_PACK(i);
    ATT_SBAR();
    ATT_PV8N(o[1], vf[1], pwP);
    if (VLOAD && !(ABL & 8)) { vf[0].lo = *(const ALDS i32x4a*)(vcur); vf[0].hi = *(const ALDS i32x4a*)(vcur + 1024); }
#pragma unroll
    for (int i = 4; i < 8; ++i) ATP_PACK(i);
    ATT_SBAR();
    ATT_L8N(L, ones, pwP);
    if (VLOAD && !(ABL & 8)) { vf[1].lo = *(const ALDS i32x4a*)(vcur + 512); vf[1].hi = *(const ALDS i32x4a*)(vcur + 512 + 1024); }
    ATT_SBAR();
    if (DK == 64) { ATT_MF6_C(N0, kf[0][0], qfn[0], cb, sa, sb); ATT_MF6_C(N1, kf[1][0], qfn[0], cb, sa, sb); }
    else if (NF == 1) { ATT_MF6_Z(N0, kf[0][0], qfn[0], sa, sb); ATT_MF6_Z(N1, kf[1][0], qfn[0], sa, sb); }
    else { ATT_MF6_Z(N0, kf[0][0], qfn[0], sa, sb); ATT_MF6_Z(N1, kf[1][0], qfn[0], sa, sb); ATT_MF6_A(N0, kf[0][1], qfn[1], sa, sb); ATT_MF6_A(N1, kf[1][1], qfn[1], sa, sb); }
    ATT_SBAR();
#pragma unroll
    for (int k = 0; k < 2 * NF; ++k) { if (!(ABL & 8)) kread6<DK>(kf, k0.a0, k0.b0, k0.a1, k0.b1, k); }
    ATT_SBAR();
#undef ATP_PACK
}
template <int DK, int NMAP, int ABL = 0>
__device__ __forceinline__ void attn_unit_f8(const unsigned char* __restrict__ Qb, const char* __restrict__ Kt, const char* __restrict__ Vt, int t0, int t1,
                                             bf16_t* __restrict__ Ob, ALDS char* lds, float lam, const float* __restrict__ gout, float oml) {
    typedef KCfg<DK> KC;
    constexpr int KTB = KC::KTB, NF = KC::NF, NRD = KC::NRD, LV = 8 * KTB, CB = LV + 8 * 4096, NKP = KTB / 1024, NP = NKP + 4, NDMA = (NP + 7) / 8;
    int tid_l = threadIdx.x; asm volatile("" : "+v"(tid_l));
    const int tid = tid_l, lane = tid & 63, r32 = lane & 31, hi = lane >> 5, wid = __builtin_amdgcn_readfirstlane(tid >> 6);
    i32x6a qbias;
    { u32x16 vq, vk; unsigned pq = 0x40B040B0u, pk = 0x40804080u;
      asm volatile("" : "+v"(pq), "+v"(pk));
#pragma unroll
      for (int r = 0; r < 16; ++r) { vq[r] = (2 * r < KC::NB) ? pq : 0u; vk[r] = (2 * r < KC::NB) ? pk : 0u; }
      qbias = cvt_fp6x32(vq);
      if (DK != 64 && tid == 0) { const i32x6a kb = cvt_fp6x32(vk); const i32x4a ka = {kb[0], kb[1], kb[2], kb[3]}; const i32x2a kc = {kb[4], kb[5]};
          *(ALDS i32x4a*)(lds + CB + KC_A) = ka; *(ALDS i32x4a*)(lds + CB + KC_A + 512) = ka; *(ALDS i32x2a*)(lds + CB + KC_B) = kc; *(ALDS i32x2a*)(lds + CB + KC_B + 256) = kc; } }
    i32x6a qf[NMAP][NF];
    { const unsigned char* qrow = Qb + (size_t)(wid * 32 + r32) * KC::QRB;
#define ATP_QG(dst, off) do { const i32x2a a_ = *(const i32x2a*)(qrow + (off)), b_ = *(const i32x2a*)(qrow + (off) + 8), c_ = *(const i32x2a*)(qrow + (off) + 16); \
          dst[0] = a_.x; dst[1] = a_.y; dst[2] = b_.x; dst[3] = b_.y; dst[4] = c_.x; dst[5] = c_.y; } while (0)
      if (DK == 64) { ATP_QG(qf[0][0], 24 * hi); }
      else if (DK == 96) { ATP_QG(qf[0][0], 24 * hi); i32x6a t; ATP_QG(t, 48);
#pragma unroll
          for (int r = 0; r < 6; ++r) qf[0][NF - 1][r] = hi ? qbias[r] : t[r]; }
      else {
#pragma unroll
          for (int m = 0; m < NMAP; ++m) { i32x6a t; ATP_QG(t, 24 * m);
#pragma unroll
              for (int r = 0; r < 6; ++r) qf[m][0][r] = hi ? qbias[r] : t[r]; } }
#undef ATP_QG
    }
#pragma unroll
    for (int m = 0; m < NMAP; ++m)
#pragma unroll
        for (int f = 0; f < NF; ++f) ATT_PIN(qf[m][f]);
    f32x16 o[NMAP][2], cb; f32x4 L[NMAP]; i32x8a pw, ones; int sa = 0x7F7F7F7F, sb = KC::SCL;
    ATT_PIN(sa); ATT_PIN(sb);
#pragma unroll
    for (int r = 0; r < 16; ++r) cb[r] = P_BIAS;
    if (DK == 64) ATT_PIN(cb);
    { const int sel = (lane == 0 || lane == 32 || lane == 17 || lane == 49) ? 0x38383838 : 0;
#pragma unroll
      for (int r = 0; r < 8; ++r) { pw[r] = 0; ones[r] = sel; } }
    ATT_PIN(ones);
#pragma unroll
    for (int m = 0; m < NMAP; ++m) {
#pragma unroll
        for (int r = 0; r < 4; ++r) L[m][r] = 0.f;
#pragma unroll
        for (int d = 0; d < 2; ++d)
#pragma unroll
            for (int r = 0; r < 16; ++r) o[m][d][r] = 0.f; }
#pragma unroll
    for (int m = 0; m < NMAP; ++m) { ATT_PIN(L[m]); ATT_PIN(o[m][0]); ATT_PIN(o[m][1]); }
    const unsigned lds0 = (unsigned)(size_t)lds;
    const char* src0; unsigned dst0; int isv0; const bool act0 = wid < NP;
    { const int p = wid; isv0 = p >= NKP; src0 = (isv0 ? Vt + (p - NKP) * 1024 : Kt + p * 1024); dst0 = lds0 + (isv0 ? LV + (p - NKP) * 1024 : p * 1024); }
    const unsigned lane16 = (unsigned)lane * 16u;
    const bool act1 = (NDMA == 2) && wid == 7;
    const char* src1 = nullptr; unsigned dst1 = 0u;
    if (NDMA == 2) { const int p = 8; src1 = Vt + (p - NKP) * 1024; dst1 = lds0 + LV + (p - NKP) * 1024; }
#define ATP_DMA(tk, tv) do { if (ABL & (2 | 32)) break; \
        if (act0) { if (isv0) glds16s(src0 + (size_t)(tv) * 4096, lane16, (unsigned)__builtin_amdgcn_readfirstlane(dst0 + ((tv) & 7) * 4096)); else glds16s(src0 + (size_t)(tk) * KTB, lane16, (unsigned)__builtin_amdgcn_readfirstlane(dst0 + ((tk) & 7) * KTB)); } \
        if (act1) glds16s(src1 + (size_t)(tv) * 4096, lane16, (unsigned)__builtin_amdgcn_readfirstlane(dst1 + ((tv) & 7) * 4096)); } while (0)
#define ATP_SYNCALL() do { if (ABL & 2) break; if (!(ABL & 128)) { if (act1) asm volatile("s_waitcnt vmcnt(4)" ::: "memory"); else asm volatile("s_waitcnt vmcnt(2)" ::: "memory"); } \
        if (!(ABL & 64)) asm volatile("s_barrier" ::: "memory"); } while (0)
    const bool c0 = (DK == 32) && hi, c1 = hi;
    const int ka0 = c0 ? CB + KC_A : ((DK == 32) ? 0 : hi * 1024) + r32 * 16, kb0 = c0 ? CB + KC_B : KC::PB + ((DK == 32) ? 0 : hi * 512) + r32 * 8, km0 = c0 ? 0 : KTB;
    const int dA = (DK == 32 && !hi) ? 1024 : 0, dB = (DK == 32 && !hi) ? 512 : 0;
    const int ka1 = c1 ? CB + KC_A : 2048 + r32 * 16, kb1 = c1 ? CB + KC_B : KC::PB + 1024 + r32 * 8, km1 = c1 ? 0 : KTB;
#define ATP_KP(t, m) (KPtr{lds + ((t) & 7) * km0 + ka0 + (m) * dA, lds + ((t) & 7) * km0 + kb0 + (m) * dB, lds + ((t) & 7) * km1 + ka1, lds + ((t) & 7) * km1 + kb1})
#define ATP_VB(t) (lds + LV + ((t) & 7) * 4096 + klane64)
#define ATP_KLOAD(t, m) do { const KPtr kp_ = ATP_KP(t, m); _Pragma("unroll") for (int k = 0; k < NRD; ++k) kread6<DK>(kf, kp_.a0, kp_.b0, kp_.a1, kp_.b1, k); \
        asm volatile("s_waitcnt lgkmcnt(0)" ::: "memory"); \
        _Pragma("unroll") for (int mt_ = 0; mt_ < 2; ++mt_) _Pragma("unroll") for (int f_ = 0; f_ < NF; ++f_) ATT_PIN(kf[mt_][f_]);     \
        asm volatile("s_nop 3" ::: "memory"); } while (0)
    const int klane64 = hi * 2048 + r32 * 16;
    ATP_DMA(t0, t0); ATP_DMA(t0 + 1, t0 + 1); ATP_DMA(t0 + 2, t0 + 1); if (NMAP == 1) ATP_DMA(t0 + 3, t0 + 1);
    asm volatile("s_waitcnt vmcnt(0) lgkmcnt(0)\n\ts_barrier" ::: "memory");
    if (NMAP == 1) { ATP_DMA(t0 + 4, t0 + 2); ATP_DMA(t0 + 5, t0 + 3); } else { ATP_DMA(t0 + 3, t0 + 2); ATP_DMA(t0 + 4, t0 + 3); }
    i32x6a kf[2][NF]; i32x8a vf[2], pwB;
    f32x16 sA0, sA1, sB0, sB1;
    ATP_KLOAD(t0, 0);
    if (DK == 64) { ATT_MF6_C(sA0, kf[0][0], qf[0][0], cb, sa, sb); ATT_MF6_C(sA1, kf[1][0], qf[0][0], cb, sa, sb); } else { ATT_MF6_Z(sA0, kf[0][0], qf[0][0], sa, sb); ATT_MF6_Z(sA1, kf[1][0], qf[0][0], sa, sb); }
    if (NF == 2) { ATT_MF6_A(sA0, kf[0][1], qf[0][1], sa, sb); ATT_MF6_A(sA1, kf[1][1], qf[0][1], sa, sb); }
    asm volatile("s_nop 15\n\ts_nop 15\n\ts_nop 15\n\ts_nop 15\n\ts_nop 15\n\ts_nop 15" : "+v"(sA0), "+v"(sA1));
    { const KPtr kp_ = (NMAP == 1) ? ATP_KP(t0 + 1, 0) : ATP_KP(t0, 1);
#pragma unroll
      for (int k = 0; k < 2 * NF; ++k) kread6<DK>(kf, kp_.a0, kp_.b0, kp_.a1, kp_.b1, k); }
#pragma unroll
    for (int r = 0; r < 8; ++r) { vf[0][r] = 0; vf[1][r] = 0; pwB[r] = 0; }
    ATT_PIN(vf[0]); ATT_PIN(vf[1]); ATT_PIN(pwB);
    asm volatile("s_nop 3" ::: "memory");
    if (NMAP == 1) {
        for (int t = t0; t < t1; t += 2) {
            att_step9<DK, 1, ABL>(sB0, sB1, sA0, sA1, kf, qf[0], o[0], L[0], pwB, pw, vf, ones, cb, sa, sb, ATP_VB(t), ATP_KP(t + 1, 0), ATP_KP(t + 2, 0), [&]() { ATP_DMA(t + 6, t + 4); ATP_DMA(t + 7, t + 5); });
            att_step9<DK, 1, ABL>(sA0, sA1, sB0, sB1, kf, qf[0], o[0], L[0], pw, pwB, vf, ones, cb, sa, sb, ATP_VB(t + 1), ATP_KP(t + 2, 0), ATP_KP(t + 3, 0), [&]() {});
            ATP_SYNCALL();
        }
    } else {
        for (int t = t0; t < t1; t += 2) {
            att_step9<DK, 1, ABL>(sB0, sB1, sA0, sA1, kf, qf[1], o[1], L[1], pwB, pw, vf, ones, cb, sa, sb, ATP_VB(t), ATP_KP(t, 1), ATP_KP(t + 1, 0), [&]() { ATP_DMA(t + 5, t + 4); });
            att_step9<DK, 0, ABL>(sA0, sA1, sB0, sB1, kf, qf[0], o[0], L[0], pw, pwB, vf, ones, cb, sa, sb, ATP_VB(t), ATP_KP(t + 1, 0), ATP_KP(t + 1, 1), [&]() { ATP_DMA(t + 6, t + 5); });
            att_step9<DK, 1, ABL>(sB0, sB1, sA0, sA1, kf, qf[1], o[1], L[1], pwB, pw, vf, ones, cb, sa, sb, ATP_VB(t + 1), ATP_KP(t + 1, 1), ATP_KP(t + 2, 0), [&]() {});
            att_step9<DK, 0, ABL>(sA0, sA1, sB0, sB1, kf, qf[0], o[0], L[0], pw, pwB, vf, ones, cb, sa, sb, ATP_VB(t + 1), ATP_KP(t + 2, 0), ATP_KP(t + 2, 1), [&]() {});
            ATP_SYNCALL();
        }
    }
    ATT_SBAR();
    ATT_PV8N(o[NMAP - 1][0], vf[0], pwB); ATT_PV8N(o[NMAP - 1][1], vf[1], pwB); ATT_L8N(L[NMAP - 1], ones, pwB);
    asm volatile("s_waitcnt vmcnt(0) lgkmcnt(0)\n\ts_barrier" ::: "memory");
#pragma unroll
    for (int m = 0; m < NMAP; ++m) asm volatile("s_nop 15\n\ts_nop 15\n\ts_nop 15\n\ts_nop 15\n\ts_nop 15" : "+v"(o[m][0]), "+v"(o[m][1]), "+v"(L[m]));
#undef ATP_DMA
#undef ATP_SYNCALL
#undef ATP_KP
#undef ATP_VB
#undef ATP_KLOAD
    float li[NMAP];
#pragma unroll
    for (int m = 0; m < NMAP; ++m) { const float l0 = __shfl(L[m][0], r32 & 15), l1 = __shfl(L[m][1], r32 & 15); li[m] = 1.0f / ((r32 & 16) ? l1 : l0); }
    float val[2][16];
    if (NMAP == 1) {
#pragma unroll
        for (int d = 0; d < 2; ++d)
#pragma unroll
            for (int r = 0; r < 16; ++r) val[d][r] = o[0][d][r] * li[0];
    } else {
        float ss = 0.f; const float l2 = lam * li[NMAP - 1];
#pragma unroll
        for (int d = 0; d < 2; ++d)
#pragma unroll
            for (int r = 0; r < 16; ++r) { const float v = o[0][d][r] * li[0] - o[NMAP - 1][d][r] * l2; val[d][r] = v; ss += v * v; }
        ss += __shfl_xor(ss, 32);
        const float rstd = rsqrtf(ss * (1.0f / 64.0f) + 1e-6f) * oml;
#pragma unroll
        for (int d = 0; d < 2; ++d)
#pragma unroll
            for (int g = 0; g < 4; ++g) { const f32x4 gv = *(const f32x4*)(gout + 32 * d + 8 * g + 4 * hi);
#pragma unroll
                for (int i = 0; i < 4; ++i) val[d][4 * g + i] *= rstd * gv[i]; }
    }
    bf16_t* orow = Ob + (size_t)(wid * 32 + r32) * 1024 + 4 * hi;
#pragma unroll
    for (int d = 0; d < 2; ++d)
#pragma unroll
        for (int g = 0; g < 4; ++g) { u32x2 w; w.x = cvtpk(val[d][4 * g], val[d][4 * g + 1]); w.y = cvtpk(val[d][4 * g + 2], val[d][4 * g + 3]);
            *(u32x2*)(orow + 32 * d + 8 * g) = w; }
}

}
constexpr int NWAVES = 8;
constexpr int DM = 1024, NB = 4, SEQ = 8192, CL = 256, NTOKB = SEQ + CL, LROWS = NB * SEQ, MROWS = LROWS + NB * CL;
constexpr int NLAYER = 2, INC = 1952, ZP = 3072, NE = 16, FFD = 2048, CAPL = 1024, CAPC = 32, NKT = NTOKB / 64;
constexpr int ZQ = 1952, ZKV = 2336, ZEND = 2848;
constexpr float EPSF = 1e-6f, LOG2E = 1.4426950408889634f, HID_SCALE = 4.0f;
constexpr int N_PHASES = 22;
enum { I_X = 0, I_C, I_CTX, I_CCTX, I_WADA, I_BADA, I_GN1, I_WIN, I_GCQ, I_GCKV, I_WUQ, I_WUKV, I_GMQ, I_GMK, I_GDQ, I_GDK, I_LQ1, I_LK1, I_LQ2, I_LK2, I_GDO, I_GGQ, I_GGK, I_WO, I_GN2, I_WR, I_WG, I_WU, I_WD, N_IN };
constexpr size_t MiB = 1u << 20;
constexpr size_t WS_CTL = 0, CTL_ZERO_BYTES = 1 * MiB;
constexpr size_t WS_MOD = 1 * MiB;
constexpr size_t WS_LAM = WS_MOD + 256 * 1024;
constexpr size_t WS_TAB = WS_MOD + 320 * 1024;
constexpr size_t TAB_AROW = 0, TAB_ACOL = 128 * 8 * 8, TAB_GROW = TAB_ACOL + 64 * 8 * 8, TAB_GCOL = TAB_GROW + 128 * 16 * 8;
constexpr size_t WS_AFF = 2 * MiB, WS_AFFC = 4 * MiB;
constexpr size_t WS_IDX = 5 * MiB, WS_GATE = 6 * MiB;
constexpr size_t WS_INV = 7 * MiB;
constexpr size_t WS_SA = 10 * MiB, WS_SAE = 11 * MiB, WS_SW = 12 * MiB;
constexpr size_t WS_SSQ = 14 * MiB;
constexpr size_t WS_SWC = 13 * MiB;
constexpr size_t WS_WCAT8 = 72 * MiB;
constexpr size_t WS_WCAT = 16 * MiB;
constexpr size_t WS_WO = 28 * MiB;
constexpr size_t WS_CTXW = 32 * MiB;
constexpr size_t WS_H = 36 * MiB;
constexpr size_t WS_WGU = 102 * MiB;
constexpr size_t WS_WD = 230 * MiB;
constexpr size_t WS_YE = 294 * MiB;
constexpr size_t WS_Z = 430 * MiB;
constexpr size_t WS_QKV = 628 * MiB;
constexpr size_t WS_ATT = 793 * MiB;
constexpr size_t WS_DELTA = 430 * MiB;
constexpr size_t WS_XE = 430 * MiB;
constexpr size_t WS_HID = 566 * MiB;
constexpr size_t WS_XB = 859 * MiB;
constexpr size_t WS_END = 925 * MiB;
constexpr size_t QO_QM = 0, QO_QD = 25952256, QO_QG = 43253760, QO_KM = 77856768, QO_KD = 103809024, QO_KG = 121110528, QO_VM = 129761280, QO_VD = 147062784, QO_VG = 164364288;
static_assert(QO_VG + 8650752 == 173015040 && WS_QKV + 173015040 <= WS_ATT && WS_HID + (size_t)16 * 4352 * 2048 * 2 <= WS_XB, "ws map");
constexpr int CW_BAR = 4096, CW_Q = 16384;
constexpr int RING_BYTES = 131072, LDSCTL_OFF = RING_BYTES, MISC_OFF = LDSCTL_OFF + 320, LDS_BYTES = 163840;

#define GAS __attribute__((address_space(1)))
#define LAS __attribute__((address_space(3)))
typedef unsigned short bf16;
typedef unsigned v4u __attribute__((ext_vector_type(4)));
typedef unsigned v2u __attribute__((ext_vector_type(2)));
typedef float f32x4 __attribute__((ext_vector_type(4)));
typedef float f32x2 __attribute__((ext_vector_type(2)));
typedef GAS unsigned gu32;
#define RLX_AGENT __ATOMIC_RELAXED, __HIP_MEMORY_SCOPE_AGENT
#define LDS_WAIT() asm volatile("s_waitcnt lgkmcnt(0)" ::: "memory")
__device__ __forceinline__ unsigned pk2(float lo, float hi) { return att::cvtpk(lo, hi); }
__device__ __forceinline__ float bflo(unsigned w) { return __uint_as_float(w << 16); }
__device__ __forceinline__ float bfhi(unsigned w) { return __uint_as_float(w & 0xffff0000u); }
#define XB_TMO      128
#define XB_XCNT(j)  (256  + 64 * (j))
#define XB_XSUB(j)  (1280 + 64 * (j))
#define XB_XGEN(j)  (2304 + 64 * (j))
#define XB_TOP      3328
#define XB_TOPGEN   3392
#define XCD_BAR_WORDS 3456
#define XB_SPIN_CAP (1u << 18)

__device__ __forceinline__ unsigned xb_ld(unsigned* p)              { return __hip_atomic_load(p, __ATOMIC_RELAXED, __HIP_MEMORY_SCOPE_AGENT); }
__device__ __forceinline__ unsigned xb_add(unsigned* p, unsigned v) { return __hip_atomic_fetch_add(p, v, __ATOMIC_RELAXED, __HIP_MEMORY_SCOPE_AGENT); }
__device__ __forceinline__ unsigned xb_xcc_id() { return (unsigned)__builtin_amdgcn_s_getreg((3 << 11) | 20) & 0xFu; }
#define XB_SPIN(cond, bar) do { unsigned _sp = 0; while (cond) { __builtin_amdgcn_s_sleep(1); \
    if ((++_sp & 255u) == 0u) { if (xb_ld(&(bar)[XB_TMO])) break; if (_sp > XB_SPIN_CAP) { atomicAdd(&(bar)[XB_TMO], 1u); break; } } } } while (0)

struct XcdBarrier {
    unsigned* bar; unsigned x;
    volatile LAS unsigned* st;
};

__device__ __forceinline__ XcdBarrier xcd_barrier_post(unsigned* bar, volatile LAS unsigned* st) {
    XcdBarrier b; b.bar = bar; b.x = xb_xcc_id(); b.st = st;
    if (threadIdx.x == 0) (void)xb_add(&bar[XB_XCNT(b.x)], 1u);
    return b;
}
__device__ __forceinline__ void xcd_barrier_complete(unsigned* bar, unsigned x, unsigned& nloc, unsigned& nx) {
    const unsigned G = gridDim.x * gridDim.y * gridDim.z;
    unsigned sum, cnt, mine, sp = 0u;
    for (;;) {
        sum = 0u; cnt = 0u; mine = 0u;
#pragma unroll
        for (unsigned j = 0; j < 16; ++j) { const unsigned c = xb_ld(&bar[XB_XCNT(j)]); sum += c; cnt += (c > 0u) ? 1u : 0u; mine = (j == x) ? c : mine; }
        if (sum == G) break;
        __builtin_amdgcn_s_sleep(1);
        if ((++sp & 255u) == 0u) { if (xb_ld(&bar[XB_TMO])) break; if (sp > XB_SPIN_CAP) { atomicAdd(&bar[XB_TMO], 1u); break; } }
    }
    nloc = mine > 0u ? mine : 1u; nx = cnt > 0u ? cnt : 1u;
}

__device__ __forceinline__ void xcd_barrier(const XcdBarrier& b) {
    asm volatile("s_waitcnt vmcnt(0)" ::: "memory");
    __syncthreads();
    if (threadIdx.x == 0) {
        unsigned* bar = b.bar;
        __builtin_amdgcn_s_waitcnt(0);
        unsigned nloc = b.st[0], nx = b.st[1];
        if (nloc == 0u) { xcd_barrier_complete(bar, b.x, nloc, nx); b.st[0] = nloc; b.st[1] = nx; }
        const unsigned old = xb_add(&bar[XB_XSUB(b.x)], 1u);
        const unsigned gen = old / nloc;
        if (old + 1u == (gen + 1u) * nloc) {
            __builtin_amdgcn_fence(__ATOMIC_RELEASE, "agent");
            asm volatile("s_waitcnt vmcnt(0)" ::: "memory");
            const unsigned og = xb_add(&bar[XB_TOP], 1u);
            const unsigned tg = og / nx;
            if (og + 1u == (tg + 1u) * nx) xb_add(&bar[XB_TOPGEN], 1u);
            else XB_SPIN(xb_ld(&bar[XB_TOPGEN]) == tg, bar);
            __builtin_amdgcn_fence(__ATOMIC_ACQUIRE, "agent");
            xb_add(&bar[XB_XGEN(b.x)], 1u);
            asm volatile("s_waitcnt vmcnt(0)" ::: "memory");
        } else {
            XB_SPIN(xb_ld(&bar[XB_XGEN(b.x)]) == gen, bar);
            __builtin_amdgcn_fence(__ATOMIC_ACQUIRE, "agent");
            asm volatile("s_waitcnt vmcnt(0)" ::: "memory");
        }
    }
    __syncthreads();
}
struct Args { const float* in[N_IN]; float* out; unsigned char* ws; int ph_lo, ph_hi; };
static_assert(sizeof(Args) == 256, "Args has no padding bytes");
typedef const __attribute__((address_space(4))) Args* KA;
__device__ __forceinline__ KA kargs() { KA p = (KA)__builtin_amdgcn_kernarg_segment_ptr(); asm volatile("" : "+s"(p)); return p; }
struct Frame {
    LAS unsigned char* lds;
    volatile LAS unsigned* MISC;
    gu32* ctl;
    int tid, lane, wave, vcu, G;
};
__device__ __forceinline__ void relane(Frame& F) { int t = threadIdx.x; asm volatile("" : "+v"(t)); F.tid = t; F.lane = t & 63; F.wave = __builtin_amdgcn_readfirstlane(t >> 6); }
__device__ __forceinline__ float wave_sum(float v) {
#pragma unroll
    for (int o = 1; o < 64; o <<= 1) v += __shfl_xor(v, o);
    return v;
}
__device__ __forceinline__ float silu_f(float x) { return x / (1.0f + __expf(-x)); }

__device__ __forceinline__ void transpose_item(const float* __restrict__ W, int N, bf16* __restrict__ WT, int ldt, int k0, int n0, int rowbase, LAS float* scr, int lane) {
    float tv[32];
    { const float* wp = W + (size_t)(k0 + (lane >> 5)) * N + n0 + (lane & 31);
#pragma unroll
      for (int i = 0; i < 32; ++i) tv[i] = __builtin_nontemporal_load(wp + (size_t)(2 * i) * N); }
#pragma unroll
    for (int i = 0; i < 32; ++i) scr[(2 * i + (lane >> 5)) * 33 + (lane & 31)] = tv[i];
    LDS_WAIT(); asm volatile("" ::: "memory");
    const int c = lane & 7;
#pragma unroll
    for (int j = 0; j < 4; ++j) { const int n = (lane >> 3) + 8 * j; const LAS float* s = scr + (8 * c) * 33 + n;
        v4u o; o.x = pk2(s[0 * 33], s[1 * 33]); o.y = pk2(s[2 * 33], s[3 * 33]); o.z = pk2(s[4 * 33], s[5 * 33]); o.w = pk2(s[6 * 33], s[7 * 33]);
        *(v4u*)(WT + (size_t)(rowbase + n) * ldt + k0 + 8 * c) = o; }
    LDS_WAIT(); asm volatile("" ::: "memory");
}

__device__ __forceinline__ void transpose_item_i8(const float* __restrict__ W, int N, signed char* __restrict__ WT, int ldt, int k0, int n0, int rowbase, float qs, LAS float* scr, int lane) {
    float tv[32];
    { const float* wp = W + (size_t)(k0 + (lane >> 5)) * N + n0 + (lane & 31);
#pragma unroll
      for (int i = 0; i < 32; ++i) tv[i] = __builtin_nontemporal_load(wp + (size_t)(2 * i) * N); }
#pragma unroll
    for (int i = 0; i < 32; ++i) scr[(2 * i + (lane >> 5)) * 33 + (lane & 31)] = tv[i];
    LDS_WAIT(); asm volatile("" ::: "memory");
    const int c = lane & 3;
#pragma unroll
    for (int j = 0; j < 2; ++j) { const int n = (lane >> 2) + 16 * j; const LAS float* s = scr + (16 * c) * 33 + n; v4u o;
#pragma unroll
        for (int d = 0; d < 4; ++d) { unsigned w = 0u;
#pragma unroll
            for (int i = 0; i < 4; ++i) { const float f = fminf(fmaxf(s[(4 * d + i) * 33] * qs, -127.0f), 127.0f); w |= ((unsigned)((int)__builtin_rintf(f)) & 255u) << (8 * i); }
            o[d] = w; }
        *(v4u*)(WT + (size_t)(rowbase + n) * ldt + k0 + 16 * c) = o; }
    LDS_WAIT(); asm volatile("" ::: "memory");
}

__device__ __forceinline__ void transpose_item_f8(const float* __restrict__ W, int N, unsigned char* __restrict__ WT, int ldt, int k0, int n0, int rowbase, float qs, LAS float* scr, int lane) {
    float tv[32];
    { const float* wp = W + (size_t)(k0 + (lane >> 5)) * N + n0 + (lane & 31);
#pragma unroll
      for (int i = 0; i < 32; ++i) tv[i] = __builtin_nontemporal_load(wp + (size_t)(2 * i) * N); }
#pragma unroll
    for (int i = 0; i < 32; ++i) scr[(2 * i + (lane >> 5)) * 33 + (lane & 31)] = tv[i];
    LDS_WAIT(); asm volatile("" ::: "memory");
    const int c = lane & 3;
#pragma unroll
    for (int j = 0; j < 2; ++j) { const int n = (lane >> 2) + 16 * j; const LAS float* s = scr + (16 * c) * 33 + n; v4u o;
#pragma unroll
        for (int d = 0; d < 4; ++d) { float f[4];
#pragma unroll
            for (int i = 0; i < 4; ++i) f[i] = fminf(fmaxf(s[(4 * d + i) * 33] * qs, -448.0f), 448.0f);
            int w = __builtin_amdgcn_cvt_pk_fp8_f32(f[0], f[1], 0, false); w = __builtin_amdgcn_cvt_pk_fp8_f32(f[2], f[3], w, true); o[d] = (unsigned)w; }
        *(v4u*)(WT + (size_t)(rowbase + n) * ldt + k0 + 16 * c) = o; }
    LDS_WAIT(); asm volatile("" ::: "memory");
}

__device__ __forceinline__ void sincos_d(float af, float& c, float& s) {
    const double a = (double)af;
    const double q = __builtin_rint(a * 0.63661977236758134308);
    double r = __builtin_fma(-q, 1.57079632679489655800e+00, a); r = __builtin_fma(-q, 6.12323399573676603587e-17, r);
    const double r2 = r * r;
    double sp = -7.6471637318198164759e-13; sp = sp * r2 + 1.6059043836821614599e-10; sp = sp * r2 - 2.5052108385441718775e-08; sp = sp * r2 + 2.7557319223985890653e-06;
    sp = sp * r2 - 1.9841269841269841270e-04; sp = sp * r2 + 8.3333333333333333333e-03; sp = sp * r2 - 1.6666666666666666667e-01; const double sn = r + r * r2 * sp;
    double cp = 4.7794773323873852974e-14; cp = cp * r2 - 1.1470745597729724714e-11; cp = cp * r2 + 2.0876756987868098979e-09; cp = cp * r2 - 2.7557319223985890653e-07;
    cp = cp * r2 + 2.4801587301587301587e-05; cp = cp * r2 - 1.3888888888888888889e-03; cp = cp * r2 + 4.1666666666666666667e-02; cp = cp * r2 - 0.5; const double cs = 1.0 + r2 * cp;
    const int qi = (int)q & 3;
    const double cc = (qi == 0) ? cs : (qi == 1) ? -sn : (qi == 2) ? -cs : sn;
    const double ss = (qi == 0) ? sn : (qi == 1) ? cs : (qi == 2) ? -sn : -cs;
    c = (float)cc; s = (float)ss;
}

#define MEMFENCE() asm volatile("" ::: "memory")
__device__ __forceinline__ void p0_prologue(KA a, Frame& F) {
    relane(F);
    unsigned char* ws = a->ws;
    float* MOD = (float*)(ws + WS_MOD);
    if ((int)blockIdx.x < 192) {
        LAS float* sl = (LAS float*)F.lds + 4096;
        for (int i = F.tid; i < 5 * 1024; i += NWAVES * 64) { const int v = i >> 10, k = i & 1023; const float cv = (v < 4) ? a->in[I_C][v * 1024 + k] : a->in[I_CCTX][k]; sl[i] = silu_f(cv); }
        __syncthreads();
        for (int it = blockIdx.x; it < 192; it += F.G) {
            const int l = it / 96, col = (it % 96) * 64 + F.lane;
            const float* W = a->in[I_WADA] + (size_t)l * 1024 * 6144;
            float acc[5] = {0.f, 0.f, 0.f, 0.f, 0.f};
#pragma unroll 8
            for (int kk = 0; kk < 128; ++kk) { const int k = F.wave * 128 + kk; const float w = W[(size_t)k * 6144 + col];
#pragma unroll
                for (int v = 0; v < 5; ++v) acc[v] += sl[v * 1024 + k] * w; }
            LAS float* red = (LAS float*)F.lds;
#pragma unroll
            for (int v = 0; v < 5; ++v) red[(F.wave * 5 + v) * 64 + F.lane] = acc[v];
            __syncthreads();
            if (F.wave < 5) { float s2 = a->in[I_BADA][l * 6144 + col];
#pragma unroll
                for (int w = 0; w < 8; ++w) s2 += red[(w * 5 + F.wave) * 64 + F.lane];
                MOD[(l * 5 + F.wave) * 6144 + col] = s2; }
            __syncthreads();
        }
    }
    for (int it = blockIdx.x; it < 96; it += F.G) {
        const int l = it / 48, e = (it % 48) / 3, which = it % 3;
        float ss = 0.f;
        if (which < 2) { const float* W = (which ? a->in[I_WU] : a->in[I_WG]) + ((size_t)l * NE + e) * 1024 * 2048;
            for (int i = 0; i < 32; ++i) { const f32x4 v = *(const f32x4*)(W + (size_t)(32 * i) * 2048 + 4 * F.tid); ss += (v.x * v.x + v.y * v.y) + (v.z * v.z + v.w * v.w); } }
        else { const float* W = a->in[I_WD] + ((size_t)l * NE + e) * 2048 * 1024;
            for (int i = 0; i < 64; ++i) { const f32x2 v = *(const f32x2*)(W + (size_t)(32 * i) * 1024 + 2 * F.tid); ss += v.x * v.x + v.y * v.y; } }
        ss = wave_sum(ss);
        LAS float* red = (LAS float*)F.lds;
        if (F.lane == 0) red[F.wave] = ss;
        __syncthreads();
        if (F.tid == 0) { float t = 0.f; for (int w = 0; w < NWAVES; ++w) t += red[w]; const float rms = fmaxf(sqrtf(t * (1.0f / 65536.0f)), 1e-20f);
            ((float*)(ws + WS_SW))[l * 48 + 3 * e + which] = (which < 2) ? 5.0f * rms * (1.0f / 127.0f) : rms * (1.0f / 16.0f); }
        __syncthreads();
    }
    if ((int)blockIdx.x == 192 % F.G && F.wave == 0) {
        float* LAM = (float*)(ws + WS_LAM);
        for (int l = 0; l < NLAYER; ++l) {
            const float p1 = F.lane < 32 ? a->in[I_LQ1][l * 32 + F.lane] * a->in[I_LK1][l * 32 + F.lane] : 0.f;
            const float p2 = F.lane < 32 ? a->in[I_LQ2][l * 32 + F.lane] * a->in[I_LK2][l * 32 + F.lane] : 0.f;
            const float s1 = wave_sum(p1), s2 = wave_sum(p2);
            const float li = 0.8f - 0.6f * expf(-0.3f * (float)l);
            if (F.lane == 0) { LAM[2 * l] = expf(s1) - expf(s2) + li; LAM[2 * l + 1] = li; }
        }
    }
    if ((int)blockIdx.x == 193 % F.G) {
        f32x2* TA_R = (f32x2*)(ws + WS_TAB + TAB_AROW); f32x2* TA_C = (f32x2*)(ws + WS_TAB + TAB_ACOL); f32x2* TG_R = (f32x2*)(ws + WS_TAB + TAB_GROW); f32x2* TG_C = (f32x2*)(ws + WS_TAB + TAB_GCOL);
        const double b8 = 1.0 / __builtin_sqrt(__builtin_sqrt(__builtin_sqrt(10000.0))), b16 = 1.0 / __builtin_sqrt(__builtin_sqrt(__builtin_sqrt(__builtin_sqrt(10000.0))));
        for (int e = F.tid; e < 4608; e += NWAVES * 64) {
            int pos, i, nf; f32x2* dst;
            if (e < 1024) { pos = e >> 3; i = e & 7; nf = 8; dst = TA_R + e; }
            else if (e < 1536) { const int r = e - 1024; pos = r >> 3; i = r & 7; nf = 8; dst = TA_C + r; }
            else if (e < 3584) { const int r = e - 1536; pos = r >> 4; i = r & 15; nf = 16; dst = TG_R + r; }
            else { const int r = e - 3584; pos = r >> 4; i = r & 15; nf = 16; dst = TG_C + r; }
            double inv = 1.0; const double bb = (nf == 8) ? b8 : b16;
            for (int j = 0; j < i; ++j) inv *= bb;
            const float ang = (float)pos * (float)inv;
            float c, s; sincos_d(ang, c, s);
            *dst = (f32x2){c, s};
        }
    }
    for (int it = blockIdx.x; it < 896; it += F.G) {
        const int l = it / 448; int r = it % 448;
        int kb, nb, R, roff, ncols, orow0; const float *Wu, *gg;
        if (r < 192) { kb = r / 6; nb = r % 6; R = 256; roff = 0; ncols = 384; orow0 = ZQ + nb * 64; Wu = a->in[I_WUQ] + (size_t)l * 256 * 384; gg = a->in[I_GCQ] + l * 256; }
        else { r -= 192; kb = r / 8; nb = r % 8; R = 128; roff = 256; ncols = 512; orow0 = ZKV + nb * 64; Wu = a->in[I_WUKV] + (size_t)l * 128 * 512; gg = a->in[I_GCKV] + l * 128; }
        const float* Win = a->in[I_WIN] + (size_t)l * 1024 * INC;
        LAS float* As = (LAS float*)F.lds; LAS float* Bs = As + 32 * 257;
        for (int idx = F.tid; idx < 32 * R; idx += NWAVES * 64) { const int kk = idx / R, rr = idx % R; As[kk * 257 + rr] = Win[(size_t)(kb * 32 + kk) * INC + roff + rr]; }
        for (int idx = F.tid; idx < R * 64; idx += NWAVES * 64) { const int rr = idx >> 6, n = idx & 63; Bs[rr * 64 + n] = gg[rr] * Wu[(size_t)rr * ncols + nb * 64 + n]; }
        __syncthreads();
        const int kk = F.tid & 31, ng = F.tid >> 5;
        f32x4 acc = (f32x4){0.f, 0.f, 0.f, 0.f};
        for (int rr = 0; rr < R; ++rr) { const float av = As[kk * 257 + rr]; const f32x4 bv = *(const LAS f32x4*)(Bs + rr * 64 + ng * 4); acc += av * bv; }
        bf16* Wc = (bf16*)(ws + WS_WCAT) + (size_t)l * ZP * 1024;
#pragma unroll
        for (int j = 0; j < 4; ++j) Wc[(size_t)(orow0 + ng * 4 + j) * 1024 + kb * 32 + kk] = (bf16)(pk2(acc[j], 0.f) & 0xffffu);
        __syncthreads();
    }
    {
        LAS float* scr = (LAS float*)(F.lds + F.wave * 16384);
        const int gw = F.vcu * NWAVES + F.wave, NGW = F.G * NWAVES;
        constexpr int I_IN = 16 * 61, I_O = 16 * 32, PER_L = I_IN + I_O;
        for (int it = gw; it < NLAYER * PER_L; it += NGW) {
            const int l = it / PER_L; int r = it % PER_L;
            if (r < I_IN) { const int kb = r / 61, nb = r % 61; transpose_item(a->in[I_WIN] + (size_t)l * 1024 * INC, INC, (bf16*)(ws + WS_WCAT) + (size_t)l * ZP * 1024, 1024, kb * 64, nb * 32, nb * 32, scr, F.lane); }
            else { r -= I_IN; const int kb = r / 32, nb = r % 32; transpose_item(a->in[I_WO] + (size_t)l * 1024 * 1024, 1024, (bf16*)(ws + WS_WO) + (size_t)l * 1024 * 1024, 1024, kb * 64, nb * 32, nb * 32, scr, F.lane); }
        }
        const int gt = F.vcu * (NWAVES * 64) + F.tid, NGT = F.G * NWAVES * 64;
        constexpr int PADV = (ZP - ZEND) * 1024 * 2 / 16;
        for (int i = gt; i < NLAYER * PADV; i += NGT) { const int l = i / PADV, j = i % PADV; ((v4u*)((bf16*)(ws + WS_WCAT) + ((size_t)l * ZP + ZEND) * 1024))[j] = (v4u){0u, 0u, 0u, 0u}; }
    }
}

__device__ __forceinline__ void phase_a(KA a, Frame& F, int l) {
    relane(F);
    unsigned char* ws = a->ws;
    const float* MOD = (const float*)(ws + WS_MOD);
    const int* INV = (const int*)(ws + WS_INV);
    const bf16* YE = (const bf16*)(ws + WS_YE);
    const bool fin = (l == NLAYER);
    const int nrows = fin ? LROWS : MROWS;
    const int gw = F.vcu * NWAVES + F.wave, NGW = F.G * NWAVES;
#define PA_LOAD(r, XF, XB, IV) do { if (l == 0) { const float* src_ = ((r) >= LROWS) ? a->in[I_CTX] + (size_t)((r) - LROWS) * 1024 : a->in[I_X] + (size_t)(r) * 1024; \
            _Pragma("unroll") for (int j = 0; j < 4; ++j) XF[j] = *(const f32x4*)(src_ + 4 * F.lane + 256 * j); } \
        else { const bf16* xb_ = (const bf16*)(ws + WS_XB) + (size_t)(r) * 1024; _Pragma("unroll") for (int j = 0; j < 4; ++j) XB[j] = *(const v2u*)(xb_ + 4 * F.lane + 256 * j); \
            IV = INV[(size_t)(r) * 16 + (F.lane & 15)]; } } while (0)
    f32x4 cf[4]; v2u cb[4]; int civ = -1;
#pragma unroll
    for (int j = 0; j < 4; ++j) { cf[j] = (f32x4){0.f, 0.f, 0.f, 0.f}; cb[j] = (v2u){0u, 0u}; }
    if (gw < nrows) PA_LOAD(gw, cf, cb, civ);
    for (int row = gw; row < nrows; row += NGW) {
        const bool isc = row >= LROWS; const int v = isc ? 4 : (row >> 13);
        bf16* xb = (bf16*)(ws + WS_XB) + (size_t)row * 1024;
        const int nrow = row + NGW; f32x4 nf[4]; v2u nb[4]; int niv = -1;
#pragma unroll
        for (int j = 0; j < 4; ++j) { nf[j] = cf[j]; nb[j] = cb[j]; }
        if (nrow < nrows) PA_LOAD(nrow, nf, nb, niv);
        f32x4 xv[4];
        if (l == 0) {
#pragma unroll
            for (int j = 0; j < 4; ++j) xv[j] = cf[j]; }
        else {
#pragma unroll
            for (int j = 0; j < 4; ++j) xv[j] = (f32x4){bflo(cb[j].x), bfhi(cb[j].x), bflo(cb[j].y), bfhi(cb[j].y)}; }
        if (l > 0) {
            const float* ga2 = MOD + ((l - 1) * 5 + v) * 6144 + 5 * 1024;
            f32x4 acc[4];
#pragma unroll
            for (int j = 0; j < 4; ++j) acc[j] = (f32x4){0.f, 0.f, 0.f, 0.f};
            unsigned sel = (unsigned)(__ballot(civ >= 0) & 0xFFFFull);
            while (sel) {
                int sl[4]; float on[4];
#pragma unroll
                for (int k = 0; k < 4; ++k) { if (sel) { const int e = __builtin_ctz(sel); sel &= sel - 1u; sl[k] = __builtin_amdgcn_readlane(civ, e); on[k] = 1.0f; } else { sl[k] = sl[0]; on[k] = 0.0f; } }
                v2u w[4][4];
#pragma unroll
                for (int k = 0; k < 4; ++k) { const bf16* yr = YE + (size_t)sl[k] * 1024 + 4 * F.lane;
#pragma unroll
                    for (int j = 0; j < 4; ++j) w[k][j] = *(const v2u*)(yr + 256 * j); }
#pragma unroll
                for (int k = 0; k < 4; ++k)
#pragma unroll
                    for (int j = 0; j < 4; ++j) acc[j] += on[k] * (f32x4){bflo(w[k][j].x), bfhi(w[k][j].x), bflo(w[k][j].y), bfhi(w[k][j].y)};
            }
#pragma unroll
            for (int j = 0; j < 4; ++j) { const f32x4 g = *(const f32x4*)(ga2 + 4 * F.lane + 256 * j); xv[j] += g * acc[j]; }
        }
#pragma unroll
        for (int j = 0; j < 4; ++j) { cf[j] = nf[j]; cb[j] = nb[j]; }
        civ = niv;
        if (fin) {
#pragma unroll
            for (int j = 0; j < 4; ++j) *(f32x4*)(a->out + (size_t)row * 1024 + 4 * F.lane + 256 * j) = xv[j];
            continue; }
#pragma unroll
        for (int j = 0; j < 4; ++j) { v2u w; w.x = pk2(xv[j].x, xv[j].y); w.y = pk2(xv[j].z, xv[j].w); *(v2u*)(xb + 4 * F.lane + 256 * j) = w; }
        float ss = 0.f;
#pragma unroll
        for (int j = 0; j < 4; ++j) ss += (xv[j].x * xv[j].x + xv[j].y * xv[j].y) + (xv[j].z * xv[j].z + xv[j].w * xv[j].w);
        const float rstd = rsqrtf(wave_sum(ss) * (1.0f / 1024.0f) + EPSF);
        const float* g1 = a->in[I_GN1] + l * 1024; const float* sh = MOD + (l * 5 + v) * 6144; const float* sc = sh + 1024;
        float am = 0.f;
#pragma unroll
        for (int j = 0; j < 4; ++j) { const int c0 = 4 * F.lane + 256 * j; const f32x4 g = *(const f32x4*)(g1 + c0), s1 = *(const f32x4*)(sc + c0), b1 = *(const f32x4*)(sh + c0);
            xv[j] = xv[j] * rstd * g * (1.0f + s1) + b1;
            am = fmaxf(fmaxf(am, fmaxf(fabsf(xv[j].x), fabsf(xv[j].y))), fmaxf(fabsf(xv[j].z), fabsf(xv[j].w))); }
#pragma unroll
        for (int o = 1; o < 64; o <<= 1) am = fmaxf(am, __shfl_xor(am, o));
        const float qs = am > 0.f ? 127.0f / am : 0.f;
        signed char* h8 = (signed char*)(ws + WS_H) + (size_t)row * 1024;
#pragma unroll
        for (int j = 0; j < 4; ++j) { const int q0 = (int)__builtin_rintf(xv[j].x * qs), q1 = (int)__builtin_rintf(xv[j].y * qs), q2 = (int)__builtin_rintf(xv[j].z * qs), q3 = (int)__builtin_rintf(xv[j].w * qs);
            *(unsigned*)(h8 + 4 * F.lane + 256 * j) = (unsigned)(q0 & 255) | ((unsigned)(q1 & 255) << 8) | ((unsigned)(q2 & 255) << 16) | ((unsigned)(q3 & 255) << 24); }
        if (F.lane == 0) ((float*)(ws + WS_SA))[row] = am * (1.0f / 127.0f);
    }
#undef PA_LOAD
    if (l == 0) {
        const bf16* Wc = (const bf16*)(ws + WS_WCAT); signed char* W8 = (signed char*)(ws + WS_WCAT8); float* SWC = (float*)(ws + WS_SWC);
        for (int r = gw; r < NLAYER * ZP; r += NGW) {
            float wv[16]; float am = 0.f;
#pragma unroll
            for (int j = 0; j < 2; ++j) { const v4u w = *(const v4u*)(Wc + (size_t)r * 1024 + 8 * F.lane + 512 * j);
                wv[8 * j + 0] = bflo(w.x); wv[8 * j + 1] = bfhi(w.x); wv[8 * j + 2] = bflo(w.y); wv[8 * j + 3] = bfhi(w.y); wv[8 * j + 4] = bflo(w.z); wv[8 * j + 5] = bfhi(w.z); wv[8 * j + 6] = bflo(w.w); wv[8 * j + 7] = bfhi(w.w); }
#pragma unroll
            for (int i = 0; i < 16; ++i) am = fmaxf(am, fabsf(wv[i]));
#pragma unroll
            for (int o = 1; o < 64; o <<= 1) am = fmaxf(am, __shfl_xor(am, o));
            const float qs = am > 0.f ? 127.0f / am : 0.f;
#pragma unroll
            for (int j = 0; j < 2; ++j) { unsigned w0 = 0u, w1 = 0u;
#pragma unroll
                for (int i = 0; i < 4; ++i) { w0 |= ((unsigned)((int)__builtin_rintf(wv[8 * j + i] * qs)) & 255u) << (8 * i); w1 |= ((unsigned)((int)__builtin_rintf(wv[8 * j + 4 + i] * qs)) & 255u) << (8 * i); }
                v2u o; o.x = w0; o.y = w1; *(v2u*)(W8 + (size_t)r * 1024 + 8 * F.lane + 512 * j) = o; }
            if (F.lane == 0) SWC[r] = am * (1.0f / 127.0f);
        }
    }
}

__device__ __forceinline__ void ld8(const bf16* p, float* f) { const v4u w = *(const v4u*)p; f[0] = bflo(w.x); f[1] = bfhi(w.x); f[2] = bflo(w.y); f[3] = bfhi(w.y); f[4] = bflo(w.z); f[5] = bfhi(w.z); f[6] = bflo(w.w); f[7] = bfhi(w.w); }
__device__ __forceinline__ v4u pk8(const float* f) { v4u w; w.x = pk2(f[0], f[1]); w.y = pk2(f[2], f[3]); w.z = pk2(f[4], f[5]); w.w = pk2(f[6], f[7]); return w; }
template <int N> __device__ __forceinline__ float ssq_row(const bf16* p) { float s = 0.f;
#pragma unroll
    for (int c = 0; c < N / 8; ++c) { float f[8]; ld8(p + 8 * c, f);
#pragma unroll
        for (int i = 0; i < 8; ++i) s += f[i] * f[i];
        if ((c & 7) == 7) MEMFENCE(); }
    return s; }
template <int NP> __device__ __forceinline__ void rope_pairs(float* x, const f32x2* trow, const f32x2* tcol) {
#pragma unroll
    for (int i = 0; i < NP; ++i) { const f32x2 cs = (i < NP / 2) ? trow[i] : tcol[i - NP / 2];
        const float x0 = x[2 * i], x1 = x[2 * i + 1]; x[2 * i] = x0 * cs.x - x1 * cs.y; x[2 * i + 1] = x0 * cs.y + x1 * cs.x; }
}
__device__ __forceinline__ void store_v_tile(char* vt, int lane, const float* v  ) {
    char* p = vt + (lane >> 4) * 1024 + ((lane >> 3) & 1) * 512 + (lane & 7) * 64;
#pragma unroll
    for (int d = 0; d < 2; ++d)
#pragma unroll
        for (int c = 0; c < 4; ++c) *(v4u*)(p + d * 4096 + c * 16) = pk8(v + d * 32 + c * 8);
}
template <bool ROPE> __device__ __forceinline__ v4u proc8(v4u w, float r, const float* g, const f32x2* cs, float qs) {
    float f[8] = {bflo(w.x), bfhi(w.x), bflo(w.y), bfhi(w.y), bflo(w.z), bfhi(w.z), bflo(w.w), bfhi(w.w)};
#pragma unroll
    for (int i = 0; i < 8; ++i) f[i] *= r * g[i];
    if (ROPE) {
#pragma unroll
        for (int i = 0; i < 4; ++i) { const f32x2 t = cs[i]; const float x0 = f[2 * i], x1 = f[2 * i + 1]; f[2 * i] = x0 * t.x - x1 * t.y; f[2 * i + 1] = x0 * t.y + x1 * t.x; }
    }
#pragma unroll
    for (int i = 0; i < 8; ++i) f[i] *= qs;
    return pk8(f);
}
__device__ __forceinline__ v2u pk8_f8(const float* f) { int w0 = __builtin_amdgcn_cvt_pk_fp8_f32(f[0], f[1], 0, false); w0 = __builtin_amdgcn_cvt_pk_fp8_f32(f[2], f[3], w0, true);
    int w1 = __builtin_amdgcn_cvt_pk_fp8_f32(f[4], f[5], 0, false); w1 = __builtin_amdgcn_cvt_pk_fp8_f32(f[6], f[7], w1, true); return (v2u){(unsigned)w0, (unsigned)w1}; }
template <bool ROPE> __device__ __forceinline__ v2u proc8f(v4u w, float r, const float* g, const f32x2* cs, float qs) {
    float f[8] = {bflo(w.x), bfhi(w.x), bflo(w.y), bfhi(w.y), bflo(w.z), bfhi(w.z), bflo(w.w), bfhi(w.w)};
#pragma unroll
    for (int i = 0; i < 8; ++i) f[i] *= r * g[i];
    if (ROPE) {
#pragma unroll
        for (int i = 0; i < 4; ++i) { const f32x2 t = cs[i]; const float x0 = f[2 * i], x1 = f[2 * i + 1]; f[2 * i] = x0 * t.x - x1 * t.y; f[2 * i + 1] = x0 * t.y + x1 * t.x; }
    }
#pragma unroll
    for (int i = 0; i < 8; ++i) f[i] *= qs;
    return pk8_f8(f);
}
__device__ __forceinline__ att::i32x6a fp6_group(const v4u& c0, const v4u& c1, const v4u& c2, const v4u& c3) {
    att::u32x16 w; w[0] = c0.x; w[1] = c0.y; w[2] = c0.z; w[3] = c0.w; w[4] = c1.x; w[5] = c1.y; w[6] = c1.z; w[7] = c1.w; w[8] = c2.x; w[9] = c2.y; w[10] = c2.z; w[11] = c2.w; w[12] = c3.x; w[13] = c3.y; w[14] = c3.z; w[15] = c3.w;
    return att::cvt_fp6x32(w); }
__device__ __forceinline__ void store_qgroup(unsigned char* q, const att::i32x6a& g) { *(v2u*)q = (v2u){(unsigned)g[0], (unsigned)g[1]}; *(v2u*)(q + 8) = (v2u){(unsigned)g[2], (unsigned)g[3]}; *(v2u*)(q + 16) = (v2u){(unsigned)g[4], (unsigned)g[5]}; }
__device__ __forceinline__ void store_kgroup(char* kt, int pb, int j, int lane, const att::i32x6a& g) {
    *(v4u*)(kt + j * 1024 + lane * 16) = (v4u){(unsigned)g[0], (unsigned)g[1], (unsigned)g[2], (unsigned)g[3]}; *(v2u*)(kt + pb + j * 512 + lane * 8) = (v2u){(unsigned)g[4], (unsigned)g[5]}; }
__device__ __forceinline__ float ssq8(v4u w) { const float f[8] = {bflo(w.x), bfhi(w.x), bflo(w.y), bfhi(w.y), bflo(w.z), bfhi(w.z), bflo(w.w), bfhi(w.w)}; float s = 0.f;
#pragma unroll
    for (int i = 0; i < 8; ++i) s += f[i] * f[i];
    return s; }
__device__ __forceinline__ v4u scale8(v4u w, float r) { float f[8] = {bflo(w.x), bfhi(w.x), bflo(w.y), bfhi(w.y), bflo(w.z), bfhi(w.z), bflo(w.w), bfhi(w.w)};
#pragma unroll
    for (int i = 0; i < 8; ++i) f[i] *= r;
    return pk8(f); }
__device__ __forceinline__ void store_v_tile_pk(char* vt, int lane, const v4u* w) {
    char* p = vt + (lane >> 4) * 1024 + ((lane >> 3) & 1) * 512 + (lane & 7) * 64;
#pragma unroll
    for (int c = 0; c < 8; ++c) *(v4u*)(p + (c >> 2) * 4096 + (c & 3) * 16) = w[c];
}
__device__ __forceinline__ void store_v_tile_f8(char* vt, int lane, const v4u* w, float sc, LAS unsigned char* scr) {
    LAS unsigned char* p = scr + (2 * ((lane >> 2) & 1) + (lane >> 5)) * 1024 + 4 * ((lane >> 3) & 3) + (lane & 3);
#pragma unroll
    for (int c = 0; c < 8; ++c) { const float f[8] = {bflo(w[c].x), bfhi(w[c].x), bflo(w[c].y), bfhi(w[c].y), bflo(w[c].z), bfhi(w[c].z), bflo(w[c].w), bfhi(w[c].w)};
#pragma unroll
        for (int i = 0; i < 8; i += 2) { const int b8 = __builtin_amdgcn_cvt_pk_fp8_f32(f[i] * sc, f[i + 1] * sc, 0, false);
            p[(8 * c + i) * 16] = (unsigned char)b8; p[(8 * c + i + 1) * 16] = (unsigned char)(b8 >> 8); } }
    LDS_WAIT(); asm volatile("" ::: "memory");
#pragma unroll
    for (int i = 0; i < 4; ++i) *(v4u*)(vt + i * 1024 + lane * 16) = *(const LAS v4u*)(scr + i * 1024 + lane * 16);
    LDS_WAIT(); asm volatile("" ::: "memory");
}
__device__ __forceinline__ void phase_c(KA a, Frame& F, int l) {
    relane(F);
    unsigned char* ws = a->ws;
    const bf16* Z = (const bf16*)(ws + WS_Z); const float* SSQ = (const float*)(ws + WS_SSQ);
    unsigned char* qkv = ws + WS_QKV;
    LAS unsigned char* vscr = (LAS unsigned char*)F.lds + F.wave * 4096;
    const f32x2* TA_R = (const f32x2*)(ws + WS_TAB + TAB_AROW); const f32x2* TA_C = (const f32x2*)(ws + WS_TAB + TAB_ACOL);
    const f32x2* TG_R = (const f32x2*)(ws + WS_TAB + TAB_GROW); const f32x2* TG_C = (const f32x2*)(ws + WS_TAB + TAB_GCOL);
    const int gw = F.vcu * NWAVES + F.wave, NGW = F.G * NWAVES, lane = F.lane;
    for (int id = gw; id < 528 * 32; id += NGW) {
        const int tile = id % 528, job = id / 528;
        const int b = tile / NKT, tt = tile % NKT; const bool isc = tt >= 128;
        const int zrow = isc ? LROWS + b * CL + (tt - 128) * 64 + lane : b * SEQ + tt * 64 + lane;
        const int tok = tt * 64 + lane;
        const bf16* zr = Z + (size_t)zrow * ZP;
        const f32x2* tar = TA_R + (isc ? 0 : tt) * 8; const f32x2* tac = TA_C + lane * 8;
        const f32x2* tgr = TG_R + (isc ? 0 : tt) * 16; const f32x2* tgc = TG_C + lane * 16;
        MEMFENCE();
        if (job < 4) {
            const int h = job;
            float r1; { const f32x4 s0 = *(const f32x4*)(SSQ + (size_t)zrow * 12), s1 = *(const f32x4*)(SSQ + (size_t)zrow * 12 + 4); r1 = rsqrtf((((s0.x + s0.y) + (s0.z + s0.w)) + ((s1.x + s1.y) + (s1.z + s1.w))) * (1.0f / 256.0f) + EPSF); }
            v4u w[12]; float ss = 0.f;
#pragma unroll
            for (int c = 0; c < 12; ++c) { w[c] = *(const v4u*)(zr + ZQ + h * 96 + 8 * c); ss += ssq8(w[c]); }
            MEMFENCE();
            const float r = r1 * rsqrtf(ss * r1 * r1 * (1.0f / 96.0f) + EPSF); const float* g = a->in[I_GMQ] + l * 96;
            const float qs = att::FQ96;
            unsigned char* q = (unsigned char*)(qkv + QO_QM) + ((size_t)(b * 4 + h) * NTOKB + tok) * 72;
#pragma unroll
            for (int gq = 0; gq < 3; ++gq) { v4u o[4];
#pragma unroll
                for (int cc = 0; cc < 4; ++cc) { const int c = 4 * gq + cc;
                    if (c < 8 || isc) o[cc] = proc8<false>(w[c], r, g + 8 * c, nullptr, qs);
                    else o[cc] = proc8<true>(w[c], r, g + 8 * c, (c < 10) ? tar + 4 * (c - 8) : tac + 4 * (c - 10), qs); }
                store_qgroup(q + 24 * gq, fp6_group(o[0], o[1], o[2], o[3])); MEMFENCE(); }
        } else if (job < 8) {
            const int h = job - 4;
            float r1; { const f32x4 s2 = *(const f32x4*)(SSQ + (size_t)zrow * 12 + 8); r1 = rsqrtf(((s2.x + s2.y) + (s2.z + s2.w)) * (1.0f / 128.0f) + EPSF); }
            v4u w[12]; float ss = 0.f, s2 = 0.f;
#pragma unroll
            for (int c = 0; c < 8; ++c) { w[c] = *(const v4u*)(zr + ZKV + h * 128 + 8 * c); ss += ssq8(w[c]); }
#pragma unroll
            for (int c = 0; c < 4; ++c) { w[8 + c] = *(const v4u*)(zr + 384 + 8 * c); s2 += ssq8(w[8 + c]); }
            MEMFENCE();
            const float r2 = rsqrtf((ss * r1 * r1 + s2) * (1.0f / 96.0f) + EPSF); const float* g = a->in[I_GMK] + l * 96;
            char* kt = (char*)(qkv + QO_KM) + ((size_t)(b * 4 + h) * NKT + tt) * 5120;
#pragma unroll
            for (int gq = 0; gq < 3; ++gq) { v4u o[4];
#pragma unroll
                for (int cc = 0; cc < 4; ++cc) { const int c = 4 * gq + cc;
                    if (c < 8) o[cc] = proc8<false>(w[c], r1 * r2, g + 8 * c, nullptr, 1.0f);
                    else if (isc) o[cc] = proc8<false>(w[c], r2, g + 8 * c, nullptr, 1.0f);
                    else o[cc] = proc8<true>(w[c], r2, g + 8 * c, (c < 10) ? tar + 4 * (c - 8) : tac + 4 * (c - 10), 1.0f); }
                store_kgroup(kt, 3072, gq, lane, fp6_group(o[0], o[1], o[2], o[3])); MEMFENCE(); }
            v4u vw[8];
#pragma unroll
            for (int c = 0; c < 8; ++c) vw[c] = *(const v4u*)(zr + ZKV + h * 128 + 64 + 8 * c);
            store_v_tile_f8((char*)(qkv + QO_VM) + ((size_t)(b * 4 + h) * NKT + tt) * 4096, lane, vw, r1, vscr);
        } else if (job < 16) {
            const bool isk = job >= 12; const int h = (job - 8) & 3;
            const bf16* zp = zr + (isk ? 672 : 416) + h * 64; const float* g = (isk ? a->in[I_GDK] : a->in[I_GDQ]) + l * 32;
            const float qs = isk ? 1.0f : att::FQ32;
            v4u w[8]; float ss[2] = {0.f, 0.f};
#pragma unroll
            for (int c = 0; c < 8; ++c) { w[c] = *(const v4u*)(zp + 8 * c); ss[c >> 2] += ssq8(w[c]); }
            MEMFENCE();
            const float r0 = rsqrtf(ss[0] * (1.0f / 32.0f) + EPSF), r1 = rsqrtf(ss[1] * (1.0f / 32.0f) + EPSF);
            char* kt = (char*)(qkv + QO_KD) + ((size_t)(b * 4 + h) * NKT + tt) * 3072;
            unsigned char* q = (unsigned char*)(qkv + QO_QD) + ((size_t)(b * 4 + h) * NTOKB + tok) * 48;
#pragma unroll
            for (int gq = 0; gq < 2; ++gq) { v4u o[4];
#pragma unroll
                for (int cm = 0; cm < 4; ++cm) { const int c = 4 * gq + cm;
                    if (isc) o[cm] = proc8<false>(w[c], gq ? r1 : r0, g + 8 * cm, nullptr, qs);
                    else o[cm] = proc8<true>(w[c], gq ? r1 : r0, g + 8 * cm, (cm < 2) ? tar + 4 * cm : tac + 4 * (cm - 2), qs); }
                const att::i32x6a gr = fp6_group(o[0], o[1], o[2], o[3]);
                if (isk) store_kgroup(kt, 2048, gq, lane, gr); else store_qgroup(q + 24 * gq, gr);
                MEMFENCE(); }
        } else if (job < 20) {
            const int h = job - 16; v4u vw[8];
#pragma unroll
            for (int c = 0; c < 8; ++c) vw[c] = *(const v4u*)(zr + 928 + h * 64 + 8 * c);
            store_v_tile_f8((char*)(qkv + QO_VD) + ((size_t)(b * 4 + h) * NKT + tt) * 4096, lane, vw, 1.0f, vscr);
        } else if (job < 30) {
            const bool isk = job >= 28; const int h = isk ? job - 28 : job - 20;
            const bf16* zp = zr + (isk ? 1696 : 1184) + h * 64; const float* g = (isk ? a->in[I_GGK] : a->in[I_GGQ]) + l * 64;
            const float qs = isk ? 1.0f : att::FQ64;
            v4u w[8]; float ss = 0.f;
#pragma unroll
            for (int c = 0; c < 8; ++c) { w[c] = *(const v4u*)(zp + 8 * c); ss += ssq8(w[c]); }
            MEMFENCE();
            const float r = rsqrtf(ss * (1.0f / 64.0f) + EPSF);
            char* kt = (char*)(qkv + QO_KG) + ((size_t)(b * 2 + h) * NKT + tt) * 3072;
            unsigned char* q = (unsigned char*)(qkv + QO_QG) + ((size_t)(b * 8 + h) * NTOKB + tok) * 48;
#pragma unroll
            for (int gq = 0; gq < 2; ++gq) { v4u o[4];
#pragma unroll
                for (int cc = 0; cc < 4; ++cc) { const int c = 4 * gq + cc;
                    if (isc) o[cc] = proc8<false>(w[c], r, g + 8 * c, nullptr, qs);
                    else o[cc] = proc8<true>(w[c], r, g + 8 * c, (c < 4) ? tgr + 4 * c : tgc + 4 * (c - 4), qs); }
                const att::i32x6a gr = fp6_group(o[0], o[1], o[2], o[3]);
                if (isk) store_kgroup(kt, 2048, gq, lane, gr); else store_qgroup(q + 24 * gq, gr);
                MEMFENCE(); }
        } else {
            const int h = job - 30; v4u vw[8];
#pragma unroll
            for (int c = 0; c < 8; ++c) vw[c] = *(const v4u*)(zr + 1824 + h * 64 + 8 * c);
            store_v_tile_f8((char*)(qkv + QO_VG) + ((size_t)(b * 2 + h) * NKT + tt) * 4096, lane, vw, 1.0f, vscr);
        }
        MEMFENCE();
    }
}

#define ATT_UNIT(KD, NM) att::attn_unit_f8<KD, NM, ABL>
#define ATT_DIFF att::attn_unit_f8<32, 2, ABL>
template <int ABL>
__device__ __forceinline__ void phase_d(KA a, Frame& F, int l, bool last) {
    relane(F);
    unsigned char* ws = a->ws; unsigned char* qkv = ws + WS_QKV;
    bf16* ATT = (bf16*)(ws + (ABL ? WS_Z : WS_ATT));
    const float* LAM = (const float*)(ws + WS_LAM);
    const float lam = LAM[2 * l], oml = 1.0f - LAM[2 * l + 1];
    const float* gdo = a->in[I_GDO] + l * 64;
    ALDS char* lds = (ALDS char*)F.lds;
    const int nctx = last ? 0 : 64;
    for (int id = F.vcu; id < 512 + nctx; id += F.G) {
        int b, h, q0, t0, t1; size_t orow;
        if (id < 512) { const int x = (id & 255) >> 5; b = x >> 1; h = 2 * (x & 1) + (id >> 8); q0 = (id & 31) * 256; t0 = 0; t1 = NKT; orow = (size_t)b * SEQ + q0; }
        else { const int c = id - 512; b = c >> 4; h = c & 15; if (h >= 4) continue; q0 = SEQ; t0 = 128; t1 = NKT; orow = (size_t)LROWS + b * CL; }
        ATT_UNIT(96, 1)((const unsigned char*)(qkv + QO_QM) + ((size_t)(b * 4 + h) * NTOKB + q0) * 72, (const char*)(qkv + QO_KM) + (size_t)(b * 4 + h) * NKT * 5120,
                        (const char*)(qkv + QO_VM) + (size_t)(b * 4 + h) * NKT * 4096, t0, t1, ATT + orow * 1024 + h * 64, lds, 0.f, gdo, 0.f);
    }
    for (int id = 512 + F.vcu; id < 1024 + nctx; id += F.G) {
        int b, h, q0, t0, t1; size_t orow;
        if (id < 1024) { const int x = (id & 255) >> 5; b = x >> 1; h = 2 * (x & 1) + ((id >> 8) - 2); q0 = (id & 31) * 256; t0 = 0; t1 = NKT; orow = (size_t)b * SEQ + q0; }
        else { const int c = id - 1024; b = c >> 4; h = (c & 15) - 4; if (h < 0 || h >= 4) continue; q0 = SEQ; t0 = 128; t1 = NKT; orow = (size_t)LROWS + b * CL; }
        ATT_DIFF((const unsigned char*)(qkv + QO_QD) + ((size_t)(b * 4 + h) * NTOKB + q0) * 48, (const char*)(qkv + QO_KD) + (size_t)(b * 4 + h) * NKT * 3072,
                        (const char*)(qkv + QO_VD) + (size_t)(b * 4 + h) * NKT * 4096, t0, t1, ATT + orow * 1024 + 256 + h * 64, lds, lam, gdo, oml);
    }
    for (int id = 1024 + F.vcu; id < 2048 + nctx; id += F.G) {
        int b, h, q0, t0, t1; size_t orow;
        if (id < 2048) { const int x = (id & 255) >> 5; b = x >> 1; h = 4 * (x & 1) + ((id >> 8) - 4); q0 = (id & 31) * 256; t0 = 0; t1 = NKT; orow = (size_t)b * SEQ + q0; }
        else { const int c = id - 2048; b = c >> 4; h = (c & 15) - 8; if (h < 0) continue; q0 = SEQ; t0 = 128; t1 = NKT; orow = (size_t)LROWS + b * CL; }
        const int g = h >> 2;
        ATT_UNIT(64, 1)((const unsigned char*)(qkv + QO_QG) + ((size_t)(b * 8 + h) * NTOKB + q0) * 48, (const char*)(qkv + QO_KG) + (size_t)(b * 2 + g) * NKT * 3072,
                        (const char*)(qkv + QO_VG) + (size_t)(b * 2 + g) * NKT * 4096, t0, t1, ATT + orow * 1024 + 512 + h * 64, lds, 0.f, gdo, 0.f);
    }
}

template <int RB>
__device__ __forceinline__ void pf_rows(KA a, Frame& F, int l, int rbeg, int nrows, LAS float* wrT) {
    unsigned char* ws = a->ws;
    const float* MOD = (const float*)(ws + WS_MOD);
    float* AFF = (float*)(ws + WS_AFF); float* AFFC = (float*)(ws + WS_AFFC); int* INV = (int*)(ws + WS_INV);
    const int gw = F.vcu * NWAVES + F.wave, NGW = F.G * NWAVES;
#define PF_LOAD(r, XW, DW) do { const bf16* xb_ = (const bf16*)(ws + WS_XB) + (size_t)(r) * 1024; const bf16* dl_ = (const bf16*)(ws + WS_DELTA) + (size_t)(r) * 1024; \
        _Pragma("unroll") for (int j = 0; j < 4; ++j) { XW[j] = *(const v2u*)(xb_ + 4 * F.lane + 256 * j); DW[j] = *(const v2u*)(dl_ + 4 * F.lane + 256 * j); } } while (0)
    v2u cxw[RB][4], cdw[RB][4];
#pragma unroll
    for (int u = 0; u < RB; ++u)
#pragma unroll
        for (int j = 0; j < 4; ++j) { cxw[u][j] = (v2u){0u, 0u}; cdw[u][j] = (v2u){0u, 0u}; }
    if (rbeg + gw * RB < nrows) {
#pragma unroll
        for (int u = 0; u < RB; ++u) PF_LOAD(rbeg + gw * RB + u, cxw[u], cdw[u]); }
    for (int grp = gw; rbeg + grp * RB < nrows; grp += NGW) {
        const int row0 = rbeg + grp * RB; const bool isc = row0 >= LROWS; const int v = isc ? 4 : (row0 >> 13);
        f32x4 hv[RB][4]; float ss[RB];
#pragma unroll
        for (int u = 0; u < RB; ++u) { bf16* xb = (bf16*)(ws + WS_XB) + (size_t)(row0 + u) * 1024; ss[u] = 0.f;
#pragma unroll
            for (int j = 0; j < 4; ++j) { const int c0 = 4 * F.lane + 256 * j; const v2u w = cdw[u][j], xw = cxw[u][j];
                hv[u][j] = (f32x4){bflo(xw.x), bfhi(xw.x), bflo(xw.y), bfhi(xw.y)} + (f32x4){bflo(w.x), bfhi(w.x), bflo(w.y), bfhi(w.y)};
                v2u o; o.x = pk2(hv[u][j].x, hv[u][j].y); o.y = pk2(hv[u][j].z, hv[u][j].w); *(v2u*)(xb + c0) = o;
                ss[u] += (hv[u][j].x * hv[u][j].x + hv[u][j].y * hv[u][j].y) + (hv[u][j].z * hv[u][j].z + hv[u][j].w * hv[u][j].w); } }
        { const int ngrp = grp + NGW;
          if (rbeg + ngrp * RB < nrows) {
#pragma unroll
              for (int u = 0; u < RB; ++u) PF_LOAD(rbeg + ngrp * RB + u, cxw[u], cdw[u]); } }
        float rstd[RB];
#pragma unroll
        for (int u = 0; u < RB; ++u) rstd[u] = rsqrtf(wave_sum(ss[u]) * (1.0f / 1024.0f) + EPSF);
        const float* g2 = a->in[I_GN2] + l * 1024; const float* sh = MOD + (l * 5 + v) * 6144 + 3 * 1024; const float* sc = sh + 1024;
        float am[RB];
#pragma unroll
        for (int u = 0; u < RB; ++u) am[u] = 0.f;
#pragma unroll
        for (int j = 0; j < 4; ++j) { const int c0 = 4 * F.lane + 256 * j; const f32x4 g = *(const f32x4*)(g2 + c0), s1 = *(const f32x4*)(sc + c0), b1 = *(const f32x4*)(sh + c0);
#pragma unroll
            for (int u = 0; u < RB; ++u) { hv[u][j] = hv[u][j] * rstd[u] * g * (1.0f + s1) + b1;
                am[u] = fmaxf(fmaxf(am[u], fmaxf(fabsf(hv[u][j].x), fabsf(hv[u][j].y))), fmaxf(fabsf(hv[u][j].z), fabsf(hv[u][j].w))); } }
#pragma unroll
        for (int o = 1; o < 64; o <<= 1) {
#pragma unroll
            for (int u = 0; u < RB; ++u) am[u] = fmaxf(am[u], __shfl_xor(am[u], o)); }
#pragma unroll
        for (int u = 0; u < RB; ++u) { const float qs = am[u] > 0.f ? 127.0f / am[u] : 0.f;
            signed char* h8 = (signed char*)(ws + WS_H) + (size_t)(row0 + u) * 1024;
#pragma unroll
            for (int j = 0; j < 4; ++j) { const int q0 = (int)__builtin_rintf(hv[u][j].x * qs), q1 = (int)__builtin_rintf(hv[u][j].y * qs), q2 = (int)__builtin_rintf(hv[u][j].z * qs), q3 = (int)__builtin_rintf(hv[u][j].w * qs);
                *(unsigned*)(h8 + 4 * F.lane + 256 * j) = (unsigned)(q0 & 255) | ((unsigned)(q1 & 255) << 8) | ((unsigned)(q2 & 255) << 16) | ((unsigned)(q3 & 255) << 24); }
            if (F.lane == 0) ((float*)(ws + WS_SA))[row0 + u] = am[u] * (1.0f / 127.0f); }
        float p[RB][16];
#pragma unroll
        for (int e = 0; e < 16; ++e) { float sacc[RB];
#pragma unroll
            for (int u = 0; u < RB; ++u) sacc[u] = 0.f;
#pragma unroll
            for (int j = 0; j < 4; ++j) { const f32x4 w = *(const LAS f32x4*)(wrT + e * 1024 + 4 * F.lane + 256 * j);
#pragma unroll
                for (int u = 0; u < RB; ++u) sacc[u] += (hv[u][j].x * w.x + hv[u][j].y * w.y) + (hv[u][j].z * w.z + hv[u][j].w * w.w); }
#pragma unroll
            for (int u = 0; u < RB; ++u) p[u][e] = sacc[u];
            if ((e & 3) == 3) MEMFENCE(); }
        float lgt[RB];
#pragma unroll
        for (int u = 0; u < RB; ++u) { float r8[8], r4[4], r2[2];
          { const bool hb = (F.lane & 32) != 0;
#pragma unroll
            for (int j = 0; j < 8; ++j) { const float keep = hb ? p[u][8 + j] : p[u][j], send = hb ? p[u][j] : p[u][8 + j]; r8[j] = keep + __shfl_xor(send, 32); } }
          { const bool hb = (F.lane & 16) != 0;
#pragma unroll
            for (int j = 0; j < 4; ++j) { const float keep = hb ? r8[4 + j] : r8[j], send = hb ? r8[j] : r8[4 + j]; r4[j] = keep + __shfl_xor(send, 16); } }
          { const bool hb = (F.lane & 8) != 0;
#pragma unroll
            for (int j = 0; j < 2; ++j) { const float keep = hb ? r4[2 + j] : r4[j], send = hb ? r4[j] : r4[2 + j]; r2[j] = keep + __shfl_xor(send, 8); } }
          { const bool hb = (F.lane & 4) != 0; const float keep = hb ? r2[1] : r2[0], send = hb ? r2[0] : r2[1]; lgt[u] = keep + __shfl_xor(send, 4); }
          lgt[u] += __shfl_xor(lgt[u], 1); lgt[u] += __shfl_xor(lgt[u], 2); }
        float mx[RB], ex[RB], sum[RB];
#pragma unroll
        for (int u = 0; u < RB; ++u) mx[u] = lgt[u];
#pragma unroll
        for (int o = 4; o < 64; o <<= 1) {
#pragma unroll
            for (int u = 0; u < RB; ++u) mx[u] = fmaxf(mx[u], __shfl_xor(mx[u], o)); }
#pragma unroll
        for (int u = 0; u < RB; ++u) { ex[u] = __builtin_amdgcn_exp2f((lgt[u] - mx[u]) * LOG2E); sum[u] = ex[u]; }
#pragma unroll
        for (int o = 4; o < 64; o <<= 1) {
#pragma unroll
            for (int u = 0; u < RB; ++u) sum[u] += __shfl_xor(sum[u], o); }
        const int ee = ((F.lane >> 5) & 1) * 8 + ((F.lane >> 4) & 1) * 4 + ((F.lane >> 3) & 1) * 2 + ((F.lane >> 2) & 1);
#pragma unroll
        for (int u = 0; u < RB; ++u) { const float mine = ex[u] / sum[u]; const int row = row0 + u;
            if ((F.lane & 3) == 0) {
                if (isc) { const int r = row - LROWS; AFFC[((size_t)((r >> 8) * 16 + ee)) * CL + (r & 255)] = mine; }
                else AFF[((size_t)((row >> 13) * 16 + ee)) * SEQ + (row & 8191)] = mine;
                INV[(size_t)row * 16 + ee] = -1;
            } }
    }
#undef PF_LOAD
}


__device__ __forceinline__ void phase_f(KA a, Frame& F, int l, bool last) {
    relane(F);
    unsigned char* ws = a->ws;
    const float* MOD = (const float*)(ws + WS_MOD);
    float* AFF = (float*)(ws + WS_AFF); float* AFFC = (float*)(ws + WS_AFFC); int* INV = (int*)(ws + WS_INV);
    LAS float* wrT = (LAS float*)F.lds;
    const float* wr = a->in[I_WR] + (size_t)l * 1024 * 16;
    for (int idx = F.tid; idx < 16384; idx += NWAVES * 64) wrT[(idx & 15) * 1024 + (idx >> 4)] = wr[idx];
    __syncthreads();
    pf_rows<4>(a, F, l, 0, LROWS, wrT);
    if (!last) pf_rows<1>(a, F, l, LROWS, MROWS, wrT);
}

__device__ __forceinline__ void topk_set(Frame& F, const float* __restrict__ src, int n, int k, int rowbase, int slotbase, int e, int* IDX, float* GATE, int* INV, const float* SA, float* SAE) {
    LAS unsigned* keys = (LAS unsigned*)F.lds; LAS unsigned* hist = keys + 8192; LAS unsigned* sc = hist + 256;
    const int tid = F.tid;
    for (int i = tid; i < n; i += NWAVES * 64) keys[i] = __float_as_uint(src[i]);
    if (tid == 0) { unsigned z_ = 0u, k_ = (unsigned)k; asm volatile("" : "+v"(z_), "+v"(k_)); sc[0] = z_; sc[1] = k_; }
    __syncthreads();
    for (int pass = 0; pass < 4; ++pass) {
        const int shift = 24 - 8 * pass; const unsigned mask = (pass == 0) ? 0u : (0xFFFFFFFFu << (shift + 8));
        if (tid < 256) hist[tid] = 0u;
        __syncthreads();
        const unsigned prefix = sc[0];
        for (int i = tid; i < n; i += NWAVES * 64) { const unsigned kv = keys[i]; if ((kv & mask) == prefix) __hip_atomic_fetch_add(&hist[(kv >> shift) & 255u], 1u, __ATOMIC_RELAXED, __HIP_MEMORY_SCOPE_WORKGROUP); }
        __syncthreads();
        if (F.wave == 0) {
            const unsigned need = sc[1]; unsigned h[4]; unsigned tot = 0u;
#pragma unroll
            for (int j = 0; j < 4; ++j) { h[j] = hist[255 - (4 * F.lane + j)]; tot += h[j]; }
            unsigned incl = tot;
#pragma unroll
            for (int d = 1; d < 64; d <<= 1) { const unsigned t = __shfl_up(incl, d); if (F.lane >= d) incl += t; }
            unsigned cum = incl - tot;
#pragma unroll
            for (int j = 0; j < 4; ++j) { if (cum < need && need <= cum + h[j]) { sc[0] = prefix | ((unsigned)(255 - (4 * F.lane + j)) << shift); sc[1] = need - cum; } cum += h[j]; }
        }
        __syncthreads();
    }
    const unsigned T = sc[0], need_eq = sc[1];
    const int per = (n + NWAVES * 64 - 1) / (NWAVES * 64), start = tid * per;
    unsigned cg = 0u, ce = 0u;
    for (int j = 0; j < per; ++j) { const int i = start + j; if (i < n) { const unsigned kv = keys[i]; cg += (kv > T) ? 1u : 0u; ce += (kv == T) ? 1u : 0u; } }
    const unsigned packed = cg | (ce << 16);
    unsigned incl = packed;
#pragma unroll
    for (int d = 1; d < 64; d <<= 1) { const unsigned t = __shfl_up(incl, d); if (F.lane >= d) incl += t; }
    if (F.lane == 63) sc[8 + F.wave] = incl;
    __syncthreads();
    unsigned base = 0u;
    for (int w = 0; w < F.wave; ++w) base += sc[8 + w];
    const unsigned excl = base + incl - packed;
    unsigned gb = excl & 0xFFFFu, eb = excl >> 16;
    for (int j = 0; j < per; ++j) { const int i = start + j; if (i < n) { const unsigned kv = keys[i]; const bool g = kv > T, q = kv == T;
        if (g || (q && eb < need_eq)) { const int slot = slotbase + (int)(gb + (eb < need_eq ? eb : need_eq)); IDX[slot] = rowbase + i; GATE[slot] = __uint_as_float(kv); SAE[slot] = SA[rowbase + i]; INV[(size_t)(rowbase + i) * 16 + e] = slot; }
        gb += g ? 1u : 0u; eb += q ? 1u : 0u; } }
    __syncthreads();
}
struct CvtItem { const float* wp; int N; unsigned char* wt; int ldt; float qs; int f8; };
__device__ __forceinline__ void cvt_load(const CvtItem& I, float (&tv)[32]) {
#pragma unroll
    for (int i = 0; i < 32; ++i) tv[i] = __builtin_nontemporal_load(I.wp + (size_t)(2 * i) * I.N);
}
__device__ __forceinline__ void cvt_store(const CvtItem& I, const float (&tv)[32], LAS float* scr, int lane) {
#pragma unroll
    for (int i = 0; i < 32; ++i) scr[(2 * i + (lane >> 5)) * 33 + (lane & 31)] = tv[i];
    LDS_WAIT(); asm volatile("" ::: "memory");
    const int c = lane & 3;
#pragma unroll
    for (int j = 0; j < 2; ++j) { const int n = (lane >> 2) + 16 * j; const LAS float* sp = scr + (16 * c) * 33 + n; v4u o;
        if (I.f8) {
#pragma unroll
            for (int d = 0; d < 4; ++d) { float f[4];
#pragma unroll
                for (int i = 0; i < 4; ++i) f[i] = fminf(fmaxf(sp[(4 * d + i) * 33] * I.qs, -448.0f), 448.0f);
                int w = __builtin_amdgcn_cvt_pk_fp8_f32(f[0], f[1], 0, false); w = __builtin_amdgcn_cvt_pk_fp8_f32(f[2], f[3], w, true); o[d] = (unsigned)w; }
        } else {
#pragma unroll
            for (int d = 0; d < 4; ++d) { unsigned w = 0u;
#pragma unroll
                for (int i = 0; i < 4; ++i) { const float f = fminf(fmaxf(sp[(4 * d + i) * 33] * I.qs, -127.0f), 127.0f); w |= ((unsigned)((int)__builtin_rintf(f)) & 255u) << (8 * i); }
                o[d] = w; }
        }
        *(v4u*)(I.wt + (size_t)n * I.ldt + 16 * c) = o; }
    LDS_WAIT(); asm volatile("" ::: "memory");
}
__device__ __forceinline__ void phase_g(KA a, Frame& F, int l, bool last, int rep) {
    relane(F);
    unsigned char* ws = a->ws;
    const float* AFF = (const float*)(ws + WS_AFF); const float* AFFC = (const float*)(ws + WS_AFFC);
    int* IDX = (int*)(ws + WS_IDX); float* GATE = (float*)(ws + WS_GATE); int* INV = (int*)(ws + WS_INV);
    const float* SA = (const float*)(ws + WS_SA); float* SAE = (float*)(ws + WS_SAE);
    const int RPE = last ? 4096 : 4352, nsets = last ? 64 : 128;
    for (int set = blockIdx.x; set < nsets; set += F.G) {
        if (set < 64) { const int b = set >> 4, e = set & 15; topk_set(F, AFF + (size_t)set * SEQ, SEQ, CAPL, b * SEQ, e * RPE + b * CAPL, e, IDX, GATE, INV, SA, SAE); }
        else { const int s2 = set - 64, b = s2 >> 4, e = s2 & 15; topk_set(F, AFFC + (size_t)s2 * CL, CL, CAPC, LROWS + b * CL, e * RPE + 4096 + b * CAPC, e, IDX, GATE, INV, SA, SAE);
            if (b == 0 && F.tid < 128) { IDX[e * RPE + 4224 + F.tid] = -1; GATE[e * RPE + 4224 + F.tid] = 0.f; SAE[e * RPE + 4224 + F.tid] = 0.f; } }
    }
    {
        LAS float* scr = (LAS float*)(F.lds + 40960 + F.wave * 8704);
        gu32* head = F.ctl + CW_Q + 64 * l + 128 * rep;
        constexpr int NIT = NE * 3072;
        const float* wg = a->in[I_WG] + (size_t)l * NE * 1024 * 2048; const float* wu = a->in[I_WU] + (size_t)l * NE * 1024 * 2048; const float* wd = a->in[I_WD] + (size_t)l * NE * 2048 * 1024;
        const float* SWL = (const float*)(ws + WS_SW) + l * 48;
        for (;;) {
            unsigned basev = 0u;
            if (F.lane == 0) basev = __hip_atomic_fetch_add(head, 8u, RLX_AGENT);
            const int base = __builtin_amdgcn_readfirstlane((int)basev);
            if (base >= NIT) break;
#define CVT_SETUP(I, j) do { const int it_ = base + (j); const int e_ = it_ / 3072, r_ = it_ % 3072, which_ = r_ >> 10, ii_ = r_ & 1023; \
                if (which_ < 2) { const int kb_ = ii_ >> 6, n0_ = (ii_ & 63) * 32; const int rowbase_ = (n0_ >> 7) * 256 + (n0_ & 127) + which_ * 128; \
                    I.wp = (which_ ? wu : wg) + (size_t)e_ * 1024 * 2048 + (size_t)(kb_ * 64 + (F.lane >> 5)) * 2048 + n0_ + (F.lane & 31); I.N = 2048; \
                    I.wt = (unsigned char*)(ws + WS_WGU) + (size_t)e_ * 4096 * 1024 + (size_t)rowbase_ * 1024 + kb_ * 64; I.ldt = 1024; I.qs = 1.0f / SWL[3 * e_ + which_]; I.f8 = 0; } \
                else { const int kb_ = ii_ >> 5, n0_ = (ii_ & 31) * 32; \
                    I.wp = wd + (size_t)e_ * 2048 * 1024 + (size_t)(kb_ * 64 + (F.lane >> 5)) * 1024 + n0_ + (F.lane & 31); I.N = 1024; \
                    I.wt = (unsigned char*)(ws + WS_WD) + (size_t)e_ * 1024 * 2048 + (size_t)n0_ * 2048 + kb_ * 64; I.ldt = 2048; I.qs = 1.0f / SWL[3 * e_ + 2]; I.f8 = 1; } } while (0)
            CvtItem IA, IB; float tvA[32], tvB[32];
            CVT_SETUP(IA, 0); cvt_load(IA, tvA);
#pragma unroll
            for (int jj = 0; jj < 4; ++jj) {
                CVT_SETUP(IB, 2 * jj + 1); cvt_load(IB, tvB);
                cvt_store(IA, tvA, scr, F.lane);
                if (jj < 3) { CVT_SETUP(IA, 2 * jj + 2); cvt_load(IA, tvA); }
                cvt_store(IB, tvB, scr, F.lane);
            }
#undef CVT_SETUP
        }
    }
}

__device__ __forceinline__ void phase_h(KA a, Frame& F, bool last) {
    relane(F);
    unsigned char* ws = a->ws;
    const int* IDX = (const int*)(ws + WS_IDX); const unsigned char* H8 = (const unsigned char*)(ws + WS_H); unsigned char* XE = (unsigned char*)(ws + WS_XE);
    const float* SA = (const float*)(ws + WS_SA); float* SAE = (float*)(ws + WS_SAE);
    const int nrow = NE * (last ? 4096 : 4352);
    const int gw = F.vcu * NWAVES + F.wave, NGW = F.G * NWAVES;
    for (int r = gw; r < nrow; r += NGW) {
        const int s = __builtin_amdgcn_readfirstlane(IDX[r]);
        v4u v0 = (v4u){0u, 0u, 0u, 0u}; float sc = 0.f;
        if (s >= 0) { v0 = ((const v4u*)(H8 + (size_t)s * 1024))[F.lane]; sc = SA[s]; }
        ((v4u*)(XE + (size_t)r * 1024))[F.lane] = v0;
        if (F.lane == 0) SAE[r] = sc;
    }
}
__global__ void __launch_bounds__(NWAVES * 64, 2) mk_fwd(Args args) {
    extern __shared__ __attribute__((aligned(16))) unsigned char lds[];
    Frame F;
    F.lds = (LAS unsigned char*)lds;
    F.MISC = (volatile LAS unsigned*)(F.lds + MISC_OFF);
    F.tid = threadIdx.x; F.lane = F.tid & 63; F.wave = __builtin_amdgcn_readfirstlane(F.tid >> 6);
    F.G = gridDim.x; { const int bx = blockIdx.x; F.vcu = (F.G % 8 == 0) ? (bx % 8) * (F.G / 8) + bx / 8 : bx; }
    F.ctl = (gu32*)(args.ws + WS_CTL);
    for (int u = F.tid; u < (LDS_BYTES - LDSCTL_OFF) / 4; u += NWAVES * 64) ((LAS unsigned*)(F.lds + LDSCTL_OFF))[u] = 0u;
    __syncthreads();
    const int lo = args.ph_lo, hi = args.ph_hi;
    const bool multi = (hi - lo) > 1;
    XcdBarrier bar; bar.bar = (unsigned*)(F.ctl + CW_BAR); bar.x = 0; bar.st = nullptr;
    if (multi) bar = xcd_barrier_post((unsigned*)(F.ctl + CW_BAR), F.MISC + 8);
#define IN(k) (lo <= (k) && (k) < hi)
#define SEAM(k) do { if (IN((k) + 1)) xcd_barrier(bar); } while (0)
#define REP(kind) (((MK_REP) >> (kind)) & 1)
#define RUNPH(kind, k, ...) do { if (IN(k)) { for (int rep_ = 0; rep_ <= REP(kind); ++rep_) { __VA_ARGS__; if (rep_ < REP(kind)) xcd_barrier(bar); } SEAM(k); } } while (0)

    RUNPH(0, 0, p0_prologue(kargs(), F));

    for (int l = 0; l < NLAYER; ++l) {
        const bool last = (l == NLAYER - 1);
        const int pb = 1 + 10 * l;
        const int RPE = last ? 4096 : 4352;
        if (IN(pb + 0)) { for (int rep_ = 0; rep_ <= (l == 0 ? REP(1) : 0); ++rep_) { phase_a(kargs(), F, l); if (rep_ < REP(1) && l == 0) xcd_barrier(bar); } SEAM(pb + 0); }
        if (IN(pb + 1)) { for (int rep_ = 0; rep_ <= REP(2); ++rep_) {
            KA ka = kargs(); unsigned char* ws = ka->ws;
            pg8::Gemm g{(const pg8::bf16_t*)(ws + WS_H), (const pg8::bf16_t*)(ws + WS_WCAT8 + (size_t)l * ZP * 1024), MROWS, ZP, DM / 2, 1 << 30, 0};
            pg8::StaticOrder S; S.init(MROWS, ZP, F.G, (int)blockIdx.x);
            pg8::EpiStoreBf16I8 E{(pg8::bf16_t*)(ws + WS_Z), ZP, (const float*)(ws + WS_SA), (const float*)(ws + WS_SWC) + (size_t)l * ZP, (float*)(ws + WS_SSQ)};
            pg8::gemm_phase<pg8::EpiStoreBf16I8, pg8::StaticOrder, true, true, 1>(F.lds, g, S, E);
            if (rep_ < REP(2)) xcd_barrier(bar); }
            SEAM(pb + 1);
        }
        RUNPH(3, pb + 2, phase_c(kargs(), F, l));
        RUNPH(4, pb + 3, phase_d<0>(kargs(), F, l, last); if (MK_ABL) { xcd_barrier(bar); phase_d<MK_ABL>(kargs(), F, l, last); });
        if (IN(pb + 4)) { for (int rep_ = 0; rep_ <= REP(5); ++rep_) {
            KA ka = kargs(); unsigned char* ws = ka->ws; const float* MODL = (const float*)(ws + WS_MOD) + (size_t)l * 5 * 6144;
            const int M = last ? LROWS : MROWS;
            pg8::Gemm g{(const pg8::bf16_t*)(ws + WS_ATT), (const pg8::bf16_t*)(ws + WS_WO) + (size_t)l * 1024 * 1024, M, DM, DM, 1 << 30, 0};
            pg8::StaticOrder S; S.init(M, DM, F.G, (int)blockIdx.x);
            pg8::EpiColGateBf16 E{(pg8::bf16_t*)(ws + WS_DELTA), DM, MODL, LROWS};
            pg8::gemm_phase<pg8::EpiColGateBf16, pg8::StaticOrder, true, true>(F.lds, g, S, E);
            if (rep_ < REP(5)) xcd_barrier(bar); }
            SEAM(pb + 4);
        }
        RUNPH(6, pb + 5, phase_f(kargs(), F, l, last));
        RUNPH(7, pb + 6, phase_g(kargs(), F, l, last, rep_));
        if (IN(pb + 8)) { for (int rep_ = 0; rep_ <= REP(9); ++rep_) {
            KA ka = kargs(); unsigned char* ws = ka->ws;
            pg8::Gemm g{(const pg8::bf16_t*)(ws + WS_H), (const pg8::bf16_t*)(ws + WS_WGU), NE * RPE, 2 * FFD, DM / 2, RPE / 256, (size_t)2 * FFD * DM, (const int*)(ws + WS_IDX)};
            pg8::StaticOrder S; S.init(NE * RPE, 2 * FFD, F.G, (int)blockIdx.x);
            pg8::EpiSwiGLUI8 E{(unsigned char*)(ws + WS_HID), FFD, (const float*)(ws + WS_SAE), (const float*)(ws + WS_SW) + l * 48, RPE / 256, HID_SCALE};
            if (MK_NOEPI && rep_ == 1) { pg8::EpiNullI8 EN{}; pg8::gemm_phase<pg8::EpiNullI8, pg8::StaticOrder, true, true, 1, true>(F.lds, g, S, EN); }
            else pg8::gemm_phase<pg8::EpiSwiGLUI8, pg8::StaticOrder, true, true, 1, true>(F.lds, g, S, E);
            if (rep_ < REP(9)) xcd_barrier(bar); }
            SEAM(pb + 8);
        }
        if (IN(pb + 9)) { for (int rep_ = 0; rep_ <= REP(10); ++rep_) {
            KA ka = kargs(); unsigned char* ws = ka->ws;
            pg8::Gemm g{(const pg8::bf16_t*)(ws + WS_HID), (const pg8::bf16_t*)(ws + WS_WD), NE * RPE, DM, FFD / 2, RPE / 256, (size_t)DM * FFD};
            pg8::StaticOrder S; S.init(NE * RPE, DM, F.G, (int)blockIdx.x);
            pg8::EpiRowScaleBf16 E{(pg8::bf16_t*)(ws + WS_YE), DM, (const float*)(ws + WS_GATE), (const float*)(ws + WS_SW) + l * 48, RPE / 256, 1.0f / HID_SCALE};
            pg8::gemm_phase<pg8::EpiRowScaleBf16, pg8::StaticOrder, true, true, 2>(F.lds, g, S, E);
            if (rep_ < REP(10)) xcd_barrier(bar); }
            SEAM(pb + 9);
        }
    }
    if (IN(N_PHASES - 1)) phase_a(kargs(), F, NLAYER);
#undef IN
#undef SEAM
}

extern "C" void kernel_launch(void* const* d_in, const int* in_sizes, int n_in, void* d_out, int out_size, void* d_ws, size_t ws_size, hipStream_t stream) {
    static int grid = 0;
    if (grid == 0) {
        if (n_in != N_IN || out_size != LROWS * DM || ws_size < WS_END) { fprintf(stderr, "kernel_launch: unexpected shapes (n_in %d, out %d, ws %zu); nothing launched\n", n_in, out_size, ws_size); grid = -1; return; }
        int dev = 0, cus = 0, per_cu = 0;
        if (hipGetDevice(&dev) != hipSuccess || hipDeviceGetAttribute(&cus, hipDeviceAttributeMultiprocessorCount, dev) != hipSuccess) { grid = -1; return; }
        if (hipFuncSetAttribute((const void*)mk_fwd, hipFuncAttributeMaxDynamicSharedMemorySize, LDS_BYTES) != hipSuccess) { fprintf(stderr, "kernel_launch: hipFuncSetAttribute failed\n"); grid = -1; return; }
        if (hipOccupancyMaxActiveBlocksPerMultiprocessor(&per_cu, (const void*)mk_fwd, NWAVES * 64, LDS_BYTES) != hipSuccess || per_cu < 1) { fprintf(stderr, "kernel_launch: occupancy query reports %d blocks per CU\n", per_cu); }
        (void)hipGetLastError();
        grid = cus;
    }
    if (grid < 0) return;
    if (hipMemsetAsync((char*)d_ws + WS_CTL, 0, CTL_ZERO_BYTES, stream) != hipSuccess) { fprintf(stderr, "kernel_launch: memset failed\n"); return; }
    Args a{};
    for (int i = 0; i < N_IN; ++i) a.in[i] = (const float*)d_in[i];
    a.out = (float*)d_out; a.ws = (unsigned char*)d_ws;
#if MK_SPLIT
    for (int ph = 0; ph < N_PHASES; ++ph) { a.ph_lo = ph; a.ph_hi = ph + 1; hipLaunchKernelGGL(mk_fwd, dim3(grid), dim3(NWAVES * 64), LDS_BYTES, stream, a); }
#else
    a.ph_lo = 0; a.ph_hi = N_PHASES;
    hipLaunchKernelGGL(mk_fwd, dim3(grid), dim3(NWAVES * 64), LDS_BYTES, stream, a);
#endif
    const hipError_t le = hipPeekAtLastError();
    if (le != hipSuccess) fprintf(stderr, "kernel_launch: launch failed: %s\n", hipGetErrorName(le));
}
```

```cpp
#include <hip/hip_runtime.h>
#include <hip/hip_bf16.h>
#include <cstdio>
#include <cstdint>
#ifndef MK_SPLIT
#define MK_SPLIT 0
#endif
#ifndef MK_REP
#define MK_REP 0
#endif
#ifndef MK_NOEPI
#define MK_NOEPI 0
#endif
#ifndef MK_ABL
#define MK_ABL 0
#endif
namespace pg8 {
#define PG8_LAS __attribute__((address_space(3)))
typedef unsigned short bf16_t;
typedef short bf16x8 __attribute__((ext_vector_type(8)));
typedef float f32x4 __attribute__((ext_vector_type(4)));
typedef unsigned u32x4 __attribute__((ext_vector_type(4)));
constexpr int BM = 256, BK = 64, HALF = 128, HTB = HALF * BK * 2  , STAGE_BYTES = 8 * HTB, NXCD = 8, WGM = 8;

__host__ __device__ __forceinline__ int lds_byte(int r, int c) { const int st = (r >> 4) * 2 + (c >> 5), rr = r & 15, cc = c & 31, ob = rr * 64 + cc * 2; return st * 1024 + (ob ^ (((ob >> 9) & 1) << 5)); }
__host__ __device__ __forceinline__ void stage_rc(int b, int& R, int& C) { const int st = b / 1024, sb = b % 1024, swz = sb ^ (((sb >> 9) & 1) << 5); R = (st >> 1) * 16 + swz / 64; C = (st & 1) * 32 + (swz % 64) / 2; }
__host__ __device__ __forceinline__ int perm32(int rho) { const int n = rho >> 4, i = rho & 15; return 8 * (i >> 2) + 4 * n + (i & 3); }

struct Unit { int pm, pn, li; };
struct Gemm { const bf16_t* A; const bf16_t* Bt; int M, N, K; int tpe; size_t bgs; const int* gidx = nullptr; };

struct StaticOrder {
    int nM, nN, nwg, G, c;
    __host__ __device__ void init(int M, int N, int G_, int c_) { nM = M / BM; nN = N / BM; nwg = nM * nN; G = G_; c = c_; }
    __host__ __device__ bool next(int i, Unit& u) const {
        const long L = (long)i * G + c; if (L >= nwg) return false;
        int wgid = (int)L; { const int q = nwg / NXCD, r = nwg % NXCD, xcd = wgid % NXCD, off = wgid / NXCD; wgid = (xcd < r ? xcd * (q + 1) : r * (q + 1) + (xcd - r) * q) + off; }
        const int nig = WGM * nN, gid = wgid / nig, fm = gid * WGM, gsz = (nM - fm) < WGM ? (nM - fm) : WGM;
        u.pm = fm + ((wgid % nig) % gsz); u.pn = (wgid % nig) / gsz; u.li = i; return true;
    }
    __device__ __forceinline__ void a_ready(const Unit&) const {}
    __device__ __forceinline__ void done(const Unit&) const {}
};
typedef int i32x4 __attribute__((ext_vector_type(4)));
__device__ __forceinline__ unsigned cvt_pk_bf16(float lo, float hi) { unsigned r; asm volatile("v_cvt_pk_bf16_f32 %0, %1, %2" : "=v"(r) : "v"(lo), "v"(hi)); return r; }
constexpr int GTAB_OFF = STAGE_BYTES + 2048, RTAB_OFF = GTAB_OFF + 17 * BM * 2, TAB_UNITS = 17;
template <class Sched> __device__ __forceinline__ void fill_rtab(PG8_LAS unsigned char* lds, const Sched& S, const float* rowv, int tid) {
    PG8_LAS float* rt = (PG8_LAS float*)(lds + RTAB_OFF); Unit uu;
    for (int i = 0; i < TAB_UNITS && S.next(i, uu); ++i) { if (tid < BM) rt[i * BM + tid] = rowv[uu.pm * BM + tid]; } }
struct EpiStoreBf16 {
    static constexpr bool PERM = true, AFTER_DRAIN = false;
    bf16_t* O; int ldc;
    template <class Sched> __device__ __forceinline__ void prefill(PG8_LAS unsigned char*, const Sched&, int) const {}
    __device__ __forceinline__ void operator()(const f32x4 (&acc)[2][2][4][2], const Unit& u, int wr, int wc, int fr, int fq, PG8_LAS unsigned char* lds) const {
        const int row0 = u.pm * BM + wr * 64 + fr, col0 = u.pn * BM + wc * 32 + 8 * fq;
#pragma unroll
        for (int ai = 0; ai < 2; ++ai)
#pragma unroll
            for (int m = 0; m < 4; ++m) { bf16_t* rowp = O + (size_t)(row0 + ai * HALF + m * 16) * ldc + col0;
#pragma unroll
                for (int bj = 0; bj < 2; ++bj) { const f32x4 v0 = acc[ai][bj][m][0], v1 = acc[ai][bj][m][1];
                    u32x4 w; w.x = cvt_pk_bf16(v0[0], v0[1]); w.y = cvt_pk_bf16(v0[2], v0[3]); w.z = cvt_pk_bf16(v1[0], v1[1]); w.w = cvt_pk_bf16(v1[2], v1[3]);
                    *(u32x4*)(rowp + bj * HALF) = w; } }
    }
};
struct EpiStoreBf16I8 {
    static constexpr bool PERM = true, AFTER_DRAIN = false;
    bf16_t* O; int ldc; const float* sa; const float* sw; float* ssq;
    template <class Sched> __device__ __forceinline__ void prefill(PG8_LAS unsigned char* lds, const Sched& S, int tid) const { fill_rtab(lds, S, sa, tid); }
    __device__ __forceinline__ void operator()(const i32x4 (&acc)[2][2][4][2], const Unit& u, int wr, int wc, int fr, int fq, PG8_LAS unsigned char* lds) const {
        const int row0 = u.pm * BM + wr * 64 + fr, col0 = u.pn * BM + wc * 32 + 8 * fq;
        f32x4 cs[2][2];
#pragma unroll
        for (int bj = 0; bj < 2; ++bj)
#pragma unroll
            for (int n = 0; n < 2; ++n) cs[bj][n] = *(const f32x4*)(sw + col0 + bj * HALF + 4 * n);
#pragma unroll
        for (int ai = 0; ai < 2; ++ai)
#pragma unroll
            for (int m = 0; m < 4; ++m) { const int row = row0 + ai * HALF + m * 16; const float rs = ((const PG8_LAS float*)(lds + RTAB_OFF))[u.li * BM + (row - u.pm * BM)]; bf16_t* rowp = O + (size_t)row * ldc + col0;
#pragma unroll
                for (int bj = 0; bj < 2; ++bj) { const i32x4 a0 = acc[ai][bj][m][0], a1 = acc[ai][bj][m][1]; const f32x4 c0 = cs[bj][0] * rs, c1 = cs[bj][1] * rs;
                    const float z0 = (float)a0[0] * c0[0], z1 = (float)a0[1] * c0[1], z2 = (float)a0[2] * c0[2], z3 = (float)a0[3] * c0[3];
                    const float z4 = (float)a1[0] * c1[0], z5 = (float)a1[1] * c1[1], z6 = (float)a1[2] * c1[2], z7 = (float)a1[3] * c1[3];
                    u32x4 w; w.x = cvt_pk_bf16(z0, z1); w.y = cvt_pk_bf16(z2, z3); w.z = cvt_pk_bf16(z4, z5); w.w = cvt_pk_bf16(z6, z7);
                    *(u32x4*)(rowp + bj * HALF) = w;
                    if (u.pn == 0 || (u.pn == 1 && bj == 0)) {
                        float q = ((z0 * z0 + z1 * z1) + (z2 * z2 + z3 * z3)) + ((z4 * z4 + z5 * z5) + (z6 * z6 + z7 * z7));
                        q += __shfl_xor(q, 16); q += __shfl_xor(q, 32);
                        if (fq == 0) ssq[(size_t)row * 12 + (u.pn == 0 ? bj * 4 + wc : 8 + wc)] = q; } } }
    }
};
struct EpiColGateBf16 {
    static constexpr bool PERM = true, AFTER_DRAIN = false;
    bf16_t* O; int ldc; const float* mod; int lrows;
    template <class Sched> __device__ __forceinline__ void prefill(PG8_LAS unsigned char*, const Sched&, int) const {}
    __device__ __forceinline__ void operator()(const f32x4 (&acc)[2][2][4][2], const Unit& u, int wr, int wc, int fr, int fq, PG8_LAS unsigned char* lds) const {
        const int R0 = u.pm * BM; const int v = (R0 >= lrows) ? 4 : (R0 >> 13);
        const float* ga = mod + v * 6144 + 2 * 1024;
        const int row0 = R0 + wr * 64 + fr, col0 = u.pn * BM + wc * 32 + 8 * fq;
        f32x4 g[2][2];
#pragma unroll
        for (int bj = 0; bj < 2; ++bj)
#pragma unroll
            for (int n = 0; n < 2; ++n) g[bj][n] = *(const f32x4*)(ga + col0 + bj * HALF + 4 * n);
#pragma unroll
        for (int ai = 0; ai < 2; ++ai)
#pragma unroll
            for (int m = 0; m < 4; ++m) { bf16_t* rowp = O + (size_t)(row0 + ai * HALF + m * 16) * ldc + col0;
#pragma unroll
                for (int bj = 0; bj < 2; ++bj) { const f32x4 v0 = acc[ai][bj][m][0] * g[bj][0], v1 = acc[ai][bj][m][1] * g[bj][1];
                    u32x4 w; w.x = cvt_pk_bf16(v0[0], v0[1]); w.y = cvt_pk_bf16(v0[2], v0[3]); w.z = cvt_pk_bf16(v1[0], v1[1]); w.w = cvt_pk_bf16(v1[2], v1[3]);
                    *(u32x4*)(rowp + bj * HALF) = w; } }
    }
};
__device__ __forceinline__ float silu_mul(float g, float u) { return g * __builtin_amdgcn_rcpf(1.0f + __builtin_amdgcn_exp2f(-1.4426950408889634f * g)) * u; }
struct EpiSwiGLU {
    static constexpr bool PERM = true, AFTER_DRAIN = false;
    bf16_t* O; int ldc;
    template <class Sched> __device__ __forceinline__ void prefill(PG8_LAS unsigned char*, const Sched&, int) const {}
    __device__ __forceinline__ void operator()(const f32x4 (&acc)[2][2][4][2], const Unit& u, int wr, int wc, int fr, int fq, PG8_LAS unsigned char* lds) const {
        const int row0 = u.pm * BM + wr * 64 + fr, col0 = u.pn * HALF + wc * 32 + 8 * fq;
#pragma unroll
        for (int ai = 0; ai < 2; ++ai)
#pragma unroll
            for (int m = 0; m < 4; ++m) { const f32x4 g0 = acc[ai][0][m][0], g1 = acc[ai][0][m][1], u0 = acc[ai][1][m][0], u1 = acc[ai][1][m][1];
                u32x4 w; w.x = cvt_pk_bf16(silu_mul(g0[0], u0[0]), silu_mul(g0[1], u0[1])); w.y = cvt_pk_bf16(silu_mul(g0[2], u0[2]), silu_mul(g0[3], u0[3]));
                w.z = cvt_pk_bf16(silu_mul(g1[0], u1[0]), silu_mul(g1[1], u1[1])); w.w = cvt_pk_bf16(silu_mul(g1[2], u1[2]), silu_mul(g1[3], u1[3]));
                *(u32x4*)(O + (size_t)(row0 + ai * HALF + m * 16) * ldc + col0) = w; }
    }
};
__device__ __forceinline__ float clamp448(float x) { return fminf(fmaxf(x, -448.0f), 448.0f); }
struct EpiSwiGLUI8 {
    static constexpr bool PERM = true, AFTER_DRAIN = false;
    unsigned char* O; int ldc; const float* sa; const float* sw; int tpe; float hs;
    template <class Sched> __device__ __forceinline__ void prefill(PG8_LAS unsigned char* lds, const Sched& S, int tid) const { fill_rtab(lds, S, sa, tid); }
    __device__ __forceinline__ void operator()(const i32x4 (&acc)[2][2][4][2], const Unit& u, int wr, int wc, int fr, int fq, PG8_LAS unsigned char* lds) const {
        const int row0 = u.pm * BM + wr * 64 + fr, col0 = u.pn * HALF + wc * 32 + 8 * fq; const int e = u.pm / tpe;
        const float sg = sw[3 * e], su = sw[3 * e + 1] * hs;
#pragma unroll
        for (int ai = 0; ai < 2; ++ai)
#pragma unroll
            for (int m = 0; m < 4; ++m) { const int row = row0 + ai * HALF + m * 16; const float rs = ((const PG8_LAS float*)(lds + RTAB_OFF))[u.li * BM + (row - u.pm * BM)], fg = rs * sg, fu = rs * su;
                const i32x4 g0 = acc[ai][0][m][0], g1 = acc[ai][0][m][1], u0 = acc[ai][1][m][0], u1 = acc[ai][1][m][1];
                typedef float f32x2 __attribute__((ext_vector_type(2)));
                float h[8]; f32x2 gi[4], gu[4], ev[4];
                const float tg = -1.4426950408889634f * fg, fgu = fg * fu;
#pragma unroll
                for (int i = 0; i < 2; ++i) { gi[i] = (f32x2){(float)g0[2 * i], (float)g0[2 * i + 1]}; gi[2 + i] = (f32x2){(float)g1[2 * i], (float)g1[2 * i + 1]};
                    gu[i] = gi[i] * (f32x2){(float)u0[2 * i], (float)u0[2 * i + 1]}; gu[2 + i] = gi[2 + i] * (f32x2){(float)u1[2 * i], (float)u1[2 * i + 1]}; }
                __builtin_amdgcn_sched_barrier(0);
#pragma unroll
                for (int i = 0; i < 4; ++i) { const f32x2 t = gi[i] * tg; ev[i] = (f32x2){__builtin_amdgcn_exp2f(t.x), __builtin_amdgcn_exp2f(t.y)}; }
                __builtin_amdgcn_sched_barrier(0);
#pragma unroll
                for (int i = 0; i < 4; ++i) { const f32x2 d = ev[i] + 1.0f; ev[i] = (f32x2){__builtin_amdgcn_rcpf(d.x), __builtin_amdgcn_rcpf(d.y)}; }
                __builtin_amdgcn_sched_barrier(0);
#pragma unroll
                for (int i = 0; i < 4; ++i) { const f32x2 hv = gu[i] * ev[i] * fgu; h[2 * i] = clamp448(hv.x); h[2 * i + 1] = clamp448(hv.y); }
                int w0 = __builtin_amdgcn_cvt_pk_fp8_f32(h[0], h[1], 0, false); w0 = __builtin_amdgcn_cvt_pk_fp8_f32(h[2], h[3], w0, true);
                int w1 = __builtin_amdgcn_cvt_pk_fp8_f32(h[4], h[5], 0, false); w1 = __builtin_amdgcn_cvt_pk_fp8_f32(h[6], h[7], w1, true);
                typedef unsigned u32x2 __attribute__((ext_vector_type(2)));
                *(u32x2*)(O + (size_t)row * ldc + col0) = (u32x2){(unsigned)w0, (unsigned)w1}; }
    }
};
struct EpiNullI8 {
    static constexpr bool PERM = true, AFTER_DRAIN = false;
    template <class Sched> __device__ __forceinline__ void prefill(PG8_LAS unsigned char*, const Sched&, int) const {}
    __device__ __forceinline__ void operator()(const i32x4 (&acc)[2][2][4][2], const Unit& u, int wr, int wc, int fr, int fq, PG8_LAS unsigned char* lds) const {
#pragma unroll
        for (int ai = 0; ai < 2; ++ai)
#pragma unroll
            for (int bj = 0; bj < 2; ++bj)
#pragma unroll
                for (int m = 0; m < 4; ++m) { asm volatile("" :: "v"(acc[ai][bj][m][0]), "v"(acc[ai][bj][m][1])); }
    }
};
struct EpiRowScaleBf16 {
    static constexpr bool PERM = true, AFTER_DRAIN = false;
    bf16_t* O; int ldc; const float* rs; const float* es; int tpe; float cs;
    template <class Sched> __device__ __forceinline__ void prefill(PG8_LAS unsigned char* lds, const Sched& S, int tid) const { fill_rtab(lds, S, rs, tid); }
    __device__ __forceinline__ void operator()(const f32x4 (&acc)[2][2][4][2], const Unit& u, int wr, int wc, int fr, int fq, PG8_LAS unsigned char* lds) const {
        const int row0 = u.pm * BM + wr * 64 + fr, col0 = u.pn * BM + wc * 32 + 8 * fq;
#pragma unroll
        for (int ai = 0; ai < 2; ++ai)
#pragma unroll
            for (int m = 0; m < 4; ++m) { const int row = row0 + ai * HALF + m * 16; const float s = ((const PG8_LAS float*)(lds + RTAB_OFF))[u.li * BM + (row - u.pm * BM)] * (es[3 * (u.pm / tpe) + 2] * cs); bf16_t* rowp = O + (size_t)row * ldc + col0;
#pragma unroll
                for (int bj = 0; bj < 2; ++bj) { const f32x4 v0 = acc[ai][bj][m][0] * s, v1 = acc[ai][bj][m][1] * s;
                    u32x4 w; w.x = cvt_pk_bf16(v0[0], v0[1]); w.y = cvt_pk_bf16(v0[2], v0[3]); w.z = cvt_pk_bf16(v1[0], v1[1]); w.w = cvt_pk_bf16(v1[2], v1[3]);
                    *(u32x4*)(rowp + bj * HALF) = w; } }
    }
};
typedef int i32x4 __attribute__((ext_vector_type(4)));
typedef int i32x8 __attribute__((ext_vector_type(8)));
template <int MODE> struct AccSel { typedef f32x4 type; };
template <> struct AccSel<1> { typedef i32x4 type; };
template <int MODE> struct Frag { bf16x8 v[2]; __device__ __forceinline__ void set(int k, bf16x8 x) { v[k] = x; } };
template <> struct Frag<2> { i32x8 w; __device__ __forceinline__ void set(int k, bf16x8 x) { const i32x4 y = __builtin_bit_cast(i32x4, x); if (k == 0) w.lo = y; else w.hi = y; } };
template <class Epi, class Sched, bool ALIGN_EPI = false, bool SP2 = false, int MODE = 0, bool GATHER = false>
__device__ __forceinline__ void gemm_phase(PG8_LAS unsigned char* lds, const Gemm g, const Sched& S, const Epi& E) {
    int tid_l = threadIdx.x; asm volatile("" : "+v"(tid_l));
    const int tid = tid_l, wid = __builtin_amdgcn_readfirstlane(tid >> 6), lane = tid & 63, wr = wid >> 2, wc = wid & 3, fr = lane & 15, fq = lane >> 4;
    const int K = g.K, nt = K / BK;
    unsigned voffA[2], voffB[2];
#pragma unroll
    for (int i = 0; i < 2; ++i) { int R, C; stage_rc(tid * 16 + i * 8192, R, C); const int Rb = Epi::PERM ? ((R & ~31) + perm32(R & 31)) : R;
        voffA[i] = (unsigned)(R * K + C) * 2u; voffB[i] = (unsigned)(Rb * K + C) * 2u; }
    static_assert(!GATHER || SP2, "the gathered A operand is wired into the SP2 schedule only");
    unsigned gvc[2][2] = {{0u, 0u}, {0u, 0u}};
    PG8_LAS unsigned short* gtab = (PG8_LAS unsigned short*)(lds + GTAB_OFF);
    if constexpr (GATHER) { Unit uu_;
        for (int i_ = 0; S.next(i_, uu_); ++i_) { if (tid < BM) { const int ix_ = g.gidx[uu_.pm * BM + tid]; gtab[i_ * BM + tid] = (unsigned short)(ix_ < 0 ? 0 : ix_); } }
    }
    E.prefill(lds, S, tid);
    __syncthreads();
#define PG8_GOFF(ui_, gv_) do { if constexpr (GATHER) { _Pragma("unroll") for (int h_ = 0; h_ < 2; ++h_) _Pragma("unroll") for (int i_ = 0; i_ < 2; ++i_) { int R_, C_; stage_rc(tid * 16 + i_ * 8192, R_, C_); \
        const unsigned ix_ = gtab[(ui_) * BM + h_ * HALF + R_]; gv_[h_][i_] = ix_ * (unsigned)(K * 2) + (unsigned)C_ * 2u; } } } while (0)
    const size_t kstep = (size_t)(BK * 2);
    const size_t hstep = (size_t)HALF * K * 2;
    const size_t tstep = 2 * hstep;
    const unsigned ldsw = (unsigned)wid * 1024u;
    const int aoff = lds_byte(wr * 64 + fr, fq * 8), boff = lds_byte(wc * 32 + fr, fq * 8);
#define PG8_SA(b, h) (((b) * 2 + (h)) * HTB)
#define PG8_SB(b, h) ((4 + (b) * 2 + (h)) * HTB)
#define PG8_STAGE(bufoff, gbase, voff) do { _Pragma("unroll") for (int _i = 0; _i < 2; ++_i) \
        __builtin_amdgcn_global_load_lds((const unsigned*)((const char*)(gbase) + (voff)[_i]), (PG8_LAS unsigned*)(lds + (bufoff) + ldsw + _i * 8192), 16, 0, 0); } while (0)
#define PG8_STAGE_A(bufoff, gbase, h_, nx_) do { if constexpr (GATHER) PG8_STAGE(bufoff, gbase, gvc[h_]); else PG8_STAGE(bufoff, (gbase) + (h_) * hstep, voffA); } while (0)
#define PG8_LDA(dst, b, h) do { _Pragma("unroll") for (int m = 0; m < 4; ++m) _Pragma("unroll") for (int k = 0; k < 2; ++k) dst[m].set(k, *(const PG8_LAS bf16x8*)(lds + PG8_SA(b, h) + aoff + m * 2048 + k * 1024)); } while (0)
#define PG8_LDB(dst, b, h) do { _Pragma("unroll") for (int n = 0; n < 2; ++n) _Pragma("unroll") for (int k = 0; k < 2; ++k) dst[n].set(k, *(const PG8_LAS bf16x8*)(lds + PG8_SB(b, h) + boff + n * 2048 + k * 1024)); } while (0)
#define PG8_MMA(ai, bj, At, Bt) do { __builtin_amdgcn_s_setprio(1); _Pragma("unroll") for (int m = 0; m < 4; ++m) _Pragma("unroll") for (int n = 0; n < 2; ++n) { \
        if constexpr (MODE == 2) { asm volatile("v_mfma_f32_16x16x128_f8f6f4 %0, %1, %2, %0" : "+v"(acc[ai][bj][m][n]) : "v"(Bt[n].w), "v"(At[m].w)); }     \
        else { _Pragma("unroll") for (int k = 0; k < 2; ++k) { \
          if constexpr (MODE == 1) acc[ai][bj][m][n] = __builtin_amdgcn_mfma_i32_16x16x64_i8(__builtin_bit_cast(i32x4, Bt[n].v[k]), __builtin_bit_cast(i32x4, At[m].v[k]), acc[ai][bj][m][n], 0, 0, 0); \
          else acc[ai][bj][m][n] = __builtin_amdgcn_mfma_f32_16x16x32_bf16(Bt[n].v[k], At[m].v[k], acc[ai][bj][m][n], 0, 0, 0); } } } __builtin_amdgcn_s_setprio(0); } while (0)
#define PG8_WAIT_V(n) asm volatile("s_waitcnt vmcnt(" #n ")" ::: "memory")
#define PG8_WAIT_L(n) asm volatile("s_waitcnt lgkmcnt(" #n ")" ::: "memory")
#define PG8_BAR __builtin_amdgcn_s_barrier()
#define PG8_SCHED __builtin_amdgcn_sched_barrier(0)
    Unit cur, nxt; int ui = 0;
    if (!S.next(0, cur)) return;
    typedef typename AccSel<MODE>::type acc_t; const acc_t acc_zero = {};
    acc_t acc[2][2][4][2];
#pragma unroll
    for (int a = 0; a < 2; ++a)
#pragma unroll
        for (int b = 0; b < 2; ++b)
#pragma unroll
            for (int m = 0; m < 4; ++m)
#pragma unroll
                for (int n = 0; n < 2; ++n) acc[a][b][m][n] = acc_zero;
    Frag<MODE> At[4], B0[2], B1[2];
    const char* cA = (const char*)g.A + (GATHER ? (size_t)0 : (size_t)cur.pm * tstep); PG8_GOFF(0, gvc); const char* cB = (const char*)g.Bt + (size_t)(cur.pm / g.tpe) * g.bgs + (size_t)cur.pn * tstep;
    S.a_ready(cur);
    if constexpr (SP2) {
        PG8_STAGE(PG8_SB(0, 0), cB, voffB); PG8_STAGE(PG8_SB(0, 1), cB + hstep, voffB); PG8_STAGE_A(PG8_SA(0, 0), cA, 0, false); PG8_STAGE_A(PG8_SA(0, 1), cA, 1, false);
        if (wr == 1) PG8_BAR;
        PG8_WAIT_V(2); PG8_BAR;
        PG8_STAGE(PG8_SB(1, 0), cB + kstep, voffB); PG8_STAGE_A(PG8_SA(1, 0), cA + kstep, 0, false); PG8_STAGE(PG8_SB(1, 1), cB + hstep + kstep, voffB);
        PG8_WAIT_V(6); PG8_BAR;
    } else {
        PG8_STAGE(PG8_SB(0, 0), cB, voffB); PG8_STAGE(PG8_SA(0, 0), cA, voffA); PG8_STAGE(PG8_SB(0, 1), cB + hstep, voffB); PG8_STAGE(PG8_SA(0, 1), cA + hstep, voffA);
        if (wr == 1) PG8_BAR;
        PG8_WAIT_V(4); PG8_BAR;
        PG8_STAGE(PG8_SB(1, 0), cB + kstep, voffB); PG8_STAGE(PG8_SA(1, 0), cA + kstep, voffA); PG8_STAGE(PG8_SB(1, 1), cB + hstep + kstep, voffB);
        PG8_WAIT_V(6); PG8_BAR;
    }
    for (;;) {
        const bool has_next = S.next(ui + 1, nxt);
        const char* nA = (has_next && !GATHER) ? (const char*)g.A + (size_t)nxt.pm * tstep : cA; const char* nB = has_next ? (const char*)g.Bt + (size_t)(nxt.pm / g.tpe) * g.bgs + (size_t)nxt.pn * tstep : cB;
        for (int t = 0; t < nt; t += 2) {
            const bool last = (t == nt - 2); const bool nxu = last && has_next;
            const char* a1 = cA + (size_t)(t + 1) * kstep;
            const char* a2 = last ? nA : cA + (size_t)(t + 2) * kstep; const char* b2 = last ? nB : cB + (size_t)(t + 2) * kstep;
            const char* a3 = a2 + kstep; const char* b3 = b2 + kstep;
            if (last && has_next) S.a_ready(nxt);
            if constexpr (SP2) {
            PG8_LDB(B0, 0, 0); PG8_LDB(B1, 0, 1); PG8_SCHED; PG8_LDA(At, 0, 0); PG8_STAGE_A(PG8_SA(1, 1), a1, 1, false); if (nxu) PG8_GOFF(ui + 1, gvc);
            PG8_WAIT_V(8); PG8_WAIT_L(0); PG8_BAR; PG8_MMA(0, 0, At, B0); PG8_MMA(0, 1, At, B1); PG8_BAR; PG8_SCHED;
            PG8_LDA(At, 0, 1); PG8_STAGE(PG8_SB(0, 0), b2, voffB); PG8_STAGE(PG8_SB(0, 1), b2 + hstep, voffB); PG8_STAGE_A(PG8_SA(0, 0), a2, 0, nxu);
            PG8_WAIT_V(8); PG8_WAIT_L(0); PG8_BAR; PG8_MMA(1, 0, At, B0); PG8_MMA(1, 1, At, B1); PG8_BAR; PG8_SCHED;
            PG8_LDB(B0, 1, 0); PG8_LDB(B1, 1, 1); PG8_SCHED; PG8_LDA(At, 1, 0); PG8_STAGE_A(PG8_SA(0, 1), a2, 1, nxu);
            PG8_WAIT_V(8); PG8_WAIT_L(0); PG8_BAR; PG8_MMA(0, 0, At, B0); PG8_MMA(0, 1, At, B1); PG8_BAR; PG8_SCHED;
            PG8_LDA(At, 1, 1); PG8_STAGE(PG8_SB(1, 0), b3, voffB); PG8_STAGE(PG8_SB(1, 1), b3 + hstep, voffB); PG8_STAGE_A(PG8_SA(1, 0), a3, 0, nxu);
            PG8_WAIT_V(8); PG8_WAIT_L(0); PG8_BAR; PG8_MMA(1, 0, At, B0); PG8_MMA(1, 1, At, B1); PG8_BAR; PG8_SCHED;
            } else {
            PG8_LDB(B0, 0, 0); PG8_SCHED; PG8_LDA(At, 0, 0); PG8_STAGE(PG8_SA(1, 1), a1 + hstep, voffA);
            PG8_WAIT_L(8); PG8_BAR; PG8_WAIT_L(0); PG8_MMA(0, 0, At, B0); PG8_BAR; PG8_SCHED;
            PG8_LDB(B1, 0, 1); PG8_STAGE(PG8_SB(0, 0), b2, voffB);
            PG8_BAR; PG8_WAIT_L(0); PG8_MMA(0, 1, At, B1); PG8_BAR;
            PG8_LDA(At, 0, 1); PG8_STAGE(PG8_SA(0, 0), a2, voffA);
            PG8_BAR; PG8_WAIT_L(0); PG8_MMA(1, 0, At, B0); PG8_BAR; PG8_SCHED;
            PG8_STAGE(PG8_SB(0, 1), b2 + hstep, voffB);
            PG8_WAIT_V(6); PG8_BAR; PG8_MMA(1, 1, At, B1); PG8_BAR;
            PG8_LDB(B0, 1, 0); PG8_SCHED; PG8_LDA(At, 1, 0); PG8_STAGE(PG8_SA(0, 1), a2 + hstep, voffA);
            PG8_WAIT_L(8); PG8_BAR; PG8_WAIT_L(0); PG8_MMA(0, 0, At, B0); PG8_BAR; PG8_SCHED;
            PG8_LDB(B1, 1, 1); PG8_STAGE(PG8_SB(1, 0), b3, voffB);
            PG8_BAR; PG8_WAIT_L(0); PG8_MMA(0, 1, At, B1); PG8_BAR;
            PG8_LDA(At, 1, 1); PG8_STAGE(PG8_SA(1, 0), a3, voffA);
            PG8_BAR; PG8_WAIT_L(0); PG8_MMA(1, 0, At, B0); PG8_BAR; PG8_SCHED;
            PG8_STAGE(PG8_SB(1, 1), b3 + hstep, voffB);
            PG8_WAIT_V(6); PG8_BAR; PG8_MMA(1, 1, At, B1); PG8_BAR;
            }
        }
        if constexpr (ALIGN_EPI) { if (wr == 0) PG8_BAR; }
        if constexpr (!Epi::AFTER_DRAIN) { E(acc, cur, wr, wc, fr, fq, lds); S.done(cur); }
        if (!has_next) break;
#pragma unroll
        for (int a = 0; a < 2; ++a)
#pragma unroll
            for (int b = 0; b < 2; ++b)
#pragma unroll
                for (int m = 0; m < 4; ++m)
#pragma unroll
                    for (int n = 0; n < 2; ++n) acc[a][b][m][n] = acc_zero;
        cur = nxt; cA = nA; cB = nB; ++ui;
        if constexpr (ALIGN_EPI) { if (wr == 1) PG8_BAR; }
    }
    PG8_WAIT_V(0);
    if constexpr (!ALIGN_EPI) { if (wr == 0) PG8_BAR; }
    PG8_BAR;
    if constexpr (Epi::AFTER_DRAIN) { E.fused(acc, cur, wr, wc, fr, fq, lds, wid, lane); S.done(cur); }
#undef PG8_SA
#undef PG8_SB
#undef PG8_STAGE
#undef PG8_STAGE_A
#undef PG8_GOFF
#undef PG8_LDA
#undef PG8_LDB
#undef PG8_MMA
#undef PG8_WAIT_V
#undef PG8_WAIT_L
#undef PG8_BAR
#undef PG8_SCHED
}
}
namespace att {
typedef unsigned short bf16_t;
typedef short bf16x8 __attribute__((ext_vector_type(8)));
typedef short s16x4 __attribute__((ext_vector_type(4)));
typedef float f32x16 __attribute__((ext_vector_type(16)));
typedef float f32x4 __attribute__((ext_vector_type(4)));
typedef unsigned u32x4 __attribute__((ext_vector_type(4)));
typedef unsigned u32x2 __attribute__((ext_vector_type(2)));
#define ALDS __attribute__((address_space(3)))
typedef float f32x2_t __attribute__((ext_vector_type(2))); typedef __bf16 bf16x2_t __attribute__((ext_vector_type(2)));
__device__ __forceinline__ unsigned cvtpk(float lo, float hi) { f32x2_t v = {lo, hi}; bf16x2_t b = __builtin_convertvector(v, bf16x2_t); return __builtin_bit_cast(unsigned, b); }
__device__ __forceinline__ float bf2f(unsigned short u) { return __uint_as_float((unsigned)u << 16); }
template <int S> __device__ __forceinline__ bf16x8 pack8(const f32x16& x) {
    u32x4 p; p.x = cvtpk(x[8 * S + 0], x[8 * S + 1]); p.y = cvtpk(x[8 * S + 2], x[8 * S + 3]); p.z = cvtpk(x[8 * S + 4], x[8 * S + 5]); p.w = cvtpk(x[8 * S + 6], x[8 * S + 7]);
    return __builtin_bit_cast(bf16x8, p);
}
typedef short v4i16_t __attribute__((ext_vector_type(4)));
__device__ __forceinline__ s16x4 vtr(const ALDS char* p) { return __builtin_bit_cast(s16x4, __builtin_amdgcn_ds_read_tr16_b64_v4i16((ALDS v4i16_t*)p)); }
__device__ __forceinline__ int crow(int r, int hi) { return (r & 3) + 8 * (r >> 2) + 4 * hi; }
constexpr int ATT_LDS_BYTES = 2 * 12288 + 2 * 8192;

__device__ __forceinline__ void glds16(const void* gsrc, unsigned lds_dst) { unsigned keep;
    asm volatile("s_mov_b32 %0, m0\n\ts_mov_b32 m0, %2\n\ts_nop 0\n\tglobal_load_lds_dwordx4 %1, off\n\ts_mov_b32 m0, %0" : "=&s"(keep) : "v"(gsrc), "s"(lds_dst) : "memory"); }
__device__ __forceinline__ void glds16s(const char* sbase, unsigned voff, unsigned lds_dst) { unsigned keep;
    asm volatile("s_mov_b32 %0, m0\n\ts_mov_b32 m0, %3\n\ts_nop 0\n\tglobal_load_lds_dwordx4 %1, %2\n\ts_mov_b32 m0, %0" : "=&s"(keep) : "v"(voff), "s"(sbase), "s"(lds_dst) : "memory"); }
#define ATT_SBAR() __builtin_amdgcn_sched_barrier(0)
#define ATT_PIN(x) asm volatile("" : "+v"(x))
typedef int i32x2a __attribute__((ext_vector_type(2)));
typedef int i32x4a __attribute__((ext_vector_type(4)));
typedef int i32x6a __attribute__((ext_vector_type(6)));
typedef int i32x8a __attribute__((ext_vector_type(8)));
typedef unsigned u32x16 __attribute__((ext_vector_type(16)));
typedef __bf16 bf16x32_t __attribute__((ext_vector_type(32)));
__device__ __forceinline__ i32x6a cvt_fp6x32(const u32x16& w) { return __builtin_bit_cast(i32x6a, __builtin_amdgcn_cvt_scalef32_pk32_fp6_bf16(__builtin_bit_cast(bf16x32_t, w), 1.0f)); }
#define ATT_MF6_Z(C, A, B, SA, SB) asm volatile("v_mfma_scale_f32_32x32x64_f8f6f4 %0, %1, %2, 0, %3, %4 op_sel:[0,0,0] op_sel_hi:[0,0,0] cbsz:2 blgp:2" : "=&v"(C) : "v"(A), "v"(B), "v"(SA), "v"(SB))
#define ATT_MF6_A(C, A, B, SA, SB) asm volatile("v_mfma_scale_f32_32x32x64_f8f6f4 %0, %1, %2, %0, %3, %4 op_sel:[0,0,0] op_sel_hi:[0,0,0] cbsz:2 blgp:2" : "+v"(C) : "v"(A), "v"(B), "v"(SA), "v"(SB))
#define ATT_MF6_C(C, A, B, C0, SA, SB) asm volatile("v_mfma_scale_f32_32x32x64_f8f6f4 %0, %1, %2, %3, %4, %5 op_sel:[0,0,0] op_sel_hi:[0,0,0] cbsz:2 blgp:2" : "=&v"(C) : "v"(A), "v"(B), "v"(C0), "v"(SA), "v"(SB))
template <int DK> struct KCfg { static constexpr int NG = (DK == 96) ? 3 : 2, KTB = (DK == 96) ? 5120 : 3072, QRB = 24 * NG, NF = (DK == 96) ? 2 : 1, NRD = 4 * NF, PB = NG * 1024,
                                                      SCL = (DK == 32) ? 0x77777777 : 0x76767676, NB = (DK == 32) ? 2 : 4; };
constexpr float FQ96 = 4.0f * 1.4426950408889634f * 0.10206207261596575f * 2.0f, FQ32 = 4.0f * 1.4426950408889634f * 0.17677669529663687f, FQ64 = 4.0f * 1.4426950408889634f * 0.125f * 2.0f;
constexpr float P_BIAS = 44.0f / 256.0f;
constexpr int KC_A = 0, KC_B = 1024;
template <int DK>
__device__ __forceinline__ void kread6(i32x6a (&kf)[2][KCfg<DK>::NF], const ALDS char* pA0, const ALDS char* pB0, const ALDS char* pA1, const ALDS char* pB1, int idx) {
    constexpr int NF = KCfg<DK>::NF;
    const int mt = idx / (2 * NF), f = (idx / 2) % NF, part = idx & 1;
    const ALDS char* pA = f ? pA1 : pA0; const ALDS char* pB = f ? pB1 : pB0;
    if (part == 0) { const i32x4a v = *(const ALDS i32x4a*)(pA + mt * 512); kf[mt][f][0] = v.x; kf[mt][f][1] = v.y; kf[mt][f][2] = v.z; kf[mt][f][3] = v.w; }
    else { const i32x2a v = *(const ALDS i32x2a*)(pB + mt * 256); kf[mt][f][4] = v.x; kf[mt][f][5] = v.y; }
}
#define ATT_PV8(C, A, B) asm volatile("s_nop 3\n\tv_mfma_f32_32x32x64_f8f6f4 %0, %1, %2, %0 cbsz:0 blgp:1" : "+v"(C) : "v"(A), "v"(B))
#define ATT_L8(C, A, B) asm volatile("s_nop 3\n\tv_mfma_f32_16x16x128_f8f6f4 %0, %1, %2, %0 cbsz:0 blgp:1" : "+v"(C) : "v"(A), "v"(B))
#define ATT_L8N(C, A, B) asm volatile("v_mfma_f32_16x16x128_f8f6f4 %0, %1, %2, %0 cbsz:0 blgp:1" : "+v"(C) : "v"(A), "v"(B))
#define ATT_PV8N(C, A, B) asm volatile("v_mfma_f32_32x32x64_f8f6f4 %0, %1, %2, %0 cbsz:0 blgp:1" : "+v"(C) : "v"(A), "v"(B))
typedef unsigned short u16x2 __attribute__((ext_vector_type(2)));
__device__ __forceinline__ unsigned pk4_bf8(float a, float b, float c, float d) {
    const u16x2 x = __builtin_amdgcn_cvt_pknorm_u16(a, b), y = __builtin_amdgcn_cvt_pknorm_u16(c, d);
    return __builtin_amdgcn_perm(__builtin_bit_cast(unsigned, y), __builtin_bit_cast(unsigned, x), 0x07050301u); }
struct KPtr { const ALDS char *a0, *b0, *a1, *b1; };
template <int DK, int VLOAD, int ABL = 0, class DF>
__device__ __forceinline__ void att_step9(f32x16& N0, f32x16& N1, const f32x16& P0, const f32x16& P1, i32x6a (&kf)[2][KCfg<DK>::NF], const i32x6a* qfn,
                                          f32x16 (&o)[2], f32x4& L, const i32x8a& pwP, i32x8a& pwC, i32x8a (&vf)[2], const i32x8a& ones, const f32x16& cb, const int& sa, const int& sb,
                                          const ALDS char* vcur, const KPtr k1, const KPtr k0, DF&& dmaf) {
    constexpr int NF = KCfg<DK>::NF;
#define ATP_PACK(i) do { if (!(ABL & 4)) { const int e = 4 * (i); \
        int w = (int)((e < 16) ? pk4_bf8(P0[e & 15], P0[(e + 1) & 15], P0[(e + 2) & 15], P0[(e + 3) & 15]) : pk4_bf8(P1[e & 15], P1[(e + 1) & 15], P1[(e + 2) & 15], P1[(e + 3) & 15])); \
        ATT_PIN(w); pwC[i] = w; } } while (0)
    ATT_SBAR();
    ATT_PV8N(o[0], vf[0], pwP);
    dmaf();
#pragma unroll
    for (int k = 2 * NF; k < 4 * NF; ++k) { if (!(ABL & 8)) kread6<DK>(kf, k1.a0, k1.b0, k1.a1, k1.b1, k); }
#pragma unroll
    for (int i = 0; i < 4; ++i) ATP_PACK(i);
    ATT_SBAR();
    ATT_PV8N(o[1], vf[1], pwP);
    if (VLOAD && !(ABL & 8)) { vf[0].lo = *(const ALDS i32x4a*)(vcur); vf[0].hi = *(const ALDS i32x4a*)(vcur + 1024); }
#pragma unroll
    for (int i = 4; i < 8; ++i) ATP_PACK(i);
    ATT_SBAR();
    ATT_L8N(L, ones, pwP);
    if (VLOAD && !(ABL & 8)) { vf[1].lo = *(const ALDS i32x4a*)(vcur + 512); vf[1].hi = *(const ALDS i32x4a*)(vcur + 512 + 1024); }
    ATT_SBAR();
    if (DK == 64) { ATT_MF6_C(N0, kf[0][0], qfn[0], cb, sa, sb); ATT_MF6_C(N1, kf[1][0], qfn[0], cb, sa, sb); }
    else if (NF == 1) { ATT_MF6_Z(N0, kf[0][0], qfn[0], sa, sb); ATT_MF6_Z(N1, kf[1][0], qfn[0], sa, sb); }
    else { ATT_MF6_Z(N0, kf[0][0], qfn[0], sa, sb); ATT_MF6_Z(N1, kf[1][0], qfn[0], sa, sb); ATT_MF6_A(N0, kf[0][1], qfn[1], sa, sb); ATT_MF6_A(N1, kf[1][1], qfn[1], sa, sb); }
    ATT_SBAR();
#pragma unroll
    for (int k = 0; k < 2 * NF; ++k) { if (!(ABL & 8)) kread6<DK>(kf, k0.a0, k0.b0, k0.a1, k0.b1, k); }
    ATT_SBAR();
#undef ATP_PACK
}
template <int DK, int NMAP, int ABL = 0>
__device__ __forceinline__ void attn_unit_f8(const unsigned char* __restrict__ Qb, const char* __restrict__ Kt, const char* __restrict__ Vt, int t0, int t1,
                                             bf16_t* __restrict__ Ob, ALDS char* lds, float lam, const float* __restrict__ gout, float oml) {
    typedef KCfg<DK> KC;
    constexpr int KTB = KC::KTB, NF = KC::NF, NRD = KC::NRD, LV = 8 * KTB, CB = LV + 8 * 4096, NKP = KTB / 1024, NP = NKP + 4, NDMA = (NP + 7) / 8;
    int tid_l = threadIdx.x; asm volatile("" : "+v"(tid_l));
    const int tid = tid_l, lane = tid & 63, r32 = lane & 31, hi = lane >> 5, wid = __builtin_amdgcn_readfirstlane(tid >> 6);
    i32x6a qbias;
    { u32x16 vq, vk; unsigned pq = 0x40B040B0u, pk = 0x40804080u;
      asm volatile("" : "+v"(pq), "+v"(pk));
#pragma unroll
      for (int r = 0; r < 16; ++r) { vq[r] = (2 * r < KC::NB) ? pq : 0u; vk[r] = (2 * r < KC::NB) ? pk : 0u; }
      qbias = cvt_fp6x32(vq);
      if (DK != 64 && tid == 0) { const i32x6a kb = cvt_fp6x32(vk); const i32x4a ka = {kb[0], kb[1], kb[2], kb[3]}; const i32x2a kc = {kb[4], kb[5]};
          *(ALDS i32x4a*)(lds + CB + KC_A) = ka; *(ALDS i32x4a*)(lds + CB + KC_A + 512) = ka; *(ALDS i32x2a*)(lds + CB + KC_B) = kc; *(ALDS i32x2a*)(lds + CB + KC_B + 256) = kc; } }
    i32x6a qf[NMAP][NF];
    { const unsigned char* qrow = Qb + (size_t)(wid * 32 + r32) * KC::QRB;
#define ATP_QG(dst, off) do { const i32x2a a_ = *(const i32x2a*)(qrow + (off)), b_ = *(const i32x2a*)(qrow + (off) + 8), c_ = *(const i32x2a*)(qrow + (off) + 16); \
          dst[0] = a_.x; dst[1] = a_.y; dst[2] = b_.x; dst[3] = b_.y; dst[4] = c_.x; dst[5] = c_.y; } while (0)
      if (DK == 64) { ATP_QG(qf[0][0], 24 * hi); }
      else if (DK == 96) { ATP_QG(qf[0][0], 24 * hi); i32x6a t; ATP_QG(t, 48);
#pragma unroll
          for (int r = 0; r < 6; ++r) qf[0][NF - 1][r] = hi ? qbias[r] : t[r]; }
      else {
#pragma unroll
          for (int m = 0; m < NMAP; ++m) { i32x6a t; ATP_QG(t, 24 * m);
#pragma unroll
              for (int r = 0; r < 6; ++r) qf[m][0][r] = hi ? qbias[r] : t[r]; } }
#undef ATP_QG
    }
#pragma unroll
    for (int m = 0; m < NMAP; ++m)
#pragma unroll
        for (int f = 0; f < NF; ++f) ATT_PIN(qf[m][f]);
    f32x16 o[NMAP][2], cb; f32x4 L[NMAP]; i32x8a pw, ones; int sa = 0x7F7F7F7F, sb = KC::SCL;
    ATT_PIN(sa); ATT_PIN(sb);
#pragma unroll
    for (int r = 0; r < 16; ++r) cb[r] = P_BIAS;
    if (DK == 64) ATT_PIN(cb);
    { const int sel = (lane == 0 || lane == 32 || lane == 17 || lane == 49) ? 0x38383838 : 0;
#pragma unroll
      for (int r = 0; r < 8; ++r) { pw[r] = 0; ones[r] = sel; } }
    ATT_PIN(ones);
#pragma unroll
    for (int m = 0; m < NMAP; ++m) {
#pragma unroll
        for (int r = 0; r < 4; ++r) L[m][r] = 0.f;
#pragma unroll
        for (int d = 0; d < 2; ++d)
#pragma unroll
            for (int r = 0; r < 16; ++r) o[m][d][r] = 0.f; }
#pragma unroll
    for (int m = 0; m < NMAP; ++m) { ATT_PIN(L[m]); ATT_PIN(o[m][0]); ATT_PIN(o[m][1]); }
    const unsigned lds0 = (unsigned)(size_t)lds;
    const char* src0; unsigned dst0; int isv0; const bool act0 = wid < NP;
    { const int p = wid; isv0 = p >= NKP; src0 = (isv0 ? Vt + (p - NKP) * 1024 : Kt + p * 1024); dst0 = lds0 + (isv0 ? LV + (p - NKP) * 1024 : p * 1024); }
    const unsigned lane16 = (unsigned)lane * 16u;
    const bool act1 = (NDMA == 2) && wid == 7;
    const char* src1 = nullptr; unsigned dst1 = 0u;
    if (NDMA == 2) { const int p = 8; src1 = Vt + (p - NKP) * 1024; dst1 = lds0 + LV + (p - NKP) * 1024; }
#define ATP_DMA(tk, tv) do { if (ABL & (2 | 32)) break; \
        if (act0) { if (isv0) glds16s(src0 + (size_t)(tv) * 4096, lane16, (unsigned)__builtin_amdgcn_readfirstlane(dst0 + ((tv) & 7) * 4096)); else glds16s(src0 + (size_t)(tk) * KTB, lane16, (unsigned)__builtin_amdgcn_readfirstlane(dst0 + ((tk) & 7) * KTB)); } \
        if (act1) glds16s(src1 + (size_t)(tv) * 4096, lane16, (unsigned)__builtin_amdgcn_readfirstlane(dst1 + ((tv) & 7) * 4096)); } while (0)
#define ATP_SYNCALL() do { if (ABL & 2) break; if (!(ABL & 128)) { if (act1) asm volatile("s_waitcnt vmcnt(4)" ::: "memory"); else asm volatile("s_waitcnt vmcnt(2)" ::: "memory"); } \
        if (!(ABL & 64)) asm volatile("s_barrier" ::: "memory"); } while (0)
    const bool c0 = (DK == 32) && hi, c1 = hi;
    const int ka0 = c0 ? CB + KC_A : ((DK == 32) ? 0 : hi * 1024) + r32 * 16, kb0 = c0 ? CB + KC_B : KC::PB + ((DK == 32) ? 0 : hi * 512) + r32 * 8, km0 = c0 ? 0 : KTB;
    const int dA = (DK == 32 && !hi) ? 1024 : 0, dB = (DK == 32 && !hi) ? 512 : 0;
    const int ka1 = c1 ? CB + KC_A : 2048 + r32 * 16, kb1 = c1 ? CB + KC_B : KC::PB + 1024 + r32 * 8, km1 = c1 ? 0 : KTB;
#define ATP_KP(t, m) (KPtr{lds + ((t) & 7) * km0 + ka0 + (m) * dA, lds + ((t) & 7) * km0 + kb0 + (m) * dB, lds + ((t) & 7) * km1 + ka1, lds + ((t) & 7) * km1 + kb1})
#define ATP_VB(t) (lds + LV + ((t) & 7) * 4096 + klane64)
#define ATP_KLOAD(t, m) do { const KPtr kp_ = ATP_KP(t, m); _Pragma("unroll") for (int k = 0; k < NRD; ++k) kread6<DK>(kf, kp_.a0, kp_.b0, kp_.a1, kp_.b1, k); \
        asm volatile("s_waitcnt lgkmcnt(0)" ::: "memory"); \
        _Pragma("unroll") for (int mt_ = 0; mt_ < 2; ++mt_) _Pragma("unroll") for (int f_ = 0; f_ < NF; ++f_) ATT_PIN(kf[mt_][f_]);     \
        asm volatile("s_nop 3" ::: "memory"); } while (0)
    const int klane64 = hi * 2048 + r32 * 16;
    ATP_DMA(t0, t0); ATP_DMA(t0 + 1, t0 + 1); ATP_DMA(t0 + 2, t0 + 1); if (NMAP == 1) ATP_DMA(t0 + 3, t0 + 1);
    asm volatile("s_waitcnt vmcnt(0) lgkmcnt(0)\n\ts_barrier" ::: "memory");
    if (NMAP == 1) { ATP_DMA(t0 + 4, t0 + 2); ATP_DMA(t0 + 5, t0 + 3); } else { ATP_DMA(t0 + 3, t0 + 2); ATP_DMA(t0 + 4, t0 + 3); }
    i32x6a kf[2][NF]; i32x8a vf[2], pwB;
    f32x16 sA0, sA1, sB0, sB1;
    ATP_KLOAD(t0, 0);
    if (DK == 64) { ATT_MF6_C(sA0, kf[0][0], qf[0][0], cb, sa, sb); ATT_MF6_C(sA1, kf[1][0], qf[0][0], cb, sa, sb); } else { ATT_MF6_Z(sA0, kf[0][0], qf[0][0], sa, sb); ATT_MF6_Z(sA1, kf[1][0], qf[0][0], sa, sb); }
    if (NF == 2) { ATT_MF6_A(sA0, kf[0][1], qf[0][1], sa, sb); ATT_MF6_A(sA1, kf[1][1], qf[0][1], sa, sb); }
    asm volatile("s_nop 15\n\ts_nop 15\n\ts_nop 15\n\ts_nop 15\n\ts_nop 15\n\ts_nop 15" : "+v"(sA0), "+v"(sA1));
    { const KPtr kp_ = (NMAP == 1) ? ATP_KP(t0 + 1, 0) : ATP_KP(t0, 1);
#pragma unroll
      for (int k = 0; k < 2 * NF; ++k) kread6<DK>(kf, kp_.a0, kp_.b0, kp_.a1, kp_.b1, k); }
#pragma unroll
    for (int r = 0; r < 8; ++r) { vf[0][r] = 0; vf[1][r] = 0; pwB[r] = 0; }
    ATT_PIN(vf[0]); ATT_PIN(vf[1]); ATT_PIN(pwB);
    asm volatile("s_nop 3" ::: "memory");
    if (NMAP == 1) {
        for (int t = t0; t < t1; t += 2) {
            att_step9<DK, 1, ABL>(sB0, sB1, sA0, sA1, kf, qf[0], o[0], L[0], pwB, pw, vf, ones, cb, sa, sb, ATP_VB(t), ATP_KP(t + 1, 0), ATP_KP(t + 2, 0), [&]() { ATP_DMA(t + 6, t + 4); ATP_DMA(t + 7, t + 5); });
            att_step9<DK, 1, ABL>(sA0, sA1, sB0, sB1, kf, qf[0], o[0], L[0], pw, pwB, vf, ones, cb, sa, sb, ATP_VB(t + 1), ATP_KP(t + 2, 0), ATP_KP(t + 3, 0), [&]() {});
            ATP_SYNCALL();
        }
    } else {
        for (int t = t0; t < t1; t += 2) {
            att_step9<DK, 1, ABL>(sB0, sB1, sA0, sA1, kf, qf[1], o[1], L[1], pwB, pw, vf, ones, cb, sa, sb, ATP_VB(t), ATP_KP(t, 1), ATP_KP(t + 1, 0), [&]() { ATP_DMA(t + 5, t + 4); });
            att_step9<DK, 0, ABL>(sA0, sA1, sB0, sB1, kf, qf[0], o[0], L[0], pw, pwB, vf, ones, cb, sa, sb, ATP_VB(t), ATP_KP(t + 1, 0), ATP_KP(t + 1, 1), [&]() { ATP_DMA(t + 6, t + 5); });
            att_step9<DK, 1, ABL>(sB0, sB1, sA0, sA1, kf, qf[1], o[1], L[1], pwB, pw, vf, ones, cb, sa, sb, ATP_VB(t + 1), ATP_KP(t + 1, 1), ATP_KP(t + 2, 0), [&]() {});
            att_step9<DK, 0, ABL>(sA0, sA1, sB0, sB1, kf, qf[0], o[0], L[0], pw, pwB, vf, ones, cb, sa, sb, ATP_VB(t + 1), ATP_KP(t + 2, 0), ATP_KP(t + 2, 1), [&]() {});
            ATP_SYNCALL();
        }
    }
    ATT_SBAR();
    ATT_PV8N(o[NMAP - 1][0], vf[0], pwB); ATT_PV8N(o[NMAP - 1][1], vf[1], pwB); ATT_L8N(L[NMAP - 1], ones, pwB);
    asm volatile("s_waitcnt vmcnt(0) lgkmcnt(0)\n\ts_barrier" ::: "memory");
#pragma unroll
    for (int m = 0; m < NMAP; ++m) asm volatile("s_nop 15\n\ts_nop 15\n\ts_nop 15\n\ts_nop 15\n\ts_nop 15" : "+v"(o[m][0]), "+v"(o[m][1]), "+v"(L[m]));
#undef ATP_DMA
#undef ATP_SYNCALL
#undef ATP_KP
#undef ATP_VB
#undef ATP_KLOAD
    float li[NMAP];
#pragma unroll
    for (int m = 0; m < NMAP; ++m) { const float l0 = __shfl(L[m][0], r32 & 15), l1 = __shfl(L[m][1], r32 & 15); li[m] = 1.0f / ((r32 & 16) ? l1 : l0); }
    float val[2][16];
    if (NMAP == 1) {
#pragma unroll
        for (int d = 0; d < 2; ++d)
#pragma unroll
            for (int r = 0; r < 16; ++r) val[d][r] = o[0][d][r] * li[0];
    } else {
        float ss = 0.f; const float l2 = lam * li[NMAP - 1];
#pragma unroll
        for (int d = 0; d < 2; ++d)
#pragma unroll
            for (int r = 0; r < 16; ++r) { const float v = o[0][d][r] * li[0] - o[NMAP - 1][d][r] * l2; val[d][r] = v; ss += v * v; }
        ss += __shfl_xor(ss, 32);
        const float rstd = rsqrtf(ss * (1.0f / 64.0f) + 1e-6f) * oml;
#pragma unroll
        for (int d = 0; d < 2; ++d)
#pragma unroll
            for (int g = 0; g < 4; ++g) { const f32x4 gv = *(const f32x4*)(gout + 32 * d + 8 * g + 4 * hi);
#pragma unroll
                for (int i = 0; i < 4; ++i) val[d][4 * g + i] *= rstd * gv[i]; }
    }
    bf16_t* orow = Ob + (size_t)(wid * 32 + r32) * 1024 + 4 * hi;
#pragma unroll
    for (int d = 0; d < 2; ++d)
#pragma unroll
        for (int g = 0; g < 4; ++g) { u32x2 w; w.x = cvtpk(val[d][4 * g], val[d][4 * g + 1]); w.y = cvtpk(val[d][4 * g + 2], val[d][4 * g + 3]);
            *(u32x2*)(orow + 32 * d + 8 * g) = w; }
}

}
constexpr int NWAVES = 8;
constexpr int DM = 1024, NB = 4, SEQ = 8192, CL = 256, NTOKB = SEQ + CL, LROWS = NB * SEQ, MROWS = LROWS + NB * CL;
constexpr int NLAYER = 2, INC = 1952, ZP = 3072, NE = 16, FFD = 2048, CAPL = 1024, CAPC = 32, NKT = NTOKB / 64;
constexpr int ZQ = 1952, ZKV = 2336, ZEND = 2848;
constexpr float EPSF = 1e-6f, LOG2E = 1.4426950408889634f, HID_SCALE = 4.0f;
constexpr int N_PHASES = 22;
enum { I_X = 0, I_C, I_CTX, I_CCTX, I_WADA, I_BADA, I_GN1, I_WIN, I_GCQ, I_GCKV, I_WUQ, I_WUKV, I_GMQ, I_GMK, I_GDQ, I_GDK, I_LQ1, I_LK1, I_LQ2, I_LK2, I_GDO, I_GGQ, I_GGK, I_WO, I_GN2, I_WR, I_WG, I_WU, I_WD, N_IN };
constexpr size_t MiB = 1u << 20;
constexpr size_t WS_CTL = 0, CTL_ZERO_BYTES = 1 * MiB;
constexpr size_t WS_MOD = 1 * MiB;
constexpr size_t WS_LAM = WS_MOD + 256 * 1024;
constexpr size_t WS_TAB = WS_MOD + 320 * 1024;
constexpr size_t TAB_AROW = 0, TAB_ACOL = 128 * 8 * 8, TAB_GROW = TAB_ACOL + 64 * 8 * 8, TAB_GCOL = TAB_GROW + 128 * 16 * 8;
constexpr size_t WS_AFF = 2 * MiB, WS_AFFC = 4 * MiB;
constexpr size_t WS_IDX = 5 * MiB, WS_GATE = 6 * MiB;
constexpr size_t WS_INV = 7 * MiB;
constexpr size_t WS_SA = 10 * MiB, WS_SAE = 11 * MiB, WS_SW = 12 * MiB;
constexpr size_t WS_SSQ = 14 * MiB;
constexpr size_t WS_SWC = 13 * MiB;
constexpr size_t WS_WCAT8 = 72 * MiB;
constexpr size_t WS_WCAT = 16 * MiB;
constexpr size_t WS_WO = 28 * MiB;
constexpr size_t WS_CTXW = 32 * MiB;
constexpr size_t WS_H = 36 * MiB;
constexpr size_t WS_WGU = 102 * MiB;
constexpr size_t WS_WD = 230 * MiB;
constexpr size_t WS_YE = 294 * MiB;
constexpr size_t WS_Z = 430 * MiB;
constexpr size_t WS_QKV = 628 * MiB;
constexpr size_t WS_ATT = 793 * MiB;
constexpr size_t WS_DELTA = 430 * MiB;
constexpr size_t WS_XE = 430 * MiB;
constexpr size_t WS_HID = 566 * MiB;
constexpr size_t WS_XB = 859 * MiB;
constexpr size_t WS_END = 925 * MiB;
constexpr size_t QO_QM = 0, QO_QD = 25952256, QO_QG = 43253760, QO_KM = 77856768, QO_KD = 103809024, QO_KG = 121110528, QO_VM = 129761280, QO_VD = 147062784, QO_VG = 164364288;
static_assert(QO_VG + 8650752 == 173015040 && WS_QKV + 173015040 <= WS_ATT && WS_HID + (size_t)16 * 4352 * 2048 * 2 <= WS_XB, "ws map");
constexpr int CW_BAR = 4096, CW_Q = 16384;
constexpr int RING_BYTES = 131072, LDSCTL_OFF = RING_BYTES, MISC_OFF = LDSCTL_OFF + 320, LDS_BYTES = 163840;

#define GAS __attribute__((address_space(1)))
#define LAS __attribute__((address_space(3)))
typedef unsigned short bf16;
typedef unsigned v4u __attribute__((ext_vector_type(4)));
typedef unsigned v2u __attribute__((ext_vector_type(2)));
typedef float f32x4 __attribute__((ext_vector_type(4)));
typedef float f32x2 __attribute__((ext_vector_type(2)));
typedef GAS unsigned gu32;
#define RLX_AGENT __ATOMIC_RELAXED, __HIP_MEMORY_SCOPE_AGENT
#define LDS_WAIT() asm volatile("s_waitcnt lgkmcnt(0)" ::: "memory")
__device__ __forceinline__ unsigned pk2(float lo, float hi) { return att::cvtpk(lo, hi); }
__device__ __forceinline__ float bflo(unsigned w) { return __uint_as_float(w << 16); }
__device__ __forceinline__ float bfhi(unsigned w) { return __uint_as_float(w & 0xffff0000u); }
#define XB_TMO      128
#define XB_XCNT(j)  (256  + 64 * (j))
#define XB_XSUB(j)  (1280 + 64 * (j))
#define XB_XGEN(j)  (2304 + 64 * (j))
#define XB_TOP      3328
#define XB_TOPGEN   3392
#define XCD_BAR_WORDS 3456
#define XB_SPIN_CAP (1u << 18)

__device__ __forceinline__ unsigned xb_ld(unsigned* p)              { return __hip_atomic_load(p, __ATOMIC_RELAXED, __HIP_MEMORY_SCOPE_AGENT); }
__device__ __forceinline__ unsigned xb_add(unsigned* p, unsigned v) { return __hip_atomic_fetch_add(p, v, __ATOMIC_RELAXED, __HIP_MEMORY_SCOPE_AGENT); }
__device__ __forceinline__ unsigned xb_xcc_id() { return (unsigned)__builtin_amdgcn_s_getreg((3 << 11) | 20) & 0xFu; }
#define XB_SPIN(cond, bar) do { unsigned _sp = 0; while (cond) { __builtin_amdgcn_s_sleep(1); \
    if ((++_sp & 255u) == 0u) { if (xb_ld(&(bar)[XB_TMO])) break; if (_sp > XB_SPIN_CAP) { atomicAdd(&(bar)[XB_TMO], 1u); break; } } } } while (0)

struct XcdBarrier {
    unsigned* bar; unsigned x;
    volatile LAS unsigned* st;
};

__device__ __forceinline__ XcdBarrier xcd_barrier_post(unsigned* bar, volatile LAS unsigned* st) {
    XcdBarrier b; b.bar = bar; b.x = xb_xcc_id(); b.st = st;
    if (threadIdx.x == 0) (void)xb_add(&bar[XB_XCNT(b.x)], 1u);
    return b;
}
__device__ __forceinline__ void xcd_barrier_complete(unsigned* bar, unsigned x, unsigned& nloc, unsigned& nx) {
    const unsigned G = gridDim.x * gridDim.y * gridDim.z;
    unsigned sum, cnt, mine, sp = 0u;
    for (;;) {
        sum = 0u; cnt = 0u; mine = 0u;
#pragma unroll
        for (unsigned j = 0; j < 16; ++j) { const unsigned c = xb_ld(&bar[XB_XCNT(j)]); sum += c; cnt += (c > 0u) ? 1u : 0u; mine = (j == x) ? c : mine; }
        if (sum == G) break;
        __builtin_amdgcn_s_sleep(1);
        if ((++sp & 255u) == 0u) { if (xb_ld(&bar[XB_TMO])) break; if (sp > XB_SPIN_CAP) { atomicAdd(&bar[XB_TMO], 1u); break; } }
    }
    nloc = mine > 0u ? mine : 1u; nx = cnt > 0u ? cnt : 1u;
}

__device__ __forceinline__ void xcd_barrier(const XcdBarrier& b) {
    asm volatile("s_waitcnt vmcnt(0)" ::: "memory");
    __syncthreads();
    if (threadIdx.x == 0) {
        unsigned* bar = b.bar;
        __builtin_amdgcn_s_waitcnt(0);
        unsigned nloc = b.st[0], nx = b.st[1];
        if (nloc == 0u) { xcd_barrier_complete(bar, b.x, nloc, nx); b.st[0] = nloc; b.st[1] = nx; }
        const unsigned old = xb_add(&bar[XB_XSUB(b.x)], 1u);
        const unsigned gen = old / nloc;
        if (old + 1u == (gen + 1u) * nloc) {
            __builtin_amdgcn_fence(__ATOMIC_RELEASE, "agent");
            asm volatile("s_waitcnt vmcnt(0)" ::: "memory");
            const unsigned og = xb_add(&bar[XB_TOP], 1u);
            const unsigned tg = og / nx;
            if (og + 1u == (tg + 1u) * nx) xb_add(&bar[XB_TOPGEN], 1u);
            else XB_SPIN(xb_ld(&bar[XB_TOPGEN]) == tg, bar);
            __builtin_amdgcn_fence(__ATOMIC_ACQUIRE, "agent");
            xb_add(&bar[XB_XGEN(b.x)], 1u);
            asm volatile("s_waitcnt vmcnt(0)" ::: "memory");
        } else {
            XB_SPIN(xb_ld(&bar[XB_XGEN(b.x)]) == gen, bar);
            __builtin_amdgcn_fence(__ATOMIC_ACQUIRE, "agent");
            asm volatile("s_waitcnt vmcnt(0)" ::: "memory");
        }
    }
    __syncthreads();
}
struct Args { const float* in[N_IN]; float* out; unsigned char* ws; int ph_lo, ph_hi; };
static_assert(sizeof(Args) == 256, "Args has no padding bytes");
typedef const __attribute__((address_space(4))) Args* KA;
__device__ __forceinline__ KA kargs() { KA p = (KA)__builtin_amdgcn_kernarg_segment_ptr(); asm volatile("" : "+s"(p)); return p; }
struct Frame {
    LAS unsigned char* lds;
    volatile LAS unsigned* MISC;
    gu32* ctl;
    int tid, lane, wave, vcu, G;
};
__device__ __forceinline__ void relane(Frame& F) { int t = threadIdx.x; asm volatile("" : "+v"(t)); F.tid = t; F.lane = t & 63; F.wave = __builtin_amdgcn_readfirstlane(t >> 6); }
__device__ __forceinline__ float wave_sum(float v) {
#pragma unroll
    for (int o = 1; o < 64; o <<= 1) v += __shfl_xor(v, o);
    return v;
}
__device__ __forceinline__ float silu_f(float x) { return x / (1.0f + __expf(-x)); }

__device__ __forceinline__ void transpose_item(const float* __restrict__ W, int N, bf16* __restrict__ WT, int ldt, int k0, int n0, int rowbase, LAS float* scr, int lane) {
    float tv[32];
    { const float* wp = W + (size_t)(k0 + (lane >> 5)) * N + n0 + (lane & 31);
#pragma unroll
      for (int i = 0; i < 32; ++i) tv[i] = __builtin_nontemporal_load(wp + (size_t)(2 * i) * N); }
#pragma unroll
    for (int i = 0; i < 32; ++i) scr[(2 * i + (lane >> 5)) * 33 + (lane & 31)] = tv[i];
    LDS_WAIT(); asm volatile("" ::: "memory");
    const int c = lane & 7;
#pragma unroll
    for (int j = 0; j < 4; ++j) { const int n = (lane >> 3) + 8 * j; const LAS float* s = scr + (8 * c) * 33 + n;
        v4u o; o.x = pk2(s[0 * 33], s[1 * 33]); o.y = pk2(s[2 * 33], s[3 * 33]); o.z = pk2(s[4 * 33], s[5 * 33]); o.w = pk2(s[6 * 33], s[7 * 33]);
        *(v4u*)(WT + (size_t)(rowbase + n) * ldt + k0 + 8 * c) = o; }
    LDS_WAIT(); asm volatile("" ::: "memory");
}

__device__ __forceinline__ void transpose_item_i8(const float* __restrict__ W, int N, signed char* __restrict__ WT, int ldt, int k0, int n0, int rowbase, float qs, LAS float* scr, int lane) {
    float tv[32];
    { const float* wp = W + (size_t)(k0 + (lane >> 5)) * N + n0 + (lane & 31);
#pragma unroll
      for (int i = 0; i < 32; ++i) tv[i] = __builtin_nontemporal_load(wp + (size_t)(2 * i) * N); }
#pragma unroll
    for (int i = 0; i < 32; ++i) scr[(2 * i + (lane >> 5)) * 33 + (lane & 31)] = tv[i];
    LDS_WAIT(); asm volatile("" ::: "memory");
    const int c = lane & 3;
#pragma unroll
    for (int j = 0; j < 2; ++j) { const int n = (lane >> 2) + 16 * j; const LAS float* s = scr + (16 * c) * 33 + n; v4u o;
#pragma unroll
        for (int d = 0; d < 4; ++d) { unsigned w = 0u;
#pragma unroll
            for (int i = 0; i < 4; ++i) { const float f = fminf(fmaxf(s[(4 * d + i) * 33] * qs, -127.0f), 127.0f); w |= ((unsigned)((int)__builtin_rintf(f)) & 255u) << (8 * i); }
            o[d] = w; }
        *(v4u*)(WT + (size_t)(rowbase + n) * ldt + k0 + 16 * c) = o; }
    LDS_WAIT(); asm volatile("" ::: "memory");
}

__device__ __forceinline__ void transpose_item_f8(const float* __restrict__ W, int N, unsigned char* __restrict__ WT, int ldt, int k0, int n0, int rowbase, float qs, LAS float* scr, int lane) {
    float tv[32];
    { const float* wp = W + (size_t)(k0 + (lane >> 5)) * N + n0 + (lane & 31);
#pragma unroll
      for (int i = 0; i < 32; ++i) tv[i] = __builtin_nontemporal_load(wp + (size_t)(2 * i) * N); }
#pragma unroll
    for (int i = 0; i < 32; ++i) scr[(2 * i + (lane >> 5)) * 33 + (lane & 31)] = tv[i];
    LDS_WAIT(); asm volatile("" ::: "memory");
    const int c = lane & 3;
#pragma unroll
    for (int j = 0; j < 2; ++j) { const int n = (lane >> 2) + 16 * j; const LAS float* s = scr + (16 * c) * 33 + n; v4u o;
#pragma unroll
        for (int d = 0; d < 4; ++d) { float f[4];
#pragma unroll
            for (int i = 0; i < 4; ++i) f[i] = fminf(fmaxf(s[(4 * d + i) * 33] * qs, -448.0f), 448.0f);
            int w = __builtin_amdgcn_cvt_pk_fp8_f32(f[0], f[1], 0, false); w = __builtin_amdgcn_cvt_pk_fp8_f32(f[2], f[3], w, true); o[d] = (unsigned)w; }
        *(v4u*)(WT + (size_t)(rowbase + n) * ldt + k0 + 16 * c) = o; }
    LDS_WAIT(); asm volatile("" ::: "memory");
}

__device__ __forceinline__ void sincos_d(float af, float& c, float& s) {
    const double a = (double)af;
    const double q = __builtin_rint(a * 0.63661977236758134308);
    double r = __builtin_fma(-q, 1.57079632679489655800e+00, a); r = __builtin_fma(-q, 6.12323399573676603587e-17, r);
    const double r2 = r * r;
    double sp = -7.6471637318198164759e-13; sp = sp * r2 + 1.6059043836821614599e-10; sp = sp * r2 - 2.5052108385441718775e-08; sp = sp * r2 + 2.7557319223985890653e-06;
    sp = sp * r2 - 1.9841269841269841270e-04; sp = sp * r2 + 8.3333333333333333333e-03; sp = sp * r2 - 1.6666666666666666667e-01; const double sn = r + r * r2 * sp;
    double cp = 4.7794773323873852974e-14; cp = cp * r2 - 1.1470745597729724714e-11; cp = cp * r2 + 2.0876756987868098979e-09; cp = cp * r2 - 2.7557319223985890653e-07;
    cp = cp * r2 + 2.4801587301587301587e-05; cp = cp * r2 - 1.3888888888888888889e-03; cp = cp * r2 + 4.1666666666666666667e-02; cp = cp * r2 - 0.5; const double cs = 1.0 + r2 * cp;
    const int qi = (int)q & 3;
    const double cc = (qi == 0) ? cs : (qi == 1) ? -sn : (qi == 2) ? -cs : sn;
    const double ss = (qi == 0) ? sn : (qi == 1) ? cs : (qi == 2) ? -sn : -cs;
    c = (float)cc; s = (float)ss;
}

#define MEMFENCE() asm volatile("" ::: "memory")
__device__ __forceinline__ void p0_prologue(KA a, Frame& F) {
    relane(F);
    unsigned char* ws = a->ws;
    float* MOD = (float*)(ws + WS_MOD);
    if ((int)blockIdx.x < 192) {
        LAS float* sl = (LAS float*)F.lds + 4096;
        for (int i = F.tid; i < 5 * 1024; i += NWAVES * 64) { const int v = i >> 10, k = i & 1023; const float cv = (v < 4) ? a->in[I_C][v * 1024 + k] : a->in[I_CCTX][k]; sl[i] = silu_f(cv); }
        __syncthreads();
        for (int it = blockIdx.x; it < 192; it += F.G) {
            const int l = it / 96, col = (it % 96) * 64 + F.lane;
            const float* W = a->in[I_WADA] + (size_t)l * 1024 * 6144;
            float acc[5] = {0.f, 0.f, 0.f, 0.f, 0.f};
#pragma unroll 8
            for (int kk = 0; kk < 128; ++kk) { const int k = F.wave * 128 + kk; const float w = W[(size_t)k * 6144 + col];
#pragma unroll
                for (int v = 0; v < 5; ++v) acc[v] += sl[v * 1024 + k] * w; }
            LAS float* red = (LAS float*)F.lds;
#pragma unroll
            for (int v = 0; v < 5; ++v) red[(F.wave * 5 + v) * 64 + F.lane] = acc[v];
            __syncthreads();
            if (F.wave < 5) { float s2 = a->in[I_BADA][l * 6144 + col];
#pragma unroll
                for (int w = 0; w < 8; ++w) s2 += red[(w * 5 + F.wave) * 64 + F.lane];
                MOD[(l * 5 + F.wave) * 6144 + col] = s2; }
            __syncthreads();
        }
    }
    for (int it = blockIdx.x; it < 96; it += F.G) {
        const int l = it / 48, e = (it % 48) / 3, which = it % 3;
        float ss = 0.f;
        if (which < 2) { const float* W = (which ? a->in[I_WU] : a->in[I_WG]) + ((size_t)l * NE + e) * 1024 * 2048;
            for (int i = 0; i < 32; ++i) { const f32x4 v = *(const f32x4*)(W + (size_t)(32 * i) * 2048 + 4 * F.tid); ss += (v.x * v.x + v.y * v.y) + (v.z * v.z + v.w * v.w); } }
        else { const float* W = a->in[I_WD] + ((size_t)l * NE + e) * 2048 * 1024;
            for (int i = 0; i < 64; ++i) { const f32x2 v = *(const f32x2*)(W + (size_t)(32 * i) * 1024 + 2 * F.tid); ss += v.x * v.x + v.y * v.y; } }
        ss = wave_sum(ss);
        LAS float* red = (LAS float*)F.lds;
        if (F.lane == 0) red[F.wave] = ss;
        __syncthreads();
        if (F.tid == 0) { float t = 0.f; for (int w = 0; w < NWAVES; ++w) t += red[w]; const float rms = fmaxf(sqrtf(t * (1.0f / 65536.0f)), 1e-20f);
            ((float*)(ws + WS_SW))[l * 48 + 3 * e + which] = (which < 2) ? 5.0f * rms * (1.0f / 127.0f) : rms * (1.0f / 16.0f); }
        __syncthreads();
    }
    if ((int)blockIdx.x == 192 % F.G && F.wave == 0) {
        float* LAM = (float*)(ws + WS_LAM);
        for (int l = 0; l < NLAYER; ++l) {
            const float p1 = F.lane < 32 ? a->in[I_LQ1][l * 32 + F.lane] * a->in[I_LK1][l * 32 + F.lane] : 0.f;
            const float p2 = F.lane < 32 ? a->in[I_LQ2][l * 32 + F.lane] * a->in[I_LK2][l * 32 + F.lane] : 0.f;
            const float s1 = wave_sum(p1), s2 = wave_sum(p2);
            const float li = 0.8f - 0.6f * expf(-0.3f * (float)l);
            if (F.lane == 0) { LAM[2 * l] = expf(s1) - expf(s2) + li; LAM[2 * l + 1] = li; }
        }
    }
    if ((int)blockIdx.x == 193 % F.G) {
        f32x2* TA_R = (f32x2*)(ws + WS_TAB + TAB_AROW); f32x2* TA_C = (f32x2*)(ws + WS_TAB + TAB_ACOL); f32x2* TG_R = (f32x2*)(ws + WS_TAB + TAB_GROW); f32x2* TG_C = (f32x2*)(ws + WS_TAB + TAB_GCOL);
        const double b8 = 1.0 / __builtin_sqrt(__builtin_sqrt(__builtin_sqrt(10000.0))), b16 = 1.0 / __builtin_sqrt(__builtin_sqrt(__builtin_sqrt(__builtin_sqrt(10000.0))));
        for (int e = F.tid; e < 4608; e += NWAVES * 64) {
            int pos, i, nf; f32x2* dst;
            if (e < 1024) { pos = e >> 3; i = e & 7; nf = 8; dst = TA_R + e; }
            else if (e < 1536) { const int r = e - 1024; pos = r >> 3; i = r & 7; nf = 8; dst = TA_C + r; }
            else if (e < 3584) { const int r = e - 1536; pos = r >> 4; i = r & 15; nf = 16; dst = TG_R + r; }
            else { const int r = e - 3584; pos = r >> 4; i = r & 15; nf = 16; dst = TG_C + r; }
            double inv = 1.0; const double bb = (nf == 8) ? b8 : b16;
            for (int j = 0; j < i; ++j) inv *= bb;
            const float ang = (float)pos * (float)inv;
            float c, s; sincos_d(ang, c, s);
            *dst = (f32x2){c, s};
        }
    }
    for (int it = blockIdx.x; it < 896; it += F.G) {
        const int l = it / 448; int r = it % 448;
        int kb, nb, R, roff, ncols, orow0; const float *Wu, *gg;
        if (r < 192) { kb = r / 6; nb = r % 6; R = 256; roff = 0; ncols = 384; orow0 = ZQ + nb * 64; Wu = a->in[I_WUQ] + (size_t)l * 256 * 384; gg = a->in[I_GCQ] + l * 256; }
        else { r -= 192; kb = r / 8; nb = r % 8; R = 128; roff = 256; ncols = 512; orow0 = ZKV + nb * 64; Wu = a->in[I_WUKV] + (size_t)l * 128 * 512; gg = a->in[I_GCKV] + l * 128; }
        const float* Win = a->in[I_WIN] + (size_t)l * 1024 * INC;
        LAS float* As = (LAS float*)F.lds; LAS float* Bs = As + 32 * 257;
        for (int idx = F.tid; idx < 32 * R; idx += NWAVES * 64) { const int kk = idx / R, rr = idx % R; As[kk * 257 + rr] = Win[(size_t)(kb * 32 + kk) * INC + roff + rr]; }
        for (int idx = F.tid; idx < R * 64; idx += NWAVES * 64) { const int rr = idx >> 6, n = idx & 63; Bs[rr * 64 + n] = gg[rr] * Wu[(size_t)rr * ncols + nb * 64 + n]; }
        __syncthreads();
        const int kk = F.tid & 31, ng = F.tid >> 5;
        f32x4 acc = (f32x4){0.f, 0.f, 0.f, 0.f};
        for (int rr = 0; rr < R; ++rr) { const float av = As[kk * 257 + rr]; const f32x4 bv = *(const LAS f32x4*)(Bs + rr * 64 + ng * 4); acc += av * bv; }
        bf16* Wc = (bf16*)(ws + WS_WCAT) + (size_t)l * ZP * 1024;
#pragma unroll
        for (int j = 0; j < 4; ++j) Wc[(size_t)(orow0 + ng * 4 + j) * 1024 + kb * 32 + kk] = (bf16)(pk2(acc[j], 0.f) & 0xffffu);
        __syncthreads();
    }
    {
        LAS float* scr = (LAS float*)(F.lds + F.wave * 16384);
        const int gw = F.vcu * NWAVES + F.wave, NGW = F.G * NWAVES;
        constexpr int I_IN = 16 * 61, I_O = 16 * 32, PER_L = I_IN + I_O;
        for (int it = gw; it < NLAYER * PER_L; it += NGW) {
            const int l = it / PER_L; int r = it % PER_L;
            if (r < I_IN) { const int kb = r / 61, nb = r % 61; transpose_item(a->in[I_WIN] + (size_t)l * 1024 * INC, INC, (bf16*)(ws + WS_WCAT) + (size_t)l * ZP * 1024, 1024, kb * 64, nb * 32, nb * 32, scr, F.lane); }
            else { r -= I_IN; const int kb = r / 32, nb = r % 32; transpose_item(a->in[I_WO] + (size_t)l * 1024 * 1024, 1024, (bf16*)(ws + WS_WO) + (size_t)l * 1024 * 1024, 1024, kb * 64, nb * 32, nb * 32, scr, F.lane); }
        }
        const int gt = F.vcu * (NWAVES * 64) + F.tid, NGT = F.G * NWAVES * 64;
        constexpr int PADV = (ZP - ZEND) * 1024 * 2 / 16;
        for (int i = gt; i < NLAYER * PADV; i += NGT) { const int l = i / PADV, j = i % PADV; ((v4u*)((bf16*)(ws + WS_WCAT) + ((size_t)l * ZP + ZEND) * 1024))[j] = (v4u){0u, 0u, 0u, 0u}; }
    }
}

__device__ __forceinline__ void phase_a(KA a, Frame& F, int l) {
    relane(F);
    unsigned char* ws = a->ws;
    const float* MOD = (const float*)(ws + WS_MOD);
    const int* INV = (const int*)(ws + WS_INV);
    const bf16* YE = (const bf16*)(ws + WS_YE);
    const bool fin = (l == NLAYER);
    const int nrows = fin ? LROWS : MROWS;
    const int gw = F.vcu * NWAVES + F.wave, NGW = F.G * NWAVES;
#define PA_LOAD(r, XF, XB, IV) do { if (l == 0) { const float* src_ = ((r) >= LROWS) ? a->in[I_CTX] + (size_t)((r) - LROWS) * 1024 : a->in[I_X] + (size_t)(r) * 1024; \
            _Pragma("unroll") for (int j = 0; j < 4; ++j) XF[j] = *(const f32x4*)(src_ + 4 * F.lane + 256 * j); } \
        else { const bf16* xb_ = (const bf16*)(ws + WS_XB) + (size_t)(r) * 1024; _Pragma("unroll") for (int j = 0; j < 4; ++j) XB[j] = *(const v2u*)(xb_ + 4 * F.lane + 256 * j); \
            IV = INV[(size_t)(r) * 16 + (F.lane & 15)]; } } while (0)
    f32x4 cf[4]; v2u cb[4]; int civ = -1;
#pragma unroll
    for (int j = 0; j < 4; ++j) { cf[j] = (f32x4){0.f, 0.f, 0.f, 0.f}; cb[j] = (v2u){0u, 0u}; }
    if (gw < nrows) PA_LOAD(gw, cf, cb, civ);
    for (int row = gw; row < nrows; row += NGW) {
        const bool isc = row >= LROWS; const int v = isc ? 4 : (row >> 13);
        bf16* xb = (bf16*)(ws + WS_XB) + (size_t)row * 1024;
        const int nrow = row + NGW; f32x4 nf[4]; v2u nb[4]; int niv = -1;
#pragma unroll
        for (int j = 0; j < 4; ++j) { nf[j] = cf[j]; nb[j] = cb[j]; }
        if (nrow < nrows) PA_LOAD(nrow, nf, nb, niv);
        f32x4 xv[4];
        if (l == 0) {
#pragma unroll
            for (int j = 0; j < 4; ++j) xv[j] = cf[j]; }
        else {
#pragma unroll
            for (int j = 0; j < 4; ++j) xv[j] = (f32x4){bflo(cb[j].x), bfhi(cb[j].x), bflo(cb[j].y), bfhi(cb[j].y)}; }
        if (l > 0) {
            const float* ga2 = MOD + ((l - 1) * 5 + v) * 6144 + 5 * 1024;
            f32x4 acc[4];
#pragma unroll
            for (int j = 0; j < 4; ++j) acc[j] = (f32x4){0.f, 0.f, 0.f, 0.f};
            unsigned sel = (unsigned)(__ballot(civ >= 0) & 0xFFFFull);
            while (sel) {
                int sl[4]; float on[4];
#pragma unroll
                for (int k = 0; k < 4; ++k) { if (sel) { const int e = __builtin_ctz(sel); sel &= sel - 1u; sl[k] = __builtin_amdgcn_readlane(civ, e); on[k] = 1.0f; } else { sl[k] = sl[0]; on[k] = 0.0f; } }
                v2u w[4][4];
#pragma unroll
                for (int k = 0; k < 4; ++k) { const bf16* yr = YE + (size_t)sl[k] * 1024 + 4 * F.lane;
#pragma unroll
                    for (int j = 0; j < 4; ++j) w[k][j] = *(const v2u*)(yr + 256 * j); }
#pragma unroll
                for (int k = 0; k < 4; ++k)
#pragma unroll
                    for (int j = 0; j < 4; ++j) acc[j] += on[k] * (f32x4){bflo(w[k][j].x), bfhi(w[k][j].x), bflo(w[k][j].y), bfhi(w[k][j].y)};
            }
#pragma unroll
            for (int j = 0; j < 4; ++j) { const f32x4 g = *(const f32x4*)(ga2 + 4 * F.lane + 256 * j); xv[j] += g * acc[j]; }
        }
#pragma unroll
        for (int j = 0; j < 4; ++j) { cf[j] = nf[j]; cb[j] = nb[j]; }
        civ = niv;
        if (fin) {
#pragma unroll
            for (int j = 0; j < 4; ++j) *(f32x4*)(a->out + (size_t)row * 1024 + 4 * F.lane + 256 * j) = xv[j];
            continue; }
#pragma unroll
        for (int j = 0; j < 4; ++j) { v2u w; w.x = pk2(xv[j].x, xv[j].y); w.y = pk2(xv[j].z, xv[j].w); *(v2u*)(xb + 4 * F.lane + 256 * j) = w; }
        float ss = 0.f;
#pragma unroll
        for (int j = 0; j < 4; ++j) ss += (xv[j].x * xv[j].x + xv[j].y * xv[j].y) + (xv[j].z * xv[j].z + xv[j].w * xv[j].w);
        const float rstd = rsqrtf(wave_sum(ss) * (1.0f / 1024.0f) + EPSF);
        const float* g1 = a->in[I_GN1] + l * 1024; const float* sh = MOD + (l * 5 + v) * 6144; const float* sc = sh + 1024;
        float am = 0.f;
#pragma unroll
        for (int j = 0; j < 4; ++j) { const int c0 = 4 * F.lane + 256 * j; const f32x4 g = *(const f32x4*)(g1 + c0), s1 = *(const f32x4*)(sc + c0), b1 = *(const f32x4*)(sh + c0);
            xv[j] = xv[j] * rstd * g * (1.0f + s1) + b1;
            am = fmaxf(fmaxf(am, fmaxf(fabsf(xv[j].x), fabsf(xv[j].y))), fmaxf(fabsf(xv[j].z), fabsf(xv[j].w))); }
#pragma unroll
        for (int o = 1; o < 64; o <<= 1) am = fmaxf(am, __shfl_xor(am, o));
        const float qs = am > 0.f ? 127.0f / am : 0.f;
        signed char* h8 = (signed char*)(ws + WS_H) + (size_t)row * 1024;
#pragma unroll
        for (int j = 0; j < 4; ++j) { const int q0 = (int)__builtin_rintf(xv[j].x * qs), q1 = (int)__builtin_rintf(xv[j].y * qs), q2 = (int)__builtin_rintf(xv[j].z * qs), q3 = (int)__builtin_rintf(xv[j].w * qs);
            *(unsigned*)(h8 + 4 * F.lane + 256 * j) = (unsigned)(q0 & 255) | ((unsigned)(q1 & 255) << 8) | ((unsigned)(q2 & 255) << 16) | ((unsigned)(q3 & 255) << 24); }
        if (F.lane == 0) ((float*)(ws + WS_SA))[row] = am * (1.0f / 127.0f);
    }
#undef PA_LOAD
    if (l == 0) {
        const bf16* Wc = (const bf16*)(ws + WS_WCAT); signed char* W8 = (signed char*)(ws + WS_WCAT8); float* SWC = (float*)(ws + WS_SWC);
        for (int r = gw; r < NLAYER * ZP; r += NGW) {
            float wv[16]; float am = 0.f;
#pragma unroll
            for (int j = 0; j < 2; ++j) { const v4u w = *(const v4u*)(Wc + (size_t)r * 1024 + 8 * F.lane + 512 * j);
                wv[8 * j + 0] = bflo(w.x); wv[8 * j + 1] = bfhi(w.x); wv[8 * j + 2] = bflo(w.y); wv[8 * j + 3] = bfhi(w.y); wv[8 * j + 4] = bflo(w.z); wv[8 * j + 5] = bfhi(w.z); wv[8 * j + 6] = bflo(w.w); wv[8 * j + 7] = bfhi(w.w); }
#pragma unroll
            for (int i = 0; i < 16; ++i) am = fmaxf(am, fabsf(wv[i]));
#pragma unroll
            for (int o = 1; o < 64; o <<= 1) am = fmaxf(am, __shfl_xor(am, o));
            const float qs = am > 0.f ? 127.0f / am : 0.f;
#pragma unroll
            for (int j = 0; j < 2; ++j) { unsigned w0 = 0u, w1 = 0u;
#pragma unroll
                for (int i = 0; i < 4; ++i) { w0 |= ((unsigned)((int)__builtin_rintf(wv[8 * j + i] * qs)) & 255u) << (8 * i); w1 |= ((unsigned)((int)__builtin_rintf(wv[8 * j + 4 + i] * qs)) & 255u) << (8 * i); }
                v2u o; o.x = w0; o.y = w1; *(v2u*)(W8 + (size_t)r * 1024 + 8 * F.lane + 512 * j) = o; }
            if (F.lane == 0) SWC[r] = am * (1.0f / 127.0f);
        }
    }
}

__device__ __forceinline__ void ld8(const bf16* p, float* f) { const v4u w = *(const v4u*)p; f[0] = bflo(w.x); f[1] = bfhi(w.x); f[2] = bflo(w.y); f[3] = bfhi(w.y); f[4] = bflo(w.z); f[5] = bfhi(w.z); f[6] = bflo(w.w); f[7] = bfhi(w.w); }
__device__ __forceinline__ v4u pk8(const float* f) { v4u w; w.x = pk2(f[0], f[1]); w.y = pk2(f[2], f[3]); w.z = pk2(f[4], f[5]); w.w = pk2(f[6], f[7]); return w; }
template <int N> __device__ __forceinline__ float ssq_row(const bf16* p) { float s = 0.f;
#pragma unroll
    for (int c = 0; c < N / 8; ++c) { float f[8]; ld8(p + 8 * c, f);
#pragma unroll
        for (int i = 0; i < 8; ++i) s += f[i] * f[i];
        if ((c & 7) == 7) MEMFENCE(); }
    return s; }
template <int NP> __device__ __forceinline__ void rope_pairs(float* x, const f32x2* trow, const f32x2* tcol) {
#pragma unroll
    for (int i = 0; i < NP; ++i) { const f32x2 cs = (i < NP / 2) ? trow[i] : tcol[i - NP / 2];
        const float x0 = x[2 * i], x1 = x[2 * i + 1]; x[2 * i] = x0 * cs.x - x1 * cs.y; x[2 * i + 1] = x0 * cs.y + x1 * cs.x; }
}
__device__ __forceinline__ void store_v_tile(char* vt, int lane, const float* v  ) {
    char* p = vt + (lane >> 4) * 1024 + ((lane >> 3) & 1) * 512 + (lane & 7) * 64;
#pragma unroll
    for (int d = 0; d < 2; ++d)
#pragma unroll
        for (int c = 0; c < 4; ++c) *(v4u*)(p + d * 4096 + c * 16) = pk8(v + d * 32 + c * 8);
}
template <bool ROPE> __device__ __forceinline__ v4u proc8(v4u w, float r, const float* g, const f32x2* cs, float qs) {
    float f[8] = {bflo(w.x), bfhi(w.x), bflo(w.y), bfhi(w.y), bflo(w.z), bfhi(w.z), bflo(w.w), bfhi(w.w)};
#pragma unroll
    for (int i = 0; i < 8; ++i) f[i] *= r * g[i];
    if (ROPE) {
#pragma unroll
        for (int i = 0; i < 4; ++i) { const f32x2 t = cs[i]; const float x0 = f[2 * i], x1 = f[2 * i + 1]; f[2 * i] = x0 * t.x - x1 * t.y; f[2 * i + 1] = x0 * t.y + x1 * t.x; }
    }
#pragma unroll
    for (int i = 0; i < 8; ++i) f[i] *= qs;
    return pk8(f);
}
__device__ __forceinline__ v2u pk8_f8(const float* f) { int w0 = __builtin_amdgcn_cvt_pk_fp8_f32(f[0], f[1], 0, false); w0 = __builtin_amdgcn_cvt_pk_fp8_f32(f[2], f[3], w0, true);
    int w1 = __builtin_amdgcn_cvt_pk_fp8_f32(f[4], f[5], 0, false); w1 = __builtin_amdgcn_cvt_pk_fp8_f32(f[6], f[7], w1, true); return (v2u){(unsigned)w0, (unsigned)w1}; }
template <bool ROPE> __device__ __forceinline__ v2u proc8f(v4u w, float r, const float* g, const f32x2* cs, float qs) {
    float f[8] = {bflo(w.x), bfhi(w.x), bflo(w.y), bfhi(w.y), bflo(w.z), bfhi(w.z), bflo(w.w), bfhi(w.w)};
#pragma unroll
    for (int i = 0; i < 8; ++i) f[i] *= r * g[i];
    if (ROPE) {
#pragma unroll
        for (int i = 0; i < 4; ++i) { const f32x2 t = cs[i]; const float x0 = f[2 * i], x1 = f[2 * i + 1]; f[2 * i] = x0 * t.x - x1 * t.y; f[2 * i + 1] = x0 * t.y + x1 * t.x; }
    }
#pragma unroll
    for (int i = 0; i < 8; ++i) f[i] *= qs;
    return pk8_f8(f);
}
__device__ __forceinline__ att::i32x6a fp6_group(const v4u& c0, const v4u& c1, const v4u& c2, const v4u& c3) {
    att::u32x16 w; w[0] = c0.x; w[1] = c0.y; w[2] = c0.z; w[3] = c0.w; w[4] = c1.x; w[5] = c1.y; w[6] = c1.z; w[7] = c1.w; w[8] = c2.x; w[9] = c2.y; w[10] = c2.z; w[11] = c2.w; w[12] = c3.x; w[13] = c3.y; w[14] = c3.z; w[15] = c3.w;
    return att::cvt_fp6x32(w); }
__device__ __forceinline__ void store_qgroup(unsigned char* q, const att::i32x6a& g) { *(v2u*)q = (v2u){(unsigned)g[0], (unsigned)g[1]}; *(v2u*)(q + 8) = (v2u){(unsigned)g[2], (unsigned)g[3]}; *(v2u*)(q + 16) = (v2u){(unsigned)g[4], (unsigned)g[5]}; }
__device__ __forceinline__ void store_kgroup(char* kt, int pb, int j, int lane, const att::i32x6a& g) {
    *(v4u*)(kt + j * 1024 + lane * 16) = (v4u){(unsigned)g[0], (unsigned)g[1], (unsigned)g[2], (unsigned)g[3]}; *(v2u*)(kt + pb + j * 512 + lane * 8) = (v2u){(unsigned)g[4], (unsigned)g[5]}; }
__device__ __forceinline__ float ssq8(v4u w) { const float f[8] = {bflo(w.x), bfhi(w.x), bflo(w.y), bfhi(w.y), bflo(w.z), bfhi(w.z), bflo(w.w), bfhi(w.w)}; float s = 0.f;
#pragma unroll
    for (int i = 0; i < 8; ++i) s += f[i] * f[i];
    return s; }
__device__ __forceinline__ v4u scale8(v4u w, float r) { float f[8] = {bflo(w.x), bfhi(w.x), bflo(w.y), bfhi(w.y), bflo(w.z), bfhi(w.z), bflo(w.w), bfhi(w.w)};
#pragma unroll
    for (int i = 0; i < 8; ++i) f[i] *= r;
    return pk8(f); }
__device__ __forceinline__ void store_v_tile_pk(char* vt, int lane, const v4u* w) {
    char* p = vt + (lane >> 4) * 1024 + ((lane >> 3) & 1) * 512 + (lane & 7) * 64;
#pragma unroll
    for (int c = 0; c < 8; ++c) *(v4u*)(p + (c >> 2) * 4096 + (c & 3) * 16) = w[c];
}
__device__ __forceinline__ void store_v_tile_f8(char* vt, int lane, const v4u* w, float sc, LAS unsigned char* scr) {
    LAS unsigned char* p = scr + (2 * ((lane >> 2) & 1) + (lane >> 5)) * 1024 + 4 * ((lane >> 3) & 3) + (lane & 3);
#pragma unroll
    for (int c = 0; c < 8; ++c) { const float f[8] = {bflo(w[c].x), bfhi(w[c].x), bflo(w[c].y), bfhi(w[c].y), bflo(w[c].z), bfhi(w[c].z), bflo(w[c].w), bfhi(w[c].w)};
#pragma unroll
        for (int i = 0; i < 8; i += 2) { const int b8 = __builtin_amdgcn_cvt_pk_fp8_f32(f[i] * sc, f[i + 1] * sc, 0, false);
            p[(8 * c + i) * 16] = (unsigned char)b8; p[(8 * c + i + 1) * 16] = (unsigned char)(b8 >> 8); } }
    LDS_WAIT(); asm volatile("" ::: "memory");
#pragma unroll
    for (int i = 0; i < 4; ++i) *(v4u*)(vt + i * 1024 + lane * 16) = *(const LAS v4u*)(scr + i * 1024 + lane * 16);
    LDS_WAIT(); asm volatile("" ::: "memory");
}
__device__ __forceinline__ void phase_c(KA a, Frame& F, int l) {
    relane(F);
    unsigned char* ws = a->ws;
    const bf16* Z = (const bf16*)(ws + WS_Z); const float* SSQ = (const float*)(ws + WS_SSQ);
    unsigned char* qkv = ws + WS_QKV;
    LAS unsigned char* vscr = (LAS unsigned char*)F.lds + F.wave * 4096;
    const f32x2* TA_R = (const f32x2*)(ws + WS_TAB + TAB_AROW); const f32x2* TA_C = (const f32x2*)(ws + WS_TAB + TAB_ACOL);
    const f32x2* TG_R = (const f32x2*)(ws + WS_TAB + TAB_GROW); const f32x2* TG_C = (const f32x2*)(ws + WS_TAB + TAB_GCOL);
    const int gw = F.vcu * NWAVES + F.wave, NGW = F.G * NWAVES, lane = F.lane;
    for (int id = gw; id < 528 * 32; id += NGW) {
        const int tile = id % 528, job = id / 528;
        const int b = tile / NKT, tt = tile % NKT; const bool isc = tt >= 128;
        const int zrow = isc ? LROWS + b * CL + (tt - 128) * 64 + lane : b * SEQ + tt * 64 + lane;
        const int tok = tt * 64 + lane;
        const bf16* zr = Z + (size_t)zrow * ZP;
        const f32x2* tar = TA_R + (isc ? 0 : tt) * 8; const f32x2* tac = TA_C + lane * 8;
        const f32x2* tgr = TG_R + (isc ? 0 : tt) * 16; const f32x2* tgc = TG_C + lane * 16;
        MEMFENCE();
        if (job < 4) {
            const int h = job;
            float r1; { const f32x4 s0 = *(const f32x4*)(SSQ + (size_t)zrow * 12), s1 = *(const f32x4*)(SSQ + (size_t)zrow * 12 + 4); r1 = rsqrtf((((s0.x + s0.y) + (s0.z + s0.w)) + ((s1.x + s1.y) + (s1.z + s1.w))) * (1.0f / 256.0f) + EPSF); }
            v4u w[12]; float ss = 0.f;
#pragma unroll
            for (int c = 0; c < 12; ++c) { w[c] = *(const v4u*)(zr + ZQ + h * 96 + 8 * c); ss += ssq8(w[c]); }
            MEMFENCE();
            const float r = r1 * rsqrtf(ss * r1 * r1 * (1.0f / 96.0f) + EPSF); const float* g = a->in[I_GMQ] + l * 96;
            const float qs = att::FQ96;
            unsigned char* q = (unsigned char*)(qkv + QO_QM) + ((size_t)(b * 4 + h) * NTOKB + tok) * 72;
#pragma unroll
            for (int gq = 0; gq < 3; ++gq) { v4u o[4];
#pragma unroll
                for (int cc = 0; cc < 4; ++cc) { const int c = 4 * gq + cc;
                    if (c < 8 || isc) o[cc] = proc8<false>(w[c], r, g + 8 * c, nullptr, qs);
                    else o[cc] = proc8<true>(w[c], r, g + 8 * c, (c < 10) ? tar + 4 * (c - 8) : tac + 4 * (c - 10), qs); }
                store_qgroup(q + 24 * gq, fp6_group(o[0], o[1], o[2], o[3])); MEMFENCE(); }
        } else if (job < 8) {
            const int h = job - 4;
            float r1; { const f32x4 s2 = *(const f32x4*)(SSQ + (size_t)zrow * 12 + 8); r1 = rsqrtf(((s2.x + s2.y) + (s2.z + s2.w)) * (1.0f / 128.0f) + EPSF); }
            v4u w[12]; float ss = 0.f, s2 = 0.f;
#pragma unroll
            for (int c = 0; c < 8; ++c) { w[c] = *(const v4u*)(zr + ZKV + h * 128 + 8 * c); ss += ssq8(w[c]); }
#pragma unroll
            for (int c = 0; c < 4; ++c) { w[8 + c] = *(const v4u*)(zr + 384 + 8 * c); s2 += ssq8(w[8 + c]); }
            MEMFENCE();
            const float r2 = rsqrtf((ss * r1 * r1 + s2) * (1.0f / 96.0f) + EPSF); const float* g = a->in[I_GMK] + l * 96;
            char* kt = (char*)(qkv + QO_KM) + ((size_t)(b * 4 + h) * NKT + tt) * 5120;
#pragma unroll
            for (int gq = 0; gq < 3; ++gq) { v4u o[4];
#pragma unroll
                for (int cc = 0; cc < 4; ++cc) { const int c = 4 * gq + cc;
                    if (c < 8) o[cc] = proc8<false>(w[c], r1 * r2, g + 8 * c, nullptr, 1.0f);
                    else if (isc) o[cc] = proc8<false>(w[c], r2, g + 8 * c, nullptr, 1.0f);
                    else o[cc] = proc8<true>(w[c], r2, g + 8 * c, (c < 10) ? tar + 4 * (c - 8) : tac + 4 * (c - 10), 1.0f); }
                store_kgroup(kt, 3072, gq, lane, fp6_group(o[0], o[1], o[2], o[3])); MEMFENCE(); }
            v4u vw[8];
#pragma unroll
            for (int c = 0; c < 8; ++c) vw[c] = *(const v4u*)(zr + ZKV + h * 128 + 64 + 8 * c);
            store_v_tile_f8((char*)(qkv + QO_VM) + ((size_t)(b * 4 + h) * NKT + tt) * 4096, lane, vw, r1, vscr);
        } else if (job < 16) {
            const bool isk = job >= 12; const int h = (job - 8) & 3;
            const bf16* zp = zr + (isk ? 672 : 416) + h * 64; const float* g = (isk ? a->in[I_GDK] : a->in[I_GDQ]) + l * 32;
            const float qs = isk ? 1.0f : att::FQ32;
            v4u w[8]; float ss[2] = {0.f, 0.f};
#pragma unroll
            for (int c = 0; c < 8; ++c) { w[c] = *(const v4u*)(zp + 8 * c); ss[c >> 2] += ssq8(w[c]); }
            MEMFENCE();
            const float r0 = rsqrtf(ss[0] * (1.0f / 32.0f) + EPSF), r1 = rsqrtf(ss[1] * (1.0f / 32.0f) + EPSF);
            char* kt = (char*)(qkv + QO_KD) + ((size_t)(b * 4 + h) * NKT + tt) * 3072;
            unsigned char* q = (unsigned char*)(qkv + QO_QD) + ((size_t)(b * 4 + h) * NTOKB + tok) * 48;
#pragma unroll
            for (int gq = 0; gq < 2; ++gq) { v4u o[4];
#pragma unroll
                for (int cm = 0; cm < 4; ++cm) { const int c = 4 * gq + cm;
                    if (isc) o[cm] = proc8<false>(w[c], gq ? r1 : r0, g + 8 * cm, nullptr, qs);
                    else o[cm] = proc8<true>(w[c], gq ? r1 : r0, g + 8 * cm, (cm < 2) ? tar + 4 * cm : tac + 4 * (cm - 2), qs); }
                const att::i32x6a gr = fp6_group(o[0], o[1], o[2], o[3]);
                if (isk) store_kgroup(kt, 2048, gq, lane, gr); else store_qgroup(q + 24 * gq, gr);
                MEMFENCE(); }
        } else if (job < 20) {
            const int h = job - 16; v4u vw[8];
#pragma unroll
            for (int c = 0; c < 8; ++c) vw[c] = *(const v4u*)(zr + 928 + h * 64 + 8 * c);
            store_v_tile_f8((char*)(qkv + QO_VD) + ((size_t)(b * 4 + h) * NKT + tt) * 4096, lane, vw, 1.0f, vscr);
        } else if (job < 30) {
            const bool isk = job >= 28; const int h = isk ? job - 28 : job - 20;
            const bf16* zp = zr + (isk ? 1696 : 1184) + h * 64; const float* g = (isk ? a->in[I_GGK] : a->in[I_GGQ]) + l * 64;
            const float qs = isk ? 1.0f : att::FQ64;
            v4u w[8]; float ss = 0.f;
#pragma unroll
            for (int c = 0; c < 8; ++c) { w[c] = *(const v4u*)(zp + 8 * c); ss += ssq8(w[c]); }
            MEMFENCE();
            const float r = rsqrtf(ss * (1.0f / 64.0f) + EPSF);
            char* kt = (char*)(qkv + QO_KG) + ((size_t)(b * 2 + h) * NKT + tt) * 3072;
            unsigned char* q = (unsigned char*)(qkv + QO_QG) + ((size_t)(b * 8 + h) * NTOKB + tok) * 48;
#pragma unroll
            for (int gq = 0; gq < 2; ++gq) { v4u o[4];
#pragma unroll
                for (int cc = 0; cc < 4; ++cc) { const int c = 4 * gq + cc;
                    if (isc) o[cc] = proc8<false>(w[c], r, g + 8 * c, nullptr, qs);
                    else o[cc] = proc8<true>(w[c], r, g + 8 * c, (c < 4) ? tgr + 4 * c : tgc + 4 * (c - 4), qs); }
                const att::i32x6a gr = fp6_group(o[0], o[1], o[2], o[3]);
                if (isk) store_kgroup(kt, 2048, gq, lane, gr); else store_qgroup(q + 24 * gq, gr);
                MEMFENCE(); }
        } else {
            const int h = job - 30; v4u vw[8];
#pragma unroll
            for (int c = 0; c < 8; ++c) vw[c] = *(const v4u*)(zr + 1824 + h * 64 + 8 * c);
            store_v_tile_f8((char*)(qkv + QO_VG) + ((size_t)(b * 2 + h) * NKT + tt) * 4096, lane, vw, 1.0f, vscr);
        }
        MEMFENCE();
    }
}

#define ATT_UNIT(KD, NM) att::attn_unit_f8<KD, NM, ABL>
#define ATT_DIFF att::attn_unit_f8<32, 2, ABL>
template <int ABL>
__device__ __forceinline__ void phase_d(KA a, Frame& F, int l, bool last) {
    relane(F);
    unsigned char* ws = a->ws; unsigned char* qkv = ws + WS_QKV;
    bf16* ATT = (bf16*)(ws + (ABL ? WS_Z : WS_ATT));
    const float* LAM = (const float*)(ws + WS_LAM);
    const float lam = LAM[2 * l], oml = 1.0f - LAM[2 * l + 1];
    const float* gdo = a->in[I_GDO] + l * 64;
    ALDS char* lds = (ALDS char*)F.lds;
    const int nctx = last ? 0 : 64;
    for (int id = F.vcu; id < 512 + nctx; id += F.G) {
        int b, h, q0, t0, t1; size_t orow;
        if (id < 512) { const int x = (id & 255) >> 5; b = x >> 1; h = 2 * (x & 1) + (id >> 8); q0 = (id & 31) * 256; t0 = 0; t1 = NKT; orow = (size_t)b * SEQ + q0; }
        else { const int c = id - 512; b = c >> 4; h = c & 15; if (h >= 4) continue; q0 = SEQ; t0 = 128; t1 = NKT; orow = (size_t)LROWS + b * CL; }
        ATT_UNIT(96, 1)((const unsigned char*)(qkv + QO_QM) + ((size_t)(b * 4 + h) * NTOKB + q0) * 72, (const char*)(qkv + QO_KM) + (size_t)(b * 4 + h) * NKT * 5120,
                        (const char*)(qkv + QO_VM) + (size_t)(b * 4 + h) * NKT * 4096, t0, t1, ATT + orow * 1024 + h * 64, lds, 0.f, gdo, 0.f);
    }
    for (int id = 512 + F.vcu; id < 1024 + nctx; id += F.G) {
        int b, h, q0, t0, t1; size_t orow;
        if (id < 1024) { const int x = (id & 255) >> 5; b = x >> 1; h = 2 * (x & 1) + ((id >> 8) - 2); q0 = (id & 31) * 256; t0 = 0; t1 = NKT; orow = (size_t)b * SEQ + q0; }
        else { const int c = id - 1024; b = c >> 4; h = (c & 15) - 4; if (h < 0 || h >= 4) continue; q0 = SEQ; t0 = 128; t1 = NKT; orow = (size_t)LROWS + b * CL; }
        ATT_DIFF((const unsigned char*)(qkv + QO_QD) + ((size_t)(b * 4 + h) * NTOKB + q0) * 48, (const char*)(qkv + QO_KD) + (size_t)(b * 4 + h) * NKT * 3072,
                        (const char*)(qkv + QO_VD) + (size_t)(b * 4 + h) * NKT * 4096, t0, t1, ATT + orow * 1024 + 256 + h * 64, lds, lam, gdo, oml);
    }
    for (int id = 1024 + F.vcu; id < 2048 + nctx; id += F.G) {
        int b, h, q0, t0, t1; size_t orow;
        if (id < 2048) { const int x = (id & 255) >> 5; b = x >> 1; h = 4 * (x & 1) + ((id >> 8) - 4); q0 = (id & 31) * 256; t0 = 0; t1 = NKT; orow = (size_t)b * SEQ + q0; }
        else { const int c = id - 2048; b = c >> 4; h = (c & 15) - 8; if (h < 0) continue; q0 = SEQ; t0 = 128; t1 = NKT; orow = (size_t)LROWS + b * CL; }
        const int g = h >> 2;
        ATT_UNIT(64, 1)((const unsigned char*)(qkv + QO_QG) + ((size_t)(b * 8 + h) * NTOKB + q0) * 48, (const char*)(qkv + QO_KG) + (size_t)(b * 2 + g) * NKT * 3072,
                        (const char*)(qkv + QO_VG) + (size_t)(b * 2 + g) * NKT * 4096, t0, t1, ATT + orow * 1024 + 512 + h * 64, lds, 0.f, gdo, 0.f);
    }
}

template <int RB>
__device__ __forceinline__ void pf_rows(KA a, Frame& F, int l, int rbeg, int nrows, LAS float* wrT) {
    unsigned char* ws = a->ws;
    const float* MOD = (const float*)(ws + WS_MOD);
    float* AFF = (float*)(ws + WS_AFF); float* AFFC = (float*)(ws + WS_AFFC); int* INV = (int*)(ws + WS_INV);
    const int gw = F.vcu * NWAVES + F.wave, NGW = F.G * NWAVES;
#define PF_LOAD(r, XW, DW) do { const bf16* xb_ = (const bf16*)(ws + WS_XB) + (size_t)(r) * 1024; const bf16* dl_ = (const bf16*)(ws + WS_DELTA) + (size_t)(r) * 1024; \
        _Pragma("unroll") for (int j = 0; j < 4; ++j) { XW[j] = *(const v2u*)(xb_ + 4 * F.lane + 256 * j); DW[j] = *(const v2u*)(dl_ + 4 * F.lane + 256 * j); } } while (0)
    v2u cxw[RB][4], cdw[RB][4];
#pragma unroll
    for (int u = 0; u < RB; ++u)
#pragma unroll
        for (int j = 0; j < 4; ++j) { cxw[u][j] = (v2u){0u, 0u}; cdw[u][j] = (v2u){0u, 0u}; }
    if (rbeg + gw * RB < nrows) {
#pragma unroll
        for (int u = 0; u < RB; ++u) PF_LOAD(rbeg + gw * RB + u, cxw[u], cdw[u]); }
    for (int grp = gw; rbeg + grp * RB < nrows; grp += NGW) {
        const int row0 = rbeg + grp * RB; const bool isc = row0 >= LROWS; const int v = isc ? 4 : (row0 >> 13);
        f32x4 hv[RB][4]; float ss[RB];
#pragma unroll
        for (int u = 0; u < RB; ++u) { bf16* xb = (bf16*)(ws + WS_XB) + (size_t)(row0 + u) * 1024; ss[u] = 0.f;
#pragma unroll
            for (int j = 0; j < 4; ++j) { const int c0 = 4 * F.lane + 256 * j; const v2u w = cdw[u][j], xw = cxw[u][j];
                hv[u][j] = (f32x4){bflo(xw.x), bfhi(xw.x), bflo(xw.y), bfhi(xw.y)} + (f32x4){bflo(w.x), bfhi(w.x), bflo(w.y), bfhi(w.y)};
                v2u o; o.x = pk2(hv[u][j].x, hv[u][j].y); o.y = pk2(hv[u][j].z, hv[u][j].w); *(v2u*)(xb + c0) = o;
                ss[u] += (hv[u][j].x * hv[u][j].x + hv[u][j].y * hv[u][j].y) + (hv[u][j].z * hv[u][j].z + hv[u][j].w * hv[u][j].w); } }
        { const int ngrp = grp + NGW;
          if (rbeg + ngrp * RB < nrows) {
#pragma unroll
              for (int u = 0; u < RB; ++u) PF_LOAD(rbeg + ngrp * RB + u, cxw[u], cdw[u]); } }
        float rstd[RB];
#pragma unroll
        for (int u = 0; u < RB; ++u) rstd[u] = rsqrtf(wave_sum(ss[u]) * (1.0f / 1024.0f) + EPSF);
        const float* g2 = a->in[I_GN2] + l * 1024; const float* sh = MOD + (l * 5 + v) * 6144 + 3 * 1024; const float* sc = sh + 1024;
        float am[RB];
#pragma unroll
        for (int u = 0; u < RB; ++u) am[u] = 0.f;
#pragma unroll
        for (int j = 0; j < 4; ++j) { const int c0 = 4 * F.lane + 256 * j; const f32x4 g = *(const f32x4*)(g2 + c0), s1 = *(const f32x4*)(sc + c0), b1 = *(const f32x4*)(sh + c0);
#pragma unroll
            for (int u = 0; u < RB; ++u) { hv[u][j] = hv[u][j] * rstd[u] * g * (1.0f + s1) + b1;
                am[u] = fmaxf(fmaxf(am[u], fmaxf(fabsf(hv[u][j].x), fabsf(hv[u][j].y))), fmaxf(fabsf(hv[u][j].z), fabsf(hv[u][j].w))); } }
#pragma unroll
        for (int o = 1; o < 64; o <<= 1) {
#pragma unroll
            for (int u = 0; u < RB; ++u) am[u] = fmaxf(am[u], __shfl_xor(am[u], o)); }
#pragma unroll
        for (int u = 0; u < RB; ++u) { const float qs = am[u] > 0.f ? 127.0f / am[u] : 0.f;
            signed char* h8 = (signed char*)(ws + WS_H) + (size_t)(row0 + u) * 1024;
#pragma unroll
            for (int j = 0; j < 4; ++j) { const int q0 = (int)__builtin_rintf(hv[u][j].x * qs), q1 = (int)__builtin_rintf(hv[u][j].y * qs), q2 = (int)__builtin_rintf(hv[u][j].z * qs), q3 = (int)__builtin_rintf(hv[u][j].w * qs);
                *(unsigned*)(h8 + 4 * F.lane + 256 * j) = (unsigned)(q0 & 255) | ((unsigned)(q1 & 255) << 8) | ((unsigned)(q2 & 255) << 16) | ((unsigned)(q3 & 255) << 24); }
            if (F.lane == 0) ((float*)(ws + WS_SA))[row0 + u] = am[u] * (1.0f / 127.0f); }
        float p[RB][16];
#pragma unroll
        for (int e = 0; e < 16; ++e) { float sacc[RB];
#pragma unroll
            for (int u = 0; u < RB; ++u) sacc[u] = 0.f;
#pragma unroll
            for (int j = 0; j < 4; ++j) { const f32x4 w = *(const LAS f32x4*)(wrT + e * 1024 + 4 * F.lane + 256 * j);
#pragma unroll
                for (int u = 0; u < RB; ++u) sacc[u] += (hv[u][j].x * w.x + hv[u][j].y * w.y) + (hv[u][j].z * w.z + hv[u][j].w * w.w); }
#pragma unroll
            for (int u = 0; u < RB; ++u) p[u][e] = sacc[u];
            if ((e & 3) == 3) MEMFENCE(); }
        float lgt[RB];
#pragma unroll
        for (int u = 0; u < RB; ++u) { float r8[8], r4[4], r2[2];
          { const bool hb = (F.lane & 32) != 0;
#pragma unroll
            for (int j = 0; j < 8; ++j) { const float keep = hb ? p[u][8 + j] : p[u][j], send = hb ? p[u][j] : p[u][8 + j]; r8[j] = keep + __shfl_xor(send, 32); } }
          { const bool hb = (F.lane & 16) != 0;
#pragma unroll
            for (int j = 0; j < 4; ++j) { const float keep = hb ? r8[4 + j] : r8[j], send = hb ? r8[j] : r8[4 + j]; r4[j] = keep + __shfl_xor(send, 16); } }
          { const bool hb = (F.lane & 8) != 0;
#pragma unroll
            for (int j = 0; j < 2; ++j) { const float keep = hb ? r4[2 + j] : r4[j], send = hb ? r4[j] : r4[2 + j]; r2[j] = keep + __shfl_xor(send, 8); } }
          { const bool hb = (F.lane & 4) != 0; const float keep = hb ? r2[1] : r2[0], send = hb ? r2[0] : r2[1]; lgt[u] = keep + __shfl_xor(send, 4); }
          lgt[u] += __shfl_xor(lgt[u], 1); lgt[u] += __shfl_xor(lgt[u], 2); }
        float mx[RB], ex[RB], sum[RB];
#pragma unroll
        for (int u = 0; u < RB; ++u) mx[u] = lgt[u];
#pragma unroll
        for (int o = 4; o < 64; o <<= 1) {
#pragma unroll
            for (int u = 0; u < RB; ++u) mx[u] = fmaxf(mx[u], __shfl_xor(mx[u], o)); }
#pragma unroll
        for (int u = 0; u < RB; ++u) { ex[u] = __builtin_amdgcn_exp2f((lgt[u] - mx[u]) * LOG2E); sum[u] = ex[u]; }
#pragma unroll
        for (int o = 4; o < 64; o <<= 1) {
#pragma unroll
            for (int u = 0; u < RB; ++u) sum[u] += __shfl_xor(sum[u], o); }
        const int ee = ((F.lane >> 5) & 1) * 8 + ((F.lane >> 4) & 1) * 4 + ((F.lane >> 3) & 1) * 2 + ((F.lane >> 2) & 1);
#pragma unroll
        for (int u = 0; u < RB; ++u) { const float mine = ex[u] / sum[u]; const int row = row0 + u;
            if ((F.lane & 3) == 0) {
                if (isc) { const int r = row - LROWS; AFFC[((size_t)((r >> 8) * 16 + ee)) * CL + (r & 255)] = mine; }
                else AFF[((size_t)((row >> 13) * 16 + ee)) * SEQ + (row & 8191)] = mine;
                INV[(size_t)row * 16 + ee] = -1;
            } }
    }
#undef PF_LOAD
}


__device__ __forceinline__ void phase_f(KA a, Frame& F, int l, bool last) {
    relane(F);
    unsigned char* ws = a->ws;
    const float* MOD = (const float*)(ws + WS_MOD);
    float* AFF = (float*)(ws + WS_AFF); float* AFFC = (float*)(ws + WS_AFFC); int* INV = (int*)(ws + WS_INV);
    LAS float* wrT = (LAS float*)F.lds;
    const float* wr = a->in[I_WR] + (size_t)l * 1024 * 16;
    for (int idx = F.tid; idx < 16384; idx += NWAVES * 64) wrT[(idx & 15) * 1024 + (idx >> 4)] = wr[idx];
    __syncthreads();
    pf_rows<4>(a, F, l, 0, LROWS, wrT);
    if (!last) pf_rows<1>(a, F, l, LROWS, MROWS, wrT);
}

__device__ __forceinline__ void topk_set(Frame& F, const float* __restrict__ src, int n, int k, int rowbase, int slotbase, int e, int* IDX, float* GATE, int* INV, const float* SA, float* SAE) {
    LAS unsigned* keys = (LAS unsigned*)F.lds; LAS unsigned* hist = keys + 8192; LAS unsigned* sc = hist + 256;
    const int tid = F.tid;
    for (int i = tid; i < n; i += NWAVES * 64) keys[i] = __float_as_uint(src[i]);
    if (tid == 0) { unsigned z_ = 0u, k_ = (unsigned)k; asm volatile("" : "+v"(z_), "+v"(k_)); sc[0] = z_; sc[1] = k_; }
    __syncthreads();
    for (int pass = 0; pass < 4; ++pass) {
        const int shift = 24 - 8 * pass; const unsigned mask = (pass == 0) ? 0u : (0xFFFFFFFFu << (shift + 8));
        if (tid < 256) hist[tid] = 0u;
        __syncthreads();
        const unsigned prefix = sc[0];
        for (int i = tid; i < n; i += NWAVES * 64) { const unsigned kv = keys[i]; if ((kv & mask) == prefix) __hip_atomic_fetch_add(&hist[(kv >> shift) & 255u], 1u, __ATOMIC_RELAXED, __HIP_MEMORY_SCOPE_WORKGROUP); }
        __syncthreads();
        if (F.wave == 0) {
            const unsigned need = sc[1]; unsigned h[4]; unsigned tot = 0u;
#pragma unroll
            for (int j = 0; j < 4; ++j) { h[j] = hist[255 - (4 * F.lane + j)]; tot += h[j]; }
            unsigned incl = tot;
#pragma unroll
            for (int d = 1; d < 64; d <<= 1) { const unsigned t = __shfl_up(incl, d); if (F.lane >= d) incl += t; }
            unsigned cum = incl - tot;
#pragma unroll
            for (int j = 0; j < 4; ++j) { if (cum < need && need <= cum + h[j]) { sc[0] = prefix | ((unsigned)(255 - (4 * F.lane + j)) << shift); sc[1] = need - cum; } cum += h[j]; }
        }
        __syncthreads();
    }
    const unsigned T = sc[0], need_eq = sc[1];
    const int per = (n + NWAVES * 64 - 1) / (NWAVES * 64), start = tid * per;
    unsigned cg = 0u, ce = 0u;
    for (int j = 0; j < per; ++j) { const int i = start + j; if (i < n) { const unsigned kv = keys[i]; cg += (kv > T) ? 1u : 0u; ce += (kv == T) ? 1u : 0u; } }
    const unsigned packed = cg | (ce << 16);
    unsigned incl = packed;
#pragma unroll
    for (int d = 1; d < 64; d <<= 1) { const unsigned t = __shfl_up(incl, d); if (F.lane >= d) incl += t; }
    if (F.lane == 63) sc[8 + F.wave] = incl;
    __syncthreads();
    unsigned base = 0u;
    for (int w = 0; w < F.wave; ++w) base += sc[8 + w];
    const unsigned excl = base + incl - packed;
    unsigned gb = excl & 0xFFFFu, eb = excl >> 16;
    for (int j = 0; j < per; ++j) { const int i = start + j; if (i < n) { const unsigned kv = keys[i]; const bool g = kv > T, q = kv == T;
        if (g || (q && eb < need_eq)) { const int slot = slotbase + (int)(gb + (eb < need_eq ? eb : need_eq)); IDX[slot] = rowbase + i; GATE[slot] = __uint_as_float(kv); SAE[slot] = SA[rowbase + i]; INV[(size_t)(rowbase + i) * 16 + e] = slot; }
        gb += g ? 1u : 0u; eb += q ? 1u : 0u; } }
    __syncthreads();
}
struct CvtItem { const float* wp; int N; unsigned char* wt; int ldt; float qs; int f8; };
__device__ __forceinline__ void cvt_load(const CvtItem& I, float (&tv)[32]) {
#pragma unroll
    for (int i = 0; i < 32; ++i) tv[i] = __builtin_nontemporal_load(I.wp + (size_t)(2 * i) * I.N);
}
__device__ __forceinline__ void cvt_store(const CvtItem& I, const float (&tv)[32], LAS float* scr, int lane) {
#pragma unroll
    for (int i = 0; i < 32; ++i) scr[(2 * i + (lane >> 5)) * 33 + (lane & 31)] = tv[i];
    LDS_WAIT(); asm volatile("" ::: "memory");
    const int c = lane & 3;
#pragma unroll
    for (int j = 0; j < 2; ++j) { const int n = (lane >> 2) + 16 * j; const LAS float* sp = scr + (16 * c) * 33 + n; v4u o;
        if (I.f8) {
#pragma unroll
            for (int d = 0; d < 4; ++d) { float f[4];
#pragma unroll
                for (int i = 0; i < 4; ++i) f[i] = fminf(fmaxf(sp[(4 * d + i) * 33] * I.qs, -448.0f), 448.0f);
                int w = __builtin_amdgcn_cvt_pk_fp8_f32(f[0], f[1], 0, false); w = __builtin_amdgcn_cvt_pk_fp8_f32(f[2], f[3], w, true); o[d] = (unsigned)w; }
        } else {
#pragma unroll
            for (int d = 0; d < 4; ++d) { unsigned w = 0u;
#pragma unroll
                for (int i = 0; i < 4; ++i) { const float f = fminf(fmaxf(sp[(4 * d + i) * 33] * I.qs, -127.0f), 127.0f); w |= ((unsigned)((int)__builtin_rintf(f)) & 255u) << (8 * i); }
                o[d] = w; }
        }
        *(v4u*)(I.wt + (size_t)n * I.ldt + 16 * c) = o; }
    LDS_WAIT(); asm volatile("" ::: "memory");
}
__device__ __forceinline__ void phase_g(KA a, Frame& F, int l, bool last, int rep) {
    relane(F);
    unsigned char* ws = a->ws;
    const float* AFF = (const float*)(ws + WS_AFF); const float* AFFC = (const float*)(ws + WS_AFFC);
    int* IDX = (int*)(ws + WS_IDX); float* GATE = (float*)(ws + WS_GATE); int* INV = (int*)(ws + WS_INV);
    const float* SA = (const float*)(ws + WS_SA); float* SAE = (float*)(ws + WS_SAE);
    const int RPE = last ? 4096 : 4352, nsets = last ? 64 : 128;
    for (int set = blockIdx.x; set < nsets; set += F.G) {
        if (set < 64) { const int b = set >> 4, e = set & 15; topk_set(F, AFF + (size_t)set * SEQ, SEQ, CAPL, b * SEQ, e * RPE + b * CAPL, e, IDX, GATE, INV, SA, SAE); }
        else { const int s2 = set - 64, b = s2 >> 4, e = s2 & 15; topk_set(F, AFFC + (size_t)s2 * CL, CL, CAPC, LROWS + b * CL, e * RPE + 4096 + b * CAPC, e, IDX, GATE, INV, SA, SAE);
            if (b == 0 && F.tid < 128) { IDX[e * RPE + 4224 + F.tid] = -1; GATE[e * RPE + 4224 + F.tid] = 0.f; SAE[e * RPE + 4224 + F.tid] = 0.f; } }
    }
    {
        LAS float* scr = (LAS float*)(F.lds + 40960 + F.wave * 8704);
        gu32* head = F.ctl + CW_Q + 64 * l + 128 * rep;
        constexpr int NIT = NE * 3072;
        const float* wg = a->in[I_WG] + (size_t)l * NE * 1024 * 2048; const float* wu = a->in[I_WU] + (size_t)l * NE * 1024 * 2048; const float* wd = a->in[I_WD] + (size_t)l * NE * 2048 * 1024;
        const float* SWL = (const float*)(ws + WS_SW) + l * 48;
        for (;;) {
            unsigned basev = 0u;
            if (F.lane == 0) basev = __hip_atomic_fetch_add(head, 8u, RLX_AGENT);
            const int base = __builtin_amdgcn_readfirstlane((int)basev);
            if (base >= NIT) break;
#define CVT_SETUP(I, j) do { const int it_ = base + (j); const int e_ = it_ / 3072, r_ = it_ % 3072, which_ = r_ >> 10, ii_ = r_ & 1023; \
                if (which_ < 2) { const int kb_ = ii_ >> 6, n0_ = (ii_ & 63) * 32; const int rowbase_ = (n0_ >> 7) * 256 + (n0_ & 127) + which_ * 128; \
                    I.wp = (which_ ? wu : wg) + (size_t)e_ * 1024 * 2048 + (size_t)(kb_ * 64 + (F.lane >> 5)) * 2048 + n0_ + (F.lane & 31); I.N = 2048; \
                    I.wt = (unsigned char*)(ws + WS_WGU) + (size_t)e_ * 4096 * 1024 + (size_t)rowbase_ * 1024 + kb_ * 64; I.ldt = 1024; I.qs = 1.0f / SWL[3 * e_ + which_]; I.f8 = 0; } \
                else { const int kb_ = ii_ >> 5, n0_ = (ii_ & 31) * 32; \
                    I.wp = wd + (size_t)e_ * 2048 * 1024 + (size_t)(kb_ * 64 + (F.lane >> 5)) * 1024 + n0_ + (F.lane & 31); I.N = 1024; \
                    I.wt = (unsigned char*)(ws + WS_WD) + (size_t)e_ * 1024 * 2048 + (size_t)n0_ * 2048 + kb_ * 64; I.ldt = 2048; I.qs = 1.0f / SWL[3 * e_ + 2]; I.f8 = 1; } } while (0)
            CvtItem IA, IB; float tvA[32], tvB[32];
            CVT_SETUP(IA, 0); cvt_load(IA, tvA);
#pragma unroll
            for (int jj = 0; jj < 4; ++jj) {
                CVT_SETUP(IB, 2 * jj + 1); cvt_load(IB, tvB);
                cvt_store(IA, tvA, scr, F.lane);
                if (jj < 3) { CVT_SETUP(IA, 2 * jj + 2); cvt_load(IA, tvA); }
                cvt_store(IB, tvB, scr, F.lane);
            }
#undef CVT_SETUP
        }
    }
}

__device__ __forceinline__ void phase_h(KA a, Frame& F, bool last) {
    relane(F);
    unsigned char* ws = a->ws;
    const int* IDX = (const int*)(ws + WS_IDX); const unsigned char* H8 = (const unsigned char*)(ws + WS_H); unsigned char* XE = (unsigned char*)(ws + WS_XE);
    const float* SA = (const float*)(ws + WS_SA); float* SAE = (float*)(ws + WS_SAE);
    const int nrow = NE * (last ? 4096 : 4352);
    const int gw = F.vcu * NWAVES + F.wave, NGW = F.G * NWAVES;
    for (int r = gw; r < nrow; r += NGW) {
        const int s = __builtin_amdgcn_readfirstlane(IDX[r]);
        v4u v0 = (v4u){0u, 0u, 0u, 0u}; float sc = 0.f;
        if (s >= 0) { v0 = ((const v4u*)(H8 + (size_t)s * 1024))[F.lane]; sc = SA[s]; }
        ((v4u*)(XE + (size_t)r * 1024))[F.lane] = v0;
        if (F.lane == 0) SAE[r] = sc;
    }
}
__global__ void __launch_bounds__(NWAVES * 64, 2) mk_fwd(Args args) {
    extern __shared__ __attribute__((aligned(16))) unsigned char lds[];
    Frame F;
    F.lds = (LAS unsigned char*)lds;
    F.MISC = (volatile LAS unsigned*)(F.lds + MISC_OFF);
    F.tid = threadIdx.x; F.lane = F.tid & 63; F.wave = __builtin_amdgcn_readfirstlane(F.tid >> 6);
    F.G = gridDim.x; { const int bx = blockIdx.x; F.vcu = (F.G % 8 == 0) ? (bx % 8) * (F.G / 8) + bx / 8 : bx; }
    F.ctl = (gu32*)(args.ws + WS_CTL);
    for (int u = F.tid; u < (LDS_BYTES - LDSCTL_OFF) / 4; u += NWAVES * 64) ((LAS unsigned*)(F.lds + LDSCTL_OFF))[u] = 0u;
    __syncthreads();
    const int lo = args.ph_lo, hi = args.ph_hi;
    const bool multi = (hi - lo) > 1;
    XcdBarrier bar; bar.bar = (unsigned*)(F.ctl + CW_BAR); bar.x = 0; bar.st = nullptr;
    if (multi) bar = xcd_barrier_post((unsigned*)(F.ctl + CW_BAR), F.MISC + 8);
#define IN(k) (lo <= (k) && (k) < hi)
#define SEAM(k) do { if (IN((k) + 1)) xcd_barrier(bar); } while (0)
#define REP(kind) (((MK_REP) >> (kind)) & 1)
#define RUNPH(kind, k, ...) do { if (IN(k)) { for (int rep_ = 0; rep_ <= REP(kind); ++rep_) { __VA_ARGS__; if (rep_ < REP(kind)) xcd_barrier(bar); } SEAM(k); } } while (0)

    RUNPH(0, 0, p0_prologue(kargs(), F));

    for (int l = 0; l < NLAYER; ++l) {
        const bool last = (l == NLAYER - 1);
        const int pb = 1 + 10 * l;
        const int RPE = last ? 4096 : 4352;
        if (IN(pb + 0)) { for (int rep_ = 0; rep_ <= (l == 0 ? REP(1) : 0); ++rep_) { phase_a(kargs(), F, l); if (rep_ < REP(1) && l == 0) xcd_barrier(bar); } SEAM(pb + 0); }
        if (IN(pb + 1)) { for (int rep_ = 0; rep_ <= REP(2); ++rep_) {
            KA ka = kargs(); unsigned char* ws = ka->ws;
            pg8::Gemm g{(const pg8::bf16_t*)(ws + WS_H), (const pg8::bf16_t*)(ws + WS_WCAT8 + (size_t)l * ZP * 1024), MROWS, ZP, DM / 2, 1 << 30, 0};
            pg8::StaticOrder S; S.init(MROWS, ZP, F.G, (int)blockIdx.x);
            pg8::EpiStoreBf16I8 E{(pg8::bf16_t*)(ws + WS_Z), ZP, (const float*)(ws + WS_SA), (const float*)(ws + WS_SWC) + (size_t)l * ZP, (float*)(ws + WS_SSQ)};
            pg8::gemm_phase<pg8::EpiStoreBf16I8, pg8::StaticOrder, true, true, 1>(F.lds, g, S, E);
            if (rep_ < REP(2)) xcd_barrier(bar); }
            SEAM(pb + 1);
        }
        RUNPH(3, pb + 2, phase_c(kargs(), F, l));
        RUNPH(4, pb + 3, phase_d<0>(kargs(), F, l, last); if (MK_ABL) { xcd_barrier(bar); phase_d<MK_ABL>(kargs(), F, l, last); });
        if (IN(pb + 4)) { for (int rep_ = 0; rep_ <= REP(5); ++rep_) {
            KA ka = kargs(); unsigned char* ws = ka->ws; const float* MODL = (const float*)(ws + WS_MOD) + (size_t)l * 5 * 6144;
            const int M = last ? LROWS : MROWS;
            pg8::Gemm g{(const pg8::bf16_t*)(ws + WS_ATT), (const pg8::bf16_t*)(ws + WS_WO) + (size_t)l * 1024 * 1024, M, DM, DM, 1 << 30, 0};
            pg8::StaticOrder S; S.init(M, DM, F.G, (int)blockIdx.x);
            pg8::EpiColGateBf16 E{(pg8::bf16_t*)(ws + WS_DELTA), DM, MODL, LROWS};
            pg8::gemm_phase<pg8::EpiColGateBf16, pg8::StaticOrder, true, true>(F.lds, g, S, E);
            if (rep_ < REP(5)) xcd_barrier(bar); }
            SEAM(pb + 4);
        }
        RUNPH(6, pb + 5, phase_f(kargs(), F, l, last));
        RUNPH(7, pb + 6, phase_g(kargs(), F, l, last, rep_));
        if (IN(pb + 8)) { for (int rep_ = 0; rep_ <= REP(9); ++rep_) {
            KA ka = kargs(); unsigned char* ws = ka->ws;
            pg8::Gemm g{(const pg8::bf16_t*)(ws + WS_H), (const pg8::bf16_t*)(ws + WS_WGU), NE * RPE, 2 * FFD, DM / 2, RPE / 256, (size_t)2 * FFD * DM, (const int*)(ws + WS_IDX)};
            pg8::StaticOrder S; S.init(NE * RPE, 2 * FFD, F.G, (int)blockIdx.x);
            pg8::EpiSwiGLUI8 E{(unsigned char*)(ws + WS_HID), FFD, (const float*)(ws + WS_SAE), (const float*)(ws + WS_SW) + l * 48, RPE / 256, HID_SCALE};
            if (MK_NOEPI && rep_ == 1) { pg8::EpiNullI8 EN{}; pg8::gemm_phase<pg8::EpiNullI8, pg8::StaticOrder, true, true, 1, true>(F.lds, g, S, EN); }
            else pg8::gemm_phase<pg8::EpiSwiGLUI8, pg8::StaticOrder, true, true, 1, true>(F.lds, g, S, E);
            if (rep_ < REP(9)) xcd_barrier(bar); }
            SEAM(pb + 8);
        }
        if (IN(pb + 9)) { for (int rep_ = 0; rep_ <= REP(10); ++rep_) {
            KA ka = kargs(); unsigned char* ws = ka->ws;
            pg8::Gemm g{(const pg8::bf16_t*)(ws + WS_HID), (const pg8::bf16_t*)(ws + WS_WD), NE * RPE, DM, FFD / 2, RPE / 256, (size_t)DM * FFD};
            pg8::StaticOrder S; S.init(NE * RPE, DM, F.G, (int)blockIdx.x);
            pg8::EpiRowScaleBf16 E{(pg8::bf16_t*)(ws + WS_YE), DM, (const float*)(ws + WS_GATE), (const float*)(ws + WS_SW) + l * 48, RPE / 256, 1.0f / HID_SCALE};
            pg8::gemm_phase<pg8::EpiRowScaleBf16, pg8::StaticOrder, true, true, 2>(F.lds, g, S, E);
            if (rep_ < REP(10)) xcd_barrier(bar); }
            SEAM(pb + 9);
        }
    }
    if (IN(N_PHASES - 1)) phase_a(kargs(), F, NLAYER);
#undef IN
#undef SEAM
}

extern "C" void kernel_launch(void* const* d_in, const int* in_sizes, int n_in, void* d_out, int out_size, void* d_ws, size_t ws_size, hipStream_t stream) {
    static int grid = 0;
    if (grid == 0) {
        if (n_in != N_IN || out_size != LROWS * DM || ws_size < WS_END) { fprintf(stderr, "kernel_launch: unexpected shapes (n_in %d, out %d, ws %zu); nothing launched\n", n_in, out_size, ws_size); grid = -1; return; }
        int dev = 0, cus = 0, per_cu = 0;
        if (hipGetDevice(&dev) != hipSuccess || hipDeviceGetAttribute(&cus, hipDeviceAttributeMultiprocessorCount, dev) != hipSuccess) { grid = -1; return; }
        if (hipFuncSetAttribute((const void*)mk_fwd, hipFuncAttributeMaxDynamicSharedMemorySize, LDS_BYTES) != hipSuccess) { fprintf(stderr, "kernel_launch: hipFuncSetAttribute failed\n"); grid = -1; return; }
        if (hipOccupancyMaxActiveBlocksPerMultiprocessor(&per_cu, (const void*)mk_fwd, NWAVES * 64, LDS_BYTES) != hipSuccess || per_cu < 1) { fprintf(stderr, "kernel_launch: occupancy query reports %d blocks per CU\n", per_cu); }
        (void)hipGetLastError();
        if (cus < 256) { fprintf(stderr, "kernel_launch: %d compute units; the per-workgroup LDS row tables of the GEMM phases are sized for a grid of at least 256 workgroups; nothing launched\n", cus); grid = -1; return; }
        grid = cus;
    }
    if (grid < 0) return;
    if (hipMemsetAsync((char*)d_ws + WS_CTL, 0, CTL_ZERO_BYTES, stream) != hipSuccess) { fprintf(stderr, "kernel_launch: memset failed\n"); return; }
    Args a{};
    for (int i = 0; i < N_IN; ++i) a.in[i] = (const float*)d_in[i];
    a.out = (float*)d_out; a.ws = (unsigned char*)d_ws;
#if MK_SPLIT
    for (int ph = 0; ph < N_PHASES; ++ph) { a.ph_lo = ph; a.ph_hi = ph + 1; hipLaunchKernelGGL(mk_fwd, dim3(grid), dim3(NWAVES * 64), LDS_BYTES, stream, a); }
#else
    a.ph_lo = 0; a.ph_hi = N_PHASES;
    hipLaunchKernelGGL(mk_fwd, dim3(grid), dim3(NWAVES * 64), LDS_BYTES, stream, a);
#endif
    const hipError_t le = hipPeekAtLastError();
    if (le != hipSuccess) fprintf(stderr, "kernel_launch: launch failed: %s\n", hipGetErrorName(le));
}
```

```cpp
#include <hip/hip_runtime.h>
#include <hip/hip_bf16.h>
#include <cstdio>
#include <cstdint>
#ifndef MK_SPLIT
#define MK_SPLIT 0
#endif
#ifndef MK_REP
#define MK_REP 0
#endif
#ifndef MK_NOEPI
#define MK_NOEPI 0
#endif
#ifndef MK_ABL
#define MK_ABL 0
#endif
namespace pg8 {
#define PG8_LAS __attribute__((address_space(3)))
typedef unsigned short bf16_t;
typedef short bf16x8 __attribute__((ext_vector_type(8)));
typedef float f32x4 __attribute__((ext_vector_type(4)));
typedef unsigned u32x4 __attribute__((ext_vector_type(4)));
constexpr int BM = 256, BK = 64, HALF = 128, HTB = HALF * BK * 2  , STAGE_BYTES = 8 * HTB, NXCD = 8, WGM = 8;

__host__ __device__ __forceinline__ int lds_byte(int r, int c) { const int st = (r >> 4) * 2 + (c >> 5), rr = r & 15, cc = c & 31, ob = rr * 64 + cc * 2; return st * 1024 + (ob ^ (((ob >> 9) & 1) << 5)); }
__host__ __device__ __forceinline__ void stage_rc(int b, int& R, int& C) { const int st = b / 1024, sb = b % 1024, swz = sb ^ (((sb >> 9) & 1) << 5); R = (st >> 1) * 16 + swz / 64; C = (st & 1) * 32 + (swz % 64) / 2; }
__host__ __device__ __forceinline__ int perm32(int rho) { const int n = rho >> 4, i = rho & 15; return 8 * (i >> 2) + 4 * n + (i & 3); }

struct Unit { int pm, pn, li; };
struct Gemm { const bf16_t* A; const bf16_t* Bt; int M, N, K; int tpe; size_t bgs; const int* gidx = nullptr; };

struct StaticOrder {
    int nM, nN, nwg, G, c;
    __host__ __device__ void init(int M, int N, int G_, int c_) { nM = M / BM; nN = N / BM; nwg = nM * nN; G = G_; c = c_; }
    __host__ __device__ bool next(int i, Unit& u) const {
        const long L = (long)i * G + c; if (L >= nwg) return false;
        int wgid = (int)L; { const int q = nwg / NXCD, r = nwg % NXCD, xcd = wgid % NXCD, off = wgid / NXCD; wgid = (xcd < r ? xcd * (q + 1) : r * (q + 1) + (xcd - r) * q) + off; }
        const int nig = WGM * nN, gid = wgid / nig, fm = gid * WGM, gsz = (nM - fm) < WGM ? (nM - fm) : WGM;
        u.pm = fm + ((wgid % nig) % gsz); u.pn = (wgid % nig) / gsz; u.li = i; return true;
    }
    __device__ __forceinline__ void a_ready(const Unit&) const {}
    __device__ __forceinline__ void done(const Unit&) const {}
};
typedef int i32x4 __attribute__((ext_vector_type(4)));
__device__ __forceinline__ unsigned cvt_pk_bf16(float lo, float hi) { unsigned r; asm volatile("v_cvt_pk_bf16_f32 %0, %1, %2" : "=v"(r) : "v"(lo), "v"(hi)); return r; }
constexpr int GTAB_OFF = STAGE_BYTES + 2048, RTAB_OFF = GTAB_OFF + 17 * BM * 2, TAB_UNITS = 17;
template <class Sched> __device__ __forceinline__ void fill_rtab(PG8_LAS unsigned char* lds, const Sched& S, const float* rowv, int tid) {
    PG8_LAS float* rt = (PG8_LAS float*)(lds + RTAB_OFF); Unit uu;
    for (int i = 0; i < TAB_UNITS && S.next(i, uu); ++i) { if (tid < BM) rt[i * BM + tid] = rowv[uu.pm * BM + tid]; } }
struct EpiStoreBf16 {
    static constexpr bool PERM = true, AFTER_DRAIN = false;
    bf16_t* O; int ldc;
    template <class Sched> __device__ __forceinline__ void prefill(PG8_LAS unsigned char*, const Sched&, int) const {}
    __device__ __forceinline__ void operator()(const f32x4 (&acc)[2][2][4][2], const Unit& u, int wr, int wc, int fr, int fq, PG8_LAS unsigned char* lds) const {
        const int row0 = u.pm * BM + wr * 64 + fr, col0 = u.pn * BM + wc * 32 + 8 * fq;
#pragma unroll
        for (int ai = 0; ai < 2; ++ai)
#pragma unroll
            for (int m = 0; m < 4; ++m) { bf16_t* rowp = O + (size_t)(row0 + ai * HALF + m * 16) * ldc + col0;
#pragma unroll
                for (int bj = 0; bj < 2; ++bj) { const f32x4 v0 = acc[ai][bj][m][0], v1 = acc[ai][bj][m][1];
                    u32x4 w; w.x = cvt_pk_bf16(v0[0], v0[1]); w.y = cvt_pk_bf16(v0[2], v0[3]); w.z = cvt_pk_bf16(v1[0], v1[1]); w.w = cvt_pk_bf16(v1[2], v1[3]);
                    *(u32x4*)(rowp + bj * HALF) = w; } }
    }
};
struct EpiStoreBf16I8 {
    static constexpr bool PERM = true, AFTER_DRAIN = false;
    bf16_t* O; int ldc; const float* sa; const float* sw; float* ssq;
    template <class Sched> __device__ __forceinline__ void prefill(PG8_LAS unsigned char* lds, const Sched& S, int tid) const { fill_rtab(lds, S, sa, tid); }
    __device__ __forceinline__ void operator()(const i32x4 (&acc)[2][2][4][2], const Unit& u, int wr, int wc, int fr, int fq, PG8_LAS unsigned char* lds) const {
        const int row0 = u.pm * BM + wr * 64 + fr, col0 = u.pn * BM + wc * 32 + 8 * fq;
        f32x4 cs[2][2];
#pragma unroll
        for (int bj = 0; bj < 2; ++bj)
#pragma unroll
            for (int n = 0; n < 2; ++n) cs[bj][n] = *(const f32x4*)(sw + col0 + bj * HALF + 4 * n);
#pragma unroll
        for (int ai = 0; ai < 2; ++ai)
#pragma unroll
            for (int m = 0; m < 4; ++m) { const int row = row0 + ai * HALF + m * 16; const float rs = ((const PG8_LAS float*)(lds + RTAB_OFF))[u.li * BM + (row - u.pm * BM)]; bf16_t* rowp = O + (size_t)row * ldc + col0;
#pragma unroll
                for (int bj = 0; bj < 2; ++bj) { const i32x4 a0 = acc[ai][bj][m][0], a1 = acc[ai][bj][m][1]; const f32x4 c0 = cs[bj][0] * rs, c1 = cs[bj][1] * rs;
                    const float z0 = (float)a0[0] * c0[0], z1 = (float)a0[1] * c0[1], z2 = (float)a0[2] * c0[2], z3 = (float)a0[3] * c0[3];
                    const float z4 = (float)a1[0] * c1[0], z5 = (float)a1[1] * c1[1], z6 = (float)a1[2] * c1[2], z7 = (float)a1[3] * c1[3];
                    u32x4 w; w.x = cvt_pk_bf16(z0, z1); w.y = cvt_pk_bf16(z2, z3); w.z = cvt_pk_bf16(z4, z5); w.w = cvt_pk_bf16(z6, z7);
                    *(u32x4*)(rowp + bj * HALF) = w;
                    if (u.pn == 0 || (u.pn == 1 && bj == 0)) {
                        float q = ((z0 * z0 + z1 * z1) + (z2 * z2 + z3 * z3)) + ((z4 * z4 + z5 * z5) + (z6 * z6 + z7 * z7));
                        q += __shfl_xor(q, 16); q += __shfl_xor(q, 32);
                        if (fq == 0) ssq[(size_t)row * 12 + (u.pn == 0 ? bj * 4 + wc : 8 + wc)] = q; } } }
    }
};
struct EpiColGateBf16 {
    static constexpr bool PERM = true, AFTER_DRAIN = false;
    bf16_t* O; int ldc; const float* mod; int lrows;
    template <class Sched> __device__ __forceinline__ void prefill(PG8_LAS unsigned char*, const Sched&, int) const {}
    __device__ __forceinline__ void operator()(const f32x4 (&acc)[2][2][4][2], const Unit& u, int wr, int wc, int fr, int fq, PG8_LAS unsigned char* lds) const {
        const int R0 = u.pm * BM; const int v = (R0 >= lrows) ? 4 : (R0 >> 13);
        const float* ga = mod + v * 6144 + 2 * 1024;
        const int row0 = R0 + wr * 64 + fr, col0 = u.pn * BM + wc * 32 + 8 * fq;
        f32x4 g[2][2];
#pragma unroll
        for (int bj = 0; bj < 2; ++bj)
#pragma unroll
            for (int n = 0; n < 2; ++n) g[bj][n] = *(const f32x4*)(ga + col0 + bj * HALF + 4 * n);
#pragma unroll
        for (int ai = 0; ai < 2; ++ai)
#pragma unroll
            for (int m = 0; m < 4; ++m) { bf16_t* rowp = O + (size_t)(row0 + ai * HALF + m * 16) * ldc + col0;
#pragma unroll
                for (int bj = 0; bj < 2; ++bj) { const f32x4 v0 = acc[ai][bj][m][0] * g[bj][0], v1 = acc[ai][bj][m][1] * g[bj][1];
                    u32x4 w; w.x = cvt_pk_bf16(v0[0], v0[1]); w.y = cvt_pk_bf16(v0[2], v0[3]); w.z = cvt_pk_bf16(v1[0], v1[1]); w.w = cvt_pk_bf16(v1[2], v1[3]);
                    *(u32x4*)(rowp + bj * HALF) = w; } }
    }
};
__device__ __forceinline__ float silu_mul(float g, float u) { return g * __builtin_amdgcn_rcpf(1.0f + __builtin_amdgcn_exp2f(-1.4426950408889634f * g)) * u; }
struct EpiSwiGLU {
    static constexpr bool PERM = true, AFTER_DRAIN = false;
    bf16_t* O; int ldc;
    template <class Sched> __device__ __forceinline__ void prefill(PG8_LAS unsigned char*, const Sched&, int) const {}
    __device__ __forceinline__ void operator()(const f32x4 (&acc)[2][2][4][2], const Unit& u, int wr, int wc, int fr, int fq, PG8_LAS unsigned char* lds) const {
        const int row0 = u.pm * BM + wr * 64 + fr, col0 = u.pn * HALF + wc * 32 + 8 * fq;
#pragma unroll
        for (int ai = 0; ai < 2; ++ai)
#pragma unroll
            for (int m = 0; m < 4; ++m) { const f32x4 g0 = acc[ai][0][m][0], g1 = acc[ai][0][m][1], u0 = acc[ai][1][m][0], u1 = acc[ai][1][m][1];
                u32x4 w; w.x = cvt_pk_bf16(silu_mul(g0[0], u0[0]), silu_mul(g0[1], u0[1])); w.y = cvt_pk_bf16(silu_mul(g0[2], u0[2]), silu_mul(g0[3], u0[3]));
                w.z = cvt_pk_bf16(silu_mul(g1[0], u1[0]), silu_mul(g1[1], u1[1])); w.w = cvt_pk_bf16(silu_mul(g1[2], u1[2]), silu_mul(g1[3], u1[3]));
                *(u32x4*)(O + (size_t)(row0 + ai * HALF + m * 16) * ldc + col0) = w; }
    }
};
__device__ __forceinline__ float clamp448(float x) { return fminf(fmaxf(x, -448.0f), 448.0f); }
struct EpiSwiGLUI8 {
    static constexpr bool PERM = true, AFTER_DRAIN = false;
    unsigned char* O; int ldc; const float* sa; const float* sw; int tpe; float hs;
    template <class Sched> __device__ __forceinline__ void prefill(PG8_LAS unsigned char* lds, const Sched& S, int tid) const { fill_rtab(lds, S, sa, tid); }
    __device__ __forceinline__ void operator()(const i32x4 (&acc)[2][2][4][2], const Unit& u, int wr, int wc, int fr, int fq, PG8_LAS unsigned char* lds) const {
        const int row0 = u.pm * BM + wr * 64 + fr, col0 = u.pn * HALF + wc * 32 + 8 * fq; const int e = u.pm / tpe;
        const float sg = sw[3 * e], su = sw[3 * e + 1] * hs;
#pragma unroll
        for (int ai = 0; ai < 2; ++ai)
#pragma unroll
            for (int m = 0; m < 4; ++m) { const int row = row0 + ai * HALF + m * 16; const float rs = ((const PG8_LAS float*)(lds + RTAB_OFF))[u.li * BM + (row - u.pm * BM)], fg = rs * sg, fu = rs * su;
                const i32x4 g0 = acc[ai][0][m][0], g1 = acc[ai][0][m][1], u0 = acc[ai][1][m][0], u1 = acc[ai][1][m][1];
                typedef float f32x2 __attribute__((ext_vector_type(2)));
                float h[8]; f32x2 gi[4], gu[4], ev[4];
                const float tg = -1.4426950408889634f * fg, fgu = fg * fu;
#pragma unroll
                for (int i = 0; i < 2; ++i) { gi[i] = (f32x2){(float)g0[2 * i], (float)g0[2 * i + 1]}; gi[2 + i] = (f32x2){(float)g1[2 * i], (float)g1[2 * i + 1]};
                    gu[i] = gi[i] * (f32x2){(float)u0[2 * i], (float)u0[2 * i + 1]}; gu[2 + i] = gi[2 + i] * (f32x2){(float)u1[2 * i], (float)u1[2 * i + 1]}; }
                __builtin_amdgcn_sched_barrier(0);
#pragma unroll
                for (int i = 0; i < 4; ++i) { const f32x2 t = gi[i] * tg; ev[i] = (f32x2){__builtin_amdgcn_exp2f(t.x), __builtin_amdgcn_exp2f(t.y)}; }
                __builtin_amdgcn_sched_barrier(0);
#pragma unroll
                for (int i = 0; i < 4; ++i) { const f32x2 d = ev[i] + 1.0f; ev[i] = (f32x2){__builtin_amdgcn_rcpf(d.x), __builtin_amdgcn_rcpf(d.y)}; }
                __builtin_amdgcn_sched_barrier(0);
#pragma unroll
                for (int i = 0; i < 4; ++i) { const f32x2 hv = gu[i] * ev[i] * fgu; h[2 * i] = clamp448(hv.x); h[2 * i + 1] = clamp448(hv.y); }
                int w0 = __builtin_amdgcn_cvt_pk_fp8_f32(h[0], h[1], 0, false); w0 = __builtin_amdgcn_cvt_pk_fp8_f32(h[2], h[3], w0, true);
                int w1 = __builtin_amdgcn_cvt_pk_fp8_f32(h[4], h[5], 0, false); w1 = __builtin_amdgcn_cvt_pk_fp8_f32(h[6], h[7], w1, true);
                typedef unsigned u32x2 __attribute__((ext_vector_type(2)));
                *(u32x2*)(O + (size_t)row * ldc + col0) = (u32x2){(unsigned)w0, (unsigned)w1}; }
    }
};
struct EpiNullI8 {
    static constexpr bool PERM = true, AFTER_DRAIN = false;
    template <class Sched> __device__ __forceinline__ void prefill(PG8_LAS unsigned char*, const Sched&, int) const {}
    __device__ __forceinline__ void operator()(const i32x4 (&acc)[2][2][4][2], const Unit& u, int wr, int wc, int fr, int fq, PG8_LAS unsigned char* lds) const {
#pragma unroll
        for (int ai = 0; ai < 2; ++ai)
#pragma unroll
            for (int bj = 0; bj < 2; ++bj)
#pragma unroll
                for (int m = 0; m < 4; ++m) { asm volatile("" :: "v"(acc[ai][bj][m][0]), "v"(acc[ai][bj][m][1])); }
    }
};
struct EpiRowScaleBf16 {
    static constexpr bool PERM = true, AFTER_DRAIN = false;
    bf16_t* O; int ldc; const float* rs; const float* es; int tpe; float cs;
    template <class Sched> __device__ __forceinline__ void prefill(PG8_LAS unsigned char* lds, const Sched& S, int tid) const { fill_rtab(lds, S, rs, tid); }
    __device__ __forceinline__ void operator()(const f32x4 (&acc)[2][2][4][2], const Unit& u, int wr, int wc, int fr, int fq, PG8_LAS unsigned char* lds) const {
        const int row0 = u.pm * BM + wr * 64 + fr, col0 = u.pn * BM + wc * 32 + 8 * fq;
#pragma unroll
        for (int ai = 0; ai < 2; ++ai)
#pragma unroll
            for (int m = 0; m < 4; ++m) { const int row = row0 + ai * HALF + m * 16; const float s = ((const PG8_LAS float*)(lds + RTAB_OFF))[u.li * BM + (row - u.pm * BM)] * (es[3 * (u.pm / tpe) + 2] * cs); bf16_t* rowp = O + (size_t)row * ldc + col0;
#pragma unroll
                for (int bj = 0; bj < 2; ++bj) { const f32x4 v0 = acc[ai][bj][m][0] * s, v1 = acc[ai][bj][m][1] * s;
                    u32x4 w; w.x = cvt_pk_bf16(v0[0], v0[1]); w.y = cvt_pk_bf16(v0[2], v0[3]); w.z = cvt_pk_bf16(v1[0], v1[1]); w.w = cvt_pk_bf16(v1[2], v1[3]);
                    *(u32x4*)(rowp + bj * HALF) = w; } }
    }
};
typedef int i32x4 __attribute__((ext_vector_type(4)));
typedef int i32x8 __attribute__((ext_vector_type(8)));
template <int MODE> struct AccSel { typedef f32x4 type; };
template <> struct AccSel<1> { typedef i32x4 type; };
template <int MODE> struct Frag { bf16x8 v[2]; __device__ __forceinline__ void set(int k, bf16x8 x) { v[k] = x; } };
template <> struct Frag<2> { i32x8 w; __device__ __forceinline__ void set(int k, bf16x8 x) { const i32x4 y = __builtin_bit_cast(i32x4, x); if (k == 0) w.lo = y; else w.hi = y; } };
template <class Epi, class Sched, bool ALIGN_EPI = false, bool SP2 = false, int MODE = 0, bool GATHER = false>
__device__ __forceinline__ void gemm_phase(PG8_LAS unsigned char* lds, const Gemm g, const Sched& S, const Epi& E) {
    int tid_l = threadIdx.x; asm volatile("" : "+v"(tid_l));
    const int tid = tid_l, wid = __builtin_amdgcn_readfirstlane(tid >> 6), lane = tid & 63, wr = wid >> 2, wc = wid & 3, fr = lane & 15, fq = lane >> 4;
    const int K = g.K, nt = K / BK;
    unsigned voffA[2], voffB[2];
#pragma unroll
    for (int i = 0; i < 2; ++i) { int R, C; stage_rc(tid * 16 + i * 8192, R, C); const int Rb = Epi::PERM ? ((R & ~31) + perm32(R & 31)) : R;
        voffA[i] = (unsigned)(R * K + C) * 2u; voffB[i] = (unsigned)(Rb * K + C) * 2u; }
    static_assert(!GATHER || SP2, "the gathered A operand is wired into the SP2 schedule only");
    unsigned gvc[2][2] = {{0u, 0u}, {0u, 0u}};
    PG8_LAS unsigned short* gtab = (PG8_LAS unsigned short*)(lds + GTAB_OFF);
    if constexpr (GATHER) { Unit uu_;
        for (int i_ = 0; S.next(i_, uu_); ++i_) { if (tid < BM) { const int ix_ = g.gidx[uu_.pm * BM + tid]; gtab[i_ * BM + tid] = (unsigned short)(ix_ < 0 ? 0 : ix_); } }
    }
    E.prefill(lds, S, tid);
    __syncthreads();
#define PG8_GOFF(ui_, gv_) do { if constexpr (GATHER) { _Pragma("unroll") for (int h_ = 0; h_ < 2; ++h_) _Pragma("unroll") for (int i_ = 0; i_ < 2; ++i_) { int R_, C_; stage_rc(tid * 16 + i_ * 8192, R_, C_); \
        const unsigned ix_ = gtab[(ui_) * BM + h_ * HALF + R_]; gv_[h_][i_] = ix_ * (unsigned)(K * 2) + (unsigned)C_ * 2u; } } } while (0)
    const size_t kstep = (size_t)(BK * 2);
    const size_t hstep = (size_t)HALF * K * 2;
    const size_t tstep = 2 * hstep;
    const unsigned ldsw = (unsigned)wid * 1024u;
    const int aoff = lds_byte(wr * 64 + fr, fq * 8), boff = lds_byte(wc * 32 + fr, fq * 8);
#define PG8_SA(b, h) (((b) * 2 + (h)) * HTB)
#define PG8_SB(b, h) ((4 + (b) * 2 + (h)) * HTB)
#define PG8_STAGE(bufoff, gbase, voff) do { _Pragma("unroll") for (int _i = 0; _i < 2; ++_i) \
        __builtin_amdgcn_global_load_lds((const unsigned*)((const char*)(gbase) + (voff)[_i]), (PG8_LAS unsigned*)(lds + (bufoff) + ldsw + _i * 8192), 16, 0, 0); } while (0)
#define PG8_STAGE_A(bufoff, gbase, h_, nx_) do { if constexpr (GATHER) PG8_STAGE(bufoff, gbase, gvc[h_]); else PG8_STAGE(bufoff, (gbase) + (h_) * hstep, voffA); } while (0)
#define PG8_LDA(dst, b, h) do { _Pragma("unroll") for (int m = 0; m < 4; ++m) _Pragma("unroll") for (int k = 0; k < 2; ++k) dst[m].set(k, *(const PG8_LAS bf16x8*)(lds + PG8_SA(b, h) + aoff + m * 2048 + k * 1024)); } while (0)
#define PG8_LDB(dst, b, h) do { _Pragma("unroll") for (int n = 0; n < 2; ++n) _Pragma("unroll") for (int k = 0; k < 2; ++k) dst[n].set(k, *(const PG8_LAS bf16x8*)(lds + PG8_SB(b, h) + boff + n * 2048 + k * 1024)); } while (0)
#define PG8_MMA(ai, bj, At, Bt) do { __builtin_amdgcn_s_setprio(1); _Pragma("unroll") for (int m = 0; m < 4; ++m) _Pragma("unroll") for (int n = 0; n < 2; ++n) { \
        if constexpr (MODE == 2) { asm volatile("v_mfma_f32_16x16x128_f8f6f4 %0, %1, %2, %0" : "+v"(acc[ai][bj][m][n]) : "v"(Bt[n].w), "v"(At[m].w)); }     \
        else { _Pragma("unroll") for (int k = 0; k < 2; ++k) { \
          if constexpr (MODE == 1) acc[ai][bj][m][n] = __builtin_amdgcn_mfma_i32_16x16x64_i8(__builtin_bit_cast(i32x4, Bt[n].v[k]), __builtin_bit_cast(i32x4, At[m].v[k]), acc[ai][bj][m][n], 0, 0, 0); \
          else acc[ai][bj][m][n] = __builtin_amdgcn_mfma_f32_16x16x32_bf16(Bt[n].v[k], At[m].v[k], acc[ai][bj][m][n], 0, 0, 0); } } } __builtin_amdgcn_s_setprio(0); } while (0)
#define PG8_WAIT_V(n) asm volatile("s_waitcnt vmcnt(" #n ")" ::: "memory")
#define PG8_WAIT_L(n) asm volatile("s_waitcnt lgkmcnt(" #n ")" ::: "memory")
#define PG8_BAR __builtin_amdgcn_s_barrier()
#define PG8_SCHED __builtin_amdgcn_sched_barrier(0)
    Unit cur, nxt; int ui = 0;
    if (!S.next(0, cur)) return;
    typedef typename AccSel<MODE>::type acc_t; const acc_t acc_zero = {};
    acc_t acc[2][2][4][2];
#pragma unroll
    for (int a = 0; a < 2; ++a)
#pragma unroll
        for (int b = 0; b < 2; ++b)
#pragma unroll
            for (int m = 0; m < 4; ++m)
#pragma unroll
                for (int n = 0; n < 2; ++n) acc[a][b][m][n] = acc_zero;
    Frag<MODE> At[4], B0[2], B1[2];
    const char* cA = (const char*)g.A + (GATHER ? (size_t)0 : (size_t)cur.pm * tstep); PG8_GOFF(0, gvc); const char* cB = (const char*)g.Bt + (size_t)(cur.pm / g.tpe) * g.bgs + (size_t)cur.pn * tstep;
    S.a_ready(cur);
    if constexpr (SP2) {
        PG8_STAGE(PG8_SB(0, 0), cB, voffB); PG8_STAGE(PG8_SB(0, 1), cB + hstep, voffB); PG8_STAGE_A(PG8_SA(0, 0), cA, 0, false); PG8_STAGE_A(PG8_SA(0, 1), cA, 1, false);
        if (wr == 1) PG8_BAR;
        PG8_WAIT_V(2); PG8_BAR;
        PG8_STAGE(PG8_SB(1, 0), cB + kstep, voffB); PG8_STAGE_A(PG8_SA(1, 0), cA + kstep, 0, false); PG8_STAGE(PG8_SB(1, 1), cB + hstep + kstep, voffB);
        PG8_WAIT_V(6); PG8_BAR;
    } else {
        PG8_STAGE(PG8_SB(0, 0), cB, voffB); PG8_STAGE(PG8_SA(0, 0), cA, voffA); PG8_STAGE(PG8_SB(0, 1), cB + hstep, voffB); PG8_STAGE(PG8_SA(0, 1), cA + hstep, voffA);
        if (wr == 1) PG8_BAR;
        PG8_WAIT_V(4); PG8_BAR;
        PG8_STAGE(PG8_SB(1, 0), cB + kstep, voffB); PG8_STAGE(PG8_SA(1, 0), cA + kstep, voffA); PG8_STAGE(PG8_SB(1, 1), cB + hstep + kstep, voffB);
        PG8_WAIT_V(6); PG8_BAR;
    }
    for (;;) {
        const bool has_next = S.next(ui + 1, nxt);
        const char* nA = (has_next && !GATHER) ? (const char*)g.A + (size_t)nxt.pm * tstep : cA; const char* nB = has_next ? (const char*)g.Bt + (size_t)(nxt.pm / g.tpe) * g.bgs + (size_t)nxt.pn * tstep : cB;
        for (int t = 0; t < nt; t += 2) {
            const bool last = (t == nt - 2); const bool nxu = last && has_next;
            const char* a1 = cA + (size_t)(t + 1) * kstep;
            const char* a2 = last ? nA : cA + (size_t)(t + 2) * kstep; const char* b2 = last ? nB : cB + (size_t)(t + 2) * kstep;
            const char* a3 = a2 + kstep; const char* b3 = b2 + kstep;
            if (last && has_next) S.a_ready(nxt);
            if constexpr (SP2) {
            PG8_LDB(B0, 0, 0); PG8_LDB(B1, 0, 1); PG8_SCHED; PG8_LDA(At, 0, 0); PG8_STAGE_A(PG8_SA(1, 1), a1, 1, false); if (nxu) PG8_GOFF(ui + 1, gvc);
            PG8_WAIT_V(8); PG8_WAIT_L(0); PG8_BAR; PG8_MMA(0, 0, At, B0); PG8_MMA(0, 1, At, B1); PG8_BAR; PG8_SCHED;
            PG8_LDA(At, 0, 1); PG8_STAGE(PG8_SB(0, 0), b2, voffB); PG8_STAGE(PG8_SB(0, 1), b2 + hstep, voffB); PG8_STAGE_A(PG8_SA(0, 0), a2, 0, nxu);
            PG8_WAIT_V(8); PG8_WAIT_L(0); PG8_BAR; PG8_MMA(1, 0, At, B0); PG8_MMA(1, 1, At, B1); PG8_BAR; PG8_SCHED;
            PG8_LDB(B0, 1, 0); PG8_LDB(B1, 1, 1); PG8_SCHED; PG8_LDA(At, 1, 0); PG8_STAGE_A(PG8_SA(0, 1), a2, 1, nxu);
            PG8_WAIT_V(8); PG8_WAIT_L(0); PG8_BAR; PG8_MMA(0, 0, At, B0); PG8_MMA(0, 1, At, B1); PG8_BAR; PG8_SCHED;
            PG8_LDA(At, 1, 1); PG8_STAGE(PG8_SB(1, 0), b3, voffB); PG8_STAGE(PG8_SB(1, 1), b3 + hstep, voffB); PG8_STAGE_A(PG8_SA(1, 0), a3, 0, nxu);
            PG8_WAIT_V(8); PG8_WAIT_L(0); PG8_BAR; PG8_MMA(1, 0, At, B0); PG8_MMA(1, 1, At, B1); PG8_BAR; PG8_SCHED;
            } else {
            PG8_LDB(B0, 0, 0); PG8_SCHED; PG8_LDA(At, 0, 0); PG8_STAGE(PG8_SA(1, 1), a1 + hstep, voffA);
            PG8_WAIT_L(8); PG8_BAR; PG8_WAIT_L(0); PG8_MMA(0, 0, At, B0); PG8_BAR; PG8_SCHED;
            PG8_LDB(B1, 0, 1); PG8_STAGE(PG8_SB(0, 0), b2, voffB);
            PG8_BAR; PG8_WAIT_L(0); PG8_MMA(0, 1, At, B1); PG8_BAR;
            PG8_LDA(At, 0, 1); PG8_STAGE(PG8_SA(0, 0), a2, voffA);
            PG8_BAR; PG8_WAIT_L(0); PG8_MMA(1, 0, At, B0); PG8_BAR; PG8_SCHED;
            PG8_STAGE(PG8_SB(0, 1), b2 + hstep, voffB);
            PG8_WAIT_V(6); PG8_BAR; PG8_MMA(1, 1, At, B1); PG8_BAR;
            PG8_LDB(B0, 1, 0); PG8_SCHED; PG8_LDA(At, 1, 0); PG8_STAGE(PG8_SA(0, 1), a2 + hstep, voffA);
            PG8_WAIT_L(8); PG8_BAR; PG8_WAIT_L(0); PG8_MMA(0, 0, At, B0); PG8_BAR; PG8_SCHED;
            PG8_LDB(B1, 1, 1); PG8_STAGE(PG8_SB(1, 0), b3, voffB);
            PG8_BAR; PG8_WAIT_L(0); PG8_MMA(0, 1, At, B1); PG8_BAR;
            PG8_LDA(At, 1, 1); PG8_STAGE(PG8_SA(1, 0), a3, voffA);
            PG8_BAR; PG8_WAIT_L(0); PG8_MMA(1, 0, At, B0); PG8_BAR; PG8_SCHED;
            PG8_STAGE(PG8_SB(1, 1), b3 + hstep, voffB);
            PG8_WAIT_V(6); PG8_BAR; PG8_MMA(1, 1, At, B1); PG8_BAR;
            }
        }
        if constexpr (ALIGN_EPI) { if (wr == 0) PG8_BAR; }
        if constexpr (!Epi::AFTER_DRAIN) { E(acc, cur, wr, wc, fr, fq, lds); S.done(cur); }
        if (!has_next) break;
#pragma unroll
        for (int a = 0; a < 2; ++a)
#pragma unroll
            for (int b = 0; b < 2; ++b)
#pragma unroll
                for (int m = 0; m < 4; ++m)
#pragma unroll
                    for (int n = 0; n < 2; ++n) acc[a][b][m][n] = acc_zero;
        cur = nxt; cA = nA; cB = nB; ++ui;
        if constexpr (ALIGN_EPI) { if (wr == 1) PG8_BAR; }
    }
    PG8_WAIT_V(0);
    if constexpr (!ALIGN_EPI) { if (wr == 0) PG8_BAR; }
    PG8_BAR;
    if constexpr (Epi::AFTER_DRAIN) { E.fused(acc, cur, wr, wc, fr, fq, lds, wid, lane); S.done(cur); }
#undef PG8_SA
#undef PG8_SB
#undef PG8_STAGE
#undef PG8_STAGE_A
#undef PG8_GOFF
#undef PG8_LDA
#undef PG8_LDB
#undef PG8_MMA
#undef PG8_WAIT_V
#undef PG8_WAIT_L
#undef PG8_BAR
#undef PG8_SCHED
}
}
namespace att {
typedef unsigned short bf16_t;
typedef short bf16x8 __attribute__((ext_vector_type(8)));
typedef short s16x4 __attribute__((ext_vector_type(4)));
typedef float f32x16 __attribute__((ext_vector_type(16)));
typedef float f32x4 __attribute__((ext_vector_type(4)));
typedef unsigned u32x4 __attribute__((ext_vector_type(4)));
typedef unsigned u32x2 __attribute__((ext_vector_type(2)));
#define ALDS __attribute__((address_space(3)))
typedef float f32x2_t __attribute__((ext_vector_type(2))); typedef __bf16 bf16x2_t __attribute__((ext_vector_type(2)));
__device__ __forceinline__ unsigned cvtpk(float lo, float hi) { f32x2_t v = {lo, hi}; bf16x2_t b = __builtin_convertvector(v, bf16x2_t); return __builtin_bit_cast(unsigned, b); }
__device__ __forceinline__ float bf2f(unsigned short u) { return __uint_as_float((unsigned)u << 16); }
template <int S> __device__ __forceinline__ bf16x8 pack8(const f32x16& x) {
    u32x4 p; p.x = cvtpk(x[8 * S + 0], x[8 * S + 1]); p.y = cvtpk(x[8 * S + 2], x[8 * S + 3]); p.z = cvtpk(x[8 * S + 4], x[8 * S + 5]); p.w = cvtpk(x[8 * S + 6], x[8 * S + 7]);
    return __builtin_bit_cast(bf16x8, p);
}
typedef short v4i16_t __attribute__((ext_vector_type(4)));
__device__ __forceinline__ s16x4 vtr(const ALDS char* p) { return __builtin_bit_cast(s16x4, __builtin_amdgcn_ds_read_tr16_b64_v4i16((ALDS v4i16_t*)p)); }
__device__ __forceinline__ int crow(int r, int hi) { return (r & 3) + 8 * (r >> 2) + 4 * hi; }
constexpr int ATT_LDS_BYTES = 2 * 12288 + 2 * 8192;

__device__ __forceinline__ void glds16(const void* gsrc, unsigned lds_dst) { unsigned keep;
    asm volatile("s_mov_b32 %0, m0\n\ts_mov_b32 m0, %2\n\ts_nop 0\n\tglobal_load_lds_dwordx4 %1, off\n\ts_mov_b32 m0, %0" : "=&s"(keep) : "v"(gsrc), "s"(lds_dst) : "memory"); }
__device__ __forceinline__ void glds16s(const char* sbase, unsigned voff, unsigned lds_dst) { unsigned keep;
    asm volatile("s_mov_b32 %0, m0\n\ts_mov_b32 m0, %3\n\ts_nop 0\n\tglobal_load_lds_dwordx4 %1, %2\n\ts_mov_b32 m0, %0" : "=&s"(keep) : "v"(voff), "s"(sbase), "s"(lds_dst) : "memory"); }
#define ATT_SBAR() __builtin_amdgcn_sched_barrier(0)
#define ATT_PIN(x) asm volatile("" : "+v"(x))
typedef int i32x2a __attribute__((ext_vector_type(2)));
typedef int i32x4a __attribute__((ext_vector_type(4)));
typedef int i32x6a __attribute__((ext_vector_type(6)));
typedef int i32x8a __attribute__((ext_vector_type(8)));
typedef unsigned u32x16 __attribute__((ext_vector_type(16)));
typedef __bf16 bf16x32_t __attribute__((ext_vector_type(32)));
__device__ __forceinline__ i32x6a cvt_fp6x32(const u32x16& w) { return __builtin_bit_cast(i32x6a, __builtin_amdgcn_cvt_scalef32_pk32_fp6_bf16(__builtin_bit_cast(bf16x32_t, w), 1.0f)); }
#define ATT_MF6_Z(C, A, B, SA, SB) asm volatile("v_mfma_scale_f32_32x32x64_f8f6f4 %0, %1, %2, 0, %3, %4 op_sel:[0,0,0] op_sel_hi:[0,0,0] cbsz:2 blgp:2" : "=&v"(C) : "v"(A), "v"(B), "v"(SA), "v"(SB))
#define ATT_MF6_A(C, A, B, SA, SB) asm volatile("v_mfma_scale_f32_32x32x64_f8f6f4 %0, %1, %2, %0, %3, %4 op_sel:[0,0,0] op_sel_hi:[0,0,0] cbsz:2 blgp:2" : "+v"(C) : "v"(A), "v"(B), "v"(SA), "v"(SB))
#define ATT_MF6_C(C, A, B, C0, SA, SB) asm volatile("v_mfma_scale_f32_32x32x64_f8f6f4 %0, %1, %2, %3, %4, %5 op_sel:[0,0,0] op_sel_hi:[0,0,0] cbsz:2 blgp:2" : "=&v"(C) : "v"(A), "v"(B), "v"(C0), "v"(SA), "v"(SB))
template <int DK> struct KCfg { static constexpr int NG = (DK == 96) ? 3 : 2, KTB = (DK == 96) ? 5120 : 3072, QRB = 24 * NG, NF = (DK == 96) ? 2 : 1, NRD = 4 * NF, PB = NG * 1024,
                                                      SCL = (DK == 32) ? 0x77777777 : 0x76767676, NB = (DK == 32) ? 2 : 4; };
constexpr float FQ96 = 4.0f * 1.4426950408889634f * 0.10206207261596575f * 2.0f, FQ32 = 4.0f * 1.4426950408889634f * 0.17677669529663687f, FQ64 = 4.0f * 1.4426950408889634f * 0.125f * 2.0f;
constexpr float P_BIAS = 44.0f / 256.0f;
constexpr int KC_A = 0, KC_B = 1024;
template <int DK>
__device__ __forceinline__ void kread6(i32x6a (&kf)[2][KCfg<DK>::NF], const ALDS char* pA0, const ALDS char* pB0, const ALDS char* pA1, const ALDS char* pB1, int idx) {
    constexpr int NF = KCfg<DK>::NF;
    const int mt = idx / (2 * NF), f = (idx / 2) % NF, part = idx & 1;
    const ALDS char* pA = f ? pA1 : pA0; const ALDS char* pB = f ? pB1 : pB0;
    if (part == 0) { const i32x4a v = *(const ALDS i32x4a*)(pA + mt * 512); kf[mt][f][0] = v.x; kf[mt][f][1] = v.y; kf[mt][f][2] = v.z; kf[mt][f][3] = v.w; }
    else { const i32x2a v = *(const ALDS i32x2a*)(pB + mt * 256); kf[mt][f][4] = v.x; kf[mt][f][5] = v.y; }
}
#define ATT_PV8(C, A, B) asm volatile("s_nop 3\n\tv_mfma_f32_32x32x64_f8f6f4 %0, %1, %2, %0 cbsz:0 blgp:1" : "+v"(C) : "v"(A), "v"(B))
#define ATT_L8(C, A, B) asm volatile("s_nop 3\n\tv_mfma_f32_16x16x128_f8f6f4 %0, %1, %2, %0 cbsz:0 blgp:1" : "+v"(C) : "v"(A), "v"(B))
#define ATT_L8N(C, A, B) asm volatile("v_mfma_f32_16x16x128_f8f6f4 %0, %1, %2, %0 cbsz:0 blgp:1" : "+v"(C) : "v"(A), "v"(B))
#define ATT_PV8N(C, A, B) asm volatile("v_mfma_f32_32x32x64_f8f6f4 %0, %1, %2, %0 cbsz:0 blgp:1" : "+v"(C) : "v"(A), "v"(B))
typedef unsigned short u16x2 __attribute__((ext_vector_type(2)));
__device__ __forceinline__ unsigned pk4_bf8(float a, float b, float c, float d) {
    const u16x2 x = __builtin_amdgcn_cvt_pknorm_u16(a, b), y = __builtin_amdgcn_cvt_pknorm_u16(c, d);
    return __builtin_amdgcn_perm(__builtin_bit_cast(unsigned, y), __builtin_bit_cast(unsigned, x), 0x07050301u); }
struct KPtr { const ALDS char *a0, *b0, *a1, *b1; };
template <int DK, int VLOAD, int ABL = 0, class DF>
__device__ __forceinline__ void att_step9(f32x16& N0, f32x16& N1, const f32x16& P0, const f32x16& P1, i32x6a (&kf)[2][KCfg<DK>::NF], const i32x6a* qfn,
                                          f32x16 (&o)[2], f32x4& L, const i32x8a& pwP, i32x8a& pwC, i32x8a (&vf)[2], const i32x8a& ones, const f32x16& cb, const int& sa, const int& sb,
                                          const ALDS char* vcur, const KPtr k1, const KPtr k0, DF&& dmaf) {
    constexpr int NF = KCfg<DK>::NF;
#define ATP_PACK(i) do { if (!(ABL & 4)) { const int e = 4 * (i); \
        int w = (int)((e < 16) ? pk4_bf8(P0[e & 15], P0[(e + 1) & 15], P0[(e + 2) & 15], P0[(e + 3) & 15]) : pk4_bf8(P1[e & 15], P1[(e + 1) & 15], P1[(e + 2) & 15], P1[(e + 3) & 15])); \
        ATT_PIN(w); pwC[i] = w; } } while (0)
    ATT_SBAR();
    ATT_PV8N(o[0], vf[0], pwP);
    dmaf();
#pragma unroll
    for (int k = 2 * NF; k < 4 * NF; ++k) { if (!(ABL & 8)) kread6<DK>(kf, k1.a0, k1.b0, k1.a1, k1.b1, k); }
#pragma unroll
    for (int i = 0; i < 4; ++i) ATP_PACK(i);
    ATT_SBAR();
    ATT_PV8N(o[1], vf[1], pwP);
    if (VLOAD && !(ABL & 8)) { vf[0].lo = *(const ALDS i32x4a*)(vcur); vf[0].hi = *(const ALDS i32x4a*)(vcur + 1024); }
#pragma unroll
    for (int i = 4; i < 8; ++i) ATP_PACK(i);
    ATT_SBAR();
    ATT_L8N(L, ones, pwP);
    if (VLOAD && !(ABL & 8)) { vf[1].lo = *(const ALDS i32x4a*)(vcur + 512); vf[1].hi = *(const ALDS i32x4a*)(vcur + 512 + 1024); }
    ATT_SBAR();
    if (DK == 64) { ATT_MF6_C(N0, kf[0][0], qfn[0], cb, sa, sb); ATT_MF6_C(N1, kf[1][0], qfn[0], cb, sa, sb); }
    else if (NF == 1) { ATT_MF6_Z(N0, kf[0][0], qfn[0], sa, sb); ATT_MF6_Z(N1, kf[1][0], qfn[0], sa, sb); }
    else { ATT_MF6_Z(N0, kf[0][0], qfn[0], sa, sb); ATT_MF6_Z(N1, kf[1][0], qfn[0], sa, sb); ATT_MF6_A(N0, kf[0][1], qfn[1], sa, sb); ATT_MF6_A(N1, kf[1][1], qfn[1], sa, sb); }
    ATT_SBAR();
#pragma unroll
    for (int k = 0; k < 2 * NF; ++k) { if (!(ABL & 8)) kread6<DK>(kf, k0.a0, k0.b0, k0.a1, k0.b1, k); }
    ATT_SBAR();
#undef ATP_PACK
}
template <int DK, int NMAP, int ABL = 0>
__device__ __forceinline__ void attn_unit_f8(const unsigned char* __restrict__ Qb, const char* __restrict__ Kt, const char* __restrict__ Vt, int t0, int t1,
                                             bf16_t* __restrict__ Ob, ALDS char* lds, float lam, const float* __restrict__ gout, float oml) {
    typedef KCfg<DK> KC;
    constexpr int KTB = KC::KTB, NF = KC::NF, NRD = KC::NRD, LV = 8 * KTB, CB = LV + 8 * 4096, NKP = KTB / 1024, NP = NKP + 4, NDMA = (NP + 7) / 8;
    int tid_l = threadIdx.x; asm volatile("" : "+v"(tid_l));
    const int tid = tid_l, lane = tid & 63, r32 = lane & 31, hi = lane >> 5, wid = __builtin_amdgcn_readfirstlane(tid >> 6);
    i32x6a qbias;
    { u32x16 vq, vk; unsigned pq = 0x40B040B0u, pk = 0x40804080u;
      asm volatile("" : "+v"(pq), "+v"(pk));
#pragma unroll
      for (int r = 0; r < 16; ++r) { vq[r] = (2 * r < KC::NB) ? pq : 0u; vk[r] = (2 * r < KC::NB) ? pk : 0u; }
      qbias = cvt_fp6x32(vq);
      if (DK != 64 && tid == 0) { const i32x6a kb = cvt_fp6x32(vk); const i32x4a ka = {kb[0], kb[1], kb[2], kb[3]}; const i32x2a kc = {kb[4], kb[5]};
          *(ALDS i32x4a*)(lds + CB + KC_A) = ka; *(ALDS i32x4a*)(lds + CB + KC_A + 512) = ka; *(ALDS i32x2a*)(lds + CB + KC_B) = kc; *(ALDS i32x2a*)(lds + CB + KC_B + 256) = kc; } }
    i32x6a qf[NMAP][NF];
    { const unsigned char* qrow = Qb + (size_t)(wid * 32 + r32) * KC::QRB;
#define ATP_QG(dst, off) do { const i32x2a a_ = *(const i32x2a*)(qrow + (off)), b_ = *(const i32x2a*)(qrow + (off) + 8), c_ = *(const i32x2a*)(qrow + (off) + 16); \
          dst[0] = a_.x; dst[1] = a_.y; dst[2] = b_.x; dst[3] = b_.y; dst[4] = c_.x; dst[5] = c_.y; } while (0)
      if (DK == 64) { ATP_QG(qf[0][0], 24 * hi); }
      else if (DK == 96) { ATP_QG(qf[0][0], 24 * hi); i32x6a t; ATP_QG(t, 48);
#pragma unroll
          for (int r = 0; r < 6; ++r) qf[0][NF - 1][r] = hi ? qbias[r] : t[r]; }
      else {
#pragma unroll
          for (int m = 0; m < NMAP; ++m) { i32x6a t; ATP_QG(t, 24 * m);
#pragma unroll
              for (int r = 0; r < 6; ++r) qf[m][0][r] = hi ? qbias[r] : t[r]; } }
#undef ATP_QG
    }
#pragma unroll
    for (int m = 0; m < NMAP; ++m)
#pragma unroll
        for (int f = 0; f < NF; ++f) ATT_PIN(qf[m][f]);
    f32x16 o[NMAP][2], cb; f32x4 L[NMAP]; i32x8a pw, ones; int sa = 0x7F7F7F7F, sb = KC::SCL;
    ATT_PIN(sa); ATT_PIN(sb);
#pragma unroll
    for (int r = 0; r < 16; ++r) cb[r] = P_BIAS;
    if (DK == 64) ATT_PIN(cb);
    { const int sel = (lane == 0 || lane == 32 || lane == 17 || lane == 49) ? 0x38383838 : 0;
#pragma unroll
      for (int r = 0; r < 8; ++r) { pw[r] = 0; ones[r] = sel; } }
    ATT_PIN(ones);
#pragma unroll
    for (int m = 0; m < NMAP; ++m) {
#pragma unroll
        for (int r = 0; r < 4; ++r) L[m][r] = 0.f;
#pragma unroll
        for (int d = 0; d < 2; ++d)
#pragma unroll
            for (int r = 0; r < 16; ++r) o[m][d][r] = 0.f; }
#pragma unroll
    for (int m = 0; m < NMAP; ++m) { ATT_PIN(L[m]); ATT_PIN(o[m][0]); ATT_PIN(o[m][1]); }
    const unsigned lds0 = (unsigned)(size_t)lds;
    const char* src0; unsigned dst0; int isv0; const bool act0 = wid < NP;
    { const int p = wid; isv0 = p >= NKP; src0 = (isv0 ? Vt + (p - NKP) * 1024 : Kt + p * 1024); dst0 = lds0 + (isv0 ? LV + (p - NKP) * 1024 : p * 1024); }
    const unsigned lane16 = (unsigned)lane * 16u;
    const bool act1 = (NDMA == 2) && wid == 7;
    const char* src1 = nullptr; unsigned dst1 = 0u;
    if (NDMA == 2) { const int p = 8; src1 = Vt + (p - NKP) * 1024; dst1 = lds0 + LV + (p - NKP) * 1024; }
#define ATP_DMA(tk, tv) do { if (ABL & (2 | 32)) break; \
        if (act0) { if (isv0) glds16s(src0 + (size_t)(tv) * 4096, lane16, (unsigned)__builtin_amdgcn_readfirstlane(dst0 + ((tv) & 7) * 4096)); else glds16s(src0 + (size_t)(tk) * KTB, lane16, (unsigned)__builtin_amdgcn_readfirstlane(dst0 + ((tk) & 7) * KTB)); } \
        if (act1) glds16s(src1 + (size_t)(tv) * 4096, lane16, (unsigned)__builtin_amdgcn_readfirstlane(dst1 + ((tv) & 7) * 4096)); } while (0)
#define ATP_SYNCALL() do { if (ABL & 2) break; if (!(ABL & 128)) { if (act1) asm volatile("s_waitcnt vmcnt(4)" ::: "memory"); else asm volatile("s_waitcnt vmcnt(2)" ::: "memory"); } \
        if (!(ABL & 64)) asm volatile("s_barrier" ::: "memory"); } while (0)
    const bool c0 = (DK == 32) && hi, c1 = hi;
    const int ka0 = c0 ? CB + KC_A : ((DK == 32) ? 0 : hi * 1024) + r32 * 16, kb0 = c0 ? CB + KC_B : KC::PB + ((DK == 32) ? 0 : hi * 512) + r32 * 8, km0 = c0 ? 0 : KTB;
    const int dA = (DK == 32 && !hi) ? 1024 : 0, dB = (DK == 32 && !hi) ? 512 : 0;
    const int ka1 = c1 ? CB + KC_A : 2048 + r32 * 16, kb1 = c1 ? CB + KC_B : KC::PB + 1024 + r32 * 8, km1 = c1 ? 0 : KTB;
#define ATP_KP(t, m) (KPtr{lds + ((t) & 7) * km0 + ka0 + (m) * dA, lds + ((t) & 7) * km0 + kb0 + (m) * dB, lds + ((t) & 7) * km1 + ka1, lds + ((t) & 7) * km1 + kb1})
#define ATP_VB(t) (lds + LV + ((t) & 7) * 4096 + klane64)
#define ATP_KLOAD(t, m) do { const KPtr kp_ = ATP_KP(t, m); _Pragma("unroll") for (int k = 0; k < NRD; ++k) kread6<DK>(kf, kp_.a0, kp_.b0, kp_.a1, kp_.b1, k); \
        asm volatile("s_waitcnt lgkmcnt(0)" ::: "memory"); \
        _Pragma("unroll") for (int mt_ = 0; mt_ < 2; ++mt_) _Pragma("unroll") for (int f_ = 0; f_ < NF; ++f_) ATT_PIN(kf[mt_][f_]);     \
        asm volatile("s_nop 3" ::: "memory"); } while (0)
    const int klane64 = hi * 2048 + r32 * 16;
    ATP_DMA(t0, t0); ATP_DMA(t0 + 1, t0 + 1); ATP_DMA(t0 + 2, t0 + 1); if (NMAP == 1) ATP_DMA(t0 + 3, t0 + 1);
    asm volatile("s_waitcnt vmcnt(0) lgkmcnt(0)\n\ts_barrier" ::: "memory");
    if (NMAP == 1) { ATP_DMA(t0 + 4, t0 + 2); ATP_DMA(t0 + 5, t0 + 3); } else { ATP_DMA(t0 + 3, t0 + 2); ATP_DMA(t0 + 4, t0 + 3); }
    i32x6a kf[2][NF]; i32x8a vf[2], pwB;
    f32x16 sA0, sA1, sB0, sB1;
    ATP_KLOAD(t0, 0);
    if (DK == 64) { ATT_MF6_C(sA0, kf[0][0], qf[0][0], cb, sa, sb); ATT_MF6_C(sA1, kf[1][0], qf[0][0], cb, sa, sb); } else { ATT_MF6_Z(sA0, kf[0][0], qf[0][0], sa, sb); ATT_MF6_Z(sA1, kf[1][0], qf[0][0], sa, sb); }
    if (NF == 2) { ATT_MF6_A(sA0, kf[0][1], qf[0][1], sa, sb); ATT_MF6_A(sA1, kf[1][1], qf[0][1], sa, sb); }
    asm volatile("s_nop 15\n\ts_nop 15\n\ts_nop 15\n\ts_nop 15\n\ts_nop 15\n\ts_nop 15" : "+v"(sA0), "+v"(sA1));
    { const KPtr kp_ = (NMAP == 1) ? ATP_KP(t0 + 1, 0) : ATP_KP(t0, 1);
#pragma unroll
      for (int k = 0; k < 2 * NF; ++k) kread6<DK>(kf, kp_.a0, kp_.b0, kp_.a1, kp_.b1, k); }
#pragma unroll
    for (int r = 0; r < 8; ++r) { vf[0][r] = 0; vf[1][r] = 0; pwB[r] = 0; }
    ATT_PIN(vf[0]); ATT_PIN(vf[1]); ATT_PIN(pwB);
    asm volatile("s_nop 3" ::: "memory");
    if (NMAP == 1) {
        for (int t = t0; t < t1; t += 2) {
            att_step9<DK, 1, ABL>(sB0, sB1, sA0, sA1, kf, qf[0], o[0], L[0], pwB, pw, vf, ones, cb, sa, sb, ATP_VB(t), ATP_KP(t + 1, 0), ATP_KP(t + 2, 0), [&]() { ATP_DMA(t + 6, t + 4); ATP_DMA(t + 7, t + 5); });
            att_step9<DK, 1, ABL>(sA0, sA1, sB0, sB1, kf, qf[0], o[0], L[0], pw, pwB, vf, ones, cb, sa, sb, ATP_VB(t + 1), ATP_KP(t + 2, 0), ATP_KP(t + 3, 0), [&]() {});
            ATP_SYNCALL();
        }
    } else {
        for (int t = t0; t < t1; t += 2) {
            att_step9<DK, 1, ABL>(sB0, sB1, sA0, sA1, kf, qf[1], o[1], L[1], pwB, pw, vf, ones, cb, sa, sb, ATP_VB(t), ATP_KP(t, 1), ATP_KP(t + 1, 0), [&]() { ATP_DMA(t + 5, t + 4); });
            att_step9<DK, 0, ABL>(sA0, sA1, sB0, sB1, kf, qf[0], o[0], L[0], pw, pwB, vf, ones, cb, sa, sb, ATP_VB(t), ATP_KP(t + 1, 0), ATP_KP(t + 1, 1), [&]() { ATP_DMA(t + 6, t + 5); });
            att_step9<DK, 1, ABL>(sB0, sB1, sA0, sA1, kf, qf[1], o[1], L[1], pwB, pw, vf, ones, cb, sa, sb, ATP_VB(t + 1), ATP_KP(t + 1, 1), ATP_KP(t + 2, 0), [&]() {});
            att_step9<DK, 0, ABL>(sA0, sA1, sB0, sB1, kf, qf[0], o[0], L[0], pw, pwB, vf, ones, cb, sa, sb, ATP_VB(t + 1), ATP_KP(t + 2, 0), ATP_KP(t + 2, 1), [&]() {});
            ATP_SYNCALL();
        }
    }
    ATT_SBAR();
    ATT_PV8N(o[NMAP - 1][0], vf[0], pwB); ATT_PV8N(o[NMAP - 1][1], vf[1], pwB); ATT_L8N(L[NMAP - 1], ones, pwB);
    asm volatile("s_waitcnt vmcnt(0) lgkmcnt(0)\n\ts_barrier" ::: "memory");
#pragma unroll
    for (int m = 0; m < NMAP; ++m) asm volatile("s_nop 15\n\ts_nop 15\n\ts_nop 15\n\ts_nop 15\n\ts_nop 15" : "+v"(o[m][0]), "+v"(o[m][1]), "+v"(L[m]));
#undef ATP_DMA
#undef ATP_SYNCALL
#undef ATP_KP
#undef ATP_VB
#undef ATP_KLOAD
    float li[NMAP];
#pragma unroll
    for (int m = 0; m < NMAP; ++m) { const float l0 = __shfl(L[m][0], r32 & 15), l1 = __shfl(L[m][1], r32 & 15); li[m] = 1.0f / ((r32 & 16) ? l1 : l0); }
    float val[2][16];
    if (NMAP == 1) {
#pragma unroll
        for (int d = 0; d < 2; ++d)
#pragma unroll
            for (int r = 0; r < 16; ++r) val[d][r] = o[0][d][r] * li[0];
    } else {
        float ss = 0.f; const float l2 = lam * li[NMAP - 1];
#pragma unroll
        for (int d = 0; d < 2; ++d)
#pragma unroll
            for (int r = 0; r < 16; ++r) { const float v = o[0][d][r] * li[0] - o[NMAP - 1][d][r] * l2; val[d][r] = v; ss += v * v; }
        ss += __shfl_xor(ss, 32);
        const float rstd = rsqrtf(ss * (1.0f / 64.0f) + 1e-6f) * oml;
#pragma unroll
        for (int d = 0; d < 2; ++d)
#pragma unroll
            for (int g = 0; g < 4; ++g) { const f32x4 gv = *(const f32x4*)(gout + 32 * d + 8 * g + 4 * hi);
#pragma unroll
                for (int i = 0; i < 4; ++i) val[d][4 * g + i] *= rstd * gv[i]; }
    }
    bf16_t* orow = Ob + (size_t)(wid * 32 + r32) * 1024 + 4 * hi;
#pragma unroll
    for (int d = 0; d < 2; ++d)
#pragma unroll
        for (int g = 0; g < 4; ++g) { u32x2 w; w.x = cvtpk(val[d][4 * g], val[d][4 * g + 1]); w.y = cvtpk(val[d][4 * g + 2], val[d][4 * g + 3]);
            *(u32x2*)(orow + 32 * d + 8 * g) = w; }
}

}
constexpr int NWAVES = 8;
constexpr int DM = 1024, NB = 4, SEQ = 8192, CL = 256, NTOKB = SEQ + CL, LROWS = NB * SEQ, MROWS = LROWS + NB * CL;
constexpr int NLAYER = 2, INC = 1952, ZP = 3072, NE = 16, FFD = 2048, CAPL = 1024, CAPC = 32, NKT = NTOKB / 64;
constexpr int ZQ = 1952, ZKV = 2336, ZEND = 2848;
constexpr float EPSF = 1e-6f, LOG2E = 1.4426950408889634f, HID_SCALE = 4.0f;
constexpr int N_PHASES = 22;
enum { I_X = 0, I_C, I_CTX, I_CCTX, I_WADA, I_BADA, I_GN1, I_WIN, I_GCQ, I_GCKV, I_WUQ, I_WUKV, I_GMQ, I_GMK, I_GDQ, I_GDK, I_LQ1, I_LK1, I_LQ2, I_LK2, I_GDO, I_GGQ, I_GGK, I_WO, I_GN2, I_WR, I_WG, I_WU, I_WD, N_IN };
constexpr size_t MiB = 1u << 20;
constexpr size_t WS_CTL = 0, CTL_ZERO_BYTES = 1 * MiB;
constexpr size_t WS_MOD = 1 * MiB;
constexpr size_t WS_LAM = WS_MOD + 256 * 1024;
constexpr size_t WS_TAB = WS_MOD + 320 * 1024;
constexpr size_t TAB_AROW = 0, TAB_ACOL = 128 * 8 * 8, TAB_GROW = TAB_ACOL + 64 * 8 * 8, TAB_GCOL = TAB_GROW + 128 * 16 * 8;
constexpr size_t WS_AFF = 2 * MiB, WS_AFFC = 4 * MiB;
constexpr size_t WS_IDX = 5 * MiB, WS_GATE = 6 * MiB;
constexpr size_t WS_INV = 7 * MiB;
constexpr size_t WS_SA = 10 * MiB, WS_SAE = 11 * MiB, WS_SW = 12 * MiB;
constexpr size_t WS_SSQ = 14 * MiB;
constexpr size_t WS_SWC = 13 * MiB;
constexpr size_t WS_WCAT8 = 72 * MiB;
constexpr size_t WS_WCAT = 16 * MiB;
constexpr size_t WS_WO = 28 * MiB;
constexpr size_t WS_CTXW = 32 * MiB;
constexpr size_t WS_H = 36 * MiB;
constexpr size_t WS_WGU = 102 * MiB;
constexpr size_t WS_WD = 230 * MiB;
constexpr size_t WS_YE = 294 * MiB;
constexpr size_t WS_Z = 430 * MiB;
constexpr size_t WS_QKV = 628 * MiB;
constexpr size_t WS_ATT = 793 * MiB;
constexpr size_t WS_DELTA = 430 * MiB;
constexpr size_t WS_XE = 430 * MiB;
constexpr size_t WS_HID = 566 * MiB;
constexpr size_t WS_XB = 859 * MiB;
constexpr size_t WS_END = 925 * MiB;
constexpr size_t QO_QM = 0, QO_QD = 25952256, QO_QG = 43253760, QO_KM = 77856768, QO_KD = 103809024, QO_KG = 121110528, QO_VM = 129761280, QO_VD = 147062784, QO_VG = 164364288;
static_assert(QO_VG + 8650752 == 173015040 && WS_QKV + 173015040 <= WS_ATT && WS_HID + (size_t)16 * 4352 * 2048 * 2 <= WS_XB, "ws map");
constexpr int CW_BAR = 4096, CW_Q = 16384;
constexpr int RING_BYTES = 131072, LDSCTL_OFF = RING_BYTES, MISC_OFF = LDSCTL_OFF + 320, LDS_BYTES = 163840;

#define GAS __attribute__((address_space(1)))
#define LAS __attribute__((address_space(3)))
typedef unsigned short bf16;
typedef unsigned v4u __attribute__((ext_vector_type(4)));
typedef unsigned v2u __attribute__((ext_vector_type(2)));
typedef float f32x4 __attribute__((ext_vector_type(4)));
typedef float f32x2 __attribute__((ext_vector_type(2)));
typedef GAS unsigned gu32;
#define RLX_AGENT __ATOMIC_RELAXED, __HIP_MEMORY_SCOPE_AGENT
#define LDS_WAIT() asm volatile("s_waitcnt lgkmcnt(0)" ::: "memory")
__device__ __forceinline__ unsigned pk2(float lo, float hi) { return att::cvtpk(lo, hi); }
__device__ __forceinline__ float bflo(unsigned w) { return __uint_as_float(w << 16); }
__device__ __forceinline__ float bfhi(unsigned w) { return __uint_as_float(w & 0xffff0000u); }
#define XB_TMO      128
#define XB_XCNT(j)  (256  + 64 * (j))
#define XB_XSUB(j)  (1280 + 64 * (j))
#define XB_XGEN(j)  (2304 + 64 * (j))
#define XB_TOP      3328
#define XB_TOPGEN   3392
#define XCD_BAR_WORDS 3456
#define XB_SPIN_CAP (1u << 18)

__device__ __forceinline__ unsigned xb_ld(unsigned* p)              { return __hip_atomic_load(p, __ATOMIC_RELAXED, __HIP_MEMORY_SCOPE_AGENT); }
__device__ __forceinline__ unsigned xb_add(unsigned* p, unsigned v) { return __hip_atomic_fetch_add(p, v, __ATOMIC_RELAXED, __HIP_MEMORY_SCOPE_AGENT); }
__device__ __forceinline__ unsigned xb_xcc_id() { return (unsigned)__builtin_amdgcn_s_getreg((3 << 11) | 20) & 0xFu; }
#define XB_SPIN(cond, bar) do { unsigned _sp = 0; while (cond) { __builtin_amdgcn_s_sleep(1); \
    if ((++_sp & 255u) == 0u) { if (xb_ld(&(bar)[XB_TMO])) break; if (_sp > XB_SPIN_CAP) { atomicAdd(&(bar)[XB_TMO], 1u); break; } } } } while (0)

struct XcdBarrier {
    unsigned* bar; unsigned x;
    volatile LAS unsigned* st;
};

__device__ __forceinline__ XcdBarrier xcd_barrier_post(unsigned* bar, volatile LAS unsigned* st) {
    XcdBarrier b; b.bar = bar; b.x = xb_xcc_id(); b.st = st;
    if (threadIdx.x == 0) (void)xb_add(&bar[XB_XCNT(b.x)], 1u);
    return b;
}
__device__ __forceinline__ void xcd_barrier_complete(unsigned* bar, unsigned x, unsigned& nloc, unsigned& nx) {
    const unsigned G = gridDim.x * gridDim.y * gridDim.z;
    unsigned sum, cnt, mine, sp = 0u;
    for (;;) {
        sum = 0u; cnt = 0u; mine = 0u;
#pragma unroll
        for (unsigned j = 0; j < 16; ++j) { const unsigned c = xb_ld(&bar[XB_XCNT(j)]); sum += c; cnt += (c > 0u) ? 1u : 0u; mine = (j == x) ? c : mine; }
        if (sum == G) break;
        __builtin_amdgcn_s_sleep(1);
        if ((++sp & 255u) == 0u) { if (xb_ld(&bar[XB_TMO])) break; if (sp > XB_SPIN_CAP) { atomicAdd(&bar[XB_TMO], 1u); break; } }
    }
    nloc = mine > 0u ? mine : 1u; nx = cnt > 0u ? cnt : 1u;
}

__device__ __forceinline__ void xcd_barrier(const XcdBarrier& b) {
    asm volatile("s_waitcnt vmcnt(0)" ::: "memory");
    __syncthreads();
    if (threadIdx.x == 0) {
        unsigned* bar = b.bar;
        __builtin_amdgcn_s_waitcnt(0);
        unsigned nloc = b.st[0], nx = b.st[1];
        if (nloc == 0u) { xcd_barrier_complete(bar, b.x, nloc, nx); b.st[0] = nloc; b.st[1] = nx; }
        const unsigned old = xb_add(&bar[XB_XSUB(b.x)], 1u);
        const unsigned gen = old / nloc;
        if (old + 1u == (gen + 1u) * nloc) {
            __builtin_amdgcn_fence(__ATOMIC_RELEASE, "agent");
            asm volatile("s_waitcnt vmcnt(0)" ::: "memory");
            const unsigned og = xb_add(&bar[XB_TOP], 1u);
            const unsigned tg = og / nx;
            if (og + 1u == (tg + 1u) * nx) xb_add(&bar[XB_TOPGEN], 1u);
            else XB_SPIN(xb_ld(&bar[XB_TOPGEN]) == tg, bar);
            __builtin_amdgcn_fence(__ATOMIC_ACQUIRE, "agent");
            xb_add(&bar[XB_XGEN(b.x)], 1u);
            asm volatile("s_waitcnt vmcnt(0)" ::: "memory");
        } else {
            XB_SPIN(xb_ld(&bar[XB_XGEN(b.x)]) == gen, bar);
            __builtin_amdgcn_fence(__ATOMIC_ACQUIRE, "agent");
            asm volatile("s_waitcnt vmcnt(0)" ::: "memory");
        }
    }
    __syncthreads();
}
struct Args { const float* in[N_IN]; float* out; unsigned char* ws; int ph_lo, ph_hi; };
static_assert(sizeof(Args) == 256, "Args has no padding bytes");
typedef const __attribute__((address_space(4))) Args* KA;
__device__ __forceinline__ KA kargs() { KA p = (KA)__builtin_amdgcn_kernarg_segment_ptr(); asm volatile("" : "+s"(p)); return p; }
struct Frame {
    LAS unsigned char* lds;
    volatile LAS unsigned* MISC;
    gu32* ctl;
    int tid, lane, wave, vcu, G;
};
__device__ __forceinline__ void relane(Frame& F) { int t = threadIdx.x; asm volatile("" : "+v"(t)); F.tid = t; F.lane = t & 63; F.wave = __builtin_amdgcn_readfirstlane(t >> 6); }
__device__ __forceinline__ float wave_sum(float v) {
#pragma unroll
    for (int o = 1; o < 64; o <<= 1) v += __shfl_xor(v, o);
    return v;
}
__device__ __forceinline__ float silu_f(float x) { return x / (1.0f + __expf(-x)); }

__device__ __forceinline__ void transpose_item(const float* __restrict__ W, int N, bf16* __restrict__ WT, int ldt, int k0, int n0, int rowbase, LAS float* scr, int lane) {
    float tv[32];
    { const float* wp = W + (size_t)(k0 + (lane >> 5)) * N + n0 + (lane & 31);
#pragma unroll
      for (int i = 0; i < 32; ++i) tv[i] = __builtin_nontemporal_load(wp + (size_t)(2 * i) * N); }
#pragma unroll
    for (int i = 0; i < 32; ++i) scr[(2 * i + (lane >> 5)) * 33 + (lane & 31)] = tv[i];
    LDS_WAIT(); asm volatile("" ::: "memory");
    const int c = lane & 7;
#pragma unroll
    for (int j = 0; j < 4; ++j) { const int n = (lane >> 3) + 8 * j; const LAS float* s = scr + (8 * c) * 33 + n;
        v4u o; o.x = pk2(s[0 * 33], s[1 * 33]); o.y = pk2(s[2 * 33], s[3 * 33]); o.z = pk2(s[4 * 33], s[5 * 33]); o.w = pk2(s[6 * 33], s[7 * 33]);
        *(v4u*)(WT + (size_t)(rowbase + n) * ldt + k0 + 8 * c) = o; }
    LDS_WAIT(); asm volatile("" ::: "memory");
}

__device__ __forceinline__ void transpose_item_i8(const float* __restrict__ W, int N, signed char* __restrict__ WT, int ldt, int k0, int n0, int rowbase, float qs, LAS float* scr, int lane) {
    float tv[32];
    { const float* wp = W + (size_t)(k0 + (lane >> 5)) * N + n0 + (lane & 31);
#pragma unroll
      for (int i = 0; i < 32; ++i) tv[i] = __builtin_nontemporal_load(wp + (size_t)(2 * i) * N); }
#pragma unroll
    for (int i = 0; i < 32; ++i) scr[(2 * i + (lane >> 5)) * 33 + (lane & 31)] = tv[i];
    LDS_WAIT(); asm volatile("" ::: "memory");
    const int c = lane & 3;
#pragma unroll
    for (int j = 0; j < 2; ++j) { const int n = (lane >> 2) + 16 * j; const LAS float* s = scr + (16 * c) * 33 + n; v4u o;
#pragma unroll
        for (int d = 0; d < 4; ++d) { unsigned w = 0u;
#pragma unroll
            for (int i = 0; i < 4; ++i) { const float f = fminf(fmaxf(s[(4 * d + i) * 33] * qs, -127.0f), 127.0f); w |= ((unsigned)((int)__builtin_rintf(f)) & 255u) << (8 * i); }
            o[d] = w; }
        *(v4u*)(WT + (size_t)(rowbase + n) * ldt + k0 + 16 * c) = o; }
    LDS_WAIT(); asm volatile("" ::: "memory");
}

__device__ __forceinline__ void transpose_item_f8(const float* __restrict__ W, int N, unsigned char* __restrict__ WT, int ldt, int k0, int n0, int rowbase, float qs, LAS float* scr, int lane) {
    float tv[32];
    { const float* wp = W + (size_t)(k0 + (lane >> 5)) * N + n0 + (lane & 31);
#pragma unroll
      for (int i = 0; i < 32; ++i) tv[i] = __builtin_nontemporal_load(wp + (size_t)(2 * i) * N); }
#pragma unroll
    for (int i = 0; i < 32; ++i) scr[(2 * i + (lane >> 5)) * 33 + (lane & 31)] = tv[i];
    LDS_WAIT(); asm volatile("" ::: "memory");
    const int c = lane & 3;
#pragma unroll
    for (int j = 0; j < 2; ++j) { const int n = (lane >> 2) + 16 * j; const LAS float* s = scr + (16 * c) * 33 + n; v4u o;
#pragma unroll
        for (int d = 0; d < 4; ++d) { float f[4];
#pragma unroll
            for (int i = 0; i < 4; ++i) f[i] = fminf(fmaxf(s[(4 * d + i) * 33] * qs, -448.0f), 448.0f);
            int w = __builtin_amdgcn_cvt_pk_fp8_f32(f[0], f[1], 0, false); w = __builtin_amdgcn_cvt_pk_fp8_f32(f[2], f[3], w, true); o[d] = (unsigned)w; }
        *(v4u*)(WT + (size_t)(rowbase + n) * ldt + k0 + 16 * c) = o; }
    LDS_WAIT(); asm volatile("" ::: "memory");
}

__device__ __forceinline__ void sincos_d(float af, float& c, float& s) {
    const double a = (double)af;
    const double q = __builtin_rint(a * 0.63661977236758134308);
    double r = __builtin_fma(-q, 1.57079632679489655800e+00, a); r = __builtin_fma(-q, 6.12323399573676603587e-17, r);
    const double r2 = r * r;
    double sp = -7.6471637318198164759e-13; sp = sp * r2 + 1.6059043836821614599e-10; sp = sp * r2 - 2.5052108385441718775e-08; sp = sp * r2 + 2.7557319223985890653e-06;
    sp = sp * r2 - 1.9841269841269841270e-04; sp = sp * r2 + 8.3333333333333333333e-03; sp = sp * r2 - 1.6666666666666666667e-01; const double sn = r + r * r2 * sp;
    double cp = 4.7794773323873852974e-14; cp = cp * r2 - 1.1470745597729724714e-11; cp = cp * r2 + 2.0876756987868098979e-09; cp = cp * r2 - 2.7557319223985890653e-07;
    cp = cp * r2 + 2.4801587301587301587e-05; cp = cp * r2 - 1.3888888888888888889e-03; cp = cp * r2 + 4.1666666666666666667e-02; cp = cp * r2 - 0.5; const double cs = 1.0 + r2 * cp;
    const int qi = (int)q & 3;
    const double cc = (qi == 0) ? cs : (qi == 1) ? -sn : (qi == 2) ? -cs : sn;
    const double ss = (qi == 0) ? sn : (qi == 1) ? cs : (qi == 2) ? -sn : -cs;
    c = (float)cc; s = (float)ss;
}

#define MEMFENCE() asm volatile("" ::: "memory")
__device__ __forceinline__ void p0_prologue(KA a, Frame& F) {
    relane(F);
    unsigned char* ws = a->ws;
    float* MOD = (float*)(ws + WS_MOD);
    if ((int)blockIdx.x < 192) {
        LAS float* sl = (LAS float*)F.lds + 4096;
        for (int i = F.tid; i < 5 * 1024; i += NWAVES * 64) { const int v = i >> 10, k = i & 1023; const float cv = (v < 4) ? a->in[I_C][v * 1024 + k] : a->in[I_CCTX][k]; sl[i] = silu_f(cv); }
        __syncthreads();
        for (int it = blockIdx.x; it < 192; it += F.G) {
            const int l = it / 96, col = (it % 96) * 64 + F.lane;
            const float* W = a->in[I_WADA] + (size_t)l * 1024 * 6144;
            float acc[5] = {0.f, 0.f, 0.f, 0.f, 0.f};
#pragma unroll 8
            for (int kk = 0; kk < 128; ++kk) { const int k = F.wave * 128 + kk; const float w = W[(size_t)k * 6144 + col];
#pragma unroll
                for (int v = 0; v < 5; ++v) acc[v] += sl[v * 1024 + k] * w; }
            LAS float* red = (LAS float*)F.lds;
#pragma unroll
            for (int v = 0; v < 5; ++v) red[(F.wave * 5 + v) * 64 + F.lane] = acc[v];
            __syncthreads();
            if (F.wave < 5) { float s2 = a->in[I_BADA][l * 6144 + col];
#pragma unroll
                for (int w = 0; w < 8; ++w) s2 += red[(w * 5 + F.wave) * 64 + F.lane];
                MOD[(l * 5 + F.wave) * 6144 + col] = s2; }
            __syncthreads();
        }
    }
    for (int it = blockIdx.x; it < 96; it += F.G) {
        const int l = it / 48, e = (it % 48) / 3, which = it % 3;
        float ss = 0.f;
        if (which < 2) { const float* W = (which ? a->in[I_WU] : a->in[I_WG]) + ((size_t)l * NE + e) * 1024 * 2048;
            for (int i = 0; i < 32; ++i) { const f32x4 v = *(const f32x4*)(W + (size_t)(32 * i) * 2048 + 4 * F.tid); ss += (v.x * v.x + v.y * v.y) + (v.z * v.z + v.w * v.w); } }
        else { const float* W = a->in[I_WD] + ((size_t)l * NE + e) * 2048 * 1024;
            for (int i = 0; i < 64; ++i) { const f32x2 v = *(const f32x2*)(W + (size_t)(32 * i) * 1024 + 2 * F.tid); ss += v.x * v.x + v.y * v.y; } }
        ss = wave_sum(ss);
        LAS float* red = (LAS float*)F.lds;
        if (F.lane == 0) red[F.wave] = ss;
        __syncthreads();
        if (F.tid == 0) { float t = 0.f; for (int w = 0; w < NWAVES; ++w) t += red[w]; const float rms = fmaxf(sqrtf(t * (1.0f / 65536.0f)), 1e-20f);
            ((float*)(ws + WS_SW))[l * 48 + 3 * e + which] = (which < 2) ? 5.0f * rms * (1.0f / 127.0f) : rms * (1.0f / 16.0f); }
        __syncthreads();
    }
    if ((int)blockIdx.x == 192 % F.G && F.wave == 0) {
        float* LAM = (float*)(ws + WS_LAM);
        for (int l = 0; l < NLAYER; ++l) {
            const float p1 = F.lane < 32 ? a->in[I_LQ1][l * 32 + F.lane] * a->in[I_LK1][l * 32 + F.lane] : 0.f;
            const float p2 = F.lane < 32 ? a->in[I_LQ2][l * 32 + F.lane] * a->in[I_LK2][l * 32 + F.lane] : 0.f;
            const float s1 = wave_sum(p1), s2 = wave_sum(p2);
            const float li = 0.8f - 0.6f * expf(-0.3f * (float)l);
            if (F.lane == 0) { LAM[2 * l] = expf(s1) - expf(s2) + li; LAM[2 * l + 1] = li; }
        }
    }
    if ((int)blockIdx.x == 193 % F.G) {
        f32x2* TA_R = (f32x2*)(ws + WS_TAB + TAB_AROW); f32x2* TA_C = (f32x2*)(ws + WS_TAB + TAB_ACOL); f32x2* TG_R = (f32x2*)(ws + WS_TAB + TAB_GROW); f32x2* TG_C = (f32x2*)(ws + WS_TAB + TAB_GCOL);
        const double b8 = 1.0 / __builtin_sqrt(__builtin_sqrt(__builtin_sqrt(10000.0))), b16 = 1.0 / __builtin_sqrt(__builtin_sqrt(__builtin_sqrt(__builtin_sqrt(10000.0))));
        for (int e = F.tid; e < 4608; e += NWAVES * 64) {
            int pos, i, nf; f32x2* dst;
            if (e < 1024) { pos = e >> 3; i = e & 7; nf = 8; dst = TA_R + e; }
            else if (e < 1536) { const int r = e - 1024; pos = r >> 3; i = r & 7; nf = 8; dst = TA_C + r; }
            else if (e < 3584) { const int r = e - 1536; pos = r >> 4; i = r & 15; nf = 16; dst = TG_R + r; }
            else { const int r = e - 3584; pos = r >> 4; i = r & 15; nf = 16; dst = TG_C + r; }
            double inv = 1.0; const double bb = (nf == 8) ? b8 : b16;
            for (int j = 0; j < i; ++j) inv *= bb;
            const float ang = (float)pos * (float)inv;
            float c, s; sincos_d(ang, c, s);
            *dst = (f32x2){c, s};
        }
    }
    for (int it = blockIdx.x; it < 896; it += F.G) {
        const int l = it / 448; int r = it % 448;
        int kb, nb, R, roff, ncols, orow0; const float *Wu, *gg;
        if (r < 192) { kb = r / 6; nb = r % 6; R = 256; roff = 0; ncols = 384; orow0 = ZQ + nb * 64; Wu = a->in[I_WUQ] + (size_t)l * 256 * 384; gg = a->in[I_GCQ] + l * 256; }
        else { r -= 192; kb = r / 8; nb = r % 8; R = 128; roff = 256; ncols = 512; orow0 = ZKV + nb * 64; Wu = a->in[I_WUKV] + (size_t)l * 128 * 512; gg = a->in[I_GCKV] + l * 128; }
        const float* Win = a->in[I_WIN] + (size_t)l * 1024 * INC;
        LAS float* As = (LAS float*)F.lds; LAS float* Bs = As + 32 * 257;
        for (int idx = F.tid; idx < 32 * R; idx += NWAVES * 64) { const int kk = idx / R, rr = idx % R; As[kk * 257 + rr] = Win[(size_t)(kb * 32 + kk) * INC + roff + rr]; }
        for (int idx = F.tid; idx < R * 64; idx += NWAVES * 64) { const int rr = idx >> 6, n = idx & 63; Bs[rr * 64 + n] = gg[rr] * Wu[(size_t)rr * ncols + nb * 64 + n]; }
        __syncthreads();
        const int kk = F.tid & 31, ng = F.tid >> 5;
        f32x4 acc = (f32x4){0.f, 0.f, 0.f, 0.f};
        for (int rr = 0; rr < R; ++rr) { const float av = As[kk * 257 + rr]; const f32x4 bv = *(const LAS f32x4*)(Bs + rr * 64 + ng * 4); acc += av * bv; }
        bf16* Wc = (bf16*)(ws + WS_WCAT) + (size_t)l * ZP * 1024;
#pragma unroll
        for (int j = 0; j < 4; ++j) Wc[(size_t)(orow0 + ng * 4 + j) * 1024 + kb * 32 + kk] = (bf16)(pk2(acc[j], 0.f) & 0xffffu);
        __syncthreads();
    }
    {
        LAS float* scr = (LAS float*)(F.lds + F.wave * 16384);
        const int gw = F.vcu * NWAVES + F.wave, NGW = F.G * NWAVES;
        constexpr int I_IN = 16 * 61, I_O = 16 * 32, PER_L = I_IN + I_O;
        for (int it = gw; it < NLAYER * PER_L; it += NGW) {
            const int l = it / PER_L; int r = it % PER_L;
            if (r < I_IN) { const int kb = r / 61, nb = r % 61; transpose_item(a->in[I_WIN] + (size_t)l * 1024 * INC, INC, (bf16*)(ws + WS_WCAT) + (size_t)l * ZP * 1024, 1024, kb * 64, nb * 32, nb * 32, scr, F.lane); }
            else { r -= I_IN; const int kb = r / 32, nb = r % 32; transpose_item(a->in[I_WO] + (size_t)l * 1024 * 1024, 1024, (bf16*)(ws + WS_WO) + (size_t)l * 1024 * 1024, 1024, kb * 64, nb * 32, nb * 32, scr, F.lane); }
        }
        const int gt = F.vcu * (NWAVES * 64) + F.tid, NGT = F.G * NWAVES * 64;
        constexpr int PADV = (ZP - ZEND) * 1024 * 2 / 16;
        for (int i = gt; i < NLAYER * PADV; i += NGT) { const int l = i / PADV, j = i % PADV; ((v4u*)((bf16*)(ws + WS_WCAT) + ((size_t)l * ZP + ZEND) * 1024))[j] = (v4u){0u, 0u, 0u, 0u}; }
    }
}

__device__ __forceinline__ void phase_a(KA a, Frame& F, int l) {
    relane(F);
    unsigned char* ws = a->ws;
    const float* MOD = (const float*)(ws + WS_MOD);
    const int* INV = (const int*)(ws + WS_INV);
    const bf16* YE = (const bf16*)(ws + WS_YE);
    const bool fin = (l == NLAYER);
    const int nrows = fin ? LROWS : MROWS;
    const int gw = F.vcu * NWAVES + F.wave, NGW = F.G * NWAVES;
#define PA_LOAD(r, XF, XB, IV) do { if (l == 0) { const float* src_ = ((r) >= LROWS) ? a->in[I_CTX] + (size_t)((r) - LROWS) * 1024 : a->in[I_X] + (size_t)(r) * 1024; \
            _Pragma("unroll") for (int j = 0; j < 4; ++j) XF[j] = *(const f32x4*)(src_ + 4 * F.lane + 256 * j); } \
        else { const bf16* xb_ = (const bf16*)(ws + WS_XB) + (size_t)(r) * 1024; _Pragma("unroll") for (int j = 0; j < 4; ++j) XB[j] = *(const v2u*)(xb_ + 4 * F.lane + 256 * j); \
            IV = INV[(size_t)(r) * 16 + (F.lane & 15)]; } } while (0)
    f32x4 cf[4]; v2u cb[4]; int civ = -1;
#pragma unroll
    for (int j = 0; j < 4; ++j) { cf[j] = (f32x4){0.f, 0.f, 0.f, 0.f}; cb[j] = (v2u){0u, 0u}; }
    if (gw < nrows) PA_LOAD(gw, cf, cb, civ);
    for (int row = gw; row < nrows; row += NGW) {
        const bool isc = row >= LROWS; const int v = isc ? 4 : (row >> 13);
        bf16* xb = (bf16*)(ws + WS_XB) + (size_t)row * 1024;
        const int nrow = row + NGW; f32x4 nf[4]; v2u nb[4]; int niv = -1;
#pragma unroll
        for (int j = 0; j < 4; ++j) { nf[j] = cf[j]; nb[j] = cb[j]; }
        if (nrow < nrows) PA_LOAD(nrow, nf, nb, niv);
        f32x4 xv[4];
        if (l == 0) {
#pragma unroll
            for (int j = 0; j < 4; ++j) xv[j] = cf[j]; }
        else {
#pragma unroll
            for (int j = 0; j < 4; ++j) xv[j] = (f32x4){bflo(cb[j].x), bfhi(cb[j].x), bflo(cb[j].y), bfhi(cb[j].y)}; }
        if (l > 0) {
            const float* ga2 = MOD + ((l - 1) * 5 + v) * 6144 + 5 * 1024;
            f32x4 acc[4];
#pragma unroll
            for (int j = 0; j < 4; ++j) acc[j] = (f32x4){0.f, 0.f, 0.f, 0.f};
            unsigned sel = (unsigned)(__ballot(civ >= 0) & 0xFFFFull);
            while (sel) {
                int sl[4]; float on[4];
#pragma unroll
                for (int k = 0; k < 4; ++k) { if (sel) { const int e = __builtin_ctz(sel); sel &= sel - 1u; sl[k] = __builtin_amdgcn_readlane(civ, e); on[k] = 1.0f; } else { sl[k] = sl[0]; on[k] = 0.0f; } }
                v2u w[4][4];
#pragma unroll
                for (int k = 0; k < 4; ++k) { const bf16* yr = YE + (size_t)sl[k] * 1024 + 4 * F.lane;
#pragma unroll
                    for (int j = 0; j < 4; ++j) w[k][j] = *(const v2u*)(yr + 256 * j); }
#pragma unroll
                for (int k = 0; k < 4; ++k)
#pragma unroll
                    for (int j = 0; j < 4; ++j) acc[j] += on[k] * (f32x4){bflo(w[k][j].x), bfhi(w[k][j].x), bflo(w[k][j].y), bfhi(w[k][j].y)};
            }
#pragma unroll
            for (int j = 0; j < 4; ++j) { const f32x4 g = *(const f32x4*)(ga2 + 4 * F.lane + 256 * j); xv[j] += g * acc[j]; }
        }
#pragma unroll
        for (int j = 0; j < 4; ++j) { cf[j] = nf[j]; cb[j] = nb[j]; }
        civ = niv;
        if (fin) {
#pragma unroll
            for (int j = 0; j < 4; ++j) *(f32x4*)(a->out + (size_t)row * 1024 + 4 * F.lane + 256 * j) = xv[j];
            continue; }
#pragma unroll
        for (int j = 0; j < 4; ++j) { v2u w; w.x = pk2(xv[j].x, xv[j].y); w.y = pk2(xv[j].z, xv[j].w); *(v2u*)(xb + 4 * F.lane + 256 * j) = w; }
        float ss = 0.f;
#pragma unroll
        for (int j = 0; j < 4; ++j) ss += (xv[j].x * xv[j].x + xv[j].y * xv[j].y) + (xv[j].z * xv[j].z + xv[j].w * xv[j].w);
        const float rstd = rsqrtf(wave_sum(ss) * (1.0f / 1024.0f) + EPSF);
        const float* g1 = a->in[I_GN1] + l * 1024; const float* sh = MOD + (l * 5 + v) * 6144; const float* sc = sh + 1024;
        float am = 0.f;
#pragma unroll
        for (int j = 0; j < 4; ++j) { const int c0 = 4 * F.lane + 256 * j; const f32x4 g = *(const f32x4*)(g1 + c0), s1 = *(const f32x4*)(sc + c0), b1 = *(const f32x4*)(sh + c0);
            xv[j] = xv[j] * rstd * g * (1.0f + s1) + b1;
            am = fmaxf(fmaxf(am, fmaxf(fabsf(xv[j].x), fabsf(xv[j].y))), fmaxf(fabsf(xv[j].z), fabsf(xv[j].w))); }
#pragma unroll
        for (int o = 1; o < 64; o <<= 1) am = fmaxf(am, __shfl_xor(am, o));
        const float qs = am > 0.f ? 127.0f / am : 0.f;
        signed char* h8 = (signed char*)(ws + WS_H) + (size_t)row * 1024;
#pragma unroll
        for (int j = 0; j < 4; ++j) { const int q0 = (int)__builtin_rintf(xv[j].x * qs), q1 = (int)__builtin_rintf(xv[j].y * qs), q2 = (int)__builtin_rintf(xv[j].z * qs), q3 = (int)__builtin_rintf(xv[j].w * qs);
            *(unsigned*)(h8 + 4 * F.lane + 256 * j) = (unsigned)(q0 & 255) | ((unsigned)(q1 & 255) << 8) | ((unsigned)(q2 & 255) << 16) | ((unsigned)(q3 & 255) << 24); }
        if (F.lane == 0) ((float*)(ws + WS_SA))[row] = am * (1.0f / 127.0f);
    }
#undef PA_LOAD
    if (l == 0) {
        const bf16* Wc = (const bf16*)(ws + WS_WCAT); signed char* W8 = (signed char*)(ws + WS_WCAT8); float* SWC = (float*)(ws + WS_SWC);
        for (int r = gw; r < NLAYER * ZP; r += NGW) {
            float wv[16]; float am = 0.f;
#pragma unroll
            for (int j = 0; j < 2; ++j) { const v4u w = *(const v4u*)(Wc + (size_t)r * 1024 + 8 * F.lane + 512 * j);
                wv[8 * j + 0] = bflo(w.x); wv[8 * j + 1] = bfhi(w.x); wv[8 * j + 2] = bflo(w.y); wv[8 * j + 3] = bfhi(w.y); wv[8 * j + 4] = bflo(w.z); wv[8 * j + 5] = bfhi(w.z); wv[8 * j + 6] = bflo(w.w); wv[8 * j + 7] = bfhi(w.w); }
#pragma unroll
            for (int i = 0; i < 16; ++i) am = fmaxf(am, fabsf(wv[i]));
#pragma unroll
            for (int o = 1; o < 64; o <<= 1) am = fmaxf(am, __shfl_xor(am, o));
            const float qs = am > 0.f ? 127.0f / am : 0.f;
#pragma unroll
            for (int j = 0; j < 2; ++j) { unsigned w0 = 0u, w1 = 0u;
#pragma unroll
                for (int i = 0; i < 4; ++i) { w0 |= ((unsigned)((int)__builtin_rintf(wv[8 * j + i] * qs)) & 255u) << (8 * i); w1 |= ((unsigned)((int)__builtin_rintf(wv[8 * j + 4 + i] * qs)) & 255u) << (8 * i); }
                v2u o; o.x = w0; o.y = w1; *(v2u*)(W8 + (size_t)r * 1024 + 8 * F.lane + 512 * j) = o; }
            if (F.lane == 0) SWC[r] = am * (1.0f / 127.0f);
        }
    }
}

__device__ __forceinline__ void ld8(const bf16* p, float* f) { const v4u w = *(const v4u*)p; f[0] = bflo(w.x); f[1] = bfhi(w.x); f[2] = bflo(w.y); f[3] = bfhi(w.y); f[4] = bflo(w.z); f[5] = bfhi(w.z); f[6] = bflo(w.w); f[7] = bfhi(w.w); }
__device__ __forceinline__ v4u pk8(const float* f) { v4u w; w.x = pk2(f[0], f[1]); w.y = pk2(f[2], f[3]); w.z = pk2(f[4], f[5]); w.w = pk2(f[6], f[7]); return w; }
template <int N> __device__ __forceinline__ float ssq_row(const bf16* p) { float s = 0.f;
#pragma unroll
    for (int c = 0; c < N / 8; ++c) { float f[8]; ld8(p + 8 * c, f);
#pragma unroll
        for (int i = 0; i < 8; ++i) s += f[i] * f[i];
        if ((c & 7) == 7) MEMFENCE(); }
    return s; }
template <int NP> __device__ __forceinline__ void rope_pairs(float* x, const f32x2* trow, const f32x2* tcol) {
#pragma unroll
    for (int i = 0; i < NP; ++i) { const f32x2 cs = (i < NP / 2) ? trow[i] : tcol[i - NP / 2];
        const float x0 = x[2 * i], x1 = x[2 * i + 1]; x[2 * i] = x0 * cs.x - x1 * cs.y; x[2 * i + 1] = x0 * cs.y + x1 * cs.x; }
}
__device__ __forceinline__ void store_v_tile(char* vt, int lane, const float* v  ) {
    char* p = vt + (lane >> 4) * 1024 + ((lane >> 3) & 1) * 512 + (lane & 7) * 64;
#pragma unroll
    for (int d = 0; d < 2; ++d)
#pragma unroll
        for (int c = 0; c < 4; ++c) *(v4u*)(p + d * 4096 + c * 16) = pk8(v + d * 32 + c * 8);
}
template <bool ROPE> __device__ __forceinline__ v4u proc8(v4u w, float r, const float* g, const f32x2* cs, float qs) {
    float f[8] = {bflo(w.x), bfhi(w.x), bflo(w.y), bfhi(w.y), bflo(w.z), bfhi(w.z), bflo(w.w), bfhi(w.w)};
#pragma unroll
    for (int i = 0; i < 8; ++i) f[i] *= r * g[i];
    if (ROPE) {
#pragma unroll
        for (int i = 0; i < 4; ++i) { const f32x2 t = cs[i]; const float x0 = f[2 * i], x1 = f[2 * i + 1]; f[2 * i] = x0 * t.x - x1 * t.y; f[2 * i + 1] = x0 * t.y + x1 * t.x; }
    }
#pragma unroll
    for (int i = 0; i < 8; ++i) f[i] *= qs;
    return pk8(f);
}
__device__ __forceinline__ v2u pk8_f8(const float* f) { int w0 = __builtin_amdgcn_cvt_pk_fp8_f32(f[0], f[1], 0, false); w0 = __builtin_amdgcn_cvt_pk_fp8_f32(f[2], f[3], w0, true);
    int w1 = __builtin_amdgcn_cvt_pk_fp8_f32(f[4], f[5], 0, false); w1 = __builtin_amdgcn_cvt_pk_fp8_f32(f[6], f[7], w1, true); return (v2u){(unsigned)w0, (unsigned)w1}; }
template <bool ROPE> __device__ __forceinline__ v2u proc8f(v4u w, float r, const float* g, const f32x2* cs, float qs) {
    float f[8] = {bflo(w.x), bfhi(w.x), bflo(w.y), bfhi(w.y), bflo(w.z), bfhi(w.z), bflo(w.w), bfhi(w.w)};
#pragma unroll
    for (int i = 0; i < 8; ++i) f[i] *= r * g[i];
    if (ROPE) {
#pragma unroll
        for (int i = 0; i < 4; ++i) { const f32x2 t = cs[i]; const float x0 = f[2 * i], x1 = f[2 * i + 1]; f[2 * i] = x0 * t.x - x1 * t.y; f[2 * i + 1] = x0 * t.y + x1 * t.x; }
    }
#pragma unroll
    for (int i = 0; i < 8; ++i) f[i] *= qs;
    return pk8_f8(f);
}
__device__ __forceinline__ att::i32x6a fp6_group(const v4u& c0, const v4u& c1, const v4u& c2, const v4u& c3) {
    att::u32x16 w; w[0] = c0.x; w[1] = c0.y; w[2] = c0.z; w[3] = c0.w; w[4] = c1.x; w[5] = c1.y; w[6] = c1.z; w[7] = c1.w; w[8] = c2.x; w[9] = c2.y; w[10] = c2.z; w[11] = c2.w; w[12] = c3.x; w[13] = c3.y; w[14] = c3.z; w[15] = c3.w;
    return att::cvt_fp6x32(w); }
__device__ __forceinline__ void store_qgroup(unsigned char* q, const att::i32x6a& g) { *(v2u*)q = (v2u){(unsigned)g[0], (unsigned)g[1]}; *(v2u*)(q + 8) = (v2u){(unsigned)g[2], (unsigned)g[3]}; *(v2u*)(q + 16) = (v2u){(unsigned)g[4], (unsigned)g[5]}; }
__device__ __forceinline__ void store_kgroup(char* kt, int pb, int j, int lane, const att::i32x6a& g) {
    *(v4u*)(kt + j * 1024 + lane * 16) = (v4u){(unsigned)g[0], (unsigned)g[1], (unsigned)g[2], (unsigned)g[3]}; *(v2u*)(kt + pb + j * 512 + lane * 8) = (v2u){(unsigned)g[4], (unsigned)g[5]}; }
__device__ __forceinline__ float ssq8(v4u w) { const float f[8] = {bflo(w.x), bfhi(w.x), bflo(w.y), bfhi(w.y), bflo(w.z), bfhi(w.z), bflo(w.w), bfhi(w.w)}; float s = 0.f;
#pragma unroll
    for (int i = 0; i < 8; ++i) s += f[i] * f[i];
    return s; }
__device__ __forceinline__ v4u scale8(v4u w, float r) { float f[8] = {bflo(w.x), bfhi(w.x), bflo(w.y), bfhi(w.y), bflo(w.z), bfhi(w.z), bflo(w.w), bfhi(w.w)};
#pragma unroll
    for (int i = 0; i < 8; ++i) f[i] *= r;
    return pk8(f); }
__device__ __forceinline__ void store_v_tile_pk(char* vt, int lane, const v4u* w) {
    char* p = vt + (lane >> 4) * 1024 + ((lane >> 3) & 1) * 512 + (lane & 7) * 64;
#pragma unroll
    for (int c = 0; c < 8; ++c) *(v4u*)(p + (c >> 2) * 4096 + (c & 3) * 16) = w[c];
}
__device__ __forceinline__ void store_v_tile_f8(char* vt, int lane, const v4u* w, float sc, LAS unsigned char* scr) {
    LAS unsigned char* p = scr + (2 * ((lane >> 2) & 1) + (lane >> 5)) * 1024 + 4 * ((lane >> 3) & 3) + (lane & 3);
#pragma unroll
    for (int c = 0; c < 8; ++c) { const float f[8] = {bflo(w[c].x), bfhi(w[c].x), bflo(w[c].y), bfhi(w[c].y), bflo(w[c].z), bfhi(w[c].z), bflo(w[c].w), bfhi(w[c].w)};
#pragma unroll
        for (int i = 0; i < 8; i += 2) { const int b8 = __builtin_amdgcn_cvt_pk_fp8_f32(f[i] * sc, f[i + 1] * sc, 0, false);
            p[(8 * c + i) * 16] = (unsigned char)b8; p[(8 * c + i + 1) * 16] = (unsigned char)(b8 >> 8); } }
    LDS_WAIT(); asm volatile("" ::: "memory");
#pragma unroll
    for (int i = 0; i < 4; ++i) *(v4u*)(vt + i * 1024 + lane * 16) = *(const LAS v4u*)(scr + i * 1024 + lane * 16);
    LDS_WAIT(); asm volatile("" ::: "memory");
}
__device__ __forceinline__ void phase_c(KA a, Frame& F, int l) {
    relane(F);
    unsigned char* ws = a->ws;
    const bf16* Z = (const bf16*)(ws + WS_Z); const float* SSQ = (const float*)(ws + WS_SSQ);
    unsigned char* qkv = ws + WS_QKV;
    LAS unsigned char* vscr = (LAS unsigned char*)F.lds + F.wave * 4096;
    const f32x2* TA_R = (const f32x2*)(ws + WS_TAB + TAB_AROW); const f32x2* TA_C = (const f32x2*)(ws + WS_TAB + TAB_ACOL);
    const f32x2* TG_R = (const f32x2*)(ws + WS_TAB + TAB_GROW); const f32x2* TG_C = (const f32x2*)(ws + WS_TAB + TAB_GCOL);
    const int gw = F.vcu * NWAVES + F.wave, NGW = F.G * NWAVES, lane = F.lane;
    for (int id = gw; id < 528 * 32; id += NGW) {
        const int tile = id % 528, job = id / 528;
        const int b = tile / NKT, tt = tile % NKT; const bool isc = tt >= 128;
        const int zrow = isc ? LROWS + b * CL + (tt - 128) * 64 + lane : b * SEQ + tt * 64 + lane;
        const int tok = tt * 64 + lane;
        const bf16* zr = Z + (size_t)zrow * ZP;
        const f32x2* tar = TA_R + (isc ? 0 : tt) * 8; const f32x2* tac = TA_C + lane * 8;
        const f32x2* tgr = TG_R + (isc ? 0 : tt) * 16; const f32x2* tgc = TG_C + lane * 16;
        MEMFENCE();
        if (job < 4) {
            const int h = job;
            float r1; { const f32x4 s0 = *(const f32x4*)(SSQ + (size_t)zrow * 12), s1 = *(const f32x4*)(SSQ + (size_t)zrow * 12 + 4); r1 = rsqrtf((((s0.x + s0.y) + (s0.z + s0.w)) + ((s1.x + s1.y) + (s1.z + s1.w))) * (1.0f / 256.0f) + EPSF); }
            v4u w[12]; float ss = 0.f;
#pragma unroll
            for (int c = 0; c < 12; ++c) { w[c] = *(const v4u*)(zr + ZQ + h * 96 + 8 * c); ss += ssq8(w[c]); }
            MEMFENCE();
            const float r = r1 * rsqrtf(ss * r1 * r1 * (1.0f / 96.0f) + EPSF); const float* g = a->in[I_GMQ] + l * 96;
            const float qs = att::FQ96;
            unsigned char* q = (unsigned char*)(qkv + QO_QM) + ((size_t)(b * 4 + h) * NTOKB + tok) * 72;
#pragma unroll
            for (int gq = 0; gq < 3; ++gq) { v4u o[4];
#pragma unroll
                for (int cc = 0; cc < 4; ++cc) { const int c = 4 * gq + cc;
                    if (c < 8 || isc) o[cc] = proc8<false>(w[c], r, g + 8 * c, nullptr, qs);
                    else o[cc] = proc8<true>(w[c], r, g + 8 * c, (c < 10) ? tar + 4 * (c - 8) : tac + 4 * (c - 10), qs); }
                store_qgroup(q + 24 * gq, fp6_group(o[0], o[1], o[2], o[3])); MEMFENCE(); }
        } else if (job < 8) {
            const int h = job - 4;
            float r1; { const f32x4 s2 = *(const f32x4*)(SSQ + (size_t)zrow * 12 + 8); r1 = rsqrtf(((s2.x + s2.y) + (s2.z + s2.w)) * (1.0f / 128.0f) + EPSF); }
            v4u w[12]; float ss = 0.f, s2 = 0.f;
#pragma unroll
            for (int c = 0; c < 8; ++c) { w[c] = *(const v4u*)(zr + ZKV + h * 128 + 8 * c); ss += ssq8(w[c]); }
#pragma unroll
            for (int c = 0; c < 4; ++c) { w[8 + c] = *(const v4u*)(zr + 384 + 8 * c); s2 += ssq8(w[8 + c]); }
            MEMFENCE();
            const float r2 = rsqrtf((ss * r1 * r1 + s2) * (1.0f / 96.0f) + EPSF); const float* g = a->in[I_GMK] + l * 96;
            char* kt = (char*)(qkv + QO_KM) + ((size_t)(b * 4 + h) * NKT + tt) * 5120;
#pragma unroll
            for (int gq = 0; gq < 3; ++gq) { v4u o[4];
#pragma unroll
                for (int cc = 0; cc < 4; ++cc) { const int c = 4 * gq + cc;
                    if (c < 8) o[cc] = proc8<false>(w[c], r1 * r2, g + 8 * c, nullptr, 1.0f);
                    else if (isc) o[cc] = proc8<false>(w[c], r2, g + 8 * c, nullptr, 1.0f);
                    else o[cc] = proc8<true>(w[c], r2, g + 8 * c, (c < 10) ? tar + 4 * (c - 8) : tac + 4 * (c - 10), 1.0f); }
                store_kgroup(kt, 3072, gq, lane, fp6_group(o[0], o[1], o[2], o[3])); MEMFENCE(); }
            v4u vw[8];
#pragma unroll
            for (int c = 0; c < 8; ++c) vw[c] = *(const v4u*)(zr + ZKV + h * 128 + 64 + 8 * c);
            store_v_tile_f8((char*)(qkv + QO_VM) + ((size_t)(b * 4 + h) * NKT + tt) * 4096, lane, vw, r1, vscr);
        } else if (job < 16) {
            const bool isk = job >= 12; const int h = (job - 8) & 3;
            const bf16* zp = zr + (isk ? 672 : 416) + h * 64; const float* g = (isk ? a->in[I_GDK] : a->in[I_GDQ]) + l * 32;
            const float qs = isk ? 1.0f : att::FQ32;
            v4u w[8]; float ss[2] = {0.f, 0.f};
#pragma unroll
            for (int c = 0; c < 8; ++c) { w[c] = *(const v4u*)(zp + 8 * c); ss[c >> 2] += ssq8(w[c]); }
            MEMFENCE();
            const float r0 = rsqrtf(ss[0] * (1.0f / 32.0f) + EPSF), r1 = rsqrtf(ss[1] * (1.0f / 32.0f) + EPSF);
            char* kt = (char*)(qkv + QO_KD) + ((size_t)(b * 4 + h) * NKT + tt) * 3072;
            unsigned char* q = (unsigned char*)(qkv + QO_QD) + ((size_t)(b * 4 + h) * NTOKB + tok) * 48;
#pragma unroll
            for (int gq = 0; gq < 2; ++gq) { v4u o[4];
#pragma unroll
                for (int cm = 0; cm < 4; ++cm) { const int c = 4 * gq + cm;
                    if (isc) o[cm] = proc8<false>(w[c], gq ? r1 : r0, g + 8 * cm, nullptr, qs);
                    else o[cm] = proc8<true>(w[c], gq ? r1 : r0, g + 8 * cm, (cm < 2) ? tar + 4 * cm : tac + 4 * (cm - 2), qs); }
                const att::i32x6a gr = fp6_group(o[0], o[1], o[2], o[3]);
                if (isk) store_kgroup(kt, 2048, gq, lane, gr); else store_qgroup(q + 24 * gq, gr);
                MEMFENCE(); }
        } else if (job < 20) {
            const int h = job - 16; v4u vw[8];
#pragma unroll
            for (int c = 0; c < 8; ++c) vw[c] = *(const v4u*)(zr + 928 + h * 64 + 8 * c);
            store_v_tile_f8((char*)(qkv + QO_VD) + ((size_t)(b * 4 + h) * NKT + tt) * 4096, lane, vw, 1.0f, vscr);
        } else if (job < 30) {
            const bool isk = job >= 28; const int h = isk ? job - 28 : job - 20;
            const bf16* zp = zr + (isk ? 1696 : 1184) + h * 64; const float* g = (isk ? a->in[I_GGK] : a->in[I_GGQ]) + l * 64;
            const float qs = isk ? 1.0f : att::FQ64;
            v4u w[8]; float ss = 0.f;
#pragma unroll
            for (int c = 0; c < 8; ++c) { w[c] = *(const v4u*)(zp + 8 * c); ss += ssq8(w[c]); }
            MEMFENCE();
            const float r = rsqrtf(ss * (1.0f / 64.0f) + EPSF);
            char* kt = (char*)(qkv + QO_KG) + ((size_t)(b * 2 + h) * NKT + tt) * 3072;
            unsigned char* q = (unsigned char*)(qkv + QO_QG) + ((size_t)(b * 8 + h) * NTOKB + tok) * 48;
#pragma unroll
            for (int gq = 0; gq < 2; ++gq) { v4u o[4];
#pragma unroll
                for (int cc = 0; cc < 4; ++cc) { const int c = 4 * gq + cc;
                    if (isc) o[cc] = proc8<false>(w[c], r, g + 8 * c, nullptr, qs);
                    else o[cc] = proc8<true>(w[c], r, g + 8 * c, (c < 4) ? tgr + 4 * c : tgc + 4 * (c - 4), qs); }
                const att::i32x6a gr = fp6_group(o[0], o[1], o[2], o[3]);
                if (isk) store_kgroup(kt, 2048, gq, lane, gr); else store_qgroup(q + 24 * gq, gr);
                MEMFENCE(); }
        } else {
            const int h = job - 30; v4u vw[8];
#pragma unroll
            for (int c = 0; c < 8; ++c) vw[c] = *(const v4u*)(zr + 1824 + h * 64 + 8 * c);
            store_v_tile_f8((char*)(qkv + QO_VG) + ((size_t)(b * 2 + h) * NKT + tt) * 4096, lane, vw, 1.0f, vscr);
        }
        MEMFENCE();
    }
}

#define ATT_UNIT(KD, NM) att::attn_unit_f8<KD, NM, ABL>
#define ATT_DIFF att::attn_unit_f8<32, 2, ABL>
template <int ABL>
__device__ __forceinline__ void phase_d(KA a, Frame& F, int l, bool last) {
    relane(F);
    unsigned char* ws = a->ws; unsigned char* qkv = ws + WS_QKV;
    bf16* ATT = (bf16*)(ws + (ABL ? WS_Z : WS_ATT));
    const float* LAM = (const float*)(ws + WS_LAM);
    const float lam = LAM[2 * l], oml = 1.0f - LAM[2 * l + 1];
    const float* gdo = a->in[I_GDO] + l * 64;
    ALDS char* lds = (ALDS char*)F.lds;
    const int nctx = last ? 0 : 64;
    for (int id = F.vcu; id < 512 + nctx; id += F.G) {
        int b, h, q0, t0, t1; size_t orow;
        if (id < 512) { const int x = (id & 255) >> 5; b = x >> 1; h = 2 * (x & 1) + (id >> 8); q0 = (id & 31) * 256; t0 = 0; t1 = NKT; orow = (size_t)b * SEQ + q0; }
        else { const int c = id - 512; b = c >> 4; h = c & 15; if (h >= 4) continue; q0 = SEQ; t0 = 128; t1 = NKT; orow = (size_t)LROWS + b * CL; }
        ATT_UNIT(96, 1)((const unsigned char*)(qkv + QO_QM) + ((size_t)(b * 4 + h) * NTOKB + q0) * 72, (const char*)(qkv + QO_KM) + (size_t)(b * 4 + h) * NKT * 5120,
                        (const char*)(qkv + QO_VM) + (size_t)(b * 4 + h) * NKT * 4096, t0, t1, ATT + orow * 1024 + h * 64, lds, 0.f, gdo, 0.f);
    }
    for (int id = 512 + F.vcu; id < 1024 + nctx; id += F.G) {
        int b, h, q0, t0, t1; size_t orow;
        if (id < 1024) { const int x = (id & 255) >> 5; b = x >> 1; h = 2 * (x & 1) + ((id >> 8) - 2); q0 = (id & 31) * 256; t0 = 0; t1 = NKT; orow = (size_t)b * SEQ + q0; }
        else { const int c = id - 1024; b = c >> 4; h = (c & 15) - 4; if (h < 0 || h >= 4) continue; q0 = SEQ; t0 = 128; t1 = NKT; orow = (size_t)LROWS + b * CL; }
        ATT_DIFF((const unsigned char*)(qkv + QO_QD) + ((size_t)(b * 4 + h) * NTOKB + q0) * 48, (const char*)(qkv + QO_KD) + (size_t)(b * 4 + h) * NKT * 3072,
                        (const char*)(qkv + QO_VD) + (size_t)(b * 4 + h) * NKT * 4096, t0, t1, ATT + orow * 1024 + 256 + h * 64, lds, lam, gdo, oml);
    }
    for (int id = 1024 + F.vcu; id < 2048 + nctx; id += F.G) {
        int b, h, q0, t0, t1; size_t orow;
        if (id < 2048) { const int x = (id & 255) >> 5; b = x >> 1; h = 4 * (x & 1) + ((id >> 8) - 4); q0 = (id & 31) * 256; t0 = 0; t1 = NKT; orow = (size_t)b * SEQ + q0; }
        else { const int c = id - 2048; b = c >> 4; h = (c & 15) - 8; if (h < 0) continue; q0 = SEQ; t0 = 128; t1 = NKT; orow = (size_t)LROWS + b * CL; }
        const int g = h >> 2;
        ATT_UNIT(64, 1)((const unsigned char*)(qkv + QO_QG) + ((size_t)(b * 8 + h) * NTOKB + q0) * 48, (const char*)(qkv + QO_KG) + (size_t)(b * 2 + g) * NKT * 3072,
                        (const char*)(qkv + QO_VG) + (size_t)(b * 2 + g) * NKT * 4096, t0, t1, ATT + orow * 1024 + 512 + h * 64, lds, 0.f, gdo, 0.f);
    }
}

template <int RB>
__device__ __forceinline__ void pf_rows(KA a, Frame& F, int l, int rbeg, int nrows, LAS float* wrT) {
    unsigned char* ws = a->ws;
    const float* MOD = (const float*)(ws + WS_MOD);
    float* AFF = (float*)(ws + WS_AFF); float* AFFC = (float*)(ws + WS_AFFC); int* INV = (int*)(ws + WS_INV);
    const int gw = F.vcu * NWAVES + F.wave, NGW = F.G * NWAVES;
#define PF_LOAD(r, XW, DW) do { const bf16* xb_ = (const bf16*)(ws + WS_XB) + (size_t)(r) * 1024; const bf16* dl_ = (const bf16*)(ws + WS_DELTA) + (size_t)(r) * 1024; \
        _Pragma("unroll") for (int j = 0; j < 4; ++j) { XW[j] = *(const v2u*)(xb_ + 4 * F.lane + 256 * j); DW[j] = *(const v2u*)(dl_ + 4 * F.lane + 256 * j); } } while (0)
    v2u cxw[RB][4], cdw[RB][4];
#pragma unroll
    for (int u = 0; u < RB; ++u)
#pragma unroll
        for (int j = 0; j < 4; ++j) { cxw[u][j] = (v2u){0u, 0u}; cdw[u][j] = (v2u){0u, 0u}; }
    if (rbeg + gw * RB < nrows) {
#pragma unroll
        for (int u = 0; u < RB; ++u) PF_LOAD(rbeg + gw * RB + u, cxw[u], cdw[u]); }
    for (int grp = gw; rbeg + grp * RB < nrows; grp += NGW) {
        const int row0 = rbeg + grp * RB; const bool isc = row0 >= LROWS; const int v = isc ? 4 : (row0 >> 13);
        f32x4 hv[RB][4]; float ss[RB];
#pragma unroll
        for (int u = 0; u < RB; ++u) { bf16* xb = (bf16*)(ws + WS_XB) + (size_t)(row0 + u) * 1024; ss[u] = 0.f;
#pragma unroll
            for (int j = 0; j < 4; ++j) { const int c0 = 4 * F.lane + 256 * j; const v2u w = cdw[u][j], xw = cxw[u][j];
                hv[u][j] = (f32x4){bflo(xw.x), bfhi(xw.x), bflo(xw.y), bfhi(xw.y)} + (f32x4){bflo(w.x), bfhi(w.x), bflo(w.y), bfhi(w.y)};
                v2u o; o.x = pk2(hv[u][j].x, hv[u][j].y); o.y = pk2(hv[u][j].z, hv[u][j].w); *(v2u*)(xb + c0) = o;
                ss[u] += (hv[u][j].x * hv[u][j].x + hv[u][j].y * hv[u][j].y) + (hv[u][j].z * hv[u][j].z + hv[u][j].w * hv[u][j].w); } }
        { const int ngrp = grp + NGW;
          if (rbeg + ngrp * RB < nrows) {
#pragma unroll
              for (int u = 0; u < RB; ++u) PF_LOAD(rbeg + ngrp * RB + u, cxw[u], cdw[u]); } }
        float rstd[RB];
#pragma unroll
        for (int u = 0; u < RB; ++u) rstd[u] = rsqrtf(wave_sum(ss[u]) * (1.0f / 1024.0f) + EPSF);
        const float* g2 = a->in[I_GN2] + l * 1024; const float* sh = MOD + (l * 5 + v) * 6144 + 3 * 1024; const float* sc = sh + 1024;
        float am[RB];
#pragma unroll
        for (int u = 0; u < RB; ++u) am[u] = 0.f;
#pragma unroll
        for (int j = 0; j < 4; ++j) { const int c0 = 4 * F.lane + 256 * j; const f32x4 g = *(const f32x4*)(g2 + c0), s1 = *(const f32x4*)(sc + c0), b1 = *(const f32x4*)(sh + c0);
#pragma unroll
            for (int u = 0; u < RB; ++u) { hv[u][j] = hv[u][j] * rstd[u] * g * (1.0f + s1) + b1;
                am[u] = fmaxf(fmaxf(am[u], fmaxf(fabsf(hv[u][j].x), fabsf(hv[u][j].y))), fmaxf(fabsf(hv[u][j].z), fabsf(hv[u][j].w))); } }
#pragma unroll
        for (int o = 1; o < 64; o <<= 1) {
#pragma unroll
            for (int u = 0; u < RB; ++u) am[u] = fmaxf(am[u], __shfl_xor(am[u], o)); }
#pragma unroll
        for (int u = 0; u < RB; ++u) { const float qs = am[u] > 0.f ? 127.0f / am[u] : 0.f;
            signed char* h8 = (signed char*)(ws + WS_H) + (size_t)(row0 + u) * 1024;
#pragma unroll
            for (int j = 0; j < 4; ++j) { const int q0 = (int)__builtin_rintf(hv[u][j].x * qs), q1 = (int)__builtin_rintf(hv[u][j].y * qs), q2 = (int)__builtin_rintf(hv[u][j].z * qs), q3 = (int)__builtin_rintf(hv[u][j].w * qs);
                *(unsigned*)(h8 + 4 * F.lane + 256 * j) = (unsigned)(q0 & 255) | ((unsigned)(q1 & 255) << 8) | ((unsigned)(q2 & 255) << 16) | ((unsigned)(q3 & 255) << 24); }
            if (F.lane == 0) ((float*)(ws + WS_SA))[row0 + u] = am[u] * (1.0f / 127.0f); }
        float p[RB][16];
#pragma unroll
        for (int e = 0; e < 16; ++e) { float sacc[RB];
#pragma unroll
            for (int u = 0; u < RB; ++u) sacc[u] = 0.f;
#pragma unroll
            for (int j = 0; j < 4; ++j) { const f32x4 w = *(const LAS f32x4*)(wrT + e * 1024 + 4 * F.lane + 256 * j);
#pragma unroll
                for (int u = 0; u < RB; ++u) sacc[u] += (hv[u][j].x * w.x + hv[u][j].y * w.y) + (hv[u][j].z * w.z + hv[u][j].w * w.w); }
#pragma unroll
            for (int u = 0; u < RB; ++u) p[u][e] = sacc[u];
            if ((e & 3) == 3) MEMFENCE(); }
        float lgt[RB];
#pragma unroll
        for (int u = 0; u < RB; ++u) { float r8[8], r4[4], r2[2];
          { const bool hb = (F.lane & 32) != 0;
#pragma unroll
            for (int j = 0; j < 8; ++j) { const float keep = hb ? p[u][8 + j] : p[u][j], send = hb ? p[u][j] : p[u][8 + j]; r8[j] = keep + __shfl_xor(send, 32); } }
          { const bool hb = (F.lane & 16) != 0;
#pragma unroll
            for (int j = 0; j < 4; ++j) { const float keep = hb ? r8[4 + j] : r8[j], send = hb ? r8[j] : r8[4 + j]; r4[j] = keep + __shfl_xor(send, 16); } }
          { const bool hb = (F.lane & 8) != 0;
#pragma unroll
            for (int j = 0; j < 2; ++j) { const float keep = hb ? r4[2 + j] : r4[j], send = hb ? r4[j] : r4[2 + j]; r2[j] = keep + __shfl_xor(send, 8); } }
          { const bool hb = (F.lane & 4) != 0; const float keep = hb ? r2[1] : r2[0], send = hb ? r2[0] : r2[1]; lgt[u] = keep + __shfl_xor(send, 4); }
          lgt[u] += __shfl_xor(lgt[u], 1); lgt[u] += __shfl_xor(lgt[u], 2); }
        float mx[RB], ex[RB], sum[RB];
#pragma unroll
        for (int u = 0; u < RB; ++u) mx[u] = lgt[u];
#pragma unroll
        for (int o = 4; o < 64; o <<= 1) {
#pragma unroll
            for (int u = 0; u < RB; ++u) mx[u] = fmaxf(mx[u], __shfl_xor(mx[u], o)); }
#pragma unroll
        for (int u = 0; u < RB; ++u) { ex[u] = __builtin_amdgcn_exp2f((lgt[u] - mx[u]) * LOG2E); sum[u] = ex[u]; }
#pragma unroll
        for (int o = 4; o < 64; o <<= 1) {
#pragma unroll
            for (int u = 0; u < RB; ++u) sum[u] += __shfl_xor(sum[u], o); }
        const int ee = ((F.lane >> 5) & 1) * 8 + ((F.lane >> 4) & 1) * 4 + ((F.lane >> 3) & 1) * 2 + ((F.lane >> 2) & 1);
#pragma unroll
        for (int u = 0; u < RB; ++u) { const float mine = ex[u] / sum[u]; const int row = row0 + u;
            if ((F.lane & 3) == 0) {
                if (isc) { const int r = row - LROWS; AFFC[((size_t)((r >> 8) * 16 + ee)) * CL + (r & 255)] = mine; }
                else AFF[((size_t)((row >> 13) * 16 + ee)) * SEQ + (row & 8191)] = mine;
                INV[(size_t)row * 16 + ee] = -1;
            } }
    }
#undef PF_LOAD
}


__device__ __forceinline__ void phase_f(KA a, Frame& F, int l, bool last) {
    relane(F);
    unsigned char* ws = a->ws;
    const float* MOD = (const float*)(ws + WS_MOD);
    float* AFF = (float*)(ws + WS_AFF); float* AFFC = (float*)(ws + WS_AFFC); int* INV = (int*)(ws + WS_INV);
    LAS float* wrT = (LAS float*)F.lds;
    const float* wr = a->in[I_WR] + (size_t)l * 1024 * 16;
    for (int idx = F.tid; idx < 16384; idx += NWAVES * 64) wrT[(idx & 15) * 1024 + (idx >> 4)] = wr[idx];
    __syncthreads();
    pf_rows<4>(a, F, l, 0, LROWS, wrT);
    if (!last) pf_rows<1>(a, F, l, LROWS, MROWS, wrT);
}

__device__ __forceinline__ void topk_set(Frame& F, const float* __restrict__ src, int n, int k, int rowbase, int slotbase, int e, int* IDX, float* GATE, int* INV, const float* SA, float* SAE) {
    LAS unsigned* keys = (LAS unsigned*)F.lds; LAS unsigned* hist = keys + 8192; LAS unsigned* sc = hist + 256;
    const int tid = F.tid;
    for (int i = tid; i < n; i += NWAVES * 64) keys[i] = __float_as_uint(src[i]);
    if (tid == 0) { unsigned z_ = 0u, k_ = (unsigned)k; asm volatile("" : "+v"(z_), "+v"(k_)); sc[0] = z_; sc[1] = k_; }
    __syncthreads();
    for (int pass = 0; pass < 4; ++pass) {
        const int shift = 24 - 8 * pass; const unsigned mask = (pass == 0) ? 0u : (0xFFFFFFFFu << (shift + 8));
        if (tid < 256) hist[tid] = 0u;
        __syncthreads();
        const unsigned prefix = sc[0];
        for (int i = tid; i < n; i += NWAVES * 64) { const unsigned kv = keys[i]; if ((kv & mask) == prefix) __hip_atomic_fetch_add(&hist[(kv >> shift) & 255u], 1u, __ATOMIC_RELAXED, __HIP_MEMORY_SCOPE_WORKGROUP); }
        __syncthreads();
        if (F.wave == 0) {
            const unsigned need = sc[1]; unsigned h[4]; unsigned tot = 0u;
#pragma unroll
            for (int j = 0; j < 4; ++j) { h[j] = hist[255 - (4 * F.lane + j)]; tot += h[j]; }
            unsigned incl = tot;
#pragma unroll
            for (int d = 1; d < 64; d <<= 1) { const unsigned t = __shfl_up(incl, d); if (F.lane >= d) incl += t; }
            unsigned cum = incl - tot;
#pragma unroll
            for (int j = 0; j < 4; ++j) { if (cum < need && need <= cum + h[j]) { sc[0] = prefix | ((unsigned)(255 - (4 * F.lane + j)) << shift); sc[1] = need - cum; } cum += h[j]; }
        }
        __syncthreads();
    }
    const unsigned T = sc[0], need_eq = sc[1];
    const int per = (n + NWAVES * 64 - 1) / (NWAVES * 64), start = tid * per;
    unsigned cg = 0u, ce = 0u;
    for (int j = 0; j < per; ++j) { const int i = start + j; if (i < n) { const unsigned kv = keys[i]; cg += (kv > T) ? 1u : 0u; ce += (kv == T) ? 1u : 0u; } }
    const unsigned packed = cg | (ce << 16);
    unsigned incl = packed;
#pragma unroll
    for (int d = 1; d < 64; d <<= 1) { const unsigned t = __shfl_up(incl, d); if (F.lane >= d) incl += t; }
    if (F.lane == 63) sc[8 + F.wave] = incl;
    __syncthreads();
    unsigned base = 0u;
    for (int w = 0; w < F.wave; ++w) base += sc[8 + w];
    const unsigned excl = base + incl - packed;
    unsigned gb = excl & 0xFFFFu, eb = excl >> 16;
    for (int j = 0; j < per; ++j) { const int i = start + j; if (i < n) { const unsigned kv = keys[i]; const bool g = kv > T, q = kv == T;
        if (g || (q && eb < need_eq)) { const int slot = slotbase + (int)(gb + (eb < need_eq ? eb : need_eq)); IDX[slot] = rowbase + i; GATE[slot] = __uint_as_float(kv); SAE[slot] = SA[rowbase + i]; INV[(size_t)(rowbase + i) * 16 + e] = slot; }
        gb += g ? 1u : 0u; eb += q ? 1u : 0u; } }
    __syncthreads();
}
struct CvtItem { const float* wp; int N; unsigned char* wt; int ldt; float qs; int f8; };
__device__ __forceinline__ void cvt_load(const CvtItem& I, float (&tv)[32]) {
#pragma unroll
    for (int i = 0; i < 32; ++i) tv[i] = __builtin_nontemporal_load(I.wp + (size_t)(2 * i) * I.N);
}
__device__ __forceinline__ void cvt_store(const CvtItem& I, const float (&tv)[32], LAS float* scr, int lane) {
#pragma unroll
    for (int i = 0; i < 32; ++i) scr[(2 * i + (lane >> 5)) * 33 + (lane & 31)] = tv[i];
    LDS_WAIT(); asm volatile("" ::: "memory");
    const int c = lane & 3;
#pragma unroll
    for (int j = 0; j < 2; ++j) { const int n = (lane >> 2) + 16 * j; const LAS float* sp = scr + (16 * c) * 33 + n; v4u o;
        if (I.f8) {
#pragma unroll
            for (int d = 0; d < 4; ++d) { float f[4];
#pragma unroll
                for (int i = 0; i < 4; ++i) f[i] = fminf(fmaxf(sp[(4 * d + i) * 33] * I.qs, -448.0f), 448.0f);
                int w = __builtin_amdgcn_cvt_pk_fp8_f32(f[0], f[1], 0, false); w = __builtin_amdgcn_cvt_pk_fp8_f32(f[2], f[3], w, true); o[d] = (unsigned)w; }
        } else {
#pragma unroll
            for (int d = 0; d < 4; ++d) { unsigned w = 0u;
#pragma unroll
                for (int i = 0; i < 4; ++i) { const float f = fminf(fmaxf(sp[(4 * d + i) * 33] * I.qs, -127.0f), 127.0f); w |= ((unsigned)((int)__builtin_rintf(f)) & 255u) << (8 * i); }
                o[d] = w; }
        }
        *(v4u*)(I.wt + (size_t)n * I.ldt + 16 * c) = o; }
    LDS_WAIT(); asm volatile("" ::: "memory");
}
__device__ __forceinline__ void phase_g(KA a, Frame& F, int l, bool last, int rep) {
    relane(F);
    unsigned char* ws = a->ws;
    const float* AFF = (const float*)(ws + WS_AFF); const float* AFFC = (const float*)(ws + WS_AFFC);
    int* IDX = (int*)(ws + WS_IDX); float* GATE = (float*)(ws + WS_GATE); int* INV = (int*)(ws + WS_INV);
    const float* SA = (const float*)(ws + WS_SA); float* SAE = (float*)(ws + WS_SAE);
    const int RPE = last ? 4096 : 4352, nsets = last ? 64 : 128;
    for (int set = blockIdx.x; set < nsets; set += F.G) {
        if (set < 64) { const int b = set >> 4, e = set & 15; topk_set(F, AFF + (size_t)set * SEQ, SEQ, CAPL, b * SEQ, e * RPE + b * CAPL, e, IDX, GATE, INV, SA, SAE); }
        else { const int s2 = set - 64, b = s2 >> 4, e = s2 & 15; topk_set(F, AFFC + (size_t)s2 * CL, CL, CAPC, LROWS + b * CL, e * RPE + 4096 + b * CAPC, e, IDX, GATE, INV, SA, SAE);
            if (b == 0 && F.tid < 128) { IDX[e * RPE + 4224 + F.tid] = -1; GATE[e * RPE + 4224 + F.tid] = 0.f; SAE[e * RPE + 4224 + F.tid] = 0.f; } }
    }
    {
        LAS float* scr = (LAS float*)(F.lds + 40960 + F.wave * 8704);
        gu32* head = F.ctl + CW_Q + 64 * l + 128 * rep;
        constexpr int NIT = NE * 3072;
        const float* wg = a->in[I_WG] + (size_t)l * NE * 1024 * 2048; const float* wu = a->in[I_WU] + (size_t)l * NE * 1024 * 2048; const float* wd = a->in[I_WD] + (size_t)l * NE * 2048 * 1024;
        const float* SWL = (const float*)(ws + WS_SW) + l * 48;
        for (;;) {
            unsigned basev = 0u;
            if (F.lane == 0) basev = __hip_atomic_fetch_add(head, 8u, RLX_AGENT);
            const int base = __builtin_amdgcn_readfirstlane((int)basev);
            if (base >= NIT) break;
#define CVT_SETUP(I, j) do { const int it_ = base + (j); const int e_ = it_ / 3072, r_ = it_ % 3072, which_ = r_ >> 10, ii_ = r_ & 1023; \
                if (which_ < 2) { const int kb_ = ii_ >> 6, n0_ = (ii_ & 63) * 32; const int rowbase_ = (n0_ >> 7) * 256 + (n0_ & 127) + which_ * 128; \
                    I.wp = (which_ ? wu : wg) + (size_t)e_ * 1024 * 2048 + (size_t)(kb_ * 64 + (F.lane >> 5)) * 2048 + n0_ + (F.lane & 31); I.N = 2048; \
                    I.wt = (unsigned char*)(ws + WS_WGU) + (size_t)e_ * 4096 * 1024 + (size_t)rowbase_ * 1024 + kb_ * 64; I.ldt = 1024; I.qs = 1.0f / SWL[3 * e_ + which_]; I.f8 = 0; } \
                else { const int kb_ = ii_ >> 5, n0_ = (ii_ & 31) * 32; \
                    I.wp = wd + (size_t)e_ * 2048 * 1024 + (size_t)(kb_ * 64 + (F.lane >> 5)) * 1024 + n0_ + (F.lane & 31); I.N = 1024; \
                    I.wt = (unsigned char*)(ws + WS_WD) + (size_t)e_ * 1024 * 2048 + (size_t)n0_ * 2048 + kb_ * 64; I.ldt = 2048; I.qs = 1.0f / SWL[3 * e_ + 2]; I.f8 = 1; } } while (0)
            CvtItem IA, IB; float tvA[32], tvB[32];
            CVT_SETUP(IA, 0); cvt_load(IA, tvA);
#pragma unroll
            for (int jj = 0; jj < 4; ++jj) {
                CVT_SETUP(IB, 2 * jj + 1); cvt_load(IB, tvB);
                cvt_store(IA, tvA, scr, F.lane);
                if (jj < 3) { CVT_SETUP(IA, 2 * jj + 2); cvt_load(IA, tvA); }
                cvt_store(IB, tvB, scr, F.lane);
            }
#undef CVT_SETUP
        }
    }
}

__global__ void __launch_bounds__(NWAVES * 64, 2) mk_fwd(Args args) {
    extern __shared__ __attribute__((aligned(16))) unsigned char lds[];
    Frame F;
    F.lds = (LAS unsigned char*)lds;
    F.MISC = (volatile LAS unsigned*)(F.lds + MISC_OFF);
    F.tid = threadIdx.x; F.lane = F.tid & 63; F.wave = __builtin_amdgcn_readfirstlane(F.tid >> 6);
    F.G = gridDim.x; { const int bx = blockIdx.x; F.vcu = (F.G % 8 == 0) ? (bx % 8) * (F.G / 8) + bx / 8 : bx; }
    F.ctl = (gu32*)(args.ws + WS_CTL);
    for (int u = F.tid; u < (LDS_BYTES - LDSCTL_OFF) / 4; u += NWAVES * 64) ((LAS unsigned*)(F.lds + LDSCTL_OFF))[u] = 0u;
    __syncthreads();
    const int lo = args.ph_lo, hi = args.ph_hi;
    const bool multi = (hi - lo) > 1;
    XcdBarrier bar; bar.bar = (unsigned*)(F.ctl + CW_BAR); bar.x = 0; bar.st = nullptr;
    if (multi) bar = xcd_barrier_post((unsigned*)(F.ctl + CW_BAR), F.MISC + 8);
#define IN(k) (lo <= (k) && (k) < hi)
#define SEAM(k) do { if (IN((k) + 1)) xcd_barrier(bar); } while (0)
#define REP(kind) (((MK_REP) >> (kind)) & 1)
#define RUNPH(kind, k, ...) do { if (IN(k)) { for (int rep_ = 0; rep_ <= REP(kind); ++rep_) { __VA_ARGS__; if (rep_ < REP(kind)) xcd_barrier(bar); } SEAM(k); } } while (0)

    RUNPH(0, 0, p0_prologue(kargs(), F));

    for (int l = 0; l < NLAYER; ++l) {
        const bool last = (l == NLAYER - 1);
        const int pb = 1 + 10 * l;
        const int RPE = last ? 4096 : 4352;
        if (IN(pb + 0)) { for (int rep_ = 0; rep_ <= (l == 0 ? REP(1) : 0); ++rep_) { phase_a(kargs(), F, l); if (rep_ < REP(1) && l == 0) xcd_barrier(bar); } SEAM(pb + 0); }
        if (IN(pb + 1)) { for (int rep_ = 0; rep_ <= REP(2); ++rep_) {
            KA ka = kargs(); unsigned char* ws = ka->ws;
            pg8::Gemm g{(const pg8::bf16_t*)(ws + WS_H), (const pg8::bf16_t*)(ws + WS_WCAT8 + (size_t)l * ZP * 1024), MROWS, ZP, DM / 2, 1 << 30, 0};
            pg8::StaticOrder S; S.init(MROWS, ZP, F.G, (int)blockIdx.x);
            pg8::EpiStoreBf16I8 E{(pg8::bf16_t*)(ws + WS_Z), ZP, (const float*)(ws + WS_SA), (const float*)(ws + WS_SWC) + (size_t)l * ZP, (float*)(ws + WS_SSQ)};
            pg8::gemm_phase<pg8::EpiStoreBf16I8, pg8::StaticOrder, true, true, 1>(F.lds, g, S, E);
            if (rep_ < REP(2)) xcd_barrier(bar); }
            SEAM(pb + 1);
        }
        RUNPH(3, pb + 2, phase_c(kargs(), F, l));
        RUNPH(4, pb + 3, phase_d<0>(kargs(), F, l, last); if (MK_ABL) { xcd_barrier(bar); phase_d<MK_ABL>(kargs(), F, l, last); });
        if (IN(pb + 4)) { for (int rep_ = 0; rep_ <= REP(5); ++rep_) {
            KA ka = kargs(); unsigned char* ws = ka->ws; const float* MODL = (const float*)(ws + WS_MOD) + (size_t)l * 5 * 6144;
            const int M = last ? LROWS : MROWS;
            pg8::Gemm g{(const pg8::bf16_t*)(ws + WS_ATT), (const pg8::bf16_t*)(ws + WS_WO) + (size_t)l * 1024 * 1024, M, DM, DM, 1 << 30, 0};
            pg8::StaticOrder S; S.init(M, DM, F.G, (int)blockIdx.x);
            pg8::EpiColGateBf16 E{(pg8::bf16_t*)(ws + WS_DELTA), DM, MODL, LROWS};
            pg8::gemm_phase<pg8::EpiColGateBf16, pg8::StaticOrder, true, true>(F.lds, g, S, E);
            if (rep_ < REP(5)) xcd_barrier(bar); }
            SEAM(pb + 4);
        }
        RUNPH(6, pb + 5, phase_f(kargs(), F, l, last));
        RUNPH(7, pb + 6, phase_g(kargs(), F, l, last, rep_));
        if (IN(pb + 8)) { for (int rep_ = 0; rep_ <= REP(9); ++rep_) {
            KA ka = kargs(); unsigned char* ws = ka->ws;
            pg8::Gemm g{(const pg8::bf16_t*)(ws + WS_H), (const pg8::bf16_t*)(ws + WS_WGU), NE * RPE, 2 * FFD, DM / 2, RPE / 256, (size_t)2 * FFD * DM, (const int*)(ws + WS_IDX)};
            pg8::StaticOrder S; S.init(NE * RPE, 2 * FFD, F.G, (int)blockIdx.x);
            pg8::EpiSwiGLUI8 E{(unsigned char*)(ws + WS_HID), FFD, (const float*)(ws + WS_SAE), (const float*)(ws + WS_SW) + l * 48, RPE / 256, HID_SCALE};
            if (MK_NOEPI && rep_ == 1) { pg8::EpiNullI8 EN{}; pg8::gemm_phase<pg8::EpiNullI8, pg8::StaticOrder, true, true, 1, true>(F.lds, g, S, EN); }
            else pg8::gemm_phase<pg8::EpiSwiGLUI8, pg8::StaticOrder, true, true, 1, true>(F.lds, g, S, E);
            if (rep_ < REP(9)) xcd_barrier(bar); }
            SEAM(pb + 8);
        }
        if (IN(pb + 9)) { for (int rep_ = 0; rep_ <= REP(10); ++rep_) {
            KA ka = kargs(); unsigned char* ws = ka->ws;
            pg8::Gemm g{(const pg8::bf16_t*)(ws + WS_HID), (const pg8::bf16_t*)(ws + WS_WD), NE * RPE, DM, FFD / 2, RPE / 256, (size_t)DM * FFD};
            pg8::StaticOrder S; S.init(NE * RPE, DM, F.G, (int)blockIdx.x);
            pg8::EpiRowScaleBf16 E{(pg8::bf16_t*)(ws + WS_YE), DM, (const float*)(ws + WS_GATE), (const float*)(ws + WS_SW) + l * 48, RPE / 256, 1.0f / HID_SCALE};
            pg8::gemm_phase<pg8::EpiRowScaleBf16, pg8::StaticOrder, true, true, 2>(F.lds, g, S, E);
            if (rep_ < REP(10)) xcd_barrier(bar); }
            SEAM(pb + 9);
        }
    }
    if (IN(N_PHASES - 1)) phase_a(kargs(), F, NLAYER);
#undef IN
#undef SEAM
}

extern "C" void kernel_launch(void* const* d_in, const int* in_sizes, int n_in, void* d_out, int out_size, void* d_ws, size_t ws_size, hipStream_t stream) {
    static int grid = 0;
    if (grid == 0) {
        if (n_in != N_IN || out_size != LROWS * DM || ws_size < WS_END) { fprintf(stderr, "kernel_launch: unexpected shapes (n_in %d, out %d, ws %zu); nothing launched\n", n_in, out_size, ws_size); grid = -1; return; }
        int dev = 0, cus = 0, per_cu = 0;
        if (hipGetDevice(&dev) != hipSuccess || hipDeviceGetAttribute(&cus, hipDeviceAttributeMultiprocessorCount, dev) != hipSuccess) { grid = -1; return; }
        if (hipFuncSetAttribute((const void*)mk_fwd, hipFuncAttributeMaxDynamicSharedMemorySize, LDS_BYTES) != hipSuccess) { fprintf(stderr, "kernel_launch: hipFuncSetAttribute failed\n"); grid = -1; return; }
        if (hipOccupancyMaxActiveBlocksPerMultiprocessor(&per_cu, (const void*)mk_fwd, NWAVES * 64, LDS_BYTES) != hipSuccess || per_cu < 1) { fprintf(stderr, "kernel_launch: occupancy query reports %d blocks per CU\n", per_cu); }
        (void)hipGetLastError();
        if (cus < 256) { fprintf(stderr, "kernel_launch: %d compute units; the per-workgroup LDS row tables of the GEMM phases are sized for a grid of at least 256 workgroups; nothing launched\n", cus); grid = -1; return; }
        grid = cus;
    }
    if (grid < 0) return;
    if (hipMemsetAsync((char*)d_ws + WS_CTL, 0, CTL_ZERO_BYTES, stream) != hipSuccess) { fprintf(stderr, "kernel_launch: memset failed\n"); return; }
    Args a{};
    for (int i = 0; i < N_IN; ++i) a.in[i] = (const float*)d_in[i];
    a.out = (float*)d_out; a.ws = (unsigned char*)d_ws;
#if MK_SPLIT
    for (int ph = 0; ph < N_PHASES; ++ph) { a.ph_lo = ph; a.ph_hi = ph + 1; hipLaunchKernelGGL(mk_fwd, dim3(grid), dim3(NWAVES * 64), LDS_BYTES, stream, a); }
#else
    a.ph_lo = 0; a.ph_hi = N_PHASES;
    hipLaunchKernelGGL(mk_fwd, dim3(grid), dim3(NWAVES * 64), LDS_BYTES, stream, a);
#endif
    const hipError_t le = hipPeekAtLastError();
    if (le != hipSuccess) fprintf(stderr, "kernel_launch: launch failed: %s\n", hipGetErrorName(le));
}
```

```cpp
#include <hip/hip_runtime.h>
#include <hip/hip_bf16.h>
#include <cstdio>
#include <cstdint>
#ifndef MK_SPLIT
#define MK_SPLIT 0
#endif
#ifndef MK_REP
#define MK_REP 0
#endif
#ifndef MK_NOEPI
#define MK_NOEPI 0
#endif
#ifndef MK_ABL
#define MK_ABL 0
#endif
namespace pg8 {
#define PG8_LAS __attribute__((address_space(3)))
typedef unsigned short bf16_t;
typedef short bf16x8 __attribute__((ext_vector_type(8)));
typedef float f32x4 __attribute__((ext_vector_type(4)));
typedef unsigned u32x4 __attribute__((ext_vector_type(4)));
constexpr int BM = 256, BK = 64, HALF = 128, HTB = HALF * BK * 2  , STAGE_BYTES = 8 * HTB, NXCD = 8, WGM = 8;

__host__ __device__ __forceinline__ int lds_byte(int r, int c) { const int st = (r >> 4) * 2 + (c >> 5), rr = r & 15, cc = c & 31, ob = rr * 64 + cc * 2; return st * 1024 + (ob ^ (((ob >> 9) & 1) << 5)); }
__host__ __device__ __forceinline__ void stage_rc(int b, int& R, int& C) { const int st = b / 1024, sb = b % 1024, swz = sb ^ (((sb >> 9) & 1) << 5); R = (st >> 1) * 16 + swz / 64; C = (st & 1) * 32 + (swz % 64) / 2; }
__host__ __device__ __forceinline__ int perm32(int rho) { const int n = rho >> 4, i = rho & 15; return 8 * (i >> 2) + 4 * n + (i & 3); }

struct Unit { int pm, pn, li; };
struct Gemm { const bf16_t* A; const bf16_t* Bt; int M, N, K; int tpe; size_t bgs; const int* gidx = nullptr; };

struct StaticOrder {
    int nM, nN, nwg, G, c;
    __host__ __device__ void init(int M, int N, int G_, int c_) { nM = M / BM; nN = N / BM; nwg = nM * nN; G = G_; c = c_; }
    __host__ __device__ bool next(int i, Unit& u) const {
        const long L = (long)i * G + c; if (L >= nwg) return false;
        int wgid = (int)L; { const int q = nwg / NXCD, r = nwg % NXCD, xcd = wgid % NXCD, off = wgid / NXCD; wgid = (xcd < r ? xcd * (q + 1) : r * (q + 1) + (xcd - r) * q) + off; }
        const int nig = WGM * nN, gid = wgid / nig, fm = gid * WGM, gsz = (nM - fm) < WGM ? (nM - fm) : WGM;
        u.pm = fm + ((wgid % nig) % gsz); u.pn = (wgid % nig) / gsz; u.li = i; return true;
    }
    __device__ __forceinline__ void a_ready(const Unit&) const {}
    __device__ __forceinline__ void done(const Unit&) const {}
};
typedef int i32x4 __attribute__((ext_vector_type(4)));
__device__ __forceinline__ unsigned cvt_pk_bf16(float lo, float hi) { unsigned r; asm volatile("v_cvt_pk_bf16_f32 %0, %1, %2" : "=v"(r) : "v"(lo), "v"(hi)); return r; }
constexpr int GTAB_OFF = STAGE_BYTES + 2048, RTAB_OFF = GTAB_OFF + 17 * BM * 2, TAB_UNITS = 17;
template <class Sched> __device__ __forceinline__ void fill_rtab(PG8_LAS unsigned char* lds, const Sched& S, const float* rowv, int tid) {
    PG8_LAS float* rt = (PG8_LAS float*)(lds + RTAB_OFF); Unit uu;
    for (int i = 0; i < TAB_UNITS && S.next(i, uu); ++i) { if (tid < BM) rt[i * BM + tid] = rowv[uu.pm * BM + tid]; } }
struct EpiStoreBf16 {
    static constexpr bool PERM = true, AFTER_DRAIN = false;
    bf16_t* O; int ldc;
    template <class Sched> __device__ __forceinline__ void prefill(PG8_LAS unsigned char*, const Sched&, int) const {}
    __device__ __forceinline__ void operator()(const f32x4 (&acc)[2][2][4][2], const Unit& u, int wr, int wc, int fr, int fq, PG8_LAS unsigned char* lds) const {
        const int row0 = u.pm * BM + wr * 64 + fr, col0 = u.pn * BM + wc * 32 + 8 * fq;
#pragma unroll
        for (int ai = 0; ai < 2; ++ai)
#pragma unroll
            for (int m = 0; m < 4; ++m) { bf16_t* rowp = O + (size_t)(row0 + ai * HALF + m * 16) * ldc + col0;
#pragma unroll
                for (int bj = 0; bj < 2; ++bj) { const f32x4 v0 = acc[ai][bj][m][0], v1 = acc[ai][bj][m][1];
                    u32x4 w; w.x = cvt_pk_bf16(v0[0], v0[1]); w.y = cvt_pk_bf16(v0[2], v0[3]); w.z = cvt_pk_bf16(v1[0], v1[1]); w.w = cvt_pk_bf16(v1[2], v1[3]);
                    *(u32x4*)(rowp + bj * HALF) = w; } }
    }
};
struct EpiStoreBf16I8 {
    static constexpr bool PERM = true, AFTER_DRAIN = false;
    bf16_t* O; int ldc; const float* sa; const float* sw; float* ssq;
    template <class Sched> __device__ __forceinline__ void prefill(PG8_LAS unsigned char* lds, const Sched& S, int tid) const { fill_rtab(lds, S, sa, tid); }
    __device__ __forceinline__ void operator()(const i32x4 (&acc)[2][2][4][2], const Unit& u, int wr, int wc, int fr, int fq, PG8_LAS unsigned char* lds) const {
        const int row0 = u.pm * BM + wr * 64 + fr, col0 = u.pn * BM + wc * 32 + 8 * fq;
        f32x4 cs[2][2];
#pragma unroll
        for (int bj = 0; bj < 2; ++bj)
#pragma unroll
            for (int n = 0; n < 2; ++n) cs[bj][n] = *(const f32x4*)(sw + col0 + bj * HALF + 4 * n);
#pragma unroll
        for (int ai = 0; ai < 2; ++ai)
#pragma unroll
            for (int m = 0; m < 4; ++m) { const int row = row0 + ai * HALF + m * 16; const float rs = ((const PG8_LAS float*)(lds + RTAB_OFF))[u.li * BM + (row - u.pm * BM)]; bf16_t* rowp = O + (size_t)row * ldc + col0;
#pragma unroll
                for (int bj = 0; bj < 2; ++bj) { const i32x4 a0 = acc[ai][bj][m][0], a1 = acc[ai][bj][m][1]; const f32x4 c0 = cs[bj][0] * rs, c1 = cs[bj][1] * rs;
                    const float z0 = (float)a0[0] * c0[0], z1 = (float)a0[1] * c0[1], z2 = (float)a0[2] * c0[2], z3 = (float)a0[3] * c0[3];
                    const float z4 = (float)a1[0] * c1[0], z5 = (float)a1[1] * c1[1], z6 = (float)a1[2] * c1[2], z7 = (float)a1[3] * c1[3];
                    u32x4 w; w.x = cvt_pk_bf16(z0, z1); w.y = cvt_pk_bf16(z2, z3); w.z = cvt_pk_bf16(z4, z5); w.w = cvt_pk_bf16(z6, z7);
                    *(u32x4*)(rowp + bj * HALF) = w;
                    if (u.pn == 0 || (u.pn == 1 && bj == 0)) {
                        float q = ((z0 * z0 + z1 * z1) + (z2 * z2 + z3 * z3)) + ((z4 * z4 + z5 * z5) + (z6 * z6 + z7 * z7));
                        q += __shfl_xor(q, 16); q += __shfl_xor(q, 32);
                        if (fq == 0) ssq[(size_t)row * 12 + (u.pn == 0 ? bj * 4 + wc : 8 + wc)] = q; } } }
    }
};
struct EpiColGateBf16 {
    static constexpr bool PERM = true, AFTER_DRAIN = false;
    bf16_t* O; int ldc; const float* mod; int lrows;
    template <class Sched> __device__ __forceinline__ void prefill(PG8_LAS unsigned char*, const Sched&, int) const {}
    __device__ __forceinline__ void operator()(const f32x4 (&acc)[2][2][4][2], const Unit& u, int wr, int wc, int fr, int fq, PG8_LAS unsigned char* lds) const {
        const int R0 = u.pm * BM; const int v = (R0 >= lrows) ? 4 : (R0 >> 13);
        const float* ga = mod + v * 6144 + 2 * 1024;
        const int row0 = R0 + wr * 64 + fr, col0 = u.pn * BM + wc * 32 + 8 * fq;
        f32x4 g[2][2];
#pragma unroll
        for (int bj = 0; bj < 2; ++bj)
#pragma unroll
            for (int n = 0; n < 2; ++n) g[bj][n] = *(const f32x4*)(ga + col0 + bj * HALF + 4 * n);
#pragma unroll
        for (int ai = 0; ai < 2; ++ai)
#pragma unroll
            for (int m = 0; m < 4; ++m) { bf16_t* rowp = O + (size_t)(row0 + ai * HALF + m * 16) * ldc + col0;
#pragma unroll
                for (int bj = 0; bj < 2; ++bj) { const f32x4 v0 = acc[ai][bj][m][0] * g[bj][0], v1 = acc[ai][bj][m][1] * g[bj][1];
                    u32x4 w; w.x = cvt_pk_bf16(v0[0], v0[1]); w.y = cvt_pk_bf16(v0[2], v0[3]); w.z = cvt_pk_bf16(v1[0], v1[1]); w.w = cvt_pk_bf16(v1[2], v1[3]);
                    *(u32x4*)(rowp + bj * HALF) = w; } }
    }
};
__device__ __forceinline__ float silu_mul(float g, float u) { return g * __builtin_amdgcn_rcpf(1.0f + __builtin_amdgcn_exp2f(-1.4426950408889634f * g)) * u; }
struct EpiSwiGLU {
    static constexpr bool PERM = true, AFTER_DRAIN = false;
    bf16_t* O; int ldc;
    template <class Sched> __device__ __forceinline__ void prefill(PG8_LAS unsigned char*, const Sched&, int) const {}
    __device__ __forceinline__ void operator()(const f32x4 (&acc)[2][2][4][2], const Unit& u, int wr, int wc, int fr, int fq, PG8_LAS unsigned char* lds) const {
        const int row0 = u.pm * BM + wr * 64 + fr, col0 = u.pn * HALF + wc * 32 + 8 * fq;
#pragma unroll
        for (int ai = 0; ai < 2; ++ai)
#pragma unroll
            for (int m = 0; m < 4; ++m) { const f32x4 g0 = acc[ai][0][m][0], g1 = acc[ai][0][m][1], u0 = acc[ai][1][m][0], u1 = acc[ai][1][m][1];
                u32x4 w; w.x = cvt_pk_bf16(silu_mul(g0[0], u0[0]), silu_mul(g0[1], u0[1])); w.y = cvt_pk_bf16(silu_mul(g0[2], u0[2]), silu_mul(g0[3], u0[3]));
                w.z = cvt_pk_bf16(silu_mul(g1[0], u1[0]), silu_mul(g1[1], u1[1])); w.w = cvt_pk_bf16(silu_mul(g1[2], u1[2]), silu_mul(g1[3], u1[3]));
                *(u32x4*)(O + (size_t)(row0 + ai * HALF + m * 16) * ldc + col0) = w; }
    }
};
__device__ __forceinline__ float clamp448(float x) { return fminf(fmaxf(x, -448.0f), 448.0f); }
struct EpiSwiGLUI8 {
    static constexpr bool PERM = true, AFTER_DRAIN = false;
    unsigned char* O; int ldc; const float* sa; const float* sw; int tpe; float hs;
    template <class Sched> __device__ __forceinline__ void prefill(PG8_LAS unsigned char* lds, const Sched& S, int tid) const { fill_rtab(lds, S, sa, tid); }
    __device__ __forceinline__ void operator()(const i32x4 (&acc)[2][2][4][2], const Unit& u, int wr, int wc, int fr, int fq, PG8_LAS unsigned char* lds) const {
        const int row0 = u.pm * BM + wr * 64 + fr, col0 = u.pn * HALF + wc * 32 + 8 * fq; const int e = u.pm / tpe;
        const float sg = sw[3 * e], su = sw[3 * e + 1] * hs;
#pragma unroll
        for (int ai = 0; ai < 2; ++ai)
#pragma unroll
            for (int m = 0; m < 4; ++m) { const int row = row0 + ai * HALF + m * 16; const float rs = ((const PG8_LAS float*)(lds + RTAB_OFF))[u.li * BM + (row - u.pm * BM)], fg = rs * sg, fu = rs * su;
                const i32x4 g0 = acc[ai][0][m][0], g1 = acc[ai][0][m][1], u0 = acc[ai][1][m][0], u1 = acc[ai][1][m][1];
                typedef float f32x2 __attribute__((ext_vector_type(2)));
                float h[8]; f32x2 gi[4], gu[4], ev[4];
                const float tg = -1.4426950408889634f * fg, fgu = fg * fu;
#pragma unroll
                for (int i = 0; i < 2; ++i) { gi[i] = (f32x2){(float)g0[2 * i], (float)g0[2 * i + 1]}; gi[2 + i] = (f32x2){(float)g1[2 * i], (float)g1[2 * i + 1]};
                    gu[i] = gi[i] * (f32x2){(float)u0[2 * i], (float)u0[2 * i + 1]}; gu[2 + i] = gi[2 + i] * (f32x2){(float)u1[2 * i], (float)u1[2 * i + 1]}; }
                __builtin_amdgcn_sched_barrier(0);
#pragma unroll
                for (int i = 0; i < 4; ++i) { const f32x2 t = gi[i] * tg; ev[i] = (f32x2){__builtin_amdgcn_exp2f(t.x), __builtin_amdgcn_exp2f(t.y)}; }
                __builtin_amdgcn_sched_barrier(0);
#pragma unroll
                for (int i = 0; i < 4; ++i) { const f32x2 d = ev[i] + 1.0f; ev[i] = (f32x2){__builtin_amdgcn_rcpf(d.x), __builtin_amdgcn_rcpf(d.y)}; }
                __builtin_amdgcn_sched_barrier(0);
#pragma unroll
                for (int i = 0; i < 4; ++i) { const f32x2 hv = gu[i] * ev[i] * fgu; h[2 * i] = clamp448(hv.x); h[2 * i + 1] = clamp448(hv.y); }
                int w0 = __builtin_amdgcn_cvt_pk_fp8_f32(h[0], h[1], 0, false); w0 = __builtin_amdgcn_cvt_pk_fp8_f32(h[2], h[3], w0, true);
                int w1 = __builtin_amdgcn_cvt_pk_fp8_f32(h[4], h[5], 0, false); w1 = __builtin_amdgcn_cvt_pk_fp8_f32(h[6], h[7], w1, true);
                typedef unsigned u32x2 __attribute__((ext_vector_type(2)));
                *(u32x2*)(O + (size_t)row * ldc + col0) = (u32x2){(unsigned)w0, (unsigned)w1}; }
    }
};
struct EpiNullI8 {
    static constexpr bool PERM = true, AFTER_DRAIN = false;
    template <class Sched> __device__ __forceinline__ void prefill(PG8_LAS unsigned char*, const Sched&, int) const {}
    __device__ __forceinline__ void operator()(const i32x4 (&acc)[2][2][4][2], const Unit& u, int wr, int wc, int fr, int fq, PG8_LAS unsigned char* lds) const {
#pragma unroll
        for (int ai = 0; ai < 2; ++ai)
#pragma unroll
            for (int bj = 0; bj < 2; ++bj)
#pragma unroll
                for (int m = 0; m < 4; ++m) { asm volatile("" :: "v"(acc[ai][bj][m][0]), "v"(acc[ai][bj][m][1])); }
    }
};
struct EpiRowScaleBf16 {
    static constexpr bool PERM = true, AFTER_DRAIN = false;
    unsigned char* O; int ldc; const float* rs; const float* es; int tpe; float cs;
    template <class Sched> __device__ __forceinline__ void prefill(PG8_LAS unsigned char* lds, const Sched& S, int tid) const { fill_rtab(lds, S, rs, tid); }
    __device__ __forceinline__ void operator()(const f32x4 (&acc)[2][2][4][2], const Unit& u, int wr, int wc, int fr, int fq, PG8_LAS unsigned char* lds) const {
        const int row0 = u.pm * BM + wr * 64 + fr, col0 = u.pn * BM + wc * 32 + 8 * fq;
#pragma unroll
        for (int ai = 0; ai < 2; ++ai)
#pragma unroll
            for (int m = 0; m < 4; ++m) { const int row = row0 + ai * HALF + m * 16; const float s = ((const PG8_LAS float*)(lds + RTAB_OFF))[u.li * BM + (row - u.pm * BM)] * (es[3 * (u.pm / tpe) + 2] * cs); unsigned char* rowp = O + (size_t)row * ldc + col0;
#pragma unroll
                for (int bj = 0; bj < 2; ++bj) { const f32x4 v0 = acc[ai][bj][m][0] * s, v1 = acc[ai][bj][m][1] * s;
                    int w0 = __builtin_amdgcn_cvt_pk_fp8_f32(clamp448(v0[0]), clamp448(v0[1]), 0, false); w0 = __builtin_amdgcn_cvt_pk_fp8_f32(clamp448(v0[2]), clamp448(v0[3]), w0, true);
                    int w1 = __builtin_amdgcn_cvt_pk_fp8_f32(clamp448(v1[0]), clamp448(v1[1]), 0, false); w1 = __builtin_amdgcn_cvt_pk_fp8_f32(clamp448(v1[2]), clamp448(v1[3]), w1, true);
                    typedef unsigned u32x2 __attribute__((ext_vector_type(2)));
                    *(u32x2*)(rowp + bj * HALF) = (u32x2){(unsigned)w0, (unsigned)w1}; } }
    }
};
typedef int i32x4 __attribute__((ext_vector_type(4)));
typedef int i32x8 __attribute__((ext_vector_type(8)));
template <int MODE> struct AccSel { typedef f32x4 type; };
template <> struct AccSel<1> { typedef i32x4 type; };
template <int MODE> struct Frag { bf16x8 v[2]; __device__ __forceinline__ void set(int k, bf16x8 x) { v[k] = x; } };
template <> struct Frag<2> { i32x8 w; __device__ __forceinline__ void set(int k, bf16x8 x) { const i32x4 y = __builtin_bit_cast(i32x4, x); if (k == 0) w.lo = y; else w.hi = y; } };
template <class Epi, class Sched, bool ALIGN_EPI = false, bool SP2 = false, int MODE = 0, bool GATHER = false>
__device__ __forceinline__ void gemm_phase(PG8_LAS unsigned char* lds, const Gemm g, const Sched& S, const Epi& E) {
    int tid_l = threadIdx.x; asm volatile("" : "+v"(tid_l));
    const int tid = tid_l, wid = __builtin_amdgcn_readfirstlane(tid >> 6), lane = tid & 63, wr = wid >> 2, wc = wid & 3, fr = lane & 15, fq = lane >> 4;
    const int K = g.K, nt = K / BK;
    unsigned voffA[2], voffB[2];
#pragma unroll
    for (int i = 0; i < 2; ++i) { int R, C; stage_rc(tid * 16 + i * 8192, R, C); const int Rb = Epi::PERM ? ((R & ~31) + perm32(R & 31)) : R;
        voffA[i] = (unsigned)(R * K + C) * 2u; voffB[i] = (unsigned)(Rb * K + C) * 2u; }
    static_assert(!GATHER || SP2, "the gathered A operand is wired into the SP2 schedule only");
    unsigned gvc[2][2] = {{0u, 0u}, {0u, 0u}};
    PG8_LAS unsigned short* gtab = (PG8_LAS unsigned short*)(lds + GTAB_OFF);
    if constexpr (GATHER) { Unit uu_;
        for (int i_ = 0; S.next(i_, uu_); ++i_) { if (tid < BM) { const int ix_ = g.gidx[uu_.pm * BM + tid]; gtab[i_ * BM + tid] = (unsigned short)(ix_ < 0 ? 0 : ix_); } }
    }
    E.prefill(lds, S, tid);
    __syncthreads();
#define PG8_GOFF(ui_, gv_) do { if constexpr (GATHER) { _Pragma("unroll") for (int h_ = 0; h_ < 2; ++h_) _Pragma("unroll") for (int i_ = 0; i_ < 2; ++i_) { int R_, C_; stage_rc(tid * 16 + i_ * 8192, R_, C_); \
        const unsigned ix_ = gtab[(ui_) * BM + h_ * HALF + R_]; gv_[h_][i_] = ix_ * (unsigned)(K * 2) + (unsigned)C_ * 2u; } } } while (0)
    const size_t kstep = (size_t)(BK * 2);
    const size_t hstep = (size_t)HALF * K * 2;
    const size_t tstep = 2 * hstep;
    const unsigned ldsw = (unsigned)wid * 1024u;
    const int aoff = lds_byte(wr * 64 + fr, fq * 8), boff = lds_byte(wc * 32 + fr, fq * 8);
#define PG8_SA(b, h) (((b) * 2 + (h)) * HTB)
#define PG8_SB(b, h) ((4 + (b) * 2 + (h)) * HTB)
#define PG8_STAGE(bufoff, gbase, voff) do { _Pragma("unroll") for (int _i = 0; _i < 2; ++_i) \
        __builtin_amdgcn_global_load_lds((const unsigned*)((const char*)(gbase) + (voff)[_i]), (PG8_LAS unsigned*)(lds + (bufoff) + ldsw + _i * 8192), 16, 0, 0); } while (0)
#define PG8_STAGE_A(bufoff, gbase, h_, nx_) do { if constexpr (GATHER) PG8_STAGE(bufoff, gbase, gvc[h_]); else PG8_STAGE(bufoff, (gbase) + (h_) * hstep, voffA); } while (0)
#define PG8_LDA(dst, b, h) do { _Pragma("unroll") for (int m = 0; m < 4; ++m) _Pragma("unroll") for (int k = 0; k < 2; ++k) dst[m].set(k, *(const PG8_LAS bf16x8*)(lds + PG8_SA(b, h) + aoff + m * 2048 + k * 1024)); } while (0)
#define PG8_LDB(dst, b, h) do { _Pragma("unroll") for (int n = 0; n < 2; ++n) _Pragma("unroll") for (int k = 0; k < 2; ++k) dst[n].set(k, *(const PG8_LAS bf16x8*)(lds + PG8_SB(b, h) + boff + n * 2048 + k * 1024)); } while (0)
#define PG8_MMA(ai, bj, At, Bt) do { __builtin_amdgcn_s_setprio(1); _Pragma("unroll") for (int m = 0; m < 4; ++m) _Pragma("unroll") for (int n = 0; n < 2; ++n) { \
        if constexpr (MODE == 2) { asm volatile("v_mfma_f32_16x16x128_f8f6f4 %0, %1, %2, %0" : "+v"(acc[ai][bj][m][n]) : "v"(Bt[n].w), "v"(At[m].w)); }     \
        else { _Pragma("unroll") for (int k = 0; k < 2; ++k) { \
          if constexpr (MODE == 1) acc[ai][bj][m][n] = __builtin_amdgcn_mfma_i32_16x16x64_i8(__builtin_bit_cast(i32x4, Bt[n].v[k]), __builtin_bit_cast(i32x4, At[m].v[k]), acc[ai][bj][m][n], 0, 0, 0); \
          else acc[ai][bj][m][n] = __builtin_amdgcn_mfma_f32_16x16x32_bf16(Bt[n].v[k], At[m].v[k], acc[ai][bj][m][n], 0, 0, 0); } } } __builtin_amdgcn_s_setprio(0); } while (0)
#define PG8_WAIT_V(n) asm volatile("s_waitcnt vmcnt(" #n ")" ::: "memory")
#define PG8_WAIT_L(n) asm volatile("s_waitcnt lgkmcnt(" #n ")" ::: "memory")
#define PG8_BAR __builtin_amdgcn_s_barrier()
#define PG8_SCHED __builtin_amdgcn_sched_barrier(0)
    Unit cur, nxt; int ui = 0;
    if (!S.next(0, cur)) return;
    typedef typename AccSel<MODE>::type acc_t; const acc_t acc_zero = {};
    acc_t acc[2][2][4][2];
#pragma unroll
    for (int a = 0; a < 2; ++a)
#pragma unroll
        for (int b = 0; b < 2; ++b)
#pragma unroll
            for (int m = 0; m < 4; ++m)
#pragma unroll
                for (int n = 0; n < 2; ++n) acc[a][b][m][n] = acc_zero;
    Frag<MODE> At[4], B0[2], B1[2];
    const char* cA = (const char*)g.A + (GATHER ? (size_t)0 : (size_t)cur.pm * tstep); PG8_GOFF(0, gvc); const char* cB = (const char*)g.Bt + (size_t)(cur.pm / g.tpe) * g.bgs + (size_t)cur.pn * tstep;
    S.a_ready(cur);
    if constexpr (SP2) {
        PG8_STAGE(PG8_SB(0, 0), cB, voffB); PG8_STAGE(PG8_SB(0, 1), cB + hstep, voffB); PG8_STAGE_A(PG8_SA(0, 0), cA, 0, false); PG8_STAGE_A(PG8_SA(0, 1), cA, 1, false);
        if (wr == 1) PG8_BAR;
        PG8_WAIT_V(2); PG8_BAR;
        PG8_STAGE(PG8_SB(1, 0), cB + kstep, voffB); PG8_STAGE_A(PG8_SA(1, 0), cA + kstep, 0, false); PG8_STAGE(PG8_SB(1, 1), cB + hstep + kstep, voffB);
        PG8_WAIT_V(6); PG8_BAR;
    } else {
        PG8_STAGE(PG8_SB(0, 0), cB, voffB); PG8_STAGE(PG8_SA(0, 0), cA, voffA); PG8_STAGE(PG8_SB(0, 1), cB + hstep, voffB); PG8_STAGE(PG8_SA(0, 1), cA + hstep, voffA);
        if (wr == 1) PG8_BAR;
        PG8_WAIT_V(4); PG8_BAR;
        PG8_STAGE(PG8_SB(1, 0), cB + kstep, voffB); PG8_STAGE(PG8_SA(1, 0), cA + kstep, voffA); PG8_STAGE(PG8_SB(1, 1), cB + hstep + kstep, voffB);
        PG8_WAIT_V(6); PG8_BAR;
    }
    for (;;) {
        const bool has_next = S.next(ui + 1, nxt);
        const char* nA = (has_next && !GATHER) ? (const char*)g.A + (size_t)nxt.pm * tstep : cA; const char* nB = has_next ? (const char*)g.Bt + (size_t)(nxt.pm / g.tpe) * g.bgs + (size_t)nxt.pn * tstep : cB;
        for (int t = 0; t < nt; t += 2) {
            const bool last = (t == nt - 2); const bool nxu = last && has_next;
            const char* a1 = cA + (size_t)(t + 1) * kstep;
            const char* a2 = last ? nA : cA + (size_t)(t + 2) * kstep; const char* b2 = last ? nB : cB + (size_t)(t + 2) * kstep;
            const char* a3 = a2 + kstep; const char* b3 = b2 + kstep;
            if (last && has_next) S.a_ready(nxt);
            if constexpr (SP2) {
            PG8_LDB(B0, 0, 0); PG8_LDB(B1, 0, 1); PG8_SCHED; PG8_LDA(At, 0, 0); PG8_STAGE_A(PG8_SA(1, 1), a1, 1, false); if (nxu) PG8_GOFF(ui + 1, gvc);
            PG8_WAIT_V(8); PG8_WAIT_L(0); PG8_BAR; PG8_MMA(0, 0, At, B0); PG8_MMA(0, 1, At, B1); PG8_BAR; PG8_SCHED;
            PG8_LDA(At, 0, 1); PG8_STAGE(PG8_SB(0, 0), b2, voffB); PG8_STAGE(PG8_SB(0, 1), b2 + hstep, voffB); PG8_STAGE_A(PG8_SA(0, 0), a2, 0, nxu);
            PG8_WAIT_V(8); PG8_WAIT_L(0); PG8_BAR; PG8_MMA(1, 0, At, B0); PG8_MMA(1, 1, At, B1); PG8_BAR; PG8_SCHED;
            PG8_LDB(B0, 1, 0); PG8_LDB(B1, 1, 1); PG8_SCHED; PG8_LDA(At, 1, 0); PG8_STAGE_A(PG8_SA(0, 1), a2, 1, nxu);
            PG8_WAIT_V(8); PG8_WAIT_L(0); PG8_BAR; PG8_MMA(0, 0, At, B0); PG8_MMA(0, 1, At, B1); PG8_BAR; PG8_SCHED;
            PG8_LDA(At, 1, 1); PG8_STAGE(PG8_SB(1, 0), b3, voffB); PG8_STAGE(PG8_SB(1, 1), b3 + hstep, voffB); PG8_STAGE_A(PG8_SA(1, 0), a3, 0, nxu);
            PG8_WAIT_V(8); PG8_WAIT_L(0); PG8_BAR; PG8_MMA(1, 0, At, B0); PG8_MMA(1, 1, At, B1); PG8_BAR; PG8_SCHED;
            } else {
            PG8_LDB(B0, 0, 0); PG8_SCHED; PG8_LDA(At, 0, 0); PG8_STAGE(PG8_SA(1, 1), a1 + hstep, voffA);
            PG8_WAIT_L(8); PG8_BAR; PG8_WAIT_L(0); PG8_MMA(0, 0, At, B0); PG8_BAR; PG8_SCHED;
            PG8_LDB(B1, 0, 1); PG8_STAGE(PG8_SB(0, 0), b2, voffB);
            PG8_BAR; PG8_WAIT_L(0); PG8_MMA(0, 1, At, B1); PG8_BAR;
            PG8_LDA(At, 0, 1); PG8_STAGE(PG8_SA(0, 0), a2, voffA);
            PG8_BAR; PG8_WAIT_L(0); PG8_MMA(1, 0, At, B0); PG8_BAR; PG8_SCHED;
            PG8_STAGE(PG8_SB(0, 1), b2 + hstep, voffB);
            PG8_WAIT_V(6); PG8_BAR; PG8_MMA(1, 1, At, B1); PG8_BAR;
            PG8_LDB(B0, 1, 0); PG8_SCHED; PG8_LDA(At, 1, 0); PG8_STAGE(PG8_SA(0, 1), a2 + hstep, voffA);
            PG8_WAIT_L(8); PG8_BAR; PG8_WAIT_L(0); PG8_MMA(0, 0, At, B0); PG8_BAR; PG8_SCHED;
            PG8_LDB(B1, 1, 1); PG8_STAGE(PG8_SB(1, 0), b3, voffB);
            PG8_BAR; PG8_WAIT_L(0); PG8_MMA(0, 1, At, B1); PG8_BAR;
            PG8_LDA(At, 1, 1); PG8_STAGE(PG8_SA(1, 0), a3, voffA);
            PG8_BAR; PG8_WAIT_L(0); PG8_MMA(1, 0, At, B0); PG8_BAR; PG8_SCHED;
            PG8_STAGE(PG8_SB(1, 1), b3 + hstep, voffB);
            PG8_WAIT_V(6); PG8_BAR; PG8_MMA(1, 1, At, B1); PG8_BAR;
            }
        }
        if constexpr (ALIGN_EPI) { if (wr == 0) PG8_BAR; }
        if constexpr (!Epi::AFTER_DRAIN) { E(acc, cur, wr, wc, fr, fq, lds); S.done(cur); }
        if (!has_next) break;
#pragma unroll
        for (int a = 0; a < 2; ++a)
#pragma unroll
            for (int b = 0; b < 2; ++b)
#pragma unroll
                for (int m = 0; m < 4; ++m)
#pragma unroll
                    for (int n = 0; n < 2; ++n) acc[a][b][m][n] = acc_zero;
        cur = nxt; cA = nA; cB = nB; ++ui;
        if constexpr (ALIGN_EPI) { if (wr == 1) PG8_BAR; }
    }
    PG8_WAIT_V(0);
    if constexpr (!ALIGN_EPI) { if (wr == 0) PG8_BAR; }
    PG8_BAR;
    if constexpr (Epi::AFTER_DRAIN) { E.fused(acc, cur, wr, wc, fr, fq, lds, wid, lane); S.done(cur); }
#undef PG8_SA
#undef PG8_SB
#undef PG8_STAGE
#undef PG8_STAGE_A
#undef PG8_GOFF
#undef PG8_LDA
#undef PG8_LDB
#undef PG8_MMA
#undef PG8_WAIT_V
#undef PG8_WAIT_L
#undef PG8_BAR
#undef PG8_SCHED
}
}
namespace att {
typedef unsigned short bf16_t;
typedef short bf16x8 __attribute__((ext_vector_type(8)));
typedef short s16x4 __attribute__((ext_vector_type(4)));
typedef float f32x16 __attribute__((ext_vector_type(16)));
typedef float f32x4 __attribute__((ext_vector_type(4)));
typedef unsigned u32x4 __attribute__((ext_vector_type(4)));
typedef unsigned u32x2 __attribute__((ext_vector_type(2)));
#define ALDS __attribute__((address_space(3)))
typedef float f32x2_t __attribute__((ext_vector_type(2))); typedef __bf16 bf16x2_t __attribute__((ext_vector_type(2)));
__device__ __forceinline__ unsigned cvtpk(float lo, float hi) { f32x2_t v = {lo, hi}; bf16x2_t b = __builtin_convertvector(v, bf16x2_t); return __builtin_bit_cast(unsigned, b); }
__device__ __forceinline__ float bf2f(unsigned short u) { return __uint_as_float((unsigned)u << 16); }
template <int S> __device__ __forceinline__ bf16x8 pack8(const f32x16& x) {
    u32x4 p; p.x = cvtpk(x[8 * S + 0], x[8 * S + 1]); p.y = cvtpk(x[8 * S + 2], x[8 * S + 3]); p.z = cvtpk(x[8 * S + 4], x[8 * S + 5]); p.w = cvtpk(x[8 * S + 6], x[8 * S + 7]);
    return __builtin_bit_cast(bf16x8, p);
}
typedef short v4i16_t __attribute__((ext_vector_type(4)));
__device__ __forceinline__ s16x4 vtr(const ALDS char* p) { return __builtin_bit_cast(s16x4, __builtin_amdgcn_ds_read_tr16_b64_v4i16((ALDS v4i16_t*)p)); }
__device__ __forceinline__ int crow(int r, int hi) { return (r & 3) + 8 * (r >> 2) + 4 * hi; }
constexpr int ATT_LDS_BYTES = 2 * 12288 + 2 * 8192;

__device__ __forceinline__ void glds16(const void* gsrc, unsigned lds_dst) { unsigned keep;
    asm volatile("s_mov_b32 %0, m0\n\ts_mov_b32 m0, %2\n\ts_nop 0\n\tglobal_load_lds_dwordx4 %1, off\n\ts_mov_b32 m0, %0" : "=&s"(keep) : "v"(gsrc), "s"(lds_dst) : "memory"); }
__device__ __forceinline__ void glds16s(const char* sbase, unsigned voff, unsigned lds_dst) { unsigned keep;
    asm volatile("s_mov_b32 %0, m0\n\ts_mov_b32 m0, %3\n\ts_nop 0\n\tglobal_load_lds_dwordx4 %1, %2\n\ts_mov_b32 m0, %0" : "=&s"(keep) : "v"(voff), "s"(sbase), "s"(lds_dst) : "memory"); }
#define ATT_SBAR() __builtin_amdgcn_sched_barrier(0)
#define ATT_PIN(x) asm volatile("" : "+v"(x))
typedef int i32x2a __attribute__((ext_vector_type(2)));
typedef int i32x4a __attribute__((ext_vector_type(4)));
typedef int i32x6a __attribute__((ext_vector_type(6)));
typedef int i32x8a __attribute__((ext_vector_type(8)));
typedef unsigned u32x16 __attribute__((ext_vector_type(16)));
typedef __bf16 bf16x32_t __attribute__((ext_vector_type(32)));
__device__ __forceinline__ i32x6a cvt_fp6x32(const u32x16& w) { return __builtin_bit_cast(i32x6a, __builtin_amdgcn_cvt_scalef32_pk32_fp6_bf16(__builtin_bit_cast(bf16x32_t, w), 1.0f)); }
#define ATT_MF6_Z(C, A, B, SA, SB) asm volatile("v_mfma_scale_f32_32x32x64_f8f6f4 %0, %1, %2, 0, %3, %4 op_sel:[0,0,0] op_sel_hi:[0,0,0] cbsz:2 blgp:2" : "=&v"(C) : "v"(A), "v"(B), "v"(SA), "v"(SB))
#define ATT_MF6_A(C, A, B, SA, SB) asm volatile("v_mfma_scale_f32_32x32x64_f8f6f4 %0, %1, %2, %0, %3, %4 op_sel:[0,0,0] op_sel_hi:[0,0,0] cbsz:2 blgp:2" : "+v"(C) : "v"(A), "v"(B), "v"(SA), "v"(SB))
#define ATT_MF6_C(C, A, B, C0, SA, SB) asm volatile("v_mfma_scale_f32_32x32x64_f8f6f4 %0, %1, %2, %3, %4, %5 op_sel:[0,0,0] op_sel_hi:[0,0,0] cbsz:2 blgp:2" : "=&v"(C) : "v"(A), "v"(B), "v"(C0), "v"(SA), "v"(SB))
template <int DK> struct KCfg { static constexpr int NG = (DK == 96) ? 3 : 2, KTB = (DK == 96) ? 5120 : 3072, QRB = 24 * NG, NF = (DK == 96) ? 2 : 1, NRD = 4 * NF, PB = NG * 1024,
                                                      SCL = (DK == 32) ? 0x77777777 : 0x76767676, NB = (DK == 32) ? 2 : 4; };
constexpr float FQ96 = 4.0f * 1.4426950408889634f * 0.10206207261596575f * 2.0f, FQ32 = 4.0f * 1.4426950408889634f * 0.17677669529663687f, FQ64 = 4.0f * 1.4426950408889634f * 0.125f * 2.0f;
constexpr float P_BIAS = 44.0f / 256.0f;
constexpr int KC_A = 0, KC_B = 1024;
template <int DK>
__device__ __forceinline__ void kread6(i32x6a (&kf)[2][KCfg<DK>::NF], const ALDS char* pA0, const ALDS char* pB0, const ALDS char* pA1, const ALDS char* pB1, int idx) {
    constexpr int NF = KCfg<DK>::NF;
    const int mt = idx / (2 * NF), f = (idx / 2) % NF, part = idx & 1;
    const ALDS char* pA = f ? pA1 : pA0; const ALDS char* pB = f ? pB1 : pB0;
    if (part == 0) { const i32x4a v = *(const ALDS i32x4a*)(pA + mt * 512); kf[mt][f][0] = v.x; kf[mt][f][1] = v.y; kf[mt][f][2] = v.z; kf[mt][f][3] = v.w; }
    else { const i32x2a v = *(const ALDS i32x2a*)(pB + mt * 256); kf[mt][f][4] = v.x; kf[mt][f][5] = v.y; }
}
#define ATT_PV8(C, A, B) asm volatile("s_nop 3\n\tv_mfma_f32_32x32x64_f8f6f4 %0, %1, %2, %0 cbsz:0 blgp:1" : "+v"(C) : "v"(A), "v"(B))
#define ATT_L8(C, A, B) asm volatile("s_nop 3\n\tv_mfma_f32_16x16x128_f8f6f4 %0, %1, %2, %0 cbsz:0 blgp:1" : "+v"(C) : "v"(A), "v"(B))
#define ATT_L8N(C, A, B) asm volatile("v_mfma_f32_16x16x128_f8f6f4 %0, %1, %2, %0 cbsz:0 blgp:1" : "+v"(C) : "v"(A), "v"(B))
#define ATT_PV8N(C, A, B) asm volatile("v_mfma_f32_32x32x64_f8f6f4 %0, %1, %2, %0 cbsz:0 blgp:1" : "+v"(C) : "v"(A), "v"(B))
typedef unsigned short u16x2 __attribute__((ext_vector_type(2)));
__device__ __forceinline__ unsigned pk4_bf8(float a, float b, float c, float d) {
    const u16x2 x = __builtin_amdgcn_cvt_pknorm_u16(a, b), y = __builtin_amdgcn_cvt_pknorm_u16(c, d);
    return __builtin_amdgcn_perm(__builtin_bit_cast(unsigned, y), __builtin_bit_cast(unsigned, x), 0x07050301u); }
struct KPtr { const ALDS char *a0, *b0, *a1, *b1; };
template <int DK, int VLOAD, int ABL = 0, class DF>
__device__ __forceinline__ void att_step9(f32x16& N0, f32x16& N1, const f32x16& P0, const f32x16& P1, i32x6a (&kf)[2][KCfg<DK>::NF], const i32x6a* qfn,
                                          f32x16 (&o)[2], f32x4& L, const i32x8a& pwP, i32x8a& pwC, i32x8a (&vf)[2], const i32x8a& ones, const f32x16& cb, const int& sa, const int& sb,
                                          const ALDS char* vcur, const KPtr k1, const KPtr k0, DF&& dmaf) {
    constexpr int NF = KCfg<DK>::NF;
#define ATP_PACK(i) do { if (!(ABL & 4)) { const int e = 4 * (i); \
        int w = (int)((e < 16) ? pk4_bf8(P0[e & 15], P0[(e + 1) & 15], P0[(e + 2) & 15], P0[(e + 3) & 15]) : pk4_bf8(P1[e & 15], P1[(e + 1) & 15], P1[(e + 2) & 15], P1[(e + 3) & 15])); \
        ATT_PIN(w); pwC[i] = w; } } while (0)
    ATT_SBAR();
    ATT_PV8N(o[0], vf[0], pwP);
    dmaf();
#pragma unroll
    for (int k = 2 * NF; k < 4 * NF; ++k) { if (!(ABL & 8)) kread6<DK>(kf, k1.a0, k1.b0, k1.a1, k1.b1, k); }
#pragma unroll
    for (int i = 0; i < 4; ++i) ATP_PACK(i);
    ATT_SBAR();
    ATT_PV8N(o[1], vf[1], pwP);
    if (VLOAD && !(ABL & 8)) { vf[0].lo = *(const ALDS i32x4a*)(vcur); vf[0].hi = *(const ALDS i32x4a*)(vcur + 1024); }
#pragma unroll
    for (int i = 4; i < 8; ++i) ATP_PACK(i);
    ATT_SBAR();
    ATT_L8N(L, ones, pwP);
    if (VLOAD && !(ABL & 8)) { vf[1].lo = *(const ALDS i32x4a*)(vcur + 512); vf[1].hi = *(const ALDS i32x4a*)(vcur + 512 + 1024); }
    ATT_SBAR();
    if (DK == 64) { ATT_MF6_C(N0, kf[0][0], qfn[0], cb, sa, sb); ATT_MF6_C(N1, kf[1][0], qfn[0], cb, sa, sb); }
    else if (NF == 1) { ATT_MF6_Z(N0, kf[0][0], qfn[0], sa, sb); ATT_MF6_Z(N1, kf[1][0], qfn[0], sa, sb); }
    else { ATT_MF6_Z(N0, kf[0][0], qfn[0], sa, sb); ATT_MF6_Z(N1, kf[1][0], qfn[0], sa, sb); ATT_MF6_A(N0, kf[0][1], qfn[1], sa, sb); ATT_MF6_A(N1, kf[1][1], qfn[1], sa, sb); }
    ATT_SBAR();
#pragma unroll
    for (int k = 0; k < 2 * NF; ++k) { if (!(ABL & 8)) kread6<DK>(kf, k0.a0, k0.b0, k0.a1, k0.b1, k); }
    ATT_SBAR();
#undef ATP_PACK
}
template <int DK, int NMAP, int ABL = 0>
__device__ __forceinline__ void attn_unit_f8(const unsigned char* __restrict__ Qb, const char* __restrict__ Kt, const char* __restrict__ Vt, int t0, int t1,
                                             bf16_t* __restrict__ Ob, ALDS char* lds, float lam, const float* __restrict__ gout, float oml) {
    typedef KCfg<DK> KC;
    constexpr int KTB = KC::KTB, NF = KC::NF, NRD = KC::NRD, LV = 8 * KTB, CB = LV + 8 * 4096, NKP = KTB / 1024, NP = NKP + 4, NDMA = (NP + 7) / 8;
    int tid_l = threadIdx.x; asm volatile("" : "+v"(tid_l));
    const int tid = tid_l, lane = tid & 63, r32 = lane & 31, hi = lane >> 5, wid = __builtin_amdgcn_readfirstlane(tid >> 6);
    i32x6a qbias;
    { u32x16 vq, vk; unsigned pq = 0x40B040B0u, pk = 0x40804080u;
      asm volatile("" : "+v"(pq), "+v"(pk));
#pragma unroll
      for (int r = 0; r < 16; ++r) { vq[r] = (2 * r < KC::NB) ? pq : 0u; vk[r] = (2 * r < KC::NB) ? pk : 0u; }
      qbias = cvt_fp6x32(vq);
      if (DK != 64 && tid == 0) { const i32x6a kb = cvt_fp6x32(vk); const i32x4a ka = {kb[0], kb[1], kb[2], kb[3]}; const i32x2a kc = {kb[4], kb[5]};
          *(ALDS i32x4a*)(lds + CB + KC_A) = ka; *(ALDS i32x4a*)(lds + CB + KC_A + 512) = ka; *(ALDS i32x2a*)(lds + CB + KC_B) = kc; *(ALDS i32x2a*)(lds + CB + KC_B + 256) = kc; } }
    i32x6a qf[NMAP][NF];
    { const unsigned char* qrow = Qb + (size_t)(wid * 32 + r32) * KC::QRB;
#define ATP_QG(dst, off) do { const i32x2a a_ = *(const i32x2a*)(qrow + (off)), b_ = *(const i32x2a*)(qrow + (off) + 8), c_ = *(const i32x2a*)(qrow + (off) + 16); \
          dst[0] = a_.x; dst[1] = a_.y; dst[2] = b_.x; dst[3] = b_.y; dst[4] = c_.x; dst[5] = c_.y; } while (0)
      if (DK == 64) { ATP_QG(qf[0][0], 24 * hi); }
      else if (DK == 96) { ATP_QG(qf[0][0], 24 * hi); i32x6a t; ATP_QG(t, 48);
#pragma unroll
          for (int r = 0; r < 6; ++r) qf[0][NF - 1][r] = hi ? qbias[r] : t[r]; }
      else {
#pragma unroll
          for (int m = 0; m < NMAP; ++m) { i32x6a t; ATP_QG(t, 24 * m);
#pragma unroll
              for (int r = 0; r < 6; ++r) qf[m][0][r] = hi ? qbias[r] : t[r]; } }
#undef ATP_QG
    }
#pragma unroll
    for (int m = 0; m < NMAP; ++m)
#pragma unroll
        for (int f = 0; f < NF; ++f) ATT_PIN(qf[m][f]);
    f32x16 o[NMAP][2], cb; f32x4 L[NMAP]; i32x8a pw, ones; int sa = 0x7F7F7F7F, sb = KC::SCL;
    ATT_PIN(sa); ATT_PIN(sb);
#pragma unroll
    for (int r = 0; r < 16; ++r) cb[r] = P_BIAS;
    if (DK == 64) ATT_PIN(cb);
    { const int sel = (lane == 0 || lane == 32 || lane == 17 || lane == 49) ? 0x38383838 : 0;
#pragma unroll
      for (int r = 0; r < 8; ++r) { pw[r] = 0; ones[r] = sel; } }
    ATT_PIN(ones);
#pragma unroll
    for (int m = 0; m < NMAP; ++m) {
#pragma unroll
        for (int r = 0; r < 4; ++r) L[m][r] = 0.f;
#pragma unroll
        for (int d = 0; d < 2; ++d)
#pragma unroll
            for (int r = 0; r < 16; ++r) o[m][d][r] = 0.f; }
#pragma unroll
    for (int m = 0; m < NMAP; ++m) { ATT_PIN(L[m]); ATT_PIN(o[m][0]); ATT_PIN(o[m][1]); }
    const unsigned lds0 = (unsigned)(size_t)lds;
    const char* src0; unsigned dst0; int isv0; const bool act0 = wid < NP;
    { const int p = wid; isv0 = p >= NKP; src0 = (isv0 ? Vt + (p - NKP) * 1024 : Kt + p * 1024); dst0 = lds0 + (isv0 ? LV + (p - NKP) * 1024 : p * 1024); }
    const unsigned lane16 = (unsigned)lane * 16u;
    const bool act1 = (NDMA == 2) && wid == 7;
    const char* src1 = nullptr; unsigned dst1 = 0u;
    if (NDMA == 2) { const int p = 8; src1 = Vt + (p - NKP) * 1024; dst1 = lds0 + LV + (p - NKP) * 1024; }
#define ATP_DMA(tk, tv) do { if (ABL & (2 | 32)) break; \
        if (act0) { if (isv0) glds16s(src0 + (size_t)(tv) * 4096, lane16, (unsigned)__builtin_amdgcn_readfirstlane(dst0 + ((tv) & 7) * 4096)); else glds16s(src0 + (size_t)(tk) * KTB, lane16, (unsigned)__builtin_amdgcn_readfirstlane(dst0 + ((tk) & 7) * KTB)); } \
        if (act1) glds16s(src1 + (size_t)(tv) * 4096, lane16, (unsigned)__builtin_amdgcn_readfirstlane(dst1 + ((tv) & 7) * 4096)); } while (0)
#define ATP_SYNCALL() do { if (ABL & 2) break; if (!(ABL & 128)) { if (act1) asm volatile("s_waitcnt vmcnt(4)" ::: "memory"); else asm volatile("s_waitcnt vmcnt(2)" ::: "memory"); } \
        if (!(ABL & 64)) asm volatile("s_barrier" ::: "memory"); } while (0)
    const bool c0 = (DK == 32) && hi, c1 = hi;
    const int ka0 = c0 ? CB + KC_A : ((DK == 32) ? 0 : hi * 1024) + r32 * 16, kb0 = c0 ? CB + KC_B : KC::PB + ((DK == 32) ? 0 : hi * 512) + r32 * 8, km0 = c0 ? 0 : KTB;
    const int dA = (DK == 32 && !hi) ? 1024 : 0, dB = (DK == 32 && !hi) ? 512 : 0;
    const int ka1 = c1 ? CB + KC_A : 2048 + r32 * 16, kb1 = c1 ? CB + KC_B : KC::PB + 1024 + r32 * 8, km1 = c1 ? 0 : KTB;
#define ATP_KP(t, m) (KPtr{lds + ((t) & 7) * km0 + ka0 + (m) * dA, lds + ((t) & 7) * km0 + kb0 + (m) * dB, lds + ((t) & 7) * km1 + ka1, lds + ((t) & 7) * km1 + kb1})
#define ATP_VB(t) (lds + LV + ((t) & 7) * 4096 + klane64)
#define ATP_KLOAD(t, m) do { const KPtr kp_ = ATP_KP(t, m); _Pragma("unroll") for (int k = 0; k < NRD; ++k) kread6<DK>(kf, kp_.a0, kp_.b0, kp_.a1, kp_.b1, k); \
        asm volatile("s_waitcnt lgkmcnt(0)" ::: "memory"); \
        _Pragma("unroll") for (int mt_ = 0; mt_ < 2; ++mt_) _Pragma("unroll") for (int f_ = 0; f_ < NF; ++f_) ATT_PIN(kf[mt_][f_]);     \
        asm volatile("s_nop 3" ::: "memory"); } while (0)
    const int klane64 = hi * 2048 + r32 * 16;
    ATP_DMA(t0, t0); ATP_DMA(t0 + 1, t0 + 1); ATP_DMA(t0 + 2, t0 + 1); if (NMAP == 1) ATP_DMA(t0 + 3, t0 + 1);
    asm volatile("s_waitcnt vmcnt(0) lgkmcnt(0)\n\ts_barrier" ::: "memory");
    if (NMAP == 1) { ATP_DMA(t0 + 4, t0 + 2); ATP_DMA(t0 + 5, t0 + 3); } else { ATP_DMA(t0 + 3, t0 + 2); ATP_DMA(t0 + 4, t0 + 3); }
    i32x6a kf[2][NF]; i32x8a vf[2], pwB;
    f32x16 sA0, sA1, sB0, sB1;
    ATP_KLOAD(t0, 0);
    if (DK == 64) { ATT_MF6_C(sA0, kf[0][0], qf[0][0], cb, sa, sb); ATT_MF6_C(sA1, kf[1][0], qf[0][0], cb, sa, sb); } else { ATT_MF6_Z(sA0, kf[0][0], qf[0][0], sa, sb); ATT_MF6_Z(sA1, kf[1][0], qf[0][0], sa, sb); }
    if (NF == 2) { ATT_MF6_A(sA0, kf[0][1], qf[0][1], sa, sb); ATT_MF6_A(sA1, kf[1][1], qf[0][1], sa, sb); }
    asm volatile("s_nop 15\n\ts_nop 15\n\ts_nop 15\n\ts_nop 15\n\ts_nop 15\n\ts_nop 15" : "+v"(sA0), "+v"(sA1));
    { const KPtr kp_ = (NMAP == 1) ? ATP_KP(t0 + 1, 0) : ATP_KP(t0, 1);
#pragma unroll
      for (int k = 0; k < 2 * NF; ++k) kread6<DK>(kf, kp_.a0, kp_.b0, kp_.a1, kp_.b1, k); }
#pragma unroll
    for (int r = 0; r < 8; ++r) { vf[0][r] = 0; vf[1][r] = 0; pwB[r] = 0; }
    ATT_PIN(vf[0]); ATT_PIN(vf[1]); ATT_PIN(pwB);
    asm volatile("s_nop 3" ::: "memory");
    if (NMAP == 1) {
        for (int t = t0; t < t1; t += 2) {
            att_step9<DK, 1, ABL>(sB0, sB1, sA0, sA1, kf, qf[0], o[0], L[0], pwB, pw, vf, ones, cb, sa, sb, ATP_VB(t), ATP_KP(t + 1, 0), ATP_KP(t + 2, 0), [&]() { ATP_DMA(t + 6, t + 4); ATP_DMA(t + 7, t + 5); });
            att_step9<DK, 1, ABL>(sA0, sA1, sB0, sB1, kf, qf[0], o[0], L[0], pw, pwB, vf, ones, cb, sa, sb, ATP_VB(t + 1), ATP_KP(t + 2, 0), ATP_KP(t + 3, 0), [&]() {});
            ATP_SYNCALL();
        }
    } else {
        for (int t = t0; t < t1; t += 2) {
            att_step9<DK, 1, ABL>(sB0, sB1, sA0, sA1, kf, qf[1], o[1], L[1], pwB, pw, vf, ones, cb, sa, sb, ATP_VB(t), ATP_KP(t, 1), ATP_KP(t + 1, 0), [&]() { ATP_DMA(t + 5, t + 4); });
            att_step9<DK, 0, ABL>(sA0, sA1, sB0, sB1, kf, qf[0], o[0], L[0], pw, pwB, vf, ones, cb, sa, sb, ATP_VB(t), ATP_KP(t + 1, 0), ATP_KP(t + 1, 1), [&]() { ATP_DMA(t + 6, t + 5); });
            att_step9<DK, 1, ABL>(sB0, sB1, sA0, sA1, kf, qf[1], o[1], L[1], pwB, pw, vf, ones, cb, sa, sb, ATP_VB(t + 1), ATP_KP(t + 1, 1), ATP_KP(t + 2, 0), [&]() {});
            att_step9<DK, 0, ABL>(sA0, sA1, sB0, sB1, kf, qf[0], o[0], L[0], pw, pwB, vf, ones, cb, sa, sb, ATP_VB(t + 1), ATP_KP(t + 2, 0), ATP_KP(t + 2, 1), [&]() {});
            ATP_SYNCALL();
        }
    }
    ATT_SBAR();
    ATT_PV8N(o[NMAP - 1][0], vf[0], pwB); ATT_PV8N(o[NMAP - 1][1], vf[1], pwB); ATT_L8N(L[NMAP - 1], ones, pwB);
    asm volatile("s_waitcnt vmcnt(0) lgkmcnt(0)\n\ts_barrier" ::: "memory");
#pragma unroll
    for (int m = 0; m < NMAP; ++m) asm volatile("s_nop 15\n\ts_nop 15\n\ts_nop 15\n\ts_nop 15\n\ts_nop 15" : "+v"(o[m][0]), "+v"(o[m][1]), "+v"(L[m]));
#undef ATP_DMA
#undef ATP_SYNCALL
#undef ATP_KP
#undef ATP_VB
#undef ATP_KLOAD
    float li[NMAP];
#pragma unroll
    for (int m = 0; m < NMAP; ++m) { const float l0 = __shfl(L[m][0], r32 & 15), l1 = __shfl(L[m][1], r32 & 15); li[m] = 1.0f / ((r32 & 16) ? l1 : l0); }
    float val[2][16];
    if (NMAP == 1) {
#pragma unroll
        for (int d = 0; d < 2; ++d)
#pragma unroll
            for (int r = 0; r < 16; ++r) val[d][r] = o[0][d][r] * li[0];
    } else {
        float ss = 0.f; const float l2 = lam * li[NMAP - 1];
#pragma unroll
        for (int d = 0; d < 2; ++d)
#pragma unroll
            for (int r = 0; r < 16; ++r) { const float v = o[0][d][r] * li[0] - o[NMAP - 1][d][r] * l2; val[d][r] = v; ss += v * v; }
        ss += __shfl_xor(ss, 32);
        const float rstd = rsqrtf(ss * (1.0f / 64.0f) + 1e-6f) * oml;
#pragma unroll
        for (int d = 0; d < 2; ++d)
#pragma unroll
            for (int g = 0; g < 4; ++g) { const f32x4 gv = *(const f32x4*)(gout + 32 * d + 8 * g + 4 * hi);
#pragma unroll
                for (int i = 0; i < 4; ++i) val[d][4 * g + i] *= rstd * gv[i]; }
    }
    bf16_t* orow = Ob + (size_t)(wid * 32 + r32) * 1024 + 4 * hi;
#pragma unroll
    for (int d = 0; d < 2; ++d)
#pragma unroll
        for (int g = 0; g < 4; ++g) { u32x2 w; w.x = cvtpk(val[d][4 * g], val[d][4 * g + 1]); w.y = cvtpk(val[d][4 * g + 2], val[d][4 * g + 3]);
            *(u32x2*)(orow + 32 * d + 8 * g) = w; }
}

}
constexpr int NWAVES = 8;
constexpr int DM = 1024, NB = 4, SEQ = 8192, CL = 256, NTOKB = SEQ + CL, LROWS = NB * SEQ, MROWS = LROWS + NB * CL;
constexpr int NLAYER = 2, INC = 1952, ZP = 3072, NE = 16, FFD = 2048, CAPL = 1024, CAPC = 32, NKT = NTOKB / 64;
constexpr int ZQ = 1952, ZKV = 2336, ZEND = 2848;
constexpr float EPSF = 1e-6f, LOG2E = 1.4426950408889634f, HID_SCALE = 4.0f, YE_SCALE = 32.0f;
constexpr int N_PHASES = 22;
enum { I_X = 0, I_C, I_CTX, I_CCTX, I_WADA, I_BADA, I_GN1, I_WIN, I_GCQ, I_GCKV, I_WUQ, I_WUKV, I_GMQ, I_GMK, I_GDQ, I_GDK, I_LQ1, I_LK1, I_LQ2, I_LK2, I_GDO, I_GGQ, I_GGK, I_WO, I_GN2, I_WR, I_WG, I_WU, I_WD, N_IN };
constexpr size_t MiB = 1u << 20;
constexpr size_t WS_CTL = 0, CTL_ZERO_BYTES = 1 * MiB;
constexpr size_t WS_MOD = 1 * MiB;
constexpr size_t WS_LAM = WS_MOD + 256 * 1024;
constexpr size_t WS_TAB = WS_MOD + 320 * 1024;
constexpr size_t TAB_AROW = 0, TAB_ACOL = 128 * 8 * 8, TAB_GROW = TAB_ACOL + 64 * 8 * 8, TAB_GCOL = TAB_GROW + 128 * 16 * 8;
constexpr size_t WS_AFF = 2 * MiB, WS_AFFC = 4 * MiB;
constexpr size_t WS_IDX = 5 * MiB, WS_GATE = 6 * MiB;
constexpr size_t WS_INV = 7 * MiB;
constexpr size_t WS_SA = 10 * MiB, WS_SAE = 11 * MiB, WS_SW = 12 * MiB;
constexpr size_t WS_SSQ = 14 * MiB;
constexpr size_t WS_SWC = 13 * MiB;
constexpr size_t WS_WCAT8 = 72 * MiB;
constexpr size_t WS_WCAT = 16 * MiB;
constexpr size_t WS_WO = 28 * MiB;
constexpr size_t WS_CTXW = 32 * MiB;
constexpr size_t WS_H = 36 * MiB;
constexpr size_t WS_WGU = 102 * MiB;
constexpr size_t WS_WD = 230 * MiB;
constexpr size_t WS_YE = 294 * MiB;
constexpr size_t WS_Z = 430 * MiB;
constexpr size_t WS_QKV = 628 * MiB;
constexpr size_t WS_ATT = 793 * MiB;
constexpr size_t WS_DELTA = 430 * MiB;
constexpr size_t WS_XE = 430 * MiB;
constexpr size_t WS_HID = 566 * MiB;
constexpr size_t WS_XB = 859 * MiB;
constexpr size_t WS_END = 925 * MiB;
constexpr size_t QO_QM = 0, QO_QD = 25952256, QO_QG = 43253760, QO_KM = 77856768, QO_KD = 103809024, QO_KG = 121110528, QO_VM = 129761280, QO_VD = 147062784, QO_VG = 164364288;
static_assert(QO_VG + 8650752 == 173015040 && WS_QKV + 173015040 <= WS_ATT && WS_HID + (size_t)16 * 4352 * 2048 * 2 <= WS_XB, "ws map");
constexpr int CW_BAR = 4096, CW_Q = 16384;
constexpr int RING_BYTES = 131072, LDSCTL_OFF = RING_BYTES, MISC_OFF = LDSCTL_OFF + 320, LDS_BYTES = 163840;

#define GAS __attribute__((address_space(1)))
#define LAS __attribute__((address_space(3)))
typedef unsigned short bf16;
typedef unsigned v4u __attribute__((ext_vector_type(4)));
typedef unsigned v2u __attribute__((ext_vector_type(2)));
typedef float f32x4 __attribute__((ext_vector_type(4)));
typedef float f32x2 __attribute__((ext_vector_type(2)));
typedef GAS unsigned gu32;
#define RLX_AGENT __ATOMIC_RELAXED, __HIP_MEMORY_SCOPE_AGENT
#define LDS_WAIT() asm volatile("s_waitcnt lgkmcnt(0)" ::: "memory")
__device__ __forceinline__ unsigned pk2(float lo, float hi) { return att::cvtpk(lo, hi); }
__device__ __forceinline__ float bflo(unsigned w) { return __uint_as_float(w << 16); }
__device__ __forceinline__ float bfhi(unsigned w) { return __uint_as_float(w & 0xffff0000u); }
#define XB_TMO      128
#define XB_XCNT(j)  (256  + 64 * (j))
#define XB_XSUB(j)  (1280 + 64 * (j))
#define XB_XGEN(j)  (2304 + 64 * (j))
#define XB_TOP      3328
#define XB_TOPGEN   3392
#define XCD_BAR_WORDS 3456
#define XB_SPIN_CAP (1u << 18)

__device__ __forceinline__ unsigned xb_ld(unsigned* p)              { return __hip_atomic_load(p, __ATOMIC_RELAXED, __HIP_MEMORY_SCOPE_AGENT); }
__device__ __forceinline__ unsigned xb_add(unsigned* p, unsigned v) { return __hip_atomic_fetch_add(p, v, __ATOMIC_RELAXED, __HIP_MEMORY_SCOPE_AGENT); }
__device__ __forceinline__ unsigned xb_xcc_id() { return (unsigned)__builtin_amdgcn_s_getreg((3 << 11) | 20) & 0xFu; }
#define XB_SPIN(cond, bar) do { unsigned _sp = 0; while (cond) { __builtin_amdgcn_s_sleep(1); \
    if ((++_sp & 255u) == 0u) { if (xb_ld(&(bar)[XB_TMO])) break; if (_sp > XB_SPIN_CAP) { atomicAdd(&(bar)[XB_TMO], 1u); break; } } } } while (0)

struct XcdBarrier {
    unsigned* bar; unsigned x;
    volatile LAS unsigned* st;
};

__device__ __forceinline__ XcdBarrier xcd_barrier_post(unsigned* bar, volatile LAS unsigned* st) {
    XcdBarrier b; b.bar = bar; b.x = xb_xcc_id(); b.st = st;
    if (threadIdx.x == 0) (void)xb_add(&bar[XB_XCNT(b.x)], 1u);
    return b;
}
__device__ __forceinline__ void xcd_barrier_complete(unsigned* bar, unsigned x, unsigned& nloc, unsigned& nx) {
    const unsigned G = gridDim.x * gridDim.y * gridDim.z;
    unsigned sum, cnt, mine, sp = 0u;
    for (;;) {
        sum = 0u; cnt = 0u; mine = 0u;
#pragma unroll
        for (unsigned j = 0; j < 16; ++j) { const unsigned c = xb_ld(&bar[XB_XCNT(j)]); sum += c; cnt += (c > 0u) ? 1u : 0u; mine = (j == x) ? c : mine; }
        if (sum == G) break;
        __builtin_amdgcn_s_sleep(1);
        if ((++sp & 255u) == 0u) { if (xb_ld(&bar[XB_TMO])) break; if (sp > XB_SPIN_CAP) { atomicAdd(&bar[XB_TMO], 1u); break; } }
    }
    nloc = mine > 0u ? mine : 1u; nx = cnt > 0u ? cnt : 1u;
}

__device__ __forceinline__ void xcd_barrier(const XcdBarrier& b) {
    asm volatile("s_waitcnt vmcnt(0)" ::: "memory");
    __syncthreads();
    if (threadIdx.x == 0) {
        unsigned* bar = b.bar;
        __builtin_amdgcn_s_waitcnt(0);
        unsigned nloc = b.st[0], nx = b.st[1];
        if (nloc == 0u) { xcd_barrier_complete(bar, b.x, nloc, nx); b.st[0] = nloc; b.st[1] = nx; }
        const unsigned old = xb_add(&bar[XB_XSUB(b.x)], 1u);
        const unsigned gen = old / nloc;
        if (old + 1u == (gen + 1u) * nloc) {
            __builtin_amdgcn_fence(__ATOMIC_RELEASE, "agent");
            asm volatile("s_waitcnt vmcnt(0)" ::: "memory");
            const unsigned og = xb_add(&bar[XB_TOP], 1u);
            const unsigned tg = og / nx;
            if (og + 1u == (tg + 1u) * nx) xb_add(&bar[XB_TOPGEN], 1u);
            else XB_SPIN(xb_ld(&bar[XB_TOPGEN]) == tg, bar);
            __builtin_amdgcn_fence(__ATOMIC_ACQUIRE, "agent");
            xb_add(&bar[XB_XGEN(b.x)], 1u);
            asm volatile("s_waitcnt vmcnt(0)" ::: "memory");
        } else {
            XB_SPIN(xb_ld(&bar[XB_XGEN(b.x)]) == gen, bar);
            __builtin_amdgcn_fence(__ATOMIC_ACQUIRE, "agent");
            asm volatile("s_waitcnt vmcnt(0)" ::: "memory");
        }
    }
    __syncthreads();
}
struct Args { const float* in[N_IN]; float* out; unsigned char* ws; int ph_lo, ph_hi; };
static_assert(sizeof(Args) == 256, "Args has no padding bytes");
typedef const __attribute__((address_space(4))) Args* KA;
__device__ __forceinline__ KA kargs() { KA p = (KA)__builtin_amdgcn_kernarg_segment_ptr(); asm volatile("" : "+s"(p)); return p; }
struct Frame {
    LAS unsigned char* lds;
    volatile LAS unsigned* MISC;
    gu32* ctl;
    int tid, lane, wave, vcu, G;
};
__device__ __forceinline__ void relane(Frame& F) { int t = threadIdx.x; asm volatile("" : "+v"(t)); F.tid = t; F.lane = t & 63; F.wave = __builtin_amdgcn_readfirstlane(t >> 6); }
__device__ __forceinline__ float wave_sum(float v) {
#pragma unroll
    for (int o = 1; o < 64; o <<= 1) v += __shfl_xor(v, o);
    return v;
}
__device__ __forceinline__ float silu_f(float x) { return x / (1.0f + __expf(-x)); }

__device__ __forceinline__ void transpose_item(const float* __restrict__ W, int N, bf16* __restrict__ WT, int ldt, int k0, int n0, int rowbase, LAS float* scr, int lane) {
    float tv[32];
    { const float* wp = W + (size_t)(k0 + (lane >> 5)) * N + n0 + (lane & 31);
#pragma unroll
      for (int i = 0; i < 32; ++i) tv[i] = __builtin_nontemporal_load(wp + (size_t)(2 * i) * N); }
#pragma unroll
    for (int i = 0; i < 32; ++i) scr[(2 * i + (lane >> 5)) * 33 + (lane & 31)] = tv[i];
    LDS_WAIT(); asm volatile("" ::: "memory");
    const int c = lane & 7;
#pragma unroll
    for (int j = 0; j < 4; ++j) { const int n = (lane >> 3) + 8 * j; const LAS float* s = scr + (8 * c) * 33 + n;
        v4u o; o.x = pk2(s[0 * 33], s[1 * 33]); o.y = pk2(s[2 * 33], s[3 * 33]); o.z = pk2(s[4 * 33], s[5 * 33]); o.w = pk2(s[6 * 33], s[7 * 33]);
        *(v4u*)(WT + (size_t)(rowbase + n) * ldt + k0 + 8 * c) = o; }
    LDS_WAIT(); asm volatile("" ::: "memory");
}

__device__ __forceinline__ void transpose_item_i8(const float* __restrict__ W, int N, signed char* __restrict__ WT, int ldt, int k0, int n0, int rowbase, float qs, LAS float* scr, int lane) {
    float tv[32];
    { const float* wp = W + (size_t)(k0 + (lane >> 5)) * N + n0 + (lane & 31);
#pragma unroll
      for (int i = 0; i < 32; ++i) tv[i] = __builtin_nontemporal_load(wp + (size_t)(2 * i) * N); }
#pragma unroll
    for (int i = 0; i < 32; ++i) scr[(2 * i + (lane >> 5)) * 33 + (lane & 31)] = tv[i];
    LDS_WAIT(); asm volatile("" ::: "memory");
    const int c = lane & 3;
#pragma unroll
    for (int j = 0; j < 2; ++j) { const int n = (lane >> 2) + 16 * j; const LAS float* s = scr + (16 * c) * 33 + n; v4u o;
#pragma unroll
        for (int d = 0; d < 4; ++d) { unsigned w = 0u;
#pragma unroll
            for (int i = 0; i < 4; ++i) { const float f = fminf(fmaxf(s[(4 * d + i) * 33] * qs, -127.0f), 127.0f); w |= ((unsigned)((int)__builtin_rintf(f)) & 255u) << (8 * i); }
            o[d] = w; }
        *(v4u*)(WT + (size_t)(rowbase + n) * ldt + k0 + 16 * c) = o; }
    LDS_WAIT(); asm volatile("" ::: "memory");
}

__device__ __forceinline__ void transpose_item_f8(const float* __restrict__ W, int N, unsigned char* __restrict__ WT, int ldt, int k0, int n0, int rowbase, float qs, LAS float* scr, int lane) {
    float tv[32];
    { const float* wp = W + (size_t)(k0 + (lane >> 5)) * N + n0 + (lane & 31);
#pragma unroll
      for (int i = 0; i < 32; ++i) tv[i] = __builtin_nontemporal_load(wp + (size_t)(2 * i) * N); }
#pragma unroll
    for (int i = 0; i < 32; ++i) scr[(2 * i + (lane >> 5)) * 33 + (lane & 31)] = tv[i];
    LDS_WAIT(); asm volatile("" ::: "memory");
    const int c = lane & 3;
#pragma unroll
    for (int j = 0; j < 2; ++j) { const int n = (lane >> 2) + 16 * j; const LAS float* s = scr + (16 * c) * 33 + n; v4u o;
#pragma unroll
        for (int d = 0; d < 4; ++d) { float f[4];
#pragma unroll
            for (int i = 0; i < 4; ++i) f[i] = fminf(fmaxf(s[(4 * d + i) * 33] * qs, -448.0f), 448.0f);
            int w = __builtin_amdgcn_cvt_pk_fp8_f32(f[0], f[1], 0, false); w = __builtin_amdgcn_cvt_pk_fp8_f32(f[2], f[3], w, true); o[d] = (unsigned)w; }
        *(v4u*)(WT + (size_t)(rowbase + n) * ldt + k0 + 16 * c) = o; }
    LDS_WAIT(); asm volatile("" ::: "memory");
}

__device__ __forceinline__ void sincos_d(float af, float& c, float& s) {
    const double a = (double)af;
    const double q = __builtin_rint(a * 0.63661977236758134308);
    double r = __builtin_fma(-q, 1.57079632679489655800e+00, a); r = __builtin_fma(-q, 6.12323399573676603587e-17, r);
    const double r2 = r * r;
    double sp = -7.6471637318198164759e-13; sp = sp * r2 + 1.6059043836821614599e-10; sp = sp * r2 - 2.5052108385441718775e-08; sp = sp * r2 + 2.7557319223985890653e-06;
    sp = sp * r2 - 1.9841269841269841270e-04; sp = sp * r2 + 8.3333333333333333333e-03; sp = sp * r2 - 1.6666666666666666667e-01; const double sn = r + r * r2 * sp;
    double cp = 4.7794773323873852974e-14; cp = cp * r2 - 1.1470745597729724714e-11; cp = cp * r2 + 2.0876756987868098979e-09; cp = cp * r2 - 2.7557319223985890653e-07;
    cp = cp * r2 + 2.4801587301587301587e-05; cp = cp * r2 - 1.3888888888888888889e-03; cp = cp * r2 + 4.1666666666666666667e-02; cp = cp * r2 - 0.5; const double cs = 1.0 + r2 * cp;
    const int qi = (int)q & 3;
    const double cc = (qi == 0) ? cs : (qi == 1) ? -sn : (qi == 2) ? -cs : sn;
    const double ss = (qi == 0) ? sn : (qi == 1) ? cs : (qi == 2) ? -sn : -cs;
    c = (float)cc; s = (float)ss;
}

#define MEMFENCE() asm volatile("" ::: "memory")
__device__ __forceinline__ void p0_prologue(KA a, Frame& F) {
    relane(F);
    unsigned char* ws = a->ws;
    float* MOD = (float*)(ws + WS_MOD);
    if ((int)blockIdx.x < 192) {
        LAS float* sl = (LAS float*)F.lds + 4096;
        for (int i = F.tid; i < 5 * 1024; i += NWAVES * 64) { const int v = i >> 10, k = i & 1023; const float cv = (v < 4) ? a->in[I_C][v * 1024 + k] : a->in[I_CCTX][k]; sl[i] = silu_f(cv); }
        __syncthreads();
        for (int it = blockIdx.x; it < 192; it += F.G) {
            const int l = it / 96, col = (it % 96) * 64 + F.lane;
            const float* W = a->in[I_WADA] + (size_t)l * 1024 * 6144;
            float acc[5] = {0.f, 0.f, 0.f, 0.f, 0.f};
#pragma unroll 8
            for (int kk = 0; kk < 128; ++kk) { const int k = F.wave * 128 + kk; const float w = W[(size_t)k * 6144 + col];
#pragma unroll
                for (int v = 0; v < 5; ++v) acc[v] += sl[v * 1024 + k] * w; }
            LAS float* red = (LAS float*)F.lds;
#pragma unroll
            for (int v = 0; v < 5; ++v) red[(F.wave * 5 + v) * 64 + F.lane] = acc[v];
            __syncthreads();
            if (F.wave < 5) { float s2 = a->in[I_BADA][l * 6144 + col];
#pragma unroll
                for (int w = 0; w < 8; ++w) s2 += red[(w * 5 + F.wave) * 64 + F.lane];
                MOD[(l * 5 + F.wave) * 6144 + col] = s2; }
            __syncthreads();
        }
    }
    for (int it = blockIdx.x; it < 96; it += F.G) {
        const int l = it / 48, e = (it % 48) / 3, which = it % 3;
        float ss = 0.f;
        if (which < 2) { const float* W = (which ? a->in[I_WU] : a->in[I_WG]) + ((size_t)l * NE + e) * 1024 * 2048;
            for (int i = 0; i < 32; ++i) { const f32x4 v = *(const f32x4*)(W + (size_t)(32 * i) * 2048 + 4 * F.tid); ss += (v.x * v.x + v.y * v.y) + (v.z * v.z + v.w * v.w); } }
        else { const float* W = a->in[I_WD] + ((size_t)l * NE + e) * 2048 * 1024;
            for (int i = 0; i < 64; ++i) { const f32x2 v = *(const f32x2*)(W + (size_t)(32 * i) * 1024 + 2 * F.tid); ss += v.x * v.x + v.y * v.y; } }
        ss = wave_sum(ss);
        LAS float* red = (LAS float*)F.lds;
        if (F.lane == 0) red[F.wave] = ss;
        __syncthreads();
        if (F.tid == 0) { float t = 0.f; for (int w = 0; w < NWAVES; ++w) t += red[w]; const float rms = fmaxf(sqrtf(t * (1.0f / 65536.0f)), 1e-20f);
            ((float*)(ws + WS_SW))[l * 48 + 3 * e + which] = (which < 2) ? 5.0f * rms * (1.0f / 127.0f) : rms * (1.0f / 16.0f); }
        __syncthreads();
    }
    if ((int)blockIdx.x == 192 % F.G && F.wave == 0) {
        float* LAM = (float*)(ws + WS_LAM);
        for (int l = 0; l < NLAYER; ++l) {
            const float p1 = F.lane < 32 ? a->in[I_LQ1][l * 32 + F.lane] * a->in[I_LK1][l * 32 + F.lane] : 0.f;
            const float p2 = F.lane < 32 ? a->in[I_LQ2][l * 32 + F.lane] * a->in[I_LK2][l * 32 + F.lane] : 0.f;
            const float s1 = wave_sum(p1), s2 = wave_sum(p2);
            const float li = 0.8f - 0.6f * expf(-0.3f * (float)l);
            if (F.lane == 0) { LAM[2 * l] = expf(s1) - expf(s2) + li; LAM[2 * l + 1] = li; }
        }
    }
    if ((int)blockIdx.x == 193 % F.G) {
        f32x2* TA_R = (f32x2*)(ws + WS_TAB + TAB_AROW); f32x2* TA_C = (f32x2*)(ws + WS_TAB + TAB_ACOL); f32x2* TG_R = (f32x2*)(ws + WS_TAB + TAB_GROW); f32x2* TG_C = (f32x2*)(ws + WS_TAB + TAB_GCOL);
        const double b8 = 1.0 / __builtin_sqrt(__builtin_sqrt(__builtin_sqrt(10000.0))), b16 = 1.0 / __builtin_sqrt(__builtin_sqrt(__builtin_sqrt(__builtin_sqrt(10000.0))));
        for (int e = F.tid; e < 4608; e += NWAVES * 64) {
            int pos, i, nf; f32x2* dst;
            if (e < 1024) { pos = e >> 3; i = e & 7; nf = 8; dst = TA_R + e; }
            else if (e < 1536) { const int r = e - 1024; pos = r >> 3; i = r & 7; nf = 8; dst = TA_C + r; }
            else if (e < 3584) { const int r = e - 1536; pos = r >> 4; i = r & 15; nf = 16; dst = TG_R + r; }
            else { const int r = e - 3584; pos = r >> 4; i = r & 15; nf = 16; dst = TG_C + r; }
            double inv = 1.0; const double bb = (nf == 8) ? b8 : b16;
            for (int j = 0; j < i; ++j) inv *= bb;
            const float ang = (float)pos * (float)inv;
            float c, s; sincos_d(ang, c, s);
            *dst = (f32x2){c, s};
        }
    }
    for (int it = blockIdx.x; it < 896; it += F.G) {
        const int l = it / 448; int r = it % 448;
        int kb, nb, R, roff, ncols, orow0; const float *Wu, *gg;
        if (r < 192) { kb = r / 6; nb = r % 6; R = 256; roff = 0; ncols = 384; orow0 = ZQ + nb * 64; Wu = a->in[I_WUQ] + (size_t)l * 256 * 384; gg = a->in[I_GCQ] + l * 256; }
        else { r -= 192; kb = r / 8; nb = r % 8; R = 128; roff = 256; ncols = 512; orow0 = ZKV + nb * 64; Wu = a->in[I_WUKV] + (size_t)l * 128 * 512; gg = a->in[I_GCKV] + l * 128; }
        const float* Win = a->in[I_WIN] + (size_t)l * 1024 * INC;
        LAS float* As = (LAS float*)F.lds; LAS float* Bs = As + 32 * 257;
        for (int idx = F.tid; idx < 32 * R; idx += NWAVES * 64) { const int kk = idx / R, rr = idx % R; As[kk * 257 + rr] = Win[(size_t)(kb * 32 + kk) * INC + roff + rr]; }
        for (int idx = F.tid; idx < R * 64; idx += NWAVES * 64) { const int rr = idx >> 6, n = idx & 63; Bs[rr * 64 + n] = gg[rr] * Wu[(size_t)rr * ncols + nb * 64 + n]; }
        __syncthreads();
        const int kk = F.tid & 31, ng = F.tid >> 5;
        f32x4 acc = (f32x4){0.f, 0.f, 0.f, 0.f};
        for (int rr = 0; rr < R; ++rr) { const float av = As[kk * 257 + rr]; const f32x4 bv = *(const LAS f32x4*)(Bs + rr * 64 + ng * 4); acc += av * bv; }
        bf16* Wc = (bf16*)(ws + WS_WCAT) + (size_t)l * ZP * 1024;
#pragma unroll
        for (int j = 0; j < 4; ++j) Wc[(size_t)(orow0 + ng * 4 + j) * 1024 + kb * 32 + kk] = (bf16)(pk2(acc[j], 0.f) & 0xffffu);
        __syncthreads();
    }
    {
        LAS float* scr = (LAS float*)(F.lds + F.wave * 16384);
        const int gw = F.vcu * NWAVES + F.wave, NGW = F.G * NWAVES;
        constexpr int I_IN = 16 * 61, I_O = 16 * 32, PER_L = I_IN + I_O;
        for (int it = gw; it < NLAYER * PER_L; it += NGW) {
            const int l = it / PER_L; int r = it % PER_L;
            if (r < I_IN) { const int kb = r / 61, nb = r % 61; transpose_item(a->in[I_WIN] + (size_t)l * 1024 * INC, INC, (bf16*)(ws + WS_WCAT) + (size_t)l * ZP * 1024, 1024, kb * 64, nb * 32, nb * 32, scr, F.lane); }
            else { r -= I_IN; const int kb = r / 32, nb = r % 32; transpose_item(a->in[I_WO] + (size_t)l * 1024 * 1024, 1024, (bf16*)(ws + WS_WO) + (size_t)l * 1024 * 1024, 1024, kb * 64, nb * 32, nb * 32, scr, F.lane); }
        }
        const int gt = F.vcu * (NWAVES * 64) + F.tid, NGT = F.G * NWAVES * 64;
        constexpr int PADV = (ZP - ZEND) * 1024 * 2 / 16;
        for (int i = gt; i < NLAYER * PADV; i += NGT) { const int l = i / PADV, j = i % PADV; ((v4u*)((bf16*)(ws + WS_WCAT) + ((size_t)l * ZP + ZEND) * 1024))[j] = (v4u){0u, 0u, 0u, 0u}; }
    }
}

__device__ __forceinline__ void phase_a(KA a, Frame& F, int l) {
    relane(F);
    unsigned char* ws = a->ws;
    const float* MOD = (const float*)(ws + WS_MOD);
    const int* INV = (const int*)(ws + WS_INV);
    const unsigned char* YE = (const unsigned char*)(ws + WS_YE);
    const bool fin = (l == NLAYER);
    const int nrows = fin ? LROWS : MROWS;
    const int gw = F.vcu * NWAVES + F.wave, NGW = F.G * NWAVES;
#define PA_LOAD(r, XF, XB, IV) do { if (l == 0) { const float* src_ = ((r) >= LROWS) ? a->in[I_CTX] + (size_t)((r) - LROWS) * 1024 : a->in[I_X] + (size_t)(r) * 1024; \
            _Pragma("unroll") for (int j = 0; j < 4; ++j) XF[j] = *(const f32x4*)(src_ + 4 * F.lane + 256 * j); } \
        else { const bf16* xb_ = (const bf16*)(ws + WS_XB) + (size_t)(r) * 1024; _Pragma("unroll") for (int j = 0; j < 4; ++j) XB[j] = *(const v2u*)(xb_ + 4 * F.lane + 256 * j); \
            IV = INV[(size_t)(r) * 16 + (F.lane & 15)]; } } while (0)
    f32x4 cf[4]; v2u cb[4]; int civ = -1;
#pragma unroll
    for (int j = 0; j < 4; ++j) { cf[j] = (f32x4){0.f, 0.f, 0.f, 0.f}; cb[j] = (v2u){0u, 0u}; }
    if (gw < nrows) PA_LOAD(gw, cf, cb, civ);
    for (int row = gw; row < nrows; row += NGW) {
        const bool isc = row >= LROWS; const int v = isc ? 4 : (row >> 13);
        bf16* xb = (bf16*)(ws + WS_XB) + (size_t)row * 1024;
        const int nrow = row + NGW; f32x4 nf[4]; v2u nb[4]; int niv = -1;
#pragma unroll
        for (int j = 0; j < 4; ++j) { nf[j] = cf[j]; nb[j] = cb[j]; }
        if (nrow < nrows) PA_LOAD(nrow, nf, nb, niv);
        f32x4 xv[4];
        if (l == 0) {
#pragma unroll
            for (int j = 0; j < 4; ++j) xv[j] = cf[j]; }
        else {
#pragma unroll
            for (int j = 0; j < 4; ++j) xv[j] = (f32x4){bflo(cb[j].x), bfhi(cb[j].x), bflo(cb[j].y), bfhi(cb[j].y)}; }
        if (l > 0) {
            const float* ga2 = MOD + ((l - 1) * 5 + v) * 6144 + 5 * 1024;
            f32x4 acc[4];
#pragma unroll
            for (int j = 0; j < 4; ++j) acc[j] = (f32x4){0.f, 0.f, 0.f, 0.f};
            unsigned sel = (unsigned)(__ballot(civ >= 0) & 0xFFFFull);
            while (sel) {
                int sl[4]; float on[4];
#pragma unroll
                for (int k = 0; k < 4; ++k) { if (sel) { const int e = __builtin_ctz(sel); sel &= sel - 1u; sl[k] = __builtin_amdgcn_readlane(civ, e); on[k] = 1.0f; } else { sl[k] = sl[0]; on[k] = 0.0f; } }
                unsigned w[4][4];
#pragma unroll
                for (int k = 0; k < 4; ++k) { const unsigned char* yr = YE + (size_t)sl[k] * 1024 + 4 * F.lane;
#pragma unroll
                    for (int j = 0; j < 4; ++j) w[k][j] = *(const unsigned*)(yr + 256 * j); }
#pragma unroll
                for (int k = 0; k < 4; ++k)
#pragma unroll
                    for (int j = 0; j < 4; ++j) { const f32x2 lo = __builtin_amdgcn_cvt_pk_f32_fp8((int)w[k][j], false), hi = __builtin_amdgcn_cvt_pk_f32_fp8((int)w[k][j], true);
                        acc[j] += on[k] * (f32x4){lo.x, lo.y, hi.x, hi.y}; }
            }
#pragma unroll
            for (int j = 0; j < 4; ++j) { const f32x4 g = *(const f32x4*)(ga2 + 4 * F.lane + 256 * j); xv[j] += g * (acc[j] * (1.0f / YE_SCALE)); }
        }
#pragma unroll
        for (int j = 0; j < 4; ++j) { cf[j] = nf[j]; cb[j] = nb[j]; }
        civ = niv;
        if (fin) {
#pragma unroll
            for (int j = 0; j < 4; ++j) *(f32x4*)(a->out + (size_t)row * 1024 + 4 * F.lane + 256 * j) = xv[j];
            continue; }
#pragma unroll
        for (int j = 0; j < 4; ++j) { v2u w; w.x = pk2(xv[j].x, xv[j].y); w.y = pk2(xv[j].z, xv[j].w); *(v2u*)(xb + 4 * F.lane + 256 * j) = w; }
        float ss = 0.f;
#pragma unroll
        for (int j = 0; j < 4; ++j) ss += (xv[j].x * xv[j].x + xv[j].y * xv[j].y) + (xv[j].z * xv[j].z + xv[j].w * xv[j].w);
        const float rstd = rsqrtf(wave_sum(ss) * (1.0f / 1024.0f) + EPSF);
        const float* g1 = a->in[I_GN1] + l * 1024; const float* sh = MOD + (l * 5 + v) * 6144; const float* sc = sh + 1024;
        float am = 0.f;
#pragma unroll
        for (int j = 0; j < 4; ++j) { const int c0 = 4 * F.lane + 256 * j; const f32x4 g = *(const f32x4*)(g1 + c0), s1 = *(const f32x4*)(sc + c0), b1 = *(const f32x4*)(sh + c0);
            xv[j] = xv[j] * rstd * g * (1.0f + s1) + b1;
            am = fmaxf(fmaxf(am, fmaxf(fabsf(xv[j].x), fabsf(xv[j].y))), fmaxf(fabsf(xv[j].z), fabsf(xv[j].w))); }
#pragma unroll
        for (int o = 1; o < 64; o <<= 1) am = fmaxf(am, __shfl_xor(am, o));
        const float qs = am > 0.f ? 127.0f / am : 0.f;
        signed char* h8 = (signed char*)(ws + WS_H) + (size_t)row * 1024;
#pragma unroll
        for (int j = 0; j < 4; ++j) { const int q0 = (int)__builtin_rintf(xv[j].x * qs), q1 = (int)__builtin_rintf(xv[j].y * qs), q2 = (int)__builtin_rintf(xv[j].z * qs), q3 = (int)__builtin_rintf(xv[j].w * qs);
            *(unsigned*)(h8 + 4 * F.lane + 256 * j) = (unsigned)(q0 & 255) | ((unsigned)(q1 & 255) << 8) | ((unsigned)(q2 & 255) << 16) | ((unsigned)(q3 & 255) << 24); }
        if (F.lane == 0) ((float*)(ws + WS_SA))[row] = am * (1.0f / 127.0f);
    }
#undef PA_LOAD
    if (l == 0) {
        const bf16* Wc = (const bf16*)(ws + WS_WCAT); signed char* W8 = (signed char*)(ws + WS_WCAT8); float* SWC = (float*)(ws + WS_SWC);
        for (int r = gw; r < NLAYER * ZP; r += NGW) {
            float wv[16]; float am = 0.f;
#pragma unroll
            for (int j = 0; j < 2; ++j) { const v4u w = *(const v4u*)(Wc + (size_t)r * 1024 + 8 * F.lane + 512 * j);
                wv[8 * j + 0] = bflo(w.x); wv[8 * j + 1] = bfhi(w.x); wv[8 * j + 2] = bflo(w.y); wv[8 * j + 3] = bfhi(w.y); wv[8 * j + 4] = bflo(w.z); wv[8 * j + 5] = bfhi(w.z); wv[8 * j + 6] = bflo(w.w); wv[8 * j + 7] = bfhi(w.w); }
#pragma unroll
            for (int i = 0; i < 16; ++i) am = fmaxf(am, fabsf(wv[i]));
#pragma unroll
            for (int o = 1; o < 64; o <<= 1) am = fmaxf(am, __shfl_xor(am, o));
            const float qs = am > 0.f ? 127.0f / am : 0.f;
#pragma unroll
            for (int j = 0; j < 2; ++j) { unsigned w0 = 0u, w1 = 0u;
#pragma unroll
                for (int i = 0; i < 4; ++i) { w0 |= ((unsigned)((int)__builtin_rintf(wv[8 * j + i] * qs)) & 255u) << (8 * i); w1 |= ((unsigned)((int)__builtin_rintf(wv[8 * j + 4 + i] * qs)) & 255u) << (8 * i); }
                v2u o; o.x = w0; o.y = w1; *(v2u*)(W8 + (size_t)r * 1024 + 8 * F.lane + 512 * j) = o; }
            if (F.lane == 0) SWC[r] = am * (1.0f / 127.0f);
        }
    }
}

__device__ __forceinline__ void ld8(const bf16* p, float* f) { const v4u w = *(const v4u*)p; f[0] = bflo(w.x); f[1] = bfhi(w.x); f[2] = bflo(w.y); f[3] = bfhi(w.y); f[4] = bflo(w.z); f[5] = bfhi(w.z); f[6] = bflo(w.w); f[7] = bfhi(w.w); }
__device__ __forceinline__ v4u pk8(const float* f) { v4u w; w.x = pk2(f[0], f[1]); w.y = pk2(f[2], f[3]); w.z = pk2(f[4], f[5]); w.w = pk2(f[6], f[7]); return w; }
template <int N> __device__ __forceinline__ float ssq_row(const bf16* p) { float s = 0.f;
#pragma unroll
    for (int c = 0; c < N / 8; ++c) { float f[8]; ld8(p + 8 * c, f);
#pragma unroll
        for (int i = 0; i < 8; ++i) s += f[i] * f[i];
        if ((c & 7) == 7) MEMFENCE(); }
    return s; }
template <int NP> __device__ __forceinline__ void rope_pairs(float* x, const f32x2* trow, const f32x2* tcol) {
#pragma unroll
    for (int i = 0; i < NP; ++i) { const f32x2 cs = (i < NP / 2) ? trow[i] : tcol[i - NP / 2];
        const float x0 = x[2 * i], x1 = x[2 * i + 1]; x[2 * i] = x0 * cs.x - x1 * cs.y; x[2 * i + 1] = x0 * cs.y + x1 * cs.x; }
}
__device__ __forceinline__ void store_v_tile(char* vt, int lane, const float* v  ) {
    char* p = vt + (lane >> 4) * 1024 + ((lane >> 3) & 1) * 512 + (lane & 7) * 64;
#pragma unroll
    for (int d = 0; d < 2; ++d)
#pragma unroll
        for (int c = 0; c < 4; ++c) *(v4u*)(p + d * 4096 + c * 16) = pk8(v + d * 32 + c * 8);
}
template <bool ROPE> __device__ __forceinline__ v4u proc8(v4u w, float r, const float* g, const f32x2* cs, float qs) {
    float f[8] = {bflo(w.x), bfhi(w.x), bflo(w.y), bfhi(w.y), bflo(w.z), bfhi(w.z), bflo(w.w), bfhi(w.w)};
#pragma unroll
    for (int i = 0; i < 8; ++i) f[i] *= r * g[i];
    if (ROPE) {
#pragma unroll
        for (int i = 0; i < 4; ++i) { const f32x2 t = cs[i]; const float x0 = f[2 * i], x1 = f[2 * i + 1]; f[2 * i] = x0 * t.x - x1 * t.y; f[2 * i + 1] = x0 * t.y + x1 * t.x; }
    }
#pragma unroll
    for (int i = 0; i < 8; ++i) f[i] *= qs;
    return pk8(f);
}
__device__ __forceinline__ v2u pk8_f8(const float* f) { int w0 = __builtin_amdgcn_cvt_pk_fp8_f32(f[0], f[1], 0, false); w0 = __builtin_amdgcn_cvt_pk_fp8_f32(f[2], f[3], w0, true);
    int w1 = __builtin_amdgcn_cvt_pk_fp8_f32(f[4], f[5], 0, false); w1 = __builtin_amdgcn_cvt_pk_fp8_f32(f[6], f[7], w1, true); return (v2u){(unsigned)w0, (unsigned)w1}; }
template <bool ROPE> __device__ __forceinline__ v2u proc8f(v4u w, float r, const float* g, const f32x2* cs, float qs) {
    float f[8] = {bflo(w.x), bfhi(w.x), bflo(w.y), bfhi(w.y), bflo(w.z), bfhi(w.z), bflo(w.w), bfhi(w.w)};
#pragma unroll
    for (int i = 0; i < 8; ++i) f[i] *= r * g[i];
    if (ROPE) {
#pragma unroll
        for (int i = 0; i < 4; ++i) { const f32x2 t = cs[i]; const float x0 = f[2 * i], x1 = f[2 * i + 1]; f[2 * i] = x0 * t.x - x1 * t.y; f[2 * i + 1] = x0 * t.y + x1 * t.x; }
    }
#pragma unroll
    for (int i = 0; i < 8; ++i) f[i] *= qs;
    return pk8_f8(f);
}
__device__ __forceinline__ att::i32x6a fp6_group(const v4u& c0, const v4u& c1, const v4u& c2, const v4u& c3) {
    att::u32x16 w; w[0] = c0.x; w[1] = c0.y; w[2] = c0.z; w[3] = c0.w; w[4] = c1.x; w[5] = c1.y; w[6] = c1.z; w[7] = c1.w; w[8] = c2.x; w[9] = c2.y; w[10] = c2.z; w[11] = c2.w; w[12] = c3.x; w[13] = c3.y; w[14] = c3.z; w[15] = c3.w;
    return att::cvt_fp6x32(w); }
__device__ __forceinline__ void store_qgroup(unsigned char* q, const att::i32x6a& g) { *(v2u*)q = (v2u){(unsigned)g[0], (unsigned)g[1]}; *(v2u*)(q + 8) = (v2u){(unsigned)g[2], (unsigned)g[3]}; *(v2u*)(q + 16) = (v2u){(unsigned)g[4], (unsigned)g[5]}; }
__device__ __forceinline__ void store_kgroup(char* kt, int pb, int j, int lane, const att::i32x6a& g) {
    *(v4u*)(kt + j * 1024 + lane * 16) = (v4u){(unsigned)g[0], (unsigned)g[1], (unsigned)g[2], (unsigned)g[3]}; *(v2u*)(kt + pb + j * 512 + lane * 8) = (v2u){(unsigned)g[4], (unsigned)g[5]}; }
__device__ __forceinline__ float ssq8(v4u w) { const float f[8] = {bflo(w.x), bfhi(w.x), bflo(w.y), bfhi(w.y), bflo(w.z), bfhi(w.z), bflo(w.w), bfhi(w.w)}; float s = 0.f;
#pragma unroll
    for (int i = 0; i < 8; ++i) s += f[i] * f[i];
    return s; }
__device__ __forceinline__ v4u scale8(v4u w, float r) { float f[8] = {bflo(w.x), bfhi(w.x), bflo(w.y), bfhi(w.y), bflo(w.z), bfhi(w.z), bflo(w.w), bfhi(w.w)};
#pragma unroll
    for (int i = 0; i < 8; ++i) f[i] *= r;
    return pk8(f); }
__device__ __forceinline__ void store_v_tile_pk(char* vt, int lane, const v4u* w) {
    char* p = vt + (lane >> 4) * 1024 + ((lane >> 3) & 1) * 512 + (lane & 7) * 64;
#pragma unroll
    for (int c = 0; c < 8; ++c) *(v4u*)(p + (c >> 2) * 4096 + (c & 3) * 16) = w[c];
}
__device__ __forceinline__ void store_v_tile_f8(char* vt, int lane, const v4u* w, float sc, LAS unsigned char* scr) {
    LAS unsigned char* p = scr + (2 * ((lane >> 2) & 1) + (lane >> 5)) * 1024 + 4 * ((lane >> 3) & 3) + (lane & 3);
#pragma unroll
    for (int c = 0; c < 8; ++c) { const float f[8] = {bflo(w[c].x), bfhi(w[c].x), bflo(w[c].y), bfhi(w[c].y), bflo(w[c].z), bfhi(w[c].z), bflo(w[c].w), bfhi(w[c].w)};
#pragma unroll
        for (int i = 0; i < 8; i += 2) { const int b8 = __builtin_amdgcn_cvt_pk_fp8_f32(f[i] * sc, f[i + 1] * sc, 0, false);
            p[(8 * c + i) * 16] = (unsigned char)b8; p[(8 * c + i + 1) * 16] = (unsigned char)(b8 >> 8); } }
    LDS_WAIT(); asm volatile("" ::: "memory");
#pragma unroll
    for (int i = 0; i < 4; ++i) *(v4u*)(vt + i * 1024 + lane * 16) = *(const LAS v4u*)(scr + i * 1024 + lane * 16);
    LDS_WAIT(); asm volatile("" ::: "memory");
}
__device__ __forceinline__ void phase_c(KA a, Frame& F, int l) {
    relane(F);
    unsigned char* ws = a->ws;
    const bf16* Z = (const bf16*)(ws + WS_Z); const float* SSQ = (const float*)(ws + WS_SSQ);
    unsigned char* qkv = ws + WS_QKV;
    LAS unsigned char* vscr = (LAS unsigned char*)F.lds + F.wave * 4096;
    const f32x2* TA_R = (const f32x2*)(ws + WS_TAB + TAB_AROW); const f32x2* TA_C = (const f32x2*)(ws + WS_TAB + TAB_ACOL);
    const f32x2* TG_R = (const f32x2*)(ws + WS_TAB + TAB_GROW); const f32x2* TG_C = (const f32x2*)(ws + WS_TAB + TAB_GCOL);
    const int gw = F.vcu * NWAVES + F.wave, NGW = F.G * NWAVES, lane = F.lane;
    for (int id = gw; id < 528 * 32; id += NGW) {
        const int tile = id % 528, job = id / 528;
        const int b = tile / NKT, tt = tile % NKT; const bool isc = tt >= 128;
        const int zrow = isc ? LROWS + b * CL + (tt - 128) * 64 + lane : b * SEQ + tt * 64 + lane;
        const int tok = tt * 64 + lane;
        const bf16* zr = Z + (size_t)zrow * ZP;
        const f32x2* tar = TA_R + (isc ? 0 : tt) * 8; const f32x2* tac = TA_C + lane * 8;
        const f32x2* tgr = TG_R + (isc ? 0 : tt) * 16; const f32x2* tgc = TG_C + lane * 16;
        MEMFENCE();
        if (job < 4) {
            const int h = job;
            float r1; { const f32x4 s0 = *(const f32x4*)(SSQ + (size_t)zrow * 12), s1 = *(const f32x4*)(SSQ + (size_t)zrow * 12 + 4); r1 = rsqrtf((((s0.x + s0.y) + (s0.z + s0.w)) + ((s1.x + s1.y) + (s1.z + s1.w))) * (1.0f / 256.0f) + EPSF); }
            v4u w[12]; float ss = 0.f;
#pragma unroll
            for (int c = 0; c < 12; ++c) { w[c] = *(const v4u*)(zr + ZQ + h * 96 + 8 * c); ss += ssq8(w[c]); }
            MEMFENCE();
            const float r = r1 * rsqrtf(ss * r1 * r1 * (1.0f / 96.0f) + EPSF); const float* g = a->in[I_GMQ] + l * 96;
            const float qs = att::FQ96;
            unsigned char* q = (unsigned char*)(qkv + QO_QM) + ((size_t)(b * 4 + h) * NTOKB + tok) * 72;
#pragma unroll
            for (int gq = 0; gq < 3; ++gq) { v4u o[4];
#pragma unroll
                for (int cc = 0; cc < 4; ++cc) { const int c = 4 * gq + cc;
                    if (c < 8 || isc) o[cc] = proc8<false>(w[c], r, g + 8 * c, nullptr, qs);
                    else o[cc] = proc8<true>(w[c], r, g + 8 * c, (c < 10) ? tar + 4 * (c - 8) : tac + 4 * (c - 10), qs); }
                store_qgroup(q + 24 * gq, fp6_group(o[0], o[1], o[2], o[3])); MEMFENCE(); }
        } else if (job < 8) {
            const int h = job - 4;
            float r1; { const f32x4 s2 = *(const f32x4*)(SSQ + (size_t)zrow * 12 + 8); r1 = rsqrtf(((s2.x + s2.y) + (s2.z + s2.w)) * (1.0f / 128.0f) + EPSF); }
            v4u w[12]; float ss = 0.f, s2 = 0.f;
#pragma unroll
            for (int c = 0; c < 8; ++c) { w[c] = *(const v4u*)(zr + ZKV + h * 128 + 8 * c); ss += ssq8(w[c]); }
#pragma unroll
            for (int c = 0; c < 4; ++c) { w[8 + c] = *(const v4u*)(zr + 384 + 8 * c); s2 += ssq8(w[8 + c]); }
            MEMFENCE();
            const float r2 = rsqrtf((ss * r1 * r1 + s2) * (1.0f / 96.0f) + EPSF); const float* g = a->in[I_GMK] + l * 96;
            char* kt = (char*)(qkv + QO_KM) + ((size_t)(b * 4 + h) * NKT + tt) * 5120;
#pragma unroll
            for (int gq = 0; gq < 3; ++gq) { v4u o[4];
#pragma unroll
                for (int cc = 0; cc < 4; ++cc) { const int c = 4 * gq + cc;
                    if (c < 8) o[cc] = proc8<false>(w[c], r1 * r2, g + 8 * c, nullptr, 1.0f);
                    else if (isc) o[cc] = proc8<false>(w[c], r2, g + 8 * c, nullptr, 1.0f);
                    else o[cc] = proc8<true>(w[c], r2, g + 8 * c, (c < 10) ? tar + 4 * (c - 8) : tac + 4 * (c - 10), 1.0f); }
                store_kgroup(kt, 3072, gq, lane, fp6_group(o[0], o[1], o[2], o[3])); MEMFENCE(); }
            v4u vw[8];
#pragma unroll
            for (int c = 0; c < 8; ++c) vw[c] = *(const v4u*)(zr + ZKV + h * 128 + 64 + 8 * c);
            store_v_tile_f8((char*)(qkv + QO_VM) + ((size_t)(b * 4 + h) * NKT + tt) * 4096, lane, vw, r1, vscr);
        } else if (job < 16) {
            const bool isk = job >= 12; const int h = (job - 8) & 3;
            const bf16* zp = zr + (isk ? 672 : 416) + h * 64; const float* g = (isk ? a->in[I_GDK] : a->in[I_GDQ]) + l * 32;
            const float qs = isk ? 1.0f : att::FQ32;
            v4u w[8]; float ss[2] = {0.f, 0.f};
#pragma unroll
            for (int c = 0; c < 8; ++c) { w[c] = *(const v4u*)(zp + 8 * c); ss[c >> 2] += ssq8(w[c]); }
            MEMFENCE();
            const float r0 = rsqrtf(ss[0] * (1.0f / 32.0f) + EPSF), r1 = rsqrtf(ss[1] * (1.0f / 32.0f) + EPSF);
            char* kt = (char*)(qkv + QO_KD) + ((size_t)(b * 4 + h) * NKT + tt) * 3072;
            unsigned char* q = (unsigned char*)(qkv + QO_QD) + ((size_t)(b * 4 + h) * NTOKB + tok) * 48;
#pragma unroll
            for (int gq = 0; gq < 2; ++gq) { v4u o[4];
#pragma unroll
                for (int cm = 0; cm < 4; ++cm) { const int c = 4 * gq + cm;
                    if (isc) o[cm] = proc8<false>(w[c], gq ? r1 : r0, g + 8 * cm, nullptr, qs);
                    else o[cm] = proc8<true>(w[c], gq ? r1 : r0, g + 8 * cm, (cm < 2) ? tar + 4 * cm : tac + 4 * (cm - 2), qs); }
                const att::i32x6a gr = fp6_group(o[0], o[1], o[2], o[3]);
                if (isk) store_kgroup(kt, 2048, gq, lane, gr); else store_qgroup(q + 24 * gq, gr);
                MEMFENCE(); }
        } else if (job < 20) {
            const int h = job - 16; v4u vw[8];
#pragma unroll
            for (int c = 0; c < 8; ++c) vw[c] = *(const v4u*)(zr + 928 + h * 64 + 8 * c);
            store_v_tile_f8((char*)(qkv + QO_VD) + ((size_t)(b * 4 + h) * NKT + tt) * 4096, lane, vw, 1.0f, vscr);
        } else if (job < 30) {
            const bool isk = job >= 28; const int h = isk ? job - 28 : job - 20;
            const bf16* zp = zr + (isk ? 1696 : 1184) + h * 64; const float* g = (isk ? a->in[I_GGK] : a->in[I_GGQ]) + l * 64;
            const float qs = isk ? 1.0f : att::FQ64;
            v4u w[8]; float ss = 0.f;
#pragma unroll
            for (int c = 0; c < 8; ++c) { w[c] = *(const v4u*)(zp + 8 * c); ss += ssq8(w[c]); }
            MEMFENCE();
            const float r = rsqrtf(ss * (1.0f / 64.0f) + EPSF);
            char* kt = (char*)(qkv + QO_KG) + ((size_t)(b * 2 + h) * NKT + tt) * 3072;
            unsigned char* q = (unsigned char*)(qkv + QO_QG) + ((size_t)(b * 8 + h) * NTOKB + tok) * 48;
#pragma unroll
            for (int gq = 0; gq < 2; ++gq) { v4u o[4];
#pragma unroll
                for (int cc = 0; cc < 4; ++cc) { const int c = 4 * gq + cc;
                    if (isc) o[cc] = proc8<false>(w[c], r, g + 8 * c, nullptr, qs);
                    else o[cc] = proc8<true>(w[c], r, g + 8 * c, (c < 4) ? tgr + 4 * c : tgc + 4 * (c - 4), qs); }
                const att::i32x6a gr = fp6_group(o[0], o[1], o[2], o[3]);
                if (isk) store_kgroup(kt, 2048, gq, lane, gr); else store_qgroup(q + 24 * gq, gr);
                MEMFENCE(); }
        } else {
            const int h = job - 30; v4u vw[8];
#pragma unroll
            for (int c = 0; c < 8; ++c) vw[c] = *(const v4u*)(zr + 1824 + h * 64 + 8 * c);
            store_v_tile_f8((char*)(qkv + QO_VG) + ((size_t)(b * 2 + h) * NKT + tt) * 4096, lane, vw, 1.0f, vscr);
        }
        MEMFENCE();
    }
}

#define ATT_UNIT(KD, NM) att::attn_unit_f8<KD, NM, ABL>
#define ATT_DIFF att::attn_unit_f8<32, 2, ABL>
template <int ABL>
__device__ __forceinline__ void phase_d(KA a, Frame& F, int l, bool last) {
    relane(F);
    unsigned char* ws = a->ws; unsigned char* qkv = ws + WS_QKV;
    bf16* ATT = (bf16*)(ws + (ABL ? WS_Z : WS_ATT));
    const float* LAM = (const float*)(ws + WS_LAM);
    const float lam = LAM[2 * l], oml = 1.0f - LAM[2 * l + 1];
    const float* gdo = a->in[I_GDO] + l * 64;
    ALDS char* lds = (ALDS char*)F.lds;
    const int nctx = last ? 0 : 64;
    for (int id = F.vcu; id < 512 + nctx; id += F.G) {
        int b, h, q0, t0, t1; size_t orow;
        if (id < 512) { const int x = (id & 255) >> 5; b = x >> 1; h = 2 * (x & 1) + (id >> 8); q0 = (id & 31) * 256; t0 = 0; t1 = NKT; orow = (size_t)b * SEQ + q0; }
        else { const int c = id - 512; b = c >> 4; h = c & 15; if (h >= 4) continue; q0 = SEQ; t0 = 128; t1 = NKT; orow = (size_t)LROWS + b * CL; }
        ATT_UNIT(96, 1)((const unsigned char*)(qkv + QO_QM) + ((size_t)(b * 4 + h) * NTOKB + q0) * 72, (const char*)(qkv + QO_KM) + (size_t)(b * 4 + h) * NKT * 5120,
                        (const char*)(qkv + QO_VM) + (size_t)(b * 4 + h) * NKT * 4096, t0, t1, ATT + orow * 1024 + h * 64, lds, 0.f, gdo, 0.f);
    }
    for (int id = 512 + F.vcu; id < 1024 + nctx; id += F.G) {
        int b, h, q0, t0, t1; size_t orow;
        if (id < 1024) { const int x = (id & 255) >> 5; b = x >> 1; h = 2 * (x & 1) + ((id >> 8) - 2); q0 = (id & 31) * 256; t0 = 0; t1 = NKT; orow = (size_t)b * SEQ + q0; }
        else { const int c = id - 1024; b = c >> 4; h = (c & 15) - 4; if (h < 0 || h >= 4) continue; q0 = SEQ; t0 = 128; t1 = NKT; orow = (size_t)LROWS + b * CL; }
        ATT_DIFF((const unsigned char*)(qkv + QO_QD) + ((size_t)(b * 4 + h) * NTOKB + q0) * 48, (const char*)(qkv + QO_KD) + (size_t)(b * 4 + h) * NKT * 3072,
                        (const char*)(qkv + QO_VD) + (size_t)(b * 4 + h) * NKT * 4096, t0, t1, ATT + orow * 1024 + 256 + h * 64, lds, lam, gdo, oml);
    }
    for (int id = 1024 + F.vcu; id < 2048 + nctx; id += F.G) {
        int b, h, q0, t0, t1; size_t orow;
        if (id < 2048) { const int x = (id & 255) >> 5; b = x >> 1; h = 4 * (x & 1) + ((id >> 8) - 4); q0 = (id & 31) * 256; t0 = 0; t1 = NKT; orow = (size_t)b * SEQ + q0; }
        else { const int c = id - 2048; b = c >> 4; h = (c & 15) - 8; if (h < 0) continue; q0 = SEQ; t0 = 128; t1 = NKT; orow = (size_t)LROWS + b * CL; }
        const int g = h >> 2;
        ATT_UNIT(64, 1)((const unsigned char*)(qkv + QO_QG) + ((size_t)(b * 8 + h) * NTOKB + q0) * 48, (const char*)(qkv + QO_KG) + (size_t)(b * 2 + g) * NKT * 3072,
                        (const char*)(qkv + QO_VG) + (size_t)(b * 2 + g) * NKT * 4096, t0, t1, ATT + orow * 1024 + 512 + h * 64, lds, 0.f, gdo, 0.f);
    }
}

template <int RB>
__device__ __forceinline__ void pf_rows(KA a, Frame& F, int l, int rbeg, int nrows, LAS float* wrT) {
    unsigned char* ws = a->ws;
    const float* MOD = (const float*)(ws + WS_MOD);
    float* AFF = (float*)(ws + WS_AFF); float* AFFC = (float*)(ws + WS_AFFC); int* INV = (int*)(ws + WS_INV);
    const int gw = F.vcu * NWAVES + F.wave, NGW = F.G * NWAVES;
#define PF_LOAD(r, XW, DW) do { const bf16* xb_ = (const bf16*)(ws + WS_XB) + (size_t)(r) * 1024; const bf16* dl_ = (const bf16*)(ws + WS_DELTA) + (size_t)(r) * 1024; \
        _Pragma("unroll") for (int j = 0; j < 4; ++j) { XW[j] = *(const v2u*)(xb_ + 4 * F.lane + 256 * j); DW[j] = *(const v2u*)(dl_ + 4 * F.lane + 256 * j); } } while (0)
    v2u cxw[RB][4], cdw[RB][4];
#pragma unroll
    for (int u = 0; u < RB; ++u)
#pragma unroll
        for (int j = 0; j < 4; ++j) { cxw[u][j] = (v2u){0u, 0u}; cdw[u][j] = (v2u){0u, 0u}; }
    if (rbeg + gw * RB < nrows) {
#pragma unroll
        for (int u = 0; u < RB; ++u) PF_LOAD(rbeg + gw * RB + u, cxw[u], cdw[u]); }
    for (int grp = gw; rbeg + grp * RB < nrows; grp += NGW) {
        const int row0 = rbeg + grp * RB; const bool isc = row0 >= LROWS; const int v = isc ? 4 : (row0 >> 13);
        f32x4 hv[RB][4]; float ss[RB];
#pragma unroll
        for (int u = 0; u < RB; ++u) { bf16* xb = (bf16*)(ws + WS_XB) + (size_t)(row0 + u) * 1024; ss[u] = 0.f;
#pragma unroll
            for (int j = 0; j < 4; ++j) { const int c0 = 4 * F.lane + 256 * j; const v2u w = cdw[u][j], xw = cxw[u][j];
                hv[u][j] = (f32x4){bflo(xw.x), bfhi(xw.x), bflo(xw.y), bfhi(xw.y)} + (f32x4){bflo(w.x), bfhi(w.x), bflo(w.y), bfhi(w.y)};
                v2u o; o.x = pk2(hv[u][j].x, hv[u][j].y); o.y = pk2(hv[u][j].z, hv[u][j].w); *(v2u*)(xb + c0) = o;
                ss[u] += (hv[u][j].x * hv[u][j].x + hv[u][j].y * hv[u][j].y) + (hv[u][j].z * hv[u][j].z + hv[u][j].w * hv[u][j].w); } }
        { const int ngrp = grp + NGW;
          if (rbeg + ngrp * RB < nrows) {
#pragma unroll
              for (int u = 0; u < RB; ++u) PF_LOAD(rbeg + ngrp * RB + u, cxw[u], cdw[u]); } }
        float rstd[RB];
#pragma unroll
        for (int u = 0; u < RB; ++u) rstd[u] = rsqrtf(wave_sum(ss[u]) * (1.0f / 1024.0f) + EPSF);
        const float* g2 = a->in[I_GN2] + l * 1024; const float* sh = MOD + (l * 5 + v) * 6144 + 3 * 1024; const float* sc = sh + 1024;
        float am[RB];
#pragma unroll
        for (int u = 0; u < RB; ++u) am[u] = 0.f;
#pragma unroll
        for (int j = 0; j < 4; ++j) { const int c0 = 4 * F.lane + 256 * j; const f32x4 g = *(const f32x4*)(g2 + c0), s1 = *(const f32x4*)(sc + c0), b1 = *(const f32x4*)(sh + c0);
#pragma unroll
            for (int u = 0; u < RB; ++u) { hv[u][j] = hv[u][j] * rstd[u] * g * (1.0f + s1) + b1;
                am[u] = fmaxf(fmaxf(am[u], fmaxf(fabsf(hv[u][j].x), fabsf(hv[u][j].y))), fmaxf(fabsf(hv[u][j].z), fabsf(hv[u][j].w))); } }
#pragma unroll
        for (int o = 1; o < 64; o <<= 1) {
#pragma unroll
            for (int u = 0; u < RB; ++u) am[u] = fmaxf(am[u], __shfl_xor(am[u], o)); }
#pragma unroll
        for (int u = 0; u < RB; ++u) { const float qs = am[u] > 0.f ? 127.0f / am[u] : 0.f;
            signed char* h8 = (signed char*)(ws + WS_H) + (size_t)(row0 + u) * 1024;
#pragma unroll
            for (int j = 0; j < 4; ++j) { const int q0 = (int)__builtin_rintf(hv[u][j].x * qs), q1 = (int)__builtin_rintf(hv[u][j].y * qs), q2 = (int)__builtin_rintf(hv[u][j].z * qs), q3 = (int)__builtin_rintf(hv[u][j].w * qs);
                *(unsigned*)(h8 + 4 * F.lane + 256 * j) = (unsigned)(q0 & 255) | ((unsigned)(q1 & 255) << 8) | ((unsigned)(q2 & 255) << 16) | ((unsigned)(q3 & 255) << 24); }
            if (F.lane == 0) ((float*)(ws + WS_SA))[row0 + u] = am[u] * (1.0f / 127.0f); }
        float p[RB][16];
#pragma unroll
        for (int e = 0; e < 16; ++e) { float sacc[RB];
#pragma unroll
            for (int u = 0; u < RB; ++u) sacc[u] = 0.f;
#pragma unroll
            for (int j = 0; j < 4; ++j) { const f32x4 w = *(const LAS f32x4*)(wrT + e * 1024 + 4 * F.lane + 256 * j);
#pragma unroll
                for (int u = 0; u < RB; ++u) sacc[u] += (hv[u][j].x * w.x + hv[u][j].y * w.y) + (hv[u][j].z * w.z + hv[u][j].w * w.w); }
#pragma unroll
            for (int u = 0; u < RB; ++u) p[u][e] = sacc[u];
            if ((e & 3) == 3) MEMFENCE(); }
        float lgt[RB];
#pragma unroll
        for (int u = 0; u < RB; ++u) { float r8[8], r4[4], r2[2];
          { const bool hb = (F.lane & 32) != 0;
#pragma unroll
            for (int j = 0; j < 8; ++j) { const float keep = hb ? p[u][8 + j] : p[u][j], send = hb ? p[u][j] : p[u][8 + j]; r8[j] = keep + __shfl_xor(send, 32); } }
          { const bool hb = (F.lane & 16) != 0;
#pragma unroll
            for (int j = 0; j < 4; ++j) { const float keep = hb ? r8[4 + j] : r8[j], send = hb ? r8[j] : r8[4 + j]; r4[j] = keep + __shfl_xor(send, 16); } }
          { const bool hb = (F.lane & 8) != 0;
#pragma unroll
            for (int j = 0; j < 2; ++j) { const float keep = hb ? r4[2 + j] : r4[j], send = hb ? r4[j] : r4[2 + j]; r2[j] = keep + __shfl_xor(send, 8); } }
          { const bool hb = (F.lane & 4) != 0; const float keep = hb ? r2[1] : r2[0], send = hb ? r2[0] : r2[1]; lgt[u] = keep + __shfl_xor(send, 4); }
          lgt[u] += __shfl_xor(lgt[u], 1); lgt[u] += __shfl_xor(lgt[u], 2); }
        float mx[RB], ex[RB], sum[RB];
#pragma unroll
        for (int u = 0; u < RB; ++u) mx[u] = lgt[u];
#pragma unroll
        for (int o = 4; o < 64; o <<= 1) {
#pragma unroll
            for (int u = 0; u < RB; ++u) mx[u] = fmaxf(mx[u], __shfl_xor(mx[u], o)); }
#pragma unroll
        for (int u = 0; u < RB; ++u) { ex[u] = __builtin_amdgcn_exp2f((lgt[u] - mx[u]) * LOG2E); sum[u] = ex[u]; }
#pragma unroll
        for (int o = 4; o < 64; o <<= 1) {
#pragma unroll
            for (int u = 0; u < RB; ++u) sum[u] += __shfl_xor(sum[u], o); }
        const int ee = ((F.lane >> 5) & 1) * 8 + ((F.lane >> 4) & 1) * 4 + ((F.lane >> 3) & 1) * 2 + ((F.lane >> 2) & 1);
#pragma unroll
        for (int u = 0; u < RB; ++u) { const float mine = ex[u] / sum[u]; const int row = row0 + u;
            if ((F.lane & 3) == 0) {
                if (isc) { const int r = row - LROWS; AFFC[((size_t)((r >> 8) * 16 + ee)) * CL + (r & 255)] = mine; }
                else AFF[((size_t)((row >> 13) * 16 + ee)) * SEQ + (row & 8191)] = mine;
                INV[(size_t)row * 16 + ee] = -1;
            } }
    }
#undef PF_LOAD
}


__device__ __forceinline__ void phase_f(KA a, Frame& F, int l, bool last) {
    relane(F);
    unsigned char* ws = a->ws;
    const float* MOD = (const float*)(ws + WS_MOD);
    float* AFF = (float*)(ws + WS_AFF); float* AFFC = (float*)(ws + WS_AFFC); int* INV = (int*)(ws + WS_INV);
    LAS float* wrT = (LAS float*)F.lds;
    const float* wr = a->in[I_WR] + (size_t)l * 1024 * 16;
    for (int idx = F.tid; idx < 16384; idx += NWAVES * 64) wrT[(idx & 15) * 1024 + (idx >> 4)] = wr[idx];
    __syncthreads();
    pf_rows<4>(a, F, l, 0, LROWS, wrT);
    if (!last) pf_rows<1>(a, F, l, LROWS, MROWS, wrT);
}

__device__ __forceinline__ void topk_set(Frame& F, const float* __restrict__ src, int n, int k, int rowbase, int slotbase, int e, int* IDX, float* GATE, int* INV, const float* SA, float* SAE) {
    LAS unsigned* keys = (LAS unsigned*)F.lds; LAS unsigned* hist = keys + 8192; LAS unsigned* sc = hist + 256;
    const int tid = F.tid;
    for (int i = tid; i < n; i += NWAVES * 64) keys[i] = __float_as_uint(src[i]);
    if (tid == 0) { unsigned z_ = 0u, k_ = (unsigned)k; asm volatile("" : "+v"(z_), "+v"(k_)); sc[0] = z_; sc[1] = k_; }
    __syncthreads();
    for (int pass = 0; pass < 4; ++pass) {
        const int shift = 24 - 8 * pass; const unsigned mask = (pass == 0) ? 0u : (0xFFFFFFFFu << (shift + 8));
        if (tid < 256) hist[tid] = 0u;
        __syncthreads();
        const unsigned prefix = sc[0];
        for (int i = tid; i < n; i += NWAVES * 64) { const unsigned kv = keys[i]; if ((kv & mask) == prefix) __hip_atomic_fetch_add(&hist[(kv >> shift) & 255u], 1u, __ATOMIC_RELAXED, __HIP_MEMORY_SCOPE_WORKGROUP); }
        __syncthreads();
        if (F.wave == 0) {
            const unsigned need = sc[1]; unsigned h[4]; unsigned tot = 0u;
#pragma unroll
            for (int j = 0; j < 4; ++j) { h[j] = hist[255 - (4 * F.lane + j)]; tot += h[j]; }
            unsigned incl = tot;
#pragma unroll
            for (int d = 1; d < 64; d <<= 1) { const unsigned t = __shfl_up(incl, d); if (F.lane >= d) incl += t; }
            unsigned cum = incl - tot;
#pragma unroll
            for (int j = 0; j < 4; ++j) { if (cum < need && need <= cum + h[j]) { sc[0] = prefix | ((unsigned)(255 - (4 * F.lane + j)) << shift); sc[1] = need - cum; } cum += h[j]; }
        }
        __syncthreads();
    }
    const unsigned T = sc[0], need_eq = sc[1];
    const int per = (n + NWAVES * 64 - 1) / (NWAVES * 64), start = tid * per;
    unsigned cg = 0u, ce = 0u;
    for (int j = 0; j < per; ++j) { const int i = start + j; if (i < n) { const unsigned kv = keys[i]; cg += (kv > T) ? 1u : 0u; ce += (kv == T) ? 1u : 0u; } }
    const unsigned packed = cg | (ce << 16);
    unsigned incl = packed;
#pragma unroll
    for (int d = 1; d < 64; d <<= 1) { const unsigned t = __shfl_up(incl, d); if (F.lane >= d) incl += t; }
    if (F.lane == 63) sc[8 + F.wave] = incl;
    __syncthreads();
    unsigned base = 0u;
    for (int w = 0; w < F.wave; ++w) base += sc[8 + w];
    const unsigned excl = base + incl - packed;
    unsigned gb = excl & 0xFFFFu, eb = excl >> 16;
    for (int j = 0; j < per; ++j) { const int i = start + j; if (i < n) { const unsigned kv = keys[i]; const bool g = kv > T, q = kv == T;
        if (g || (q && eb < need_eq)) { const int slot = slotbase + (int)(gb + (eb < need_eq ? eb : need_eq)); IDX[slot] = rowbase + i; GATE[slot] = __uint_as_float(kv); SAE[slot] = SA[rowbase + i]; INV[(size_t)(rowbase + i) * 16 + e] = slot; }
        gb += g ? 1u : 0u; eb += q ? 1u : 0u; } }
    __syncthreads();
}
struct CvtItem { const float* wp; int N; unsigned char* wt; int ldt; float qs; int f8; };
__device__ __forceinline__ void cvt_load(const CvtItem& I, float (&tv)[32]) {
#pragma unroll
    for (int i = 0; i < 32; ++i) tv[i] = __builtin_nontemporal_load(I.wp + (size_t)(2 * i) * I.N);
}
__device__ __forceinline__ void cvt_store(const CvtItem& I, const float (&tv)[32], LAS float* scr, int lane) {
#pragma unroll
    for (int i = 0; i < 32; ++i) scr[(2 * i + (lane >> 5)) * 33 + (lane & 31)] = tv[i];
    LDS_WAIT(); asm volatile("" ::: "memory");
    const int c = lane & 3;
#pragma unroll
    for (int j = 0; j < 2; ++j) { const int n = (lane >> 2) + 16 * j; const LAS float* sp = scr + (16 * c) * 33 + n; v4u o;
        if (I.f8) {
#pragma unroll
            for (int d = 0; d < 4; ++d) { float f[4];
#pragma unroll
                for (int i = 0; i < 4; ++i) f[i] = fminf(fmaxf(sp[(4 * d + i) * 33] * I.qs, -448.0f), 448.0f);
                int w = __builtin_amdgcn_cvt_pk_fp8_f32(f[0], f[1], 0, false); w = __builtin_amdgcn_cvt_pk_fp8_f32(f[2], f[3], w, true); o[d] = (unsigned)w; }
        } else {
#pragma unroll
            for (int d = 0; d < 4; ++d) { unsigned w = 0u;
#pragma unroll
                for (int i = 0; i < 4; ++i) { const float f = fminf(fmaxf(sp[(4 * d + i) * 33] * I.qs, -127.0f), 127.0f); w |= ((unsigned)((int)__builtin_rintf(f)) & 255u) << (8 * i); }
                o[d] = w; }
        }
        *(v4u*)(I.wt + (size_t)n * I.ldt + 16 * c) = o; }
    LDS_WAIT(); asm volatile("" ::: "memory");
}
__device__ __forceinline__ void phase_g(KA a, Frame& F, int l, bool last, int rep) {
    relane(F);
    unsigned char* ws = a->ws;
    const float* AFF = (const float*)(ws + WS_AFF); const float* AFFC = (const float*)(ws + WS_AFFC);
    int* IDX = (int*)(ws + WS_IDX); float* GATE = (float*)(ws + WS_GATE); int* INV = (int*)(ws + WS_INV);
    const float* SA = (const float*)(ws + WS_SA); float* SAE = (float*)(ws + WS_SAE);
    const int RPE = last ? 4096 : 4352, nsets = last ? 64 : 128;
    for (int set = blockIdx.x; set < nsets; set += F.G) {
        if (set < 64) { const int b = set >> 4, e = set & 15; topk_set(F, AFF + (size_t)set * SEQ, SEQ, CAPL, b * SEQ, e * RPE + b * CAPL, e, IDX, GATE, INV, SA, SAE); }
        else { const int s2 = set - 64, b = s2 >> 4, e = s2 & 15; topk_set(F, AFFC + (size_t)s2 * CL, CL, CAPC, LROWS + b * CL, e * RPE + 4096 + b * CAPC, e, IDX, GATE, INV, SA, SAE);
            if (b == 0 && F.tid < 128) { IDX[e * RPE + 4224 + F.tid] = -1; GATE[e * RPE + 4224 + F.tid] = 0.f; SAE[e * RPE + 4224 + F.tid] = 0.f; } }
    }
    {
        LAS float* scr = (LAS float*)(F.lds + 40960 + F.wave * 8704);
        gu32* head = F.ctl + CW_Q + 64 * l + 128 * rep;
        constexpr int NIT = NE * 3072;
        const float* wg = a->in[I_WG] + (size_t)l * NE * 1024 * 2048; const float* wu = a->in[I_WU] + (size_t)l * NE * 1024 * 2048; const float* wd = a->in[I_WD] + (size_t)l * NE * 2048 * 1024;
        const float* SWL = (const float*)(ws + WS_SW) + l * 48;
        for (;;) {
            unsigned basev = 0u;
            if (F.lane == 0) basev = __hip_atomic_fetch_add(head, 8u, RLX_AGENT);
            const int base = __builtin_amdgcn_readfirstlane((int)basev);
            if (base >= NIT) break;
#define CVT_SETUP(I, j) do { const int it_ = base + (j); const int e_ = it_ / 3072, r_ = it_ % 3072, which_ = r_ >> 10, ii_ = r_ & 1023; \
                if (which_ < 2) { const int kb_ = ii_ >> 6, n0_ = (ii_ & 63) * 32; const int rowbase_ = (n0_ >> 7) * 256 + (n0_ & 127) + which_ * 128; \
                    I.wp = (which_ ? wu : wg) + (size_t)e_ * 1024 * 2048 + (size_t)(kb_ * 64 + (F.lane >> 5)) * 2048 + n0_ + (F.lane & 31); I.N = 2048; \
                    I.wt = (unsigned char*)(ws + WS_WGU) + (size_t)e_ * 4096 * 1024 + (size_t)rowbase_ * 1024 + kb_ * 64; I.ldt = 1024; I.qs = 1.0f / SWL[3 * e_ + which_]; I.f8 = 0; } \
                else { const int kb_ = ii_ >> 5, n0_ = (ii_ & 31) * 32; \
                    I.wp = wd + (size_t)e_ * 2048 * 1024 + (size_t)(kb_ * 64 + (F.lane >> 5)) * 1024 + n0_ + (F.lane & 31); I.N = 1024; \
                    I.wt = (unsigned char*)(ws + WS_WD) + (size_t)e_ * 1024 * 2048 + (size_t)n0_ * 2048 + kb_ * 64; I.ldt = 2048; I.qs = 1.0f / SWL[3 * e_ + 2]; I.f8 = 1; } } while (0)
            CvtItem IA, IB; float tvA[32], tvB[32];
            CVT_SETUP(IA, 0); cvt_load(IA, tvA);
#pragma unroll
            for (int jj = 0; jj < 4; ++jj) {
                CVT_SETUP(IB, 2 * jj + 1); cvt_load(IB, tvB);
                cvt_store(IA, tvA, scr, F.lane);
                if (jj < 3) { CVT_SETUP(IA, 2 * jj + 2); cvt_load(IA, tvA); }
                cvt_store(IB, tvB, scr, F.lane);
            }
#undef CVT_SETUP
        }
    }
}

__global__ void __launch_bounds__(NWAVES * 64, 2) mk_fwd(Args args) {
    extern __shared__ __attribute__((aligned(16))) unsigned char lds[];
    Frame F;
    F.lds = (LAS unsigned char*)lds;
    F.MISC = (volatile LAS unsigned*)(F.lds + MISC_OFF);
    F.tid = threadIdx.x; F.lane = F.tid & 63; F.wave = __builtin_amdgcn_readfirstlane(F.tid >> 6);
    F.G = gridDim.x; { const int bx = blockIdx.x; F.vcu = (F.G % 8 == 0) ? (bx % 8) * (F.G / 8) + bx / 8 : bx; }
    F.ctl = (gu32*)(args.ws + WS_CTL);
    for (int u = F.tid; u < (LDS_BYTES - LDSCTL_OFF) / 4; u += NWAVES * 64) ((LAS unsigned*)(F.lds + LDSCTL_OFF))[u] = 0u;
    __syncthreads();
    const int lo = args.ph_lo, hi = args.ph_hi;
    const bool multi = (hi - lo) > 1;
    XcdBarrier bar; bar.bar = (unsigned*)(F.ctl + CW_BAR); bar.x = 0; bar.st = nullptr;
    if (multi) bar = xcd_barrier_post((unsigned*)(F.ctl + CW_BAR), F.MISC + 8);
#define IN(k) (lo <= (k) && (k) < hi)
#define SEAM(k) do { if (IN((k) + 1)) xcd_barrier(bar); } while (0)
#define REP(kind) (((MK_REP) >> (kind)) & 1)
#define RUNPH(kind, k, ...) do { if (IN(k)) { for (int rep_ = 0; rep_ <= REP(kind); ++rep_) { __VA_ARGS__; if (rep_ < REP(kind)) xcd_barrier(bar); } SEAM(k); } } while (0)

    RUNPH(0, 0, p0_prologue(kargs(), F));

    for (int l = 0; l < NLAYER; ++l) {
        const bool last = (l == NLAYER - 1);
        const int pb = 1 + 10 * l;
        const int RPE = last ? 4096 : 4352;
        if (IN(pb + 0)) { for (int rep_ = 0; rep_ <= (l == 0 ? REP(1) : 0); ++rep_) { phase_a(kargs(), F, l); if (rep_ < REP(1) && l == 0) xcd_barrier(bar); } SEAM(pb + 0); }
        if (IN(pb + 1)) { for (int rep_ = 0; rep_ <= REP(2); ++rep_) {
            KA ka = kargs(); unsigned char* ws = ka->ws;
            pg8::Gemm g{(const pg8::bf16_t*)(ws + WS_H), (const pg8::bf16_t*)(ws + WS_WCAT8 + (size_t)l * ZP * 1024), MROWS, ZP, DM / 2, 1 << 30, 0};
            pg8::StaticOrder S; S.init(MROWS, ZP, F.G, (int)blockIdx.x);
            pg8::EpiStoreBf16I8 E{(pg8::bf16_t*)(ws + WS_Z), ZP, (const float*)(ws + WS_SA), (const float*)(ws + WS_SWC) + (size_t)l * ZP, (float*)(ws + WS_SSQ)};
            pg8::gemm_phase<pg8::EpiStoreBf16I8, pg8::StaticOrder, true, true, 1>(F.lds, g, S, E);
            if (rep_ < REP(2)) xcd_barrier(bar); }
            SEAM(pb + 1);
        }
        RUNPH(3, pb + 2, phase_c(kargs(), F, l));
        RUNPH(4, pb + 3, phase_d<0>(kargs(), F, l, last); if (MK_ABL) { xcd_barrier(bar); phase_d<MK_ABL>(kargs(), F, l, last); });
        if (IN(pb + 4)) { for (int rep_ = 0; rep_ <= REP(5); ++rep_) {
            KA ka = kargs(); unsigned char* ws = ka->ws; const float* MODL = (const float*)(ws + WS_MOD) + (size_t)l * 5 * 6144;
            const int M = last ? LROWS : MROWS;
            pg8::Gemm g{(const pg8::bf16_t*)(ws + WS_ATT), (const pg8::bf16_t*)(ws + WS_WO) + (size_t)l * 1024 * 1024, M, DM, DM, 1 << 30, 0};
            pg8::StaticOrder S; S.init(M, DM, F.G, (int)blockIdx.x);
            pg8::EpiColGateBf16 E{(pg8::bf16_t*)(ws + WS_DELTA), DM, MODL, LROWS};
            pg8::gemm_phase<pg8::EpiColGateBf16, pg8::StaticOrder, true, true>(F.lds, g, S, E);
            if (rep_ < REP(5)) xcd_barrier(bar); }
            SEAM(pb + 4);
        }
        RUNPH(6, pb + 5, phase_f(kargs(), F, l, last));
        RUNPH(7, pb + 6, phase_g(kargs(), F, l, last, rep_));
        if (IN(pb + 8)) { for (int rep_ = 0; rep_ <= REP(9); ++rep_) {
            KA ka = kargs(); unsigned char* ws = ka->ws;
            pg8::Gemm g{(const pg8::bf16_t*)(ws + WS_H), (const pg8::bf16_t*)(ws + WS_WGU), NE * RPE, 2 * FFD, DM / 2, RPE / 256, (size_t)2 * FFD * DM, (const int*)(ws + WS_IDX)};
            pg8::StaticOrder S; S.init(NE * RPE, 2 * FFD, F.G, (int)blockIdx.x);
            pg8::EpiSwiGLUI8 E{(unsigned char*)(ws + WS_HID), FFD, (const float*)(ws + WS_SAE), (const float*)(ws + WS_SW) + l * 48, RPE / 256, HID_SCALE};
            if (MK_NOEPI && rep_ == 1) { pg8::EpiNullI8 EN{}; pg8::gemm_phase<pg8::EpiNullI8, pg8::StaticOrder, true, true, 1, true>(F.lds, g, S, EN); }
            else pg8::gemm_phase<pg8::EpiSwiGLUI8, pg8::StaticOrder, true, true, 1, true>(F.lds, g, S, E);
            if (rep_ < REP(9)) xcd_barrier(bar); }
            SEAM(pb + 8);
        }
        if (IN(pb + 9)) { for (int rep_ = 0; rep_ <= REP(10); ++rep_) {
            KA ka = kargs(); unsigned char* ws = ka->ws;
            pg8::Gemm g{(const pg8::bf16_t*)(ws + WS_HID), (const pg8::bf16_t*)(ws + WS_WD), NE * RPE, DM, FFD / 2, RPE / 256, (size_t)DM * FFD};
            pg8::StaticOrder S; S.init(NE * RPE, DM, F.G, (int)blockIdx.x);
            pg8::EpiRowScaleBf16 E{(unsigned char*)(ws + WS_YE), DM, (const float*)(ws + WS_GATE), (const float*)(ws + WS_SW) + l * 48, RPE / 256, YE_SCALE / HID_SCALE};
            pg8::gemm_phase<pg8::EpiRowScaleBf16, pg8::StaticOrder, true, true, 2>(F.lds, g, S, E);
            if (rep_ < REP(10)) xcd_barrier(bar); }
            SEAM(pb + 9);
        }
    }
    if (IN(N_PHASES - 1)) phase_a(kargs(), F, NLAYER);
#undef IN
#undef SEAM
}

extern "C" void kernel_launch(void* const* d_in, const int* in_sizes, int n_in, void* d_out, int out_size, void* d_ws, size_t ws_size, hipStream_t stream) {
    static int grid = 0;
    if (grid == 0) {
        if (n_in != N_IN || out_size != LROWS * DM || ws_size < WS_END) { fprintf(stderr, "kernel_launch: unexpected shapes (n_in %d, out %d, ws %zu); nothing launched\n", n_in, out_size, ws_size); grid = -1; return; }
        int dev = 0, cus = 0, per_cu = 0;
        if (hipGetDevice(&dev) != hipSuccess || hipDeviceGetAttribute(&cus, hipDeviceAttributeMultiprocessorCount, dev) != hipSuccess) { grid = -1; return; }
        if (hipFuncSetAttribute((const void*)mk_fwd, hipFuncAttributeMaxDynamicSharedMemorySize, LDS_BYTES) != hipSuccess) { fprintf(stderr, "kernel_launch: hipFuncSetAttribute failed\n"); grid = -1; return; }
        if (hipOccupancyMaxActiveBlocksPerMultiprocessor(&per_cu, (const void*)mk_fwd, NWAVES * 64, LDS_BYTES) != hipSuccess || per_cu < 1) { fprintf(stderr, "kernel_launch: occupancy query reports %d blocks per CU\n", per_cu); }
        (void)hipGetLastError();
        if (cus < 256) { fprintf(stderr, "kernel_launch: %d compute units; the per-workgroup LDS row tables of the GEMM phases are sized for a grid of at least 256 workgroups; nothing launched\n", cus); grid = -1; return; }
        grid = cus;
    }
    if (grid < 0) return;
    if (hipMemsetAsync((char*)d_ws + WS_CTL, 0, CTL_ZERO_BYTES, stream) != hipSuccess) { fprintf(stderr, "kernel_launch: memset failed\n"); return; }
    Args a{};
    for (int i = 0; i < N_IN; ++i) a.in[i] = (const float*)d_in[i];
    a.out = (float*)d_out; a.ws = (unsigned char*)d_ws;
#if MK_SPLIT
    for (int ph = 0; ph < N_PHASES; ++ph) { a.ph_lo = ph; a.ph_hi = ph + 1; hipLaunchKernelGGL(mk_fwd, dim3(grid), dim3(NWAVES * 64), LDS_BYTES, stream, a); }
#else
    a.ph_lo = 0; a.ph_hi = N_PHASES;
    hipLaunchKernelGGL(mk_fwd, dim3(grid), dim3(NWAVES * 64), LDS_BYTES, stream, a);
#endif
    const hipError_t le = hipPeekAtLastError();
    if (le != hipSuccess) fprintf(stderr, "kernel_launch: launch failed: %s\n", hipGetErrorName(le));
}
```

```cpp
#include <hip/hip_runtime.h>
#include <hip/hip_bf16.h>
#include <cstdio>
#include <cstdint>
#ifndef MK_SPLIT
#define MK_SPLIT 0
#endif
#ifndef MK_REP
#define MK_REP 0
#endif
#ifndef MK_NOEPI
#define MK_NOEPI 0
#endif
#ifndef MK_ABL
#define MK_ABL 0
#endif
namespace pg8 {
#define PG8_LAS __attribute__((address_space(3)))
typedef unsigned short bf16_t;
typedef short bf16x8 __attribute__((ext_vector_type(8)));
typedef float f32x4 __attribute__((ext_vector_type(4)));
typedef unsigned u32x4 __attribute__((ext_vector_type(4)));
constexpr int BM = 256, BK = 64, HALF = 128, HTB = HALF * BK * 2  , STAGE_BYTES = 8 * HTB, NXCD = 8, WGM = 8;

__host__ __device__ __forceinline__ int lds_byte(int r, int c) { const int st = (r >> 4) * 2 + (c >> 5), rr = r & 15, cc = c & 31, ob = rr * 64 + cc * 2; return st * 1024 + (ob ^ (((ob >> 9) & 1) << 5)); }
__host__ __device__ __forceinline__ void stage_rc(int b, int& R, int& C) { const int st = b / 1024, sb = b % 1024, swz = sb ^ (((sb >> 9) & 1) << 5); R = (st >> 1) * 16 + swz / 64; C = (st & 1) * 32 + (swz % 64) / 2; }
__host__ __device__ __forceinline__ int perm32(int rho) { const int n = rho >> 4, i = rho & 15; return 8 * (i >> 2) + 4 * n + (i & 3); }

struct Unit { int pm, pn, li; };
struct Gemm { const bf16_t* A; const bf16_t* Bt; int M, N, K; int tpe; size_t bgs; const int* gidx = nullptr; };

struct StaticOrder {
    int nM, nN, nwg, G, c;
    __host__ __device__ void init(int M, int N, int G_, int c_) { nM = M / BM; nN = N / BM; nwg = nM * nN; G = G_; c = c_; }
    __host__ __device__ bool next(int i, Unit& u) const {
        const long L = (long)i * G + c; if (L >= nwg) return false;
        int wgid = (int)L; { const int q = nwg / NXCD, r = nwg % NXCD, xcd = wgid % NXCD, off = wgid / NXCD; wgid = (xcd < r ? xcd * (q + 1) : r * (q + 1) + (xcd - r) * q) + off; }
        const int nig = WGM * nN, gid = wgid / nig, fm = gid * WGM, gsz = (nM - fm) < WGM ? (nM - fm) : WGM;
        u.pm = fm + ((wgid % nig) % gsz); u.pn = (wgid % nig) / gsz; u.li = i; return true;
    }
    __device__ __forceinline__ void a_ready(const Unit&) const {}
    __device__ __forceinline__ void done(const Unit&) const {}
};
typedef int i32x4 __attribute__((ext_vector_type(4)));
__device__ __forceinline__ unsigned cvt_pk_bf16(float lo, float hi) { unsigned r; asm volatile("v_cvt_pk_bf16_f32 %0, %1, %2" : "=v"(r) : "v"(lo), "v"(hi)); return r; }
constexpr int GTAB_OFF = STAGE_BYTES + 2048, RTAB_OFF = GTAB_OFF + 17 * BM * 2, TAB_UNITS = 17;
template <class Sched> __device__ __forceinline__ void fill_rtab(PG8_LAS unsigned char* lds, const Sched& S, const float* rowv, int tid) {
    PG8_LAS float* rt = (PG8_LAS float*)(lds + RTAB_OFF); Unit uu;
    for (int i = 0; i < TAB_UNITS && S.next(i, uu); ++i) { if (tid < BM) rt[i * BM + tid] = rowv[uu.pm * BM + tid]; } }
struct EpiStoreBf16 {
    static constexpr bool PERM = true, AFTER_DRAIN = false;
    bf16_t* O; int ldc;
    template <class Sched> __device__ __forceinline__ void prefill(PG8_LAS unsigned char*, const Sched&, int) const {}
    __device__ __forceinline__ void operator()(const f32x4 (&acc)[2][2][4][2], const Unit& u, int wr, int wc, int fr, int fq, PG8_LAS unsigned char* lds) const {
        const int row0 = u.pm * BM + wr * 64 + fr, col0 = u.pn * BM + wc * 32 + 8 * fq;
#pragma unroll
        for (int ai = 0; ai < 2; ++ai)
#pragma unroll
            for (int m = 0; m < 4; ++m) { bf16_t* rowp = O + (size_t)(row0 + ai * HALF + m * 16) * ldc + col0;
#pragma unroll
                for (int bj = 0; bj < 2; ++bj) { const f32x4 v0 = acc[ai][bj][m][0], v1 = acc[ai][bj][m][1];
                    u32x4 w; w.x = cvt_pk_bf16(v0[0], v0[1]); w.y = cvt_pk_bf16(v0[2], v0[3]); w.z = cvt_pk_bf16(v1[0], v1[1]); w.w = cvt_pk_bf16(v1[2], v1[3]);
                    *(u32x4*)(rowp + bj * HALF) = w; } }
    }
};
__device__ __forceinline__ float clampz(float x) { return fminf(fmaxf(x, -448.0f), 448.0f); }
struct EpiStoreBf16I8 {
    static constexpr bool PERM = true, AFTER_DRAIN = false;
    unsigned char* O; int ldc; const float* sa; const float* sw; float* ssq;
    template <class Sched> __device__ __forceinline__ void prefill(PG8_LAS unsigned char* lds, const Sched& S, int tid) const { fill_rtab(lds, S, sa, tid); }
    __device__ __forceinline__ void operator()(const i32x4 (&acc)[2][2][4][2], const Unit& u, int wr, int wc, int fr, int fq, PG8_LAS unsigned char* lds) const {
        const int row0 = u.pm * BM + wr * 64 + fr, col0 = u.pn * BM + wc * 32 + 8 * fq;
        f32x4 cs[2][2];
#pragma unroll
        for (int bj = 0; bj < 2; ++bj)
#pragma unroll
            for (int n = 0; n < 2; ++n) cs[bj][n] = *(const f32x4*)(sw + col0 + bj * HALF + 4 * n);
#pragma unroll
        for (int ai = 0; ai < 2; ++ai)
#pragma unroll
            for (int m = 0; m < 4; ++m) { const int row = row0 + ai * HALF + m * 16; const float rs = ((const PG8_LAS float*)(lds + RTAB_OFF))[u.li * BM + (row - u.pm * BM)]; unsigned char* rowp = O + (size_t)row * ldc + col0;
#pragma unroll
                for (int bj = 0; bj < 2; ++bj) { const i32x4 a0 = acc[ai][bj][m][0], a1 = acc[ai][bj][m][1]; const f32x4 c0 = cs[bj][0] * rs, c1 = cs[bj][1] * rs;
                    const float z0 = (float)a0[0] * c0[0], z1 = (float)a0[1] * c0[1], z2 = (float)a0[2] * c0[2], z3 = (float)a0[3] * c0[3];
                    const float z4 = (float)a1[0] * c1[0], z5 = (float)a1[1] * c1[1], z6 = (float)a1[2] * c1[2], z7 = (float)a1[3] * c1[3];
                    int w0 = __builtin_amdgcn_cvt_pk_fp8_f32(clampz(z0), clampz(z1), 0, false); w0 = __builtin_amdgcn_cvt_pk_fp8_f32(clampz(z2), clampz(z3), w0, true);
                    int w1 = __builtin_amdgcn_cvt_pk_fp8_f32(clampz(z4), clampz(z5), 0, false); w1 = __builtin_amdgcn_cvt_pk_fp8_f32(clampz(z6), clampz(z7), w1, true);
                    typedef unsigned u32x2 __attribute__((ext_vector_type(2)));
                    *(u32x2*)(rowp + bj * HALF) = (u32x2){(unsigned)w0, (unsigned)w1};
                    if (u.pn == 0 || (u.pn == 1 && bj == 0)) {
                        float q = ((z0 * z0 + z1 * z1) + (z2 * z2 + z3 * z3)) + ((z4 * z4 + z5 * z5) + (z6 * z6 + z7 * z7));
                        q += __shfl_xor(q, 16); q += __shfl_xor(q, 32);
                        if (fq == 0) ssq[(size_t)row * 12 + (u.pn == 0 ? bj * 4 + wc : 8 + wc)] = q; } } }
    }
};
struct EpiColGateBf16 {
    static constexpr bool PERM = true, AFTER_DRAIN = false;
    bf16_t* O; int ldc; const float* mod; int lrows;
    template <class Sched> __device__ __forceinline__ void prefill(PG8_LAS unsigned char*, const Sched&, int) const {}
    __device__ __forceinline__ void operator()(const f32x4 (&acc)[2][2][4][2], const Unit& u, int wr, int wc, int fr, int fq, PG8_LAS unsigned char* lds) const {
        const int R0 = u.pm * BM; const int v = (R0 >= lrows) ? 4 : (R0 >> 13);
        const float* ga = mod + v * 6144 + 2 * 1024;
        const int row0 = R0 + wr * 64 + fr, col0 = u.pn * BM + wc * 32 + 8 * fq;
        f32x4 g[2][2];
#pragma unroll
        for (int bj = 0; bj < 2; ++bj)
#pragma unroll
            for (int n = 0; n < 2; ++n) g[bj][n] = *(const f32x4*)(ga + col0 + bj * HALF + 4 * n);
#pragma unroll
        for (int ai = 0; ai < 2; ++ai)
#pragma unroll
            for (int m = 0; m < 4; ++m) { bf16_t* rowp = O + (size_t)(row0 + ai * HALF + m * 16) * ldc + col0;
#pragma unroll
                for (int bj = 0; bj < 2; ++bj) { const f32x4 v0 = acc[ai][bj][m][0] * g[bj][0], v1 = acc[ai][bj][m][1] * g[bj][1];
                    u32x4 w; w.x = cvt_pk_bf16(v0[0], v0[1]); w.y = cvt_pk_bf16(v0[2], v0[3]); w.z = cvt_pk_bf16(v1[0], v1[1]); w.w = cvt_pk_bf16(v1[2], v1[3]);
                    *(u32x4*)(rowp + bj * HALF) = w; } }
    }
};
__device__ __forceinline__ float silu_mul(float g, float u) { return g * __builtin_amdgcn_rcpf(1.0f + __builtin_amdgcn_exp2f(-1.4426950408889634f * g)) * u; }
struct EpiSwiGLU {
    static constexpr bool PERM = true, AFTER_DRAIN = false;
    bf16_t* O; int ldc;
    template <class Sched> __device__ __forceinline__ void prefill(PG8_LAS unsigned char*, const Sched&, int) const {}
    __device__ __forceinline__ void operator()(const f32x4 (&acc)[2][2][4][2], const Unit& u, int wr, int wc, int fr, int fq, PG8_LAS unsigned char* lds) const {
        const int row0 = u.pm * BM + wr * 64 + fr, col0 = u.pn * HALF + wc * 32 + 8 * fq;
#pragma unroll
        for (int ai = 0; ai < 2; ++ai)
#pragma unroll
            for (int m = 0; m < 4; ++m) { const f32x4 g0 = acc[ai][0][m][0], g1 = acc[ai][0][m][1], u0 = acc[ai][1][m][0], u1 = acc[ai][1][m][1];
                u32x4 w; w.x = cvt_pk_bf16(silu_mul(g0[0], u0[0]), silu_mul(g0[1], u0[1])); w.y = cvt_pk_bf16(silu_mul(g0[2], u0[2]), silu_mul(g0[3], u0[3]));
                w.z = cvt_pk_bf16(silu_mul(g1[0], u1[0]), silu_mul(g1[1], u1[1])); w.w = cvt_pk_bf16(silu_mul(g1[2], u1[2]), silu_mul(g1[3], u1[3]));
                *(u32x4*)(O + (size_t)(row0 + ai * HALF + m * 16) * ldc + col0) = w; }
    }
};
__device__ __forceinline__ float clamp448(float x) { return fminf(fmaxf(x, -448.0f), 448.0f); }
struct EpiSwiGLUI8 {
    static constexpr bool PERM = true, AFTER_DRAIN = false;
    unsigned char* O; int ldc; const float* sa; const float* sw; int tpe; float hs;
    template <class Sched> __device__ __forceinline__ void prefill(PG8_LAS unsigned char* lds, const Sched& S, int tid) const { fill_rtab(lds, S, sa, tid); }
    __device__ __forceinline__ void operator()(const i32x4 (&acc)[2][2][4][2], const Unit& u, int wr, int wc, int fr, int fq, PG8_LAS unsigned char* lds) const {
        const int row0 = u.pm * BM + wr * 64 + fr, col0 = u.pn * HALF + wc * 32 + 8 * fq; const int e = u.pm / tpe;
        const float sg = sw[3 * e], su = sw[3 * e + 1] * hs;
#pragma unroll
        for (int ai = 0; ai < 2; ++ai)
#pragma unroll
            for (int m = 0; m < 4; ++m) { const int row = row0 + ai * HALF + m * 16; const float rs = ((const PG8_LAS float*)(lds + RTAB_OFF))[u.li * BM + (row - u.pm * BM)], fg = rs * sg, fu = rs * su;
                const i32x4 g0 = acc[ai][0][m][0], g1 = acc[ai][0][m][1], u0 = acc[ai][1][m][0], u1 = acc[ai][1][m][1];
                typedef float f32x2 __attribute__((ext_vector_type(2)));
                float h[8]; f32x2 gi[4], gu[4], ev[4];
                const float tg = -1.4426950408889634f * fg, fgu = fg * fu;
#pragma unroll
                for (int i = 0; i < 2; ++i) { gi[i] = (f32x2){(float)g0[2 * i], (float)g0[2 * i + 1]}; gi[2 + i] = (f32x2){(float)g1[2 * i], (float)g1[2 * i + 1]};
                    gu[i] = gi[i] * (f32x2){(float)u0[2 * i], (float)u0[2 * i + 1]}; gu[2 + i] = gi[2 + i] * (f32x2){(float)u1[2 * i], (float)u1[2 * i + 1]}; }
                __builtin_amdgcn_sched_barrier(0);
#pragma unroll
                for (int i = 0; i < 4; ++i) { const f32x2 t = gi[i] * tg; ev[i] = (f32x2){__builtin_amdgcn_exp2f(t.x), __builtin_amdgcn_exp2f(t.y)}; }
                __builtin_amdgcn_sched_barrier(0);
#pragma unroll
                for (int i = 0; i < 4; ++i) { const f32x2 d = ev[i] + 1.0f; ev[i] = (f32x2){__builtin_amdgcn_rcpf(d.x), __builtin_amdgcn_rcpf(d.y)}; }
                __builtin_amdgcn_sched_barrier(0);
#pragma unroll
                for (int i = 0; i < 4; ++i) { const f32x2 hv = gu[i] * ev[i] * fgu; h[2 * i] = clamp448(hv.x); h[2 * i + 1] = clamp448(hv.y); }
                int w0 = __builtin_amdgcn_cvt_pk_fp8_f32(h[0], h[1], 0, false); w0 = __builtin_amdgcn_cvt_pk_fp8_f32(h[2], h[3], w0, true);
                int w1 = __builtin_amdgcn_cvt_pk_fp8_f32(h[4], h[5], 0, false); w1 = __builtin_amdgcn_cvt_pk_fp8_f32(h[6], h[7], w1, true);
                typedef unsigned u32x2 __attribute__((ext_vector_type(2)));
                *(u32x2*)(O + (size_t)row * ldc + col0) = (u32x2){(unsigned)w0, (unsigned)w1}; }
    }
};
struct EpiNullI8 {
    static constexpr bool PERM = true, AFTER_DRAIN = false;
    template <class Sched> __device__ __forceinline__ void prefill(PG8_LAS unsigned char*, const Sched&, int) const {}
    __device__ __forceinline__ void operator()(const i32x4 (&acc)[2][2][4][2], const Unit& u, int wr, int wc, int fr, int fq, PG8_LAS unsigned char* lds) const {
#pragma unroll
        for (int ai = 0; ai < 2; ++ai)
#pragma unroll
            for (int bj = 0; bj < 2; ++bj)
#pragma unroll
                for (int m = 0; m < 4; ++m) { asm volatile("" :: "v"(acc[ai][bj][m][0]), "v"(acc[ai][bj][m][1])); }
    }
};
struct EpiRowScaleBf16 {
    static constexpr bool PERM = true, AFTER_DRAIN = false;
    unsigned char* O; int ldc; const float* rs; const float* es; int tpe; float cs;
    template <class Sched> __device__ __forceinline__ void prefill(PG8_LAS unsigned char* lds, const Sched& S, int tid) const { fill_rtab(lds, S, rs, tid); }
    __device__ __forceinline__ void operator()(const f32x4 (&acc)[2][2][4][2], const Unit& u, int wr, int wc, int fr, int fq, PG8_LAS unsigned char* lds) const {
        const int row0 = u.pm * BM + wr * 64 + fr, col0 = u.pn * BM + wc * 32 + 8 * fq;
#pragma unroll
        for (int ai = 0; ai < 2; ++ai)
#pragma unroll
            for (int m = 0; m < 4; ++m) { const int row = row0 + ai * HALF + m * 16; const float s = ((const PG8_LAS float*)(lds + RTAB_OFF))[u.li * BM + (row - u.pm * BM)] * (es[3 * (u.pm / tpe) + 2] * cs); unsigned char* rowp = O + (size_t)row * ldc + col0;
#pragma unroll
                for (int bj = 0; bj < 2; ++bj) { const f32x4 v0 = acc[ai][bj][m][0] * s, v1 = acc[ai][bj][m][1] * s;
                    int w0 = __builtin_amdgcn_cvt_pk_fp8_f32(clamp448(v0[0]), clamp448(v0[1]), 0, false); w0 = __builtin_amdgcn_cvt_pk_fp8_f32(clamp448(v0[2]), clamp448(v0[3]), w0, true);
                    int w1 = __builtin_amdgcn_cvt_pk_fp8_f32(clamp448(v1[0]), clamp448(v1[1]), 0, false); w1 = __builtin_amdgcn_cvt_pk_fp8_f32(clamp448(v1[2]), clamp448(v1[3]), w1, true);
                    typedef unsigned u32x2 __attribute__((ext_vector_type(2)));
                    *(u32x2*)(rowp + bj * HALF) = (u32x2){(unsigned)w0, (unsigned)w1}; } }
    }
};
typedef int i32x4 __attribute__((ext_vector_type(4)));
typedef int i32x8 __attribute__((ext_vector_type(8)));
template <int MODE> struct AccSel { typedef f32x4 type; };
template <> struct AccSel<1> { typedef i32x4 type; };
template <int MODE> struct Frag { bf16x8 v[2]; __device__ __forceinline__ void set(int k, bf16x8 x) { v[k] = x; } };
template <> struct Frag<2> { i32x8 w; __device__ __forceinline__ void set(int k, bf16x8 x) { const i32x4 y = __builtin_bit_cast(i32x4, x); if (k == 0) w.lo = y; else w.hi = y; } };
template <class Epi, class Sched, bool ALIGN_EPI = false, bool SP2 = false, int MODE = 0, bool GATHER = false>
__device__ __forceinline__ void gemm_phase(PG8_LAS unsigned char* lds, const Gemm g, const Sched& S, const Epi& E) {
    int tid_l = threadIdx.x; asm volatile("" : "+v"(tid_l));
    const int tid = tid_l, wid = __builtin_amdgcn_readfirstlane(tid >> 6), lane = tid & 63, wr = wid >> 2, wc = wid & 3, fr = lane & 15, fq = lane >> 4;
    const int K = g.K, nt = K / BK;
    unsigned voffA[2], voffB[2];
#pragma unroll
    for (int i = 0; i < 2; ++i) { int R, C; stage_rc(tid * 16 + i * 8192, R, C); const int Rb = Epi::PERM ? ((R & ~31) + perm32(R & 31)) : R;
        voffA[i] = (unsigned)(R * K + C) * 2u; voffB[i] = (unsigned)(Rb * K + C) * 2u; }
    static_assert(!GATHER || SP2, "the gathered A operand is wired into the SP2 schedule only");
    unsigned gvc[2][2] = {{0u, 0u}, {0u, 0u}};
    PG8_LAS unsigned short* gtab = (PG8_LAS unsigned short*)(lds + GTAB_OFF);
    if constexpr (GATHER) { Unit uu_;
        for (int i_ = 0; S.next(i_, uu_); ++i_) { if (tid < BM) { const int ix_ = g.gidx[uu_.pm * BM + tid]; gtab[i_ * BM + tid] = (unsigned short)(ix_ < 0 ? 0 : ix_); } }
    }
    E.prefill(lds, S, tid);
    __syncthreads();
#define PG8_GOFF(ui_, gv_) do { if constexpr (GATHER) { _Pragma("unroll") for (int h_ = 0; h_ < 2; ++h_) _Pragma("unroll") for (int i_ = 0; i_ < 2; ++i_) { int R_, C_; stage_rc(tid * 16 + i_ * 8192, R_, C_); \
        const unsigned ix_ = gtab[(ui_) * BM + h_ * HALF + R_]; gv_[h_][i_] = ix_ * (unsigned)(K * 2) + (unsigned)C_ * 2u; } } } while (0)
    const size_t kstep = (size_t)(BK * 2);
    const size_t hstep = (size_t)HALF * K * 2;
    const size_t tstep = 2 * hstep;
    const unsigned ldsw = (unsigned)wid * 1024u;
    const int aoff = lds_byte(wr * 64 + fr, fq * 8), boff = lds_byte(wc * 32 + fr, fq * 8);
#define PG8_SA(b, h) (((b) * 2 + (h)) * HTB)
#define PG8_SB(b, h) ((4 + (b) * 2 + (h)) * HTB)
#define PG8_STAGE(bufoff, gbase, voff) do { _Pragma("unroll") for (int _i = 0; _i < 2; ++_i) \
        __builtin_amdgcn_global_load_lds((const unsigned*)((const char*)(gbase) + (voff)[_i]), (PG8_LAS unsigned*)(lds + (bufoff) + ldsw + _i * 8192), 16, 0, 0); } while (0)
#define PG8_STAGE_A(bufoff, gbase, h_, nx_) do { if constexpr (GATHER) PG8_STAGE(bufoff, gbase, gvc[h_]); else PG8_STAGE(bufoff, (gbase) + (h_) * hstep, voffA); } while (0)
#define PG8_LDA(dst, b, h) do { _Pragma("unroll") for (int m = 0; m < 4; ++m) _Pragma("unroll") for (int k = 0; k < 2; ++k) dst[m].set(k, *(const PG8_LAS bf16x8*)(lds + PG8_SA(b, h) + aoff + m * 2048 + k * 1024)); } while (0)
#define PG8_LDB(dst, b, h) do { _Pragma("unroll") for (int n = 0; n < 2; ++n) _Pragma("unroll") for (int k = 0; k < 2; ++k) dst[n].set(k, *(const PG8_LAS bf16x8*)(lds + PG8_SB(b, h) + boff + n * 2048 + k * 1024)); } while (0)
#define PG8_MMA(ai, bj, At, Bt) do { __builtin_amdgcn_s_setprio(1); _Pragma("unroll") for (int m = 0; m < 4; ++m) _Pragma("unroll") for (int n = 0; n < 2; ++n) { \
        if constexpr (MODE == 2) { asm volatile("v_mfma_f32_16x16x128_f8f6f4 %0, %1, %2, %0" : "+v"(acc[ai][bj][m][n]) : "v"(Bt[n].w), "v"(At[m].w)); }     \
        else { _Pragma("unroll") for (int k = 0; k < 2; ++k) { \
          if constexpr (MODE == 1) acc[ai][bj][m][n] = __builtin_amdgcn_mfma_i32_16x16x64_i8(__builtin_bit_cast(i32x4, Bt[n].v[k]), __builtin_bit_cast(i32x4, At[m].v[k]), acc[ai][bj][m][n], 0, 0, 0); \
          else acc[ai][bj][m][n] = __builtin_amdgcn_mfma_f32_16x16x32_bf16(Bt[n].v[k], At[m].v[k], acc[ai][bj][m][n], 0, 0, 0); } } } __builtin_amdgcn_s_setprio(0); } while (0)
#define PG8_WAIT_V(n) asm volatile("s_waitcnt vmcnt(" #n ")" ::: "memory")
#define PG8_WAIT_L(n) asm volatile("s_waitcnt lgkmcnt(" #n ")" ::: "memory")
#define PG8_BAR __builtin_amdgcn_s_barrier()
#define PG8_SCHED __builtin_amdgcn_sched_barrier(0)
    Unit cur, nxt; int ui = 0;
    if (!S.next(0, cur)) return;
    typedef typename AccSel<MODE>::type acc_t; const acc_t acc_zero = {};
    acc_t acc[2][2][4][2];
#pragma unroll
    for (int a = 0; a < 2; ++a)
#pragma unroll
        for (int b = 0; b < 2; ++b)
#pragma unroll
            for (int m = 0; m < 4; ++m)
#pragma unroll
                for (int n = 0; n < 2; ++n) acc[a][b][m][n] = acc_zero;
    Frag<MODE> At[4], B0[2], B1[2];
    const char* cA = (const char*)g.A + (GATHER ? (size_t)0 : (size_t)cur.pm * tstep); PG8_GOFF(0, gvc); const char* cB = (const char*)g.Bt + (size_t)(cur.pm / g.tpe) * g.bgs + (size_t)cur.pn * tstep;
    S.a_ready(cur);
    if constexpr (SP2) {
        PG8_STAGE(PG8_SB(0, 0), cB, voffB); PG8_STAGE(PG8_SB(0, 1), cB + hstep, voffB); PG8_STAGE_A(PG8_SA(0, 0), cA, 0, false); PG8_STAGE_A(PG8_SA(0, 1), cA, 1, false);
        if (wr == 1) PG8_BAR;
        PG8_WAIT_V(2); PG8_BAR;
        PG8_STAGE(PG8_SB(1, 0), cB + kstep, voffB); PG8_STAGE_A(PG8_SA(1, 0), cA + kstep, 0, false); PG8_STAGE(PG8_SB(1, 1), cB + hstep + kstep, voffB);
        PG8_WAIT_V(6); PG8_BAR;
    } else {
        PG8_STAGE(PG8_SB(0, 0), cB, voffB); PG8_STAGE(PG8_SA(0, 0), cA, voffA); PG8_STAGE(PG8_SB(0, 1), cB + hstep, voffB); PG8_STAGE(PG8_SA(0, 1), cA + hstep, voffA);
        if (wr == 1) PG8_BAR;
        PG8_WAIT_V(4); PG8_BAR;
        PG8_STAGE(PG8_SB(1, 0), cB + kstep, voffB); PG8_STAGE(PG8_SA(1, 0), cA + kstep, voffA); PG8_STAGE(PG8_SB(1, 1), cB + hstep + kstep, voffB);
        PG8_WAIT_V(6); PG8_BAR;
    }
    for (;;) {
        const bool has_next = S.next(ui + 1, nxt);
        const char* nA = (has_next && !GATHER) ? (const char*)g.A + (size_t)nxt.pm * tstep : cA; const char* nB = has_next ? (const char*)g.Bt + (size_t)(nxt.pm / g.tpe) * g.bgs + (size_t)nxt.pn * tstep : cB;
        for (int t = 0; t < nt; t += 2) {
            const bool last = (t == nt - 2); const bool nxu = last && has_next;
            const char* a1 = cA + (size_t)(t + 1) * kstep;
            const char* a2 = last ? nA : cA + (size_t)(t + 2) * kstep; const char* b2 = last ? nB : cB + (size_t)(t + 2) * kstep;
            const char* a3 = a2 + kstep; const char* b3 = b2 + kstep;
            if (last && has_next) S.a_ready(nxt);
            if constexpr (SP2) {
            PG8_LDB(B0, 0, 0); PG8_LDB(B1, 0, 1); PG8_SCHED; PG8_LDA(At, 0, 0); PG8_STAGE_A(PG8_SA(1, 1), a1, 1, false); if (nxu) PG8_GOFF(ui + 1, gvc);
            PG8_WAIT_V(8); PG8_WAIT_L(0); PG8_BAR; PG8_MMA(0, 0, At, B0); PG8_MMA(0, 1, At, B1); PG8_BAR; PG8_SCHED;
            PG8_LDA(At, 0, 1); PG8_STAGE(PG8_SB(0, 0), b2, voffB); PG8_STAGE(PG8_SB(0, 1), b2 + hstep, voffB); PG8_STAGE_A(PG8_SA(0, 0), a2, 0, nxu);
            PG8_WAIT_V(8); PG8_WAIT_L(0); PG8_BAR; PG8_MMA(1, 0, At, B0); PG8_MMA(1, 1, At, B1); PG8_BAR; PG8_SCHED;
            PG8_LDB(B0, 1, 0); PG8_LDB(B1, 1, 1); PG8_SCHED; PG8_LDA(At, 1, 0); PG8_STAGE_A(PG8_SA(0, 1), a2, 1, nxu);
            PG8_WAIT_V(8); PG8_WAIT_L(0); PG8_BAR; PG8_MMA(0, 0, At, B0); PG8_MMA(0, 1, At, B1); PG8_BAR; PG8_SCHED;
            PG8_LDA(At, 1, 1); PG8_STAGE(PG8_SB(1, 0), b3, voffB); PG8_STAGE(PG8_SB(1, 1), b3 + hstep, voffB); PG8_STAGE_A(PG8_SA(1, 0), a3, 0, nxu);
            PG8_WAIT_V(8); PG8_WAIT_L(0); PG8_BAR; PG8_MMA(1, 0, At, B0); PG8_MMA(1, 1, At, B1); PG8_BAR; PG8_SCHED;
            } else {
            PG8_LDB(B0, 0, 0); PG8_SCHED; PG8_LDA(At, 0, 0); PG8_STAGE(PG8_SA(1, 1), a1 + hstep, voffA);
            PG8_WAIT_L(8); PG8_BAR; PG8_WAIT_L(0); PG8_MMA(0, 0, At, B0); PG8_BAR; PG8_SCHED;
            PG8_LDB(B1, 0, 1); PG8_STAGE(PG8_SB(0, 0), b2, voffB);
            PG8_BAR; PG8_WAIT_L(0); PG8_MMA(0, 1, At, B1); PG8_BAR;
            PG8_LDA(At, 0, 1); PG8_STAGE(PG8_SA(0, 0), a2, voffA);
            PG8_BAR; PG8_WAIT_L(0); PG8_MMA(1, 0, At, B0); PG8_BAR; PG8_SCHED;
            PG8_STAGE(PG8_SB(0, 1), b2 + hstep, voffB);
            PG8_WAIT_V(6); PG8_BAR; PG8_MMA(1, 1, At, B1); PG8_BAR;
            PG8_LDB(B0, 1, 0); PG8_SCHED; PG8_LDA(At, 1, 0); PG8_STAGE(PG8_SA(0, 1), a2 + hstep, voffA);
            PG8_WAIT_L(8); PG8_BAR; PG8_WAIT_L(0); PG8_MMA(0, 0, At, B0); PG8_BAR; PG8_SCHED;
            PG8_LDB(B1, 1, 1); PG8_STAGE(PG8_SB(1, 0), b3, voffB);
            PG8_BAR; PG8_WAIT_L(0); PG8_MMA(0, 1, At, B1); PG8_BAR;
            PG8_LDA(At, 1, 1); PG8_STAGE(PG8_SA(1, 0), a3, voffA);
            PG8_BAR; PG8_WAIT_L(0); PG8_MMA(1, 0, At, B0); PG8_BAR; PG8_SCHED;
            PG8_STAGE(PG8_SB(1, 1), b3 + hstep, voffB);
            PG8_WAIT_V(6); PG8_BAR; PG8_MMA(1, 1, At, B1); PG8_BAR;
            }
        }
        if constexpr (ALIGN_EPI) { if (wr == 0) PG8_BAR; }
        if constexpr (!Epi::AFTER_DRAIN) { E(acc, cur, wr, wc, fr, fq, lds); S.done(cur); }
        if (!has_next) break;
#pragma unroll
        for (int a = 0; a < 2; ++a)
#pragma unroll
            for (int b = 0; b < 2; ++b)
#pragma unroll
                for (int m = 0; m < 4; ++m)
#pragma unroll
                    for (int n = 0; n < 2; ++n) acc[a][b][m][n] = acc_zero;
        cur = nxt; cA = nA; cB = nB; ++ui;
        if constexpr (ALIGN_EPI) { if (wr == 1) PG8_BAR; }
    }
    PG8_WAIT_V(0);
    if constexpr (!ALIGN_EPI) { if (wr == 0) PG8_BAR; }
    PG8_BAR;
    if constexpr (Epi::AFTER_DRAIN) { E.fused(acc, cur, wr, wc, fr, fq, lds, wid, lane); S.done(cur); }
#undef PG8_SA
#undef PG8_SB
#undef PG8_STAGE
#undef PG8_STAGE_A
#undef PG8_GOFF
#undef PG8_LDA
#undef PG8_LDB
#undef PG8_MMA
#undef PG8_WAIT_V
#undef PG8_WAIT_L
#undef PG8_BAR
#undef PG8_SCHED
}
}
namespace att {
typedef unsigned short bf16_t;
typedef short bf16x8 __attribute__((ext_vector_type(8)));
typedef short s16x4 __attribute__((ext_vector_type(4)));
typedef float f32x16 __attribute__((ext_vector_type(16)));
typedef float f32x4 __attribute__((ext_vector_type(4)));
typedef unsigned u32x4 __attribute__((ext_vector_type(4)));
typedef unsigned u32x2 __attribute__((ext_vector_type(2)));
#define ALDS __attribute__((address_space(3)))
typedef float f32x2_t __attribute__((ext_vector_type(2))); typedef __bf16 bf16x2_t __attribute__((ext_vector_type(2)));
__device__ __forceinline__ unsigned cvtpk(float lo, float hi) { f32x2_t v = {lo, hi}; bf16x2_t b = __builtin_convertvector(v, bf16x2_t); return __builtin_bit_cast(unsigned, b); }
__device__ __forceinline__ float bf2f(unsigned short u) { return __uint_as_float((unsigned)u << 16); }
template <int S> __device__ __forceinline__ bf16x8 pack8(const f32x16& x) {
    u32x4 p; p.x = cvtpk(x[8 * S + 0], x[8 * S + 1]); p.y = cvtpk(x[8 * S + 2], x[8 * S + 3]); p.z = cvtpk(x[8 * S + 4], x[8 * S + 5]); p.w = cvtpk(x[8 * S + 6], x[8 * S + 7]);
    return __builtin_bit_cast(bf16x8, p);
}
typedef short v4i16_t __attribute__((ext_vector_type(4)));
__device__ __forceinline__ s16x4 vtr(const ALDS char* p) { return __builtin_bit_cast(s16x4, __builtin_amdgcn_ds_read_tr16_b64_v4i16((ALDS v4i16_t*)p)); }
__device__ __forceinline__ int crow(int r, int hi) { return (r & 3) + 8 * (r >> 2) + 4 * hi; }
constexpr int ATT_LDS_BYTES = 2 * 12288 + 2 * 8192;

__device__ __forceinline__ void glds16(const void* gsrc, unsigned lds_dst) { unsigned keep;
    asm volatile("s_mov_b32 %0, m0\n\ts_mov_b32 m0, %2\n\ts_nop 0\n\tglobal_load_lds_dwordx4 %1, off\n\ts_mov_b32 m0, %0" : "=&s"(keep) : "v"(gsrc), "s"(lds_dst) : "memory"); }
__device__ __forceinline__ void glds16s(const char* sbase, unsigned voff, unsigned lds_dst) { unsigned keep;
    asm volatile("s_mov_b32 %0, m0\n\ts_mov_b32 m0, %3\n\ts_nop 0\n\tglobal_load_lds_dwordx4 %1, %2\n\ts_mov_b32 m0, %0" : "=&s"(keep) : "v"(voff), "s"(sbase), "s"(lds_dst) : "memory"); }
#define ATT_SBAR() __builtin_amdgcn_sched_barrier(0)
#define ATT_PIN(x) asm volatile("" : "+v"(x))
typedef int i32x2a __attribute__((ext_vector_type(2)));
typedef int i32x4a __attribute__((ext_vector_type(4)));
typedef int i32x6a __attribute__((ext_vector_type(6)));
typedef int i32x8a __attribute__((ext_vector_type(8)));
typedef unsigned u32x16 __attribute__((ext_vector_type(16)));
typedef __bf16 bf16x32_t __attribute__((ext_vector_type(32)));
__device__ __forceinline__ i32x6a cvt_fp6x32(const u32x16& w) { return __builtin_bit_cast(i32x6a, __builtin_amdgcn_cvt_scalef32_pk32_fp6_bf16(__builtin_bit_cast(bf16x32_t, w), 1.0f)); }
#define ATT_MF6_Z(C, A, B, SA, SB) asm volatile("v_mfma_scale_f32_32x32x64_f8f6f4 %0, %1, %2, 0, %3, %4 op_sel:[0,0,0] op_sel_hi:[0,0,0] cbsz:2 blgp:2" : "=&v"(C) : "v"(A), "v"(B), "v"(SA), "v"(SB))
#define ATT_MF6_A(C, A, B, SA, SB) asm volatile("v_mfma_scale_f32_32x32x64_f8f6f4 %0, %1, %2, %0, %3, %4 op_sel:[0,0,0] op_sel_hi:[0,0,0] cbsz:2 blgp:2" : "+v"(C) : "v"(A), "v"(B), "v"(SA), "v"(SB))
#define ATT_MF6_C(C, A, B, C0, SA, SB) asm volatile("v_mfma_scale_f32_32x32x64_f8f6f4 %0, %1, %2, %3, %4, %5 op_sel:[0,0,0] op_sel_hi:[0,0,0] cbsz:2 blgp:2" : "=&v"(C) : "v"(A), "v"(B), "v"(C0), "v"(SA), "v"(SB))
template <int DK> struct KCfg { static constexpr int NG = (DK == 96) ? 3 : 2, KTB = (DK == 96) ? 5120 : 3072, QRB = 24 * NG, NF = (DK == 96) ? 2 : 1, NRD = 4 * NF, PB = NG * 1024,
                                                      SCL = (DK == 32) ? 0x77777777 : 0x76767676, NB = (DK == 32) ? 2 : 4; };
constexpr float FQ96 = 4.0f * 1.4426950408889634f * 0.10206207261596575f * 2.0f, FQ32 = 4.0f * 1.4426950408889634f * 0.17677669529663687f, FQ64 = 4.0f * 1.4426950408889634f * 0.125f * 2.0f;
constexpr float P_BIAS = 44.0f / 256.0f;
constexpr int KC_A = 0, KC_B = 1024;
template <int DK>
__device__ __forceinline__ void kread6(i32x6a (&kf)[2][KCfg<DK>::NF], const ALDS char* pA0, const ALDS char* pB0, const ALDS char* pA1, const ALDS char* pB1, int idx) {
    constexpr int NF = KCfg<DK>::NF;
    const int mt = idx / (2 * NF), f = (idx / 2) % NF, part = idx & 1;
    const ALDS char* pA = f ? pA1 : pA0; const ALDS char* pB = f ? pB1 : pB0;
    if (part == 0) { const i32x4a v = *(const ALDS i32x4a*)(pA + mt * 512); kf[mt][f][0] = v.x; kf[mt][f][1] = v.y; kf[mt][f][2] = v.z; kf[mt][f][3] = v.w; }
    else { const i32x2a v = *(const ALDS i32x2a*)(pB + mt * 256); kf[mt][f][4] = v.x; kf[mt][f][5] = v.y; }
}
#define ATT_PV8(C, A, B) asm volatile("s_nop 3\n\tv_mfma_f32_32x32x64_f8f6f4 %0, %1, %2, %0 cbsz:0 blgp:1" : "+v"(C) : "v"(A), "v"(B))
#define ATT_L8(C, A, B) asm volatile("s_nop 3\n\tv_mfma_f32_16x16x128_f8f6f4 %0, %1, %2, %0 cbsz:0 blgp:1" : "+v"(C) : "v"(A), "v"(B))
#define ATT_L8N(C, A, B) asm volatile("v_mfma_f32_16x16x128_f8f6f4 %0, %1, %2, %0 cbsz:0 blgp:1" : "+v"(C) : "v"(A), "v"(B))
#define ATT_PV8N(C, A, B) asm volatile("v_mfma_f32_32x32x64_f8f6f4 %0, %1, %2, %0 cbsz:0 blgp:1" : "+v"(C) : "v"(A), "v"(B))
typedef unsigned short u16x2 __attribute__((ext_vector_type(2)));
__device__ __forceinline__ unsigned pk4_bf8(float a, float b, float c, float d) {
    const u16x2 x = __builtin_amdgcn_cvt_pknorm_u16(a, b), y = __builtin_amdgcn_cvt_pknorm_u16(c, d);
    return __builtin_amdgcn_perm(__builtin_bit_cast(unsigned, y), __builtin_bit_cast(unsigned, x), 0x07050301u); }
struct KPtr { const ALDS char *a0, *b0, *a1, *b1; };
template <int DK, int VLOAD, int ABL = 0, class DF>
__device__ __forceinline__ void att_step9(f32x16& N0, f32x16& N1, const f32x16& P0, const f32x16& P1, i32x6a (&kf)[2][KCfg<DK>::NF], const i32x6a* qfn,
                                          f32x16 (&o)[2], f32x4& L, const i32x8a& pwP, i32x8a& pwC, i32x8a (&vf)[2], const i32x8a& ones, const f32x16& cb, const int& sa, const int& sb,
                                          const ALDS char* vcur, const KPtr k1, const KPtr k0, DF&& dmaf) {
    constexpr int NF = KCfg<DK>::NF;
#define ATP_PACK(i) do { if (!(ABL & 4)) { const int e = 4 * (i); \
        int w = (int)((e < 16) ? pk4_bf8(P0[e & 15], P0[(e + 1) & 15], P0[(e + 2) & 15], P0[(e + 3) & 15]) : pk4_bf8(P1[e & 15], P1[(e + 1) & 15], P1[(e + 2) & 15], P1[(e + 3) & 15])); \
        ATT_PIN(w); pwC[i] = w; } } while (0)
    ATT_SBAR();
    ATT_PV8N(o[0], vf[0], pwP);
    dmaf();
#pragma unroll
    for (int k = 2 * NF; k < 4 * NF; ++k) { if (!(ABL & 8)) kread6<DK>(kf, k1.a0, k1.b0, k1.a1, k1.b1, k); }
#pragma unroll
    for (int i = 0; i < 4; ++i) ATP_PACK(i);
    ATT_SBAR();
    ATT_PV8N(o[1], vf[1], pwP);
    if (VLOAD && !(ABL & 8)) { vf[0].lo = *(const ALDS i32x4a*)(vcur); vf[0].hi = *(const ALDS i32x4a*)(vcur + 1024); }
#pragma unroll
    for (int i = 4; i < 8; ++i) ATP_PACK(i);
    ATT_SBAR();
    ATT_L8N(L, ones, pwP);
    if (VLOAD && !(ABL & 8)) { vf[1].lo = *(const ALDS i32x4a*)(vcur + 512); vf[1].hi = *(const ALDS i32x4a*)(vcur + 512 + 1024); }
    ATT_SBAR();
    if (DK == 64) { ATT_MF6_C(N0, kf[0][0], qfn[0], cb, sa, sb); ATT_MF6_C(N1, kf[1][0], qfn[0], cb, sa, sb); }
    else if (NF == 1) { ATT_MF6_Z(N0, kf[0][0], qfn[0], sa, sb); ATT_MF6_Z(N1, kf[1][0], qfn[0], sa, sb); }
    else { ATT_MF6_Z(N0, kf[0][0], qfn[0], sa, sb); ATT_MF6_Z(N1, kf[1][0], qfn[0], sa, sb); ATT_MF6_A(N0, kf[0][1], qfn[1], sa, sb); ATT_MF6_A(N1, kf[1][1], qfn[1], sa, sb); }
    ATT_SBAR();
#pragma unroll
    for (int k = 0; k < 2 * NF; ++k) { if (!(ABL & 8)) kread6<DK>(kf, k0.a0, k0.b0, k0.a1, k0.b1, k); }
    ATT_SBAR();
#undef ATP_PACK
}
template <int DK, int NMAP, int ABL = 0>
__device__ __forceinline__ void attn_unit_f8(const unsigned char* __restrict__ Qb, const char* __restrict__ Kt, const char* __restrict__ Vt, int t0, int t1,
                                             bf16_t* __restrict__ Ob, ALDS char* lds, float lam, const float* __restrict__ gout, float oml) {
    typedef KCfg<DK> KC;
    constexpr int KTB = KC::KTB, NF = KC::NF, NRD = KC::NRD, LV = 8 * KTB, CB = LV + 8 * 4096, NKP = KTB / 1024, NP = NKP + 4, NDMA = (NP + 7) / 8;
    int tid_l = threadIdx.x; asm volatile("" : "+v"(tid_l));
    const int tid = tid_l, lane = tid & 63, r32 = lane & 31, hi = lane >> 5, wid = __builtin_amdgcn_readfirstlane(tid >> 6);
    i32x6a qbias;
    { u32x16 vq, vk; unsigned pq = 0x40B040B0u, pk = 0x40804080u;
      asm volatile("" : "+v"(pq), "+v"(pk));
#pragma unroll
      for (int r = 0; r < 16; ++r) { vq[r] = (2 * r < KC::NB) ? pq : 0u; vk[r] = (2 * r < KC::NB) ? pk : 0u; }
      qbias = cvt_fp6x32(vq);
      if (DK != 64 && tid == 0) { const i32x6a kb = cvt_fp6x32(vk); const i32x4a ka = {kb[0], kb[1], kb[2], kb[3]}; const i32x2a kc = {kb[4], kb[5]};
          *(ALDS i32x4a*)(lds + CB + KC_A) = ka; *(ALDS i32x4a*)(lds + CB + KC_A + 512) = ka; *(ALDS i32x2a*)(lds + CB + KC_B) = kc; *(ALDS i32x2a*)(lds + CB + KC_B + 256) = kc; } }
    i32x6a qf[NMAP][NF];
    { const unsigned char* qrow = Qb + (size_t)(wid * 32 + r32) * KC::QRB;
#define ATP_QG(dst, off) do { const i32x2a a_ = *(const i32x2a*)(qrow + (off)), b_ = *(const i32x2a*)(qrow + (off) + 8), c_ = *(const i32x2a*)(qrow + (off) + 16); \
          dst[0] = a_.x; dst[1] = a_.y; dst[2] = b_.x; dst[3] = b_.y; dst[4] = c_.x; dst[5] = c_.y; } while (0)
      if (DK == 64) { ATP_QG(qf[0][0], 24 * hi); }
      else if (DK == 96) { ATP_QG(qf[0][0], 24 * hi); i32x6a t; ATP_QG(t, 48);
#pragma unroll
          for (int r = 0; r < 6; ++r) qf[0][NF - 1][r] = hi ? qbias[r] : t[r]; }
      else {
#pragma unroll
          for (int m = 0; m < NMAP; ++m) { i32x6a t; ATP_QG(t, 24 * m);
#pragma unroll
              for (int r = 0; r < 6; ++r) qf[m][0][r] = hi ? qbias[r] : t[r]; } }
#undef ATP_QG
    }
#pragma unroll
    for (int m = 0; m < NMAP; ++m)
#pragma unroll
        for (int f = 0; f < NF; ++f) ATT_PIN(qf[m][f]);
    f32x16 o[NMAP][2], cb; f32x4 L[NMAP]; i32x8a pw, ones; int sa = 0x7F7F7F7F, sb = KC::SCL;
    ATT_PIN(sa); ATT_PIN(sb);
#pragma unroll
    for (int r = 0; r < 16; ++r) cb[r] = P_BIAS;
    if (DK == 64) ATT_PIN(cb);
    { const int sel = (lane == 0 || lane == 32 || lane == 17 || lane == 49) ? 0x38383838 : 0;
#pragma unroll
      for (int r = 0; r < 8; ++r) { pw[r] = 0; ones[r] = sel; } }
    ATT_PIN(ones);
#pragma unroll
    for (int m = 0; m < NMAP; ++m) {
#pragma unroll
        for (int r = 0; r < 4; ++r) L[m][r] = 0.f;
#pragma unroll
        for (int d = 0; d < 2; ++d)
#pragma unroll
            for (int r = 0; r < 16; ++r) o[m][d][r] = 0.f; }
#pragma unroll
    for (int m = 0; m < NMAP; ++m) { ATT_PIN(L[m]); ATT_PIN(o[m][0]); ATT_PIN(o[m][1]); }
    const unsigned lds0 = (unsigned)(size_t)lds;
    const char* src0; unsigned dst0; int isv0; const bool act0 = wid < NP;
    { const int p = wid; isv0 = p >= NKP; src0 = (isv0 ? Vt + (p - NKP) * 1024 : Kt + p * 1024); dst0 = lds0 + (isv0 ? LV + (p - NKP) * 1024 : p * 1024); }
    const unsigned lane16 = (unsigned)lane * 16u;
    const bool act1 = (NDMA == 2) && wid == 7;
    const char* src1 = nullptr; unsigned dst1 = 0u;
    if (NDMA == 2) { const int p = 8; src1 = Vt + (p - NKP) * 1024; dst1 = lds0 + LV + (p - NKP) * 1024; }
#define ATP_DMA(tk, tv) do { if (ABL & (2 | 32)) break; \
        if (act0) { if (isv0) glds16s(src0 + (size_t)(tv) * 4096, lane16, (unsigned)__builtin_amdgcn_readfirstlane(dst0 + ((tv) & 7) * 4096)); else glds16s(src0 + (size_t)(tk) * KTB, lane16, (unsigned)__builtin_amdgcn_readfirstlane(dst0 + ((tk) & 7) * KTB)); } \
        if (act1) glds16s(src1 + (size_t)(tv) * 4096, lane16, (unsigned)__builtin_amdgcn_readfirstlane(dst1 + ((tv) & 7) * 4096)); } while (0)
#define ATP_SYNCALL() do { if (ABL & 2) break; if (!(ABL & 128)) { if (act1) asm volatile("s_waitcnt vmcnt(4)" ::: "memory"); else asm volatile("s_waitcnt vmcnt(2)" ::: "memory"); } \
        if (!(ABL & 64)) asm volatile("s_barrier" ::: "memory"); } while (0)
    const bool c0 = (DK == 32) && hi, c1 = hi;
    const int ka0 = c0 ? CB + KC_A : ((DK == 32) ? 0 : hi * 1024) + r32 * 16, kb0 = c0 ? CB + KC_B : KC::PB + ((DK == 32) ? 0 : hi * 512) + r32 * 8, km0 = c0 ? 0 : KTB;
    const int dA = (DK == 32 && !hi) ? 1024 : 0, dB = (DK == 32 && !hi) ? 512 : 0;
    const int ka1 = c1 ? CB + KC_A : 2048 + r32 * 16, kb1 = c1 ? CB + KC_B : KC::PB + 1024 + r32 * 8, km1 = c1 ? 0 : KTB;
#define ATP_KP(t, m) (KPtr{lds + ((t) & 7) * km0 + ka0 + (m) * dA, lds + ((t) & 7) * km0 + kb0 + (m) * dB, lds + ((t) & 7) * km1 + ka1, lds + ((t) & 7) * km1 + kb1})
#define ATP_VB(t) (lds + LV + ((t) & 7) * 4096 + klane64)
#define ATP_KLOAD(t, m) do { const KPtr kp_ = ATP_KP(t, m); _Pragma("unroll") for (int k = 0; k < NRD; ++k) kread6<DK>(kf, kp_.a0, kp_.b0, kp_.a1, kp_.b1, k); \
        asm volatile("s_waitcnt lgkmcnt(0)" ::: "memory"); \
        _Pragma("unroll") for (int mt_ = 0; mt_ < 2; ++mt_) _Pragma("unroll") for (int f_ = 0; f_ < NF; ++f_) ATT_PIN(kf[mt_][f_]);     \
        asm volatile("s_nop 3" ::: "memory"); } while (0)
    const int klane64 = hi * 2048 + r32 * 16;
    ATP_DMA(t0, t0); ATP_DMA(t0 + 1, t0 + 1); ATP_DMA(t0 + 2, t0 + 1); if (NMAP == 1) ATP_DMA(t0 + 3, t0 + 1);
    asm volatile("s_waitcnt vmcnt(0) lgkmcnt(0)\n\ts_barrier" ::: "memory");
    if (NMAP == 1) { ATP_DMA(t0 + 4, t0 + 2); ATP_DMA(t0 + 5, t0 + 3); } else { ATP_DMA(t0 + 3, t0 + 2); ATP_DMA(t0 + 4, t0 + 3); }
    i32x6a kf[2][NF]; i32x8a vf[2], pwB;
    f32x16 sA0, sA1, sB0, sB1;
    ATP_KLOAD(t0, 0);
    if (DK == 64) { ATT_MF6_C(sA0, kf[0][0], qf[0][0], cb, sa, sb); ATT_MF6_C(sA1, kf[1][0], qf[0][0], cb, sa, sb); } else { ATT_MF6_Z(sA0, kf[0][0], qf[0][0], sa, sb); ATT_MF6_Z(sA1, kf[1][0], qf[0][0], sa, sb); }
    if (NF == 2) { ATT_MF6_A(sA0, kf[0][1], qf[0][1], sa, sb); ATT_MF6_A(sA1, kf[1][1], qf[0][1], sa, sb); }
    asm volatile("s_nop 15\n\ts_nop 15\n\ts_nop 15\n\ts_nop 15\n\ts_nop 15\n\ts_nop 15" : "+v"(sA0), "+v"(sA1));
    { const KPtr kp_ = (NMAP == 1) ? ATP_KP(t0 + 1, 0) : ATP_KP(t0, 1);
#pragma unroll
      for (int k = 0; k < 2 * NF; ++k) kread6<DK>(kf, kp_.a0, kp_.b0, kp_.a1, kp_.b1, k); }
#pragma unroll
    for (int r = 0; r < 8; ++r) { vf[0][r] = 0; vf[1][r] = 0; pwB[r] = 0; }
    ATT_PIN(vf[0]); ATT_PIN(vf[1]); ATT_PIN(pwB);
    asm volatile("s_nop 3" ::: "memory");
    if (NMAP == 1) {
        for (int t = t0; t < t1; t += 2) {
            att_step9<DK, 1, ABL>(sB0, sB1, sA0, sA1, kf, qf[0], o[0], L[0], pwB, pw, vf, ones, cb, sa, sb, ATP_VB(t), ATP_KP(t + 1, 0), ATP_KP(t + 2, 0), [&]() { ATP_DMA(t + 6, t + 4); ATP_DMA(t + 7, t + 5); });
            att_step9<DK, 1, ABL>(sA0, sA1, sB0, sB1, kf, qf[0], o[0], L[0], pw, pwB, vf, ones, cb, sa, sb, ATP_VB(t + 1), ATP_KP(t + 2, 0), ATP_KP(t + 3, 0), [&]() {});
            ATP_SYNCALL();
        }
    } else {
        for (int t = t0; t < t1; t += 2) {
            att_step9<DK, 1, ABL>(sB0, sB1, sA0, sA1, kf, qf[1], o[1], L[1], pwB, pw, vf, ones, cb, sa, sb, ATP_VB(t), ATP_KP(t, 1), ATP_KP(t + 1, 0), [&]() { ATP_DMA(t + 5, t + 4); });
            att_step9<DK, 0, ABL>(sA0, sA1, sB0, sB1, kf, qf[0], o[0], L[0], pw, pwB, vf, ones, cb, sa, sb, ATP_VB(t), ATP_KP(t + 1, 0), ATP_KP(t + 1, 1), [&]() { ATP_DMA(t + 6, t + 5); });
            att_step9<DK, 1, ABL>(sB0, sB1, sA0, sA1, kf, qf[1], o[1], L[1], pwB, pw, vf, ones, cb, sa, sb, ATP_VB(t + 1), ATP_KP(t + 1, 1), ATP_KP(t + 2, 0), [&]() {});
            att_step9<DK, 0, ABL>(sA0, sA1, sB0, sB1, kf, qf[0], o[0], L[0], pw, pwB, vf, ones, cb, sa, sb, ATP_VB(t + 1), ATP_KP(t + 2, 0), ATP_KP(t + 2, 1), [&]() {});
            ATP_SYNCALL();
        }
    }
    ATT_SBAR();
    ATT_PV8N(o[NMAP - 1][0], vf[0], pwB); ATT_PV8N(o[NMAP - 1][1], vf[1], pwB); ATT_L8N(L[NMAP - 1], ones, pwB);
    asm volatile("s_waitcnt vmcnt(0) lgkmcnt(0)\n\ts_barrier" ::: "memory");
#pragma unroll
    for (int m = 0; m < NMAP; ++m) asm volatile("s_nop 15\n\ts_nop 15\n\ts_nop 15\n\ts_nop 15\n\ts_nop 15" : "+v"(o[m][0]), "+v"(o[m][1]), "+v"(L[m]));
#undef ATP_DMA
#undef ATP_SYNCALL
#undef ATP_KP
#undef ATP_VB
#undef ATP_KLOAD
    float li[NMAP];
#pragma unroll
    for (int m = 0; m < NMAP; ++m) { const float l0 = __shfl(L[m][0], r32 & 15), l1 = __shfl(L[m][1], r32 & 15); li[m] = 1.0f / ((r32 & 16) ? l1 : l0); }
    float val[2][16];
    if (NMAP == 1) {
#pragma unroll
        for (int d = 0; d < 2; ++d)
#pragma unroll
            for (int r = 0; r < 16; ++r) val[d][r] = o[0][d][r] * li[0];
    } else {
        float ss = 0.f; const float l2 = lam * li[NMAP - 1];
#pragma unroll
        for (int d = 0; d < 2; ++d)
#pragma unroll
            for (int r = 0; r < 16; ++r) { const float v = o[0][d][r] * li[0] - o[NMAP - 1][d][r] * l2; val[d][r] = v; ss += v * v; }
        ss += __shfl_xor(ss, 32);
        const float rstd = rsqrtf(ss * (1.0f / 64.0f) + 1e-6f) * oml;
#pragma unroll
        for (int d = 0; d < 2; ++d)
#pragma unroll
            for (int g = 0; g < 4; ++g) { const f32x4 gv = *(const f32x4*)(gout + 32 * d + 8 * g + 4 * hi);
#pragma unroll
                for (int i = 0; i < 4; ++i) val[d][4 * g + i] *= rstd * gv[i]; }
    }
    bf16_t* orow = Ob + (size_t)(wid * 32 + r32) * 1024 + 4 * hi;
#pragma unroll
    for (int d = 0; d < 2; ++d)
#pragma unroll
        for (int g = 0; g < 4; ++g) { u32x2 w; w.x = cvtpk(val[d][4 * g], val[d][4 * g + 1]); w.y = cvtpk(val[d][4 * g + 2], val[d][4 * g + 3]);
            *(u32x2*)(orow + 32 * d + 8 * g) = w; }
}

}
constexpr int NWAVES = 8;
constexpr int DM = 1024, NB = 4, SEQ = 8192, CL = 256, NTOKB = SEQ + CL, LROWS = NB * SEQ, MROWS = LROWS + NB * CL;
constexpr int NLAYER = 2, INC = 1952, ZP = 3072, NE = 16, FFD = 2048, CAPL = 1024, CAPC = 32, NKT = NTOKB / 64;
constexpr int ZQ = 1952, ZKV = 2336, ZEND = 2848;
constexpr float EPSF = 1e-6f, LOG2E = 1.4426950408889634f, HID_SCALE = 4.0f, YE_SCALE = 32.0f;
constexpr int N_PHASES = 22;
enum { I_X = 0, I_C, I_CTX, I_CCTX, I_WADA, I_BADA, I_GN1, I_WIN, I_GCQ, I_GCKV, I_WUQ, I_WUKV, I_GMQ, I_GMK, I_GDQ, I_GDK, I_LQ1, I_LK1, I_LQ2, I_LK2, I_GDO, I_GGQ, I_GGK, I_WO, I_GN2, I_WR, I_WG, I_WU, I_WD, N_IN };
constexpr size_t MiB = 1u << 20;
constexpr size_t WS_CTL = 0, CTL_ZERO_BYTES = 1 * MiB;
constexpr size_t WS_MOD = 1 * MiB;
constexpr size_t WS_LAM = WS_MOD + 256 * 1024;
constexpr size_t WS_TAB = WS_MOD + 320 * 1024;
constexpr size_t TAB_AROW = 0, TAB_ACOL = 128 * 8 * 8, TAB_GROW = TAB_ACOL + 64 * 8 * 8, TAB_GCOL = TAB_GROW + 128 * 16 * 8;
constexpr size_t WS_AFF = 2 * MiB, WS_AFFC = 4 * MiB;
constexpr size_t WS_IDX = 5 * MiB, WS_GATE = 6 * MiB;
constexpr size_t WS_INV = 7 * MiB;
constexpr size_t WS_SA = 10 * MiB, WS_SAE = 11 * MiB, WS_SW = 12 * MiB;
constexpr size_t WS_SSQ = 14 * MiB;
constexpr size_t WS_SWC = 13 * MiB;
constexpr size_t WS_WCAT8 = 72 * MiB;
constexpr size_t WS_WCAT = 16 * MiB;
constexpr size_t WS_WO = 28 * MiB;
constexpr size_t WS_CTXW = 32 * MiB;
constexpr size_t WS_H = 36 * MiB;
constexpr size_t WS_WGU = 102 * MiB;
constexpr size_t WS_WD = 230 * MiB;
constexpr size_t WS_YE = 294 * MiB;
constexpr size_t WS_Z = 430 * MiB;
constexpr size_t WS_QKV = 628 * MiB;
constexpr size_t WS_ATT = 793 * MiB;
constexpr size_t WS_DELTA = 430 * MiB;
constexpr size_t WS_XE = 430 * MiB;
constexpr size_t WS_HID = 566 * MiB;
constexpr size_t WS_XB = 859 * MiB;
constexpr size_t WS_END = 925 * MiB;
constexpr size_t QO_QM = 0, QO_QD = 25952256, QO_QG = 43253760, QO_KM = 77856768, QO_KD = 103809024, QO_KG = 121110528, QO_VM = 129761280, QO_VD = 147062784, QO_VG = 164364288;
static_assert(QO_VG + 8650752 == 173015040 && WS_QKV + 173015040 <= WS_ATT && WS_HID + (size_t)16 * 4352 * 2048 * 2 <= WS_XB, "ws map");
constexpr int CW_BAR = 4096, CW_Q = 16384;
constexpr int RING_BYTES = 131072, LDSCTL_OFF = RING_BYTES, MISC_OFF = LDSCTL_OFF + 320, LDS_BYTES = 163840;

#define GAS __attribute__((address_space(1)))
#define LAS __attribute__((address_space(3)))
typedef unsigned short bf16;
typedef unsigned v4u __attribute__((ext_vector_type(4)));
typedef unsigned v2u __attribute__((ext_vector_type(2)));
typedef float f32x4 __attribute__((ext_vector_type(4)));
typedef float f32x2 __attribute__((ext_vector_type(2)));
typedef GAS unsigned gu32;
#define RLX_AGENT __ATOMIC_RELAXED, __HIP_MEMORY_SCOPE_AGENT
#define LDS_WAIT() asm volatile("s_waitcnt lgkmcnt(0)" ::: "memory")
__device__ __forceinline__ unsigned pk2(float lo, float hi) { return att::cvtpk(lo, hi); }
__device__ __forceinline__ float bflo(unsigned w) { return __uint_as_float(w << 16); }
__device__ __forceinline__ float bfhi(unsigned w) { return __uint_as_float(w & 0xffff0000u); }
#define XB_TMO      128
#define XB_XCNT(j)  (256  + 64 * (j))
#define XB_XSUB(j)  (1280 + 64 * (j))
#define XB_XGEN(j)  (2304 + 64 * (j))
#define XB_TOP      3328
#define XB_TOPGEN   3392
#define XCD_BAR_WORDS 3456
#define XB_SPIN_CAP (1u << 18)

__device__ __forceinline__ unsigned xb_ld(unsigned* p)              { return __hip_atomic_load(p, __ATOMIC_RELAXED, __HIP_MEMORY_SCOPE_AGENT); }
__device__ __forceinline__ unsigned xb_add(unsigned* p, unsigned v) { return __hip_atomic_fetch_add(p, v, __ATOMIC_RELAXED, __HIP_MEMORY_SCOPE_AGENT); }
__device__ __forceinline__ unsigned xb_xcc_id() { return (unsigned)__builtin_amdgcn_s_getreg((3 << 11) | 20) & 0xFu; }
#define XB_SPIN(cond, bar) do { unsigned _sp = 0; while (cond) { __builtin_amdgcn_s_sleep(1); \
    if ((++_sp & 255u) == 0u) { if (xb_ld(&(bar)[XB_TMO])) break; if (_sp > XB_SPIN_CAP) { atomicAdd(&(bar)[XB_TMO], 1u); break; } } } } while (0)

struct XcdBarrier {
    unsigned* bar; unsigned x;
    volatile LAS unsigned* st;
};

__device__ __forceinline__ XcdBarrier xcd_barrier_post(unsigned* bar, volatile LAS unsigned* st) {
    XcdBarrier b; b.bar = bar; b.x = xb_xcc_id(); b.st = st;
    if (threadIdx.x == 0) (void)xb_add(&bar[XB_XCNT(b.x)], 1u);
    return b;
}
__device__ __forceinline__ void xcd_barrier_complete(unsigned* bar, unsigned x, unsigned& nloc, unsigned& nx) {
    const unsigned G = gridDim.x * gridDim.y * gridDim.z;
    unsigned sum, cnt, mine, sp = 0u;
    for (;;) {
        sum = 0u; cnt = 0u; mine = 0u;
#pragma unroll
        for (unsigned j = 0; j < 16; ++j) { const unsigned c = xb_ld(&bar[XB_XCNT(j)]); sum += c; cnt += (c > 0u) ? 1u : 0u; mine = (j == x) ? c : mine; }
        if (sum == G) break;
        __builtin_amdgcn_s_sleep(1);
        if ((++sp & 255u) == 0u) { if (xb_ld(&bar[XB_TMO])) break; if (sp > XB_SPIN_CAP) { atomicAdd(&bar[XB_TMO], 1u); break; } }
    }
    nloc = mine > 0u ? mine : 1u; nx = cnt > 0u ? cnt : 1u;
}

__device__ __forceinline__ void xcd_barrier(const XcdBarrier& b) {
    asm volatile("s_waitcnt vmcnt(0)" ::: "memory");
    __syncthreads();
    if (threadIdx.x == 0) {
        unsigned* bar = b.bar;
        __builtin_amdgcn_s_waitcnt(0);
        unsigned nloc = b.st[0], nx = b.st[1];
        if (nloc == 0u) { xcd_barrier_complete(bar, b.x, nloc, nx); b.st[0] = nloc; b.st[1] = nx; }
        const unsigned old = xb_add(&bar[XB_XSUB(b.x)], 1u);
        const unsigned gen = old / nloc;
        if (old + 1u == (gen + 1u) * nloc) {
            __builtin_amdgcn_fence(__ATOMIC_RELEASE, "agent");
            asm volatile("s_waitcnt vmcnt(0)" ::: "memory");
            const unsigned og = xb_add(&bar[XB_TOP], 1u);
            const unsigned tg = og / nx;
            if (og + 1u == (tg + 1u) * nx) xb_add(&bar[XB_TOPGEN], 1u);
            else XB_SPIN(xb_ld(&bar[XB_TOPGEN]) == tg, bar);
            __builtin_amdgcn_fence(__ATOMIC_ACQUIRE, "agent");
            xb_add(&bar[XB_XGEN(b.x)], 1u);
            asm volatile("s_waitcnt vmcnt(0)" ::: "memory");
        } else {
            XB_SPIN(xb_ld(&bar[XB_XGEN(b.x)]) == gen, bar);
            __builtin_amdgcn_fence(__ATOMIC_ACQUIRE, "agent");
            asm volatile("s_waitcnt vmcnt(0)" ::: "memory");
        }
    }
    __syncthreads();
}
struct Args { const float* in[N_IN]; float* out; unsigned char* ws; int ph_lo, ph_hi; };
static_assert(sizeof(Args) == 256, "Args has no padding bytes");
typedef const __attribute__((address_space(4))) Args* KA;
__device__ __forceinline__ KA kargs() { KA p = (KA)__builtin_amdgcn_kernarg_segment_ptr(); asm volatile("" : "+s"(p)); return p; }
struct Frame {
    LAS unsigned char* lds;
    volatile LAS unsigned* MISC;
    gu32* ctl;
    int tid, lane, wave, vcu, G;
};
__device__ __forceinline__ void relane(Frame& F) { int t = threadIdx.x; asm volatile("" : "+v"(t)); F.tid = t; F.lane = t & 63; F.wave = __builtin_amdgcn_readfirstlane(t >> 6); }
__device__ __forceinline__ float wave_sum(float v) {
#pragma unroll
    for (int o = 1; o < 64; o <<= 1) v += __shfl_xor(v, o);
    return v;
}
__device__ __forceinline__ float silu_f(float x) { return x / (1.0f + __expf(-x)); }

__device__ __forceinline__ void transpose_item(const float* __restrict__ W, int N, bf16* __restrict__ WT, int ldt, int k0, int n0, int rowbase, LAS float* scr, int lane) {
    float tv[32];
    { const float* wp = W + (size_t)(k0 + (lane >> 5)) * N + n0 + (lane & 31);
#pragma unroll
      for (int i = 0; i < 32; ++i) tv[i] = __builtin_nontemporal_load(wp + (size_t)(2 * i) * N); }
#pragma unroll
    for (int i = 0; i < 32; ++i) scr[(2 * i + (lane >> 5)) * 33 + (lane & 31)] = tv[i];
    LDS_WAIT(); asm volatile("" ::: "memory");
    const int c = lane & 7;
#pragma unroll
    for (int j = 0; j < 4; ++j) { const int n = (lane >> 3) + 8 * j; const LAS float* s = scr + (8 * c) * 33 + n;
        v4u o; o.x = pk2(s[0 * 33], s[1 * 33]); o.y = pk2(s[2 * 33], s[3 * 33]); o.z = pk2(s[4 * 33], s[5 * 33]); o.w = pk2(s[6 * 33], s[7 * 33]);
        *(v4u*)(WT + (size_t)(rowbase + n) * ldt + k0 + 8 * c) = o; }
    LDS_WAIT(); asm volatile("" ::: "memory");
}

__device__ __forceinline__ void transpose_item_i8(const float* __restrict__ W, int N, signed char* __restrict__ WT, int ldt, int k0, int n0, int rowbase, float qs, LAS float* scr, int lane) {
    float tv[32];
    { const float* wp = W + (size_t)(k0 + (lane >> 5)) * N + n0 + (lane & 31);
#pragma unroll
      for (int i = 0; i < 32; ++i) tv[i] = __builtin_nontemporal_load(wp + (size_t)(2 * i) * N); }
#pragma unroll
    for (int i = 0; i < 32; ++i) scr[(2 * i + (lane >> 5)) * 33 + (lane & 31)] = tv[i];
    LDS_WAIT(); asm volatile("" ::: "memory");
    const int c = lane & 3;
#pragma unroll
    for (int j = 0; j < 2; ++j) { const int n = (lane >> 2) + 16 * j; const LAS float* s = scr + (16 * c) * 33 + n; v4u o;
#pragma unroll
        for (int d = 0; d < 4; ++d) { unsigned w = 0u;
#pragma unroll
            for (int i = 0; i < 4; ++i) { const float f = fminf(fmaxf(s[(4 * d + i) * 33] * qs, -127.0f), 127.0f); w |= ((unsigned)((int)__builtin_rintf(f)) & 255u) << (8 * i); }
            o[d] = w; }
        *(v4u*)(WT + (size_t)(rowbase + n) * ldt + k0 + 16 * c) = o; }
    LDS_WAIT(); asm volatile("" ::: "memory");
}

__device__ __forceinline__ void transpose_item_f8(const float* __restrict__ W, int N, unsigned char* __restrict__ WT, int ldt, int k0, int n0, int rowbase, float qs, LAS float* scr, int lane) {
    float tv[32];
    { const float* wp = W + (size_t)(k0 + (lane >> 5)) * N + n0 + (lane & 31);
#pragma unroll
      for (int i = 0; i < 32; ++i) tv[i] = __builtin_nontemporal_load(wp + (size_t)(2 * i) * N); }
#pragma unroll
    for (int i = 0; i < 32; ++i) scr[(2 * i + (lane >> 5)) * 33 + (lane & 31)] = tv[i];
    LDS_WAIT(); asm volatile("" ::: "memory");
    const int c = lane & 3;
#pragma unroll
    for (int j = 0; j < 2; ++j) { const int n = (lane >> 2) + 16 * j; const LAS float* s = scr + (16 * c) * 33 + n; v4u o;
#pragma unroll
        for (int d = 0; d < 4; ++d) { float f[4];
#pragma unroll
            for (int i = 0; i < 4; ++i) f[i] = fminf(fmaxf(s[(4 * d + i) * 33] * qs, -448.0f), 448.0f);
            int w = __builtin_amdgcn_cvt_pk_fp8_f32(f[0], f[1], 0, false); w = __builtin_amdgcn_cvt_pk_fp8_f32(f[2], f[3], w, true); o[d] = (unsigned)w; }
        *(v4u*)(WT + (size_t)(rowbase + n) * ldt + k0 + 16 * c) = o; }
    LDS_WAIT(); asm volatile("" ::: "memory");
}

__device__ __forceinline__ void sincos_d(float af, float& c, float& s) {
    const double a = (double)af;
    const double q = __builtin_rint(a * 0.63661977236758134308);
    double r = __builtin_fma(-q, 1.57079632679489655800e+00, a); r = __builtin_fma(-q, 6.12323399573676603587e-17, r);
    const double r2 = r * r;
    double sp = -7.6471637318198164759e-13; sp = sp * r2 + 1.6059043836821614599e-10; sp = sp * r2 - 2.5052108385441718775e-08; sp = sp * r2 + 2.7557319223985890653e-06;
    sp = sp * r2 - 1.9841269841269841270e-04; sp = sp * r2 + 8.3333333333333333333e-03; sp = sp * r2 - 1.6666666666666666667e-01; const double sn = r + r * r2 * sp;
    double cp = 4.7794773323873852974e-14; cp = cp * r2 - 1.1470745597729724714e-11; cp = cp * r2 + 2.0876756987868098979e-09; cp = cp * r2 - 2.7557319223985890653e-07;
    cp = cp * r2 + 2.4801587301587301587e-05; cp = cp * r2 - 1.3888888888888888889e-03; cp = cp * r2 + 4.1666666666666666667e-02; cp = cp * r2 - 0.5; const double cs = 1.0 + r2 * cp;
    const int qi = (int)q & 3;
    const double cc = (qi == 0) ? cs : (qi == 1) ? -sn : (qi == 2) ? -cs : sn;
    const double ss = (qi == 0) ? sn : (qi == 1) ? cs : (qi == 2) ? -sn : -cs;
    c = (float)cc; s = (float)ss;
}

#define MEMFENCE() asm volatile("" ::: "memory")
__device__ __forceinline__ void p0_prologue(KA a, Frame& F) {
    relane(F);
    unsigned char* ws = a->ws;
    float* MOD = (float*)(ws + WS_MOD);
    if ((int)blockIdx.x < 192) {
        LAS float* sl = (LAS float*)F.lds + 4096;
        for (int i = F.tid; i < 5 * 1024; i += NWAVES * 64) { const int v = i >> 10, k = i & 1023; const float cv = (v < 4) ? a->in[I_C][v * 1024 + k] : a->in[I_CCTX][k]; sl[i] = silu_f(cv); }
        __syncthreads();
        for (int it = blockIdx.x; it < 192; it += F.G) {
            const int l = it / 96, col = (it % 96) * 64 + F.lane;
            const float* W = a->in[I_WADA] + (size_t)l * 1024 * 6144;
            float acc[5] = {0.f, 0.f, 0.f, 0.f, 0.f};
#pragma unroll 8
            for (int kk = 0; kk < 128; ++kk) { const int k = F.wave * 128 + kk; const float w = W[(size_t)k * 6144 + col];
#pragma unroll
                for (int v = 0; v < 5; ++v) acc[v] += sl[v * 1024 + k] * w; }
            LAS float* red = (LAS float*)F.lds;
#pragma unroll
            for (int v = 0; v < 5; ++v) red[(F.wave * 5 + v) * 64 + F.lane] = acc[v];
            __syncthreads();
            if (F.wave < 5) { float s2 = a->in[I_BADA][l * 6144 + col];
#pragma unroll
                for (int w = 0; w < 8; ++w) s2 += red[(w * 5 + F.wave) * 64 + F.lane];
                MOD[(l * 5 + F.wave) * 6144 + col] = s2; }
            __syncthreads();
        }
    }
    for (int it = blockIdx.x; it < 96; it += F.G) {
        const int l = it / 48, e = (it % 48) / 3, which = it % 3;
        float ss = 0.f;
        if (which < 2) { const float* W = (which ? a->in[I_WU] : a->in[I_WG]) + ((size_t)l * NE + e) * 1024 * 2048;
            for (int i = 0; i < 32; ++i) { const f32x4 v = *(const f32x4*)(W + (size_t)(32 * i) * 2048 + 4 * F.tid); ss += (v.x * v.x + v.y * v.y) + (v.z * v.z + v.w * v.w); } }
        else { const float* W = a->in[I_WD] + ((size_t)l * NE + e) * 2048 * 1024;
            for (int i = 0; i < 64; ++i) { const f32x2 v = *(const f32x2*)(W + (size_t)(32 * i) * 1024 + 2 * F.tid); ss += v.x * v.x + v.y * v.y; } }
        ss = wave_sum(ss);
        LAS float* red = (LAS float*)F.lds;
        if (F.lane == 0) red[F.wave] = ss;
        __syncthreads();
        if (F.tid == 0) { float t = 0.f; for (int w = 0; w < NWAVES; ++w) t += red[w]; const float rms = fmaxf(sqrtf(t * (1.0f / 65536.0f)), 1e-20f);
            ((float*)(ws + WS_SW))[l * 48 + 3 * e + which] = (which < 2) ? 5.0f * rms * (1.0f / 127.0f) : rms * (1.0f / 16.0f); }
        __syncthreads();
    }
    if ((int)blockIdx.x == 192 % F.G && F.wave == 0) {
        float* LAM = (float*)(ws + WS_LAM);
        for (int l = 0; l < NLAYER; ++l) {
            const float p1 = F.lane < 32 ? a->in[I_LQ1][l * 32 + F.lane] * a->in[I_LK1][l * 32 + F.lane] : 0.f;
            const float p2 = F.lane < 32 ? a->in[I_LQ2][l * 32 + F.lane] * a->in[I_LK2][l * 32 + F.lane] : 0.f;
            const float s1 = wave_sum(p1), s2 = wave_sum(p2);
            const float li = 0.8f - 0.6f * expf(-0.3f * (float)l);
            if (F.lane == 0) { LAM[2 * l] = expf(s1) - expf(s2) + li; LAM[2 * l + 1] = li; }
        }
    }
    if ((int)blockIdx.x == 193 % F.G) {
        f32x2* TA_R = (f32x2*)(ws + WS_TAB + TAB_AROW); f32x2* TA_C = (f32x2*)(ws + WS_TAB + TAB_ACOL); f32x2* TG_R = (f32x2*)(ws + WS_TAB + TAB_GROW); f32x2* TG_C = (f32x2*)(ws + WS_TAB + TAB_GCOL);
        const double b8 = 1.0 / __builtin_sqrt(__builtin_sqrt(__builtin_sqrt(10000.0))), b16 = 1.0 / __builtin_sqrt(__builtin_sqrt(__builtin_sqrt(__builtin_sqrt(10000.0))));
        for (int e = F.tid; e < 4608; e += NWAVES * 64) {
            int pos, i, nf; f32x2* dst;
            if (e < 1024) { pos = e >> 3; i = e & 7; nf = 8; dst = TA_R + e; }
            else if (e < 1536) { const int r = e - 1024; pos = r >> 3; i = r & 7; nf = 8; dst = TA_C + r; }
            else if (e < 3584) { const int r = e - 1536; pos = r >> 4; i = r & 15; nf = 16; dst = TG_R + r; }
            else { const int r = e - 3584; pos = r >> 4; i = r & 15; nf = 16; dst = TG_C + r; }
            double inv = 1.0; const double bb = (nf == 8) ? b8 : b16;
            for (int j = 0; j < i; ++j) inv *= bb;
            const float ang = (float)pos * (float)inv;
            float c, s; sincos_d(ang, c, s);
            *dst = (f32x2){c, s};
        }
    }
    for (int it = blockIdx.x; it < 896; it += F.G) {
        const int l = it / 448; int r = it % 448;
        int kb, nb, R, roff, ncols, orow0; const float *Wu, *gg;
        if (r < 192) { kb = r / 6; nb = r % 6; R = 256; roff = 0; ncols = 384; orow0 = ZQ + nb * 64; Wu = a->in[I_WUQ] + (size_t)l * 256 * 384; gg = a->in[I_GCQ] + l * 256; }
        else { r -= 192; kb = r / 8; nb = r % 8; R = 128; roff = 256; ncols = 512; orow0 = ZKV + nb * 64; Wu = a->in[I_WUKV] + (size_t)l * 128 * 512; gg = a->in[I_GCKV] + l * 128; }
        const float* Win = a->in[I_WIN] + (size_t)l * 1024 * INC;
        LAS float* As = (LAS float*)F.lds; LAS float* Bs = As + 32 * 257;
        for (int idx = F.tid; idx < 32 * R; idx += NWAVES * 64) { const int kk = idx / R, rr = idx % R; As[kk * 257 + rr] = Win[(size_t)(kb * 32 + kk) * INC + roff + rr]; }
        for (int idx = F.tid; idx < R * 64; idx += NWAVES * 64) { const int rr = idx >> 6, n = idx & 63; Bs[rr * 64 + n] = gg[rr] * Wu[(size_t)rr * ncols + nb * 64 + n]; }
        __syncthreads();
        const int kk = F.tid & 31, ng = F.tid >> 5;
        f32x4 acc = (f32x4){0.f, 0.f, 0.f, 0.f};
        for (int rr = 0; rr < R; ++rr) { const float av = As[kk * 257 + rr]; const f32x4 bv = *(const LAS f32x4*)(Bs + rr * 64 + ng * 4); acc += av * bv; }
        bf16* Wc = (bf16*)(ws + WS_WCAT) + (size_t)l * ZP * 1024;
#pragma unroll
        for (int j = 0; j < 4; ++j) Wc[(size_t)(orow0 + ng * 4 + j) * 1024 + kb * 32 + kk] = (bf16)(pk2(acc[j], 0.f) & 0xffffu);
        __syncthreads();
    }
    {
        LAS float* scr = (LAS float*)(F.lds + F.wave * 16384);
        const int gw = F.vcu * NWAVES + F.wave, NGW = F.G * NWAVES;
        constexpr int I_IN = 16 * 61, I_O = 16 * 32, PER_L = I_IN + I_O;
        for (int it = gw; it < NLAYER * PER_L; it += NGW) {
            const int l = it / PER_L; int r = it % PER_L;
            if (r < I_IN) { const int kb = r / 61, nb = r % 61; transpose_item(a->in[I_WIN] + (size_t)l * 1024 * INC, INC, (bf16*)(ws + WS_WCAT) + (size_t)l * ZP * 1024, 1024, kb * 64, nb * 32, nb * 32, scr, F.lane); }
            else { r -= I_IN; const int kb = r / 32, nb = r % 32; transpose_item(a->in[I_WO] + (size_t)l * 1024 * 1024, 1024, (bf16*)(ws + WS_WO) + (size_t)l * 1024 * 1024, 1024, kb * 64, nb * 32, nb * 32, scr, F.lane); }
        }
        const int gt = F.vcu * (NWAVES * 64) + F.tid, NGT = F.G * NWAVES * 64;
        constexpr int PADV = (ZP - ZEND) * 1024 * 2 / 16;
        for (int i = gt; i < NLAYER * PADV; i += NGT) { const int l = i / PADV, j = i % PADV; ((v4u*)((bf16*)(ws + WS_WCAT) + ((size_t)l * ZP + ZEND) * 1024))[j] = (v4u){0u, 0u, 0u, 0u}; }
    }
}

__device__ __forceinline__ void phase_a(KA a, Frame& F, int l) {
    relane(F);
    unsigned char* ws = a->ws;
    const float* MOD = (const float*)(ws + WS_MOD);
    const int* INV = (const int*)(ws + WS_INV);
    const unsigned char* YE = (const unsigned char*)(ws + WS_YE);
    const bool fin = (l == NLAYER);
    const int nrows = fin ? LROWS : MROWS;
    const int gw = F.vcu * NWAVES + F.wave, NGW = F.G * NWAVES;
#define PA_LOAD(r, XF, XB, IV) do { if (l == 0) { const float* src_ = ((r) >= LROWS) ? a->in[I_CTX] + (size_t)((r) - LROWS) * 1024 : a->in[I_X] + (size_t)(r) * 1024; \
            _Pragma("unroll") for (int j = 0; j < 4; ++j) XF[j] = *(const f32x4*)(src_ + 4 * F.lane + 256 * j); } \
        else { const bf16* xb_ = (const bf16*)(ws + WS_XB) + (size_t)(r) * 1024; _Pragma("unroll") for (int j = 0; j < 4; ++j) XB[j] = *(const v2u*)(xb_ + 4 * F.lane + 256 * j); \
            IV = INV[(size_t)(r) * 16 + (F.lane & 15)]; } } while (0)
    f32x4 cf[4]; v2u cb[4]; int civ = -1;
#pragma unroll
    for (int j = 0; j < 4; ++j) { cf[j] = (f32x4){0.f, 0.f, 0.f, 0.f}; cb[j] = (v2u){0u, 0u}; }
    if (gw < nrows) PA_LOAD(gw, cf, cb, civ);
    for (int row = gw; row < nrows; row += NGW) {
        const bool isc = row >= LROWS; const int v = isc ? 4 : (row >> 13);
        bf16* xb = (bf16*)(ws + WS_XB) + (size_t)row * 1024;
        const int nrow = row + NGW; f32x4 nf[4]; v2u nb[4]; int niv = -1;
#pragma unroll
        for (int j = 0; j < 4; ++j) { nf[j] = cf[j]; nb[j] = cb[j]; }
        if (nrow < nrows) PA_LOAD(nrow, nf, nb, niv);
        f32x4 xv[4];
        if (l == 0) {
#pragma unroll
            for (int j = 0; j < 4; ++j) xv[j] = cf[j]; }
        else {
#pragma unroll
            for (int j = 0; j < 4; ++j) xv[j] = (f32x4){bflo(cb[j].x), bfhi(cb[j].x), bflo(cb[j].y), bfhi(cb[j].y)}; }
        if (l > 0) {
            const float* ga2 = MOD + ((l - 1) * 5 + v) * 6144 + 5 * 1024;
            f32x4 acc[4];
#pragma unroll
            for (int j = 0; j < 4; ++j) acc[j] = (f32x4){0.f, 0.f, 0.f, 0.f};
            unsigned sel = (unsigned)(__ballot(civ >= 0) & 0xFFFFull);
            while (sel) {
                int sl[4]; float on[4];
#pragma unroll
                for (int k = 0; k < 4; ++k) { if (sel) { const int e = __builtin_ctz(sel); sel &= sel - 1u; sl[k] = __builtin_amdgcn_readlane(civ, e); on[k] = 1.0f; } else { sl[k] = sl[0]; on[k] = 0.0f; } }
                unsigned w[4][4];
#pragma unroll
                for (int k = 0; k < 4; ++k) { const unsigned char* yr = YE + (size_t)sl[k] * 1024 + 4 * F.lane;
#pragma unroll
                    for (int j = 0; j < 4; ++j) w[k][j] = *(const unsigned*)(yr + 256 * j); }
#pragma unroll
                for (int k = 0; k < 4; ++k)
#pragma unroll
                    for (int j = 0; j < 4; ++j) { const f32x2 lo = __builtin_amdgcn_cvt_pk_f32_fp8((int)w[k][j], false), hi = __builtin_amdgcn_cvt_pk_f32_fp8((int)w[k][j], true);
                        acc[j] += on[k] * (f32x4){lo.x, lo.y, hi.x, hi.y}; }
            }
#pragma unroll
            for (int j = 0; j < 4; ++j) { const f32x4 g = *(const f32x4*)(ga2 + 4 * F.lane + 256 * j); xv[j] += g * (acc[j] * (1.0f / YE_SCALE)); }
        }
#pragma unroll
        for (int j = 0; j < 4; ++j) { cf[j] = nf[j]; cb[j] = nb[j]; }
        civ = niv;
        if (fin) {
#pragma unroll
            for (int j = 0; j < 4; ++j) *(f32x4*)(a->out + (size_t)row * 1024 + 4 * F.lane + 256 * j) = xv[j];
            continue; }
#pragma unroll
        for (int j = 0; j < 4; ++j) { v2u w; w.x = pk2(xv[j].x, xv[j].y); w.y = pk2(xv[j].z, xv[j].w); *(v2u*)(xb + 4 * F.lane + 256 * j) = w; }
        float ss = 0.f;
#pragma unroll
        for (int j = 0; j < 4; ++j) ss += (xv[j].x * xv[j].x + xv[j].y * xv[j].y) + (xv[j].z * xv[j].z + xv[j].w * xv[j].w);
        const float rstd = rsqrtf(wave_sum(ss) * (1.0f / 1024.0f) + EPSF);
        const float* g1 = a->in[I_GN1] + l * 1024; const float* sh = MOD + (l * 5 + v) * 6144; const float* sc = sh + 1024;
        float am = 0.f;
#pragma unroll
        for (int j = 0; j < 4; ++j) { const int c0 = 4 * F.lane + 256 * j; const f32x4 g = *(const f32x4*)(g1 + c0), s1 = *(const f32x4*)(sc + c0), b1 = *(const f32x4*)(sh + c0);
            xv[j] = xv[j] * rstd * g * (1.0f + s1) + b1;
            am = fmaxf(fmaxf(am, fmaxf(fabsf(xv[j].x), fabsf(xv[j].y))), fmaxf(fabsf(xv[j].z), fabsf(xv[j].w))); }
#pragma unroll
        for (int o = 1; o < 64; o <<= 1) am = fmaxf(am, __shfl_xor(am, o));
        const float qs = am > 0.f ? 127.0f / am : 0.f;
        signed char* h8 = (signed char*)(ws + WS_H) + (size_t)row * 1024;
#pragma unroll
        for (int j = 0; j < 4; ++j) { const int q0 = (int)__builtin_rintf(xv[j].x * qs), q1 = (int)__builtin_rintf(xv[j].y * qs), q2 = (int)__builtin_rintf(xv[j].z * qs), q3 = (int)__builtin_rintf(xv[j].w * qs);
            *(unsigned*)(h8 + 4 * F.lane + 256 * j) = (unsigned)(q0 & 255) | ((unsigned)(q1 & 255) << 8) | ((unsigned)(q2 & 255) << 16) | ((unsigned)(q3 & 255) << 24); }
        if (F.lane == 0) ((float*)(ws + WS_SA))[row] = am * (1.0f / 127.0f);
    }
#undef PA_LOAD
    if (l == 0) {
        const bf16* Wc = (const bf16*)(ws + WS_WCAT); signed char* W8 = (signed char*)(ws + WS_WCAT8); float* SWC = (float*)(ws + WS_SWC);
        for (int r = gw; r < NLAYER * ZP; r += NGW) {
            float wv[16]; float am = 0.f;
#pragma unroll
            for (int j = 0; j < 2; ++j) { const v4u w = *(const v4u*)(Wc + (size_t)r * 1024 + 8 * F.lane + 512 * j);
                wv[8 * j + 0] = bflo(w.x); wv[8 * j + 1] = bfhi(w.x); wv[8 * j + 2] = bflo(w.y); wv[8 * j + 3] = bfhi(w.y); wv[8 * j + 4] = bflo(w.z); wv[8 * j + 5] = bfhi(w.z); wv[8 * j + 6] = bflo(w.w); wv[8 * j + 7] = bfhi(w.w); }
#pragma unroll
            for (int i = 0; i < 16; ++i) am = fmaxf(am, fabsf(wv[i]));
#pragma unroll
            for (int o = 1; o < 64; o <<= 1) am = fmaxf(am, __shfl_xor(am, o));
            const float qs = am > 0.f ? 127.0f / am : 0.f;
#pragma unroll
            for (int j = 0; j < 2; ++j) { unsigned w0 = 0u, w1 = 0u;
#pragma unroll
                for (int i = 0; i < 4; ++i) { w0 |= ((unsigned)((int)__builtin_rintf(wv[8 * j + i] * qs)) & 255u) << (8 * i); w1 |= ((unsigned)((int)__builtin_rintf(wv[8 * j + 4 + i] * qs)) & 255u) << (8 * i); }
                v2u o; o.x = w0; o.y = w1; *(v2u*)(W8 + (size_t)r * 1024 + 8 * F.lane + 512 * j) = o; }
            if (F.lane == 0) SWC[r] = am * (1.0f / 127.0f);
        }
    }
}

__device__ __forceinline__ void ld8(const bf16* p, float* f) { const v4u w = *(const v4u*)p; f[0] = bflo(w.x); f[1] = bfhi(w.x); f[2] = bflo(w.y); f[3] = bfhi(w.y); f[4] = bflo(w.z); f[5] = bfhi(w.z); f[6] = bflo(w.w); f[7] = bfhi(w.w); }
__device__ __forceinline__ v4u pk8(const float* f) { v4u w; w.x = pk2(f[0], f[1]); w.y = pk2(f[2], f[3]); w.z = pk2(f[4], f[5]); w.w = pk2(f[6], f[7]); return w; }
template <int N> __device__ __forceinline__ float ssq_row(const bf16* p) { float s = 0.f;
#pragma unroll
    for (int c = 0; c < N / 8; ++c) { float f[8]; ld8(p + 8 * c, f);
#pragma unroll
        for (int i = 0; i < 8; ++i) s += f[i] * f[i];
        if ((c & 7) == 7) MEMFENCE(); }
    return s; }
template <int NP> __device__ __forceinline__ void rope_pairs(float* x, const f32x2* trow, const f32x2* tcol) {
#pragma unroll
    for (int i = 0; i < NP; ++i) { const f32x2 cs = (i < NP / 2) ? trow[i] : tcol[i - NP / 2];
        const float x0 = x[2 * i], x1 = x[2 * i + 1]; x[2 * i] = x0 * cs.x - x1 * cs.y; x[2 * i + 1] = x0 * cs.y + x1 * cs.x; }
}
__device__ __forceinline__ void store_v_tile(char* vt, int lane, const float* v  ) {
    char* p = vt + (lane >> 4) * 1024 + ((lane >> 3) & 1) * 512 + (lane & 7) * 64;
#pragma unroll
    for (int d = 0; d < 2; ++d)
#pragma unroll
        for (int c = 0; c < 4; ++c) *(v4u*)(p + d * 4096 + c * 16) = pk8(v + d * 32 + c * 8);
}
template <bool ROPE> __device__ __forceinline__ v4u proc8(v4u w, float r, const float* g, const f32x2* cs, float qs) {
    float f[8] = {bflo(w.x), bfhi(w.x), bflo(w.y), bfhi(w.y), bflo(w.z), bfhi(w.z), bflo(w.w), bfhi(w.w)};
#pragma unroll
    for (int i = 0; i < 8; ++i) f[i] *= r * g[i];
    if (ROPE) {
#pragma unroll
        for (int i = 0; i < 4; ++i) { const f32x2 t = cs[i]; const float x0 = f[2 * i], x1 = f[2 * i + 1]; f[2 * i] = x0 * t.x - x1 * t.y; f[2 * i + 1] = x0 * t.y + x1 * t.x; }
    }
#pragma unroll
    for (int i = 0; i < 8; ++i) f[i] *= qs;
    return pk8(f);
}
__device__ __forceinline__ v2u pk8_f8(const float* f) { int w0 = __builtin_amdgcn_cvt_pk_fp8_f32(f[0], f[1], 0, false); w0 = __builtin_amdgcn_cvt_pk_fp8_f32(f[2], f[3], w0, true);
    int w1 = __builtin_amdgcn_cvt_pk_fp8_f32(f[4], f[5], 0, false); w1 = __builtin_amdgcn_cvt_pk_fp8_f32(f[6], f[7], w1, true); return (v2u){(unsigned)w0, (unsigned)w1}; }
template <bool ROPE> __device__ __forceinline__ v2u proc8f(v4u w, float r, const float* g, const f32x2* cs, float qs) {
    float f[8] = {bflo(w.x), bfhi(w.x), bflo(w.y), bfhi(w.y), bflo(w.z), bfhi(w.z), bflo(w.w), bfhi(w.w)};
#pragma unroll
    for (int i = 0; i < 8; ++i) f[i] *= r * g[i];
    if (ROPE) {
#pragma unroll
        for (int i = 0; i < 4; ++i) { const f32x2 t = cs[i]; const float x0 = f[2 * i], x1 = f[2 * i + 1]; f[2 * i] = x0 * t.x - x1 * t.y; f[2 * i + 1] = x0 * t.y + x1 * t.x; }
    }
#pragma unroll
    for (int i = 0; i < 8; ++i) f[i] *= qs;
    return pk8_f8(f);
}
__device__ __forceinline__ att::i32x6a fp6_group(const v4u& c0, const v4u& c1, const v4u& c2, const v4u& c3) {
    att::u32x16 w; w[0] = c0.x; w[1] = c0.y; w[2] = c0.z; w[3] = c0.w; w[4] = c1.x; w[5] = c1.y; w[6] = c1.z; w[7] = c1.w; w[8] = c2.x; w[9] = c2.y; w[10] = c2.z; w[11] = c2.w; w[12] = c3.x; w[13] = c3.y; w[14] = c3.z; w[15] = c3.w;
    return att::cvt_fp6x32(w); }
__device__ __forceinline__ void store_qgroup(unsigned char* q, const att::i32x6a& g) { *(v2u*)q = (v2u){(unsigned)g[0], (unsigned)g[1]}; *(v2u*)(q + 8) = (v2u){(unsigned)g[2], (unsigned)g[3]}; *(v2u*)(q + 16) = (v2u){(unsigned)g[4], (unsigned)g[5]}; }
__device__ __forceinline__ void store_kgroup(char* kt, int pb, int j, int lane, const att::i32x6a& g) {
    *(v4u*)(kt + j * 1024 + lane * 16) = (v4u){(unsigned)g[0], (unsigned)g[1], (unsigned)g[2], (unsigned)g[3]}; *(v2u*)(kt + pb + j * 512 + lane * 8) = (v2u){(unsigned)g[4], (unsigned)g[5]}; }
__device__ __forceinline__ v4u ldz8(const unsigned char* p) { const v2u r = *(const v2u*)p;
    const f32x2 a = __builtin_amdgcn_cvt_pk_f32_fp8((int)r.x, false), b = __builtin_amdgcn_cvt_pk_f32_fp8((int)r.x, true), c = __builtin_amdgcn_cvt_pk_f32_fp8((int)r.y, false), d = __builtin_amdgcn_cvt_pk_f32_fp8((int)r.y, true);
    v4u w; w.x = pk2(a.x, a.y); w.y = pk2(b.x, b.y); w.z = pk2(c.x, c.y); w.w = pk2(d.x, d.y); return w; }
__device__ __forceinline__ float ssq8(v4u w) { const float f[8] = {bflo(w.x), bfhi(w.x), bflo(w.y), bfhi(w.y), bflo(w.z), bfhi(w.z), bflo(w.w), bfhi(w.w)}; float s = 0.f;
#pragma unroll
    for (int i = 0; i < 8; ++i) s += f[i] * f[i];
    return s; }
__device__ __forceinline__ v4u scale8(v4u w, float r) { float f[8] = {bflo(w.x), bfhi(w.x), bflo(w.y), bfhi(w.y), bflo(w.z), bfhi(w.z), bflo(w.w), bfhi(w.w)};
#pragma unroll
    for (int i = 0; i < 8; ++i) f[i] *= r;
    return pk8(f); }
__device__ __forceinline__ void store_v_tile_pk(char* vt, int lane, const v4u* w) {
    char* p = vt + (lane >> 4) * 1024 + ((lane >> 3) & 1) * 512 + (lane & 7) * 64;
#pragma unroll
    for (int c = 0; c < 8; ++c) *(v4u*)(p + (c >> 2) * 4096 + (c & 3) * 16) = w[c];
}
__device__ __forceinline__ void store_v_tile_f8(char* vt, int lane, const v4u* w, float sc, LAS unsigned char* scr) {
    LAS unsigned char* p = scr + (2 * ((lane >> 2) & 1) + (lane >> 5)) * 1024 + 4 * ((lane >> 3) & 3) + (lane & 3);
#pragma unroll
    for (int c = 0; c < 8; ++c) { const float f[8] = {bflo(w[c].x), bfhi(w[c].x), bflo(w[c].y), bfhi(w[c].y), bflo(w[c].z), bfhi(w[c].z), bflo(w[c].w), bfhi(w[c].w)};
#pragma unroll
        for (int i = 0; i < 8; i += 2) { const int b8 = __builtin_amdgcn_cvt_pk_fp8_f32(f[i] * sc, f[i + 1] * sc, 0, false);
            p[(8 * c + i) * 16] = (unsigned char)b8; p[(8 * c + i + 1) * 16] = (unsigned char)(b8 >> 8); } }
    LDS_WAIT(); asm volatile("" ::: "memory");
#pragma unroll
    for (int i = 0; i < 4; ++i) *(v4u*)(vt + i * 1024 + lane * 16) = *(const LAS v4u*)(scr + i * 1024 + lane * 16);
    LDS_WAIT(); asm volatile("" ::: "memory");
}
__device__ __forceinline__ void phase_c(KA a, Frame& F, int l) {
    relane(F);
    unsigned char* ws = a->ws;
    const unsigned char* Z = (const unsigned char*)(ws + WS_Z); const float* SSQ = (const float*)(ws + WS_SSQ);
    unsigned char* qkv = ws + WS_QKV;
    LAS unsigned char* vscr = (LAS unsigned char*)F.lds + F.wave * 4096;
    const f32x2* TA_R = (const f32x2*)(ws + WS_TAB + TAB_AROW); const f32x2* TA_C = (const f32x2*)(ws + WS_TAB + TAB_ACOL);
    const f32x2* TG_R = (const f32x2*)(ws + WS_TAB + TAB_GROW); const f32x2* TG_C = (const f32x2*)(ws + WS_TAB + TAB_GCOL);
    const int gw = F.vcu * NWAVES + F.wave, NGW = F.G * NWAVES, lane = F.lane;
    for (int id = gw; id < 528 * 32; id += NGW) {
        const int tile = id % 528, job = id / 528;
        const int b = tile / NKT, tt = tile % NKT; const bool isc = tt >= 128;
        const int zrow = isc ? LROWS + b * CL + (tt - 128) * 64 + lane : b * SEQ + tt * 64 + lane;
        const int tok = tt * 64 + lane;
        const unsigned char* zr = Z + (size_t)zrow * ZP;
        const f32x2* tar = TA_R + (isc ? 0 : tt) * 8; const f32x2* tac = TA_C + lane * 8;
        const f32x2* tgr = TG_R + (isc ? 0 : tt) * 16; const f32x2* tgc = TG_C + lane * 16;
        MEMFENCE();
        if (job < 4) {
            const int h = job;
            float r1; { const f32x4 s0 = *(const f32x4*)(SSQ + (size_t)zrow * 12), s1 = *(const f32x4*)(SSQ + (size_t)zrow * 12 + 4); r1 = rsqrtf((((s0.x + s0.y) + (s0.z + s0.w)) + ((s1.x + s1.y) + (s1.z + s1.w))) * (1.0f / 256.0f) + EPSF); }
            v4u w[12]; float ss = 0.f;
#pragma unroll
            for (int c = 0; c < 12; ++c) { w[c] = ldz8(zr + ZQ + h * 96 + 8 * c); ss += ssq8(w[c]); }
            MEMFENCE();
            const float r = r1 * rsqrtf(ss * r1 * r1 * (1.0f / 96.0f) + EPSF); const float* g = a->in[I_GMQ] + l * 96;
            const float qs = att::FQ96;
            unsigned char* q = (unsigned char*)(qkv + QO_QM) + ((size_t)(b * 4 + h) * NTOKB + tok) * 72;
#pragma unroll
            for (int gq = 0; gq < 3; ++gq) { v4u o[4];
#pragma unroll
                for (int cc = 0; cc < 4; ++cc) { const int c = 4 * gq + cc;
                    if (c < 8 || isc) o[cc] = proc8<false>(w[c], r, g + 8 * c, nullptr, qs);
                    else o[cc] = proc8<true>(w[c], r, g + 8 * c, (c < 10) ? tar + 4 * (c - 8) : tac + 4 * (c - 10), qs); }
                store_qgroup(q + 24 * gq, fp6_group(o[0], o[1], o[2], o[3])); MEMFENCE(); }
        } else if (job < 8) {
            const int h = job - 4;
            float r1; { const f32x4 s2 = *(const f32x4*)(SSQ + (size_t)zrow * 12 + 8); r1 = rsqrtf(((s2.x + s2.y) + (s2.z + s2.w)) * (1.0f / 128.0f) + EPSF); }
            v4u w[12]; float ss = 0.f, s2 = 0.f;
#pragma unroll
            for (int c = 0; c < 8; ++c) { w[c] = ldz8(zr + ZKV + h * 128 + 8 * c); ss += ssq8(w[c]); }
#pragma unroll
            for (int c = 0; c < 4; ++c) { w[8 + c] = ldz8(zr + 384 + 8 * c); s2 += ssq8(w[8 + c]); }
            MEMFENCE();
            const float r2 = rsqrtf((ss * r1 * r1 + s2) * (1.0f / 96.0f) + EPSF); const float* g = a->in[I_GMK] + l * 96;
            char* kt = (char*)(qkv + QO_KM) + ((size_t)(b * 4 + h) * NKT + tt) * 5120;
#pragma unroll
            for (int gq = 0; gq < 3; ++gq) { v4u o[4];
#pragma unroll
                for (int cc = 0; cc < 4; ++cc) { const int c = 4 * gq + cc;
                    if (c < 8) o[cc] = proc8<false>(w[c], r1 * r2, g + 8 * c, nullptr, 1.0f);
                    else if (isc) o[cc] = proc8<false>(w[c], r2, g + 8 * c, nullptr, 1.0f);
                    else o[cc] = proc8<true>(w[c], r2, g + 8 * c, (c < 10) ? tar + 4 * (c - 8) : tac + 4 * (c - 10), 1.0f); }
                store_kgroup(kt, 3072, gq, lane, fp6_group(o[0], o[1], o[2], o[3])); MEMFENCE(); }
            v4u vw[8];
#pragma unroll
            for (int c = 0; c < 8; ++c) vw[c] = ldz8(zr + ZKV + h * 128 + 64 + 8 * c);
            store_v_tile_f8((char*)(qkv + QO_VM) + ((size_t)(b * 4 + h) * NKT + tt) * 4096, lane, vw, r1, vscr);
        } else if (job < 16) {
            const bool isk = job >= 12; const int h = (job - 8) & 3;
            const unsigned char* zp = zr + (isk ? 672 : 416) + h * 64; const float* g = (isk ? a->in[I_GDK] : a->in[I_GDQ]) + l * 32;
            const float qs = isk ? 1.0f : att::FQ32;
            v4u w[8]; float ss[2] = {0.f, 0.f};
#pragma unroll
            for (int c = 0; c < 8; ++c) { w[c] = ldz8(zp + 8 * c); ss[c >> 2] += ssq8(w[c]); }
            MEMFENCE();
            const float r0 = rsqrtf(ss[0] * (1.0f / 32.0f) + EPSF), r1 = rsqrtf(ss[1] * (1.0f / 32.0f) + EPSF);
            char* kt = (char*)(qkv + QO_KD) + ((size_t)(b * 4 + h) * NKT + tt) * 3072;
            unsigned char* q = (unsigned char*)(qkv + QO_QD) + ((size_t)(b * 4 + h) * NTOKB + tok) * 48;
#pragma unroll
            for (int gq = 0; gq < 2; ++gq) { v4u o[4];
#pragma unroll
                for (int cm = 0; cm < 4; ++cm) { const int c = 4 * gq + cm;
                    if (isc) o[cm] = proc8<false>(w[c], gq ? r1 : r0, g + 8 * cm, nullptr, qs);
                    else o[cm] = proc8<true>(w[c], gq ? r1 : r0, g + 8 * cm, (cm < 2) ? tar + 4 * cm : tac + 4 * (cm - 2), qs); }
                const att::i32x6a gr = fp6_group(o[0], o[1], o[2], o[3]);
                if (isk) store_kgroup(kt, 2048, gq, lane, gr); else store_qgroup(q + 24 * gq, gr);
                MEMFENCE(); }
        } else if (job < 20) {
            const int h = job - 16; v4u vw[8];
#pragma unroll
            for (int c = 0; c < 8; ++c) vw[c] = ldz8(zr + 928 + h * 64 + 8 * c);
            store_v_tile_f8((char*)(qkv + QO_VD) + ((size_t)(b * 4 + h) * NKT + tt) * 4096, lane, vw, 1.0f, vscr);
        } else if (job < 30) {
            const bool isk = job >= 28; const int h = isk ? job - 28 : job - 20;
            const unsigned char* zp = zr + (isk ? 1696 : 1184) + h * 64; const float* g = (isk ? a->in[I_GGK] : a->in[I_GGQ]) + l * 64;
            const float qs = isk ? 1.0f : att::FQ64;
            v4u w[8]; float ss = 0.f;
#pragma unroll
            for (int c = 0; c < 8; ++c) { w[c] = ldz8(zp + 8 * c); ss += ssq8(w[c]); }
            MEMFENCE();
            const float r = rsqrtf(ss * (1.0f / 64.0f) + EPSF);
            char* kt = (char*)(qkv + QO_KG) + ((size_t)(b * 2 + h) * NKT + tt) * 3072;
            unsigned char* q = (unsigned char*)(qkv + QO_QG) + ((size_t)(b * 8 + h) * NTOKB + tok) * 48;
#pragma unroll
            for (int gq = 0; gq < 2; ++gq) { v4u o[4];
#pragma unroll
                for (int cc = 0; cc < 4; ++cc) { const int c = 4 * gq + cc;
                    if (isc) o[cc] = proc8<false>(w[c], r, g + 8 * c, nullptr, qs);
                    else o[cc] = proc8<true>(w[c], r, g + 8 * c, (c < 4) ? tgr + 4 * c : tgc + 4 * (c - 4), qs); }
                const att::i32x6a gr = fp6_group(o[0], o[1], o[2], o[3]);
                if (isk) store_kgroup(kt, 2048, gq, lane, gr); else store_qgroup(q + 24 * gq, gr);
                MEMFENCE(); }
        } else {
            const int h = job - 30; v4u vw[8];
#pragma unroll
            for (int c = 0; c < 8; ++c) vw[c] = ldz8(zr + 1824 + h * 64 + 8 * c);
            store_v_tile_f8((char*)(qkv + QO_VG) + ((size_t)(b * 2 + h) * NKT + tt) * 4096, lane, vw, 1.0f, vscr);
        }
        MEMFENCE();
    }
}

#define ATT_UNIT(KD, NM) att::attn_unit_f8<KD, NM, ABL>
#define ATT_DIFF att::attn_unit_f8<32, 2, ABL>
template <int ABL>
__device__ __forceinline__ void phase_d(KA a, Frame& F, int l, bool last) {
    relane(F);
    unsigned char* ws = a->ws; unsigned char* qkv = ws + WS_QKV;
    bf16* ATT = (bf16*)(ws + (ABL ? WS_Z : WS_ATT));
    const float* LAM = (const float*)(ws + WS_LAM);
    const float lam = LAM[2 * l], oml = 1.0f - LAM[2 * l + 1];
    const float* gdo = a->in[I_GDO] + l * 64;
    ALDS char* lds = (ALDS char*)F.lds;
    const int nctx = last ? 0 : 64;
    for (int id = F.vcu; id < 512 + nctx; id += F.G) {
        int b, h, q0, t0, t1; size_t orow;
        if (id < 512) { const int x = (id & 255) >> 5; b = x >> 1; h = 2 * (x & 1) + (id >> 8); q0 = (id & 31) * 256; t0 = 0; t1 = NKT; orow = (size_t)b * SEQ + q0; }
        else { const int c = id - 512; b = c >> 4; h = c & 15; if (h >= 4) continue; q0 = SEQ; t0 = 128; t1 = NKT; orow = (size_t)LROWS + b * CL; }
        ATT_UNIT(96, 1)((const unsigned char*)(qkv + QO_QM) + ((size_t)(b * 4 + h) * NTOKB + q0) * 72, (const char*)(qkv + QO_KM) + (size_t)(b * 4 + h) * NKT * 5120,
                        (const char*)(qkv + QO_VM) + (size_t)(b * 4 + h) * NKT * 4096, t0, t1, ATT + orow * 1024 + h * 64, lds, 0.f, gdo, 0.f);
    }
    for (int id = 512 + F.vcu; id < 1024 + nctx; id += F.G) {
        int b, h, q0, t0, t1; size_t orow;
        if (id < 1024) { const int x = (id & 255) >> 5; b = x >> 1; h = 2 * (x & 1) + ((id >> 8) - 2); q0 = (id & 31) * 256; t0 = 0; t1 = NKT; orow = (size_t)b * SEQ + q0; }
        else { const int c = id - 1024; b = c >> 4; h = (c & 15) - 4; if (h < 0 || h >= 4) continue; q0 = SEQ; t0 = 128; t1 = NKT; orow = (size_t)LROWS + b * CL; }
        ATT_DIFF((const unsigned char*)(qkv + QO_QD) + ((size_t)(b * 4 + h) * NTOKB + q0) * 48, (const char*)(qkv + QO_KD) + (size_t)(b * 4 + h) * NKT * 3072,
                        (const char*)(qkv + QO_VD) + (size_t)(b * 4 + h) * NKT * 4096, t0, t1, ATT + orow * 1024 + 256 + h * 64, lds, lam, gdo, oml);
    }
    for (int id = 1024 + F.vcu; id < 2048 + nctx; id += F.G) {
        int b, h, q0, t0, t1; size_t orow;
        if (id < 2048) { const int x = (id & 255) >> 5; b = x >> 1; h = 4 * (x & 1) + ((id >> 8) - 4); q0 = (id & 31) * 256; t0 = 0; t1 = NKT; orow = (size_t)b * SEQ + q0; }
        else { const int c = id - 2048; b = c >> 4; h = (c & 15) - 8; if (h < 0) continue; q0 = SEQ; t0 = 128; t1 = NKT; orow = (size_t)LROWS + b * CL; }
        const int g = h >> 2;
        ATT_UNIT(64, 1)((const unsigned char*)(qkv + QO_QG) + ((size_t)(b * 8 + h) * NTOKB + q0) * 48, (const char*)(qkv + QO_KG) + (size_t)(b * 2 + g) * NKT * 3072,
                        (const char*)(qkv + QO_VG) + (size_t)(b * 2 + g) * NKT * 4096, t0, t1, ATT + orow * 1024 + 512 + h * 64, lds, 0.f, gdo, 0.f);
    }
}

template <int RB>
__device__ __forceinline__ void pf_rows(KA a, Frame& F, int l, int rbeg, int nrows, LAS float* wrT) {
    unsigned char* ws = a->ws;
    const float* MOD = (const float*)(ws + WS_MOD);
    float* AFF = (float*)(ws + WS_AFF); float* AFFC = (float*)(ws + WS_AFFC); int* INV = (int*)(ws + WS_INV);
    const int gw = F.vcu * NWAVES + F.wave, NGW = F.G * NWAVES;
#define PF_LOAD(r, XW, DW) do { const bf16* xb_ = (const bf16*)(ws + WS_XB) + (size_t)(r) * 1024; const bf16* dl_ = (const bf16*)(ws + WS_DELTA) + (size_t)(r) * 1024; \
        _Pragma("unroll") for (int j = 0; j < 4; ++j) { XW[j] = *(const v2u*)(xb_ + 4 * F.lane + 256 * j); DW[j] = *(const v2u*)(dl_ + 4 * F.lane + 256 * j); } } while (0)
    v2u cxw[RB][4], cdw[RB][4];
#pragma unroll
    for (int u = 0; u < RB; ++u)
#pragma unroll
        for (int j = 0; j < 4; ++j) { cxw[u][j] = (v2u){0u, 0u}; cdw[u][j] = (v2u){0u, 0u}; }
    if (rbeg + gw * RB < nrows) {
#pragma unroll
        for (int u = 0; u < RB; ++u) PF_LOAD(rbeg + gw * RB + u, cxw[u], cdw[u]); }
    for (int grp = gw; rbeg + grp * RB < nrows; grp += NGW) {
        const int row0 = rbeg + grp * RB; const bool isc = row0 >= LROWS; const int v = isc ? 4 : (row0 >> 13);
        f32x4 hv[RB][4]; float ss[RB];
#pragma unroll
        for (int u = 0; u < RB; ++u) { bf16* xb = (bf16*)(ws + WS_XB) + (size_t)(row0 + u) * 1024; ss[u] = 0.f;
#pragma unroll
            for (int j = 0; j < 4; ++j) { const int c0 = 4 * F.lane + 256 * j; const v2u w = cdw[u][j], xw = cxw[u][j];
                hv[u][j] = (f32x4){bflo(xw.x), bfhi(xw.x), bflo(xw.y), bfhi(xw.y)} + (f32x4){bflo(w.x), bfhi(w.x), bflo(w.y), bfhi(w.y)};
                v2u o; o.x = pk2(hv[u][j].x, hv[u][j].y); o.y = pk2(hv[u][j].z, hv[u][j].w); *(v2u*)(xb + c0) = o;
                ss[u] += (hv[u][j].x * hv[u][j].x + hv[u][j].y * hv[u][j].y) + (hv[u][j].z * hv[u][j].z + hv[u][j].w * hv[u][j].w); } }
        { const int ngrp = grp + NGW;
          if (rbeg + ngrp * RB < nrows) {
#pragma unroll
              for (int u = 0; u < RB; ++u) PF_LOAD(rbeg + ngrp * RB + u, cxw[u], cdw[u]); } }
        float rstd[RB];
#pragma unroll
        for (int u = 0; u < RB; ++u) rstd[u] = rsqrtf(wave_sum(ss[u]) * (1.0f / 1024.0f) + EPSF);
        const float* g2 = a->in[I_GN2] + l * 1024; const float* sh = MOD + (l * 5 + v) * 6144 + 3 * 1024; const float* sc = sh + 1024;
        float am[RB];
#pragma unroll
        for (int u = 0; u < RB; ++u) am[u] = 0.f;
#pragma unroll
        for (int j = 0; j < 4; ++j) { const int c0 = 4 * F.lane + 256 * j; const f32x4 g = *(const f32x4*)(g2 + c0), s1 = *(const f32x4*)(sc + c0), b1 = *(const f32x4*)(sh + c0);
#pragma unroll
            for (int u = 0; u < RB; ++u) { hv[u][j] = hv[u][j] * rstd[u] * g * (1.0f + s1) + b1;
                am[u] = fmaxf(fmaxf(am[u], fmaxf(fabsf(hv[u][j].x), fabsf(hv[u][j].y))), fmaxf(fabsf(hv[u][j].z), fabsf(hv[u][j].w))); } }
#pragma unroll
        for (int o = 1; o < 64; o <<= 1) {
#pragma unroll
            for (int u = 0; u < RB; ++u) am[u] = fmaxf(am[u], __shfl_xor(am[u], o)); }
#pragma unroll
        for (int u = 0; u < RB; ++u) { const float qs = am[u] > 0.f ? 127.0f / am[u] : 0.f;
            signed char* h8 = (signed char*)(ws + WS_H) + (size_t)(row0 + u) * 1024;
#pragma unroll
            for (int j = 0; j < 4; ++j) { const int q0 = (int)__builtin_rintf(hv[u][j].x * qs), q1 = (int)__builtin_rintf(hv[u][j].y * qs), q2 = (int)__builtin_rintf(hv[u][j].z * qs), q3 = (int)__builtin_rintf(hv[u][j].w * qs);
                *(unsigned*)(h8 + 4 * F.lane + 256 * j) = (unsigned)(q0 & 255) | ((unsigned)(q1 & 255) << 8) | ((unsigned)(q2 & 255) << 16) | ((unsigned)(q3 & 255) << 24); }
            if (F.lane == 0) ((float*)(ws + WS_SA))[row0 + u] = am[u] * (1.0f / 127.0f); }
        float p[RB][16];
#pragma unroll
        for (int e = 0; e < 16; ++e) { float sacc[RB];
#pragma unroll
            for (int u = 0; u < RB; ++u) sacc[u] = 0.f;
#pragma unroll
            for (int j = 0; j < 4; ++j) { const f32x4 w = *(const LAS f32x4*)(wrT + e * 1024 + 4 * F.lane + 256 * j);
#pragma unroll
                for (int u = 0; u < RB; ++u) sacc[u] += (hv[u][j].x * w.x + hv[u][j].y * w.y) + (hv[u][j].z * w.z + hv[u][j].w * w.w); }
#pragma unroll
            for (int u = 0; u < RB; ++u) p[u][e] = sacc[u];
            if ((e & 3) == 3) MEMFENCE(); }
        float lgt[RB];
#pragma unroll
        for (int u = 0; u < RB; ++u) { float r8[8], r4[4], r2[2];
          { const bool hb = (F.lane & 32) != 0;
#pragma unroll
            for (int j = 0; j < 8; ++j) { const float keep = hb ? p[u][8 + j] : p[u][j], send = hb ? p[u][j] : p[u][8 + j]; r8[j] = keep + __shfl_xor(send, 32); } }
          { const bool hb = (F.lane & 16) != 0;
#pragma unroll
            for (int j = 0; j < 4; ++j) { const float keep = hb ? r8[4 + j] : r8[j], send = hb ? r8[j] : r8[4 + j]; r4[j] = keep + __shfl_xor(send, 16); } }
          { const bool hb = (F.lane & 8) != 0;
#pragma unroll
            for (int j = 0; j < 2; ++j) { const float keep = hb ? r4[2 + j] : r4[j], send = hb ? r4[j] : r4[2 + j]; r2[j] = keep + __shfl_xor(send, 8); } }
          { const bool hb = (F.lane & 4) != 0; const float keep = hb ? r2[1] : r2[0], send = hb ? r2[0] : r2[1]; lgt[u] = keep + __shfl_xor(send, 4); }
          lgt[u] += __shfl_xor(lgt[u], 1); lgt[u] += __shfl_xor(lgt[u], 2); }
        float mx[RB], ex[RB], sum[RB];
#pragma unroll
        for (int u = 0; u < RB; ++u) mx[u] = lgt[u];
#pragma unroll
        for (int o = 4; o < 64; o <<= 1) {
#pragma unroll
            for (int u = 0; u < RB; ++u) mx[u] = fmaxf(mx[u], __shfl_xor(mx[u], o)); }
#pragma unroll
        for (int u = 0; u < RB; ++u) { ex[u] = __builtin_amdgcn_exp2f((lgt[u] - mx[u]) * LOG2E); sum[u] = ex[u]; }
#pragma unroll
        for (int o = 4; o < 64; o <<= 1) {
#pragma unroll
            for (int u = 0; u < RB; ++u) sum[u] += __shfl_xor(sum[u], o); }
        const int ee = ((F.lane >> 5) & 1) * 8 + ((F.lane >> 4) & 1) * 4 + ((F.lane >> 3) & 1) * 2 + ((F.lane >> 2) & 1);
#pragma unroll
        for (int u = 0; u < RB; ++u) { const float mine = ex[u] / sum[u]; const int row = row0 + u;
            if ((F.lane & 3) == 0) {
                if (isc) { const int r = row - LROWS; AFFC[((size_t)((r >> 8) * 16 + ee)) * CL + (r & 255)] = mine; }
                else AFF[((size_t)((row >> 13) * 16 + ee)) * SEQ + (row & 8191)] = mine;
                INV[(size_t)row * 16 + ee] = -1;
            } }
    }
#undef PF_LOAD
}


__device__ __forceinline__ void phase_f(KA a, Frame& F, int l, bool last) {
    relane(F);
    unsigned char* ws = a->ws;
    const float* MOD = (const float*)(ws + WS_MOD);
    float* AFF = (float*)(ws + WS_AFF); float* AFFC = (float*)(ws + WS_AFFC); int* INV = (int*)(ws + WS_INV);
    LAS float* wrT = (LAS float*)F.lds;
    const float* wr = a->in[I_WR] + (size_t)l * 1024 * 16;
    for (int idx = F.tid; idx < 16384; idx += NWAVES * 64) wrT[(idx & 15) * 1024 + (idx >> 4)] = wr[idx];
    __syncthreads();
    pf_rows<4>(a, F, l, 0, LROWS, wrT);
    if (!last) pf_rows<1>(a, F, l, LROWS, MROWS, wrT);
}

__device__ __forceinline__ void topk_set(Frame& F, const float* __restrict__ src, int n, int k, int rowbase, int slotbase, int e, int* IDX, float* GATE, int* INV, const float* SA, float* SAE) {
    LAS unsigned* keys = (LAS unsigned*)F.lds; LAS unsigned* hist = keys + 8192; LAS unsigned* sc = hist + 256;
    const int tid = F.tid;
    for (int i = tid; i < n; i += NWAVES * 64) keys[i] = __float_as_uint(src[i]);
    if (tid == 0) { unsigned z_ = 0u, k_ = (unsigned)k; asm volatile("" : "+v"(z_), "+v"(k_)); sc[0] = z_; sc[1] = k_; }
    __syncthreads();
    for (int pass = 0; pass < 4; ++pass) {
        const int shift = 24 - 8 * pass; const unsigned mask = (pass == 0) ? 0u : (0xFFFFFFFFu << (shift + 8));
        if (tid < 256) hist[tid] = 0u;
        __syncthreads();
        const unsigned prefix = sc[0];
        for (int i = tid; i < n; i += NWAVES * 64) { const unsigned kv = keys[i]; if ((kv & mask) == prefix) __hip_atomic_fetch_add(&hist[(kv >> shift) & 255u], 1u, __ATOMIC_RELAXED, __HIP_MEMORY_SCOPE_WORKGROUP); }
        __syncthreads();
        if (F.wave == 0) {
            const unsigned need = sc[1]; unsigned h[4]; unsigned tot = 0u;
#pragma unroll
            for (int j = 0; j < 4; ++j) { h[j] = hist[255 - (4 * F.lane + j)]; tot += h[j]; }
            unsigned incl = tot;
#pragma unroll
            for (int d = 1; d < 64; d <<= 1) { const unsigned t = __shfl_up(incl, d); if (F.lane >= d) incl += t; }
            unsigned cum = incl - tot;
#pragma unroll
            for (int j = 0; j < 4; ++j) { if (cum < need && need <= cum + h[j]) { sc[0] = prefix | ((unsigned)(255 - (4 * F.lane + j)) << shift); sc[1] = need - cum; } cum += h[j]; }
        }
        __syncthreads();
    }
    const unsigned T = sc[0], need_eq = sc[1];
    const int per = (n + NWAVES * 64 - 1) / (NWAVES * 64), start = tid * per;
    unsigned cg = 0u, ce = 0u;
    for (int j = 0; j < per; ++j) { const int i = start + j; if (i < n) { const unsigned kv = keys[i]; cg += (kv > T) ? 1u : 0u; ce += (kv == T) ? 1u : 0u; } }
    const unsigned packed = cg | (ce << 16);
    unsigned incl = packed;
#pragma unroll
    for (int d = 1; d < 64; d <<= 1) { const unsigned t = __shfl_up(incl, d); if (F.lane >= d) incl += t; }
    if (F.lane == 63) sc[8 + F.wave] = incl;
    __syncthreads();
    unsigned base = 0u;
    for (int w = 0; w < F.wave; ++w) base += sc[8 + w];
    const unsigned excl = base + incl - packed;
    unsigned gb = excl & 0xFFFFu, eb = excl >> 16;
    for (int j = 0; j < per; ++j) { const int i = start + j; if (i < n) { const unsigned kv = keys[i]; const bool g = kv > T, q = kv == T;
        if (g || (q && eb < need_eq)) { const int slot = slotbase + (int)(gb + (eb < need_eq ? eb : need_eq)); IDX[slot] = rowbase + i; GATE[slot] = __uint_as_float(kv); SAE[slot] = SA[rowbase + i]; INV[(size_t)(rowbase + i) * 16 + e] = slot; }
        gb += g ? 1u : 0u; eb += q ? 1u : 0u; } }
    __syncthreads();
}
struct CvtItem { const float* wp; int N; unsigned char* wt; int ldt; float qs; int f8; };
__device__ __forceinline__ void cvt_load(const CvtItem& I, float (&tv)[32]) {
#pragma unroll
    for (int i = 0; i < 32; ++i) tv[i] = __builtin_nontemporal_load(I.wp + (size_t)(2 * i) * I.N);
}
__device__ __forceinline__ void cvt_store(const CvtItem& I, const float (&tv)[32], LAS float* scr, int lane) {
#pragma unroll
    for (int i = 0; i < 32; ++i) scr[(2 * i + (lane >> 5)) * 33 + (lane & 31)] = tv[i];
    LDS_WAIT(); asm volatile("" ::: "memory");
    const int c = lane & 3;
#pragma unroll
    for (int j = 0; j < 2; ++j) { const int n = (lane >> 2) + 16 * j; const LAS float* sp = scr + (16 * c) * 33 + n; v4u o;
        if (I.f8) {
#pragma unroll
            for (int d = 0; d < 4; ++d) { float f[4];
#pragma unroll
                for (int i = 0; i < 4; ++i) f[i] = fminf(fmaxf(sp[(4 * d + i) * 33] * I.qs, -448.0f), 448.0f);
                int w = __builtin_amdgcn_cvt_pk_fp8_f32(f[0], f[1], 0, false); w = __builtin_amdgcn_cvt_pk_fp8_f32(f[2], f[3], w, true); o[d] = (unsigned)w; }
        } else {
#pragma unroll
            for (int d = 0; d < 4; ++d) { unsigned w = 0u;
#pragma unroll
                for (int i = 0; i < 4; ++i) { const float f = fminf(fmaxf(sp[(4 * d + i) * 33] * I.qs, -127.0f), 127.0f); w |= ((unsigned)((int)__builtin_rintf(f)) & 255u) << (8 * i); }
                o[d] = w; }
        }
        *(v4u*)(I.wt + (size_t)n * I.ldt + 16 * c) = o; }
    LDS_WAIT(); asm volatile("" ::: "memory");
}
__device__ __forceinline__ void phase_g(KA a, Frame& F, int l, bool last, int rep) {
    relane(F);
    unsigned char* ws = a->ws;
    const float* AFF = (const float*)(ws + WS_AFF); const float* AFFC = (const float*)(ws + WS_AFFC);
    int* IDX = (int*)(ws + WS_IDX); float* GATE = (float*)(ws + WS_GATE); int* INV = (int*)(ws + WS_INV);
    const float* SA = (const float*)(ws + WS_SA); float* SAE = (float*)(ws + WS_SAE);
    const int RPE = last ? 4096 : 4352, nsets = last ? 64 : 128;
    for (int set = blockIdx.x; set < nsets; set += F.G) {
        if (set < 64) { const int b = set >> 4, e = set & 15; topk_set(F, AFF + (size_t)set * SEQ, SEQ, CAPL, b * SEQ, e * RPE + b * CAPL, e, IDX, GATE, INV, SA, SAE); }
        else { const int s2 = set - 64, b = s2 >> 4, e = s2 & 15; topk_set(F, AFFC + (size_t)s2 * CL, CL, CAPC, LROWS + b * CL, e * RPE + 4096 + b * CAPC, e, IDX, GATE, INV, SA, SAE);
            if (b == 0 && F.tid < 128) { IDX[e * RPE + 4224 + F.tid] = -1; GATE[e * RPE + 4224 + F.tid] = 0.f; SAE[e * RPE + 4224 + F.tid] = 0.f; } }
    }
    {
        LAS float* scr = (LAS float*)(F.lds + 40960 + F.wave * 8704);
        gu32* head = F.ctl + CW_Q + 64 * l + 128 * rep;
        constexpr int NIT = NE * 3072;
        const float* wg = a->in[I_WG] + (size_t)l * NE * 1024 * 2048; const float* wu = a->in[I_WU] + (size_t)l * NE * 1024 * 2048; const float* wd = a->in[I_WD] + (size_t)l * NE * 2048 * 1024;
        const float* SWL = (const float*)(ws + WS_SW) + l * 48;
        for (;;) {
            unsigned basev = 0u;
            if (F.lane == 0) basev = __hip_atomic_fetch_add(head, 8u, RLX_AGENT);
            const int base = __builtin_amdgcn_readfirstlane((int)basev);
            if (base >= NIT) break;
#define CVT_SETUP(I, j) do { const int it_ = base + (j); const int e_ = it_ / 3072, r_ = it_ % 3072, which_ = r_ >> 10, ii_ = r_ & 1023; \
                if (which_ < 2) { const int kb_ = ii_ >> 6, n0_ = (ii_ & 63) * 32; const int rowbase_ = (n0_ >> 7) * 256 + (n0_ & 127) + which_ * 128; \
                    I.wp = (which_ ? wu : wg) + (size_t)e_ * 1024 * 2048 + (size_t)(kb_ * 64 + (F.lane >> 5)) * 2048 + n0_ + (F.lane & 31); I.N = 2048; \
                    I.wt = (unsigned char*)(ws + WS_WGU) + (size_t)e_ * 4096 * 1024 + (size_t)rowbase_ * 1024 + kb_ * 64; I.ldt = 1024; I.qs = 1.0f / SWL[3 * e_ + which_]; I.f8 = 0; } \
                else { const int kb_ = ii_ >> 5, n0_ = (ii_ & 31) * 32; \
                    I.wp = wd + (size_t)e_ * 2048 * 1024 + (size_t)(kb_ * 64 + (F.lane >> 5)) * 1024 + n0_ + (F.lane & 31); I.N = 1024; \
                    I.wt = (unsigned char*)(ws + WS_WD) + (size_t)e_ * 1024 * 2048 + (size_t)n0_ * 2048 + kb_ * 64; I.ldt = 2048; I.qs = 1.0f / SWL[3 * e_ + 2]; I.f8 = 1; } } while (0)
            CvtItem IA, IB; float tvA[32], tvB[32];
            CVT_SETUP(IA, 0); cvt_load(IA, tvA);
#pragma unroll
            for (int jj = 0; jj < 4; ++jj) {
                CVT_SETUP(IB, 2 * jj + 1); cvt_load(IB, tvB);
                cvt_store(IA, tvA, scr, F.lane);
                if (jj < 3) { CVT_SETUP(IA, 2 * jj + 2); cvt_load(IA, tvA); }
                cvt_store(IB, tvB, scr, F.lane);
            }
#undef CVT_SETUP
        }
    }
}

__global__ void __launch_bounds__(NWAVES * 64, 2) mk_fwd(Args args) {
    extern __shared__ __attribute__((aligned(16))) unsigned char lds[];
    Frame F;
    F.lds = (LAS unsigned char*)lds;
    F.MISC = (volatile LAS unsigned*)(F.lds + MISC_OFF);
    F.tid = threadIdx.x; F.lane = F.tid & 63; F.wave = __builtin_amdgcn_readfirstlane(F.tid >> 6);
    F.G = gridDim.x; { const int bx = blockIdx.x; F.vcu = (F.G % 8 == 0) ? (bx % 8) * (F.G / 8) + bx / 8 : bx; }
    F.ctl = (gu32*)(args.ws + WS_CTL);
    for (int u = F.tid; u < (LDS_BYTES - LDSCTL_OFF) / 4; u += NWAVES * 64) ((LAS unsigned*)(F.lds + LDSCTL_OFF))[u] = 0u;
    __syncthreads();
    const int lo = args.ph_lo, hi = args.ph_hi;
    const bool multi = (hi - lo) > 1;
    XcdBarrier bar; bar.bar = (unsigned*)(F.ctl + CW_BAR); bar.x = 0; bar.st = nullptr;
    if (multi) bar = xcd_barrier_post((unsigned*)(F.ctl + CW_BAR), F.MISC + 8);
#define IN(k) (lo <= (k) && (k) < hi)
#define SEAM(k) do { if (IN((k) + 1)) xcd_barrier(bar); } while (0)
#define REP(kind) (((MK_REP) >> (kind)) & 1)
#define RUNPH(kind, k, ...) do { if (IN(k)) { for (int rep_ = 0; rep_ <= REP(kind); ++rep_) { __VA_ARGS__; if (rep_ < REP(kind)) xcd_barrier(bar); } SEAM(k); } } while (0)

    RUNPH(0, 0, p0_prologue(kargs(), F));

    for (int l = 0; l < NLAYER; ++l) {
        const bool last = (l == NLAYER - 1);
        const int pb = 1 + 10 * l;
        const int RPE = last ? 4096 : 4352;
        if (IN(pb + 0)) { for (int rep_ = 0; rep_ <= (l == 0 ? REP(1) : 0); ++rep_) { phase_a(kargs(), F, l); if (rep_ < REP(1) && l == 0) xcd_barrier(bar); } SEAM(pb + 0); }
        if (IN(pb + 1)) { for (int rep_ = 0; rep_ <= REP(2); ++rep_) {
            KA ka = kargs(); unsigned char* ws = ka->ws;
            pg8::Gemm g{(const pg8::bf16_t*)(ws + WS_H), (const pg8::bf16_t*)(ws + WS_WCAT8 + (size_t)l * ZP * 1024), MROWS, ZP, DM / 2, 1 << 30, 0};
            pg8::StaticOrder S; S.init(MROWS, ZP, F.G, (int)blockIdx.x);
            pg8::EpiStoreBf16I8 E{(unsigned char*)(ws + WS_Z), ZP, (const float*)(ws + WS_SA), (const float*)(ws + WS_SWC) + (size_t)l * ZP, (float*)(ws + WS_SSQ)};
            pg8::gemm_phase<pg8::EpiStoreBf16I8, pg8::StaticOrder, true, true, 1>(F.lds, g, S, E);
            if (rep_ < REP(2)) xcd_barrier(bar); }
            SEAM(pb + 1);
        }
        RUNPH(3, pb + 2, phase_c(kargs(), F, l));
        RUNPH(4, pb + 3, phase_d<0>(kargs(), F, l, last); if (MK_ABL) { xcd_barrier(bar); phase_d<MK_ABL>(kargs(), F, l, last); });
        if (IN(pb + 4)) { for (int rep_ = 0; rep_ <= REP(5); ++rep_) {
            KA ka = kargs(); unsigned char* ws = ka->ws; const float* MODL = (const float*)(ws + WS_MOD) + (size_t)l * 5 * 6144;
            const int M = last ? LROWS : MROWS;
            pg8::Gemm g{(const pg8::bf16_t*)(ws + WS_ATT), (const pg8::bf16_t*)(ws + WS_WO) + (size_t)l * 1024 * 1024, M, DM, DM, 1 << 30, 0};
            pg8::StaticOrder S; S.init(M, DM, F.G, (int)blockIdx.x);
            pg8::EpiColGateBf16 E{(pg8::bf16_t*)(ws + WS_DELTA), DM, MODL, LROWS};
            pg8::gemm_phase<pg8::EpiColGateBf16, pg8::StaticOrder, true, true>(F.lds, g, S, E);
            if (rep_ < REP(5)) xcd_barrier(bar); }
            SEAM(pb + 4);
        }
        RUNPH(6, pb + 5, phase_f(kargs(), F, l, last));
        RUNPH(7, pb + 6, phase_g(kargs(), F, l, last, rep_));
        if (IN(pb + 8)) { for (int rep_ = 0; rep_ <= REP(9); ++rep_) {
            KA ka = kargs(); unsigned char* ws = ka->ws;
            pg8::Gemm g{(const pg8::bf16_t*)(ws + WS_H), (const pg8::bf16_t*)(ws + WS_WGU), NE * RPE, 2 * FFD, DM / 2, RPE / 256, (size_t)2 * FFD * DM, (const int*)(ws + WS_IDX)};
            pg8::StaticOrder S; S.init(NE * RPE, 2 * FFD, F.G, (int)blockIdx.x);
            pg8::EpiSwiGLUI8 E{(unsigned char*)(ws + WS_HID), FFD, (const float*)(ws + WS_SAE), (const float*)(ws + WS_SW) + l * 48, RPE / 256, HID_SCALE};
            if (MK_NOEPI && rep_ == 1) { pg8::EpiNullI8 EN{}; pg8::gemm_phase<pg8::EpiNullI8, pg8::StaticOrder, true, true, 1, true>(F.lds, g, S, EN); }
            else pg8::gemm_phase<pg8::EpiSwiGLUI8, pg8::StaticOrder, true, true, 1, true>(F.lds, g, S, E);
            if (rep_ < REP(9)) xcd_barrier(bar); }
            SEAM(pb + 8);
        }
        if (IN(pb + 9)) { for (int rep_ = 0; rep_ <= REP(10); ++rep_) {
            KA ka = kargs(); unsigned char* ws = ka->ws;
            pg8::Gemm g{(const pg8::bf16_t*)(ws + WS_HID), (const pg8::bf16_t*)(ws + WS_WD), NE * RPE, DM, FFD / 2, RPE / 256, (size_t)DM * FFD};
            pg8::StaticOrder S; S.init(NE * RPE, DM, F.G, (int)blockIdx.x);
            pg8::EpiRowScaleBf16 E{(unsigned char*)(ws + WS_YE), DM, (const float*)(ws + WS_GATE), (const float*)(ws + WS_SW) + l * 48, RPE / 256, YE_SCALE / HID_SCALE};
            pg8::gemm_phase<pg8::EpiRowScaleBf16, pg8::StaticOrder, true, true, 2>(F.lds, g, S, E);
            if (rep_ < REP(10)) xcd_barrier(bar); }
            SEAM(pb + 9);
        }
    }
    if (IN(N_PHASES - 1)) phase_a(kargs(), F, NLAYER);
#undef IN
#undef SEAM
}

extern "C" void kernel_launch(void* const* d_in, const int* in_sizes, int n_in, void* d_out, int out_size, void* d_ws, size_t ws_size, hipStream_t stream) {
    static int grid = 0;
    if (grid == 0) {
        if (n_in != N_IN || out_size != LROWS * DM || ws_size < WS_END) { fprintf(stderr, "kernel_launch: unexpected shapes (n_in %d, out %d, ws %zu); nothing launched\n", n_in, out_size, ws_size); grid = -1; return; }
        int dev = 0, cus = 0, per_cu = 0;
        if (hipGetDevice(&dev) != hipSuccess || hipDeviceGetAttribute(&cus, hipDeviceAttributeMultiprocessorCount, dev) != hipSuccess) { grid = -1; return; }
        if (hipFuncSetAttribute((const void*)mk_fwd, hipFuncAttributeMaxDynamicSharedMemorySize, LDS_BYTES) != hipSuccess) { fprintf(stderr, "kernel_launch: hipFuncSetAttribute failed\n"); grid = -1; return; }
        if (hipOccupancyMaxActiveBlocksPerMultiprocessor(&per_cu, (const void*)mk_fwd, NWAVES * 64, LDS_BYTES) != hipSuccess || per_cu < 1) { fprintf(stderr, "kernel_launch: occupancy query reports %d blocks per CU\n", per_cu); }
        (void)hipGetLastError();
        if (cus < 256) { fprintf(stderr, "kernel_launch: %d compute units; the per-workgroup LDS row tables of the GEMM phases are sized for a grid of at least 256 workgroups; nothing launched\n", cus); grid = -1; return; }
        grid = cus;
    }
    if (grid < 0) return;
    if (hipMemsetAsync((char*)d_ws + WS_CTL, 0, CTL_ZERO_BYTES, stream) != hipSuccess) { fprintf(stderr, "kernel_launch: memset failed\n"); return; }
    Args a{};
    for (int i = 0; i < N_IN; ++i) a.in[i] = (const float*)d_in[i];
    a.out = (float*)d_out; a.ws = (unsigned char*)d_ws;
#if MK_SPLIT
    for (int ph = 0; ph < N_PHASES; ++ph) { a.ph_lo = ph; a.ph_hi = ph + 1; hipLaunchKernelGGL(mk_fwd, dim3(grid), dim3(NWAVES * 64), LDS_BYTES, stream, a); }
#else
    a.ph_lo = 0; a.ph_hi = N_PHASES;
    hipLaunchKernelGGL(mk_fwd, dim3(grid), dim3(NWAVES * 64), LDS_BYTES, stream, a);
#endif
    const hipError_t le = hipPeekAtLastError();
    if (le != hipSuccess) fprintf(stderr, "kernel_launch: launch failed: %s\n", hipGetErrorName(le));
}
```

```cpp
#include <hip/hip_runtime.h>
#include <hip/hip_bf16.h>
#include <cstdio>
#include <cstdint>
#ifndef MK_SPLIT
#define MK_SPLIT 0
#endif
#ifndef MK_REP
#define MK_REP 0
#endif
#ifndef MK_NOEPI
#define MK_NOEPI 0
#endif
#ifndef MK_ABL
#define MK_ABL 0
#endif
namespace pg8 {
#define PG8_LAS __attribute__((address_space(3)))
typedef unsigned short bf16_t;
typedef short bf16x8 __attribute__((ext_vector_type(8)));
typedef float f32x4 __attribute__((ext_vector_type(4)));
typedef unsigned u32x4 __attribute__((ext_vector_type(4)));
constexpr int BM = 256, BK = 64, HALF = 128, HTB = HALF * BK * 2  , STAGE_BYTES = 8 * HTB, NXCD = 8, WGM = 8;

__host__ __device__ __forceinline__ int lds_byte(int r, int c) { const int st = (r >> 4) * 2 + (c >> 5), rr = r & 15, cc = c & 31, ob = rr * 64 + cc * 2; return st * 1024 + (ob ^ (((ob >> 9) & 1) << 5)); }
__host__ __device__ __forceinline__ void stage_rc(int b, int& R, int& C) { const int st = b / 1024, sb = b % 1024, swz = sb ^ (((sb >> 9) & 1) << 5); R = (st >> 1) * 16 + swz / 64; C = (st & 1) * 32 + (swz % 64) / 2; }
__host__ __device__ __forceinline__ int perm32(int rho) { const int n = rho >> 4, i = rho & 15; return 8 * (i >> 2) + 4 * n + (i & 3); }

struct Unit { int pm, pn, li; };
struct Gemm { const bf16_t* A; const bf16_t* Bt; int M, N, K; int tpe; size_t bgs; const int* gidx = nullptr; };

struct StaticOrder {
    int nM, nN, nwg, G, c;
    __host__ __device__ void init(int M, int N, int G_, int c_) { nM = M / BM; nN = N / BM; nwg = nM * nN; G = G_; c = c_; }
    __host__ __device__ bool next(int i, Unit& u) const {
        const long L = (long)i * G + c; if (L >= nwg) return false;
        int wgid = (int)L; { const int q = nwg / NXCD, r = nwg % NXCD, xcd = wgid % NXCD, off = wgid / NXCD; wgid = (xcd < r ? xcd * (q + 1) : r * (q + 1) + (xcd - r) * q) + off; }
        const int nig = WGM * nN, gid = wgid / nig, fm = gid * WGM, gsz = (nM - fm) < WGM ? (nM - fm) : WGM;
        u.pm = fm + ((wgid % nig) % gsz); u.pn = (wgid % nig) / gsz; u.li = i; return true;
    }
    __device__ __forceinline__ void a_ready(const Unit&) const {}
    __device__ __forceinline__ void done(const Unit&) const {}
};
typedef int i32x4 __attribute__((ext_vector_type(4)));
__device__ __forceinline__ unsigned cvt_pk_bf16(float lo, float hi) { unsigned r; asm volatile("v_cvt_pk_bf16_f32 %0, %1, %2" : "=v"(r) : "v"(lo), "v"(hi)); return r; }
constexpr int GTAB_OFF = STAGE_BYTES + 2048, RTAB_OFF = GTAB_OFF + 17 * BM * 2, TAB_UNITS = 17;
template <class Sched> __device__ __forceinline__ void fill_rtab(PG8_LAS unsigned char* lds, const Sched& S, const float* rowv, int tid) {
    PG8_LAS float* rt = (PG8_LAS float*)(lds + RTAB_OFF); Unit uu;
    for (int i = 0; i < TAB_UNITS && S.next(i, uu); ++i) { if (tid < BM) rt[i * BM + tid] = rowv[uu.pm * BM + tid]; } }
struct EpiStoreBf16 {
    static constexpr bool PERM = true, AFTER_DRAIN = false;
    bf16_t* O; int ldc;
    template <class Sched> __device__ __forceinline__ void prefill(PG8_LAS unsigned char*, const Sched&, int) const {}
    __device__ __forceinline__ void operator()(const f32x4 (&acc)[2][2][4][2], const Unit& u, int wr, int wc, int fr, int fq, PG8_LAS unsigned char* lds) const {
        const int row0 = u.pm * BM + wr * 64 + fr, col0 = u.pn * BM + wc * 32 + 8 * fq;
#pragma unroll
        for (int ai = 0; ai < 2; ++ai)
#pragma unroll
            for (int m = 0; m < 4; ++m) { bf16_t* rowp = O + (size_t)(row0 + ai * HALF + m * 16) * ldc + col0;
#pragma unroll
                for (int bj = 0; bj < 2; ++bj) { const f32x4 v0 = acc[ai][bj][m][0], v1 = acc[ai][bj][m][1];
                    u32x4 w; w.x = cvt_pk_bf16(v0[0], v0[1]); w.y = cvt_pk_bf16(v0[2], v0[3]); w.z = cvt_pk_bf16(v1[0], v1[1]); w.w = cvt_pk_bf16(v1[2], v1[3]);
                    *(u32x4*)(rowp + bj * HALF) = w; } }
    }
};
__device__ __forceinline__ float clampz(float x) { return fminf(fmaxf(x, -448.0f), 448.0f); }
struct EpiStoreBf16I8 {
    static constexpr bool PERM = true, AFTER_DRAIN = false;
    unsigned char* O; int ldc; const float* sa; const float* sw; float* ssq; int clo, chi;
    template <class Sched> __device__ __forceinline__ void prefill(PG8_LAS unsigned char* lds, const Sched& S, int tid) const { fill_rtab(lds, S, sa, tid); }
    __device__ __forceinline__ void operator()(const i32x4 (&acc)[2][2][4][2], const Unit& u, int wr, int wc, int fr, int fq, PG8_LAS unsigned char* lds) const {
        const int row0 = u.pm * BM + wr * 64 + fr, col0 = u.pn * BM + wc * 32 + 8 * fq;
        bool cst[2];
#pragma unroll
        for (int bj = 0; bj < 2; ++bj) { const int cb = u.pn * BM + bj * HALF + wc * 32; cst[bj] = cb >= clo && cb < chi; }
        f32x4 cs[2][2];
#pragma unroll
        for (int bj = 0; bj < 2; ++bj)
#pragma unroll
            for (int n = 0; n < 2; ++n) cs[bj][n] = *(const f32x4*)(sw + col0 + bj * HALF + 4 * n);
#pragma unroll
        for (int ai = 0; ai < 2; ++ai)
#pragma unroll
            for (int m = 0; m < 4; ++m) { const int row = row0 + ai * HALF + m * 16; const float rs = ((const PG8_LAS float*)(lds + RTAB_OFF))[u.li * BM + (row - u.pm * BM)]; unsigned char* rowp = O + (size_t)row * ldc + col0;
#pragma unroll
                for (int bj = 0; bj < 2; ++bj) { const i32x4 a0 = acc[ai][bj][m][0], a1 = acc[ai][bj][m][1]; const f32x4 c0 = cs[bj][0] * rs, c1 = cs[bj][1] * rs;
                    const float z0 = (float)a0[0] * c0[0], z1 = (float)a0[1] * c0[1], z2 = (float)a0[2] * c0[2], z3 = (float)a0[3] * c0[3];
                    const float z4 = (float)a1[0] * c1[0], z5 = (float)a1[1] * c1[1], z6 = (float)a1[2] * c1[2], z7 = (float)a1[3] * c1[3];
                    int w0 = __builtin_amdgcn_cvt_pk_fp8_f32(clampz(z0), clampz(z1), 0, false); w0 = __builtin_amdgcn_cvt_pk_fp8_f32(clampz(z2), clampz(z3), w0, true);
                    int w1 = __builtin_amdgcn_cvt_pk_fp8_f32(clampz(z4), clampz(z5), 0, false); w1 = __builtin_amdgcn_cvt_pk_fp8_f32(clampz(z6), clampz(z7), w1, true);
                    typedef unsigned u32x2 __attribute__((ext_vector_type(2)));
                    if (cst[bj]) *(u32x2*)(rowp + bj * HALF) = (u32x2){(unsigned)w0, (unsigned)w1};
                    if (u.pn == 0 || (u.pn == 1 && bj == 0)) {
                        float q = ((z0 * z0 + z1 * z1) + (z2 * z2 + z3 * z3)) + ((z4 * z4 + z5 * z5) + (z6 * z6 + z7 * z7));
                        q += __shfl_xor(q, 16); q += __shfl_xor(q, 32);
                        if (fq == 0) ssq[(size_t)row * 12 + (u.pn == 0 ? bj * 4 + wc : 8 + wc)] = q; } } }
    }
};
struct EpiColGateBf16 {
    static constexpr bool PERM = true, AFTER_DRAIN = false;
    bf16_t* O; int ldc; const float* mod; int lrows;
    template <class Sched> __device__ __forceinline__ void prefill(PG8_LAS unsigned char*, const Sched&, int) const {}
    __device__ __forceinline__ void operator()(const f32x4 (&acc)[2][2][4][2], const Unit& u, int wr, int wc, int fr, int fq, PG8_LAS unsigned char* lds) const {
        const int R0 = u.pm * BM; const int v = (R0 >= lrows) ? 4 : (R0 >> 13);
        const float* ga = mod + v * 6144 + 2 * 1024;
        const int row0 = R0 + wr * 64 + fr, col0 = u.pn * BM + wc * 32 + 8 * fq;
        f32x4 g[2][2];
#pragma unroll
        for (int bj = 0; bj < 2; ++bj)
#pragma unroll
            for (int n = 0; n < 2; ++n) g[bj][n] = *(const f32x4*)(ga + col0 + bj * HALF + 4 * n);
#pragma unroll
        for (int ai = 0; ai < 2; ++ai)
#pragma unroll
            for (int m = 0; m < 4; ++m) { bf16_t* rowp = O + (size_t)(row0 + ai * HALF + m * 16) * ldc + col0;
#pragma unroll
                for (int bj = 0; bj < 2; ++bj) { const f32x4 v0 = acc[ai][bj][m][0] * g[bj][0], v1 = acc[ai][bj][m][1] * g[bj][1];
                    u32x4 w; w.x = cvt_pk_bf16(v0[0], v0[1]); w.y = cvt_pk_bf16(v0[2], v0[3]); w.z = cvt_pk_bf16(v1[0], v1[1]); w.w = cvt_pk_bf16(v1[2], v1[3]);
                    *(u32x4*)(rowp + bj * HALF) = w; } }
    }
};
__device__ __forceinline__ float silu_mul(float g, float u) { return g * __builtin_amdgcn_rcpf(1.0f + __builtin_amdgcn_exp2f(-1.4426950408889634f * g)) * u; }
struct EpiSwiGLU {
    static constexpr bool PERM = true, AFTER_DRAIN = false;
    bf16_t* O; int ldc;
    template <class Sched> __device__ __forceinline__ void prefill(PG8_LAS unsigned char*, const Sched&, int) const {}
    __device__ __forceinline__ void operator()(const f32x4 (&acc)[2][2][4][2], const Unit& u, int wr, int wc, int fr, int fq, PG8_LAS unsigned char* lds) const {
        const int row0 = u.pm * BM + wr * 64 + fr, col0 = u.pn * HALF + wc * 32 + 8 * fq;
#pragma unroll
        for (int ai = 0; ai < 2; ++ai)
#pragma unroll
            for (int m = 0; m < 4; ++m) { const f32x4 g0 = acc[ai][0][m][0], g1 = acc[ai][0][m][1], u0 = acc[ai][1][m][0], u1 = acc[ai][1][m][1];
                u32x4 w; w.x = cvt_pk_bf16(silu_mul(g0[0], u0[0]), silu_mul(g0[1], u0[1])); w.y = cvt_pk_bf16(silu_mul(g0[2], u0[2]), silu_mul(g0[3], u0[3]));
                w.z = cvt_pk_bf16(silu_mul(g1[0], u1[0]), silu_mul(g1[1], u1[1])); w.w = cvt_pk_bf16(silu_mul(g1[2], u1[2]), silu_mul(g1[3], u1[3]));
                *(u32x4*)(O + (size_t)(row0 + ai * HALF + m * 16) * ldc + col0) = w; }
    }
};
__device__ __forceinline__ float clamp448(float x) { return fminf(fmaxf(x, -448.0f), 448.0f); }
struct EpiSwiGLUI8 {
    static constexpr bool PERM = true, AFTER_DRAIN = false;
    unsigned char* O; int ldc; const float* sa; const float* sw; int tpe; float hs;
    template <class Sched> __device__ __forceinline__ void prefill(PG8_LAS unsigned char* lds, const Sched& S, int tid) const { fill_rtab(lds, S, sa, tid); }
    __device__ __forceinline__ void operator()(const i32x4 (&acc)[2][2][4][2], const Unit& u, int wr, int wc, int fr, int fq, PG8_LAS unsigned char* lds) const {
        const int row0 = u.pm * BM + wr * 64 + fr, col0 = u.pn * HALF + wc * 32 + 8 * fq; const int e = u.pm / tpe;
        const float sg = sw[3 * e], su = sw[3 * e + 1] * hs;
#pragma unroll
        for (int ai = 0; ai < 2; ++ai)
#pragma unroll
            for (int m = 0; m < 4; ++m) { const int row = row0 + ai * HALF + m * 16; const float rs = ((const PG8_LAS float*)(lds + RTAB_OFF))[u.li * BM + (row - u.pm * BM)], fg = rs * sg, fu = rs * su;
                const i32x4 g0 = acc[ai][0][m][0], g1 = acc[ai][0][m][1], u0 = acc[ai][1][m][0], u1 = acc[ai][1][m][1];
                typedef float f32x2 __attribute__((ext_vector_type(2)));
                float h[8]; f32x2 gi[4], gu[4], ev[4];
                const float tg = -1.4426950408889634f * fg, fgu = fg * fu;
#pragma unroll
                for (int i = 0; i < 2; ++i) { gi[i] = (f32x2){(float)g0[2 * i], (float)g0[2 * i + 1]}; gi[2 + i] = (f32x2){(float)g1[2 * i], (float)g1[2 * i + 1]};
                    gu[i] = gi[i] * (f32x2){(float)u0[2 * i], (float)u0[2 * i + 1]}; gu[2 + i] = gi[2 + i] * (f32x2){(float)u1[2 * i], (float)u1[2 * i + 1]}; }
                __builtin_amdgcn_sched_barrier(0);
#pragma unroll
                for (int i = 0; i < 4; ++i) { const f32x2 t = gi[i] * tg; ev[i] = (f32x2){__builtin_amdgcn_exp2f(t.x), __builtin_amdgcn_exp2f(t.y)}; }
                __builtin_amdgcn_sched_barrier(0);
#pragma unroll
                for (int i = 0; i < 4; ++i) { const f32x2 d = ev[i] + 1.0f; ev[i] = (f32x2){__builtin_amdgcn_rcpf(d.x), __builtin_amdgcn_rcpf(d.y)}; }
                __builtin_amdgcn_sched_barrier(0);
#pragma unroll
                for (int i = 0; i < 4; ++i) { const f32x2 hv = gu[i] * ev[i] * fgu; h[2 * i] = clamp448(hv.x); h[2 * i + 1] = clamp448(hv.y); }
                int w0 = __builtin_amdgcn_cvt_pk_fp8_f32(h[0], h[1], 0, false); w0 = __builtin_amdgcn_cvt_pk_fp8_f32(h[2], h[3], w0, true);
                int w1 = __builtin_amdgcn_cvt_pk_fp8_f32(h[4], h[5], 0, false); w1 = __builtin_amdgcn_cvt_pk_fp8_f32(h[6], h[7], w1, true);
                typedef unsigned u32x2 __attribute__((ext_vector_type(2)));
                *(u32x2*)(O + (size_t)row * ldc + col0) = (u32x2){(unsigned)w0, (unsigned)w1}; }
    }
};
struct EpiNullI8 {
    static constexpr bool PERM = true, AFTER_DRAIN = false;
    template <class Sched> __device__ __forceinline__ void prefill(PG8_LAS unsigned char*, const Sched&, int) const {}
    __device__ __forceinline__ void operator()(const i32x4 (&acc)[2][2][4][2], const Unit& u, int wr, int wc, int fr, int fq, PG8_LAS unsigned char* lds) const {
#pragma unroll
        for (int ai = 0; ai < 2; ++ai)
#pragma unroll
            for (int bj = 0; bj < 2; ++bj)
#pragma unroll
                for (int m = 0; m < 4; ++m) { asm volatile("" :: "v"(acc[ai][bj][m][0]), "v"(acc[ai][bj][m][1])); }
    }
};
struct EpiRowScaleBf16 {
    static constexpr bool PERM = true, AFTER_DRAIN = false;
    unsigned char* O; int ldc; const float* rs; const float* es; int tpe; float cs;
    template <class Sched> __device__ __forceinline__ void prefill(PG8_LAS unsigned char* lds, const Sched& S, int tid) const { fill_rtab(lds, S, rs, tid); }
    __device__ __forceinline__ void operator()(const f32x4 (&acc)[2][2][4][2], const Unit& u, int wr, int wc, int fr, int fq, PG8_LAS unsigned char* lds) const {
        const int row0 = u.pm * BM + wr * 64 + fr, col0 = u.pn * BM + wc * 32 + 8 * fq;
#pragma unroll
        for (int ai = 0; ai < 2; ++ai)
#pragma unroll
            for (int m = 0; m < 4; ++m) { const int row = row0 + ai * HALF + m * 16; const float s = ((const PG8_LAS float*)(lds + RTAB_OFF))[u.li * BM + (row - u.pm * BM)] * (es[3 * (u.pm / tpe) + 2] * cs); unsigned char* rowp = O + (size_t)row * ldc + col0;
#pragma unroll
                for (int bj = 0; bj < 2; ++bj) { const f32x4 v0 = acc[ai][bj][m][0] * s, v1 = acc[ai][bj][m][1] * s;
                    int w0 = __builtin_amdgcn_cvt_pk_fp8_f32(clamp448(v0[0]), clamp448(v0[1]), 0, false); w0 = __builtin_amdgcn_cvt_pk_fp8_f32(clamp448(v0[2]), clamp448(v0[3]), w0, true);
                    int w1 = __builtin_amdgcn_cvt_pk_fp8_f32(clamp448(v1[0]), clamp448(v1[1]), 0, false); w1 = __builtin_amdgcn_cvt_pk_fp8_f32(clamp448(v1[2]), clamp448(v1[3]), w1, true);
                    typedef unsigned u32x2 __attribute__((ext_vector_type(2)));
                    *(u32x2*)(rowp + bj * HALF) = (u32x2){(unsigned)w0, (unsigned)w1}; } }
    }
};
typedef int i32x4 __attribute__((ext_vector_type(4)));
typedef int i32x8 __attribute__((ext_vector_type(8)));
template <int MODE> struct AccSel { typedef f32x4 type; };
template <> struct AccSel<1> { typedef i32x4 type; };
template <int MODE> struct Frag { bf16x8 v[2]; __device__ __forceinline__ void set(int k, bf16x8 x) { v[k] = x; } };
template <> struct Frag<2> { i32x8 w; __device__ __forceinline__ void set(int k, bf16x8 x) { const i32x4 y = __builtin_bit_cast(i32x4, x); if (k == 0) w.lo = y; else w.hi = y; } };
template <class Epi, class Sched, bool ALIGN_EPI = false, bool SP2 = false, int MODE = 0, bool GATHER = false>
__device__ __forceinline__ void gemm_phase(PG8_LAS unsigned char* lds, const Gemm g, const Sched& S, const Epi& E) {
    int tid_l = threadIdx.x; asm volatile("" : "+v"(tid_l));
    const int tid = tid_l, wid = __builtin_amdgcn_readfirstlane(tid >> 6), lane = tid & 63, wr = wid >> 2, wc = wid & 3, fr = lane & 15, fq = lane >> 4;
    const int K = g.K, nt = K / BK;
    unsigned voffA[2], voffB[2];
#pragma unroll
    for (int i = 0; i < 2; ++i) { int R, C; stage_rc(tid * 16 + i * 8192, R, C); const int Rb = Epi::PERM ? ((R & ~31) + perm32(R & 31)) : R;
        voffA[i] = (unsigned)(R * K + C) * 2u; voffB[i] = (unsigned)(Rb * K + C) * 2u; }
    static_assert(!GATHER || SP2, "the gathered A operand is wired into the SP2 schedule only");
    unsigned gvc[2][2] = {{0u, 0u}, {0u, 0u}};
    PG8_LAS unsigned short* gtab = (PG8_LAS unsigned short*)(lds + GTAB_OFF);
    if constexpr (GATHER) { Unit uu_;
        for (int i_ = 0; S.next(i_, uu_); ++i_) { if (tid < BM) { const int ix_ = g.gidx[uu_.pm * BM + tid]; gtab[i_ * BM + tid] = (unsigned short)(ix_ < 0 ? 0 : ix_); } }
    }
    E.prefill(lds, S, tid);
    __syncthreads();
#define PG8_GOFF(ui_, gv_) do { if constexpr (GATHER) { _Pragma("unroll") for (int h_ = 0; h_ < 2; ++h_) _Pragma("unroll") for (int i_ = 0; i_ < 2; ++i_) { int R_, C_; stage_rc(tid * 16 + i_ * 8192, R_, C_); \
        const unsigned ix_ = gtab[(ui_) * BM + h_ * HALF + R_]; gv_[h_][i_] = ix_ * (unsigned)(K * 2) + (unsigned)C_ * 2u; } } } while (0)
    const size_t kstep = (size_t)(BK * 2);
    const size_t hstep = (size_t)HALF * K * 2;
    const size_t tstep = 2 * hstep;
    const unsigned ldsw = (unsigned)wid * 1024u;
    const int aoff = lds_byte(wr * 64 + fr, fq * 8), boff = lds_byte(wc * 32 + fr, fq * 8);
#define PG8_SA(b, h) (((b) * 2 + (h)) * HTB)
#define PG8_SB(b, h) ((4 + (b) * 2 + (h)) * HTB)
#define PG8_STAGE(bufoff, gbase, voff) do { _Pragma("unroll") for (int _i = 0; _i < 2; ++_i) \
        __builtin_amdgcn_global_load_lds((const unsigned*)((const char*)(gbase) + (voff)[_i]), (PG8_LAS unsigned*)(lds + (bufoff) + ldsw + _i * 8192), 16, 0, 0); } while (0)
#define PG8_STAGE_A(bufoff, gbase, h_, nx_) do { if constexpr (GATHER) PG8_STAGE(bufoff, gbase, gvc[h_]); else PG8_STAGE(bufoff, (gbase) + (h_) * hstep, voffA); } while (0)
#define PG8_LDA(dst, b, h) do { _Pragma("unroll") for (int m = 0; m < 4; ++m) _Pragma("unroll") for (int k = 0; k < 2; ++k) dst[m].set(k, *(const PG8_LAS bf16x8*)(lds + PG8_SA(b, h) + aoff + m * 2048 + k * 1024)); } while (0)
#define PG8_LDB(dst, b, h) do { _Pragma("unroll") for (int n = 0; n < 2; ++n) _Pragma("unroll") for (int k = 0; k < 2; ++k) dst[n].set(k, *(const PG8_LAS bf16x8*)(lds + PG8_SB(b, h) + boff + n * 2048 + k * 1024)); } while (0)
#define PG8_MMA(ai, bj, At, Bt) do { __builtin_amdgcn_s_setprio(1); _Pragma("unroll") for (int m = 0; m < 4; ++m) _Pragma("unroll") for (int n = 0; n < 2; ++n) { \
        if constexpr (MODE == 2) { asm volatile("v_mfma_f32_16x16x128_f8f6f4 %0, %1, %2, %0" : "+v"(acc[ai][bj][m][n]) : "v"(Bt[n].w), "v"(At[m].w)); }     \
        else { _Pragma("unroll") for (int k = 0; k < 2; ++k) { \
          if constexpr (MODE == 1) acc[ai][bj][m][n] = __builtin_amdgcn_mfma_i32_16x16x64_i8(__builtin_bit_cast(i32x4, Bt[n].v[k]), __builtin_bit_cast(i32x4, At[m].v[k]), acc[ai][bj][m][n], 0, 0, 0); \
          else acc[ai][bj][m][n] = __builtin_amdgcn_mfma_f32_16x16x32_bf16(Bt[n].v[k], At[m].v[k], acc[ai][bj][m][n], 0, 0, 0); } } } __builtin_amdgcn_s_setprio(0); } while (0)
#define PG8_WAIT_V(n) asm volatile("s_waitcnt vmcnt(" #n ")" ::: "memory")
#define PG8_WAIT_L(n) asm volatile("s_waitcnt lgkmcnt(" #n ")" ::: "memory")
#define PG8_BAR __builtin_amdgcn_s_barrier()
#define PG8_SCHED __builtin_amdgcn_sched_barrier(0)
    Unit cur, nxt; int ui = 0;
    if (!S.next(0, cur)) return;
    typedef typename AccSel<MODE>::type acc_t; const acc_t acc_zero = {};
    acc_t acc[2][2][4][2];
#pragma unroll
    for (int a = 0; a < 2; ++a)
#pragma unroll
        for (int b = 0; b < 2; ++b)
#pragma unroll
            for (int m = 0; m < 4; ++m)
#pragma unroll
                for (int n = 0; n < 2; ++n) acc[a][b][m][n] = acc_zero;
    Frag<MODE> At[4], B0[2], B1[2];
    const char* cA = (const char*)g.A + (GATHER ? (size_t)0 : (size_t)cur.pm * tstep); PG8_GOFF(0, gvc); const char* cB = (const char*)g.Bt + (size_t)(cur.pm / g.tpe) * g.bgs + (size_t)cur.pn * tstep;
    S.a_ready(cur);
    if constexpr (SP2) {
        PG8_STAGE(PG8_SB(0, 0), cB, voffB); PG8_STAGE(PG8_SB(0, 1), cB + hstep, voffB); PG8_STAGE_A(PG8_SA(0, 0), cA, 0, false); PG8_STAGE_A(PG8_SA(0, 1), cA, 1, false);
        if (wr == 1) PG8_BAR;
        PG8_WAIT_V(2); PG8_BAR;
        PG8_STAGE(PG8_SB(1, 0), cB + kstep, voffB); PG8_STAGE_A(PG8_SA(1, 0), cA + kstep, 0, false); PG8_STAGE(PG8_SB(1, 1), cB + hstep + kstep, voffB);
        PG8_WAIT_V(6); PG8_BAR;
    } else {
        PG8_STAGE(PG8_SB(0, 0), cB, voffB); PG8_STAGE(PG8_SA(0, 0), cA, voffA); PG8_STAGE(PG8_SB(0, 1), cB + hstep, voffB); PG8_STAGE(PG8_SA(0, 1), cA + hstep, voffA);
        if (wr == 1) PG8_BAR;
        PG8_WAIT_V(4); PG8_BAR;
        PG8_STAGE(PG8_SB(1, 0), cB + kstep, voffB); PG8_STAGE(PG8_SA(1, 0), cA + kstep, voffA); PG8_STAGE(PG8_SB(1, 1), cB + hstep + kstep, voffB);
        PG8_WAIT_V(6); PG8_BAR;
    }
    for (;;) {
        const bool has_next = S.next(ui + 1, nxt);
        const char* nA = (has_next && !GATHER) ? (const char*)g.A + (size_t)nxt.pm * tstep : cA; const char* nB = has_next ? (const char*)g.Bt + (size_t)(nxt.pm / g.tpe) * g.bgs + (size_t)nxt.pn * tstep : cB;
        for (int t = 0; t < nt; t += 2) {
            const bool last = (t == nt - 2); const bool nxu = last && has_next;
            const char* a1 = cA + (size_t)(t + 1) * kstep;
            const char* a2 = last ? nA : cA + (size_t)(t + 2) * kstep; const char* b2 = last ? nB : cB + (size_t)(t + 2) * kstep;
            const char* a3 = a2 + kstep; const char* b3 = b2 + kstep;
            if (last && has_next) S.a_ready(nxt);
            if constexpr (SP2) {
            PG8_LDB(B0, 0, 0); PG8_LDB(B1, 0, 1); PG8_SCHED; PG8_LDA(At, 0, 0); PG8_STAGE_A(PG8_SA(1, 1), a1, 1, false); if (nxu) PG8_GOFF(ui + 1, gvc);
            PG8_WAIT_V(8); PG8_WAIT_L(0); PG8_BAR; PG8_MMA(0, 0, At, B0); PG8_MMA(0, 1, At, B1); PG8_BAR; PG8_SCHED;
            PG8_LDA(At, 0, 1); PG8_STAGE(PG8_SB(0, 0), b2, voffB); PG8_STAGE(PG8_SB(0, 1), b2 + hstep, voffB); PG8_STAGE_A(PG8_SA(0, 0), a2, 0, nxu);
            PG8_WAIT_V(8); PG8_WAIT_L(0); PG8_BAR; PG8_MMA(1, 0, At, B0); PG8_MMA(1, 1, At, B1); PG8_BAR; PG8_SCHED;
            PG8_LDB(B0, 1, 0); PG8_LDB(B1, 1, 1); PG8_SCHED; PG8_LDA(At, 1, 0); PG8_STAGE_A(PG8_SA(0, 1), a2, 1, nxu);
            PG8_WAIT_V(8); PG8_WAIT_L(0); PG8_BAR; PG8_MMA(0, 0, At, B0); PG8_MMA(0, 1, At, B1); PG8_BAR; PG8_SCHED;
            PG8_LDA(At, 1, 1); PG8_STAGE(PG8_SB(1, 0), b3, voffB); PG8_STAGE(PG8_SB(1, 1), b3 + hstep, voffB); PG8_STAGE_A(PG8_SA(1, 0), a3, 0, nxu);
            PG8_WAIT_V(8); PG8_WAIT_L(0); PG8_BAR; PG8_MMA(1, 0, At, B0); PG8_MMA(1, 1, At, B1); PG8_BAR; PG8_SCHED;
            } else {
            PG8_LDB(B0, 0, 0); PG8_SCHED; PG8_LDA(At, 0, 0); PG8_STAGE(PG8_SA(1, 1), a1 + hstep, voffA);
            PG8_WAIT_L(8); PG8_BAR; PG8_WAIT_L(0); PG8_MMA(0, 0, At, B0); PG8_BAR; PG8_SCHED;
            PG8_LDB(B1, 0, 1); PG8_STAGE(PG8_SB(0, 0), b2, voffB);
            PG8_BAR; PG8_WAIT_L(0); PG8_MMA(0, 1, At, B1); PG8_BAR;
            PG8_LDA(At, 0, 1); PG8_STAGE(PG8_SA(0, 0), a2, voffA);
            PG8_BAR; PG8_WAIT_L(0); PG8_MMA(1, 0, At, B0); PG8_BAR; PG8_SCHED;
            PG8_STAGE(PG8_SB(0, 1), b2 + hstep, voffB);
            PG8_WAIT_V(6); PG8_BAR; PG8_MMA(1, 1, At, B1); PG8_BAR;
            PG8_LDB(B0, 1, 0); PG8_SCHED; PG8_LDA(At, 1, 0); PG8_STAGE(PG8_SA(0, 1), a2 + hstep, voffA);
            PG8_WAIT_L(8); PG8_BAR; PG8_WAIT_L(0); PG8_MMA(0, 0, At, B0); PG8_BAR; PG8_SCHED;
            PG8_LDB(B1, 1, 1); PG8_STAGE(PG8_SB(1, 0), b3, voffB);
            PG8_BAR; PG8_WAIT_L(0); PG8_MMA(0, 1, At, B1); PG8_BAR;
            PG8_LDA(At, 1, 1); PG8_STAGE(PG8_SA(1, 0), a3, voffA);
            PG8_BAR; PG8_WAIT_L(0); PG8_MMA(1, 0, At, B0); PG8_BAR; PG8_SCHED;
            PG8_STAGE(PG8_SB(1, 1), b3 + hstep, voffB);
            PG8_WAIT_V(6); PG8_BAR; PG8_MMA(1, 1, At, B1); PG8_BAR;
            }
        }
        if constexpr (ALIGN_EPI) { if (wr == 0) PG8_BAR; }
        if constexpr (!Epi::AFTER_DRAIN) { E(acc, cur, wr, wc, fr, fq, lds); S.done(cur); }
        if (!has_next) break;
#pragma unroll
        for (int a = 0; a < 2; ++a)
#pragma unroll
            for (int b = 0; b < 2; ++b)
#pragma unroll
                for (int m = 0; m < 4; ++m)
#pragma unroll
                    for (int n = 0; n < 2; ++n) acc[a][b][m][n] = acc_zero;
        cur = nxt; cA = nA; cB = nB; ++ui;
        if constexpr (ALIGN_EPI) { if (wr == 1) PG8_BAR; }
    }
    PG8_WAIT_V(0);
    if constexpr (!ALIGN_EPI) { if (wr == 0) PG8_BAR; }
    PG8_BAR;
    if constexpr (Epi::AFTER_DRAIN) { E.fused(acc, cur, wr, wc, fr, fq, lds, wid, lane); S.done(cur); }
#undef PG8_SA
#undef PG8_SB
#undef PG8_STAGE
#undef PG8_STAGE_A
#undef PG8_GOFF
#undef PG8_LDA
#undef PG8_LDB
#undef PG8_MMA
#undef PG8_WAIT_V
#undef PG8_WAIT_L
#undef PG8_BAR
#undef PG8_SCHED
}
}
namespace att {
typedef unsigned short bf16_t;
typedef short bf16x8 __attribute__((ext_vector_type(8)));
typedef short s16x4 __attribute__((ext_vector_type(4)));
typedef float f32x16 __attribute__((ext_vector_type(16)));
typedef float f32x4 __attribute__((ext_vector_type(4)));
typedef unsigned u32x4 __attribute__((ext_vector_type(4)));
typedef unsigned u32x2 __attribute__((ext_vector_type(2)));
#define ALDS __attribute__((address_space(3)))
typedef float f32x2_t __attribute__((ext_vector_type(2))); typedef __bf16 bf16x2_t __attribute__((ext_vector_type(2)));
__device__ __forceinline__ unsigned cvtpk(float lo, float hi) { f32x2_t v = {lo, hi}; bf16x2_t b = __builtin_convertvector(v, bf16x2_t); return __builtin_bit_cast(unsigned, b); }
__device__ __forceinline__ float bf2f(unsigned short u) { return __uint_as_float((unsigned)u << 16); }
template <int S> __device__ __forceinline__ bf16x8 pack8(const f32x16& x) {
    u32x4 p; p.x = cvtpk(x[8 * S + 0], x[8 * S + 1]); p.y = cvtpk(x[8 * S + 2], x[8 * S + 3]); p.z = cvtpk(x[8 * S + 4], x[8 * S + 5]); p.w = cvtpk(x[8 * S + 6], x[8 * S + 7]);
    return __builtin_bit_cast(bf16x8, p);
}
typedef short v4i16_t __attribute__((ext_vector_type(4)));
__device__ __forceinline__ s16x4 vtr(const ALDS char* p) { return __builtin_bit_cast(s16x4, __builtin_amdgcn_ds_read_tr16_b64_v4i16((ALDS v4i16_t*)p)); }
__device__ __forceinline__ int crow(int r, int hi) { return (r & 3) + 8 * (r >> 2) + 4 * hi; }
constexpr int ATT_LDS_BYTES = 2 * 12288 + 2 * 8192;

__device__ __forceinline__ void glds16(const void* gsrc, unsigned lds_dst) { unsigned keep;
    asm volatile("s_mov_b32 %0, m0\n\ts_mov_b32 m0, %2\n\ts_nop 0\n\tglobal_load_lds_dwordx4 %1, off\n\ts_mov_b32 m0, %0" : "=&s"(keep) : "v"(gsrc), "s"(lds_dst) : "memory"); }
__device__ __forceinline__ void glds16s(const char* sbase, unsigned voff, unsigned lds_dst) { unsigned keep;
    asm volatile("s_mov_b32 %0, m0\n\ts_mov_b32 m0, %3\n\ts_nop 0\n\tglobal_load_lds_dwordx4 %1, %2\n\ts_mov_b32 m0, %0" : "=&s"(keep) : "v"(voff), "s"(sbase), "s"(lds_dst) : "memory"); }
#define ATT_SBAR() __builtin_amdgcn_sched_barrier(0)
#define ATT_PIN(x) asm volatile("" : "+v"(x))
typedef int i32x2a __attribute__((ext_vector_type(2)));
typedef int i32x4a __attribute__((ext_vector_type(4)));
typedef int i32x6a __attribute__((ext_vector_type(6)));
typedef int i32x8a __attribute__((ext_vector_type(8)));
typedef unsigned u32x16 __attribute__((ext_vector_type(16)));
typedef __bf16 bf16x32_t __attribute__((ext_vector_type(32)));
__device__ __forceinline__ i32x6a cvt_fp6x32(const u32x16& w) { return __builtin_bit_cast(i32x6a, __builtin_amdgcn_cvt_scalef32_pk32_fp6_bf16(__builtin_bit_cast(bf16x32_t, w), 1.0f)); }
#define ATT_MF6_Z(C, A, B, SA, SB) asm volatile("v_mfma_scale_f32_32x32x64_f8f6f4 %0, %1, %2, 0, %3, %4 op_sel:[0,0,0] op_sel_hi:[0,0,0] cbsz:2 blgp:2" : "=&v"(C) : "v"(A), "v"(B), "v"(SA), "v"(SB))
#define ATT_MF6_A(C, A, B, SA, SB) asm volatile("v_mfma_scale_f32_32x32x64_f8f6f4 %0, %1, %2, %0, %3, %4 op_sel:[0,0,0] op_sel_hi:[0,0,0] cbsz:2 blgp:2" : "+v"(C) : "v"(A), "v"(B), "v"(SA), "v"(SB))
#define ATT_MF6_C(C, A, B, C0, SA, SB) asm volatile("v_mfma_scale_f32_32x32x64_f8f6f4 %0, %1, %2, %3, %4, %5 op_sel:[0,0,0] op_sel_hi:[0,0,0] cbsz:2 blgp:2" : "=&v"(C) : "v"(A), "v"(B), "v"(C0), "v"(SA), "v"(SB))
template <int DK> struct KCfg { static constexpr int NG = (DK == 96) ? 3 : 2, KTB = (DK == 96) ? 5120 : 3072, QRB = 24 * NG, NF = (DK == 96) ? 2 : 1, NRD = 4 * NF, PB = NG * 1024,
                                                      SCL = (DK == 32) ? 0x77777777 : 0x76767676, NB = (DK == 32) ? 2 : 4; };
constexpr float FQ96 = 4.0f * 1.4426950408889634f * 0.10206207261596575f * 2.0f, FQ32 = 4.0f * 1.4426950408889634f * 0.17677669529663687f, FQ64 = 4.0f * 1.4426950408889634f * 0.125f * 2.0f;
constexpr float P_BIAS = 44.0f / 256.0f;
constexpr int KC_A = 0, KC_B = 1024;
template <int DK>
__device__ __forceinline__ void kread6(i32x6a (&kf)[2][KCfg<DK>::NF], const ALDS char* pA0, const ALDS char* pB0, const ALDS char* pA1, const ALDS char* pB1, int idx) {
    constexpr int NF = KCfg<DK>::NF;
    const int mt = idx / (2 * NF), f = (idx / 2) % NF, part = idx & 1;
    const ALDS char* pA = f ? pA1 : pA0; const ALDS char* pB = f ? pB1 : pB0;
    if (part == 0) { const i32x4a v = *(const ALDS i32x4a*)(pA + mt * 512); kf[mt][f][0] = v.x; kf[mt][f][1] = v.y; kf[mt][f][2] = v.z; kf[mt][f][3] = v.w; }
    else { const i32x2a v = *(const ALDS i32x2a*)(pB + mt * 256); kf[mt][f][4] = v.x; kf[mt][f][5] = v.y; }
}
#define ATT_PV8(C, A, B) asm volatile("s_nop 3\n\tv_mfma_f32_32x32x64_f8f6f4 %0, %1, %2, %0 cbsz:0 blgp:1" : "+v"(C) : "v"(A), "v"(B))
#define ATT_L8(C, A, B) asm volatile("s_nop 3\n\tv_mfma_f32_16x16x128_f8f6f4 %0, %1, %2, %0 cbsz:0 blgp:1" : "+v"(C) : "v"(A), "v"(B))
#define ATT_L8N(C, A, B) asm volatile("v_mfma_f32_16x16x128_f8f6f4 %0, %1, %2, %0 cbsz:0 blgp:1" : "+v"(C) : "v"(A), "v"(B))
#define ATT_PV8N(C, A, B) asm volatile("v_mfma_f32_32x32x64_f8f6f4 %0, %1, %2, %0 cbsz:0 blgp:1" : "+v"(C) : "v"(A), "v"(B))
typedef unsigned short u16x2 __attribute__((ext_vector_type(2)));
__device__ __forceinline__ unsigned pk4_bf8(float a, float b, float c, float d) {
    const u16x2 x = __builtin_amdgcn_cvt_pknorm_u16(a, b), y = __builtin_amdgcn_cvt_pknorm_u16(c, d);
    return __builtin_amdgcn_perm(__builtin_bit_cast(unsigned, y), __builtin_bit_cast(unsigned, x), 0x07050301u); }
struct KPtr { const ALDS char *a0, *b0, *a1, *b1; };
template <int DK, int VLOAD, int ABL = 0, class DF>
__device__ __forceinline__ void att_step9(f32x16& N0, f32x16& N1, const f32x16& P0, const f32x16& P1, i32x6a (&kf)[2][KCfg<DK>::NF], const i32x6a* qfn,
                                          f32x16 (&o)[2], f32x4& L, const i32x8a& pwP, i32x8a& pwC, i32x8a (&vf)[2], const i32x8a& ones, const f32x16& cb, const int& sa, const int& sb,
                                          const ALDS char* vcur, const KPtr k1, const KPtr k0, DF&& dmaf) {
    constexpr int NF = KCfg<DK>::NF;
#define ATP_PACK(i) do { if (!(ABL & 4)) { const int e = 4 * (i); \
        int w = (int)((e < 16) ? pk4_bf8(P0[e & 15], P0[(e + 1) & 15], P0[(e + 2) & 15], P0[(e + 3) & 15]) : pk4_bf8(P1[e & 15], P1[(e + 1) & 15], P1[(e + 2) & 15], P1[(e + 3) & 15])); \
        ATT_PIN(w); pwC[i] = w; } } while (0)
    ATT_SBAR();
    ATT_PV8N(o[0], vf[0], pwP);
    dmaf();
#pragma unroll
    for (int k = 2 * NF; k < 4 * NF; ++k) { if (!(ABL & 8)) kread6<DK>(kf, k1.a0, k1.b0, k1.a1, k1.b1, k); }
#pragma unroll
    for (int i = 0; i < 4; ++i) ATP_PACK(i);
    ATT_SBAR();
    ATT_PV8N(o[1], vf[1], pwP);
    if (VLOAD && !(ABL & 8)) { vf[0].lo = *(const ALDS i32x4a*)(vcur); vf[0].hi = *(const ALDS i32x4a*)(vcur + 1024); }
#pragma unroll
    for (int i = 4; i < 8; ++i) ATP_PACK(i);
    ATT_SBAR();
    ATT_L8N(L, ones, pwP);
    if (VLOAD && !(ABL & 8)) { vf[1].lo = *(const ALDS i32x4a*)(vcur + 512); vf[1].hi = *(const ALDS i32x4a*)(vcur + 512 + 1024); }
    ATT_SBAR();
    if (DK == 64) { ATT_MF6_C(N0, kf[0][0], qfn[0], cb, sa, sb); ATT_MF6_C(N1, kf[1][0], qfn[0], cb, sa, sb); }
    else if (NF == 1) { ATT_MF6_Z(N0, kf[0][0], qfn[0], sa, sb); ATT_MF6_Z(N1, kf[1][0], qfn[0], sa, sb); }
    else { ATT_MF6_Z(N0, kf[0][0], qfn[0], sa, sb); ATT_MF6_Z(N1, kf[1][0], qfn[0], sa, sb); ATT_MF6_A(N0, kf[0][1], qfn[1], sa, sb); ATT_MF6_A(N1, kf[1][1], qfn[1], sa, sb); }
    ATT_SBAR();
#pragma unroll
    for (int k = 0; k < 2 * NF; ++k) { if (!(ABL & 8)) kread6<DK>(kf, k0.a0, k0.b0, k0.a1, k0.b1, k); }
    ATT_SBAR();
#undef ATP_PACK
}
template <int DK, int NMAP, int ABL = 0>
__device__ __forceinline__ void attn_unit_f8(const unsigned char* __restrict__ Qb, const char* __restrict__ Kt, const char* __restrict__ Vt, int t0, int t1,
                                             bf16_t* __restrict__ Ob, ALDS char* lds, float lam, const float* __restrict__ gout, float oml) {
    typedef KCfg<DK> KC;
    constexpr int KTB = KC::KTB, NF = KC::NF, NRD = KC::NRD, LV = 8 * KTB, CB = LV + 8 * 4096, NKP = KTB / 1024, NP = NKP + 4, NDMA = (NP + 7) / 8;
    int tid_l = threadIdx.x; asm volatile("" : "+v"(tid_l));
    const int tid = tid_l, lane = tid & 63, r32 = lane & 31, hi = lane >> 5, wid = __builtin_amdgcn_readfirstlane(tid >> 6);
    i32x6a qbias;
    { u32x16 vq, vk; unsigned pq = 0x40B040B0u, pk = 0x40804080u;
      asm volatile("" : "+v"(pq), "+v"(pk));
#pragma unroll
      for (int r = 0; r < 16; ++r) { vq[r] = (2 * r < KC::NB) ? pq : 0u; vk[r] = (2 * r < KC::NB) ? pk : 0u; }
      qbias = cvt_fp6x32(vq);
      if (DK != 64 && tid == 0) { const i32x6a kb = cvt_fp6x32(vk); const i32x4a ka = {kb[0], kb[1], kb[2], kb[3]}; const i32x2a kc = {kb[4], kb[5]};
          *(ALDS i32x4a*)(lds + CB + KC_A) = ka; *(ALDS i32x4a*)(lds + CB + KC_A + 512) = ka; *(ALDS i32x2a*)(lds + CB + KC_B) = kc; *(ALDS i32x2a*)(lds + CB + KC_B + 256) = kc; } }
    i32x6a qf[NMAP][NF];
    { const unsigned char* qrow = Qb + (size_t)(wid * 32 + r32) * KC::QRB;
#define ATP_QG(dst, off) do { const i32x2a a_ = *(const i32x2a*)(qrow + (off)), b_ = *(const i32x2a*)(qrow + (off) + 8), c_ = *(const i32x2a*)(qrow + (off) + 16); \
          dst[0] = a_.x; dst[1] = a_.y; dst[2] = b_.x; dst[3] = b_.y; dst[4] = c_.x; dst[5] = c_.y; } while (0)
      if (DK == 64) { ATP_QG(qf[0][0], 24 * hi); }
      else if (DK == 96) { ATP_QG(qf[0][0], 24 * hi); i32x6a t; ATP_QG(t, 48);
#pragma unroll
          for (int r = 0; r < 6; ++r) qf[0][NF - 1][r] = hi ? qbias[r] : t[r]; }
      else {
#pragma unroll
          for (int m = 0; m < NMAP; ++m) { i32x6a t; ATP_QG(t, 24 * m);
#pragma unroll
              for (int r = 0; r < 6; ++r) qf[m][0][r] = hi ? qbias[r] : t[r]; } }
#undef ATP_QG
    }
#pragma unroll
    for (int m = 0; m < NMAP; ++m)
#pragma unroll
        for (int f = 0; f < NF; ++f) ATT_PIN(qf[m][f]);
    f32x16 o[NMAP][2], cb; f32x4 L[NMAP]; i32x8a pw, ones; int sa = 0x7F7F7F7F, sb = KC::SCL;
    ATT_PIN(sa); ATT_PIN(sb);
#pragma unroll
    for (int r = 0; r < 16; ++r) cb[r] = P_BIAS;
    if (DK == 64) ATT_PIN(cb);
    { const int sel = (lane == 0 || lane == 32 || lane == 17 || lane == 49) ? 0x38383838 : 0;
#pragma unroll
      for (int r = 0; r < 8; ++r) { pw[r] = 0; ones[r] = sel; } }
    ATT_PIN(ones);
#pragma unroll
    for (int m = 0; m < NMAP; ++m) {
#pragma unroll
        for (int r = 0; r < 4; ++r) L[m][r] = 0.f;
#pragma unroll
        for (int d = 0; d < 2; ++d)
#pragma unroll
            for (int r = 0; r < 16; ++r) o[m][d][r] = 0.f; }
#pragma unroll
    for (int m = 0; m < NMAP; ++m) { ATT_PIN(L[m]); ATT_PIN(o[m][0]); ATT_PIN(o[m][1]); }
    const unsigned lds0 = (unsigned)(size_t)lds;
    const char* src0; unsigned dst0; int isv0; const bool act0 = wid < NP;
    { const int p = wid; isv0 = p >= NKP; src0 = (isv0 ? Vt + (p - NKP) * 1024 : Kt + p * 1024); dst0 = lds0 + (isv0 ? LV + (p - NKP) * 1024 : p * 1024); }
    const unsigned lane16 = (unsigned)lane * 16u;
    const bool act1 = (NDMA == 2) && wid == 7;
    const char* src1 = nullptr; unsigned dst1 = 0u;
    if (NDMA == 2) { const int p = 8; src1 = Vt + (p - NKP) * 1024; dst1 = lds0 + LV + (p - NKP) * 1024; }
#define ATP_DMA(tk, tv) do { if (ABL & (2 | 32)) break; \
        if (act0) { if (isv0) glds16s(src0 + (size_t)(tv) * 4096, lane16, (unsigned)__builtin_amdgcn_readfirstlane(dst0 + ((tv) & 7) * 4096)); else glds16s(src0 + (size_t)(tk) * KTB, lane16, (unsigned)__builtin_amdgcn_readfirstlane(dst0 + ((tk) & 7) * KTB)); } \
        if (act1) glds16s(src1 + (size_t)(tv) * 4096, lane16, (unsigned)__builtin_amdgcn_readfirstlane(dst1 + ((tv) & 7) * 4096)); } while (0)
#define ATP_SYNCALL() do { if (ABL & 2) break; if (!(ABL & 128)) { if (act1) asm volatile("s_waitcnt vmcnt(4)" ::: "memory"); else asm volatile("s_waitcnt vmcnt(2)" ::: "memory"); } \
        if (!(ABL & 64)) asm volatile("s_barrier" ::: "memory"); } while (0)
    const bool c0 = (DK == 32) && hi, c1 = hi;
    const int ka0 = c0 ? CB + KC_A : ((DK == 32) ? 0 : hi * 1024) + r32 * 16, kb0 = c0 ? CB + KC_B : KC::PB + ((DK == 32) ? 0 : hi * 512) + r32 * 8, km0 = c0 ? 0 : KTB;
    const int dA = (DK == 32 && !hi) ? 1024 : 0, dB = (DK == 32 && !hi) ? 512 : 0;
    const int ka1 = c1 ? CB + KC_A : 2048 + r32 * 16, kb1 = c1 ? CB + KC_B : KC::PB + 1024 + r32 * 8, km1 = c1 ? 0 : KTB;
#define ATP_KP(t, m) (KPtr{lds + ((t) & 7) * km0 + ka0 + (m) * dA, lds + ((t) & 7) * km0 + kb0 + (m) * dB, lds + ((t) & 7) * km1 + ka1, lds + ((t) & 7) * km1 + kb1})
#define ATP_VB(t) (lds + LV + ((t) & 7) * 4096 + klane64)
#define ATP_KLOAD(t, m) do { const KPtr kp_ = ATP_KP(t, m); _Pragma("unroll") for (int k = 0; k < NRD; ++k) kread6<DK>(kf, kp_.a0, kp_.b0, kp_.a1, kp_.b1, k); \
        asm volatile("s_waitcnt lgkmcnt(0)" ::: "memory"); \
        _Pragma("unroll") for (int mt_ = 0; mt_ < 2; ++mt_) _Pragma("unroll") for (int f_ = 0; f_ < NF; ++f_) ATT_PIN(kf[mt_][f_]);     \
        asm volatile("s_nop 3" ::: "memory"); } while (0)
    const int klane64 = hi * 2048 + r32 * 16;
    ATP_DMA(t0, t0); ATP_DMA(t0 + 1, t0 + 1); ATP_DMA(t0 + 2, t0 + 1); if (NMAP == 1) ATP_DMA(t0 + 3, t0 + 1);
    asm volatile("s_waitcnt vmcnt(0) lgkmcnt(0)\n\ts_barrier" ::: "memory");
    if (NMAP == 1) { ATP_DMA(t0 + 4, t0 + 2); ATP_DMA(t0 + 5, t0 + 3); } else { ATP_DMA(t0 + 3, t0 + 2); ATP_DMA(t0 + 4, t0 + 3); }
    i32x6a kf[2][NF]; i32x8a vf[2], pwB;
    f32x16 sA0, sA1, sB0, sB1;
    ATP_KLOAD(t0, 0);
    if (DK == 64) { ATT_MF6_C(sA0, kf[0][0], qf[0][0], cb, sa, sb); ATT_MF6_C(sA1, kf[1][0], qf[0][0], cb, sa, sb); } else { ATT_MF6_Z(sA0, kf[0][0], qf[0][0], sa, sb); ATT_MF6_Z(sA1, kf[1][0], qf[0][0], sa, sb); }
    if (NF == 2) { ATT_MF6_A(sA0, kf[0][1], qf[0][1], sa, sb); ATT_MF6_A(sA1, kf[1][1], qf[0][1], sa, sb); }
    asm volatile("s_nop 15\n\ts_nop 15\n\ts_nop 15\n\ts_nop 15\n\ts_nop 15\n\ts_nop 15" : "+v"(sA0), "+v"(sA1));
    { const KPtr kp_ = (NMAP == 1) ? ATP_KP(t0 + 1, 0) : ATP_KP(t0, 1);
#pragma unroll
      for (int k = 0; k < 2 * NF; ++k) kread6<DK>(kf, kp_.a0, kp_.b0, kp_.a1, kp_.b1, k); }
#pragma unroll
    for (int r = 0; r < 8; ++r) { vf[0][r] = 0; vf[1][r] = 0; pwB[r] = 0; }
    ATT_PIN(vf[0]); ATT_PIN(vf[1]); ATT_PIN(pwB);
    asm volatile("s_nop 3" ::: "memory");
    if (NMAP == 1) {
        for (int t = t0; t < t1; t += 2) {
            att_step9<DK, 1, ABL>(sB0, sB1, sA0, sA1, kf, qf[0], o[0], L[0], pwB, pw, vf, ones, cb, sa, sb, ATP_VB(t), ATP_KP(t + 1, 0), ATP_KP(t + 2, 0), [&]() { ATP_DMA(t + 6, t + 4); ATP_DMA(t + 7, t + 5); });
            att_step9<DK, 1, ABL>(sA0, sA1, sB0, sB1, kf, qf[0], o[0], L[0], pw, pwB, vf, ones, cb, sa, sb, ATP_VB(t + 1), ATP_KP(t + 2, 0), ATP_KP(t + 3, 0), [&]() {});
            ATP_SYNCALL();
        }
    } else {
        for (int t = t0; t < t1; t += 2) {
            att_step9<DK, 1, ABL>(sB0, sB1, sA0, sA1, kf, qf[1], o[1], L[1], pwB, pw, vf, ones, cb, sa, sb, ATP_VB(t), ATP_KP(t, 1), ATP_KP(t + 1, 0), [&]() { ATP_DMA(t + 5, t + 4); });
            att_step9<DK, 0, ABL>(sA0, sA1, sB0, sB1, kf, qf[0], o[0], L[0], pw, pwB, vf, ones, cb, sa, sb, ATP_VB(t), ATP_KP(t + 1, 0), ATP_KP(t + 1, 1), [&]() { ATP_DMA(t + 6, t + 5); });
            att_step9<DK, 1, ABL>(sB0, sB1, sA0, sA1, kf, qf[1], o[1], L[1], pwB, pw, vf, ones, cb, sa, sb, ATP_VB(t + 1), ATP_KP(t + 1, 1), ATP_KP(t + 2, 0), [&]() {});
            att_step9<DK, 0, ABL>(sA0, sA1, sB0, sB1, kf, qf[0], o[0], L[0], pw, pwB, vf, ones, cb, sa, sb, ATP_VB(t + 1), ATP_KP(t + 2, 0), ATP_KP(t + 2, 1), [&]() {});
            ATP_SYNCALL();
        }
    }
    ATT_SBAR();
    ATT_PV8N(o[NMAP - 1][0], vf[0], pwB); ATT_PV8N(o[NMAP - 1][1], vf[1], pwB); ATT_L8N(L[NMAP - 1], ones, pwB);
    asm volatile("s_waitcnt vmcnt(0) lgkmcnt(0)\n\ts_barrier" ::: "memory");
#pragma unroll
    for (int m = 0; m < NMAP; ++m) asm volatile("s_nop 15\n\ts_nop 15\n\ts_nop 15\n\ts_nop 15\n\ts_nop 15" : "+v"(o[m][0]), "+v"(o[m][1]), "+v"(L[m]));
#undef ATP_DMA
#undef ATP_SYNCALL
#undef ATP_KP
#undef ATP_VB
#undef ATP_KLOAD
    float li[NMAP];
#pragma unroll
    for (int m = 0; m < NMAP; ++m) { const float l0 = __shfl(L[m][0], r32 & 15), l1 = __shfl(L[m][1], r32 & 15); li[m] = 1.0f / ((r32 & 16) ? l1 : l0); }
    float val[2][16];
    if (NMAP == 1) {
#pragma unroll
        for (int d = 0; d < 2; ++d)
#pragma unroll
            for (int r = 0; r < 16; ++r) val[d][r] = o[0][d][r] * li[0];
    } else {
        float ss = 0.f; const float l2 = lam * li[NMAP - 1];
#pragma unroll
        for (int d = 0; d < 2; ++d)
#pragma unroll
            for (int r = 0; r < 16; ++r) { const float v = o[0][d][r] * li[0] - o[NMAP - 1][d][r] * l2; val[d][r] = v; ss += v * v; }
        ss += __shfl_xor(ss, 32);
        const float rstd = rsqrtf(ss * (1.0f / 64.0f) + 1e-6f) * oml;
#pragma unroll
        for (int d = 0; d < 2; ++d)
#pragma unroll
            for (int g = 0; g < 4; ++g) { const f32x4 gv = *(const f32x4*)(gout + 32 * d + 8 * g + 4 * hi);
#pragma unroll
                for (int i = 0; i < 4; ++i) val[d][4 * g + i] *= rstd * gv[i]; }
    }
    bf16_t* orow = Ob + (size_t)(wid * 32 + r32) * 1024 + 4 * hi;
#pragma unroll
    for (int d = 0; d < 2; ++d)
#pragma unroll
        for (int g = 0; g < 4; ++g) { u32x2 w; w.x = cvtpk(val[d][4 * g], val[d][4 * g + 1]); w.y = cvtpk(val[d][4 * g + 2], val[d][4 * g + 3]);
            *(u32x2*)(orow + 32 * d + 8 * g) = w; }
}

}
constexpr int NWAVES = 8;
constexpr int DM = 1024, NB = 4, SEQ = 8192, CL = 256, NTOKB = SEQ + CL, LROWS = NB * SEQ, MROWS = LROWS + NB * CL;
constexpr int NLAYER = 2, INC = 1952, ZP = 3072, NE = 16, FFD = 2048, CAPL = 1024, CAPC = 32, NKT = NTOKB / 64;
constexpr int ZQ = 1952, ZKV = 2336, ZEND = 2848;
constexpr float EPSF = 1e-6f, LOG2E = 1.4426950408889634f, HID_SCALE = 4.0f, YE_SCALE = 32.0f;
constexpr int N_PHASES = 22;
enum { I_X = 0, I_C, I_CTX, I_CCTX, I_WADA, I_BADA, I_GN1, I_WIN, I_GCQ, I_GCKV, I_WUQ, I_WUKV, I_GMQ, I_GMK, I_GDQ, I_GDK, I_LQ1, I_LK1, I_LQ2, I_LK2, I_GDO, I_GGQ, I_GGK, I_WO, I_GN2, I_WR, I_WG, I_WU, I_WD, N_IN };
constexpr size_t MiB = 1u << 20;
constexpr size_t WS_CTL = 0, CTL_ZERO_BYTES = 1 * MiB;
constexpr size_t WS_MOD = 1 * MiB;
constexpr size_t WS_LAM = WS_MOD + 256 * 1024;
constexpr size_t WS_TAB = WS_MOD + 320 * 1024;
constexpr size_t TAB_AROW = 0, TAB_ACOL = 128 * 8 * 8, TAB_GROW = TAB_ACOL + 64 * 8 * 8, TAB_GCOL = TAB_GROW + 128 * 16 * 8;
constexpr size_t WS_AFF = 2 * MiB, WS_AFFC = 4 * MiB;
constexpr size_t WS_IDX = 5 * MiB, WS_GATE = 6 * MiB;
constexpr size_t WS_INV = 7 * MiB;
constexpr size_t WS_SA = 10 * MiB, WS_SAE = 11 * MiB, WS_SW = 12 * MiB;
constexpr size_t WS_SSQ = 14 * MiB;
constexpr size_t WS_SWC = 13 * MiB;
constexpr size_t WS_WCAT8 = 72 * MiB;
constexpr size_t WS_WCAT = 16 * MiB;
constexpr size_t WS_WO = 28 * MiB;
constexpr size_t WS_CTXW = 32 * MiB;
constexpr size_t WS_H = 36 * MiB;
constexpr size_t WS_WGU = 102 * MiB;
constexpr size_t WS_WD = 230 * MiB;
constexpr size_t WS_YE = 294 * MiB;
constexpr size_t WS_Z = 430 * MiB;
constexpr size_t WS_QKV = 628 * MiB;
constexpr size_t WS_ATT = 793 * MiB;
constexpr size_t WS_DELTA = 430 * MiB;
constexpr size_t WS_XE = 430 * MiB;
constexpr size_t WS_HID = 566 * MiB;
constexpr size_t WS_XB = 859 * MiB;
constexpr size_t WS_END = 925 * MiB;
constexpr size_t QO_QM = 0, QO_QD = 25952256, QO_QG = 43253760, QO_KM = 77856768, QO_KD = 103809024, QO_KG = 121110528, QO_VM = 129761280, QO_VD = 147062784, QO_VG = 164364288;
static_assert(QO_VG + 8650752 == 173015040 && WS_QKV + 173015040 <= WS_ATT && WS_HID + (size_t)16 * 4352 * 2048 * 2 <= WS_XB, "ws map");
constexpr int CW_BAR = 4096, CW_Q = 16384;
constexpr int RING_BYTES = 131072, LDSCTL_OFF = RING_BYTES, MISC_OFF = LDSCTL_OFF + 320, LDS_BYTES = 163840;

#define GAS __attribute__((address_space(1)))
#define LAS __attribute__((address_space(3)))
typedef unsigned short bf16;
typedef unsigned v4u __attribute__((ext_vector_type(4)));
typedef unsigned v2u __attribute__((ext_vector_type(2)));
typedef float f32x4 __attribute__((ext_vector_type(4)));
typedef float f32x2 __attribute__((ext_vector_type(2)));
typedef GAS unsigned gu32;
#define RLX_AGENT __ATOMIC_RELAXED, __HIP_MEMORY_SCOPE_AGENT
#define LDS_WAIT() asm volatile("s_waitcnt lgkmcnt(0)" ::: "memory")
__device__ __forceinline__ unsigned pk2(float lo, float hi) { return att::cvtpk(lo, hi); }
__device__ __forceinline__ float bflo(unsigned w) { return __uint_as_float(w << 16); }
__device__ __forceinline__ float bfhi(unsigned w) { return __uint_as_float(w & 0xffff0000u); }
#define XB_TMO      128
#define XB_XCNT(j)  (256  + 64 * (j))
#define XB_XSUB(j)  (1280 + 64 * (j))
#define XB_XGEN(j)  (2304 + 64 * (j))
#define XB_TOP      3328
#define XB_TOPGEN   3392
#define XCD_BAR_WORDS 3456
#define XB_SPIN_CAP (1u << 18)

__device__ __forceinline__ unsigned xb_ld(unsigned* p)              { return __hip_atomic_load(p, __ATOMIC_RELAXED, __HIP_MEMORY_SCOPE_AGENT); }
__device__ __forceinline__ unsigned xb_add(unsigned* p, unsigned v) { return __hip_atomic_fetch_add(p, v, __ATOMIC_RELAXED, __HIP_MEMORY_SCOPE_AGENT); }
__device__ __forceinline__ unsigned xb_xcc_id() { return (unsigned)__builtin_amdgcn_s_getreg((3 << 11) | 20) & 0xFu; }
#define XB_SPIN(cond, bar) do { unsigned _sp = 0; while (cond) { __builtin_amdgcn_s_sleep(1); \
    if ((++_sp & 255u) == 0u) { if (xb_ld(&(bar)[XB_TMO])) break; if (_sp > XB_SPIN_CAP) { atomicAdd(&(bar)[XB_TMO], 1u); break; } } } } while (0)

struct XcdBarrier {
    unsigned* bar; unsigned x;
    volatile LAS unsigned* st;
};

__device__ __forceinline__ XcdBarrier xcd_barrier_post(unsigned* bar, volatile LAS unsigned* st) {
    XcdBarrier b; b.bar = bar; b.x = xb_xcc_id(); b.st = st;
    if (threadIdx.x == 0) (void)xb_add(&bar[XB_XCNT(b.x)], 1u);
    return b;
}
__device__ __forceinline__ void xcd_barrier_complete(unsigned* bar, unsigned x, unsigned& nloc, unsigned& nx) {
    const unsigned G = gridDim.x * gridDim.y * gridDim.z;
    unsigned sum, cnt, mine, sp = 0u;
    for (;;) {
        sum = 0u; cnt = 0u; mine = 0u;
#pragma unroll
        for (unsigned j = 0; j < 16; ++j) { const unsigned c = xb_ld(&bar[XB_XCNT(j)]); sum += c; cnt += (c > 0u) ? 1u : 0u; mine = (j == x) ? c : mine; }
        if (sum == G) break;
        __builtin_amdgcn_s_sleep(1);
        if ((++sp & 255u) == 0u) { if (xb_ld(&bar[XB_TMO])) break; if (sp > XB_SPIN_CAP) { atomicAdd(&bar[XB_TMO], 1u); break; } }
    }
    nloc = mine > 0u ? mine : 1u; nx = cnt > 0u ? cnt : 1u;
}

__device__ __forceinline__ void xcd_barrier(const XcdBarrier& b) {
    asm volatile("s_waitcnt vmcnt(0)" ::: "memory");
    __syncthreads();
    if (threadIdx.x == 0) {
        unsigned* bar = b.bar;
        __builtin_amdgcn_s_waitcnt(0);
        unsigned nloc = b.st[0], nx = b.st[1];
        if (nloc == 0u) { xcd_barrier_complete(bar, b.x, nloc, nx); b.st[0] = nloc; b.st[1] = nx; }
        const unsigned old = xb_add(&bar[XB_XSUB(b.x)], 1u);
        const unsigned gen = old / nloc;
        if (old + 1u == (gen + 1u) * nloc) {
            __builtin_amdgcn_fence(__ATOMIC_RELEASE, "agent");
            asm volatile("s_waitcnt vmcnt(0)" ::: "memory");
            const unsigned og = xb_add(&bar[XB_TOP], 1u);
            const unsigned tg = og / nx;
            if (og + 1u == (tg + 1u) * nx) xb_add(&bar[XB_TOPGEN], 1u);
            else XB_SPIN(xb_ld(&bar[XB_TOPGEN]) == tg, bar);
            __builtin_amdgcn_fence(__ATOMIC_ACQUIRE, "agent");
            xb_add(&bar[XB_XGEN(b.x)], 1u);
            asm volatile("s_waitcnt vmcnt(0)" ::: "memory");
        } else {
            XB_SPIN(xb_ld(&bar[XB_XGEN(b.x)]) == gen, bar);
            __builtin_amdgcn_fence(__ATOMIC_ACQUIRE, "agent");
            asm volatile("s_waitcnt vmcnt(0)" ::: "memory");
        }
    }
    __syncthreads();
}
struct Args { const float* in[N_IN]; float* out; unsigned char* ws; int ph_lo, ph_hi; };
static_assert(sizeof(Args) == 256, "Args has no padding bytes");
typedef const __attribute__((address_space(4))) Args* KA;
__device__ __forceinline__ KA kargs() { KA p = (KA)__builtin_amdgcn_kernarg_segment_ptr(); asm volatile("" : "+s"(p)); return p; }
struct Frame {
    LAS unsigned char* lds;
    volatile LAS unsigned* MISC;
    gu32* ctl;
    int tid, lane, wave, vcu, G;
};
__device__ __forceinline__ void relane(Frame& F) { int t = threadIdx.x; asm volatile("" : "+v"(t)); F.tid = t; F.lane = t & 63; F.wave = __builtin_amdgcn_readfirstlane(t >> 6); }
__device__ __forceinline__ float wave_sum(float v) {
#pragma unroll
    for (int o = 1; o < 64; o <<= 1) v += __shfl_xor(v, o);
    return v;
}
__device__ __forceinline__ float silu_f(float x) { return x / (1.0f + __expf(-x)); }

__device__ __forceinline__ void transpose_item(const float* __restrict__ W, int N, bf16* __restrict__ WT, int ldt, int k0, int n0, int rowbase, LAS float* scr, int lane) {
    float tv[32];
    { const float* wp = W + (size_t)(k0 + (lane >> 5)) * N + n0 + (lane & 31);
#pragma unroll
      for (int i = 0; i < 32; ++i) tv[i] = __builtin_nontemporal_load(wp + (size_t)(2 * i) * N); }
#pragma unroll
    for (int i = 0; i < 32; ++i) scr[(2 * i + (lane >> 5)) * 33 + (lane & 31)] = tv[i];
    LDS_WAIT(); asm volatile("" ::: "memory");
    const int c = lane & 7;
#pragma unroll
    for (int j = 0; j < 4; ++j) { const int n = (lane >> 3) + 8 * j; const LAS float* s = scr + (8 * c) * 33 + n;
        v4u o; o.x = pk2(s[0 * 33], s[1 * 33]); o.y = pk2(s[2 * 33], s[3 * 33]); o.z = pk2(s[4 * 33], s[5 * 33]); o.w = pk2(s[6 * 33], s[7 * 33]);
        *(v4u*)(WT + (size_t)(rowbase + n) * ldt + k0 + 8 * c) = o; }
    LDS_WAIT(); asm volatile("" ::: "memory");
}

__device__ __forceinline__ void transpose_item_i8(const float* __restrict__ W, int N, signed char* __restrict__ WT, int ldt, int k0, int n0, int rowbase, float qs, LAS float* scr, int lane) {
    float tv[32];
    { const float* wp = W + (size_t)(k0 + (lane >> 5)) * N + n0 + (lane & 31);
#pragma unroll
      for (int i = 0; i < 32; ++i) tv[i] = __builtin_nontemporal_load(wp + (size_t)(2 * i) * N); }
#pragma unroll
    for (int i = 0; i < 32; ++i) scr[(2 * i + (lane >> 5)) * 33 + (lane & 31)] = tv[i];
    LDS_WAIT(); asm volatile("" ::: "memory");
    const int c = lane & 3;
#pragma unroll
    for (int j = 0; j < 2; ++j) { const int n = (lane >> 2) + 16 * j; const LAS float* s = scr + (16 * c) * 33 + n; v4u o;
#pragma unroll
        for (int d = 0; d < 4; ++d) { unsigned w = 0u;
#pragma unroll
            for (int i = 0; i < 4; ++i) { const float f = fminf(fmaxf(s[(4 * d + i) * 33] * qs, -127.0f), 127.0f); w |= ((unsigned)((int)__builtin_rintf(f)) & 255u) << (8 * i); }
            o[d] = w; }
        *(v4u*)(WT + (size_t)(rowbase + n) * ldt + k0 + 16 * c) = o; }
    LDS_WAIT(); asm volatile("" ::: "memory");
}

__device__ __forceinline__ void transpose_item_f8(const float* __restrict__ W, int N, unsigned char* __restrict__ WT, int ldt, int k0, int n0, int rowbase, float qs, LAS float* scr, int lane) {
    float tv[32];
    { const float* wp = W + (size_t)(k0 + (lane >> 5)) * N + n0 + (lane & 31);
#pragma unroll
      for (int i = 0; i < 32; ++i) tv[i] = __builtin_nontemporal_load(wp + (size_t)(2 * i) * N); }
#pragma unroll
    for (int i = 0; i < 32; ++i) scr[(2 * i + (lane >> 5)) * 33 + (lane & 31)] = tv[i];
    LDS_WAIT(); asm volatile("" ::: "memory");
    const int c = lane & 3;
#pragma unroll
    for (int j = 0; j < 2; ++j) { const int n = (lane >> 2) + 16 * j; const LAS float* s = scr + (16 * c) * 33 + n; v4u o;
#pragma unroll
        for (int d = 0; d < 4; ++d) { float f[4];
#pragma unroll
            for (int i = 0; i < 4; ++i) f[i] = fminf(fmaxf(s[(4 * d + i) * 33] * qs, -448.0f), 448.0f);
            int w = __builtin_amdgcn_cvt_pk_fp8_f32(f[0], f[1], 0, false); w = __builtin_amdgcn_cvt_pk_fp8_f32(f[2], f[3], w, true); o[d] = (unsigned)w; }
        *(v4u*)(WT + (size_t)(rowbase + n) * ldt + k0 + 16 * c) = o; }
    LDS_WAIT(); asm volatile("" ::: "memory");
}

__device__ __forceinline__ void sincos_d(float af, float& c, float& s) {
    const double a = (double)af;
    const double q = __builtin_rint(a * 0.63661977236758134308);
    double r = __builtin_fma(-q, 1.57079632679489655800e+00, a); r = __builtin_fma(-q, 6.12323399573676603587e-17, r);
    const double r2 = r * r;
    double sp = -7.6471637318198164759e-13; sp = sp * r2 + 1.6059043836821614599e-10; sp = sp * r2 - 2.5052108385441718775e-08; sp = sp * r2 + 2.7557319223985890653e-06;
    sp = sp * r2 - 1.9841269841269841270e-04; sp = sp * r2 + 8.3333333333333333333e-03; sp = sp * r2 - 1.6666666666666666667e-01; const double sn = r + r * r2 * sp;
    double cp = 4.7794773323873852974e-14; cp = cp * r2 - 1.1470745597729724714e-11; cp = cp * r2 + 2.0876756987868098979e-09; cp = cp * r2 - 2.7557319223985890653e-07;
    cp = cp * r2 + 2.4801587301587301587e-05; cp = cp * r2 - 1.3888888888888888889e-03; cp = cp * r2 + 4.1666666666666666667e-02; cp = cp * r2 - 0.5; const double cs = 1.0 + r2 * cp;
    const int qi = (int)q & 3;
    const double cc = (qi == 0) ? cs : (qi == 1) ? -sn : (qi == 2) ? -cs : sn;
    const double ss = (qi == 0) ? sn : (qi == 1) ? cs : (qi == 2) ? -sn : -cs;
    c = (float)cc; s = (float)ss;
}

#define MEMFENCE() asm volatile("" ::: "memory")
__device__ __forceinline__ void p0_prologue(KA a, Frame& F) {
    relane(F);
    unsigned char* ws = a->ws;
    float* MOD = (float*)(ws + WS_MOD);
    if ((int)blockIdx.x < 192) {
        LAS float* sl = (LAS float*)F.lds + 4096;
        for (int i = F.tid; i < 5 * 1024; i += NWAVES * 64) { const int v = i >> 10, k = i & 1023; const float cv = (v < 4) ? a->in[I_C][v * 1024 + k] : a->in[I_CCTX][k]; sl[i] = silu_f(cv); }
        __syncthreads();
        for (int it = blockIdx.x; it < 192; it += F.G) {
            const int l = it / 96, col = (it % 96) * 64 + F.lane;
            const float* W = a->in[I_WADA] + (size_t)l * 1024 * 6144;
            float acc[5] = {0.f, 0.f, 0.f, 0.f, 0.f};
#pragma unroll 8
            for (int kk = 0; kk < 128; ++kk) { const int k = F.wave * 128 + kk; const float w = W[(size_t)k * 6144 + col];
#pragma unroll
                for (int v = 0; v < 5; ++v) acc[v] += sl[v * 1024 + k] * w; }
            LAS float* red = (LAS float*)F.lds;
#pragma unroll
            for (int v = 0; v < 5; ++v) red[(F.wave * 5 + v) * 64 + F.lane] = acc[v];
            __syncthreads();
            if (F.wave < 5) { float s2 = a->in[I_BADA][l * 6144 + col];
#pragma unroll
                for (int w = 0; w < 8; ++w) s2 += red[(w * 5 + F.wave) * 64 + F.lane];
                MOD[(l * 5 + F.wave) * 6144 + col] = s2; }
            __syncthreads();
        }
    }
    for (int it = blockIdx.x; it < 96; it += F.G) {
        const int l = it / 48, e = (it % 48) / 3, which = it % 3;
        float ss = 0.f;
        if (which < 2) { const float* W = (which ? a->in[I_WU] : a->in[I_WG]) + ((size_t)l * NE + e) * 1024 * 2048;
            for (int i = 0; i < 32; ++i) { const f32x4 v = *(const f32x4*)(W + (size_t)(32 * i) * 2048 + 4 * F.tid); ss += (v.x * v.x + v.y * v.y) + (v.z * v.z + v.w * v.w); } }
        else { const float* W = a->in[I_WD] + ((size_t)l * NE + e) * 2048 * 1024;
            for (int i = 0; i < 64; ++i) { const f32x2 v = *(const f32x2*)(W + (size_t)(32 * i) * 1024 + 2 * F.tid); ss += v.x * v.x + v.y * v.y; } }
        ss = wave_sum(ss);
        LAS float* red = (LAS float*)F.lds;
        if (F.lane == 0) red[F.wave] = ss;
        __syncthreads();
        if (F.tid == 0) { float t = 0.f; for (int w = 0; w < NWAVES; ++w) t += red[w]; const float rms = fmaxf(sqrtf(t * (1.0f / 65536.0f)), 1e-20f);
            ((float*)(ws + WS_SW))[l * 48 + 3 * e + which] = (which < 2) ? 5.0f * rms * (1.0f / 127.0f) : rms * (1.0f / 16.0f); }
        __syncthreads();
    }
    if ((int)blockIdx.x == 192 % F.G && F.wave == 0) {
        float* LAM = (float*)(ws + WS_LAM);
        for (int l = 0; l < NLAYER; ++l) {
            const float p1 = F.lane < 32 ? a->in[I_LQ1][l * 32 + F.lane] * a->in[I_LK1][l * 32 + F.lane] : 0.f;
            const float p2 = F.lane < 32 ? a->in[I_LQ2][l * 32 + F.lane] * a->in[I_LK2][l * 32 + F.lane] : 0.f;
            const float s1 = wave_sum(p1), s2 = wave_sum(p2);
            const float li = 0.8f - 0.6f * expf(-0.3f * (float)l);
            if (F.lane == 0) { LAM[2 * l] = expf(s1) - expf(s2) + li; LAM[2 * l + 1] = li; }
        }
    }
    if ((int)blockIdx.x == 193 % F.G) {
        f32x2* TA_R = (f32x2*)(ws + WS_TAB + TAB_AROW); f32x2* TA_C = (f32x2*)(ws + WS_TAB + TAB_ACOL); f32x2* TG_R = (f32x2*)(ws + WS_TAB + TAB_GROW); f32x2* TG_C = (f32x2*)(ws + WS_TAB + TAB_GCOL);
        const double b8 = 1.0 / __builtin_sqrt(__builtin_sqrt(__builtin_sqrt(10000.0))), b16 = 1.0 / __builtin_sqrt(__builtin_sqrt(__builtin_sqrt(__builtin_sqrt(10000.0))));
        for (int e = F.tid; e < 4608; e += NWAVES * 64) {
            int pos, i, nf; f32x2* dst;
            if (e < 1024) { pos = e >> 3; i = e & 7; nf = 8; dst = TA_R + e; }
            else if (e < 1536) { const int r = e - 1024; pos = r >> 3; i = r & 7; nf = 8; dst = TA_C + r; }
            else if (e < 3584) { const int r = e - 1536; pos = r >> 4; i = r & 15; nf = 16; dst = TG_R + r; }
            else { const int r = e - 3584; pos = r >> 4; i = r & 15; nf = 16; dst = TG_C + r; }
            double inv = 1.0; const double bb = (nf == 8) ? b8 : b16;
            for (int j = 0; j < i; ++j) inv *= bb;
            const float ang = (float)pos * (float)inv;
            float c, s; sincos_d(ang, c, s);
            *dst = (f32x2){c, s};
        }
    }
    for (int it = blockIdx.x; it < 896; it += F.G) {
        const int l = it / 448; int r = it % 448;
        int kb, nb, R, roff, ncols, orow0; const float *Wu, *gg;
        if (r < 192) { kb = r / 6; nb = r % 6; R = 256; roff = 0; ncols = 384; orow0 = ZQ + nb * 64; Wu = a->in[I_WUQ] + (size_t)l * 256 * 384; gg = a->in[I_GCQ] + l * 256; }
        else { r -= 192; kb = r / 8; nb = r % 8; R = 128; roff = 256; ncols = 512; orow0 = ZKV + nb * 64; Wu = a->in[I_WUKV] + (size_t)l * 128 * 512; gg = a->in[I_GCKV] + l * 128; }
        const float* Win = a->in[I_WIN] + (size_t)l * 1024 * INC;
        LAS float* As = (LAS float*)F.lds; LAS float* Bs = As + 32 * 257;
        for (int idx = F.tid; idx < 32 * R; idx += NWAVES * 64) { const int kk = idx / R, rr = idx % R; As[kk * 257 + rr] = Win[(size_t)(kb * 32 + kk) * INC + roff + rr]; }
        for (int idx = F.tid; idx < R * 64; idx += NWAVES * 64) { const int rr = idx >> 6, n = idx & 63; Bs[rr * 64 + n] = gg[rr] * Wu[(size_t)rr * ncols + nb * 64 + n]; }
        __syncthreads();
        const int kk = F.tid & 31, ng = F.tid >> 5;
        f32x4 acc = (f32x4){0.f, 0.f, 0.f, 0.f};
        for (int rr = 0; rr < R; ++rr) { const float av = As[kk * 257 + rr]; const f32x4 bv = *(const LAS f32x4*)(Bs + rr * 64 + ng * 4); acc += av * bv; }
        bf16* Wc = (bf16*)(ws + WS_WCAT) + (size_t)l * ZP * 1024;
#pragma unroll
        for (int j = 0; j < 4; ++j) Wc[(size_t)(orow0 + ng * 4 + j) * 1024 + kb * 32 + kk] = (bf16)(pk2(acc[j], 0.f) & 0xffffu);
        __syncthreads();
    }
    {
        LAS float* scr = (LAS float*)(F.lds + F.wave * 16384);
        const int gw = F.vcu * NWAVES + F.wave, NGW = F.G * NWAVES;
        constexpr int I_IN = 16 * 61, I_O = 16 * 32, PER_L = I_IN + I_O;
        for (int it = gw; it < NLAYER * PER_L; it += NGW) {
            const int l = it / PER_L; int r = it % PER_L;
            if (r < I_IN) { const int kb = r / 61, nb = r % 61; transpose_item(a->in[I_WIN] + (size_t)l * 1024 * INC, INC, (bf16*)(ws + WS_WCAT) + (size_t)l * ZP * 1024, 1024, kb * 64, nb * 32, nb * 32, scr, F.lane); }
            else { r -= I_IN; const int kb = r / 32, nb = r % 32; transpose_item(a->in[I_WO] + (size_t)l * 1024 * 1024, 1024, (bf16*)(ws + WS_WO) + (size_t)l * 1024 * 1024, 1024, kb * 64, nb * 32, nb * 32, scr, F.lane); }
        }
        const int gt = F.vcu * (NWAVES * 64) + F.tid, NGT = F.G * NWAVES * 64;
        constexpr int PADV = (ZP - ZEND) * 1024 * 2 / 16;
        for (int i = gt; i < NLAYER * PADV; i += NGT) { const int l = i / PADV, j = i % PADV; ((v4u*)((bf16*)(ws + WS_WCAT) + ((size_t)l * ZP + ZEND) * 1024))[j] = (v4u){0u, 0u, 0u, 0u}; }
    }
}

__device__ __forceinline__ void phase_a(KA a, Frame& F, int l) {
    relane(F);
    unsigned char* ws = a->ws;
    const float* MOD = (const float*)(ws + WS_MOD);
    const int* INV = (const int*)(ws + WS_INV);
    const unsigned char* YE = (const unsigned char*)(ws + WS_YE);
    const bool fin = (l == NLAYER);
    const int nrows = fin ? LROWS : MROWS;
    const int gw = F.vcu * NWAVES + F.wave, NGW = F.G * NWAVES;
#define PA_LOAD(r, XF, XB, IV) do { if (l == 0) { const float* src_ = ((r) >= LROWS) ? a->in[I_CTX] + (size_t)((r) - LROWS) * 1024 : a->in[I_X] + (size_t)(r) * 1024; \
            _Pragma("unroll") for (int j = 0; j < 4; ++j) XF[j] = *(const f32x4*)(src_ + 4 * F.lane + 256 * j); } \
        else { const bf16* xb_ = (const bf16*)(ws + WS_XB) + (size_t)(r) * 1024; _Pragma("unroll") for (int j = 0; j < 4; ++j) XB[j] = *(const v2u*)(xb_ + 4 * F.lane + 256 * j); \
            IV = INV[(size_t)(r) * 16 + (F.lane & 15)]; } } while (0)
    f32x4 cf[4]; v2u cb[4]; int civ = -1;
#pragma unroll
    for (int j = 0; j < 4; ++j) { cf[j] = (f32x4){0.f, 0.f, 0.f, 0.f}; cb[j] = (v2u){0u, 0u}; }
    if (gw < nrows) PA_LOAD(gw, cf, cb, civ);
    for (int row = gw; row < nrows; row += NGW) {
        const bool isc = row >= LROWS; const int v = isc ? 4 : (row >> 13);
        bf16* xb = (bf16*)(ws + WS_XB) + (size_t)row * 1024;
        const int nrow = row + NGW; f32x4 nf[4]; v2u nb[4]; int niv = -1;
#pragma unroll
        for (int j = 0; j < 4; ++j) { nf[j] = cf[j]; nb[j] = cb[j]; }
        if (nrow < nrows) PA_LOAD(nrow, nf, nb, niv);
        f32x4 xv[4];
        if (l == 0) {
#pragma unroll
            for (int j = 0; j < 4; ++j) xv[j] = cf[j]; }
        else {
#pragma unroll
            for (int j = 0; j < 4; ++j) xv[j] = (f32x4){bflo(cb[j].x), bfhi(cb[j].x), bflo(cb[j].y), bfhi(cb[j].y)}; }
        if (l > 0) {
            const float* ga2 = MOD + ((l - 1) * 5 + v) * 6144 + 5 * 1024;
            f32x4 acc[4];
#pragma unroll
            for (int j = 0; j < 4; ++j) acc[j] = (f32x4){0.f, 0.f, 0.f, 0.f};
            unsigned sel = (unsigned)(__ballot(civ >= 0) & 0xFFFFull);
            while (sel) {
                int sl[4]; float on[4];
#pragma unroll
                for (int k = 0; k < 4; ++k) { if (sel) { const int e = __builtin_ctz(sel); sel &= sel - 1u; sl[k] = __builtin_amdgcn_readlane(civ, e); on[k] = 1.0f; } else { sl[k] = sl[0]; on[k] = 0.0f; } }
                unsigned w[4][4];
#pragma unroll
                for (int k = 0; k < 4; ++k) { const unsigned char* yr = YE + (size_t)sl[k] * 1024 + 4 * F.lane;
#pragma unroll
                    for (int j = 0; j < 4; ++j) w[k][j] = *(const unsigned*)(yr + 256 * j); }
#pragma unroll
                for (int k = 0; k < 4; ++k)
#pragma unroll
                    for (int j = 0; j < 4; ++j) { const f32x2 lo = __builtin_amdgcn_cvt_pk_f32_fp8((int)w[k][j], false), hi = __builtin_amdgcn_cvt_pk_f32_fp8((int)w[k][j], true);
                        acc[j] += on[k] * (f32x4){lo.x, lo.y, hi.x, hi.y}; }
            }
#pragma unroll
            for (int j = 0; j < 4; ++j) { const f32x4 g = *(const f32x4*)(ga2 + 4 * F.lane + 256 * j); xv[j] += g * (acc[j] * (1.0f / YE_SCALE)); }
        }
#pragma unroll
        for (int j = 0; j < 4; ++j) { cf[j] = nf[j]; cb[j] = nb[j]; }
        civ = niv;
        if (fin) {
#pragma unroll
            for (int j = 0; j < 4; ++j) *(f32x4*)(a->out + (size_t)row * 1024 + 4 * F.lane + 256 * j) = xv[j];
            continue; }
#pragma unroll
        for (int j = 0; j < 4; ++j) { v2u w; w.x = pk2(xv[j].x, xv[j].y); w.y = pk2(xv[j].z, xv[j].w); *(v2u*)(xb + 4 * F.lane + 256 * j) = w; }
        float ss = 0.f;
#pragma unroll
        for (int j = 0; j < 4; ++j) ss += (xv[j].x * xv[j].x + xv[j].y * xv[j].y) + (xv[j].z * xv[j].z + xv[j].w * xv[j].w);
        const float rstd = rsqrtf(wave_sum(ss) * (1.0f / 1024.0f) + EPSF);
        const float* g1 = a->in[I_GN1] + l * 1024; const float* sh = MOD + (l * 5 + v) * 6144; const float* sc = sh + 1024;
        float am = 0.f;
#pragma unroll
        for (int j = 0; j < 4; ++j) { const int c0 = 4 * F.lane + 256 * j; const f32x4 g = *(const f32x4*)(g1 + c0), s1 = *(const f32x4*)(sc + c0), b1 = *(const f32x4*)(sh + c0);
            xv[j] = xv[j] * rstd * g * (1.0f + s1) + b1;
            am = fmaxf(fmaxf(am, fmaxf(fabsf(xv[j].x), fabsf(xv[j].y))), fmaxf(fabsf(xv[j].z), fabsf(xv[j].w))); }
#pragma unroll
        for (int o = 1; o < 64; o <<= 1) am = fmaxf(am, __shfl_xor(am, o));
        const float qs = am > 0.f ? 127.0f / am : 0.f;
        signed char* h8 = (signed char*)(ws + WS_H) + (size_t)row * 1024;
#pragma unroll
        for (int j = 0; j < 4; ++j) { const int q0 = (int)__builtin_rintf(xv[j].x * qs), q1 = (int)__builtin_rintf(xv[j].y * qs), q2 = (int)__builtin_rintf(xv[j].z * qs), q3 = (int)__builtin_rintf(xv[j].w * qs);
            *(unsigned*)(h8 + 4 * F.lane + 256 * j) = (unsigned)(q0 & 255) | ((unsigned)(q1 & 255) << 8) | ((unsigned)(q2 & 255) << 16) | ((unsigned)(q3 & 255) << 24); }
        if (F.lane == 0) ((float*)(ws + WS_SA))[row] = am * (1.0f / 127.0f);
    }
#undef PA_LOAD
    if (l == 0) {
        const bf16* Wc = (const bf16*)(ws + WS_WCAT); signed char* W8 = (signed char*)(ws + WS_WCAT8); float* SWC = (float*)(ws + WS_SWC);
        for (int r = gw; r < NLAYER * ZP; r += NGW) {
            float wv[16]; float am = 0.f;
#pragma unroll
            for (int j = 0; j < 2; ++j) { const v4u w = *(const v4u*)(Wc + (size_t)r * 1024 + 8 * F.lane + 512 * j);
                wv[8 * j + 0] = bflo(w.x); wv[8 * j + 1] = bfhi(w.x); wv[8 * j + 2] = bflo(w.y); wv[8 * j + 3] = bfhi(w.y); wv[8 * j + 4] = bflo(w.z); wv[8 * j + 5] = bfhi(w.z); wv[8 * j + 6] = bflo(w.w); wv[8 * j + 7] = bfhi(w.w); }
#pragma unroll
            for (int i = 0; i < 16; ++i) am = fmaxf(am, fabsf(wv[i]));
#pragma unroll
            for (int o = 1; o < 64; o <<= 1) am = fmaxf(am, __shfl_xor(am, o));
            const float qs = am > 0.f ? 127.0f / am : 0.f;
#pragma unroll
            for (int j = 0; j < 2; ++j) { unsigned w0 = 0u, w1 = 0u;
#pragma unroll
                for (int i = 0; i < 4; ++i) { w0 |= ((unsigned)((int)__builtin_rintf(wv[8 * j + i] * qs)) & 255u) << (8 * i); w1 |= ((unsigned)((int)__builtin_rintf(wv[8 * j + 4 + i] * qs)) & 255u) << (8 * i); }
                v2u o; o.x = w0; o.y = w1; *(v2u*)(W8 + (size_t)r * 1024 + 8 * F.lane + 512 * j) = o; }
            if (F.lane == 0) SWC[r] = am * (1.0f / 127.0f);
        }
    }
}

__device__ __forceinline__ void ld8(const bf16* p, float* f) { const v4u w = *(const v4u*)p; f[0] = bflo(w.x); f[1] = bfhi(w.x); f[2] = bflo(w.y); f[3] = bfhi(w.y); f[4] = bflo(w.z); f[5] = bfhi(w.z); f[6] = bflo(w.w); f[7] = bfhi(w.w); }
__device__ __forceinline__ v4u pk8(const float* f) { v4u w; w.x = pk2(f[0], f[1]); w.y = pk2(f[2], f[3]); w.z = pk2(f[4], f[5]); w.w = pk2(f[6], f[7]); return w; }
template <int N> __device__ __forceinline__ float ssq_row(const bf16* p) { float s = 0.f;
#pragma unroll
    for (int c = 0; c < N / 8; ++c) { float f[8]; ld8(p + 8 * c, f);
#pragma unroll
        for (int i = 0; i < 8; ++i) s += f[i] * f[i];
        if ((c & 7) == 7) MEMFENCE(); }
    return s; }
template <int NP> __device__ __forceinline__ void rope_pairs(float* x, const f32x2* trow, const f32x2* tcol) {
#pragma unroll
    for (int i = 0; i < NP; ++i) { const f32x2 cs = (i < NP / 2) ? trow[i] : tcol[i - NP / 2];
        const float x0 = x[2 * i], x1 = x[2 * i + 1]; x[2 * i] = x0 * cs.x - x1 * cs.y; x[2 * i + 1] = x0 * cs.y + x1 * cs.x; }
}
__device__ __forceinline__ void store_v_tile(char* vt, int lane, const float* v  ) {
    char* p = vt + (lane >> 4) * 1024 + ((lane >> 3) & 1) * 512 + (lane & 7) * 64;
#pragma unroll
    for (int d = 0; d < 2; ++d)
#pragma unroll
        for (int c = 0; c < 4; ++c) *(v4u*)(p + d * 4096 + c * 16) = pk8(v + d * 32 + c * 8);
}
template <bool ROPE> __device__ __forceinline__ v4u proc8(v4u w, float r, const float* g, const f32x2* cs, float qs) {
    float f[8] = {bflo(w.x), bfhi(w.x), bflo(w.y), bfhi(w.y), bflo(w.z), bfhi(w.z), bflo(w.w), bfhi(w.w)};
#pragma unroll
    for (int i = 0; i < 8; ++i) f[i] *= r * g[i];
    if (ROPE) {
#pragma unroll
        for (int i = 0; i < 4; ++i) { const f32x2 t = cs[i]; const float x0 = f[2 * i], x1 = f[2 * i + 1]; f[2 * i] = x0 * t.x - x1 * t.y; f[2 * i + 1] = x0 * t.y + x1 * t.x; }
    }
#pragma unroll
    for (int i = 0; i < 8; ++i) f[i] *= qs;
    return pk8(f);
}
__device__ __forceinline__ v2u pk8_f8(const float* f) { int w0 = __builtin_amdgcn_cvt_pk_fp8_f32(f[0], f[1], 0, false); w0 = __builtin_amdgcn_cvt_pk_fp8_f32(f[2], f[3], w0, true);
    int w1 = __builtin_amdgcn_cvt_pk_fp8_f32(f[4], f[5], 0, false); w1 = __builtin_amdgcn_cvt_pk_fp8_f32(f[6], f[7], w1, true); return (v2u){(unsigned)w0, (unsigned)w1}; }
template <bool ROPE> __device__ __forceinline__ v2u proc8f(v4u w, float r, const float* g, const f32x2* cs, float qs) {
    float f[8] = {bflo(w.x), bfhi(w.x), bflo(w.y), bfhi(w.y), bflo(w.z), bfhi(w.z), bflo(w.w), bfhi(w.w)};
#pragma unroll
    for (int i = 0; i < 8; ++i) f[i] *= r * g[i];
    if (ROPE) {
#pragma unroll
        for (int i = 0; i < 4; ++i) { const f32x2 t = cs[i]; const float x0 = f[2 * i], x1 = f[2 * i + 1]; f[2 * i] = x0 * t.x - x1 * t.y; f[2 * i + 1] = x0 * t.y + x1 * t.x; }
    }
#pragma unroll
    for (int i = 0; i < 8; ++i) f[i] *= qs;
    return pk8_f8(f);
}
__device__ __forceinline__ att::i32x6a fp6_group(const v4u& c0, const v4u& c1, const v4u& c2, const v4u& c3) {
    att::u32x16 w; w[0] = c0.x; w[1] = c0.y; w[2] = c0.z; w[3] = c0.w; w[4] = c1.x; w[5] = c1.y; w[6] = c1.z; w[7] = c1.w; w[8] = c2.x; w[9] = c2.y; w[10] = c2.z; w[11] = c2.w; w[12] = c3.x; w[13] = c3.y; w[14] = c3.z; w[15] = c3.w;
    return att::cvt_fp6x32(w); }
__device__ __forceinline__ void store_qgroup(unsigned char* q, const att::i32x6a& g) { *(v2u*)q = (v2u){(unsigned)g[0], (unsigned)g[1]}; *(v2u*)(q + 8) = (v2u){(unsigned)g[2], (unsigned)g[3]}; *(v2u*)(q + 16) = (v2u){(unsigned)g[4], (unsigned)g[5]}; }
__device__ __forceinline__ void store_kgroup(char* kt, int pb, int j, int lane, const att::i32x6a& g) {
    *(v4u*)(kt + j * 1024 + lane * 16) = (v4u){(unsigned)g[0], (unsigned)g[1], (unsigned)g[2], (unsigned)g[3]}; *(v2u*)(kt + pb + j * 512 + lane * 8) = (v2u){(unsigned)g[4], (unsigned)g[5]}; }
__device__ __forceinline__ v4u ldz8(const unsigned char* p) { const v2u r = *(const v2u*)p;
    const f32x2 a = __builtin_amdgcn_cvt_pk_f32_fp8((int)r.x, false), b = __builtin_amdgcn_cvt_pk_f32_fp8((int)r.x, true), c = __builtin_amdgcn_cvt_pk_f32_fp8((int)r.y, false), d = __builtin_amdgcn_cvt_pk_f32_fp8((int)r.y, true);
    v4u w; w.x = pk2(a.x, a.y); w.y = pk2(b.x, b.y); w.z = pk2(c.x, c.y); w.w = pk2(d.x, d.y); return w; }
__device__ __forceinline__ float ssq8(v4u w) { const float f[8] = {bflo(w.x), bfhi(w.x), bflo(w.y), bfhi(w.y), bflo(w.z), bfhi(w.z), bflo(w.w), bfhi(w.w)}; float s = 0.f;
#pragma unroll
    for (int i = 0; i < 8; ++i) s += f[i] * f[i];
    return s; }
__device__ __forceinline__ v4u scale8(v4u w, float r) { float f[8] = {bflo(w.x), bfhi(w.x), bflo(w.y), bfhi(w.y), bflo(w.z), bfhi(w.z), bflo(w.w), bfhi(w.w)};
#pragma unroll
    for (int i = 0; i < 8; ++i) f[i] *= r;
    return pk8(f); }
__device__ __forceinline__ void store_v_tile_pk(char* vt, int lane, const v4u* w) {
    char* p = vt + (lane >> 4) * 1024 + ((lane >> 3) & 1) * 512 + (lane & 7) * 64;
#pragma unroll
    for (int c = 0; c < 8; ++c) *(v4u*)(p + (c >> 2) * 4096 + (c & 3) * 16) = w[c];
}
__device__ __forceinline__ void store_v_tile_f8(char* vt, int lane, const v4u* w, float sc, LAS unsigned char* scr) {
    LAS unsigned char* p = scr + (2 * ((lane >> 2) & 1) + (lane >> 5)) * 1024 + 4 * ((lane >> 3) & 3) + (lane & 3);
#pragma unroll
    for (int c = 0; c < 8; ++c) { const float f[8] = {bflo(w[c].x), bfhi(w[c].x), bflo(w[c].y), bfhi(w[c].y), bflo(w[c].z), bfhi(w[c].z), bflo(w[c].w), bfhi(w[c].w)};
#pragma unroll
        for (int i = 0; i < 8; i += 2) { const int b8 = __builtin_amdgcn_cvt_pk_fp8_f32(f[i] * sc, f[i + 1] * sc, 0, false);
            p[(8 * c + i) * 16] = (unsigned char)b8; p[(8 * c + i + 1) * 16] = (unsigned char)(b8 >> 8); } }
    LDS_WAIT(); asm volatile("" ::: "memory");
#pragma unroll
    for (int i = 0; i < 4; ++i) *(v4u*)(vt + i * 1024 + lane * 16) = *(const LAS v4u*)(scr + i * 1024 + lane * 16);
    LDS_WAIT(); asm volatile("" ::: "memory");
}
__device__ __forceinline__ void phase_c(KA a, Frame& F, int l) {
    relane(F);
    unsigned char* ws = a->ws;
    const unsigned char* Z = (const unsigned char*)(ws + WS_Z); const float* SSQ = (const float*)(ws + WS_SSQ);
    unsigned char* qkv = ws + WS_QKV;
    LAS unsigned char* vscr = (LAS unsigned char*)F.lds + F.wave * 4096;
    const f32x2* TA_R = (const f32x2*)(ws + WS_TAB + TAB_AROW); const f32x2* TA_C = (const f32x2*)(ws + WS_TAB + TAB_ACOL);
    const f32x2* TG_R = (const f32x2*)(ws + WS_TAB + TAB_GROW); const f32x2* TG_C = (const f32x2*)(ws + WS_TAB + TAB_GCOL);
    const int gw = F.vcu * NWAVES + F.wave, NGW = F.G * NWAVES, lane = F.lane;
    for (int id = gw; id < 528 * 32; id += NGW) {
        const int tile = id % 528, job = id / 528;
        const int b = tile / NKT, tt = tile % NKT; const bool isc = tt >= 128;
        const int zrow = isc ? LROWS + b * CL + (tt - 128) * 64 + lane : b * SEQ + tt * 64 + lane;
        const int tok = tt * 64 + lane;
        const unsigned char* zr = Z + (size_t)zrow * ZP;
        const f32x2* tar = TA_R + (isc ? 0 : tt) * 8; const f32x2* tac = TA_C + lane * 8;
        const f32x2* tgr = TG_R + (isc ? 0 : tt) * 16; const f32x2* tgc = TG_C + lane * 16;
        MEMFENCE();
        if (job < 4) {
            const int h = job;
            float r1; { const f32x4 s0 = *(const f32x4*)(SSQ + (size_t)zrow * 12), s1 = *(const f32x4*)(SSQ + (size_t)zrow * 12 + 4); r1 = rsqrtf((((s0.x + s0.y) + (s0.z + s0.w)) + ((s1.x + s1.y) + (s1.z + s1.w))) * (1.0f / 256.0f) + EPSF); }
            v4u w[12]; float ss = 0.f;
#pragma unroll
            for (int c = 0; c < 12; ++c) { w[c] = ldz8(zr + ZQ + h * 96 + 8 * c); ss += ssq8(w[c]); }
            MEMFENCE();
            const float r = r1 * rsqrtf(ss * r1 * r1 * (1.0f / 96.0f) + EPSF); const float* g = a->in[I_GMQ] + l * 96;
            const float qs = att::FQ96;
            unsigned char* q = (unsigned char*)(qkv + QO_QM) + ((size_t)(b * 4 + h) * NTOKB + tok) * 72;
#pragma unroll
            for (int gq = 0; gq < 3; ++gq) { v4u o[4];
#pragma unroll
                for (int cc = 0; cc < 4; ++cc) { const int c = 4 * gq + cc;
                    if (c < 8 || isc) o[cc] = proc8<false>(w[c], r, g + 8 * c, nullptr, qs);
                    else o[cc] = proc8<true>(w[c], r, g + 8 * c, (c < 10) ? tar + 4 * (c - 8) : tac + 4 * (c - 10), qs); }
                store_qgroup(q + 24 * gq, fp6_group(o[0], o[1], o[2], o[3])); MEMFENCE(); }
        } else if (job < 8) {
            const int h = job - 4;
            float r1; { const f32x4 s2 = *(const f32x4*)(SSQ + (size_t)zrow * 12 + 8); r1 = rsqrtf(((s2.x + s2.y) + (s2.z + s2.w)) * (1.0f / 128.0f) + EPSF); }
            v4u w[12]; float ss = 0.f, s2 = 0.f;
#pragma unroll
            for (int c = 0; c < 8; ++c) { w[c] = ldz8(zr + ZKV + h * 128 + 8 * c); ss += ssq8(w[c]); }
#pragma unroll
            for (int c = 0; c < 4; ++c) { w[8 + c] = ldz8(zr + 384 + 8 * c); s2 += ssq8(w[8 + c]); }
            MEMFENCE();
            const float r2 = rsqrtf((ss * r1 * r1 + s2) * (1.0f / 96.0f) + EPSF); const float* g = a->in[I_GMK] + l * 96;
            char* kt = (char*)(qkv + QO_KM) + ((size_t)(b * 4 + h) * NKT + tt) * 5120;
#pragma unroll
            for (int gq = 0; gq < 3; ++gq) { v4u o[4];
#pragma unroll
                for (int cc = 0; cc < 4; ++cc) { const int c = 4 * gq + cc;
                    if (c < 8) o[cc] = proc8<false>(w[c], r1 * r2, g + 8 * c, nullptr, 1.0f);
                    else if (isc) o[cc] = proc8<false>(w[c], r2, g + 8 * c, nullptr, 1.0f);
                    else o[cc] = proc8<true>(w[c], r2, g + 8 * c, (c < 10) ? tar + 4 * (c - 8) : tac + 4 * (c - 10), 1.0f); }
                store_kgroup(kt, 3072, gq, lane, fp6_group(o[0], o[1], o[2], o[3])); MEMFENCE(); }
            v4u vw[8];
#pragma unroll
            for (int c = 0; c < 8; ++c) vw[c] = ldz8(zr + ZKV + h * 128 + 64 + 8 * c);
            store_v_tile_f8((char*)(qkv + QO_VM) + ((size_t)(b * 4 + h) * NKT + tt) * 4096, lane, vw, r1, vscr);
        } else if (job < 16) {
            const bool isk = job >= 12; const int h = (job - 8) & 3;
            const unsigned char* zp = zr + (isk ? 672 : 416) + h * 64; const float* g = (isk ? a->in[I_GDK] : a->in[I_GDQ]) + l * 32;
            const float qs = isk ? 1.0f : att::FQ32;
            v4u w[8]; float ss[2] = {0.f, 0.f};
#pragma unroll
            for (int c = 0; c < 8; ++c) { w[c] = ldz8(zp + 8 * c); ss[c >> 2] += ssq8(w[c]); }
            MEMFENCE();
            const float r0 = rsqrtf(ss[0] * (1.0f / 32.0f) + EPSF), r1 = rsqrtf(ss[1] * (1.0f / 32.0f) + EPSF);
            char* kt = (char*)(qkv + QO_KD) + ((size_t)(b * 4 + h) * NKT + tt) * 3072;
            unsigned char* q = (unsigned char*)(qkv + QO_QD) + ((size_t)(b * 4 + h) * NTOKB + tok) * 48;
#pragma unroll
            for (int gq = 0; gq < 2; ++gq) { v4u o[4];
#pragma unroll
                for (int cm = 0; cm < 4; ++cm) { const int c = 4 * gq + cm;
                    if (isc) o[cm] = proc8<false>(w[c], gq ? r1 : r0, g + 8 * cm, nullptr, qs);
                    else o[cm] = proc8<true>(w[c], gq ? r1 : r0, g + 8 * cm, (cm < 2) ? tar + 4 * cm : tac + 4 * (cm - 2), qs); }
                const att::i32x6a gr = fp6_group(o[0], o[1], o[2], o[3]);
                if (isk) store_kgroup(kt, 2048, gq, lane, gr); else store_qgroup(q + 24 * gq, gr);
                MEMFENCE(); }
        } else if (job < 20) {
            const int h = job - 16; v4u vw[8];
#pragma unroll
            for (int c = 0; c < 8; ++c) vw[c] = ldz8(zr + 928 + h * 64 + 8 * c);
            store_v_tile_f8((char*)(qkv + QO_VD) + ((size_t)(b * 4 + h) * NKT + tt) * 4096, lane, vw, 1.0f, vscr);
        } else if (job < 30) {
            const bool isk = job >= 28; const int h = isk ? job - 28 : job - 20;
            const unsigned char* zp = zr + (isk ? 1696 : 1184) + h * 64; const float* g = (isk ? a->in[I_GGK] : a->in[I_GGQ]) + l * 64;
            const float qs = isk ? 1.0f : att::FQ64;
            v4u w[8]; float ss = 0.f;
#pragma unroll
            for (int c = 0; c < 8; ++c) { w[c] = ldz8(zp + 8 * c); ss += ssq8(w[c]); }
            MEMFENCE();
            const float r = rsqrtf(ss * (1.0f / 64.0f) + EPSF);
            char* kt = (char*)(qkv + QO_KG) + ((size_t)(b * 2 + h) * NKT + tt) * 3072;
            unsigned char* q = (unsigned char*)(qkv + QO_QG) + ((size_t)(b * 8 + h) * NTOKB + tok) * 48;
#pragma unroll
            for (int gq = 0; gq < 2; ++gq) { v4u o[4];
#pragma unroll
                for (int cc = 0; cc < 4; ++cc) { const int c = 4 * gq + cc;
                    if (isc) o[cc] = proc8<false>(w[c], r, g + 8 * c, nullptr, qs);
                    else o[cc] = proc8<true>(w[c], r, g + 8 * c, (c < 4) ? tgr + 4 * c : tgc + 4 * (c - 4), qs); }
                const att::i32x6a gr = fp6_group(o[0], o[1], o[2], o[3]);
                if (isk) store_kgroup(kt, 2048, gq, lane, gr); else store_qgroup(q + 24 * gq, gr);
                MEMFENCE(); }
        } else {
            const int h = job - 30; v4u vw[8];
#pragma unroll
            for (int c = 0; c < 8; ++c) vw[c] = ldz8(zr + 1824 + h * 64 + 8 * c);
            store_v_tile_f8((char*)(qkv + QO_VG) + ((size_t)(b * 2 + h) * NKT + tt) * 4096, lane, vw, 1.0f, vscr);
        }
        MEMFENCE();
    }
}

#define ATT_UNIT(KD, NM) att::attn_unit_f8<KD, NM, ABL>
#define ATT_DIFF att::attn_unit_f8<32, 2, ABL>
template <int ABL>
__device__ __forceinline__ void phase_d(KA a, Frame& F, int l, bool last) {
    relane(F);
    unsigned char* ws = a->ws; unsigned char* qkv = ws + WS_QKV;
    bf16* ATT = (bf16*)(ws + (ABL ? WS_Z : WS_ATT));
    const float* LAM = (const float*)(ws + WS_LAM);
    const float lam = LAM[2 * l], oml = 1.0f - LAM[2 * l + 1];
    const float* gdo = a->in[I_GDO] + l * 64;
    ALDS char* lds = (ALDS char*)F.lds;
    const int nctx = last ? 0 : 64;
    for (int id = F.vcu; id < 512 + nctx; id += F.G) {
        int b, h, q0, t0, t1; size_t orow;
        if (id < 512) { const int x = (id & 255) >> 5; b = x >> 1; h = 2 * (x & 1) + (id >> 8); q0 = (id & 31) * 256; t0 = 0; t1 = NKT; orow = (size_t)b * SEQ + q0; }
        else { const int c = id - 512; b = c >> 4; h = c & 15; if (h >= 4) continue; q0 = SEQ; t0 = 128; t1 = NKT; orow = (size_t)LROWS + b * CL; }
        ATT_UNIT(96, 1)((const unsigned char*)(qkv + QO_QM) + ((size_t)(b * 4 + h) * NTOKB + q0) * 72, (const char*)(qkv + QO_KM) + (size_t)(b * 4 + h) * NKT * 5120,
                        (const char*)(qkv + QO_VM) + (size_t)(b * 4 + h) * NKT * 4096, t0, t1, ATT + orow * 1024 + h * 64, lds, 0.f, gdo, 0.f);
    }
    for (int id = 512 + F.vcu; id < 1024 + nctx; id += F.G) {
        int b, h, q0, t0, t1; size_t orow;
        if (id < 1024) { const int x = (id & 255) >> 5; b = x >> 1; h = 2 * (x & 1) + ((id >> 8) - 2); q0 = (id & 31) * 256; t0 = 0; t1 = NKT; orow = (size_t)b * SEQ + q0; }
        else { const int c = id - 1024; b = c >> 4; h = (c & 15) - 4; if (h < 0 || h >= 4) continue; q0 = SEQ; t0 = 128; t1 = NKT; orow = (size_t)LROWS + b * CL; }
        ATT_DIFF((const unsigned char*)(qkv + QO_QD) + ((size_t)(b * 4 + h) * NTOKB + q0) * 48, (const char*)(qkv + QO_KD) + (size_t)(b * 4 + h) * NKT * 3072,
                        (const char*)(qkv + QO_VD) + (size_t)(b * 4 + h) * NKT * 4096, t0, t1, ATT + orow * 1024 + 256 + h * 64, lds, lam, gdo, oml);
    }
    for (int id = 1024 + F.vcu; id < 2048 + nctx; id += F.G) {
        int b, h, q0, t0, t1; size_t orow;
        if (id < 2048) { const int x = (id & 255) >> 5; b = x >> 1; h = 4 * (x & 1) + ((id >> 8) - 4); q0 = (id & 31) * 256; t0 = 0; t1 = NKT; orow = (size_t)b * SEQ + q0; }
        else { const int c = id - 2048; b = c >> 4; h = (c & 15) - 8; if (h < 0) continue; q0 = SEQ; t0 = 128; t1 = NKT; orow = (size_t)LROWS + b * CL; }
        const int g = h >> 2;
        ATT_UNIT(64, 1)((const unsigned char*)(qkv + QO_QG) + ((size_t)(b * 8 + h) * NTOKB + q0) * 48, (const char*)(qkv + QO_KG) + (size_t)(b * 2 + g) * NKT * 3072,
                        (const char*)(qkv + QO_VG) + (size_t)(b * 2 + g) * NKT * 4096, t0, t1, ATT + orow * 1024 + 512 + h * 64, lds, 0.f, gdo, 0.f);
    }
}

template <int RB>
__device__ __forceinline__ void pf_rows(KA a, Frame& F, int l, int rbeg, int nrows, LAS float* wrT) {
    unsigned char* ws = a->ws;
    const float* MOD = (const float*)(ws + WS_MOD);
    float* AFF = (float*)(ws + WS_AFF); float* AFFC = (float*)(ws + WS_AFFC); int* INV = (int*)(ws + WS_INV);
    const int gw = F.vcu * NWAVES + F.wave, NGW = F.G * NWAVES;
#define PF_LOAD(r, XW, DW) do { const bf16* xb_ = (const bf16*)(ws + WS_XB) + (size_t)(r) * 1024; const bf16* dl_ = (const bf16*)(ws + WS_DELTA) + (size_t)(r) * 1024; \
        _Pragma("unroll") for (int j = 0; j < 4; ++j) { XW[j] = *(const v2u*)(xb_ + 4 * F.lane + 256 * j); DW[j] = *(const v2u*)(dl_ + 4 * F.lane + 256 * j); } } while (0)
    v2u cxw[RB][4], cdw[RB][4];
#pragma unroll
    for (int u = 0; u < RB; ++u)
#pragma unroll
        for (int j = 0; j < 4; ++j) { cxw[u][j] = (v2u){0u, 0u}; cdw[u][j] = (v2u){0u, 0u}; }
    if (rbeg + gw * RB < nrows) {
#pragma unroll
        for (int u = 0; u < RB; ++u) PF_LOAD(rbeg + gw * RB + u, cxw[u], cdw[u]); }
    for (int grp = gw; rbeg + grp * RB < nrows; grp += NGW) {
        const int row0 = rbeg + grp * RB; const bool isc = row0 >= LROWS; const int v = isc ? 4 : (row0 >> 13);
        f32x4 hv[RB][4]; float ss[RB];
#pragma unroll
        for (int u = 0; u < RB; ++u) { bf16* xb = (bf16*)(ws + WS_XB) + (size_t)(row0 + u) * 1024; ss[u] = 0.f;
#pragma unroll
            for (int j = 0; j < 4; ++j) { const int c0 = 4 * F.lane + 256 * j; const v2u w = cdw[u][j], xw = cxw[u][j];
                hv[u][j] = (f32x4){bflo(xw.x), bfhi(xw.x), bflo(xw.y), bfhi(xw.y)} + (f32x4){bflo(w.x), bfhi(w.x), bflo(w.y), bfhi(w.y)};
                v2u o; o.x = pk2(hv[u][j].x, hv[u][j].y); o.y = pk2(hv[u][j].z, hv[u][j].w); *(v2u*)(xb + c0) = o;
                ss[u] += (hv[u][j].x * hv[u][j].x + hv[u][j].y * hv[u][j].y) + (hv[u][j].z * hv[u][j].z + hv[u][j].w * hv[u][j].w); } }
        { const int ngrp = grp + NGW;
          if (rbeg + ngrp * RB < nrows) {
#pragma unroll
              for (int u = 0; u < RB; ++u) PF_LOAD(rbeg + ngrp * RB + u, cxw[u], cdw[u]); } }
        float rstd[RB];
#pragma unroll
        for (int u = 0; u < RB; ++u) rstd[u] = rsqrtf(wave_sum(ss[u]) * (1.0f / 1024.0f) + EPSF);
        const float* g2 = a->in[I_GN2] + l * 1024; const float* sh = MOD + (l * 5 + v) * 6144 + 3 * 1024; const float* sc = sh + 1024;
        float am[RB];
#pragma unroll
        for (int u = 0; u < RB; ++u) am[u] = 0.f;
#pragma unroll
        for (int j = 0; j < 4; ++j) { const int c0 = 4 * F.lane + 256 * j; const f32x4 g = *(const f32x4*)(g2 + c0), s1 = *(const f32x4*)(sc + c0), b1 = *(const f32x4*)(sh + c0);
#pragma unroll
            for (int u = 0; u < RB; ++u) { hv[u][j] = hv[u][j] * rstd[u] * g * (1.0f + s1) + b1;
                am[u] = fmaxf(fmaxf(am[u], fmaxf(fabsf(hv[u][j].x), fabsf(hv[u][j].y))), fmaxf(fabsf(hv[u][j].z), fabsf(hv[u][j].w))); } }
#pragma unroll
        for (int o = 1; o < 64; o <<= 1) {
#pragma unroll
            for (int u = 0; u < RB; ++u) am[u] = fmaxf(am[u], __shfl_xor(am[u], o)); }
#pragma unroll
        for (int u = 0; u < RB; ++u) { const float qs = am[u] > 0.f ? 127.0f / am[u] : 0.f;
            signed char* h8 = (signed char*)(ws + WS_H) + (size_t)(row0 + u) * 1024;
#pragma unroll
            for (int j = 0; j < 4; ++j) { const int q0 = (int)__builtin_rintf(hv[u][j].x * qs), q1 = (int)__builtin_rintf(hv[u][j].y * qs), q2 = (int)__builtin_rintf(hv[u][j].z * qs), q3 = (int)__builtin_rintf(hv[u][j].w * qs);
                *(unsigned*)(h8 + 4 * F.lane + 256 * j) = (unsigned)(q0 & 255) | ((unsigned)(q1 & 255) << 8) | ((unsigned)(q2 & 255) << 16) | ((unsigned)(q3 & 255) << 24); }
            if (F.lane == 0) ((float*)(ws + WS_SA))[row0 + u] = am[u] * (1.0f / 127.0f); }
        float p[RB][16];
#pragma unroll
        for (int e = 0; e < 16; ++e) { float sacc[RB];
#pragma unroll
            for (int u = 0; u < RB; ++u) sacc[u] = 0.f;
#pragma unroll
            for (int j = 0; j < 4; ++j) { const f32x4 w = *(const LAS f32x4*)(wrT + e * 1024 + 4 * F.lane + 256 * j);
#pragma unroll
                for (int u = 0; u < RB; ++u) sacc[u] += (hv[u][j].x * w.x + hv[u][j].y * w.y) + (hv[u][j].z * w.z + hv[u][j].w * w.w); }
#pragma unroll
            for (int u = 0; u < RB; ++u) p[u][e] = sacc[u];
            if ((e & 3) == 3) MEMFENCE(); }
        float lgt[RB];
#pragma unroll
        for (int u = 0; u < RB; ++u) { float r8[8], r4[4], r2[2];
          { const bool hb = (F.lane & 32) != 0;
#pragma unroll
            for (int j = 0; j < 8; ++j) { const float keep = hb ? p[u][8 + j] : p[u][j], send = hb ? p[u][j] : p[u][8 + j]; r8[j] = keep + __shfl_xor(send, 32); } }
          { const bool hb = (F.lane & 16) != 0;
#pragma unroll
            for (int j = 0; j < 4; ++j) { const float keep = hb ? r8[4 + j] : r8[j], send = hb ? r8[j] : r8[4 + j]; r4[j] = keep + __shfl_xor(send, 16); } }
          { const bool hb = (F.lane & 8) != 0;
#pragma unroll
            for (int j = 0; j < 2; ++j) { const float keep = hb ? r4[2 + j] : r4[j], send = hb ? r4[j] : r4[2 + j]; r2[j] = keep + __shfl_xor(send, 8); } }
          { const bool hb = (F.lane & 4) != 0; const float keep = hb ? r2[1] : r2[0], send = hb ? r2[0] : r2[1]; lgt[u] = keep + __shfl_xor(send, 4); }
          lgt[u] += __shfl_xor(lgt[u], 1); lgt[u] += __shfl_xor(lgt[u], 2); }
        float mx[RB], ex[RB], sum[RB];
#pragma unroll
        for (int u = 0; u < RB; ++u) mx[u] = lgt[u];
#pragma unroll
        for (int o = 4; o < 64; o <<= 1) {
#pragma unroll
            for (int u = 0; u < RB; ++u) mx[u] = fmaxf(mx[u], __shfl_xor(mx[u], o)); }
#pragma unroll
        for (int u = 0; u < RB; ++u) { ex[u] = __builtin_amdgcn_exp2f((lgt[u] - mx[u]) * LOG2E); sum[u] = ex[u]; }
#pragma unroll
        for (int o = 4; o < 64; o <<= 1) {
#pragma unroll
            for (int u = 0; u < RB; ++u) sum[u] += __shfl_xor(sum[u], o); }
        const int ee = ((F.lane >> 5) & 1) * 8 + ((F.lane >> 4) & 1) * 4 + ((F.lane >> 3) & 1) * 2 + ((F.lane >> 2) & 1);
#pragma unroll
        for (int u = 0; u < RB; ++u) { const float mine = ex[u] / sum[u]; const int row = row0 + u;
            if ((F.lane & 3) == 0) {
                if (isc) { const int r = row - LROWS; AFFC[((size_t)((r >> 8) * 16 + ee)) * CL + (r & 255)] = mine; }
                else AFF[((size_t)((row >> 13) * 16 + ee)) * SEQ + (row & 8191)] = mine;
                INV[(size_t)row * 16 + ee] = -1;
            } }
    }
#undef PF_LOAD
}


__device__ __forceinline__ void phase_f(KA a, Frame& F, int l, bool last) {
    relane(F);
    unsigned char* ws = a->ws;
    const float* MOD = (const float*)(ws + WS_MOD);
    float* AFF = (float*)(ws + WS_AFF); float* AFFC = (float*)(ws + WS_AFFC); int* INV = (int*)(ws + WS_INV);
    LAS float* wrT = (LAS float*)F.lds;
    const float* wr = a->in[I_WR] + (size_t)l * 1024 * 16;
    for (int idx = F.tid; idx < 16384; idx += NWAVES * 64) wrT[(idx & 15) * 1024 + (idx >> 4)] = wr[idx];
    __syncthreads();
    pf_rows<4>(a, F, l, 0, LROWS, wrT);
    if (!last) pf_rows<1>(a, F, l, LROWS, MROWS, wrT);
}

__device__ __forceinline__ void topk_set(Frame& F, const float* __restrict__ src, int n, int k, int rowbase, int slotbase, int e, int* IDX, float* GATE, int* INV, const float* SA, float* SAE) {
    LAS unsigned* keys = (LAS unsigned*)F.lds; LAS unsigned* hist = keys + 8192; LAS unsigned* sc = hist + 256;
    const int tid = F.tid;
    for (int i = tid; i < n; i += NWAVES * 64) keys[i] = __float_as_uint(src[i]);
    if (tid == 0) { unsigned z_ = 0u, k_ = (unsigned)k; asm volatile("" : "+v"(z_), "+v"(k_)); sc[0] = z_; sc[1] = k_; }
    __syncthreads();
    for (int pass = 0; pass < 4; ++pass) {
        const int shift = 24 - 8 * pass; const unsigned mask = (pass == 0) ? 0u : (0xFFFFFFFFu << (shift + 8));
        if (tid < 256) hist[tid] = 0u;
        __syncthreads();
        const unsigned prefix = sc[0];
        for (int i = tid; i < n; i += NWAVES * 64) { const unsigned kv = keys[i]; if ((kv & mask) == prefix) __hip_atomic_fetch_add(&hist[(kv >> shift) & 255u], 1u, __ATOMIC_RELAXED, __HIP_MEMORY_SCOPE_WORKGROUP); }
        __syncthreads();
        if (F.wave == 0) {
            const unsigned need = sc[1]; unsigned h[4]; unsigned tot = 0u;
#pragma unroll
            for (int j = 0; j < 4; ++j) { h[j] = hist[255 - (4 * F.lane + j)]; tot += h[j]; }
            unsigned incl = tot;
#pragma unroll
            for (int d = 1; d < 64; d <<= 1) { const unsigned t = __shfl_up(incl, d); if (F.lane >= d) incl += t; }
            unsigned cum = incl - tot;
#pragma unroll
            for (int j = 0; j < 4; ++j) { if (cum < need && need <= cum + h[j]) { sc[0] = prefix | ((unsigned)(255 - (4 * F.lane + j)) << shift); sc[1] = need - cum; } cum += h[j]; }
        }
        __syncthreads();
    }
    const unsigned T = sc[0], need_eq = sc[1];
    const int per = (n + NWAVES * 64 - 1) / (NWAVES * 64), start = tid * per;
    unsigned cg = 0u, ce = 0u;
    for (int j = 0; j < per; ++j) { const int i = start + j; if (i < n) { const unsigned kv = keys[i]; cg += (kv > T) ? 1u : 0u; ce += (kv == T) ? 1u : 0u; } }
    const unsigned packed = cg | (ce << 16);
    unsigned incl = packed;
#pragma unroll
    for (int d = 1; d < 64; d <<= 1) { const unsigned t = __shfl_up(incl, d); if (F.lane >= d) incl += t; }
    if (F.lane == 63) sc[8 + F.wave] = incl;
    __syncthreads();
    unsigned base = 0u;
    for (int w = 0; w < F.wave; ++w) base += sc[8 + w];
    const unsigned excl = base + incl - packed;
    unsigned gb = excl & 0xFFFFu, eb = excl >> 16;
    for (int j = 0; j < per; ++j) { const int i = start + j; if (i < n) { const unsigned kv = keys[i]; const bool g = kv > T, q = kv == T;
        if (g || (q && eb < need_eq)) { const int slot = slotbase + (int)(gb + (eb < need_eq ? eb : need_eq)); IDX[slot] = rowbase + i; GATE[slot] = __uint_as_float(kv); SAE[slot] = SA[rowbase + i]; INV[(size_t)(rowbase + i) * 16 + e] = slot; }
        gb += g ? 1u : 0u; eb += q ? 1u : 0u; } }
    __syncthreads();
}
struct CvtItem { const float* wp; int N; unsigned char* wt; int ldt; float qs; int f8; };
__device__ __forceinline__ void cvt_load(const CvtItem& I, float (&tv)[32]) {
#pragma unroll
    for (int i = 0; i < 32; ++i) tv[i] = __builtin_nontemporal_load(I.wp + (size_t)(2 * i) * I.N);
}
__device__ __forceinline__ void cvt_store(const CvtItem& I, const float (&tv)[32], LAS float* scr, int lane) {
#pragma unroll
    for (int i = 0; i < 32; ++i) scr[(2 * i + (lane >> 5)) * 33 + (lane & 31)] = tv[i];
    LDS_WAIT(); asm volatile("" ::: "memory");
    const int c = lane & 3;
#pragma unroll
    for (int j = 0; j < 2; ++j) { const int n = (lane >> 2) + 16 * j; const LAS float* sp = scr + (16 * c) * 33 + n; v4u o;
        if (I.f8) {
#pragma unroll
            for (int d = 0; d < 4; ++d) { float f[4];
#pragma unroll
                for (int i = 0; i < 4; ++i) f[i] = fminf(fmaxf(sp[(4 * d + i) * 33] * I.qs, -448.0f), 448.0f);
                int w = __builtin_amdgcn_cvt_pk_fp8_f32(f[0], f[1], 0, false); w = __builtin_amdgcn_cvt_pk_fp8_f32(f[2], f[3], w, true); o[d] = (unsigned)w; }
        } else {
#pragma unroll
            for (int d = 0; d < 4; ++d) { unsigned w = 0u;
#pragma unroll
                for (int i = 0; i < 4; ++i) { const float f = fminf(fmaxf(sp[(4 * d + i) * 33] * I.qs, -127.0f), 127.0f); w |= ((unsigned)((int)__builtin_rintf(f)) & 255u) << (8 * i); }
                o[d] = w; }
        }
        *(v4u*)(I.wt + (size_t)n * I.ldt + 16 * c) = o; }
    LDS_WAIT(); asm volatile("" ::: "memory");
}
__device__ __forceinline__ void phase_g(KA a, Frame& F, int l, bool last, int rep) {
    relane(F);
    unsigned char* ws = a->ws;
    const float* AFF = (const float*)(ws + WS_AFF); const float* AFFC = (const float*)(ws + WS_AFFC);
    int* IDX = (int*)(ws + WS_IDX); float* GATE = (float*)(ws + WS_GATE); int* INV = (int*)(ws + WS_INV);
    const float* SA = (const float*)(ws + WS_SA); float* SAE = (float*)(ws + WS_SAE);
    const int RPE = last ? 4096 : 4352, nsets = last ? 64 : 128;
    for (int set = blockIdx.x; set < nsets; set += F.G) {
        if (set < 64) { const int b = set >> 4, e = set & 15; topk_set(F, AFF + (size_t)set * SEQ, SEQ, CAPL, b * SEQ, e * RPE + b * CAPL, e, IDX, GATE, INV, SA, SAE); }
        else { const int s2 = set - 64, b = s2 >> 4, e = s2 & 15; topk_set(F, AFFC + (size_t)s2 * CL, CL, CAPC, LROWS + b * CL, e * RPE + 4096 + b * CAPC, e, IDX, GATE, INV, SA, SAE);
            if (b == 0 && F.tid < 128) { IDX[e * RPE + 4224 + F.tid] = -1; GATE[e * RPE + 4224 + F.tid] = 0.f; SAE[e * RPE + 4224 + F.tid] = 0.f; } }
    }
    {
        LAS float* scr = (LAS float*)(F.lds + 40960 + F.wave * 8704);
        gu32* head = F.ctl + CW_Q + 64 * l + 128 * rep;
        constexpr int NIT = NE * 3072;
        const float* wg = a->in[I_WG] + (size_t)l * NE * 1024 * 2048; const float* wu = a->in[I_WU] + (size_t)l * NE * 1024 * 2048; const float* wd = a->in[I_WD] + (size_t)l * NE * 2048 * 1024;
        const float* SWL = (const float*)(ws + WS_SW) + l * 48;
        for (;;) {
            unsigned basev = 0u;
            if (F.lane == 0) basev = __hip_atomic_fetch_add(head, 8u, RLX_AGENT);
            const int base = __builtin_amdgcn_readfirstlane((int)basev);
            if (base >= NIT) break;
#define CVT_SETUP(I, j) do { const int it_ = base + (j); const int e_ = it_ / 3072, r_ = it_ % 3072, which_ = r_ >> 10, ii_ = r_ & 1023; \
                if (which_ < 2) { const int kb_ = ii_ >> 6, n0_ = (ii_ & 63) * 32; const int rowbase_ = (n0_ >> 7) * 256 + (n0_ & 127) + which_ * 128; \
                    I.wp = (which_ ? wu : wg) + (size_t)e_ * 1024 * 2048 + (size_t)(kb_ * 64 + (F.lane >> 5)) * 2048 + n0_ + (F.lane & 31); I.N = 2048; \
                    I.wt = (unsigned char*)(ws + WS_WGU) + (size_t)e_ * 4096 * 1024 + (size_t)rowbase_ * 1024 + kb_ * 64; I.ldt = 1024; I.qs = 1.0f / SWL[3 * e_ + which_]; I.f8 = 0; } \
                else { const int kb_ = ii_ >> 5, n0_ = (ii_ & 31) * 32; \
                    I.wp = wd + (size_t)e_ * 2048 * 1024 + (size_t)(kb_ * 64 + (F.lane >> 5)) * 1024 + n0_ + (F.lane & 31); I.N = 1024; \
                    I.wt = (unsigned char*)(ws + WS_WD) + (size_t)e_ * 1024 * 2048 + (size_t)n0_ * 2048 + kb_ * 64; I.ldt = 2048; I.qs = 1.0f / SWL[3 * e_ + 2]; I.f8 = 1; } } while (0)
            CvtItem IA, IB; float tvA[32], tvB[32];
            CVT_SETUP(IA, 0); cvt_load(IA, tvA);
#pragma unroll
            for (int jj = 0; jj < 4; ++jj) {
                CVT_SETUP(IB, 2 * jj + 1); cvt_load(IB, tvB);
                cvt_store(IA, tvA, scr, F.lane);
                if (jj < 3) { CVT_SETUP(IA, 2 * jj + 2); cvt_load(IA, tvA); }
                cvt_store(IB, tvB, scr, F.lane);
            }
#undef CVT_SETUP
        }
    }
}

__global__ void __launch_bounds__(NWAVES * 64, 2) mk_fwd(Args args) {
    extern __shared__ __attribute__((aligned(16))) unsigned char lds[];
    Frame F;
    F.lds = (LAS unsigned char*)lds;
    F.MISC = (volatile LAS unsigned*)(F.lds + MISC_OFF);
    F.tid = threadIdx.x; F.lane = F.tid & 63; F.wave = __builtin_amdgcn_readfirstlane(F.tid >> 6);
    F.G = gridDim.x; { const int bx = blockIdx.x; F.vcu = (F.G % 8 == 0) ? (bx % 8) * (F.G / 8) + bx / 8 : bx; }
    F.ctl = (gu32*)(args.ws + WS_CTL);
    for (int u = F.tid; u < (LDS_BYTES - LDSCTL_OFF) / 4; u += NWAVES * 64) ((LAS unsigned*)(F.lds + LDSCTL_OFF))[u] = 0u;
    __syncthreads();
    const int lo = args.ph_lo, hi = args.ph_hi;
    const bool multi = (hi - lo) > 1;
    XcdBarrier bar; bar.bar = (unsigned*)(F.ctl + CW_BAR); bar.x = 0; bar.st = nullptr;
    if (multi) bar = xcd_barrier_post((unsigned*)(F.ctl + CW_BAR), F.MISC + 8);
#define IN(k) (lo <= (k) && (k) < hi)
#define SEAM(k) do { if (IN((k) + 1)) xcd_barrier(bar); } while (0)
#define REP(kind) (((MK_REP) >> (kind)) & 1)
#define RUNPH(kind, k, ...) do { if (IN(k)) { for (int rep_ = 0; rep_ <= REP(kind); ++rep_) { __VA_ARGS__; if (rep_ < REP(kind)) xcd_barrier(bar); } SEAM(k); } } while (0)

    RUNPH(0, 0, p0_prologue(kargs(), F));

    for (int l = 0; l < NLAYER; ++l) {
        const bool last = (l == NLAYER - 1);
        const int pb = 1 + 10 * l;
        const int RPE = last ? 4096 : 4352;
        if (IN(pb + 0)) { for (int rep_ = 0; rep_ <= (l == 0 ? REP(1) : 0); ++rep_) { phase_a(kargs(), F, l); if (rep_ < REP(1) && l == 0) xcd_barrier(bar); } SEAM(pb + 0); }
        if (IN(pb + 1)) { for (int rep_ = 0; rep_ <= REP(2); ++rep_) {
            KA ka = kargs(); unsigned char* ws = ka->ws;
            pg8::Gemm g{(const pg8::bf16_t*)(ws + WS_H), (const pg8::bf16_t*)(ws + WS_WCAT8 + (size_t)l * ZP * 1024), MROWS, ZP, DM / 2, 1 << 30, 0};
            pg8::StaticOrder S; S.init(MROWS, ZP, F.G, (int)blockIdx.x);
            pg8::EpiStoreBf16I8 E{(unsigned char*)(ws + WS_Z), ZP, (const float*)(ws + WS_SA), (const float*)(ws + WS_SWC) + (size_t)l * ZP, (float*)(ws + WS_SSQ), 384, ZEND};
            pg8::gemm_phase<pg8::EpiStoreBf16I8, pg8::StaticOrder, true, true, 1>(F.lds, g, S, E);
            if (rep_ < REP(2)) xcd_barrier(bar); }
            SEAM(pb + 1);
        }
        RUNPH(3, pb + 2, phase_c(kargs(), F, l));
        RUNPH(4, pb + 3, phase_d<0>(kargs(), F, l, last); if (MK_ABL) { xcd_barrier(bar); phase_d<MK_ABL>(kargs(), F, l, last); });
        if (IN(pb + 4)) { for (int rep_ = 0; rep_ <= REP(5); ++rep_) {
            KA ka = kargs(); unsigned char* ws = ka->ws; const float* MODL = (const float*)(ws + WS_MOD) + (size_t)l * 5 * 6144;
            const int M = last ? LROWS : MROWS;
            pg8::Gemm g{(const pg8::bf16_t*)(ws + WS_ATT), (const pg8::bf16_t*)(ws + WS_WO) + (size_t)l * 1024 * 1024, M, DM, DM, 1 << 30, 0};
            pg8::StaticOrder S; S.init(M, DM, F.G, (int)blockIdx.x);
            pg8::EpiColGateBf16 E{(pg8::bf16_t*)(ws + WS_DELTA), DM, MODL, LROWS};
            pg8::gemm_phase<pg8::EpiColGateBf16, pg8::StaticOrder, true, true>(F.lds, g, S, E);
            if (rep_ < REP(5)) xcd_barrier(bar); }
            SEAM(pb + 4);
        }
        RUNPH(6, pb + 5, phase_f(kargs(), F, l, last));
        RUNPH(7, pb + 6, phase_g(kargs(), F, l, last, rep_));
        if (IN(pb + 8)) { for (int rep_ = 0; rep_ <= REP(9); ++rep_) {
            KA ka = kargs(); unsigned char* ws = ka->ws;
            pg8::Gemm g{(const pg8::bf16_t*)(ws + WS_H), (const pg8::bf16_t*)(ws + WS_WGU), NE * RPE, 2 * FFD, DM / 2, RPE / 256, (size_t)2 * FFD * DM, (const int*)(ws + WS_IDX)};
            pg8::StaticOrder S; S.init(NE * RPE, 2 * FFD, F.G, (int)blockIdx.x);
            pg8::EpiSwiGLUI8 E{(unsigned char*)(ws + WS_HID), FFD, (const float*)(ws + WS_SAE), (const float*)(ws + WS_SW) + l * 48, RPE / 256, HID_SCALE};
            if (MK_NOEPI && rep_ == 1) { pg8::EpiNullI8 EN{}; pg8::gemm_phase<pg8::EpiNullI8, pg8::StaticOrder, true, true, 1, true>(F.lds, g, S, EN); }
            else pg8::gemm_phase<pg8::EpiSwiGLUI8, pg8::StaticOrder, true, true, 1, true>(F.lds, g, S, E);
            if (rep_ < REP(9)) xcd_barrier(bar); }
            SEAM(pb + 8);
        }
        if (IN(pb + 9)) { for (int rep_ = 0; rep_ <= REP(10); ++rep_) {
            KA ka = kargs(); unsigned char* ws = ka->ws;
            pg8::Gemm g{(const pg8::bf16_t*)(ws + WS_HID), (const pg8::bf16_t*)(ws + WS_WD), NE * RPE, DM, FFD / 2, RPE / 256, (size_t)DM * FFD};
            pg8::StaticOrder S; S.init(NE * RPE, DM, F.G, (int)blockIdx.x);
            pg8::EpiRowScaleBf16 E{(unsigned char*)(ws + WS_YE), DM, (const float*)(ws + WS_GATE), (const float*)(ws + WS_SW) + l * 48, RPE / 256, YE_SCALE / HID_SCALE};
            pg8::gemm_phase<pg8::EpiRowScaleBf16, pg8::StaticOrder, true, true, 2>(F.lds, g, S, E);
            if (rep_ < REP(10)) xcd_barrier(bar); }
            SEAM(pb + 9);
        }
    }
    if (IN(N_PHASES - 1)) phase_a(kargs(), F, NLAYER);
#undef IN
#undef SEAM
}

extern "C" void kernel_launch(void* const* d_in, const int* in_sizes, int n_in, void* d_out, int out_size, void* d_ws, size_t ws_size, hipStream_t stream) {
    static int grid = 0;
    if (grid == 0) {
        if (n_in != N_IN || out_size != LROWS * DM || ws_size < WS_END) { fprintf(stderr, "kernel_launch: unexpected shapes (n_in %d, out %d, ws %zu); nothing launched\n", n_in, out_size, ws_size); grid = -1; return; }
        int dev = 0, cus = 0, per_cu = 0;
        if (hipGetDevice(&dev) != hipSuccess || hipDeviceGetAttribute(&cus, hipDeviceAttributeMultiprocessorCount, dev) != hipSuccess) { grid = -1; return; }
        if (hipFuncSetAttribute((const void*)mk_fwd, hipFuncAttributeMaxDynamicSharedMemorySize, LDS_BYTES) != hipSuccess) { fprintf(stderr, "kernel_launch: hipFuncSetAttribute failed\n"); grid = -1; return; }
        if (hipOccupancyMaxActiveBlocksPerMultiprocessor(&per_cu, (const void*)mk_fwd, NWAVES * 64, LDS_BYTES) != hipSuccess || per_cu < 1) { fprintf(stderr, "kernel_launch: occupancy query reports %d blocks per CU\n", per_cu); }
        (void)hipGetLastError();
        if (cus < 256) { fprintf(stderr, "kernel_launch: %d compute units; the per-workgroup LDS row tables of the GEMM phases are sized for a grid of at least 256 workgroups; nothing launched\n", cus); grid = -1; return; }
        grid = cus;
    }
    if (grid < 0) return;
    if (hipMemsetAsync((char*)d_ws + WS_CTL, 0, CTL_ZERO_BYTES, stream) != hipSuccess) { fprintf(stderr, "kernel_launch: memset failed\n"); return; }
    Args a{};
    for (int i = 0; i < N_IN; ++i) a.in[i] = (const float*)d_in[i];
    a.out = (float*)d_out; a.ws = (unsigned char*)d_ws;
#if MK_SPLIT
    for (int ph = 0; ph < N_PHASES; ++ph) { a.ph_lo = ph; a.ph_hi = ph + 1; hipLaunchKernelGGL(mk_fwd, dim3(grid), dim3(NWAVES * 64), LDS_BYTES, stream, a); }
#else
    a.ph_lo = 0; a.ph_hi = N_PHASES;
    hipLaunchKernelGGL(mk_fwd, dim3(grid), dim3(NWAVES * 64), LDS_BYTES, stream, a);
#endif
    const hipError_t le = hipPeekAtLastError();
    if (le != hipSuccess) fprintf(stderr, "kernel_launch: launch failed: %s\n", hipGetErrorName(le));
}
```

```cpp
#include <hip/hip_runtime.h>
#include <hip/hip_bf16.h>
#include <cstdio>
#include <cstdint>
#ifndef MK_SPLIT
#define MK_SPLIT 0
#endif
#ifndef MK_REP
#define MK_REP 0
#endif
#ifndef MK_NOEPI
#define MK_NOEPI 0
#endif
#ifndef MK_ABL
#define MK_ABL 0
#endif
namespace pg8 {
#define PG8_LAS __attribute__((address_space(3)))
typedef unsigned short bf16_t;
typedef short bf16x8 __attribute__((ext_vector_type(8)));
typedef float f32x4 __attribute__((ext_vector_type(4)));
typedef unsigned u32x4 __attribute__((ext_vector_type(4)));
constexpr int BM = 256, BK = 64, HALF = 128, HTB = HALF * BK * 2  , STAGE_BYTES = 8 * HTB, NXCD = 8, WGM = 8;

__host__ __device__ __forceinline__ int lds_byte(int r, int c) { const int st = (r >> 4) * 2 + (c >> 5), rr = r & 15, cc = c & 31, ob = rr * 64 + cc * 2; return st * 1024 + (ob ^ (((ob >> 9) & 1) << 5)); }
__host__ __device__ __forceinline__ void stage_rc(int b, int& R, int& C) { const int st = b / 1024, sb = b % 1024, swz = sb ^ (((sb >> 9) & 1) << 5); R = (st >> 1) * 16 + swz / 64; C = (st & 1) * 32 + (swz % 64) / 2; }
__host__ __device__ __forceinline__ int perm32(int rho) { const int n = rho >> 4, i = rho & 15; return 8 * (i >> 2) + 4 * n + (i & 3); }

struct Unit { int pm, pn, li; };
struct Gemm { const bf16_t* A; const bf16_t* Bt; int M, N, K; int tpe; size_t bgs; const int* gidx = nullptr; };

struct StaticOrder {
    int nM, nN, nwg, G, c;
    __host__ __device__ void init(int M, int N, int G_, int c_) { nM = M / BM; nN = N / BM; nwg = nM * nN; G = G_; c = c_; }
    __host__ __device__ bool next(int i, Unit& u) const {
        const long L = (long)i * G + c; if (L >= nwg) return false;
        int wgid = (int)L; { const int q = nwg / NXCD, r = nwg % NXCD, xcd = wgid % NXCD, off = wgid / NXCD; wgid = (xcd < r ? xcd * (q + 1) : r * (q + 1) + (xcd - r) * q) + off; }
        const int nig = WGM * nN, gid = wgid / nig, fm = gid * WGM, gsz = (nM - fm) < WGM ? (nM - fm) : WGM;
        u.pm = fm + ((wgid % nig) % gsz); u.pn = (wgid % nig) / gsz; u.li = i; return true;
    }
    __device__ __forceinline__ void a_ready(const Unit&) const {}
    __device__ __forceinline__ void done(const Unit&) const {}
};
typedef int i32x4 __attribute__((ext_vector_type(4)));
__device__ __forceinline__ unsigned cvt_pk_bf16(float lo, float hi) { unsigned r; asm volatile("v_cvt_pk_bf16_f32 %0, %1, %2" : "=v"(r) : "v"(lo), "v"(hi)); return r; }
constexpr int GTAB_OFF = STAGE_BYTES + 2048, RTAB_OFF = GTAB_OFF + 17 * BM * 2, TAB_UNITS = 17;
template <class Sched> __device__ __forceinline__ void fill_rtab(PG8_LAS unsigned char* lds, const Sched& S, const float* rowv, int tid) {
    PG8_LAS float* rt = (PG8_LAS float*)(lds + RTAB_OFF); Unit uu;
    for (int i = 0; i < TAB_UNITS && S.next(i, uu); ++i) { if (tid < BM) rt[i * BM + tid] = rowv[uu.pm * BM + tid]; } }
struct EpiStoreBf16 {
    static constexpr bool PERM = true, AFTER_DRAIN = false;
    bf16_t* O; int ldc;
    template <class Sched> __device__ __forceinline__ void prefill(PG8_LAS unsigned char*, const Sched&, int) const {}
    __device__ __forceinline__ void operator()(const f32x4 (&acc)[2][2][4][2], const Unit& u, int wr, int wc, int fr, int fq, PG8_LAS unsigned char* lds) const {
        const int row0 = u.pm * BM + wr * 64 + fr, col0 = u.pn * BM + wc * 32 + 8 * fq;
#pragma unroll
        for (int ai = 0; ai < 2; ++ai)
#pragma unroll
            for (int m = 0; m < 4; ++m) { bf16_t* rowp = O + (size_t)(row0 + ai * HALF + m * 16) * ldc + col0;
#pragma unroll
                for (int bj = 0; bj < 2; ++bj) { const f32x4 v0 = acc[ai][bj][m][0], v1 = acc[ai][bj][m][1];
                    u32x4 w; w.x = cvt_pk_bf16(v0[0], v0[1]); w.y = cvt_pk_bf16(v0[2], v0[3]); w.z = cvt_pk_bf16(v1[0], v1[1]); w.w = cvt_pk_bf16(v1[2], v1[3]);
                    *(u32x4*)(rowp + bj * HALF) = w; } }
    }
};
__device__ __forceinline__ float clampz(float x) { return fminf(fmaxf(x, -448.0f), 448.0f); }
struct EpiStoreBf16I8 {
    static constexpr bool PERM = true, AFTER_DRAIN = false;
    unsigned char* O; int ldc; const float* sa; const float* sw; float* ssq; int clo, chi;
    template <class Sched> __device__ __forceinline__ void prefill(PG8_LAS unsigned char* lds, const Sched& S, int tid) const { fill_rtab(lds, S, sa, tid); }
    __device__ __forceinline__ void operator()(const i32x4 (&acc)[2][2][4][2], const Unit& u, int wr, int wc, int fr, int fq, PG8_LAS unsigned char* lds) const {
        const int row0 = u.pm * BM + wr * 64 + fr, col0 = u.pn * BM + wc * 32 + 8 * fq;
        bool cst[2];
#pragma unroll
        for (int bj = 0; bj < 2; ++bj) { const int cb = u.pn * BM + bj * HALF + wc * 32; cst[bj] = cb >= clo && cb < chi; }
        f32x4 cs[2][2];
#pragma unroll
        for (int bj = 0; bj < 2; ++bj)
#pragma unroll
            for (int n = 0; n < 2; ++n) cs[bj][n] = *(const f32x4*)(sw + col0 + bj * HALF + 4 * n);
#pragma unroll
        for (int ai = 0; ai < 2; ++ai)
#pragma unroll
            for (int m = 0; m < 4; ++m) { const int row = row0 + ai * HALF + m * 16; const float rs = ((const PG8_LAS float*)(lds + RTAB_OFF))[u.li * BM + (row - u.pm * BM)]; unsigned char* rowp = O + (size_t)row * ldc + col0;
#pragma unroll
                for (int bj = 0; bj < 2; ++bj) { const i32x4 a0 = acc[ai][bj][m][0], a1 = acc[ai][bj][m][1]; const f32x4 c0 = cs[bj][0] * rs, c1 = cs[bj][1] * rs;
                    const float z0 = (float)a0[0] * c0[0], z1 = (float)a0[1] * c0[1], z2 = (float)a0[2] * c0[2], z3 = (float)a0[3] * c0[3];
                    const float z4 = (float)a1[0] * c1[0], z5 = (float)a1[1] * c1[1], z6 = (float)a1[2] * c1[2], z7 = (float)a1[3] * c1[3];
                    int w0 = __builtin_amdgcn_cvt_pk_fp8_f32(clampz(z0), clampz(z1), 0, false); w0 = __builtin_amdgcn_cvt_pk_fp8_f32(clampz(z2), clampz(z3), w0, true);
                    int w1 = __builtin_amdgcn_cvt_pk_fp8_f32(clampz(z4), clampz(z5), 0, false); w1 = __builtin_amdgcn_cvt_pk_fp8_f32(clampz(z6), clampz(z7), w1, true);
                    typedef unsigned u32x2 __attribute__((ext_vector_type(2)));
                    if (cst[bj]) *(u32x2*)(rowp + bj * HALF) = (u32x2){(unsigned)w0, (unsigned)w1};
                    if (u.pn == 0 || (u.pn == 1 && bj == 0)) {
                        float q = ((z0 * z0 + z1 * z1) + (z2 * z2 + z3 * z3)) + ((z4 * z4 + z5 * z5) + (z6 * z6 + z7 * z7));
                        q += __shfl_xor(q, 16); q += __shfl_xor(q, 32);
                        if (fq == 0) ssq[(size_t)row * 12 + (u.pn == 0 ? bj * 4 + wc : 8 + wc)] = q; } } }
    }
};
struct EpiColGateBf16 {
    static constexpr bool PERM = true, AFTER_DRAIN = false;
    bf16_t* O; int ldc; const float* mod; int lrows; float cs;
    template <class Sched> __device__ __forceinline__ void prefill(PG8_LAS unsigned char*, const Sched&, int) const {}
    __device__ __forceinline__ void operator()(const f32x4 (&acc)[2][2][4][2], const Unit& u, int wr, int wc, int fr, int fq, PG8_LAS unsigned char* lds) const {
        const int R0 = u.pm * BM; const int v = (R0 >= lrows) ? 4 : (R0 >> 13);
        const float* ga = mod + v * 6144 + 2 * 1024;
        const int row0 = R0 + wr * 64 + fr, col0 = u.pn * BM + wc * 32 + 8 * fq;
        f32x4 g[2][2];
#pragma unroll
        for (int bj = 0; bj < 2; ++bj)
#pragma unroll
            for (int n = 0; n < 2; ++n) g[bj][n] = *(const f32x4*)(ga + col0 + bj * HALF + 4 * n);
#pragma unroll
        for (int ai = 0; ai < 2; ++ai)
#pragma unroll
            for (int m = 0; m < 4; ++m) { bf16_t* rowp = O + (size_t)(row0 + ai * HALF + m * 16) * ldc + col0;
#pragma unroll
                for (int bj = 0; bj < 2; ++bj) { const f32x4 v0 = acc[ai][bj][m][0] * (g[bj][0] * cs), v1 = acc[ai][bj][m][1] * (g[bj][1] * cs);
                    u32x4 w; w.x = cvt_pk_bf16(v0[0], v0[1]); w.y = cvt_pk_bf16(v0[2], v0[3]); w.z = cvt_pk_bf16(v1[0], v1[1]); w.w = cvt_pk_bf16(v1[2], v1[3]);
                    *(u32x4*)(rowp + bj * HALF) = w; } }
    }
};
__device__ __forceinline__ float silu_mul(float g, float u) { return g * __builtin_amdgcn_rcpf(1.0f + __builtin_amdgcn_exp2f(-1.4426950408889634f * g)) * u; }
struct EpiSwiGLU {
    static constexpr bool PERM = true, AFTER_DRAIN = false;
    bf16_t* O; int ldc;
    template <class Sched> __device__ __forceinline__ void prefill(PG8_LAS unsigned char*, const Sched&, int) const {}
    __device__ __forceinline__ void operator()(const f32x4 (&acc)[2][2][4][2], const Unit& u, int wr, int wc, int fr, int fq, PG8_LAS unsigned char* lds) const {
        const int row0 = u.pm * BM + wr * 64 + fr, col0 = u.pn * HALF + wc * 32 + 8 * fq;
#pragma unroll
        for (int ai = 0; ai < 2; ++ai)
#pragma unroll
            for (int m = 0; m < 4; ++m) { const f32x4 g0 = acc[ai][0][m][0], g1 = acc[ai][0][m][1], u0 = acc[ai][1][m][0], u1 = acc[ai][1][m][1];
                u32x4 w; w.x = cvt_pk_bf16(silu_mul(g0[0], u0[0]), silu_mul(g0[1], u0[1])); w.y = cvt_pk_bf16(silu_mul(g0[2], u0[2]), silu_mul(g0[3], u0[3]));
                w.z = cvt_pk_bf16(silu_mul(g1[0], u1[0]), silu_mul(g1[1], u1[1])); w.w = cvt_pk_bf16(silu_mul(g1[2], u1[2]), silu_mul(g1[3], u1[3]));
                *(u32x4*)(O + (size_t)(row0 + ai * HALF + m * 16) * ldc + col0) = w; }
    }
};
__device__ __forceinline__ float clamp448(float x) { return fminf(fmaxf(x, -448.0f), 448.0f); }
struct EpiSwiGLUI8 {
    static constexpr bool PERM = true, AFTER_DRAIN = false;
    unsigned char* O; int ldc; const float* sa; const float* sw; int tpe; float hs;
    template <class Sched> __device__ __forceinline__ void prefill(PG8_LAS unsigned char* lds, const Sched& S, int tid) const { fill_rtab(lds, S, sa, tid); }
    __device__ __forceinline__ void operator()(const i32x4 (&acc)[2][2][4][2], const Unit& u, int wr, int wc, int fr, int fq, PG8_LAS unsigned char* lds) const {
        const int row0 = u.pm * BM + wr * 64 + fr, col0 = u.pn * HALF + wc * 32 + 8 * fq; const int e = u.pm / tpe;
        const float sg = sw[3 * e], su = sw[3 * e + 1] * hs;
#pragma unroll
        for (int ai = 0; ai < 2; ++ai)
#pragma unroll
            for (int m = 0; m < 4; ++m) { const int row = row0 + ai * HALF + m * 16; const float rs = ((const PG8_LAS float*)(lds + RTAB_OFF))[u.li * BM + (row - u.pm * BM)], fg = rs * sg, fu = rs * su;
                const i32x4 g0 = acc[ai][0][m][0], g1 = acc[ai][0][m][1], u0 = acc[ai][1][m][0], u1 = acc[ai][1][m][1];
                typedef float f32x2 __attribute__((ext_vector_type(2)));
                float h[8]; f32x2 gi[4], gu[4], ev[4];
                const float tg = -1.4426950408889634f * fg, fgu = fg * fu;
#pragma unroll
                for (int i = 0; i < 2; ++i) { gi[i] = (f32x2){(float)g0[2 * i], (float)g0[2 * i + 1]}; gi[2 + i] = (f32x2){(float)g1[2 * i], (float)g1[2 * i + 1]};
                    gu[i] = gi[i] * (f32x2){(float)u0[2 * i], (float)u0[2 * i + 1]}; gu[2 + i] = gi[2 + i] * (f32x2){(float)u1[2 * i], (float)u1[2 * i + 1]}; }
                __builtin_amdgcn_sched_barrier(0);
#pragma unroll
                for (int i = 0; i < 4; ++i) { const f32x2 t = gi[i] * tg; ev[i] = (f32x2){__builtin_amdgcn_exp2f(t.x), __builtin_amdgcn_exp2f(t.y)}; }
                __builtin_amdgcn_sched_barrier(0);
#pragma unroll
                for (int i = 0; i < 4; ++i) { const f32x2 d = ev[i] + 1.0f; ev[i] = (f32x2){__builtin_amdgcn_rcpf(d.x), __builtin_amdgcn_rcpf(d.y)}; }
                __builtin_amdgcn_sched_barrier(0);
#pragma unroll
                for (int i = 0; i < 4; ++i) { const f32x2 hv = gu[i] * ev[i] * fgu; h[2 * i] = clamp448(hv.x); h[2 * i + 1] = clamp448(hv.y); }
                int w0 = __builtin_amdgcn_cvt_pk_fp8_f32(h[0], h[1], 0, false); w0 = __builtin_amdgcn_cvt_pk_fp8_f32(h[2], h[3], w0, true);
                int w1 = __builtin_amdgcn_cvt_pk_fp8_f32(h[4], h[5], 0, false); w1 = __builtin_amdgcn_cvt_pk_fp8_f32(h[6], h[7], w1, true);
                typedef unsigned u32x2 __attribute__((ext_vector_type(2)));
                *(u32x2*)(O + (size_t)row * ldc + col0) = (u32x2){(unsigned)w0, (unsigned)w1}; }
    }
};
struct EpiNullI8 {
    static constexpr bool PERM = true, AFTER_DRAIN = false;
    template <class Sched> __device__ __forceinline__ void prefill(PG8_LAS unsigned char*, const Sched&, int) const {}
    __device__ __forceinline__ void operator()(const i32x4 (&acc)[2][2][4][2], const Unit& u, int wr, int wc, int fr, int fq, PG8_LAS unsigned char* lds) const {
#pragma unroll
        for (int ai = 0; ai < 2; ++ai)
#pragma unroll
            for (int bj = 0; bj < 2; ++bj)
#pragma unroll
                for (int m = 0; m < 4; ++m) { asm volatile("" :: "v"(acc[ai][bj][m][0]), "v"(acc[ai][bj][m][1])); }
    }
};
struct EpiRowScaleBf16 {
    static constexpr bool PERM = true, AFTER_DRAIN = false;
    unsigned char* O; int ldc; const float* rs; const float* es; int tpe; float cs;
    template <class Sched> __device__ __forceinline__ void prefill(PG8_LAS unsigned char* lds, const Sched& S, int tid) const { fill_rtab(lds, S, rs, tid); }
    __device__ __forceinline__ void operator()(const f32x4 (&acc)[2][2][4][2], const Unit& u, int wr, int wc, int fr, int fq, PG8_LAS unsigned char* lds) const {
        const int row0 = u.pm * BM + wr * 64 + fr, col0 = u.pn * BM + wc * 32 + 8 * fq;
#pragma unroll
        for (int ai = 0; ai < 2; ++ai)
#pragma unroll
            for (int m = 0; m < 4; ++m) { const int row = row0 + ai * HALF + m * 16; const float s = ((const PG8_LAS float*)(lds + RTAB_OFF))[u.li * BM + (row - u.pm * BM)] * (es[3 * (u.pm / tpe) + 2] * cs); unsigned char* rowp = O + (size_t)row * ldc + col0;
#pragma unroll
                for (int bj = 0; bj < 2; ++bj) { const f32x4 v0 = acc[ai][bj][m][0] * s, v1 = acc[ai][bj][m][1] * s;
                    int w0 = __builtin_amdgcn_cvt_pk_fp8_f32(clamp448(v0[0]), clamp448(v0[1]), 0, false); w0 = __builtin_amdgcn_cvt_pk_fp8_f32(clamp448(v0[2]), clamp448(v0[3]), w0, true);
                    int w1 = __builtin_amdgcn_cvt_pk_fp8_f32(clamp448(v1[0]), clamp448(v1[1]), 0, false); w1 = __builtin_amdgcn_cvt_pk_fp8_f32(clamp448(v1[2]), clamp448(v1[3]), w1, true);
                    typedef unsigned u32x2 __attribute__((ext_vector_type(2)));
                    *(u32x2*)(rowp + bj * HALF) = (u32x2){(unsigned)w0, (unsigned)w1}; } }
    }
};
typedef int i32x4 __attribute__((ext_vector_type(4)));
typedef int i32x8 __attribute__((ext_vector_type(8)));
template <int MODE> struct AccSel { typedef f32x4 type; };
template <> struct AccSel<1> { typedef i32x4 type; };
template <int MODE> struct Frag { bf16x8 v[2]; __device__ __forceinline__ void set(int k, bf16x8 x) { v[k] = x; } };
template <> struct Frag<2> { i32x8 w; __device__ __forceinline__ void set(int k, bf16x8 x) { const i32x4 y = __builtin_bit_cast(i32x4, x); if (k == 0) w.lo = y; else w.hi = y; } };
template <class Epi, class Sched, bool ALIGN_EPI = false, bool SP2 = false, int MODE = 0, bool GATHER = false>
__device__ __forceinline__ void gemm_phase(PG8_LAS unsigned char* lds, const Gemm g, const Sched& S, const Epi& E) {
    int tid_l = threadIdx.x; asm volatile("" : "+v"(tid_l));
    const int tid = tid_l, wid = __builtin_amdgcn_readfirstlane(tid >> 6), lane = tid & 63, wr = wid >> 2, wc = wid & 3, fr = lane & 15, fq = lane >> 4;
    const int K = g.K, nt = K / BK;
    unsigned voffA[2], voffB[2];
#pragma unroll
    for (int i = 0; i < 2; ++i) { int R, C; stage_rc(tid * 16 + i * 8192, R, C); const int Rb = Epi::PERM ? ((R & ~31) + perm32(R & 31)) : R;
        voffA[i] = (unsigned)(R * K + C) * 2u; voffB[i] = (unsigned)(Rb * K + C) * 2u; }
    static_assert(!GATHER || SP2, "the gathered A operand is wired into the SP2 schedule only");
    unsigned gvc[2][2] = {{0u, 0u}, {0u, 0u}};
    PG8_LAS unsigned short* gtab = (PG8_LAS unsigned short*)(lds + GTAB_OFF);
    if constexpr (GATHER) { Unit uu_;
        for (int i_ = 0; S.next(i_, uu_); ++i_) { if (tid < BM) { const int ix_ = g.gidx[uu_.pm * BM + tid]; gtab[i_ * BM + tid] = (unsigned short)(ix_ < 0 ? 0 : ix_); } }
    }
    E.prefill(lds, S, tid);
    __syncthreads();
#define PG8_GOFF(ui_, gv_) do { if constexpr (GATHER) { _Pragma("unroll") for (int h_ = 0; h_ < 2; ++h_) _Pragma("unroll") for (int i_ = 0; i_ < 2; ++i_) { int R_, C_; stage_rc(tid * 16 + i_ * 8192, R_, C_); \
        const unsigned ix_ = gtab[(ui_) * BM + h_ * HALF + R_]; gv_[h_][i_] = ix_ * (unsigned)(K * 2) + (unsigned)C_ * 2u; } } } while (0)
    const size_t kstep = (size_t)(BK * 2);
    const size_t hstep = (size_t)HALF * K * 2;
    const size_t tstep = 2 * hstep;
    const unsigned ldsw = (unsigned)wid * 1024u;
    const int aoff = lds_byte(wr * 64 + fr, fq * 8), boff = lds_byte(wc * 32 + fr, fq * 8);
#define PG8_SA(b, h) (((b) * 2 + (h)) * HTB)
#define PG8_SB(b, h) ((4 + (b) * 2 + (h)) * HTB)
#define PG8_STAGE(bufoff, gbase, voff) do { _Pragma("unroll") for (int _i = 0; _i < 2; ++_i) \
        __builtin_amdgcn_global_load_lds((const unsigned*)((const char*)(gbase) + (voff)[_i]), (PG8_LAS unsigned*)(lds + (bufoff) + ldsw + _i * 8192), 16, 0, 0); } while (0)
#define PG8_STAGE_A(bufoff, gbase, h_, nx_) do { if constexpr (GATHER) PG8_STAGE(bufoff, gbase, gvc[h_]); else PG8_STAGE(bufoff, (gbase) + (h_) * hstep, voffA); } while (0)
#define PG8_LDA(dst, b, h) do { _Pragma("unroll") for (int m = 0; m < 4; ++m) _Pragma("unroll") for (int k = 0; k < 2; ++k) dst[m].set(k, *(const PG8_LAS bf16x8*)(lds + PG8_SA(b, h) + aoff + m * 2048 + k * 1024)); } while (0)
#define PG8_LDB(dst, b, h) do { _Pragma("unroll") for (int n = 0; n < 2; ++n) _Pragma("unroll") for (int k = 0; k < 2; ++k) dst[n].set(k, *(const PG8_LAS bf16x8*)(lds + PG8_SB(b, h) + boff + n * 2048 + k * 1024)); } while (0)
#define PG8_MMA(ai, bj, At, Bt) do { __builtin_amdgcn_s_setprio(1); _Pragma("unroll") for (int m = 0; m < 4; ++m) _Pragma("unroll") for (int n = 0; n < 2; ++n) { \
        if constexpr (MODE == 2) { asm volatile("v_mfma_f32_16x16x128_f8f6f4 %0, %1, %2, %0" : "+v"(acc[ai][bj][m][n]) : "v"(Bt[n].w), "v"(At[m].w)); }     \
        else { _Pragma("unroll") for (int k = 0; k < 2; ++k) { \
          if constexpr (MODE == 1) acc[ai][bj][m][n] = __builtin_amdgcn_mfma_i32_16x16x64_i8(__builtin_bit_cast(i32x4, Bt[n].v[k]), __builtin_bit_cast(i32x4, At[m].v[k]), acc[ai][bj][m][n], 0, 0, 0); \
          else acc[ai][bj][m][n] = __builtin_amdgcn_mfma_f32_16x16x32_bf16(Bt[n].v[k], At[m].v[k], acc[ai][bj][m][n], 0, 0, 0); } } } __builtin_amdgcn_s_setprio(0); } while (0)
#define PG8_WAIT_V(n) asm volatile("s_waitcnt vmcnt(" #n ")" ::: "memory")
#define PG8_WAIT_L(n) asm volatile("s_waitcnt lgkmcnt(" #n ")" ::: "memory")
#define PG8_BAR __builtin_amdgcn_s_barrier()
#define PG8_SCHED __builtin_amdgcn_sched_barrier(0)
    Unit cur, nxt; int ui = 0;
    if (!S.next(0, cur)) return;
    typedef typename AccSel<MODE>::type acc_t; const acc_t acc_zero = {};
    acc_t acc[2][2][4][2];
#pragma unroll
    for (int a = 0; a < 2; ++a)
#pragma unroll
        for (int b = 0; b < 2; ++b)
#pragma unroll
            for (int m = 0; m < 4; ++m)
#pragma unroll
                for (int n = 0; n < 2; ++n) acc[a][b][m][n] = acc_zero;
    Frag<MODE> At[4], B0[2], B1[2];
    const char* cA = (const char*)g.A + (GATHER ? (size_t)0 : (size_t)cur.pm * tstep); PG8_GOFF(0, gvc); const char* cB = (const char*)g.Bt + (size_t)(cur.pm / g.tpe) * g.bgs + (size_t)cur.pn * tstep;
    S.a_ready(cur);
    if constexpr (SP2) {
        PG8_STAGE(PG8_SB(0, 0), cB, voffB); PG8_STAGE(PG8_SB(0, 1), cB + hstep, voffB); PG8_STAGE_A(PG8_SA(0, 0), cA, 0, false); PG8_STAGE_A(PG8_SA(0, 1), cA, 1, false);
        if (wr == 1) PG8_BAR;
        PG8_WAIT_V(2); PG8_BAR;
        PG8_STAGE(PG8_SB(1, 0), cB + kstep, voffB); PG8_STAGE_A(PG8_SA(1, 0), cA + kstep, 0, false); PG8_STAGE(PG8_SB(1, 1), cB + hstep + kstep, voffB);
        PG8_WAIT_V(6); PG8_BAR;
    } else {
        PG8_STAGE(PG8_SB(0, 0), cB, voffB); PG8_STAGE(PG8_SA(0, 0), cA, voffA); PG8_STAGE(PG8_SB(0, 1), cB + hstep, voffB); PG8_STAGE(PG8_SA(0, 1), cA + hstep, voffA);
        if (wr == 1) PG8_BAR;
        PG8_WAIT_V(4); PG8_BAR;
        PG8_STAGE(PG8_SB(1, 0), cB + kstep, voffB); PG8_STAGE(PG8_SA(1, 0), cA + kstep, voffA); PG8_STAGE(PG8_SB(1, 1), cB + hstep + kstep, voffB);
        PG8_WAIT_V(6); PG8_BAR;
    }
    for (;;) {
        const bool has_next = S.next(ui + 1, nxt);
        const char* nA = (has_next && !GATHER) ? (const char*)g.A + (size_t)nxt.pm * tstep : cA; const char* nB = has_next ? (const char*)g.Bt + (size_t)(nxt.pm / g.tpe) * g.bgs + (size_t)nxt.pn * tstep : cB;
        for (int t = 0; t < nt; t += 2) {
            const bool last = (t == nt - 2); const bool nxu = last && has_next;
            const char* a1 = cA + (size_t)(t + 1) * kstep;
            const char* a2 = last ? nA : cA + (size_t)(t + 2) * kstep; const char* b2 = last ? nB : cB + (size_t)(t + 2) * kstep;
            const char* a3 = a2 + kstep; const char* b3 = b2 + kstep;
            if (last && has_next) S.a_ready(nxt);
            if constexpr (SP2) {
            PG8_LDB(B0, 0, 0); PG8_LDB(B1, 0, 1); PG8_SCHED; PG8_LDA(At, 0, 0); PG8_STAGE_A(PG8_SA(1, 1), a1, 1, false); if (nxu) PG8_GOFF(ui + 1, gvc);
            PG8_WAIT_V(8); PG8_WAIT_L(0); PG8_BAR; PG8_MMA(0, 0, At, B0); PG8_MMA(0, 1, At, B1); PG8_BAR; PG8_SCHED;
            PG8_LDA(At, 0, 1); PG8_STAGE(PG8_SB(0, 0), b2, voffB); PG8_STAGE(PG8_SB(0, 1), b2 + hstep, voffB); PG8_STAGE_A(PG8_SA(0, 0), a2, 0, nxu);
            PG8_WAIT_V(8); PG8_WAIT_L(0); PG8_BAR; PG8_MMA(1, 0, At, B0); PG8_MMA(1, 1, At, B1); PG8_BAR; PG8_SCHED;
            PG8_LDB(B0, 1, 0); PG8_LDB(B1, 1, 1); PG8_SCHED; PG8_LDA(At, 1, 0); PG8_STAGE_A(PG8_SA(0, 1), a2, 1, nxu);
            PG8_WAIT_V(8); PG8_WAIT_L(0); PG8_BAR; PG8_MMA(0, 0, At, B0); PG8_MMA(0, 1, At, B1); PG8_BAR; PG8_SCHED;
            PG8_LDA(At, 1, 1); PG8_STAGE(PG8_SB(1, 0), b3, voffB); PG8_STAGE(PG8_SB(1, 1), b3 + hstep, voffB); PG8_STAGE_A(PG8_SA(1, 0), a3, 0, nxu);
            PG8_WAIT_V(8); PG8_WAIT_L(0); PG8_BAR; PG8_MMA(1, 0, At, B0); PG8_MMA(1, 1, At, B1); PG8_BAR; PG8_SCHED;
            } else {
            PG8_LDB(B0, 0, 0); PG8_SCHED; PG8_LDA(At, 0, 0); PG8_STAGE(PG8_SA(1, 1), a1 + hstep, voffA);
            PG8_WAIT_L(8); PG8_BAR; PG8_WAIT_L(0); PG8_MMA(0, 0, At, B0); PG8_BAR; PG8_SCHED;
            PG8_LDB(B1, 0, 1); PG8_STAGE(PG8_SB(0, 0), b2, voffB);
            PG8_BAR; PG8_WAIT_L(0); PG8_MMA(0, 1, At, B1); PG8_BAR;
            PG8_LDA(At, 0, 1); PG8_STAGE(PG8_SA(0, 0), a2, voffA);
            PG8_BAR; PG8_WAIT_L(0); PG8_MMA(1, 0, At, B0); PG8_BAR; PG8_SCHED;
            PG8_STAGE(PG8_SB(0, 1), b2 + hstep, voffB);
            PG8_WAIT_V(6); PG8_BAR; PG8_MMA(1, 1, At, B1); PG8_BAR;
            PG8_LDB(B0, 1, 0); PG8_SCHED; PG8_LDA(At, 1, 0); PG8_STAGE(PG8_SA(0, 1), a2 + hstep, voffA);
            PG8_WAIT_L(8); PG8_BAR; PG8_WAIT_L(0); PG8_MMA(0, 0, At, B0); PG8_BAR; PG8_SCHED;
            PG8_LDB(B1, 1, 1); PG8_STAGE(PG8_SB(1, 0), b3, voffB);
            PG8_BAR; PG8_WAIT_L(0); PG8_MMA(0, 1, At, B1); PG8_BAR;
            PG8_LDA(At, 1, 1); PG8_STAGE(PG8_SA(1, 0), a3, voffA);
            PG8_BAR; PG8_WAIT_L(0); PG8_MMA(1, 0, At, B0); PG8_BAR; PG8_SCHED;
            PG8_STAGE(PG8_SB(1, 1), b3 + hstep, voffB);
            PG8_WAIT_V(6); PG8_BAR; PG8_MMA(1, 1, At, B1); PG8_BAR;
            }
        }
        if constexpr (ALIGN_EPI) { if (wr == 0) PG8_BAR; }
        if constexpr (!Epi::AFTER_DRAIN) { E(acc, cur, wr, wc, fr, fq, lds); S.done(cur); }
        if (!has_next) break;
#pragma unroll
        for (int a = 0; a < 2; ++a)
#pragma unroll
            for (int b = 0; b < 2; ++b)
#pragma unroll
                for (int m = 0; m < 4; ++m)
#pragma unroll
                    for (int n = 0; n < 2; ++n) acc[a][b][m][n] = acc_zero;
        cur = nxt; cA = nA; cB = nB; ++ui;
        if constexpr (ALIGN_EPI) { if (wr == 1) PG8_BAR; }
    }
    PG8_WAIT_V(0);
    if constexpr (!ALIGN_EPI) { if (wr == 0) PG8_BAR; }
    PG8_BAR;
    if constexpr (Epi::AFTER_DRAIN) { E.fused(acc, cur, wr, wc, fr, fq, lds, wid, lane); S.done(cur); }
#undef PG8_SA
#undef PG8_SB
#undef PG8_STAGE
#undef PG8_STAGE_A
#undef PG8_GOFF
#undef PG8_LDA
#undef PG8_LDB
#undef PG8_MMA
#undef PG8_WAIT_V
#undef PG8_WAIT_L
#undef PG8_BAR
#undef PG8_SCHED
}
}
namespace att {
typedef unsigned short bf16_t;
typedef short bf16x8 __attribute__((ext_vector_type(8)));
typedef short s16x4 __attribute__((ext_vector_type(4)));
typedef float f32x16 __attribute__((ext_vector_type(16)));
typedef float f32x4 __attribute__((ext_vector_type(4)));
typedef unsigned u32x4 __attribute__((ext_vector_type(4)));
typedef unsigned u32x2 __attribute__((ext_vector_type(2)));
#define ALDS __attribute__((address_space(3)))
typedef float f32x2_t __attribute__((ext_vector_type(2))); typedef __bf16 bf16x2_t __attribute__((ext_vector_type(2)));
__device__ __forceinline__ unsigned cvtpk(float lo, float hi) { f32x2_t v = {lo, hi}; bf16x2_t b = __builtin_convertvector(v, bf16x2_t); return __builtin_bit_cast(unsigned, b); }
__device__ __forceinline__ float bf2f(unsigned short u) { return __uint_as_float((unsigned)u << 16); }
template <int S> __device__ __forceinline__ bf16x8 pack8(const f32x16& x) {
    u32x4 p; p.x = cvtpk(x[8 * S + 0], x[8 * S + 1]); p.y = cvtpk(x[8 * S + 2], x[8 * S + 3]); p.z = cvtpk(x[8 * S + 4], x[8 * S + 5]); p.w = cvtpk(x[8 * S + 6], x[8 * S + 7]);
    return __builtin_bit_cast(bf16x8, p);
}
typedef short v4i16_t __attribute__((ext_vector_type(4)));
__device__ __forceinline__ s16x4 vtr(const ALDS char* p) { return __builtin_bit_cast(s16x4, __builtin_amdgcn_ds_read_tr16_b64_v4i16((ALDS v4i16_t*)p)); }
__device__ __forceinline__ int crow(int r, int hi) { return (r & 3) + 8 * (r >> 2) + 4 * hi; }
constexpr int ATT_LDS_BYTES = 2 * 12288 + 2 * 8192;

__device__ __forceinline__ void glds16(const void* gsrc, unsigned lds_dst) { unsigned keep;
    asm volatile("s_mov_b32 %0, m0\n\ts_mov_b32 m0, %2\n\ts_nop 0\n\tglobal_load_lds_dwordx4 %1, off\n\ts_mov_b32 m0, %0" : "=&s"(keep) : "v"(gsrc), "s"(lds_dst) : "memory"); }
__device__ __forceinline__ void glds16s(const char* sbase, unsigned voff, unsigned lds_dst) { unsigned keep;
    asm volatile("s_mov_b32 %0, m0\n\ts_mov_b32 m0, %3\n\ts_nop 0\n\tglobal_load_lds_dwordx4 %1, %2\n\ts_mov_b32 m0, %0" : "=&s"(keep) : "v"(voff), "s"(sbase), "s"(lds_dst) : "memory"); }
#define ATT_SBAR() __builtin_amdgcn_sched_barrier(0)
#define ATT_PIN(x) asm volatile("" : "+v"(x))
typedef int i32x2a __attribute__((ext_vector_type(2)));
typedef int i32x4a __attribute__((ext_vector_type(4)));
typedef int i32x6a __attribute__((ext_vector_type(6)));
typedef int i32x8a __attribute__((ext_vector_type(8)));
typedef unsigned u32x16 __attribute__((ext_vector_type(16)));
typedef __bf16 bf16x32_t __attribute__((ext_vector_type(32)));
__device__ __forceinline__ i32x6a cvt_fp6x32(const u32x16& w) { return __builtin_bit_cast(i32x6a, __builtin_amdgcn_cvt_scalef32_pk32_fp6_bf16(__builtin_bit_cast(bf16x32_t, w), 1.0f)); }
#define ATT_MF6_Z(C, A, B, SA, SB) asm volatile("v_mfma_scale_f32_32x32x64_f8f6f4 %0, %1, %2, 0, %3, %4 op_sel:[0,0,0] op_sel_hi:[0,0,0] cbsz:2 blgp:2" : "=&v"(C) : "v"(A), "v"(B), "v"(SA), "v"(SB))
#define ATT_MF6_A(C, A, B, SA, SB) asm volatile("v_mfma_scale_f32_32x32x64_f8f6f4 %0, %1, %2, %0, %3, %4 op_sel:[0,0,0] op_sel_hi:[0,0,0] cbsz:2 blgp:2" : "+v"(C) : "v"(A), "v"(B), "v"(SA), "v"(SB))
#define ATT_MF6_C(C, A, B, C0, SA, SB) asm volatile("v_mfma_scale_f32_32x32x64_f8f6f4 %0, %1, %2, %3, %4, %5 op_sel:[0,0,0] op_sel_hi:[0,0,0] cbsz:2 blgp:2" : "=&v"(C) : "v"(A), "v"(B), "v"(C0), "v"(SA), "v"(SB))
template <int DK> struct KCfg { static constexpr int NG = (DK == 96) ? 3 : 2, KTB = (DK == 96) ? 5120 : 3072, QRB = 24 * NG, NF = (DK == 96) ? 2 : 1, NRD = 4 * NF, PB = NG * 1024,
                                                      SCL = (DK == 32) ? 0x77777777 : 0x76767676, NB = (DK == 32) ? 2 : 4; };
constexpr float FQ96 = 4.0f * 1.4426950408889634f * 0.10206207261596575f * 2.0f, FQ32 = 4.0f * 1.4426950408889634f * 0.17677669529663687f, FQ64 = 4.0f * 1.4426950408889634f * 0.125f * 2.0f;
constexpr float P_BIAS = 44.0f / 256.0f, ATT_SCALE = 16.0f;
constexpr int KC_A = 0, KC_B = 1024;
template <int DK>
__device__ __forceinline__ void kread6(i32x6a (&kf)[2][KCfg<DK>::NF], const ALDS char* pA0, const ALDS char* pB0, const ALDS char* pA1, const ALDS char* pB1, int idx) {
    constexpr int NF = KCfg<DK>::NF;
    const int mt = idx / (2 * NF), f = (idx / 2) % NF, part = idx & 1;
    const ALDS char* pA = f ? pA1 : pA0; const ALDS char* pB = f ? pB1 : pB0;
    if (part == 0) { const i32x4a v = *(const ALDS i32x4a*)(pA + mt * 512); kf[mt][f][0] = v.x; kf[mt][f][1] = v.y; kf[mt][f][2] = v.z; kf[mt][f][3] = v.w; }
    else { const i32x2a v = *(const ALDS i32x2a*)(pB + mt * 256); kf[mt][f][4] = v.x; kf[mt][f][5] = v.y; }
}
#define ATT_PV8(C, A, B) asm volatile("s_nop 3\n\tv_mfma_f32_32x32x64_f8f6f4 %0, %1, %2, %0 cbsz:0 blgp:1" : "+v"(C) : "v"(A), "v"(B))
#define ATT_L8(C, A, B) asm volatile("s_nop 3\n\tv_mfma_f32_16x16x128_f8f6f4 %0, %1, %2, %0 cbsz:0 blgp:1" : "+v"(C) : "v"(A), "v"(B))
#define ATT_L8N(C, A, B) asm volatile("v_mfma_f32_16x16x128_f8f6f4 %0, %1, %2, %0 cbsz:0 blgp:1" : "+v"(C) : "v"(A), "v"(B))
#define ATT_PV8N(C, A, B) asm volatile("v_mfma_f32_32x32x64_f8f6f4 %0, %1, %2, %0 cbsz:0 blgp:1" : "+v"(C) : "v"(A), "v"(B))
typedef unsigned short u16x2 __attribute__((ext_vector_type(2)));
__device__ __forceinline__ unsigned pk4_bf8(float a, float b, float c, float d) {
    const u16x2 x = __builtin_amdgcn_cvt_pknorm_u16(a, b), y = __builtin_amdgcn_cvt_pknorm_u16(c, d);
    return __builtin_amdgcn_perm(__builtin_bit_cast(unsigned, y), __builtin_bit_cast(unsigned, x), 0x07050301u); }
struct KPtr { const ALDS char *a0, *b0, *a1, *b1; };
template <int DK, int VLOAD, int ABL = 0, class DF>
__device__ __forceinline__ void att_step9(f32x16& N0, f32x16& N1, const f32x16& P0, const f32x16& P1, i32x6a (&kf)[2][KCfg<DK>::NF], const i32x6a* qfn,
                                          f32x16 (&o)[2], f32x4& L, const i32x8a& pwP, i32x8a& pwC, i32x8a (&vf)[2], const i32x8a& ones, const f32x16& cb, const int& sa, const int& sb,
                                          const ALDS char* vcur, const KPtr k1, const KPtr k0, DF&& dmaf) {
    constexpr int NF = KCfg<DK>::NF;
#define ATP_PACK(i) do { if (!(ABL & 4)) { const int e = 4 * (i); \
        int w = (int)((e < 16) ? pk4_bf8(P0[e & 15], P0[(e + 1) & 15], P0[(e + 2) & 15], P0[(e + 3) & 15]) : pk4_bf8(P1[e & 15], P1[(e + 1) & 15], P1[(e + 2) & 15], P1[(e + 3) & 15])); \
        ATT_PIN(w); pwC[i] = w; } } while (0)
    ATT_SBAR();
    ATT_PV8N(o[0], vf[0], pwP);
    dmaf();
#pragma unroll
    for (int k = 2 * NF; k < 4 * NF; ++k) { if (!(ABL & 8)) kread6<DK>(kf, k1.a0, k1.b0, k1.a1, k1.b1, k); }
#pragma unroll
    for (int i = 0; i < 4; ++i) ATP_PACK(i);
    ATT_SBAR();
    ATT_PV8N(o[1], vf[1], pwP);
    if (VLOAD && !(ABL & 8)) { vf[0].lo = *(const ALDS i32x4a*)(vcur); vf[0].hi = *(const ALDS i32x4a*)(vcur + 1024); }
#pragma unroll
    for (int i = 4; i < 8; ++i) ATP_PACK(i);
    ATT_SBAR();
    ATT_L8N(L, ones, pwP);
    if (VLOAD && !(ABL & 8)) { vf[1].lo = *(const ALDS i32x4a*)(vcur + 512); vf[1].hi = *(const ALDS i32x4a*)(vcur + 512 + 1024); }
    ATT_SBAR();
    if (DK == 64) { ATT_MF6_C(N0, kf[0][0], qfn[0], cb, sa, sb); ATT_MF6_C(N1, kf[1][0], qfn[0], cb, sa, sb); }
    else if (NF == 1) { ATT_MF6_Z(N0, kf[0][0], qfn[0], sa, sb); ATT_MF6_Z(N1, kf[1][0], qfn[0], sa, sb); }
    else { ATT_MF6_Z(N0, kf[0][0], qfn[0], sa, sb); ATT_MF6_Z(N1, kf[1][0], qfn[0], sa, sb); ATT_MF6_A(N0, kf[0][1], qfn[1], sa, sb); ATT_MF6_A(N1, kf[1][1], qfn[1], sa, sb); }
    ATT_SBAR();
#pragma unroll
    for (int k = 0; k < 2 * NF; ++k) { if (!(ABL & 8)) kread6<DK>(kf, k0.a0, k0.b0, k0.a1, k0.b1, k); }
    ATT_SBAR();
#undef ATP_PACK
}
template <int DK, int NMAP, int ABL = 0>
__device__ __forceinline__ void attn_unit_f8(const unsigned char* __restrict__ Qb, const char* __restrict__ Kt, const char* __restrict__ Vt, int t0, int t1,
                                             unsigned char* __restrict__ Ob, ALDS char* lds, float lam, const float* __restrict__ gout, float oml) {
    typedef KCfg<DK> KC;
    constexpr int KTB = KC::KTB, NF = KC::NF, NRD = KC::NRD, LV = 8 * KTB, CB = LV + 8 * 4096, NKP = KTB / 1024, NP = NKP + 4, NDMA = (NP + 7) / 8;
    int tid_l = threadIdx.x; asm volatile("" : "+v"(tid_l));
    const int tid = tid_l, lane = tid & 63, r32 = lane & 31, hi = lane >> 5, wid = __builtin_amdgcn_readfirstlane(tid >> 6);
    i32x6a qbias;
    { u32x16 vq, vk; unsigned pq = 0x40B040B0u, pk = 0x40804080u;
      asm volatile("" : "+v"(pq), "+v"(pk));
#pragma unroll
      for (int r = 0; r < 16; ++r) { vq[r] = (2 * r < KC::NB) ? pq : 0u; vk[r] = (2 * r < KC::NB) ? pk : 0u; }
      qbias = cvt_fp6x32(vq);
      if (DK != 64 && tid == 0) { const i32x6a kb = cvt_fp6x32(vk); const i32x4a ka = {kb[0], kb[1], kb[2], kb[3]}; const i32x2a kc = {kb[4], kb[5]};
          *(ALDS i32x4a*)(lds + CB + KC_A) = ka; *(ALDS i32x4a*)(lds + CB + KC_A + 512) = ka; *(ALDS i32x2a*)(lds + CB + KC_B) = kc; *(ALDS i32x2a*)(lds + CB + KC_B + 256) = kc; } }
    i32x6a qf[NMAP][NF];
    { const unsigned char* qrow = Qb + (size_t)(wid * 32 + r32) * KC::QRB;
#define ATP_QG(dst, off) do { const i32x2a a_ = *(const i32x2a*)(qrow + (off)), b_ = *(const i32x2a*)(qrow + (off) + 8), c_ = *(const i32x2a*)(qrow + (off) + 16); \
          dst[0] = a_.x; dst[1] = a_.y; dst[2] = b_.x; dst[3] = b_.y; dst[4] = c_.x; dst[5] = c_.y; } while (0)
      if (DK == 64) { ATP_QG(qf[0][0], 24 * hi); }
      else if (DK == 96) { ATP_QG(qf[0][0], 24 * hi); i32x6a t; ATP_QG(t, 48);
#pragma unroll
          for (int r = 0; r < 6; ++r) qf[0][NF - 1][r] = hi ? qbias[r] : t[r]; }
      else {
#pragma unroll
          for (int m = 0; m < NMAP; ++m) { i32x6a t; ATP_QG(t, 24 * m);
#pragma unroll
              for (int r = 0; r < 6; ++r) qf[m][0][r] = hi ? qbias[r] : t[r]; } }
#undef ATP_QG
    }
#pragma unroll
    for (int m = 0; m < NMAP; ++m)
#pragma unroll
        for (int f = 0; f < NF; ++f) ATT_PIN(qf[m][f]);
    f32x16 o[NMAP][2], cb; f32x4 L[NMAP]; i32x8a pw, ones; int sa = 0x7F7F7F7F, sb = KC::SCL;
    ATT_PIN(sa); ATT_PIN(sb);
#pragma unroll
    for (int r = 0; r < 16; ++r) cb[r] = P_BIAS;
    if (DK == 64) ATT_PIN(cb);
    { const int sel = (lane == 0 || lane == 32 || lane == 17 || lane == 49) ? 0x38383838 : 0;
#pragma unroll
      for (int r = 0; r < 8; ++r) { pw[r] = 0; ones[r] = sel; } }
    ATT_PIN(ones);
#pragma unroll
    for (int m = 0; m < NMAP; ++m) {
#pragma unroll
        for (int r = 0; r < 4; ++r) L[m][r] = 0.f;
#pragma unroll
        for (int d = 0; d < 2; ++d)
#pragma unroll
            for (int r = 0; r < 16; ++r) o[m][d][r] = 0.f; }
#pragma unroll
    for (int m = 0; m < NMAP; ++m) { ATT_PIN(L[m]); ATT_PIN(o[m][0]); ATT_PIN(o[m][1]); }
    const unsigned lds0 = (unsigned)(size_t)lds;
    const char* src0; unsigned dst0; int isv0; const bool act0 = wid < NP;
    { const int p = wid; isv0 = p >= NKP; src0 = (isv0 ? Vt + (p - NKP) * 1024 : Kt + p * 1024); dst0 = lds0 + (isv0 ? LV + (p - NKP) * 1024 : p * 1024); }
    const unsigned lane16 = (unsigned)lane * 16u;
    const bool act1 = (NDMA == 2) && wid == 7;
    const char* src1 = nullptr; unsigned dst1 = 0u;
    if (NDMA == 2) { const int p = 8; src1 = Vt + (p - NKP) * 1024; dst1 = lds0 + LV + (p - NKP) * 1024; }
#define ATP_DMA(tk, tv) do { if (ABL & (2 | 32)) break; \
        if (act0) { if (isv0) glds16s(src0 + (size_t)(tv) * 4096, lane16, (unsigned)__builtin_amdgcn_readfirstlane(dst0 + ((tv) & 7) * 4096)); else glds16s(src0 + (size_t)(tk) * KTB, lane16, (unsigned)__builtin_amdgcn_readfirstlane(dst0 + ((tk) & 7) * KTB)); } \
        if (act1) glds16s(src1 + (size_t)(tv) * 4096, lane16, (unsigned)__builtin_amdgcn_readfirstlane(dst1 + ((tv) & 7) * 4096)); } while (0)
#define ATP_SYNCALL() do { if (ABL & 2) break; if (!(ABL & 128)) { if (act1) asm volatile("s_waitcnt vmcnt(4)" ::: "memory"); else asm volatile("s_waitcnt vmcnt(2)" ::: "memory"); } \
        if (!(ABL & 64)) asm volatile("s_barrier" ::: "memory"); } while (0)
    const bool c0 = (DK == 32) && hi, c1 = hi;
    const int ka0 = c0 ? CB + KC_A : ((DK == 32) ? 0 : hi * 1024) + r32 * 16, kb0 = c0 ? CB + KC_B : KC::PB + ((DK == 32) ? 0 : hi * 512) + r32 * 8, km0 = c0 ? 0 : KTB;
    const int dA = (DK == 32 && !hi) ? 1024 : 0, dB = (DK == 32 && !hi) ? 512 : 0;
    const int ka1 = c1 ? CB + KC_A : 2048 + r32 * 16, kb1 = c1 ? CB + KC_B : KC::PB + 1024 + r32 * 8, km1 = c1 ? 0 : KTB;
#define ATP_KP(t, m) (KPtr{lds + ((t) & 7) * km0 + ka0 + (m) * dA, lds + ((t) & 7) * km0 + kb0 + (m) * dB, lds + ((t) & 7) * km1 + ka1, lds + ((t) & 7) * km1 + kb1})
#define ATP_VB(t) (lds + LV + ((t) & 7) * 4096 + klane64)
#define ATP_KLOAD(t, m) do { const KPtr kp_ = ATP_KP(t, m); _Pragma("unroll") for (int k = 0; k < NRD; ++k) kread6<DK>(kf, kp_.a0, kp_.b0, kp_.a1, kp_.b1, k); \
        asm volatile("s_waitcnt lgkmcnt(0)" ::: "memory"); \
        _Pragma("unroll") for (int mt_ = 0; mt_ < 2; ++mt_) _Pragma("unroll") for (int f_ = 0; f_ < NF; ++f_) ATT_PIN(kf[mt_][f_]);     \
        asm volatile("s_nop 3" ::: "memory"); } while (0)
    const int klane64 = hi * 2048 + r32 * 16;
    ATP_DMA(t0, t0); ATP_DMA(t0 + 1, t0 + 1); ATP_DMA(t0 + 2, t0 + 1); if (NMAP == 1) ATP_DMA(t0 + 3, t0 + 1);
    asm volatile("s_waitcnt vmcnt(0) lgkmcnt(0)\n\ts_barrier" ::: "memory");
    if (NMAP == 1) { ATP_DMA(t0 + 4, t0 + 2); ATP_DMA(t0 + 5, t0 + 3); } else { ATP_DMA(t0 + 3, t0 + 2); ATP_DMA(t0 + 4, t0 + 3); }
    i32x6a kf[2][NF]; i32x8a vf[2], pwB;
    f32x16 sA0, sA1, sB0, sB1;
    ATP_KLOAD(t0, 0);
    if (DK == 64) { ATT_MF6_C(sA0, kf[0][0], qf[0][0], cb, sa, sb); ATT_MF6_C(sA1, kf[1][0], qf[0][0], cb, sa, sb); } else { ATT_MF6_Z(sA0, kf[0][0], qf[0][0], sa, sb); ATT_MF6_Z(sA1, kf[1][0], qf[0][0], sa, sb); }
    if (NF == 2) { ATT_MF6_A(sA0, kf[0][1], qf[0][1], sa, sb); ATT_MF6_A(sA1, kf[1][1], qf[0][1], sa, sb); }
    asm volatile("s_nop 15\n\ts_nop 15\n\ts_nop 15\n\ts_nop 15\n\ts_nop 15\n\ts_nop 15" : "+v"(sA0), "+v"(sA1));
    { const KPtr kp_ = (NMAP == 1) ? ATP_KP(t0 + 1, 0) : ATP_KP(t0, 1);
#pragma unroll
      for (int k = 0; k < 2 * NF; ++k) kread6<DK>(kf, kp_.a0, kp_.b0, kp_.a1, kp_.b1, k); }
#pragma unroll
    for (int r = 0; r < 8; ++r) { vf[0][r] = 0; vf[1][r] = 0; pwB[r] = 0; }
    ATT_PIN(vf[0]); ATT_PIN(vf[1]); ATT_PIN(pwB);
    asm volatile("s_nop 3" ::: "memory");
    if (NMAP == 1) {
        for (int t = t0; t < t1; t += 2) {
            att_step9<DK, 1, ABL>(sB0, sB1, sA0, sA1, kf, qf[0], o[0], L[0], pwB, pw, vf, ones, cb, sa, sb, ATP_VB(t), ATP_KP(t + 1, 0), ATP_KP(t + 2, 0), [&]() { ATP_DMA(t + 6, t + 4); ATP_DMA(t + 7, t + 5); });
            att_step9<DK, 1, ABL>(sA0, sA1, sB0, sB1, kf, qf[0], o[0], L[0], pw, pwB, vf, ones, cb, sa, sb, ATP_VB(t + 1), ATP_KP(t + 2, 0), ATP_KP(t + 3, 0), [&]() {});
            ATP_SYNCALL();
        }
    } else {
        for (int t = t0; t < t1; t += 2) {
            att_step9<DK, 1, ABL>(sB0, sB1, sA0, sA1, kf, qf[1], o[1], L[1], pwB, pw, vf, ones, cb, sa, sb, ATP_VB(t), ATP_KP(t, 1), ATP_KP(t + 1, 0), [&]() { ATP_DMA(t + 5, t + 4); });
            att_step9<DK, 0, ABL>(sA0, sA1, sB0, sB1, kf, qf[0], o[0], L[0], pw, pwB, vf, ones, cb, sa, sb, ATP_VB(t), ATP_KP(t + 1, 0), ATP_KP(t + 1, 1), [&]() { ATP_DMA(t + 6, t + 5); });
            att_step9<DK, 1, ABL>(sB0, sB1, sA0, sA1, kf, qf[1], o[1], L[1], pwB, pw, vf, ones, cb, sa, sb, ATP_VB(t + 1), ATP_KP(t + 1, 1), ATP_KP(t + 2, 0), [&]() {});
            att_step9<DK, 0, ABL>(sA0, sA1, sB0, sB1, kf, qf[0], o[0], L[0], pw, pwB, vf, ones, cb, sa, sb, ATP_VB(t + 1), ATP_KP(t + 2, 0), ATP_KP(t + 2, 1), [&]() {});
            ATP_SYNCALL();
        }
    }
    ATT_SBAR();
    ATT_PV8N(o[NMAP - 1][0], vf[0], pwB); ATT_PV8N(o[NMAP - 1][1], vf[1], pwB); ATT_L8N(L[NMAP - 1], ones, pwB);
    asm volatile("s_waitcnt vmcnt(0) lgkmcnt(0)\n\ts_barrier" ::: "memory");
#pragma unroll
    for (int m = 0; m < NMAP; ++m) asm volatile("s_nop 15\n\ts_nop 15\n\ts_nop 15\n\ts_nop 15\n\ts_nop 15" : "+v"(o[m][0]), "+v"(o[m][1]), "+v"(L[m]));
#undef ATP_DMA
#undef ATP_SYNCALL
#undef ATP_KP
#undef ATP_VB
#undef ATP_KLOAD
    float li[NMAP];
#pragma unroll
    for (int m = 0; m < NMAP; ++m) { const float l0 = __shfl(L[m][0], r32 & 15), l1 = __shfl(L[m][1], r32 & 15); li[m] = 1.0f / ((r32 & 16) ? l1 : l0); }
    float val[2][16];
    if (NMAP == 1) {
#pragma unroll
        for (int d = 0; d < 2; ++d)
#pragma unroll
            for (int r = 0; r < 16; ++r) val[d][r] = o[0][d][r] * li[0];
    } else {
        float ss = 0.f; const float l2 = lam * li[NMAP - 1];
#pragma unroll
        for (int d = 0; d < 2; ++d)
#pragma unroll
            for (int r = 0; r < 16; ++r) { const float v = o[0][d][r] * li[0] - o[NMAP - 1][d][r] * l2; val[d][r] = v; ss += v * v; }
        ss += __shfl_xor(ss, 32);
        const float rstd = rsqrtf(ss * (1.0f / 64.0f) + 1e-6f) * oml;
#pragma unroll
        for (int d = 0; d < 2; ++d)
#pragma unroll
            for (int g = 0; g < 4; ++g) { const f32x4 gv = *(const f32x4*)(gout + 32 * d + 8 * g + 4 * hi);
#pragma unroll
                for (int i = 0; i < 4; ++i) val[d][4 * g + i] *= rstd * gv[i]; }
    }
    unsigned char* orow = Ob + (size_t)(wid * 32 + r32) * 1024 + 4 * hi;
#pragma unroll
    for (int d = 0; d < 2; ++d)
#pragma unroll
        for (int g = 0; g < 4; ++g) { float v4[4];
#pragma unroll
            for (int i = 0; i < 4; ++i) v4[i] = fminf(fmaxf(val[d][4 * g + i] * ATT_SCALE, -448.0f), 448.0f);
            int w = __builtin_amdgcn_cvt_pk_fp8_f32(v4[0], v4[1], 0, false); w = __builtin_amdgcn_cvt_pk_fp8_f32(v4[2], v4[3], w, true);
            *(unsigned*)(orow + 32 * d + 8 * g) = (unsigned)w; }
}

}
constexpr int NWAVES = 8;
constexpr int DM = 1024, NB = 4, SEQ = 8192, CL = 256, NTOKB = SEQ + CL, LROWS = NB * SEQ, MROWS = LROWS + NB * CL;
constexpr int NLAYER = 2, INC = 1952, ZP = 3072, NE = 16, FFD = 2048, CAPL = 1024, CAPC = 32, NKT = NTOKB / 64;
constexpr int ZQ = 1952, ZKV = 2336, ZEND = 2848;
constexpr float EPSF = 1e-6f, LOG2E = 1.4426950408889634f, HID_SCALE = 4.0f, YE_SCALE = 32.0f, WO_SCALE = 32.0f;
constexpr int N_PHASES = 22;
enum { I_X = 0, I_C, I_CTX, I_CCTX, I_WADA, I_BADA, I_GN1, I_WIN, I_GCQ, I_GCKV, I_WUQ, I_WUKV, I_GMQ, I_GMK, I_GDQ, I_GDK, I_LQ1, I_LK1, I_LQ2, I_LK2, I_GDO, I_GGQ, I_GGK, I_WO, I_GN2, I_WR, I_WG, I_WU, I_WD, N_IN };
constexpr size_t MiB = 1u << 20;
constexpr size_t WS_CTL = 0, CTL_ZERO_BYTES = 1 * MiB;
constexpr size_t WS_MOD = 1 * MiB;
constexpr size_t WS_LAM = WS_MOD + 256 * 1024;
constexpr size_t WS_TAB = WS_MOD + 320 * 1024;
constexpr size_t TAB_AROW = 0, TAB_ACOL = 128 * 8 * 8, TAB_GROW = TAB_ACOL + 64 * 8 * 8, TAB_GCOL = TAB_GROW + 128 * 16 * 8;
constexpr size_t WS_AFF = 2 * MiB, WS_AFFC = 4 * MiB;
constexpr size_t WS_IDX = 5 * MiB, WS_GATE = 6 * MiB;
constexpr size_t WS_INV = 7 * MiB;
constexpr size_t WS_SA = 10 * MiB, WS_SAE = 11 * MiB, WS_SW = 12 * MiB;
constexpr size_t WS_SSQ = 14 * MiB;
constexpr size_t WS_SWC = 13 * MiB;
constexpr size_t WS_WCAT8 = 72 * MiB;
constexpr size_t WS_WCAT = 16 * MiB;
constexpr size_t WS_WO = 28 * MiB;
constexpr size_t WS_CTXW = 32 * MiB;
constexpr size_t WS_H = 36 * MiB;
constexpr size_t WS_WGU = 102 * MiB;
constexpr size_t WS_WD = 230 * MiB;
constexpr size_t WS_YE = 294 * MiB;
constexpr size_t WS_Z = 430 * MiB;
constexpr size_t WS_QKV = 628 * MiB;
constexpr size_t WS_ATT = 793 * MiB;
constexpr size_t WS_DELTA = 430 * MiB;
constexpr size_t WS_XE = 430 * MiB;
constexpr size_t WS_HID = 566 * MiB;
constexpr size_t WS_XB = 859 * MiB;
constexpr size_t WS_END = 925 * MiB;
constexpr size_t QO_QM = 0, QO_QD = 25952256, QO_QG = 43253760, QO_KM = 77856768, QO_KD = 103809024, QO_KG = 121110528, QO_VM = 129761280, QO_VD = 147062784, QO_VG = 164364288;
static_assert(QO_VG + 8650752 == 173015040 && WS_QKV + 173015040 <= WS_ATT && WS_HID + (size_t)16 * 4352 * 2048 * 2 <= WS_XB, "ws map");
constexpr int CW_BAR = 4096, CW_Q = 16384;
constexpr int RING_BYTES = 131072, LDSCTL_OFF = RING_BYTES, MISC_OFF = LDSCTL_OFF + 320, LDS_BYTES = 163840;

#define GAS __attribute__((address_space(1)))
#define LAS __attribute__((address_space(3)))
typedef unsigned short bf16;
typedef unsigned v4u __attribute__((ext_vector_type(4)));
typedef unsigned v2u __attribute__((ext_vector_type(2)));
typedef float f32x4 __attribute__((ext_vector_type(4)));
typedef float f32x2 __attribute__((ext_vector_type(2)));
typedef GAS unsigned gu32;
#define RLX_AGENT __ATOMIC_RELAXED, __HIP_MEMORY_SCOPE_AGENT
#define LDS_WAIT() asm volatile("s_waitcnt lgkmcnt(0)" ::: "memory")
__device__ __forceinline__ unsigned pk2(float lo, float hi) { return att::cvtpk(lo, hi); }
__device__ __forceinline__ float bflo(unsigned w) { return __uint_as_float(w << 16); }
__device__ __forceinline__ float bfhi(unsigned w) { return __uint_as_float(w & 0xffff0000u); }
#define XB_TMO      128
#define XB_XCNT(j)  (256  + 64 * (j))
#define XB_XSUB(j)  (1280 + 64 * (j))
#define XB_XGEN(j)  (2304 + 64 * (j))
#define XB_TOP      3328
#define XB_TOPGEN   3392
#define XCD_BAR_WORDS 3456
#define XB_SPIN_CAP (1u << 18)

__device__ __forceinline__ unsigned xb_ld(unsigned* p)              { return __hip_atomic_load(p, __ATOMIC_RELAXED, __HIP_MEMORY_SCOPE_AGENT); }
__device__ __forceinline__ unsigned xb_add(unsigned* p, unsigned v) { return __hip_atomic_fetch_add(p, v, __ATOMIC_RELAXED, __HIP_MEMORY_SCOPE_AGENT); }
__device__ __forceinline__ unsigned xb_xcc_id() { return (unsigned)__builtin_amdgcn_s_getreg((3 << 11) | 20) & 0xFu; }
#define XB_SPIN(cond, bar) do { unsigned _sp = 0; while (cond) { __builtin_amdgcn_s_sleep(1); \
    if ((++_sp & 255u) == 0u) { if (xb_ld(&(bar)[XB_TMO])) break; if (_sp > XB_SPIN_CAP) { atomicAdd(&(bar)[XB_TMO], 1u); break; } } } } while (0)

struct XcdBarrier {
    unsigned* bar; unsigned x;
    volatile LAS unsigned* st;
};

__device__ __forceinline__ XcdBarrier xcd_barrier_post(unsigned* bar, volatile LAS unsigned* st) {
    XcdBarrier b; b.bar = bar; b.x = xb_xcc_id(); b.st = st;
    if (threadIdx.x == 0) (void)xb_add(&bar[XB_XCNT(b.x)], 1u);
    return b;
}
__device__ __forceinline__ void xcd_barrier_complete(unsigned* bar, unsigned x, unsigned& nloc, unsigned& nx) {
    const unsigned G = gridDim.x * gridDim.y * gridDim.z;
    unsigned sum, cnt, mine, sp = 0u;
    for (;;) {
        sum = 0u; cnt = 0u; mine = 0u;
#pragma unroll
        for (unsigned j = 0; j < 16; ++j) { const unsigned c = xb_ld(&bar[XB_XCNT(j)]); sum += c; cnt += (c > 0u) ? 1u : 0u; mine = (j == x) ? c : mine; }
        if (sum == G) break;
        __builtin_amdgcn_s_sleep(1);
        if ((++sp & 255u) == 0u) { if (xb_ld(&bar[XB_TMO])) break; if (sp > XB_SPIN_CAP) { atomicAdd(&bar[XB_TMO], 1u); break; } }
    }
    nloc = mine > 0u ? mine : 1u; nx = cnt > 0u ? cnt : 1u;
}

__device__ __forceinline__ void xcd_barrier(const XcdBarrier& b) {
    asm volatile("s_waitcnt vmcnt(0)" ::: "memory");
    __syncthreads();
    if (threadIdx.x == 0) {
        unsigned* bar = b.bar;
        __builtin_amdgcn_s_waitcnt(0);
        unsigned nloc = b.st[0], nx = b.st[1];
        if (nloc == 0u) { xcd_barrier_complete(bar, b.x, nloc, nx); b.st[0] = nloc; b.st[1] = nx; }
        const unsigned old = xb_add(&bar[XB_XSUB(b.x)], 1u);
        const unsigned gen = old / nloc;
        if (old + 1u == (gen + 1u) * nloc) {
            __builtin_amdgcn_fence(__ATOMIC_RELEASE, "agent");
            asm volatile("s_waitcnt vmcnt(0)" ::: "memory");
            const unsigned og = xb_add(&bar[XB_TOP], 1u);
            const unsigned tg = og / nx;
            if (og + 1u == (tg + 1u) * nx) xb_add(&bar[XB_TOPGEN], 1u);
            else XB_SPIN(xb_ld(&bar[XB_TOPGEN]) == tg, bar);
            __builtin_amdgcn_fence(__ATOMIC_ACQUIRE, "agent");
            xb_add(&bar[XB_XGEN(b.x)], 1u);
            asm volatile("s_waitcnt vmcnt(0)" ::: "memory");
        } else {
            XB_SPIN(xb_ld(&bar[XB_XGEN(b.x)]) == gen, bar);
            __builtin_amdgcn_fence(__ATOMIC_ACQUIRE, "agent");
            asm volatile("s_waitcnt vmcnt(0)" ::: "memory");
        }
    }
    __syncthreads();
}
struct Args { const float* in[N_IN]; float* out; unsigned char* ws; int ph_lo, ph_hi; };
static_assert(sizeof(Args) == 256, "Args has no padding bytes");
typedef const __attribute__((address_space(4))) Args* KA;
__device__ __forceinline__ KA kargs() { KA p = (KA)__builtin_amdgcn_kernarg_segment_ptr(); asm volatile("" : "+s"(p)); return p; }
struct Frame {
    LAS unsigned char* lds;
    volatile LAS unsigned* MISC;
    gu32* ctl;
    int tid, lane, wave, vcu, G;
};
__device__ __forceinline__ void relane(Frame& F) { int t = threadIdx.x; asm volatile("" : "+v"(t)); F.tid = t; F.lane = t & 63; F.wave = __builtin_amdgcn_readfirstlane(t >> 6); }
__device__ __forceinline__ float wave_sum(float v) {
#pragma unroll
    for (int o = 1; o < 64; o <<= 1) v += __shfl_xor(v, o);
    return v;
}
__device__ __forceinline__ float silu_f(float x) { return x / (1.0f + __expf(-x)); }

__device__ __forceinline__ void transpose_item(const float* __restrict__ W, int N, bf16* __restrict__ WT, int ldt, int k0, int n0, int rowbase, LAS float* scr, int lane) {
    float tv[32];
    { const float* wp = W + (size_t)(k0 + (lane >> 5)) * N + n0 + (lane & 31);
#pragma unroll
      for (int i = 0; i < 32; ++i) tv[i] = __builtin_nontemporal_load(wp + (size_t)(2 * i) * N); }
#pragma unroll
    for (int i = 0; i < 32; ++i) scr[(2 * i + (lane >> 5)) * 33 + (lane & 31)] = tv[i];
    LDS_WAIT(); asm volatile("" ::: "memory");
    const int c = lane & 7;
#pragma unroll
    for (int j = 0; j < 4; ++j) { const int n = (lane >> 3) + 8 * j; const LAS float* s = scr + (8 * c) * 33 + n;
        v4u o; o.x = pk2(s[0 * 33], s[1 * 33]); o.y = pk2(s[2 * 33], s[3 * 33]); o.z = pk2(s[4 * 33], s[5 * 33]); o.w = pk2(s[6 * 33], s[7 * 33]);
        *(v4u*)(WT + (size_t)(rowbase + n) * ldt + k0 + 8 * c) = o; }
    LDS_WAIT(); asm volatile("" ::: "memory");
}

__device__ __forceinline__ void transpose_item_i8(const float* __restrict__ W, int N, signed char* __restrict__ WT, int ldt, int k0, int n0, int rowbase, float qs, LAS float* scr, int lane) {
    float tv[32];
    { const float* wp = W + (size_t)(k0 + (lane >> 5)) * N + n0 + (lane & 31);
#pragma unroll
      for (int i = 0; i < 32; ++i) tv[i] = __builtin_nontemporal_load(wp + (size_t)(2 * i) * N); }
#pragma unroll
    for (int i = 0; i < 32; ++i) scr[(2 * i + (lane >> 5)) * 33 + (lane & 31)] = tv[i];
    LDS_WAIT(); asm volatile("" ::: "memory");
    const int c = lane & 3;
#pragma unroll
    for (int j = 0; j < 2; ++j) { const int n = (lane >> 2) + 16 * j; const LAS float* s = scr + (16 * c) * 33 + n; v4u o;
#pragma unroll
        for (int d = 0; d < 4; ++d) { unsigned w = 0u;
#pragma unroll
            for (int i = 0; i < 4; ++i) { const float f = fminf(fmaxf(s[(4 * d + i) * 33] * qs, -127.0f), 127.0f); w |= ((unsigned)((int)__builtin_rintf(f)) & 255u) << (8 * i); }
            o[d] = w; }
        *(v4u*)(WT + (size_t)(rowbase + n) * ldt + k0 + 16 * c) = o; }
    LDS_WAIT(); asm volatile("" ::: "memory");
}

__device__ __forceinline__ void transpose_item_f8(const float* __restrict__ W, int N, unsigned char* __restrict__ WT, int ldt, int k0, int n0, int rowbase, float qs, LAS float* scr, int lane) {
    float tv[32];
    { const float* wp = W + (size_t)(k0 + (lane >> 5)) * N + n0 + (lane & 31);
#pragma unroll
      for (int i = 0; i < 32; ++i) tv[i] = __builtin_nontemporal_load(wp + (size_t)(2 * i) * N); }
#pragma unroll
    for (int i = 0; i < 32; ++i) scr[(2 * i + (lane >> 5)) * 33 + (lane & 31)] = tv[i];
    LDS_WAIT(); asm volatile("" ::: "memory");
    const int c = lane & 3;
#pragma unroll
    for (int j = 0; j < 2; ++j) { const int n = (lane >> 2) + 16 * j; const LAS float* s = scr + (16 * c) * 33 + n; v4u o;
#pragma unroll
        for (int d = 0; d < 4; ++d) { float f[4];
#pragma unroll
            for (int i = 0; i < 4; ++i) f[i] = fminf(fmaxf(s[(4 * d + i) * 33] * qs, -448.0f), 448.0f);
            int w = __builtin_amdgcn_cvt_pk_fp8_f32(f[0], f[1], 0, false); w = __builtin_amdgcn_cvt_pk_fp8_f32(f[2], f[3], w, true); o[d] = (unsigned)w; }
        *(v4u*)(WT + (size_t)(rowbase + n) * ldt + k0 + 16 * c) = o; }
    LDS_WAIT(); asm volatile("" ::: "memory");
}

__device__ __forceinline__ void sincos_d(float af, float& c, float& s) {
    const double a = (double)af;
    const double q = __builtin_rint(a * 0.63661977236758134308);
    double r = __builtin_fma(-q, 1.57079632679489655800e+00, a); r = __builtin_fma(-q, 6.12323399573676603587e-17, r);
    const double r2 = r * r;
    double sp = -7.6471637318198164759e-13; sp = sp * r2 + 1.6059043836821614599e-10; sp = sp * r2 - 2.5052108385441718775e-08; sp = sp * r2 + 2.7557319223985890653e-06;
    sp = sp * r2 - 1.9841269841269841270e-04; sp = sp * r2 + 8.3333333333333333333e-03; sp = sp * r2 - 1.6666666666666666667e-01; const double sn = r + r * r2 * sp;
    double cp = 4.7794773323873852974e-14; cp = cp * r2 - 1.1470745597729724714e-11; cp = cp * r2 + 2.0876756987868098979e-09; cp = cp * r2 - 2.7557319223985890653e-07;
    cp = cp * r2 + 2.4801587301587301587e-05; cp = cp * r2 - 1.3888888888888888889e-03; cp = cp * r2 + 4.1666666666666666667e-02; cp = cp * r2 - 0.5; const double cs = 1.0 + r2 * cp;
    const int qi = (int)q & 3;
    const double cc = (qi == 0) ? cs : (qi == 1) ? -sn : (qi == 2) ? -cs : sn;
    const double ss = (qi == 0) ? sn : (qi == 1) ? cs : (qi == 2) ? -sn : -cs;
    c = (float)cc; s = (float)ss;
}

#define MEMFENCE() asm volatile("" ::: "memory")
__device__ __forceinline__ void p0_prologue(KA a, Frame& F) {
    relane(F);
    unsigned char* ws = a->ws;
    float* MOD = (float*)(ws + WS_MOD);
    if ((int)blockIdx.x < 192) {
        LAS float* sl = (LAS float*)F.lds + 4096;
        for (int i = F.tid; i < 5 * 1024; i += NWAVES * 64) { const int v = i >> 10, k = i & 1023; const float cv = (v < 4) ? a->in[I_C][v * 1024 + k] : a->in[I_CCTX][k]; sl[i] = silu_f(cv); }
        __syncthreads();
        for (int it = blockIdx.x; it < 192; it += F.G) {
            const int l = it / 96, col = (it % 96) * 64 + F.lane;
            const float* W = a->in[I_WADA] + (size_t)l * 1024 * 6144;
            float acc[5] = {0.f, 0.f, 0.f, 0.f, 0.f};
#pragma unroll 8
            for (int kk = 0; kk < 128; ++kk) { const int k = F.wave * 128 + kk; const float w = W[(size_t)k * 6144 + col];
#pragma unroll
                for (int v = 0; v < 5; ++v) acc[v] += sl[v * 1024 + k] * w; }
            LAS float* red = (LAS float*)F.lds;
#pragma unroll
            for (int v = 0; v < 5; ++v) red[(F.wave * 5 + v) * 64 + F.lane] = acc[v];
            __syncthreads();
            if (F.wave < 5) { float s2 = a->in[I_BADA][l * 6144 + col];
#pragma unroll
                for (int w = 0; w < 8; ++w) s2 += red[(w * 5 + F.wave) * 64 + F.lane];
                MOD[(l * 5 + F.wave) * 6144 + col] = s2; }
            __syncthreads();
        }
    }
    for (int it = blockIdx.x; it < 96; it += F.G) {
        const int l = it / 48, e = (it % 48) / 3, which = it % 3;
        float ss = 0.f;
        if (which < 2) { const float* W = (which ? a->in[I_WU] : a->in[I_WG]) + ((size_t)l * NE + e) * 1024 * 2048;
            for (int i = 0; i < 32; ++i) { const f32x4 v = *(const f32x4*)(W + (size_t)(32 * i) * 2048 + 4 * F.tid); ss += (v.x * v.x + v.y * v.y) + (v.z * v.z + v.w * v.w); } }
        else { const float* W = a->in[I_WD] + ((size_t)l * NE + e) * 2048 * 1024;
            for (int i = 0; i < 64; ++i) { const f32x2 v = *(const f32x2*)(W + (size_t)(32 * i) * 1024 + 2 * F.tid); ss += v.x * v.x + v.y * v.y; } }
        ss = wave_sum(ss);
        LAS float* red = (LAS float*)F.lds;
        if (F.lane == 0) red[F.wave] = ss;
        __syncthreads();
        if (F.tid == 0) { float t = 0.f; for (int w = 0; w < NWAVES; ++w) t += red[w]; const float rms = fmaxf(sqrtf(t * (1.0f / 65536.0f)), 1e-20f);
            ((float*)(ws + WS_SW))[l * 48 + 3 * e + which] = (which < 2) ? 5.0f * rms * (1.0f / 127.0f) : rms * (1.0f / 16.0f); }
        __syncthreads();
    }
    if ((int)blockIdx.x == 192 % F.G && F.wave == 0) {
        float* LAM = (float*)(ws + WS_LAM);
        for (int l = 0; l < NLAYER; ++l) {
            const float p1 = F.lane < 32 ? a->in[I_LQ1][l * 32 + F.lane] * a->in[I_LK1][l * 32 + F.lane] : 0.f;
            const float p2 = F.lane < 32 ? a->in[I_LQ2][l * 32 + F.lane] * a->in[I_LK2][l * 32 + F.lane] : 0.f;
            const float s1 = wave_sum(p1), s2 = wave_sum(p2);
            const float li = 0.8f - 0.6f * expf(-0.3f * (float)l);
            if (F.lane == 0) { LAM[2 * l] = expf(s1) - expf(s2) + li; LAM[2 * l + 1] = li; }
        }
    }
    if ((int)blockIdx.x == 193 % F.G) {
        f32x2* TA_R = (f32x2*)(ws + WS_TAB + TAB_AROW); f32x2* TA_C = (f32x2*)(ws + WS_TAB + TAB_ACOL); f32x2* TG_R = (f32x2*)(ws + WS_TAB + TAB_GROW); f32x2* TG_C = (f32x2*)(ws + WS_TAB + TAB_GCOL);
        const double b8 = 1.0 / __builtin_sqrt(__builtin_sqrt(__builtin_sqrt(10000.0))), b16 = 1.0 / __builtin_sqrt(__builtin_sqrt(__builtin_sqrt(__builtin_sqrt(10000.0))));
        for (int e = F.tid; e < 4608; e += NWAVES * 64) {
            int pos, i, nf; f32x2* dst;
            if (e < 1024) { pos = e >> 3; i = e & 7; nf = 8; dst = TA_R + e; }
            else if (e < 1536) { const int r = e - 1024; pos = r >> 3; i = r & 7; nf = 8; dst = TA_C + r; }
            else if (e < 3584) { const int r = e - 1536; pos = r >> 4; i = r & 15; nf = 16; dst = TG_R + r; }
            else { const int r = e - 3584; pos = r >> 4; i = r & 15; nf = 16; dst = TG_C + r; }
            double inv = 1.0; const double bb = (nf == 8) ? b8 : b16;
            for (int j = 0; j < i; ++j) inv *= bb;
            const float ang = (float)pos * (float)inv;
            float c, s; sincos_d(ang, c, s);
            *dst = (f32x2){c, s};
        }
    }
    for (int it = blockIdx.x; it < 896; it += F.G) {
        const int l = it / 448; int r = it % 448;
        int kb, nb, R, roff, ncols, orow0; const float *Wu, *gg;
        if (r < 192) { kb = r / 6; nb = r % 6; R = 256; roff = 0; ncols = 384; orow0 = ZQ + nb * 64; Wu = a->in[I_WUQ] + (size_t)l * 256 * 384; gg = a->in[I_GCQ] + l * 256; }
        else { r -= 192; kb = r / 8; nb = r % 8; R = 128; roff = 256; ncols = 512; orow0 = ZKV + nb * 64; Wu = a->in[I_WUKV] + (size_t)l * 128 * 512; gg = a->in[I_GCKV] + l * 128; }
        const float* Win = a->in[I_WIN] + (size_t)l * 1024 * INC;
        LAS float* As = (LAS float*)F.lds; LAS float* Bs = As + 32 * 257;
        for (int idx = F.tid; idx < 32 * R; idx += NWAVES * 64) { const int kk = idx / R, rr = idx % R; As[kk * 257 + rr] = Win[(size_t)(kb * 32 + kk) * INC + roff + rr]; }
        for (int idx = F.tid; idx < R * 64; idx += NWAVES * 64) { const int rr = idx >> 6, n = idx & 63; Bs[rr * 64 + n] = gg[rr] * Wu[(size_t)rr * ncols + nb * 64 + n]; }
        __syncthreads();
        const int kk = F.tid & 31, ng = F.tid >> 5;
        f32x4 acc = (f32x4){0.f, 0.f, 0.f, 0.f};
        for (int rr = 0; rr < R; ++rr) { const float av = As[kk * 257 + rr]; const f32x4 bv = *(const LAS f32x4*)(Bs + rr * 64 + ng * 4); acc += av * bv; }
        bf16* Wc = (bf16*)(ws + WS_WCAT) + (size_t)l * ZP * 1024;
#pragma unroll
        for (int j = 0; j < 4; ++j) Wc[(size_t)(orow0 + ng * 4 + j) * 1024 + kb * 32 + kk] = (bf16)(pk2(acc[j], 0.f) & 0xffffu);
        __syncthreads();
    }
    {
        LAS float* scr = (LAS float*)(F.lds + F.wave * 16384);
        const int gw = F.vcu * NWAVES + F.wave, NGW = F.G * NWAVES;
        constexpr int I_IN = 16 * 61, I_O = 16 * 32, PER_L = I_IN + I_O;
        for (int it = gw; it < NLAYER * PER_L; it += NGW) {
            const int l = it / PER_L; int r = it % PER_L;
            if (r < I_IN) { const int kb = r / 61, nb = r % 61; transpose_item(a->in[I_WIN] + (size_t)l * 1024 * INC, INC, (bf16*)(ws + WS_WCAT) + (size_t)l * ZP * 1024, 1024, kb * 64, nb * 32, nb * 32, scr, F.lane); }
            else { r -= I_IN; const int kb = r / 32, nb = r % 32; transpose_item_f8(a->in[I_WO] + (size_t)l * 1024 * 1024, 1024, (unsigned char*)(ws + WS_WO) + (size_t)l * 1024 * 1024, 1024, kb * 64, nb * 32, nb * 32, WO_SCALE, scr, F.lane); }
        }
        const int gt = F.vcu * (NWAVES * 64) + F.tid, NGT = F.G * NWAVES * 64;
        constexpr int PADV = (ZP - ZEND) * 1024 * 2 / 16;
        for (int i = gt; i < NLAYER * PADV; i += NGT) { const int l = i / PADV, j = i % PADV; ((v4u*)((bf16*)(ws + WS_WCAT) + ((size_t)l * ZP + ZEND) * 1024))[j] = (v4u){0u, 0u, 0u, 0u}; }
    }
}

__device__ __forceinline__ void phase_a(KA a, Frame& F, int l) {
    relane(F);
    unsigned char* ws = a->ws;
    const float* MOD = (const float*)(ws + WS_MOD);
    const int* INV = (const int*)(ws + WS_INV);
    const unsigned char* YE = (const unsigned char*)(ws + WS_YE);
    const bool fin = (l == NLAYER);
    const int nrows = fin ? LROWS : MROWS;
    const int gw = F.vcu * NWAVES + F.wave, NGW = F.G * NWAVES;
#define PA_LOAD(r, XF, XB, IV) do { if (l == 0) { const float* src_ = ((r) >= LROWS) ? a->in[I_CTX] + (size_t)((r) - LROWS) * 1024 : a->in[I_X] + (size_t)(r) * 1024; \
            _Pragma("unroll") for (int j = 0; j < 4; ++j) XF[j] = *(const f32x4*)(src_ + 4 * F.lane + 256 * j); } \
        else { const bf16* xb_ = (const bf16*)(ws + WS_XB) + (size_t)(r) * 1024; _Pragma("unroll") for (int j = 0; j < 4; ++j) XB[j] = *(const v2u*)(xb_ + 4 * F.lane + 256 * j); \
            IV = INV[(size_t)(r) * 16 + (F.lane & 15)]; } } while (0)
    f32x4 cf[4]; v2u cb[4]; int civ = -1;
#pragma unroll
    for (int j = 0; j < 4; ++j) { cf[j] = (f32x4){0.f, 0.f, 0.f, 0.f}; cb[j] = (v2u){0u, 0u}; }
    if (gw < nrows) PA_LOAD(gw, cf, cb, civ);
    for (int row = gw; row < nrows; row += NGW) {
        const bool isc = row >= LROWS; const int v = isc ? 4 : (row >> 13);
        bf16* xb = (bf16*)(ws + WS_XB) + (size_t)row * 1024;
        const int nrow = row + NGW; f32x4 nf[4]; v2u nb[4]; int niv = -1;
#pragma unroll
        for (int j = 0; j < 4; ++j) { nf[j] = cf[j]; nb[j] = cb[j]; }
        if (nrow < nrows) PA_LOAD(nrow, nf, nb, niv);
        f32x4 xv[4];
        if (l == 0) {
#pragma unroll
            for (int j = 0; j < 4; ++j) xv[j] = cf[j]; }
        else {
#pragma unroll
            for (int j = 0; j < 4; ++j) xv[j] = (f32x4){bflo(cb[j].x), bfhi(cb[j].x), bflo(cb[j].y), bfhi(cb[j].y)}; }
        if (l > 0) {
            const float* ga2 = MOD + ((l - 1) * 5 + v) * 6144 + 5 * 1024;
            f32x4 acc[4];
#pragma unroll
            for (int j = 0; j < 4; ++j) acc[j] = (f32x4){0.f, 0.f, 0.f, 0.f};
            unsigned sel = (unsigned)(__ballot(civ >= 0) & 0xFFFFull);
            while (sel) {
                int sl[4]; float on[4];
#pragma unroll
                for (int k = 0; k < 4; ++k) { if (sel) { const int e = __builtin_ctz(sel); sel &= sel - 1u; sl[k] = __builtin_amdgcn_readlane(civ, e); on[k] = 1.0f; } else { sl[k] = sl[0]; on[k] = 0.0f; } }
                unsigned w[4][4];
#pragma unroll
                for (int k = 0; k < 4; ++k) { const unsigned char* yr = YE + (size_t)sl[k] * 1024 + 4 * F.lane;
#pragma unroll
                    for (int j = 0; j < 4; ++j) w[k][j] = *(const unsigned*)(yr + 256 * j); }
#pragma unroll
                for (int k = 0; k < 4; ++k)
#pragma unroll
                    for (int j = 0; j < 4; ++j) { const f32x2 lo = __builtin_amdgcn_cvt_pk_f32_fp8((int)w[k][j], false), hi = __builtin_amdgcn_cvt_pk_f32_fp8((int)w[k][j], true);
                        acc[j] += on[k] * (f32x4){lo.x, lo.y, hi.x, hi.y}; }
            }
#pragma unroll
            for (int j = 0; j < 4; ++j) { const f32x4 g = *(const f32x4*)(ga2 + 4 * F.lane + 256 * j); xv[j] += g * (acc[j] * (1.0f / YE_SCALE)); }
        }
#pragma unroll
        for (int j = 0; j < 4; ++j) { cf[j] = nf[j]; cb[j] = nb[j]; }
        civ = niv;
        if (fin) {
#pragma unroll
            for (int j = 0; j < 4; ++j) *(f32x4*)(a->out + (size_t)row * 1024 + 4 * F.lane + 256 * j) = xv[j];
            continue; }
#pragma unroll
        for (int j = 0; j < 4; ++j) { v2u w; w.x = pk2(xv[j].x, xv[j].y); w.y = pk2(xv[j].z, xv[j].w); *(v2u*)(xb + 4 * F.lane + 256 * j) = w; }
        float ss = 0.f;
#pragma unroll
        for (int j = 0; j < 4; ++j) ss += (xv[j].x * xv[j].x + xv[j].y * xv[j].y) + (xv[j].z * xv[j].z + xv[j].w * xv[j].w);
        const float rstd = rsqrtf(wave_sum(ss) * (1.0f / 1024.0f) + EPSF);
        const float* g1 = a->in[I_GN1] + l * 1024; const float* sh = MOD + (l * 5 + v) * 6144; const float* sc = sh + 1024;
        float am = 0.f;
#pragma unroll
        for (int j = 0; j < 4; ++j) { const int c0 = 4 * F.lane + 256 * j; const f32x4 g = *(const f32x4*)(g1 + c0), s1 = *(const f32x4*)(sc + c0), b1 = *(const f32x4*)(sh + c0);
            xv[j] = xv[j] * rstd * g * (1.0f + s1) + b1;
            am = fmaxf(fmaxf(am, fmaxf(fabsf(xv[j].x), fabsf(xv[j].y))), fmaxf(fabsf(xv[j].z), fabsf(xv[j].w))); }
#pragma unroll
        for (int o = 1; o < 64; o <<= 1) am = fmaxf(am, __shfl_xor(am, o));
        const float qs = am > 0.f ? 127.0f / am : 0.f;
        signed char* h8 = (signed char*)(ws + WS_H) + (size_t)row * 1024;
#pragma unroll
        for (int j = 0; j < 4; ++j) { const int q0 = (int)__builtin_rintf(xv[j].x * qs), q1 = (int)__builtin_rintf(xv[j].y * qs), q2 = (int)__builtin_rintf(xv[j].z * qs), q3 = (int)__builtin_rintf(xv[j].w * qs);
            *(unsigned*)(h8 + 4 * F.lane + 256 * j) = (unsigned)(q0 & 255) | ((unsigned)(q1 & 255) << 8) | ((unsigned)(q2 & 255) << 16) | ((unsigned)(q3 & 255) << 24); }
        if (F.lane == 0) ((float*)(ws + WS_SA))[row] = am * (1.0f / 127.0f);
    }
#undef PA_LOAD
    if (l == 0) {
        const bf16* Wc = (const bf16*)(ws + WS_WCAT); signed char* W8 = (signed char*)(ws + WS_WCAT8); float* SWC = (float*)(ws + WS_SWC);
        for (int r = gw; r < NLAYER * ZP; r += NGW) {
            float wv[16]; float am = 0.f;
#pragma unroll
            for (int j = 0; j < 2; ++j) { const v4u w = *(const v4u*)(Wc + (size_t)r * 1024 + 8 * F.lane + 512 * j);
                wv[8 * j + 0] = bflo(w.x); wv[8 * j + 1] = bfhi(w.x); wv[8 * j + 2] = bflo(w.y); wv[8 * j + 3] = bfhi(w.y); wv[8 * j + 4] = bflo(w.z); wv[8 * j + 5] = bfhi(w.z); wv[8 * j + 6] = bflo(w.w); wv[8 * j + 7] = bfhi(w.w); }
#pragma unroll
            for (int i = 0; i < 16; ++i) am = fmaxf(am, fabsf(wv[i]));
#pragma unroll
            for (int o = 1; o < 64; o <<= 1) am = fmaxf(am, __shfl_xor(am, o));
            const float qs = am > 0.f ? 127.0f / am : 0.f;
#pragma unroll
            for (int j = 0; j < 2; ++j) { unsigned w0 = 0u, w1 = 0u;
#pragma unroll
                for (int i = 0; i < 4; ++i) { w0 |= ((unsigned)((int)__builtin_rintf(wv[8 * j + i] * qs)) & 255u) << (8 * i); w1 |= ((unsigned)((int)__builtin_rintf(wv[8 * j + 4 + i] * qs)) & 255u) << (8 * i); }
                v2u o; o.x = w0; o.y = w1; *(v2u*)(W8 + (size_t)r * 1024 + 8 * F.lane + 512 * j) = o; }
            if (F.lane == 0) SWC[r] = am * (1.0f / 127.0f);
        }
    }
}

__device__ __forceinline__ void ld8(const bf16* p, float* f) { const v4u w = *(const v4u*)p; f[0] = bflo(w.x); f[1] = bfhi(w.x); f[2] = bflo(w.y); f[3] = bfhi(w.y); f[4] = bflo(w.z); f[5] = bfhi(w.z); f[6] = bflo(w.w); f[7] = bfhi(w.w); }
__device__ __forceinline__ v4u pk8(const float* f) { v4u w; w.x = pk2(f[0], f[1]); w.y = pk2(f[2], f[3]); w.z = pk2(f[4], f[5]); w.w = pk2(f[6], f[7]); return w; }
template <int N> __device__ __forceinline__ float ssq_row(const bf16* p) { float s = 0.f;
#pragma unroll
    for (int c = 0; c < N / 8; ++c) { float f[8]; ld8(p + 8 * c, f);
#pragma unroll
        for (int i = 0; i < 8; ++i) s += f[i] * f[i];
        if ((c & 7) == 7) MEMFENCE(); }
    return s; }
template <int NP> __device__ __forceinline__ void rope_pairs(float* x, const f32x2* trow, const f32x2* tcol) {
#pragma unroll
    for (int i = 0; i < NP; ++i) { const f32x2 cs = (i < NP / 2) ? trow[i] : tcol[i - NP / 2];
        const float x0 = x[2 * i], x1 = x[2 * i + 1]; x[2 * i] = x0 * cs.x - x1 * cs.y; x[2 * i + 1] = x0 * cs.y + x1 * cs.x; }
}
__device__ __forceinline__ void store_v_tile(char* vt, int lane, const float* v  ) {
    char* p = vt + (lane >> 4) * 1024 + ((lane >> 3) & 1) * 512 + (lane & 7) * 64;
#pragma unroll
    for (int d = 0; d < 2; ++d)
#pragma unroll
        for (int c = 0; c < 4; ++c) *(v4u*)(p + d * 4096 + c * 16) = pk8(v + d * 32 + c * 8);
}
template <bool ROPE> __device__ __forceinline__ v4u proc8(v4u w, float r, const float* g, const f32x2* cs, float qs) {
    float f[8] = {bflo(w.x), bfhi(w.x), bflo(w.y), bfhi(w.y), bflo(w.z), bfhi(w.z), bflo(w.w), bfhi(w.w)};
#pragma unroll
    for (int i = 0; i < 8; ++i) f[i] *= r * g[i];
    if (ROPE) {
#pragma unroll
        for (int i = 0; i < 4; ++i) { const f32x2 t = cs[i]; const float x0 = f[2 * i], x1 = f[2 * i + 1]; f[2 * i] = x0 * t.x - x1 * t.y; f[2 * i + 1] = x0 * t.y + x1 * t.x; }
    }
#pragma unroll
    for (int i = 0; i < 8; ++i) f[i] *= qs;
    return pk8(f);
}
__device__ __forceinline__ v2u pk8_f8(const float* f) { int w0 = __builtin_amdgcn_cvt_pk_fp8_f32(f[0], f[1], 0, false); w0 = __builtin_amdgcn_cvt_pk_fp8_f32(f[2], f[3], w0, true);
    int w1 = __builtin_amdgcn_cvt_pk_fp8_f32(f[4], f[5], 0, false); w1 = __builtin_amdgcn_cvt_pk_fp8_f32(f[6], f[7], w1, true); return (v2u){(unsigned)w0, (unsigned)w1}; }
template <bool ROPE> __device__ __forceinline__ v2u proc8f(v4u w, float r, const float* g, const f32x2* cs, float qs) {
    float f[8] = {bflo(w.x), bfhi(w.x), bflo(w.y), bfhi(w.y), bflo(w.z), bfhi(w.z), bflo(w.w), bfhi(w.w)};
#pragma unroll
    for (int i = 0; i < 8; ++i) f[i] *= r * g[i];
    if (ROPE) {
#pragma unroll
        for (int i = 0; i < 4; ++i) { const f32x2 t = cs[i]; const float x0 = f[2 * i], x1 = f[2 * i + 1]; f[2 * i] = x0 * t.x - x1 * t.y; f[2 * i + 1] = x0 * t.y + x1 * t.x; }
    }
#pragma unroll
    for (int i = 0; i < 8; ++i) f[i] *= qs;
    return pk8_f8(f);
}
__device__ __forceinline__ att::i32x6a fp6_group(const v4u& c0, const v4u& c1, const v4u& c2, const v4u& c3) {
    att::u32x16 w; w[0] = c0.x; w[1] = c0.y; w[2] = c0.z; w[3] = c0.w; w[4] = c1.x; w[5] = c1.y; w[6] = c1.z; w[7] = c1.w; w[8] = c2.x; w[9] = c2.y; w[10] = c2.z; w[11] = c2.w; w[12] = c3.x; w[13] = c3.y; w[14] = c3.z; w[15] = c3.w;
    return att::cvt_fp6x32(w); }
__device__ __forceinline__ void store_qgroup(unsigned char* q, const att::i32x6a& g) { *(v2u*)q = (v2u){(unsigned)g[0], (unsigned)g[1]}; *(v2u*)(q + 8) = (v2u){(unsigned)g[2], (unsigned)g[3]}; *(v2u*)(q + 16) = (v2u){(unsigned)g[4], (unsigned)g[5]}; }
__device__ __forceinline__ void store_kgroup(char* kt, int pb, int j, int lane, const att::i32x6a& g) {
    *(v4u*)(kt + j * 1024 + lane * 16) = (v4u){(unsigned)g[0], (unsigned)g[1], (unsigned)g[2], (unsigned)g[3]}; *(v2u*)(kt + pb + j * 512 + lane * 8) = (v2u){(unsigned)g[4], (unsigned)g[5]}; }
__device__ __forceinline__ v4u ldz8(const unsigned char* p) { const v2u r = *(const v2u*)p;
    const f32x2 a = __builtin_amdgcn_cvt_pk_f32_fp8((int)r.x, false), b = __builtin_amdgcn_cvt_pk_f32_fp8((int)r.x, true), c = __builtin_amdgcn_cvt_pk_f32_fp8((int)r.y, false), d = __builtin_amdgcn_cvt_pk_f32_fp8((int)r.y, true);
    v4u w; w.x = pk2(a.x, a.y); w.y = pk2(b.x, b.y); w.z = pk2(c.x, c.y); w.w = pk2(d.x, d.y); return w; }
__device__ __forceinline__ float ssq8(v4u w) { const float f[8] = {bflo(w.x), bfhi(w.x), bflo(w.y), bfhi(w.y), bflo(w.z), bfhi(w.z), bflo(w.w), bfhi(w.w)}; float s = 0.f;
#pragma unroll
    for (int i = 0; i < 8; ++i) s += f[i] * f[i];
    return s; }
__device__ __forceinline__ v4u scale8(v4u w, float r) { float f[8] = {bflo(w.x), bfhi(w.x), bflo(w.y), bfhi(w.y), bflo(w.z), bfhi(w.z), bflo(w.w), bfhi(w.w)};
#pragma unroll
    for (int i = 0; i < 8; ++i) f[i] *= r;
    return pk8(f); }
__device__ __forceinline__ void store_v_tile_pk(char* vt, int lane, const v4u* w) {
    char* p = vt + (lane >> 4) * 1024 + ((lane >> 3) & 1) * 512 + (lane & 7) * 64;
#pragma unroll
    for (int c = 0; c < 8; ++c) *(v4u*)(p + (c >> 2) * 4096 + (c & 3) * 16) = w[c];
}
__device__ __forceinline__ void store_v_tile_f8(char* vt, int lane, const v4u* w, float sc, LAS unsigned char* scr) {
    LAS unsigned char* p = scr + (2 * ((lane >> 2) & 1) + (lane >> 5)) * 1024 + 4 * ((lane >> 3) & 3) + (lane & 3);
#pragma unroll
    for (int c = 0; c < 8; ++c) { const float f[8] = {bflo(w[c].x), bfhi(w[c].x), bflo(w[c].y), bfhi(w[c].y), bflo(w[c].z), bfhi(w[c].z), bflo(w[c].w), bfhi(w[c].w)};
#pragma unroll
        for (int i = 0; i < 8; i += 2) { const int b8 = __builtin_amdgcn_cvt_pk_fp8_f32(f[i] * sc, f[i + 1] * sc, 0, false);
            p[(8 * c + i) * 16] = (unsigned char)b8; p[(8 * c + i + 1) * 16] = (unsigned char)(b8 >> 8); } }
    LDS_WAIT(); asm volatile("" ::: "memory");
#pragma unroll
    for (int i = 0; i < 4; ++i) *(v4u*)(vt + i * 1024 + lane * 16) = *(const LAS v4u*)(scr + i * 1024 + lane * 16);
    LDS_WAIT(); asm volatile("" ::: "memory");
}
__device__ __forceinline__ void phase_c(KA a, Frame& F, int l) {
    relane(F);
    unsigned char* ws = a->ws;
    const unsigned char* Z = (const unsigned char*)(ws + WS_Z); const float* SSQ = (const float*)(ws + WS_SSQ);
    unsigned char* qkv = ws + WS_QKV;
    LAS unsigned char* vscr = (LAS unsigned char*)F.lds + F.wave * 4096;
    const f32x2* TA_R = (const f32x2*)(ws + WS_TAB + TAB_AROW); const f32x2* TA_C = (const f32x2*)(ws + WS_TAB + TAB_ACOL);
    const f32x2* TG_R = (const f32x2*)(ws + WS_TAB + TAB_GROW); const f32x2* TG_C = (const f32x2*)(ws + WS_TAB + TAB_GCOL);
    const int gw = F.vcu * NWAVES + F.wave, NGW = F.G * NWAVES, lane = F.lane;
    for (int id = gw; id < 528 * 32; id += NGW) {
        const int tile = id % 528, job = id / 528;
        const int b = tile / NKT, tt = tile % NKT; const bool isc = tt >= 128;
        const int zrow = isc ? LROWS + b * CL + (tt - 128) * 64 + lane : b * SEQ + tt * 64 + lane;
        const int tok = tt * 64 + lane;
        const unsigned char* zr = Z + (size_t)zrow * ZP;
        const f32x2* tar = TA_R + (isc ? 0 : tt) * 8; const f32x2* tac = TA_C + lane * 8;
        const f32x2* tgr = TG_R + (isc ? 0 : tt) * 16; const f32x2* tgc = TG_C + lane * 16;
        MEMFENCE();
        if (job < 4) {
            const int h = job;
            float r1; { const f32x4 s0 = *(const f32x4*)(SSQ + (size_t)zrow * 12), s1 = *(const f32x4*)(SSQ + (size_t)zrow * 12 + 4); r1 = rsqrtf((((s0.x + s0.y) + (s0.z + s0.w)) + ((s1.x + s1.y) + (s1.z + s1.w))) * (1.0f / 256.0f) + EPSF); }
            v4u w[12]; float ss = 0.f;
#pragma unroll
            for (int c = 0; c < 12; ++c) { w[c] = ldz8(zr + ZQ + h * 96 + 8 * c); ss += ssq8(w[c]); }
            MEMFENCE();
            const float r = r1 * rsqrtf(ss * r1 * r1 * (1.0f / 96.0f) + EPSF); const float* g = a->in[I_GMQ] + l * 96;
            const float qs = att::FQ96;
            unsigned char* q = (unsigned char*)(qkv + QO_QM) + ((size_t)(b * 4 + h) * NTOKB + tok) * 72;
#pragma unroll
            for (int gq = 0; gq < 3; ++gq) { v4u o[4];
#pragma unroll
                for (int cc = 0; cc < 4; ++cc) { const int c = 4 * gq + cc;
                    if (c < 8 || isc) o[cc] = proc8<false>(w[c], r, g + 8 * c, nullptr, qs);
                    else o[cc] = proc8<true>(w[c], r, g + 8 * c, (c < 10) ? tar + 4 * (c - 8) : tac + 4 * (c - 10), qs); }
                store_qgroup(q + 24 * gq, fp6_group(o[0], o[1], o[2], o[3])); MEMFENCE(); }
        } else if (job < 8) {
            const int h = job - 4;
            float r1; { const f32x4 s2 = *(const f32x4*)(SSQ + (size_t)zrow * 12 + 8); r1 = rsqrtf(((s2.x + s2.y) + (s2.z + s2.w)) * (1.0f / 128.0f) + EPSF); }
            v4u w[12]; float ss = 0.f, s2 = 0.f;
#pragma unroll
            for (int c = 0; c < 8; ++c) { w[c] = ldz8(zr + ZKV + h * 128 + 8 * c); ss += ssq8(w[c]); }
#pragma unroll
            for (int c = 0; c < 4; ++c) { w[8 + c] = ldz8(zr + 384 + 8 * c); s2 += ssq8(w[8 + c]); }
            MEMFENCE();
            const float r2 = rsqrtf((ss * r1 * r1 + s2) * (1.0f / 96.0f) + EPSF); const float* g = a->in[I_GMK] + l * 96;
            char* kt = (char*)(qkv + QO_KM) + ((size_t)(b * 4 + h) * NKT + tt) * 5120;
#pragma unroll
            for (int gq = 0; gq < 3; ++gq) { v4u o[4];
#pragma unroll
                for (int cc = 0; cc < 4; ++cc) { const int c = 4 * gq + cc;
                    if (c < 8) o[cc] = proc8<false>(w[c], r1 * r2, g + 8 * c, nullptr, 1.0f);
                    else if (isc) o[cc] = proc8<false>(w[c], r2, g + 8 * c, nullptr, 1.0f);
                    else o[cc] = proc8<true>(w[c], r2, g + 8 * c, (c < 10) ? tar + 4 * (c - 8) : tac + 4 * (c - 10), 1.0f); }
                store_kgroup(kt, 3072, gq, lane, fp6_group(o[0], o[1], o[2], o[3])); MEMFENCE(); }
            v4u vw[8];
#pragma unroll
            for (int c = 0; c < 8; ++c) vw[c] = ldz8(zr + ZKV + h * 128 + 64 + 8 * c);
            store_v_tile_f8((char*)(qkv + QO_VM) + ((size_t)(b * 4 + h) * NKT + tt) * 4096, lane, vw, r1, vscr);
        } else if (job < 16) {
            const bool isk = job >= 12; const int h = (job - 8) & 3;
            const unsigned char* zp = zr + (isk ? 672 : 416) + h * 64; const float* g = (isk ? a->in[I_GDK] : a->in[I_GDQ]) + l * 32;
            const float qs = isk ? 1.0f : att::FQ32;
            v4u w[8]; float ss[2] = {0.f, 0.f};
#pragma unroll
            for (int c = 0; c < 8; ++c) { w[c] = ldz8(zp + 8 * c); ss[c >> 2] += ssq8(w[c]); }
            MEMFENCE();
            const float r0 = rsqrtf(ss[0] * (1.0f / 32.0f) + EPSF), r1 = rsqrtf(ss[1] * (1.0f / 32.0f) + EPSF);
            char* kt = (char*)(qkv + QO_KD) + ((size_t)(b * 4 + h) * NKT + tt) * 3072;
            unsigned char* q = (unsigned char*)(qkv + QO_QD) + ((size_t)(b * 4 + h) * NTOKB + tok) * 48;
#pragma unroll
            for (int gq = 0; gq < 2; ++gq) { v4u o[4];
#pragma unroll
                for (int cm = 0; cm < 4; ++cm) { const int c = 4 * gq + cm;
                    if (isc) o[cm] = proc8<false>(w[c], gq ? r1 : r0, g + 8 * cm, nullptr, qs);
                    else o[cm] = proc8<true>(w[c], gq ? r1 : r0, g + 8 * cm, (cm < 2) ? tar + 4 * cm : tac + 4 * (cm - 2), qs); }
                const att::i32x6a gr = fp6_group(o[0], o[1], o[2], o[3]);
                if (isk) store_kgroup(kt, 2048, gq, lane, gr); else store_qgroup(q + 24 * gq, gr);
                MEMFENCE(); }
        } else if (job < 20) {
            const int h = job - 16; v4u vw[8];
#pragma unroll
            for (int c = 0; c < 8; ++c) vw[c] = ldz8(zr + 928 + h * 64 + 8 * c);
            store_v_tile_f8((char*)(qkv + QO_VD) + ((size_t)(b * 4 + h) * NKT + tt) * 4096, lane, vw, 1.0f, vscr);
        } else if (job < 30) {
            const bool isk = job >= 28; const int h = isk ? job - 28 : job - 20;
            const unsigned char* zp = zr + (isk ? 1696 : 1184) + h * 64; const float* g = (isk ? a->in[I_GGK] : a->in[I_GGQ]) + l * 64;
            const float qs = isk ? 1.0f : att::FQ64;
            v4u w[8]; float ss = 0.f;
#pragma unroll
            for (int c = 0; c < 8; ++c) { w[c] = ldz8(zp + 8 * c); ss += ssq8(w[c]); }
            MEMFENCE();
            const float r = rsqrtf(ss * (1.0f / 64.0f) + EPSF);
            char* kt = (char*)(qkv + QO_KG) + ((size_t)(b * 2 + h) * NKT + tt) * 3072;
            unsigned char* q = (unsigned char*)(qkv + QO_QG) + ((size_t)(b * 8 + h) * NTOKB + tok) * 48;
#pragma unroll
            for (int gq = 0; gq < 2; ++gq) { v4u o[4];
#pragma unroll
                for (int cc = 0; cc < 4; ++cc) { const int c = 4 * gq + cc;
                    if (isc) o[cc] = proc8<false>(w[c], r, g + 8 * c, nullptr, qs);
                    else o[cc] = proc8<true>(w[c], r, g + 8 * c, (c < 4) ? tgr + 4 * c : tgc + 4 * (c - 4), qs); }
                const att::i32x6a gr = fp6_group(o[0], o[1], o[2], o[3]);
                if (isk) store_kgroup(kt, 2048, gq, lane, gr); else store_qgroup(q + 24 * gq, gr);
                MEMFENCE(); }
        } else {
            const int h = job - 30; v4u vw[8];
#pragma unroll
            for (int c = 0; c < 8; ++c) vw[c] = ldz8(zr + 1824 + h * 64 + 8 * c);
            store_v_tile_f8((char*)(qkv + QO_VG) + ((size_t)(b * 2 + h) * NKT + tt) * 4096, lane, vw, 1.0f, vscr);
        }
        MEMFENCE();
    }
}

#define ATT_UNIT(KD, NM) att::attn_unit_f8<KD, NM, ABL>
#define ATT_DIFF att::attn_unit_f8<32, 2, ABL>
template <int ABL>
__device__ __forceinline__ void phase_d(KA a, Frame& F, int l, bool last) {
    relane(F);
    unsigned char* ws = a->ws; unsigned char* qkv = ws + WS_QKV;
    unsigned char* ATT = (unsigned char*)(ws + (ABL ? WS_Z : WS_ATT));
    const float* LAM = (const float*)(ws + WS_LAM);
    const float lam = LAM[2 * l], oml = 1.0f - LAM[2 * l + 1];
    const float* gdo = a->in[I_GDO] + l * 64;
    ALDS char* lds = (ALDS char*)F.lds;
    const int nctx = last ? 0 : 64;
    for (int id = F.vcu; id < 512 + nctx; id += F.G) {
        int b, h, q0, t0, t1; size_t orow;
        if (id < 512) { const int x = (id & 255) >> 5; b = x >> 1; h = 2 * (x & 1) + (id >> 8); q0 = (id & 31) * 256; t0 = 0; t1 = NKT; orow = (size_t)b * SEQ + q0; }
        else { const int c = id - 512; b = c >> 4; h = c & 15; if (h >= 4) continue; q0 = SEQ; t0 = 128; t1 = NKT; orow = (size_t)LROWS + b * CL; }
        ATT_UNIT(96, 1)((const unsigned char*)(qkv + QO_QM) + ((size_t)(b * 4 + h) * NTOKB + q0) * 72, (const char*)(qkv + QO_KM) + (size_t)(b * 4 + h) * NKT * 5120,
                        (const char*)(qkv + QO_VM) + (size_t)(b * 4 + h) * NKT * 4096, t0, t1, ATT + orow * 1024 + h * 64, lds, 0.f, gdo, 0.f);
    }
    for (int id = 512 + F.vcu; id < 1024 + nctx; id += F.G) {
        int b, h, q0, t0, t1; size_t orow;
        if (id < 1024) { const int x = (id & 255) >> 5; b = x >> 1; h = 2 * (x & 1) + ((id >> 8) - 2); q0 = (id & 31) * 256; t0 = 0; t1 = NKT; orow = (size_t)b * SEQ + q0; }
        else { const int c = id - 1024; b = c >> 4; h = (c & 15) - 4; if (h < 0 || h >= 4) continue; q0 = SEQ; t0 = 128; t1 = NKT; orow = (size_t)LROWS + b * CL; }
        ATT_DIFF((const unsigned char*)(qkv + QO_QD) + ((size_t)(b * 4 + h) * NTOKB + q0) * 48, (const char*)(qkv + QO_KD) + (size_t)(b * 4 + h) * NKT * 3072,
                        (const char*)(qkv + QO_VD) + (size_t)(b * 4 + h) * NKT * 4096, t0, t1, ATT + orow * 1024 + 256 + h * 64, lds, lam, gdo, oml);
    }
    for (int id = 1024 + F.vcu; id < 2048 + nctx; id += F.G) {
        int b, h, q0, t0, t1; size_t orow;
        if (id < 2048) { const int x = (id & 255) >> 5; b = x >> 1; h = 4 * (x & 1) + ((id >> 8) - 4); q0 = (id & 31) * 256; t0 = 0; t1 = NKT; orow = (size_t)b * SEQ + q0; }
        else { const int c = id - 2048; b = c >> 4; h = (c & 15) - 8; if (h < 0) continue; q0 = SEQ; t0 = 128; t1 = NKT; orow = (size_t)LROWS + b * CL; }
        const int g = h >> 2;
        ATT_UNIT(64, 1)((const unsigned char*)(qkv + QO_QG) + ((size_t)(b * 8 + h) * NTOKB + q0) * 48, (const char*)(qkv + QO_KG) + (size_t)(b * 2 + g) * NKT * 3072,
                        (const char*)(qkv + QO_VG) + (size_t)(b * 2 + g) * NKT * 4096, t0, t1, ATT + orow * 1024 + 512 + h * 64, lds, 0.f, gdo, 0.f);
    }
}

template <int RB>
__device__ __forceinline__ void pf_rows(KA a, Frame& F, int l, int rbeg, int nrows, LAS float* wrT) {
    unsigned char* ws = a->ws;
    const float* MOD = (const float*)(ws + WS_MOD);
    float* AFF = (float*)(ws + WS_AFF); float* AFFC = (float*)(ws + WS_AFFC); int* INV = (int*)(ws + WS_INV);
    const int gw = F.vcu * NWAVES + F.wave, NGW = F.G * NWAVES;
#define PF_LOAD(r, XW, DW) do { const bf16* xb_ = (const bf16*)(ws + WS_XB) + (size_t)(r) * 1024; const bf16* dl_ = (const bf16*)(ws + WS_DELTA) + (size_t)(r) * 1024; \
        _Pragma("unroll") for (int j = 0; j < 4; ++j) { XW[j] = *(const v2u*)(xb_ + 4 * F.lane + 256 * j); DW[j] = *(const v2u*)(dl_ + 4 * F.lane + 256 * j); } } while (0)
    v2u cxw[RB][4], cdw[RB][4];
#pragma unroll
    for (int u = 0; u < RB; ++u)
#pragma unroll
        for (int j = 0; j < 4; ++j) { cxw[u][j] = (v2u){0u, 0u}; cdw[u][j] = (v2u){0u, 0u}; }
    if (rbeg + gw * RB < nrows) {
#pragma unroll
        for (int u = 0; u < RB; ++u) PF_LOAD(rbeg + gw * RB + u, cxw[u], cdw[u]); }
    for (int grp = gw; rbeg + grp * RB < nrows; grp += NGW) {
        const int row0 = rbeg + grp * RB; const bool isc = row0 >= LROWS; const int v = isc ? 4 : (row0 >> 13);
        f32x4 hv[RB][4]; float ss[RB];
#pragma unroll
        for (int u = 0; u < RB; ++u) { bf16* xb = (bf16*)(ws + WS_XB) + (size_t)(row0 + u) * 1024; ss[u] = 0.f;
#pragma unroll
            for (int j = 0; j < 4; ++j) { const int c0 = 4 * F.lane + 256 * j; const v2u w = cdw[u][j], xw = cxw[u][j];
                hv[u][j] = (f32x4){bflo(xw.x), bfhi(xw.x), bflo(xw.y), bfhi(xw.y)} + (f32x4){bflo(w.x), bfhi(w.x), bflo(w.y), bfhi(w.y)};
                v2u o; o.x = pk2(hv[u][j].x, hv[u][j].y); o.y = pk2(hv[u][j].z, hv[u][j].w); *(v2u*)(xb + c0) = o;
                ss[u] += (hv[u][j].x * hv[u][j].x + hv[u][j].y * hv[u][j].y) + (hv[u][j].z * hv[u][j].z + hv[u][j].w * hv[u][j].w); } }
        { const int ngrp = grp + NGW;
          if (rbeg + ngrp * RB < nrows) {
#pragma unroll
              for (int u = 0; u < RB; ++u) PF_LOAD(rbeg + ngrp * RB + u, cxw[u], cdw[u]); } }
        float rstd[RB];
#pragma unroll
        for (int u = 0; u < RB; ++u) rstd[u] = rsqrtf(wave_sum(ss[u]) * (1.0f / 1024.0f) + EPSF);
        const float* g2 = a->in[I_GN2] + l * 1024; const float* sh = MOD + (l * 5 + v) * 6144 + 3 * 1024; const float* sc = sh + 1024;
        float am[RB];
#pragma unroll
        for (int u = 0; u < RB; ++u) am[u] = 0.f;
#pragma unroll
        for (int j = 0; j < 4; ++j) { const int c0 = 4 * F.lane + 256 * j; const f32x4 g = *(const f32x4*)(g2 + c0), s1 = *(const f32x4*)(sc + c0), b1 = *(const f32x4*)(sh + c0);
#pragma unroll
            for (int u = 0; u < RB; ++u) { hv[u][j] = hv[u][j] * rstd[u] * g * (1.0f + s1) + b1;
                am[u] = fmaxf(fmaxf(am[u], fmaxf(fabsf(hv[u][j].x), fabsf(hv[u][j].y))), fmaxf(fabsf(hv[u][j].z), fabsf(hv[u][j].w))); } }
#pragma unroll
        for (int o = 1; o < 64; o <<= 1) {
#pragma unroll
            for (int u = 0; u < RB; ++u) am[u] = fmaxf(am[u], __shfl_xor(am[u], o)); }
#pragma unroll
        for (int u = 0; u < RB; ++u) { const float qs = am[u] > 0.f ? 127.0f / am[u] : 0.f;
            signed char* h8 = (signed char*)(ws + WS_H) + (size_t)(row0 + u) * 1024;
#pragma unroll
            for (int j = 0; j < 4; ++j) { const int q0 = (int)__builtin_rintf(hv[u][j].x * qs), q1 = (int)__builtin_rintf(hv[u][j].y * qs), q2 = (int)__builtin_rintf(hv[u][j].z * qs), q3 = (int)__builtin_rintf(hv[u][j].w * qs);
                *(unsigned*)(h8 + 4 * F.lane + 256 * j) = (unsigned)(q0 & 255) | ((unsigned)(q1 & 255) << 8) | ((unsigned)(q2 & 255) << 16) | ((unsigned)(q3 & 255) << 24); }
            if (F.lane == 0) ((float*)(ws + WS_SA))[row0 + u] = am[u] * (1.0f / 127.0f); }
        float p[RB][16];
#pragma unroll
        for (int e = 0; e < 16; ++e) { float sacc[RB];
#pragma unroll
            for (int u = 0; u < RB; ++u) sacc[u] = 0.f;
#pragma unroll
            for (int j = 0; j < 4; ++j) { const f32x4 w = *(const LAS f32x4*)(wrT + e * 1024 + 4 * F.lane + 256 * j);
#pragma unroll
                for (int u = 0; u < RB; ++u) sacc[u] += (hv[u][j].x * w.x + hv[u][j].y * w.y) + (hv[u][j].z * w.z + hv[u][j].w * w.w); }
#pragma unroll
            for (int u = 0; u < RB; ++u) p[u][e] = sacc[u];
            if ((e & 3) == 3) MEMFENCE(); }
        float lgt[RB];
#pragma unroll
        for (int u = 0; u < RB; ++u) { float r8[8], r4[4], r2[2];
          { const bool hb = (F.lane & 32) != 0;
#pragma unroll
            for (int j = 0; j < 8; ++j) { const float keep = hb ? p[u][8 + j] : p[u][j], send = hb ? p[u][j] : p[u][8 + j]; r8[j] = keep + __shfl_xor(send, 32); } }
          { const bool hb = (F.lane & 16) != 0;
#pragma unroll
            for (int j = 0; j < 4; ++j) { const float keep = hb ? r8[4 + j] : r8[j], send = hb ? r8[j] : r8[4 + j]; r4[j] = keep + __shfl_xor(send, 16); } }
          { const bool hb = (F.lane & 8) != 0;
#pragma unroll
            for (int j = 0; j < 2; ++j) { const float keep = hb ? r4[2 + j] : r4[j], send = hb ? r4[j] : r4[2 + j]; r2[j] = keep + __shfl_xor(send, 8); } }
          { const bool hb = (F.lane & 4) != 0; const float keep = hb ? r2[1] : r2[0], send = hb ? r2[0] : r2[1]; lgt[u] = keep + __shfl_xor(send, 4); }
          lgt[u] += __shfl_xor(lgt[u], 1); lgt[u] += __shfl_xor(lgt[u], 2); }
        float mx[RB], ex[RB], sum[RB];
#pragma unroll
        for (int u = 0; u < RB; ++u) mx[u] = lgt[u];
#pragma unroll
        for (int o = 4; o < 64; o <<= 1) {
#pragma unroll
            for (int u = 0; u < RB; ++u) mx[u] = fmaxf(mx[u], __shfl_xor(mx[u], o)); }
#pragma unroll
        for (int u = 0; u < RB; ++u) { ex[u] = __builtin_amdgcn_exp2f((lgt[u] - mx[u]) * LOG2E); sum[u] = ex[u]; }
#pragma unroll
        for (int o = 4; o < 64; o <<= 1) {
#pragma unroll
            for (int u = 0; u < RB; ++u) sum[u] += __shfl_xor(sum[u], o); }
        const int ee = ((F.lane >> 5) & 1) * 8 + ((F.lane >> 4) & 1) * 4 + ((F.lane >> 3) & 1) * 2 + ((F.lane >> 2) & 1);
#pragma unroll
        for (int u = 0; u < RB; ++u) { const float mine = ex[u] / sum[u]; const int row = row0 + u;
            if ((F.lane & 3) == 0) {
                if (isc) { const int r = row - LROWS; AFFC[((size_t)((r >> 8) * 16 + ee)) * CL + (r & 255)] = mine; }
                else AFF[((size_t)((row >> 13) * 16 + ee)) * SEQ + (row & 8191)] = mine;
                INV[(size_t)row * 16 + ee] = -1;
            } }
    }
#undef PF_LOAD
}


__device__ __forceinline__ void phase_f(KA a, Frame& F, int l, bool last) {
    relane(F);
    unsigned char* ws = a->ws;
    const float* MOD = (const float*)(ws + WS_MOD);
    float* AFF = (float*)(ws + WS_AFF); float* AFFC = (float*)(ws + WS_AFFC); int* INV = (int*)(ws + WS_INV);
    LAS float* wrT = (LAS float*)F.lds;
    const float* wr = a->in[I_WR] + (size_t)l * 1024 * 16;
    for (int idx = F.tid; idx < 16384; idx += NWAVES * 64) wrT[(idx & 15) * 1024 + (idx >> 4)] = wr[idx];
    __syncthreads();
    pf_rows<4>(a, F, l, 0, LROWS, wrT);
    if (!last) pf_rows<1>(a, F, l, LROWS, MROWS, wrT);
}

__device__ __forceinline__ void topk_set(Frame& F, const float* __restrict__ src, int n, int k, int rowbase, int slotbase, int e, int* IDX, float* GATE, int* INV, const float* SA, float* SAE) {
    LAS unsigned* keys = (LAS unsigned*)F.lds; LAS unsigned* hist = keys + 8192; LAS unsigned* sc = hist + 256;
    const int tid = F.tid;
    for (int i = tid; i < n; i += NWAVES * 64) keys[i] = __float_as_uint(src[i]);
    if (tid == 0) { unsigned z_ = 0u, k_ = (unsigned)k; asm volatile("" : "+v"(z_), "+v"(k_)); sc[0] = z_; sc[1] = k_; }
    __syncthreads();
    for (int pass = 0; pass < 4; ++pass) {
        const int shift = 24 - 8 * pass; const unsigned mask = (pass == 0) ? 0u : (0xFFFFFFFFu << (shift + 8));
        if (tid < 256) hist[tid] = 0u;
        __syncthreads();
        const unsigned prefix = sc[0];
        for (int i = tid; i < n; i += NWAVES * 64) { const unsigned kv = keys[i]; if ((kv & mask) == prefix) __hip_atomic_fetch_add(&hist[(kv >> shift) & 255u], 1u, __ATOMIC_RELAXED, __HIP_MEMORY_SCOPE_WORKGROUP); }
        __syncthreads();
        if (F.wave == 0) {
            const unsigned need = sc[1]; unsigned h[4]; unsigned tot = 0u;
#pragma unroll
            for (int j = 0; j < 4; ++j) { h[j] = hist[255 - (4 * F.lane + j)]; tot += h[j]; }
            unsigned incl = tot;
#pragma unroll
            for (int d = 1; d < 64; d <<= 1) { const unsigned t = __shfl_up(incl, d); if (F.lane >= d) incl += t; }
            unsigned cum = incl - tot;
#pragma unroll
            for (int j = 0; j < 4; ++j) { if (cum < need && need <= cum + h[j]) { sc[0] = prefix | ((unsigned)(255 - (4 * F.lane + j)) << shift); sc[1] = need - cum; } cum += h[j]; }
        }
        __syncthreads();
    }
    const unsigned T = sc[0], need_eq = sc[1];
    const int per = (n + NWAVES * 64 - 1) / (NWAVES * 64), start = tid * per;
    unsigned cg = 0u, ce = 0u;
    for (int j = 0; j < per; ++j) { const int i = start + j; if (i < n) { const unsigned kv = keys[i]; cg += (kv > T) ? 1u : 0u; ce += (kv == T) ? 1u : 0u; } }
    const unsigned packed = cg | (ce << 16);
    unsigned incl = packed;
#pragma unroll
    for (int d = 1; d < 64; d <<= 1) { const unsigned t = __shfl_up(incl, d); if (F.lane >= d) incl += t; }
    if (F.lane == 63) sc[8 + F.wave] = incl;
    __syncthreads();
    unsigned base = 0u;
    for (int w = 0; w < F.wave; ++w) base += sc[8 + w];
    const unsigned excl = base + incl - packed;
    unsigned gb = excl & 0xFFFFu, eb = excl >> 16;
    for (int j = 0; j < per; ++j) { const int i = start + j; if (i < n) { const unsigned kv = keys[i]; const bool g = kv > T, q = kv == T;
        if (g || (q && eb < need_eq)) { const int slot = slotbase + (int)(gb + (eb < need_eq ? eb : need_eq)); IDX[slot] = rowbase + i; GATE[slot] = __uint_as_float(kv); SAE[slot] = SA[rowbase + i]; INV[(size_t)(rowbase + i) * 16 + e] = slot; }
        gb += g ? 1u : 0u; eb += q ? 1u : 0u; } }
    __syncthreads();
}
struct CvtItem { const float* wp; int N; unsigned char* wt; int ldt; float qs; int f8; };
__device__ __forceinline__ void cvt_load(const CvtItem& I, float (&tv)[32]) {
#pragma unroll
    for (int i = 0; i < 32; ++i) tv[i] = __builtin_nontemporal_load(I.wp + (size_t)(2 * i) * I.N);
}
__device__ __forceinline__ void cvt_store(const CvtItem& I, const float (&tv)[32], LAS float* scr, int lane) {
#pragma unroll
    for (int i = 0; i < 32; ++i) scr[(2 * i + (lane >> 5)) * 33 + (lane & 31)] = tv[i];
    LDS_WAIT(); asm volatile("" ::: "memory");
    const int c = lane & 3;
#pragma unroll
    for (int j = 0; j < 2; ++j) { const int n = (lane >> 2) + 16 * j; const LAS float* sp = scr + (16 * c) * 33 + n; v4u o;
        if (I.f8) {
#pragma unroll
            for (int d = 0; d < 4; ++d) { float f[4];
#pragma unroll
                for (int i = 0; i < 4; ++i) f[i] = fminf(fmaxf(sp[(4 * d + i) * 33] * I.qs, -448.0f), 448.0f);
                int w = __builtin_amdgcn_cvt_pk_fp8_f32(f[0], f[1], 0, false); w = __builtin_amdgcn_cvt_pk_fp8_f32(f[2], f[3], w, true); o[d] = (unsigned)w; }
        } else {
#pragma unroll
            for (int d = 0; d < 4; ++d) { unsigned w = 0u;
#pragma unroll
                for (int i = 0; i < 4; ++i) { const float f = fminf(fmaxf(sp[(4 * d + i) * 33] * I.qs, -127.0f), 127.0f); w |= ((unsigned)((int)__builtin_rintf(f)) & 255u) << (8 * i); }
                o[d] = w; }
        }
        *(v4u*)(I.wt + (size_t)n * I.ldt + 16 * c) = o; }
    LDS_WAIT(); asm volatile("" ::: "memory");
}
__device__ __forceinline__ void phase_g(KA a, Frame& F, int l, bool last, int rep) {
    relane(F);
    unsigned char* ws = a->ws;
    const float* AFF = (const float*)(ws + WS_AFF); const float* AFFC = (const float*)(ws + WS_AFFC);
    int* IDX = (int*)(ws + WS_IDX); float* GATE = (float*)(ws + WS_GATE); int* INV = (int*)(ws + WS_INV);
    const float* SA = (const float*)(ws + WS_SA); float* SAE = (float*)(ws + WS_SAE);
    const int RPE = last ? 4096 : 4352, nsets = last ? 64 : 128;
    for (int set = blockIdx.x; set < nsets; set += F.G) {
        if (set < 64) { const int b = set >> 4, e = set & 15; topk_set(F, AFF + (size_t)set * SEQ, SEQ, CAPL, b * SEQ, e * RPE + b * CAPL, e, IDX, GATE, INV, SA, SAE); }
        else { const int s2 = set - 64, b = s2 >> 4, e = s2 & 15; topk_set(F, AFFC + (size_t)s2 * CL, CL, CAPC, LROWS + b * CL, e * RPE + 4096 + b * CAPC, e, IDX, GATE, INV, SA, SAE);
            if (b == 0 && F.tid < 128) { IDX[e * RPE + 4224 + F.tid] = -1; GATE[e * RPE + 4224 + F.tid] = 0.f; SAE[e * RPE + 4224 + F.tid] = 0.f; } }
    }
    {
        LAS float* scr = (LAS float*)(F.lds + 40960 + F.wave * 8704);
        gu32* head = F.ctl + CW_Q + 64 * l + 128 * rep;
        constexpr int NIT = NE * 3072;
        const float* wg = a->in[I_WG] + (size_t)l * NE * 1024 * 2048; const float* wu = a->in[I_WU] + (size_t)l * NE * 1024 * 2048; const float* wd = a->in[I_WD] + (size_t)l * NE * 2048 * 1024;
        const float* SWL = (const float*)(ws + WS_SW) + l * 48;
        for (;;) {
            unsigned basev = 0u;
            if (F.lane == 0) basev = __hip_atomic_fetch_add(head, 8u, RLX_AGENT);
            const int base = __builtin_amdgcn_readfirstlane((int)basev);
            if (base >= NIT) break;
#define CVT_SETUP(I, j) do { const int it_ = base + (j); const int e_ = it_ / 3072, r_ = it_ % 3072, which_ = r_ >> 10, ii_ = r_ & 1023; \
                if (which_ < 2) { const int kb_ = ii_ >> 6, n0_ = (ii_ & 63) * 32; const int rowbase_ = (n0_ >> 7) * 256 + (n0_ & 127) + which_ * 128; \
                    I.wp = (which_ ? wu : wg) + (size_t)e_ * 1024 * 2048 + (size_t)(kb_ * 64 + (F.lane >> 5)) * 2048 + n0_ + (F.lane & 31); I.N = 2048; \
                    I.wt = (unsigned char*)(ws + WS_WGU) + (size_t)e_ * 4096 * 1024 + (size_t)rowbase_ * 1024 + kb_ * 64; I.ldt = 1024; I.qs = 1.0f / SWL[3 * e_ + which_]; I.f8 = 0; } \
                else { const int kb_ = ii_ >> 5, n0_ = (ii_ & 31) * 32; \
                    I.wp = wd + (size_t)e_ * 2048 * 1024 + (size_t)(kb_ * 64 + (F.lane >> 5)) * 1024 + n0_ + (F.lane & 31); I.N = 1024; \
                    I.wt = (unsigned char*)(ws + WS_WD) + (size_t)e_ * 1024 * 2048 + (size_t)n0_ * 2048 + kb_ * 64; I.ldt = 2048; I.qs = 1.0f / SWL[3 * e_ + 2]; I.f8 = 1; } } while (0)
            CvtItem IA, IB; float tvA[32], tvB[32];
            CVT_SETUP(IA, 0); cvt_load(IA, tvA);
#pragma unroll
            for (int jj = 0; jj < 4; ++jj) {
                CVT_SETUP(IB, 2 * jj + 1); cvt_load(IB, tvB);
                cvt_store(IA, tvA, scr, F.lane);
                if (jj < 3) { CVT_SETUP(IA, 2 * jj + 2); cvt_load(IA, tvA); }
                cvt_store(IB, tvB, scr, F.lane);
            }
#undef CVT_SETUP
        }
    }
}

__global__ void __launch_bounds__(NWAVES * 64, 2) mk_fwd(Args args) {
    extern __shared__ __attribute__((aligned(16))) unsigned char lds[];
    Frame F;
    F.lds = (LAS unsigned char*)lds;
    F.MISC = (volatile LAS unsigned*)(F.lds + MISC_OFF);
    F.tid = threadIdx.x; F.lane = F.tid & 63; F.wave = __builtin_amdgcn_readfirstlane(F.tid >> 6);
    F.G = gridDim.x; { const int bx = blockIdx.x; F.vcu = (F.G % 8 == 0) ? (bx % 8) * (F.G / 8) + bx / 8 : bx; }
    F.ctl = (gu32*)(args.ws + WS_CTL);
    for (int u = F.tid; u < (LDS_BYTES - LDSCTL_OFF) / 4; u += NWAVES * 64) ((LAS unsigned*)(F.lds + LDSCTL_OFF))[u] = 0u;
    __syncthreads();
    const int lo = args.ph_lo, hi = args.ph_hi;
    const bool multi = (hi - lo) > 1;
    XcdBarrier bar; bar.bar = (unsigned*)(F.ctl + CW_BAR); bar.x = 0; bar.st = nullptr;
    if (multi) bar = xcd_barrier_post((unsigned*)(F.ctl + CW_BAR), F.MISC + 8);
#define IN(k) (lo <= (k) && (k) < hi)
#define SEAM(k) do { if (IN((k) + 1)) xcd_barrier(bar); } while (0)
#define REP(kind) (((MK_REP) >> (kind)) & 1)
#define RUNPH(kind, k, ...) do { if (IN(k)) { for (int rep_ = 0; rep_ <= REP(kind); ++rep_) { __VA_ARGS__; if (rep_ < REP(kind)) xcd_barrier(bar); } SEAM(k); } } while (0)

    RUNPH(0, 0, p0_prologue(kargs(), F));

    for (int l = 0; l < NLAYER; ++l) {
        const bool last = (l == NLAYER - 1);
        const int pb = 1 + 10 * l;
        const int RPE = last ? 4096 : 4352;
        if (IN(pb + 0)) { for (int rep_ = 0; rep_ <= (l == 0 ? REP(1) : 0); ++rep_) { phase_a(kargs(), F, l); if (rep_ < REP(1) && l == 0) xcd_barrier(bar); } SEAM(pb + 0); }
        if (IN(pb + 1)) { for (int rep_ = 0; rep_ <= REP(2); ++rep_) {
            KA ka = kargs(); unsigned char* ws = ka->ws;
            pg8::Gemm g{(const pg8::bf16_t*)(ws + WS_H), (const pg8::bf16_t*)(ws + WS_WCAT8 + (size_t)l * ZP * 1024), MROWS, ZP, DM / 2, 1 << 30, 0};
            pg8::StaticOrder S; S.init(MROWS, ZP, F.G, (int)blockIdx.x);
            pg8::EpiStoreBf16I8 E{(unsigned char*)(ws + WS_Z), ZP, (const float*)(ws + WS_SA), (const float*)(ws + WS_SWC) + (size_t)l * ZP, (float*)(ws + WS_SSQ), 384, ZEND};
            pg8::gemm_phase<pg8::EpiStoreBf16I8, pg8::StaticOrder, true, true, 1>(F.lds, g, S, E);
            if (rep_ < REP(2)) xcd_barrier(bar); }
            SEAM(pb + 1);
        }
        RUNPH(3, pb + 2, phase_c(kargs(), F, l));
        RUNPH(4, pb + 3, phase_d<0>(kargs(), F, l, last); if (MK_ABL) { xcd_barrier(bar); phase_d<MK_ABL>(kargs(), F, l, last); });
        if (IN(pb + 4)) { for (int rep_ = 0; rep_ <= REP(5); ++rep_) {
            KA ka = kargs(); unsigned char* ws = ka->ws; const float* MODL = (const float*)(ws + WS_MOD) + (size_t)l * 5 * 6144;
            const int M = last ? LROWS : MROWS;
            pg8::Gemm g{(const pg8::bf16_t*)(ws + WS_ATT), (const pg8::bf16_t*)(ws + WS_WO + (size_t)l * 1024 * 1024), M, DM, DM / 2, 1 << 30, 0};
            pg8::StaticOrder S; S.init(M, DM, F.G, (int)blockIdx.x);
            pg8::EpiColGateBf16 E{(pg8::bf16_t*)(ws + WS_DELTA), DM, MODL, LROWS, 1.0f / (att::ATT_SCALE * WO_SCALE)};
            pg8::gemm_phase<pg8::EpiColGateBf16, pg8::StaticOrder, true, true, 2>(F.lds, g, S, E);
            if (rep_ < REP(5)) xcd_barrier(bar); }
            SEAM(pb + 4);
        }
        RUNPH(6, pb + 5, phase_f(kargs(), F, l, last));
        RUNPH(7, pb + 6, phase_g(kargs(), F, l, last, rep_));
        if (IN(pb + 8)) { for (int rep_ = 0; rep_ <= REP(9); ++rep_) {
            KA ka = kargs(); unsigned char* ws = ka->ws;
            pg8::Gemm g{(const pg8::bf16_t*)(ws + WS_H), (const pg8::bf16_t*)(ws + WS_WGU), NE * RPE, 2 * FFD, DM / 2, RPE / 256, (size_t)2 * FFD * DM, (const int*)(ws + WS_IDX)};
            pg8::StaticOrder S; S.init(NE * RPE, 2 * FFD, F.G, (int)blockIdx.x);
            pg8::EpiSwiGLUI8 E{(unsigned char*)(ws + WS_HID), FFD, (const float*)(ws + WS_SAE), (const float*)(ws + WS_SW) + l * 48, RPE / 256, HID_SCALE};
            if (MK_NOEPI && rep_ == 1) { pg8::EpiNullI8 EN{}; pg8::gemm_phase<pg8::EpiNullI8, pg8::StaticOrder, true, true, 1, true>(F.lds, g, S, EN); }
            else pg8::gemm_phase<pg8::EpiSwiGLUI8, pg8::StaticOrder, true, true, 1, true>(F.lds, g, S, E);
            if (rep_ < REP(9)) xcd_barrier(bar); }
            SEAM(pb + 8);
        }
        if (IN(pb + 9)) { for (int rep_ = 0; rep_ <= REP(10); ++rep_) {
            KA ka = kargs(); unsigned char* ws = ka->ws;
            pg8::Gemm g{(const pg8::bf16_t*)(ws + WS_HID), (const pg8::bf16_t*)(ws + WS_WD), NE * RPE, DM, FFD / 2, RPE / 256, (size_t)DM * FFD};
            pg8::StaticOrder S; S.init(NE * RPE, DM, F.G, (int)blockIdx.x);
            pg8::EpiRowScaleBf16 E{(unsigned char*)(ws + WS_YE), DM, (const float*)(ws + WS_GATE), (const float*)(ws + WS_SW) + l * 48, RPE / 256, YE_SCALE / HID_SCALE};
            pg8::gemm_phase<pg8::EpiRowScaleBf16, pg8::StaticOrder, true, true, 2>(F.lds, g, S, E);
            if (rep_ < REP(10)) xcd_barrier(bar); }
            SEAM(pb + 9);
        }
    }
    if (IN(N_PHASES - 1)) phase_a(kargs(), F, NLAYER);
#undef IN
#undef SEAM
}

extern "C" void kernel_launch(void* const* d_in, const int* in_sizes, int n_in, void* d_out, int out_size, void* d_ws, size_t ws_size, hipStream_t stream) {
    static int grid = 0;
    if (grid == 0) {
        if (n_in != N_IN || out_size != LROWS * DM || ws_size < WS_END) { fprintf(stderr, "kernel_launch: unexpected shapes (n_in %d, out %d, ws %zu); nothing launched\n", n_in, out_size, ws_size); grid = -1; return; }
        int dev = 0, cus = 0, per_cu = 0;
        if (hipGetDevice(&dev) != hipSuccess || hipDeviceGetAttribute(&cus, hipDeviceAttributeMultiprocessorCount, dev) != hipSuccess) { grid = -1; return; }
        if (hipFuncSetAttribute((const void*)mk_fwd, hipFuncAttributeMaxDynamicSharedMemorySize, LDS_BYTES) != hipSuccess) { fprintf(stderr, "kernel_launch: hipFuncSetAttribute failed\n"); grid = -1; return; }
        if (hipOccupancyMaxActiveBlocksPerMultiprocessor(&per_cu, (const void*)mk_fwd, NWAVES * 64, LDS_BYTES) != hipSuccess || per_cu < 1) { fprintf(stderr, "kernel_launch: occupancy query reports %d blocks per CU\n", per_cu); }
        (void)hipGetLastError();
        if (cus < 256) { fprintf(stderr, "kernel_launch: %d compute units; the per-workgroup LDS row tables of the GEMM phases are sized for a grid of at least 256 workgroups; nothing launched\n", cus); grid = -1; return; }
        grid = cus;
    }
    if (grid < 0) return;
    if (hipMemsetAsync((char*)d_ws + WS_CTL, 0, CTL_ZERO_BYTES, stream) != hipSuccess) { fprintf(stderr, "kernel_launch: memset failed\n"); return; }
    Args a{};
    for (int i = 0; i < N_IN; ++i) a.in[i] = (const float*)d_in[i];
    a.out = (float*)d_out; a.ws = (unsigned char*)d_ws;
#if MK_SPLIT
    for (int ph = 0; ph < N_PHASES; ++ph) { a.ph_lo = ph; a.ph_hi = ph + 1; hipLaunchKernelGGL(mk_fwd, dim3(grid), dim3(NWAVES * 64), LDS_BYTES, stream, a); }
#else
    a.ph_lo = 0; a.ph_hi = N_PHASES;
    hipLaunchKernelGGL(mk_fwd, dim3(grid), dim3(NWAVES * 64), LDS_BYTES, stream, a);
#endif
    const hipError_t le = hipPeekAtLastError();
    if (le != hipSuccess) fprintf(stderr, "kernel_launch: launch failed: %s\n", hipGetErrorName(le));
}
```

```cpp
#include <hip/hip_runtime.h>
#include <hip/hip_bf16.h>
#include <cstdio>
#include <cstdint>
#ifndef MK_SPLIT
#define MK_SPLIT 0
#endif
#ifndef MK_TAILCVT
#define MK_TAILCVT 1
#endif
#ifndef MK_TAILWAVES
#define MK_TAILWAVES 8
#endif
#ifndef MK_REP
#define MK_REP 0
#endif
#ifndef MK_NOEPI
#define MK_NOEPI 0
#endif
#ifndef MK_ABL
#define MK_ABL 0
#endif
namespace pg8 {
#define PG8_LAS __attribute__((address_space(3)))
typedef unsigned short bf16_t;
typedef short bf16x8 __attribute__((ext_vector_type(8)));
typedef float f32x4 __attribute__((ext_vector_type(4)));
typedef unsigned u32x4 __attribute__((ext_vector_type(4)));
constexpr int BM = 256, BK = 64, HALF = 128, HTB = HALF * BK * 2  , STAGE_BYTES = 8 * HTB, NXCD = 8, WGM = 8;

__host__ __device__ __forceinline__ int lds_byte(int r, int c) { const int st = (r >> 4) * 2 + (c >> 5), rr = r & 15, cc = c & 31, ob = rr * 64 + cc * 2; return st * 1024 + (ob ^ (((ob >> 9) & 1) << 5)); }
__host__ __device__ __forceinline__ void stage_rc(int b, int& R, int& C) { const int st = b / 1024, sb = b % 1024, swz = sb ^ (((sb >> 9) & 1) << 5); R = (st >> 1) * 16 + swz / 64; C = (st & 1) * 32 + (swz % 64) / 2; }
__host__ __device__ __forceinline__ int perm32(int rho) { const int n = rho >> 4, i = rho & 15; return 8 * (i >> 2) + 4 * n + (i & 3); }

struct Unit { int pm, pn, li; };
struct Gemm { const bf16_t* A; const bf16_t* Bt; int M, N, K; int tpe; size_t bgs; const int* gidx = nullptr; };

struct StaticOrder {
    int nM, nN, nwg, G, c;
    __host__ __device__ void init(int M, int N, int G_, int c_) { nM = M / BM; nN = N / BM; nwg = nM * nN; G = G_; c = c_; }
    __host__ __device__ bool next(int i, Unit& u) const {
        const long L = (long)i * G + c; if (L >= nwg) return false;
        int wgid = (int)L; { const int q = nwg / NXCD, r = nwg % NXCD, xcd = wgid % NXCD, off = wgid / NXCD; wgid = (xcd < r ? xcd * (q + 1) : r * (q + 1) + (xcd - r) * q) + off; }
        const int nig = WGM * nN, gid = wgid / nig, fm = gid * WGM, gsz = (nM - fm) < WGM ? (nM - fm) : WGM;
        u.pm = fm + ((wgid % nig) % gsz); u.pn = (wgid % nig) / gsz; u.li = i; return true;
    }
    __device__ __forceinline__ void a_ready(const Unit&) const {}
    __device__ __forceinline__ void done(const Unit&) const {}
};
typedef int i32x4 __attribute__((ext_vector_type(4)));
__device__ __forceinline__ unsigned cvt_pk_bf16(float lo, float hi) { unsigned r; asm volatile("v_cvt_pk_bf16_f32 %0, %1, %2" : "=v"(r) : "v"(lo), "v"(hi)); return r; }
constexpr int GTAB_OFF = STAGE_BYTES + 2048, RTAB_OFF = GTAB_OFF + 17 * BM * 2, TAB_UNITS = 17;
template <class Sched> __device__ __forceinline__ void fill_rtab(PG8_LAS unsigned char* lds, const Sched& S, const float* rowv, int tid) {
    PG8_LAS float* rt = (PG8_LAS float*)(lds + RTAB_OFF); float v[TAB_UNITS]; int pmv[TAB_UNITS];
#pragma unroll
    for (int i = 0; i < TAB_UNITS; ++i) { Unit uu; pmv[i] = S.next(i, uu) ? uu.pm : -1; }
#pragma unroll
    for (int i = 0; i < TAB_UNITS; ++i) v[i] = rowv[(pmv[i] < 0 ? 0 : pmv[i]) * BM + (tid & (BM - 1))];
#pragma unroll
    for (int i = 0; i < TAB_UNITS; ++i) { if (pmv[i] >= 0 && tid < BM) rt[i * BM + tid] = v[i]; } }
struct EpiStoreBf16 {
    static constexpr bool PERM = true, AFTER_DRAIN = false;
    bf16_t* O; int ldc;
    template <class Sched> __device__ __forceinline__ void prefill(PG8_LAS unsigned char*, const Sched&, int) const {}
    __device__ __forceinline__ void operator()(const f32x4 (&acc)[2][2][4][2], const Unit& u, int wr, int wc, int fr, int fq, PG8_LAS unsigned char* lds) const {
        const int row0 = u.pm * BM + wr * 64 + fr, col0 = u.pn * BM + wc * 32 + 8 * fq;
#pragma unroll
        for (int ai = 0; ai < 2; ++ai)
#pragma unroll
            for (int m = 0; m < 4; ++m) { bf16_t* rowp = O + (size_t)(row0 + ai * HALF + m * 16) * ldc + col0;
#pragma unroll
                for (int bj = 0; bj < 2; ++bj) { const f32x4 v0 = acc[ai][bj][m][0], v1 = acc[ai][bj][m][1];
                    u32x4 w; w.x = cvt_pk_bf16(v0[0], v0[1]); w.y = cvt_pk_bf16(v0[2], v0[3]); w.z = cvt_pk_bf16(v1[0], v1[1]); w.w = cvt_pk_bf16(v1[2], v1[3]);
                    *(u32x4*)(rowp + bj * HALF) = w; } }
    }
};
__device__ __forceinline__ float clampz(float x) { return fminf(fmaxf(x, -448.0f), 448.0f); }
struct EpiStoreBf16I8 {
    static constexpr bool PERM = true, AFTER_DRAIN = false;
    unsigned char* O; int ldc; const float* sa; const float* sw; float* ssq; int clo, chi;
    template <class Sched> __device__ __forceinline__ void prefill(PG8_LAS unsigned char* lds, const Sched& S, int tid) const { fill_rtab(lds, S, sa, tid); }
    __device__ __forceinline__ void operator()(const i32x4 (&acc)[2][2][4][2], const Unit& u, int wr, int wc, int fr, int fq, PG8_LAS unsigned char* lds) const {
        const int row0 = u.pm * BM + wr * 64 + fr, col0 = u.pn * BM + wc * 32 + 8 * fq;
        bool cst[2];
#pragma unroll
        for (int bj = 0; bj < 2; ++bj) { const int cb = u.pn * BM + bj * HALF + wc * 32; cst[bj] = cb >= clo && cb < chi; }
        f32x4 cs[2][2];
#pragma unroll
        for (int bj = 0; bj < 2; ++bj)
#pragma unroll
            for (int n = 0; n < 2; ++n) cs[bj][n] = *(const f32x4*)(sw + col0 + bj * HALF + 4 * n);
#pragma unroll
        for (int ai = 0; ai < 2; ++ai)
#pragma unroll
            for (int m = 0; m < 4; ++m) { const int row = row0 + ai * HALF + m * 16; const float rs = ((const PG8_LAS float*)(lds + RTAB_OFF))[u.li * BM + (row - u.pm * BM)]; unsigned char* rowp = O + (size_t)(row >> 6) * ((size_t)ldc * 64) + (size_t)(col0 >> 3) * 512 + (row & 63) * 8;
#pragma unroll
                for (int bj = 0; bj < 2; ++bj) { const i32x4 a0 = acc[ai][bj][m][0], a1 = acc[ai][bj][m][1]; const f32x4 c0 = cs[bj][0] * rs, c1 = cs[bj][1] * rs;
                    const float z0 = (float)a0[0] * c0[0], z1 = (float)a0[1] * c0[1], z2 = (float)a0[2] * c0[2], z3 = (float)a0[3] * c0[3];
                    const float z4 = (float)a1[0] * c1[0], z5 = (float)a1[1] * c1[1], z6 = (float)a1[2] * c1[2], z7 = (float)a1[3] * c1[3];
                    int w0 = __builtin_amdgcn_cvt_pk_fp8_f32(clampz(z0), clampz(z1), 0, false); w0 = __builtin_amdgcn_cvt_pk_fp8_f32(clampz(z2), clampz(z3), w0, true);
                    int w1 = __builtin_amdgcn_cvt_pk_fp8_f32(clampz(z4), clampz(z5), 0, false); w1 = __builtin_amdgcn_cvt_pk_fp8_f32(clampz(z6), clampz(z7), w1, true);
                    typedef unsigned u32x2 __attribute__((ext_vector_type(2)));
                    if (cst[bj]) *(u32x2*)(rowp + bj * (HALF / 8) * 512) = (u32x2){(unsigned)w0, (unsigned)w1};
                    if (u.pn == 0 || (u.pn == 1 && bj == 0)) {
                        float q = ((z0 * z0 + z1 * z1) + (z2 * z2 + z3 * z3)) + ((z4 * z4 + z5 * z5) + (z6 * z6 + z7 * z7));
                        q += __shfl_xor(q, 16); q += __shfl_xor(q, 32);
                        if (fq == 0) ssq[(size_t)row * 12 + (u.pn == 0 ? bj * 4 + wc : 8 + wc)] = q; } } }
    }
};
struct EpiColGateBf16 {
    static constexpr bool PERM = true, AFTER_DRAIN = false;
    bf16_t* O; int ldc; const float* mod; int lrows;
    template <class Sched> __device__ __forceinline__ void prefill(PG8_LAS unsigned char*, const Sched&, int) const {}
    __device__ __forceinline__ void operator()(const f32x4 (&acc)[2][2][4][2], const Unit& u, int wr, int wc, int fr, int fq, PG8_LAS unsigned char* lds) const {
        const int R0 = u.pm * BM; const int v = (R0 >= lrows) ? 4 : (R0 >> 13);
        const float* ga = mod + v * 6144 + 2 * 1024;
        const int row0 = R0 + wr * 64 + fr, col0 = u.pn * BM + wc * 32 + 8 * fq;
        f32x4 g[2][2];
#pragma unroll
        for (int bj = 0; bj < 2; ++bj)
#pragma unroll
            for (int n = 0; n < 2; ++n) g[bj][n] = *(const f32x4*)(ga + col0 + bj * HALF + 4 * n);
#pragma unroll
        for (int ai = 0; ai < 2; ++ai)
#pragma unroll
            for (int m = 0; m < 4; ++m) { bf16_t* rowp = O + (size_t)(row0 + ai * HALF + m * 16) * ldc + col0;
#pragma unroll
                for (int bj = 0; bj < 2; ++bj) { const f32x4 v0 = acc[ai][bj][m][0] * g[bj][0], v1 = acc[ai][bj][m][1] * g[bj][1];
                    u32x4 w; w.x = cvt_pk_bf16(v0[0], v0[1]); w.y = cvt_pk_bf16(v0[2], v0[3]); w.z = cvt_pk_bf16(v1[0], v1[1]); w.w = cvt_pk_bf16(v1[2], v1[3]);
                    *(u32x4*)(rowp + bj * HALF) = w; } }
    }
};
__device__ __forceinline__ float silu_mul(float g, float u) { return g * __builtin_amdgcn_rcpf(1.0f + __builtin_amdgcn_exp2f(-1.4426950408889634f * g)) * u; }
struct EpiSwiGLU {
    static constexpr bool PERM = true, AFTER_DRAIN = false;
    bf16_t* O; int ldc;
    template <class Sched> __device__ __forceinline__ void prefill(PG8_LAS unsigned char*, const Sched&, int) const {}
    __device__ __forceinline__ void operator()(const f32x4 (&acc)[2][2][4][2], const Unit& u, int wr, int wc, int fr, int fq, PG8_LAS unsigned char* lds) const {
        const int row0 = u.pm * BM + wr * 64 + fr, col0 = u.pn * HALF + wc * 32 + 8 * fq;
#pragma unroll
        for (int ai = 0; ai < 2; ++ai)
#pragma unroll
            for (int m = 0; m < 4; ++m) { const f32x4 g0 = acc[ai][0][m][0], g1 = acc[ai][0][m][1], u0 = acc[ai][1][m][0], u1 = acc[ai][1][m][1];
                u32x4 w; w.x = cvt_pk_bf16(silu_mul(g0[0], u0[0]), silu_mul(g0[1], u0[1])); w.y = cvt_pk_bf16(silu_mul(g0[2], u0[2]), silu_mul(g0[3], u0[3]));
                w.z = cvt_pk_bf16(silu_mul(g1[0], u1[0]), silu_mul(g1[1], u1[1])); w.w = cvt_pk_bf16(silu_mul(g1[2], u1[2]), silu_mul(g1[3], u1[3]));
                *(u32x4*)(O + (size_t)(row0 + ai * HALF + m * 16) * ldc + col0) = w; }
    }
};
__device__ __forceinline__ float clamp448(float x) { return fminf(fmaxf(x, -448.0f), 448.0f); }
struct EpiSwiGLUI8 {
    static constexpr bool PERM = true, AFTER_DRAIN = false;
    unsigned char* O; int ldc; const float* sa; const float* sw; int tpe; float hs;
    template <class Sched> __device__ __forceinline__ void prefill(PG8_LAS unsigned char* lds, const Sched& S, int tid) const { fill_rtab(lds, S, sa, tid); }
    __device__ __forceinline__ void operator()(const i32x4 (&acc)[2][2][4][2], const Unit& u, int wr, int wc, int fr, int fq, PG8_LAS unsigned char* lds) const {
        const int row0 = u.pm * BM + wr * 64 + fr, col0 = u.pn * HALF + wc * 32 + 8 * fq; const int e = u.pm / tpe;
        const float sg = sw[3 * e], su = sw[3 * e + 1] * hs;
#pragma unroll
        for (int ai = 0; ai < 2; ++ai)
#pragma unroll
            for (int m = 0; m < 4; ++m) { const int row = row0 + ai * HALF + m * 16; const float rs = ((const PG8_LAS float*)(lds + RTAB_OFF))[u.li * BM + (row - u.pm * BM)], fg = rs * sg, fu = rs * su;
                const i32x4 g0 = acc[ai][0][m][0], g1 = acc[ai][0][m][1], u0 = acc[ai][1][m][0], u1 = acc[ai][1][m][1];
                typedef float f32x2 __attribute__((ext_vector_type(2)));
                float h[8]; f32x2 gi[4], gu[4], ev[4];
                const float tg = -1.4426950408889634f * fg, fgu = fg * fu;
#pragma unroll
                for (int i = 0; i < 2; ++i) { gi[i] = (f32x2){(float)g0[2 * i], (float)g0[2 * i + 1]}; gi[2 + i] = (f32x2){(float)g1[2 * i], (float)g1[2 * i + 1]};
                    gu[i] = gi[i] * (f32x2){(float)u0[2 * i], (float)u0[2 * i + 1]}; gu[2 + i] = gi[2 + i] * (f32x2){(float)u1[2 * i], (float)u1[2 * i + 1]}; }
                __builtin_amdgcn_sched_barrier(0);
#pragma unroll
                for (int i = 0; i < 4; ++i) { const f32x2 t = gi[i] * tg; ev[i] = (f32x2){__builtin_amdgcn_exp2f(t.x), __builtin_amdgcn_exp2f(t.y)}; }
                __builtin_amdgcn_sched_barrier(0);
#pragma unroll
                for (int i = 0; i < 4; ++i) { const f32x2 d = ev[i] + 1.0f; ev[i] = (f32x2){__builtin_amdgcn_rcpf(d.x), __builtin_amdgcn_rcpf(d.y)}; }
                __builtin_amdgcn_sched_barrier(0);
#pragma unroll
                for (int i = 0; i < 4; ++i) { const f32x2 hv = gu[i] * ev[i] * fgu; h[2 * i] = clamp448(hv.x); h[2 * i + 1] = clamp448(hv.y); }
                int w0 = __builtin_amdgcn_cvt_pk_fp8_f32(h[0], h[1], 0, false); w0 = __builtin_amdgcn_cvt_pk_fp8_f32(h[2], h[3], w0, true);
                int w1 = __builtin_amdgcn_cvt_pk_fp8_f32(h[4], h[5], 0, false); w1 = __builtin_amdgcn_cvt_pk_fp8_f32(h[6], h[7], w1, true);
                typedef unsigned u32x2 __attribute__((ext_vector_type(2)));
                *(u32x2*)(O + (size_t)row * ldc + col0) = (u32x2){(unsigned)w0, (unsigned)w1}; }
    }
};
struct EpiNullI8 {
    static constexpr bool PERM = true, AFTER_DRAIN = false;
    template <class Sched> __device__ __forceinline__ void prefill(PG8_LAS unsigned char*, const Sched&, int) const {}
    __device__ __forceinline__ void operator()(const i32x4 (&acc)[2][2][4][2], const Unit& u, int wr, int wc, int fr, int fq, PG8_LAS unsigned char* lds) const {
#pragma unroll
        for (int ai = 0; ai < 2; ++ai)
#pragma unroll
            for (int bj = 0; bj < 2; ++bj)
#pragma unroll
                for (int m = 0; m < 4; ++m) { asm volatile("" :: "v"(acc[ai][bj][m][0]), "v"(acc[ai][bj][m][1])); }
    }
};
struct EpiRowScaleBf16 {
    static constexpr bool PERM = true, AFTER_DRAIN = false;
    unsigned char* O; int ldc; const float* rs; const float* es; int tpe; float cs;
    template <class Sched> __device__ __forceinline__ void prefill(PG8_LAS unsigned char* lds, const Sched& S, int tid) const { fill_rtab(lds, S, rs, tid); }
    __device__ __forceinline__ void operator()(const f32x4 (&acc)[2][2][4][2], const Unit& u, int wr, int wc, int fr, int fq, PG8_LAS unsigned char* lds) const {
        const int row0 = u.pm * BM + wr * 64 + fr, col0 = u.pn * BM + wc * 32 + 8 * fq;
        const float esc = es[3 * (u.pm / tpe) + 2] * cs;
#pragma unroll
        for (int ai = 0; ai < 2; ++ai)
#pragma unroll
            for (int m = 0; m < 4; ++m) { const int row = row0 + ai * HALF + m * 16; const float s = ((const PG8_LAS float*)(lds + RTAB_OFF))[u.li * BM + (row - u.pm * BM)] * esc; unsigned char* rowp = O + (size_t)row * ldc + col0;
#pragma unroll
                for (int bj = 0; bj < 2; ++bj) { const f32x4 v0 = acc[ai][bj][m][0] * s, v1 = acc[ai][bj][m][1] * s;
                    int w0 = __builtin_amdgcn_cvt_pk_fp8_f32(clamp448(v0[0]), clamp448(v0[1]), 0, false); w0 = __builtin_amdgcn_cvt_pk_fp8_f32(clamp448(v0[2]), clamp448(v0[3]), w0, true);
                    int w1 = __builtin_amdgcn_cvt_pk_fp8_f32(clamp448(v1[0]), clamp448(v1[1]), 0, false); w1 = __builtin_amdgcn_cvt_pk_fp8_f32(clamp448(v1[2]), clamp448(v1[3]), w1, true);
                    typedef unsigned u32x2 __attribute__((ext_vector_type(2)));
                    *(u32x2*)(rowp + bj * HALF) = (u32x2){(unsigned)w0, (unsigned)w1}; } }
    }
};
typedef int i32x4 __attribute__((ext_vector_type(4)));
typedef int i32x8 __attribute__((ext_vector_type(8)));
template <int MODE> struct AccSel { typedef f32x4 type; };
template <> struct AccSel<1> { typedef i32x4 type; };
template <int MODE> struct Frag { bf16x8 v[2]; __device__ __forceinline__ void set(int k, bf16x8 x) { v[k] = x; } };
template <> struct Frag<2> { i32x8 w; __device__ __forceinline__ void set(int k, bf16x8 x) { const i32x4 y = __builtin_bit_cast(i32x4, x); if (k == 0) w.lo = y; else w.hi = y; } };
template <class Epi, class Sched, bool ALIGN_EPI = false, bool SP2 = false, int MODE = 0, bool GATHER = false>
__device__ __forceinline__ void gemm_phase(PG8_LAS unsigned char* lds, const Gemm g, const Sched& S, const Epi& E) {
    int tid_l = threadIdx.x; asm volatile("" : "+v"(tid_l));
    const int tid = tid_l, wid = __builtin_amdgcn_readfirstlane(tid >> 6), lane = tid & 63, wr = wid >> 2, wc = wid & 3, fr = lane & 15, fq = lane >> 4;
    const int K = g.K, nt = K / BK;
    unsigned voffA[2], voffB[2];
#pragma unroll
    for (int i = 0; i < 2; ++i) { int R, C; stage_rc(tid * 16 + i * 8192, R, C); const int Rb = Epi::PERM ? ((R & ~31) + perm32(R & 31)) : R;
        voffA[i] = (unsigned)(R * K + C) * 2u; voffB[i] = (unsigned)(Rb * K + C) * 2u; }
    static_assert(!GATHER || SP2, "the gathered A operand is wired into the SP2 schedule only");
    unsigned gvc[2][2] = {{0u, 0u}, {0u, 0u}};
    PG8_LAS unsigned short* gtab = (PG8_LAS unsigned short*)(lds + GTAB_OFF);
    if constexpr (GATHER) { int ixv_[TAB_UNITS], pmv_[TAB_UNITS];
#pragma unroll
        for (int i_ = 0; i_ < TAB_UNITS; ++i_) { Unit uu_; pmv_[i_] = S.next(i_, uu_) ? uu_.pm : -1; }
#pragma unroll
        for (int i_ = 0; i_ < TAB_UNITS; ++i_) ixv_[i_] = g.gidx[(pmv_[i_] < 0 ? 0 : pmv_[i_]) * BM + (tid & (BM - 1))];
#pragma unroll
        for (int i_ = 0; i_ < TAB_UNITS; ++i_) { if (pmv_[i_] >= 0 && tid < BM) gtab[i_ * BM + tid] = (unsigned short)(ixv_[i_] < 0 ? 0 : ixv_[i_]); }
    }
    E.prefill(lds, S, tid);
    __syncthreads();
#define PG8_GOFF(ui_, gv_) do { if constexpr (GATHER) { _Pragma("unroll") for (int h_ = 0; h_ < 2; ++h_) _Pragma("unroll") for (int i_ = 0; i_ < 2; ++i_) { int R_, C_; stage_rc(tid * 16 + i_ * 8192, R_, C_); \
        const unsigned ix_ = gtab[(ui_) * BM + h_ * HALF + R_]; gv_[h_][i_] = ix_ * (unsigned)(K * 2) + (unsigned)C_ * 2u; } } } while (0)
    const size_t kstep = (size_t)(BK * 2);
    const size_t hstep = (size_t)HALF * K * 2;
    const size_t tstep = 2 * hstep;
    const unsigned ldsw = (unsigned)wid * 1024u;
    const int aoff = lds_byte(wr * 64 + fr, fq * 8), boff = lds_byte(wc * 32 + fr, fq * 8);
#define PG8_SA(b, h) (((b) * 2 + (h)) * HTB)
#define PG8_SB(b, h) ((4 + (b) * 2 + (h)) * HTB)
#define PG8_STAGE(bufoff, gbase, voff) do { _Pragma("unroll") for (int _i = 0; _i < 2; ++_i) \
        __builtin_amdgcn_global_load_lds((const unsigned*)((const char*)(gbase) + (voff)[_i]), (PG8_LAS unsigned*)(lds + (bufoff) + ldsw + _i * 8192), 16, 0, 0); } while (0)
#define PG8_STAGE_A(bufoff, gbase, h_, nx_) do { if constexpr (GATHER) PG8_STAGE(bufoff, gbase, gvc[h_]); else PG8_STAGE(bufoff, (gbase) + (h_) * hstep, voffA); } while (0)
#define PG8_LDA(dst, b, h) do { _Pragma("unroll") for (int m = 0; m < 4; ++m) _Pragma("unroll") for (int k = 0; k < 2; ++k) dst[m].set(k, *(const PG8_LAS bf16x8*)(lds + PG8_SA(b, h) + aoff + m * 2048 + k * 1024)); } while (0)
#define PG8_LDB(dst, b, h) do { _Pragma("unroll") for (int n = 0; n < 2; ++n) _Pragma("unroll") for (int k = 0; k < 2; ++k) dst[n].set(k, *(const PG8_LAS bf16x8*)(lds + PG8_SB(b, h) + boff + n * 2048 + k * 1024)); } while (0)
#define PG8_MMA(ai, bj, At, Bt) do { __builtin_amdgcn_s_setprio(1); _Pragma("unroll") for (int m = 0; m < 4; ++m) _Pragma("unroll") for (int n = 0; n < 2; ++n) { \
        if constexpr (MODE == 2) { asm volatile("v_mfma_f32_16x16x128_f8f6f4 %0, %1, %2, %0" : "+v"(acc[ai][bj][m][n]) : "v"(Bt[n].w), "v"(At[m].w)); }     \
        else { _Pragma("unroll") for (int k = 0; k < 2; ++k) { \
          if constexpr (MODE == 1) acc[ai][bj][m][n] = __builtin_amdgcn_mfma_i32_16x16x64_i8(__builtin_bit_cast(i32x4, Bt[n].v[k]), __builtin_bit_cast(i32x4, At[m].v[k]), acc[ai][bj][m][n], 0, 0, 0); \
          else acc[ai][bj][m][n] = __builtin_amdgcn_mfma_f32_16x16x32_bf16(Bt[n].v[k], At[m].v[k], acc[ai][bj][m][n], 0, 0, 0); } } } __builtin_amdgcn_s_setprio(0); } while (0)
#define PG8_WAIT_V(n) asm volatile("s_waitcnt vmcnt(" #n ")" ::: "memory")
#define PG8_WAIT_L(n) asm volatile("s_waitcnt lgkmcnt(" #n ")" ::: "memory")
#define PG8_BAR __builtin_amdgcn_s_barrier()
#define PG8_SCHED __builtin_amdgcn_sched_barrier(0)
    Unit cur, nxt; int ui = 0;
    if (!S.next(0, cur)) return;
    typedef typename AccSel<MODE>::type acc_t; const acc_t acc_zero = {};
    acc_t acc[2][2][4][2];
#pragma unroll
    for (int a = 0; a < 2; ++a)
#pragma unroll
        for (int b = 0; b < 2; ++b)
#pragma unroll
            for (int m = 0; m < 4; ++m)
#pragma unroll
                for (int n = 0; n < 2; ++n) acc[a][b][m][n] = acc_zero;
    Frag<MODE> At[4], B0[2], B1[2];
    const char* cA = (const char*)g.A + (GATHER ? (size_t)0 : (size_t)cur.pm * tstep); PG8_GOFF(0, gvc); const char* cB = (const char*)g.Bt + (size_t)(cur.pm / g.tpe) * g.bgs + (size_t)cur.pn * tstep;
    S.a_ready(cur);
    if constexpr (SP2) {
        PG8_STAGE(PG8_SB(0, 0), cB, voffB); PG8_STAGE(PG8_SB(0, 1), cB + hstep, voffB); PG8_STAGE_A(PG8_SA(0, 0), cA, 0, false); PG8_STAGE_A(PG8_SA(0, 1), cA, 1, false);
        if (wr == 1) PG8_BAR;
        PG8_WAIT_V(2); PG8_BAR;
        PG8_STAGE(PG8_SB(1, 0), cB + kstep, voffB); PG8_STAGE_A(PG8_SA(1, 0), cA + kstep, 0, false); PG8_STAGE(PG8_SB(1, 1), cB + hstep + kstep, voffB);
        PG8_WAIT_V(6); PG8_BAR;
    } else {
        PG8_STAGE(PG8_SB(0, 0), cB, voffB); PG8_STAGE(PG8_SA(0, 0), cA, voffA); PG8_STAGE(PG8_SB(0, 1), cB + hstep, voffB); PG8_STAGE(PG8_SA(0, 1), cA + hstep, voffA);
        if (wr == 1) PG8_BAR;
        PG8_WAIT_V(4); PG8_BAR;
        PG8_STAGE(PG8_SB(1, 0), cB + kstep, voffB); PG8_STAGE(PG8_SA(1, 0), cA + kstep, voffA); PG8_STAGE(PG8_SB(1, 1), cB + hstep + kstep, voffB);
        PG8_WAIT_V(6); PG8_BAR;
    }
    for (;;) {
        const bool has_next = S.next(ui + 1, nxt);
        const char* nA = (has_next && !GATHER) ? (const char*)g.A + (size_t)nxt.pm * tstep : cA; const char* nB = has_next ? (const char*)g.Bt + (size_t)(nxt.pm / g.tpe) * g.bgs + (size_t)nxt.pn * tstep : cB;
        for (int t = 0; t < nt; t += 2) {
            const bool last = (t == nt - 2); const bool nxu = last && has_next;
            const char* a1 = cA + (size_t)(t + 1) * kstep;
            const char* a2 = last ? nA : cA + (size_t)(t + 2) * kstep; const char* b2 = last ? nB : cB + (size_t)(t + 2) * kstep;
            const char* a3 = a2 + kstep; const char* b3 = b2 + kstep;
            if (last && has_next) S.a_ready(nxt);
            if constexpr (SP2) {
            PG8_LDB(B0, 0, 0); PG8_LDB(B1, 0, 1); PG8_SCHED; PG8_LDA(At, 0, 0); PG8_STAGE_A(PG8_SA(1, 1), a1, 1, false); if (nxu) PG8_GOFF(ui + 1, gvc);
            PG8_WAIT_V(8); PG8_WAIT_L(0); PG8_BAR; PG8_MMA(0, 0, At, B0); PG8_MMA(0, 1, At, B1); PG8_BAR; PG8_SCHED;
            PG8_LDA(At, 0, 1); PG8_STAGE(PG8_SB(0, 0), b2, voffB); PG8_STAGE(PG8_SB(0, 1), b2 + hstep, voffB); PG8_STAGE_A(PG8_SA(0, 0), a2, 0, nxu);
            PG8_WAIT_V(8); PG8_WAIT_L(0); PG8_BAR; PG8_MMA(1, 0, At, B0); PG8_MMA(1, 1, At, B1); PG8_BAR; PG8_SCHED;
            PG8_LDB(B0, 1, 0); PG8_LDB(B1, 1, 1); PG8_SCHED; PG8_LDA(At, 1, 0); PG8_STAGE_A(PG8_SA(0, 1), a2, 1, nxu);
            PG8_WAIT_V(8); PG8_WAIT_L(0); PG8_BAR; PG8_MMA(0, 0, At, B0); PG8_MMA(0, 1, At, B1); PG8_BAR; PG8_SCHED;
            PG8_LDA(At, 1, 1); PG8_STAGE(PG8_SB(1, 0), b3, voffB); PG8_STAGE(PG8_SB(1, 1), b3 + hstep, voffB); PG8_STAGE_A(PG8_SA(1, 0), a3, 0, nxu);
            PG8_WAIT_V(8); PG8_WAIT_L(0); PG8_BAR; PG8_MMA(1, 0, At, B0); PG8_MMA(1, 1, At, B1); PG8_BAR; PG8_SCHED;
            } else {
            PG8_LDB(B0, 0, 0); PG8_SCHED; PG8_LDA(At, 0, 0); PG8_STAGE(PG8_SA(1, 1), a1 + hstep, voffA);
            PG8_WAIT_L(8); PG8_BAR; PG8_WAIT_L(0); PG8_MMA(0, 0, At, B0); PG8_BAR; PG8_SCHED;
            PG8_LDB(B1, 0, 1); PG8_STAGE(PG8_SB(0, 0), b2, voffB);
            PG8_BAR; PG8_WAIT_L(0); PG8_MMA(0, 1, At, B1); PG8_BAR;
            PG8_LDA(At, 0, 1); PG8_STAGE(PG8_SA(0, 0), a2, voffA);
            PG8_BAR; PG8_WAIT_L(0); PG8_MMA(1, 0, At, B0); PG8_BAR; PG8_SCHED;
            PG8_STAGE(PG8_SB(0, 1), b2 + hstep, voffB);
            PG8_WAIT_V(6); PG8_BAR; PG8_MMA(1, 1, At, B1); PG8_BAR;
            PG8_LDB(B0, 1, 0); PG8_SCHED; PG8_LDA(At, 1, 0); PG8_STAGE(PG8_SA(0, 1), a2 + hstep, voffA);
            PG8_WAIT_L(8); PG8_BAR; PG8_WAIT_L(0); PG8_MMA(0, 0, At, B0); PG8_BAR; PG8_SCHED;
            PG8_LDB(B1, 1, 1); PG8_STAGE(PG8_SB(1, 0), b3, voffB);
            PG8_BAR; PG8_WAIT_L(0); PG8_MMA(0, 1, At, B1); PG8_BAR;
            PG8_LDA(At, 1, 1); PG8_STAGE(PG8_SA(1, 0), a3, voffA);
            PG8_BAR; PG8_WAIT_L(0); PG8_MMA(1, 0, At, B0); PG8_BAR; PG8_SCHED;
            PG8_STAGE(PG8_SB(1, 1), b3 + hstep, voffB);
            PG8_WAIT_V(6); PG8_BAR; PG8_MMA(1, 1, At, B1); PG8_BAR;
            }
        }
        if constexpr (ALIGN_EPI) { if (wr == 0) PG8_BAR; }
        if constexpr (!Epi::AFTER_DRAIN) { E(acc, cur, wr, wc, fr, fq, lds); S.done(cur); }
        if (!has_next) break;
#pragma unroll
        for (int a = 0; a < 2; ++a)
#pragma unroll
            for (int b = 0; b < 2; ++b)
#pragma unroll
                for (int m = 0; m < 4; ++m)
#pragma unroll
                    for (int n = 0; n < 2; ++n) acc[a][b][m][n] = acc_zero;
        cur = nxt; cA = nA; cB = nB; ++ui;
        if constexpr (ALIGN_EPI) { if (wr == 1) PG8_BAR; }
    }
    PG8_WAIT_V(0);
    if constexpr (!ALIGN_EPI) { if (wr == 0) PG8_BAR; }
    PG8_BAR;
    if constexpr (Epi::AFTER_DRAIN) { E.fused(acc, cur, wr, wc, fr, fq, lds, wid, lane); S.done(cur); }
#undef PG8_SA
#undef PG8_SB
#undef PG8_STAGE
#undef PG8_STAGE_A
#undef PG8_GOFF
#undef PG8_LDA
#undef PG8_LDB
#undef PG8_MMA
#undef PG8_WAIT_V
#undef PG8_WAIT_L
#undef PG8_BAR
#undef PG8_SCHED
}
}
namespace att {
typedef unsigned short bf16_t;
typedef short bf16x8 __attribute__((ext_vector_type(8)));
typedef short s16x4 __attribute__((ext_vector_type(4)));
typedef float f32x16 __attribute__((ext_vector_type(16)));
typedef float f32x4 __attribute__((ext_vector_type(4)));
typedef unsigned u32x4 __attribute__((ext_vector_type(4)));
typedef unsigned u32x2 __attribute__((ext_vector_type(2)));
#define ALDS __attribute__((address_space(3)))
typedef float f32x2_t __attribute__((ext_vector_type(2))); typedef __bf16 bf16x2_t __attribute__((ext_vector_type(2)));
__device__ __forceinline__ unsigned cvtpk(float lo, float hi) { f32x2_t v = {lo, hi}; bf16x2_t b = __builtin_convertvector(v, bf16x2_t); return __builtin_bit_cast(unsigned, b); }
__device__ __forceinline__ float bf2f(unsigned short u) { return __uint_as_float((unsigned)u << 16); }
template <int S> __device__ __forceinline__ bf16x8 pack8(const f32x16& x) {
    u32x4 p; p.x = cvtpk(x[8 * S + 0], x[8 * S + 1]); p.y = cvtpk(x[8 * S + 2], x[8 * S + 3]); p.z = cvtpk(x[8 * S + 4], x[8 * S + 5]); p.w = cvtpk(x[8 * S + 6], x[8 * S + 7]);
    return __builtin_bit_cast(bf16x8, p);
}
typedef short v4i16_t __attribute__((ext_vector_type(4)));
__device__ __forceinline__ s16x4 vtr(const ALDS char* p) { return __builtin_bit_cast(s16x4, __builtin_amdgcn_ds_read_tr16_b64_v4i16((ALDS v4i16_t*)p)); }
__device__ __forceinline__ int crow(int r, int hi) { return (r & 3) + 8 * (r >> 2) + 4 * hi; }
constexpr int ATT_LDS_BYTES = 2 * 12288 + 2 * 8192;

__device__ __forceinline__ void glds16(const void* gsrc, unsigned lds_dst) { unsigned keep;
    asm volatile("s_mov_b32 %0, m0\n\ts_mov_b32 m0, %2\n\ts_nop 0\n\tglobal_load_lds_dwordx4 %1, off\n\ts_mov_b32 m0, %0" : "=&s"(keep) : "v"(gsrc), "s"(lds_dst) : "memory"); }
__device__ __forceinline__ void glds16s(const char* sbase, unsigned voff, unsigned lds_dst) { unsigned keep;
    asm volatile("s_mov_b32 %0, m0\n\ts_mov_b32 m0, %3\n\ts_nop 0\n\tglobal_load_lds_dwordx4 %1, %2\n\ts_mov_b32 m0, %0" : "=&s"(keep) : "v"(voff), "s"(sbase), "s"(lds_dst) : "memory"); }
#define ATT_SBAR() __builtin_amdgcn_sched_barrier(0)
#define ATT_PIN(x) asm volatile("" : "+v"(x))
typedef int i32x2a __attribute__((ext_vector_type(2)));
typedef int i32x4a __attribute__((ext_vector_type(4)));
typedef int i32x6a __attribute__((ext_vector_type(6)));
typedef int i32x8a __attribute__((ext_vector_type(8)));
typedef unsigned u32x16 __attribute__((ext_vector_type(16)));
typedef __bf16 bf16x32_t __attribute__((ext_vector_type(32)));
__device__ __forceinline__ i32x6a cvt_fp6x32(const u32x16& w) { return __builtin_bit_cast(i32x6a, __builtin_amdgcn_cvt_scalef32_pk32_fp6_bf16(__builtin_bit_cast(bf16x32_t, w), 1.0f)); }
#define ATT_MF6_Z(C, A, B, SA, SB) asm volatile("v_mfma_scale_f32_32x32x64_f8f6f4 %0, %1, %2, 0, %3, %4 op_sel:[0,0,0] op_sel_hi:[0,0,0] cbsz:2 blgp:2" : "=&v"(C) : "v"(A), "v"(B), "v"(SA), "v"(SB))
#define ATT_MF6_A(C, A, B, SA, SB) asm volatile("v_mfma_scale_f32_32x32x64_f8f6f4 %0, %1, %2, %0, %3, %4 op_sel:[0,0,0] op_sel_hi:[0,0,0] cbsz:2 blgp:2" : "+v"(C) : "v"(A), "v"(B), "v"(SA), "v"(SB))
#define ATT_MF6_C(C, A, B, C0, SA, SB) asm volatile("v_mfma_scale_f32_32x32x64_f8f6f4 %0, %1, %2, %3, %4, %5 op_sel:[0,0,0] op_sel_hi:[0,0,0] cbsz:2 blgp:2" : "=&v"(C) : "v"(A), "v"(B), "v"(C0), "v"(SA), "v"(SB))
template <int DK> struct KCfg { static constexpr int NG = (DK == 96) ? 3 : 2, KTB = (DK == 96) ? 5120 : 3072, QRB = 24 * NG, NF = (DK == 96) ? 2 : 1, NRD = 4 * NF, PB = NG * 1024,
                                                      SCL = (DK == 32) ? 0x77777777 : 0x76767676, NB = (DK == 32) ? 2 : 4; };
constexpr float FQ96 = 4.0f * 1.4426950408889634f * 0.10206207261596575f * 2.0f, FQ32 = 4.0f * 1.4426950408889634f * 0.17677669529663687f, FQ64 = 4.0f * 1.4426950408889634f * 0.125f * 2.0f;
constexpr float P_BIAS = 44.0f / 256.0f;
constexpr int KC_A = 0, KC_B = 1024;
template <int DK>
__device__ __forceinline__ void kread6(i32x6a (&kf)[2][KCfg<DK>::NF], const ALDS char* pA0, const ALDS char* pB0, const ALDS char* pA1, const ALDS char* pB1, int idx) {
    constexpr int NF = KCfg<DK>::NF;
    const int mt = idx / (2 * NF), f = (idx / 2) % NF, part = idx & 1;
    const ALDS char* pA = f ? pA1 : pA0; const ALDS char* pB = f ? pB1 : pB0;
    if (part == 0) { const i32x4a v = *(const ALDS i32x4a*)(pA + mt * 512); kf[mt][f][0] = v.x; kf[mt][f][1] = v.y; kf[mt][f][2] = v.z; kf[mt][f][3] = v.w; }
    else { const i32x2a v = *(const ALDS i32x2a*)(pB + mt * 256); kf[mt][f][4] = v.x; kf[mt][f][5] = v.y; }
}
#define ATT_PV8(C, A, B) asm volatile("s_nop 3\n\tv_mfma_f32_32x32x64_f8f6f4 %0, %1, %2, %0 cbsz:0 blgp:1" : "+v"(C) : "v"(A), "v"(B))
#define ATT_L8(C, A, B) asm volatile("s_nop 3\n\tv_mfma_f32_16x16x128_f8f6f4 %0, %1, %2, %0 cbsz:0 blgp:1" : "+v"(C) : "v"(A), "v"(B))
#define ATT_L8N(C, A, B) asm volatile("v_mfma_f32_16x16x128_f8f6f4 %0, %1, %2, %0 cbsz:0 blgp:1" : "+v"(C) : "v"(A), "v"(B))
#define ATT_PV8N(C, A, B) asm volatile("v_mfma_f32_32x32x64_f8f6f4 %0, %1, %2, %0 cbsz:0 blgp:1" : "+v"(C) : "v"(A), "v"(B))
typedef unsigned short u16x2 __attribute__((ext_vector_type(2)));
__device__ __forceinline__ unsigned pk4_bf8(float a, float b, float c, float d) {
    const u16x2 x = __builtin_amdgcn_cvt_pknorm_u16(a, b), y = __builtin_amdgcn_cvt_pknorm_u16(c, d);
    return __builtin_amdgcn_perm(__builtin_bit_cast(unsigned, y), __builtin_bit_cast(unsigned, x), 0x07050301u); }
struct KPtr { const ALDS char *a0, *b0, *a1, *b1; };
template <int DK, int VLOAD, int ABL = 0, class DF>
__device__ __forceinline__ void att_step9(f32x16& N0, f32x16& N1, const f32x16& P0, const f32x16& P1, i32x6a (&kf)[2][KCfg<DK>::NF], const i32x6a* qfn,
                                          f32x16 (&o)[2], f32x4& L, const i32x8a& pwP, i32x8a& pwC, i32x8a (&vf)[2], const i32x8a& ones, const f32x16& cb, const int& sa, const int& sb,
                                          const ALDS char* vcur, const KPtr k1, const KPtr k0, DF&& dmaf) {
    constexpr int NF = KCfg<DK>::NF;
#define ATP_PACK(i) do { if (!(ABL & 4)) { const int e = 4 * (i); \
        int w = (int)((e < 16) ? pk4_bf8(P0[e & 15], P0[(e + 1) & 15], P0[(e + 2) & 15], P0[(e + 3) & 15]) : pk4_bf8(P1[e & 15], P1[(e + 1) & 15], P1[(e + 2) & 15], P1[(e + 3) & 15])); \
        ATT_PIN(w); pwC[i] = w; } } while (0)
    ATT_SBAR();
    ATT_PV8N(o[0], vf[0], pwP);
    dmaf();
#pragma unroll
    for (int k = 2 * NF; k < 4 * NF; ++k) { if (!(ABL & 8)) kread6<DK>(kf, k1.a0, k1.b0, k1.a1, k1.b1, k); }
#pragma unroll
    for (int i = 0; i < 4; ++i) ATP_PACK(i);
    ATT_SBAR();
    ATT_PV8N(o[1], vf[1], pwP);
    if (VLOAD && !(ABL & 8)) { vf[0].lo = *(const ALDS i32x4a*)(vcur); vf[0].hi = *(const ALDS i32x4a*)(vcur + 1024); }
#pragma unroll
    for (int i = 4; i < 8; ++i) ATP_PACK(i);
    ATT_SBAR();
    ATT_L8N(L, ones, pwP);
    if (VLOAD && !(ABL & 8)) { vf[1].lo = *(const ALDS i32x4a*)(vcur + 512); vf[1].hi = *(const ALDS i32x4a*)(vcur + 512 + 1024); }
    ATT_SBAR();
    if (DK == 64) { ATT_MF6_C(N0, kf[0][0], qfn[0], cb, sa, sb); ATT_MF6_C(N1, kf[1][0], qfn[0], cb, sa, sb); }
    else if (NF == 1) { ATT_MF6_Z(N0, kf[0][0], qfn[0], sa, sb); ATT_MF6_Z(N1, kf[1][0], qfn[0], sa, sb); }
    else { ATT_MF6_Z(N0, kf[0][0], qfn[0], sa, sb); ATT_MF6_Z(N1, kf[1][0], qfn[0], sa, sb); ATT_MF6_A(N0, kf[0][1], qfn[1], sa, sb); ATT_MF6_A(N1, kf[1][1], qfn[1], sa, sb); }
    ATT_SBAR();
#pragma unroll
    for (int k = 0; k < 2 * NF; ++k) { if (!(ABL & 8)) kread6<DK>(kf, k0.a0, k0.b0, k0.a1, k0.b1, k); }
    ATT_SBAR();
#undef ATP_PACK
}
template <int DK, int NMAP, int ABL = 0>
__device__ __forceinline__ void attn_unit_f8(const unsigned char* __restrict__ Qb, const char* __restrict__ Kt, const char* __restrict__ Vt, int t0, int t1,
                                             bf16_t* __restrict__ Ob, ALDS char* lds, float lam, const float* __restrict__ gout, float oml) {
    typedef KCfg<DK> KC;
    constexpr int KTB = KC::KTB, NF = KC::NF, NRD = KC::NRD, LV = 8 * KTB, CB = LV + 8 * 4096, NKP = KTB / 1024, NP = NKP + 4, NDMA = (NP + 7) / 8;
    int tid_l = threadIdx.x; asm volatile("" : "+v"(tid_l));
    const int tid = tid_l, lane = tid & 63, r32 = lane & 31, hi = lane >> 5, wid = __builtin_amdgcn_readfirstlane(tid >> 6);
    i32x6a qbias;
    { u32x16 vq, vk; unsigned pq = 0x40B040B0u, pk = 0x40804080u;
      asm volatile("" : "+v"(pq), "+v"(pk));
#pragma unroll
      for (int r = 0; r < 16; ++r) { vq[r] = (2 * r < KC::NB) ? pq : 0u; vk[r] = (2 * r < KC::NB) ? pk : 0u; }
      qbias = cvt_fp6x32(vq);
      if (DK != 64 && tid == 0) { const i32x6a kb = cvt_fp6x32(vk); const i32x4a ka = {kb[0], kb[1], kb[2], kb[3]}; const i32x2a kc = {kb[4], kb[5]};
          *(ALDS i32x4a*)(lds + CB + KC_A) = ka; *(ALDS i32x4a*)(lds + CB + KC_A + 512) = ka; *(ALDS i32x2a*)(lds + CB + KC_B) = kc; *(ALDS i32x2a*)(lds + CB + KC_B + 256) = kc; } }
    i32x6a qf[NMAP][NF];
    { const unsigned char* qrow = Qb + (size_t)(wid * 32 + r32) * KC::QRB;
#define ATP_QG(dst, off) do { const i32x2a a_ = *(const i32x2a*)(qrow + (off)), b_ = *(const i32x2a*)(qrow + (off) + 8), c_ = *(const i32x2a*)(qrow + (off) + 16); \
          dst[0] = a_.x; dst[1] = a_.y; dst[2] = b_.x; dst[3] = b_.y; dst[4] = c_.x; dst[5] = c_.y; } while (0)
      if (DK == 64) { ATP_QG(qf[0][0], 24 * hi); }
      else if (DK == 96) { ATP_QG(qf[0][0], 24 * hi); i32x6a t; ATP_QG(t, 48);
#pragma unroll
          for (int r = 0; r < 6; ++r) qf[0][NF - 1][r] = hi ? qbias[r] : t[r]; }
      else {
#pragma unroll
          for (int m = 0; m < NMAP; ++m) { i32x6a t; ATP_QG(t, 24 * m);
#pragma unroll
              for (int r = 0; r < 6; ++r) qf[m][0][r] = hi ? qbias[r] : t[r]; } }
#undef ATP_QG
    }
#pragma unroll
    for (int m = 0; m < NMAP; ++m)
#pragma unroll
        for (int f = 0; f < NF; ++f) ATT_PIN(qf[m][f]);
    f32x16 o[NMAP][2], cb; f32x4 L[NMAP]; i32x8a pw, ones; int sa = 0x7F7F7F7F, sb = KC::SCL;
    ATT_PIN(sa); ATT_PIN(sb);
#pragma unroll
    for (int r = 0; r < 16; ++r) cb[r] = P_BIAS;
    if (DK == 64) ATT_PIN(cb);
    { const int sel = (lane == 0 || lane == 32 || lane == 17 || lane == 49) ? 0x38383838 : 0;
#pragma unroll
      for (int r = 0; r < 8; ++r) { pw[r] = 0; ones[r] = sel; } }
    ATT_PIN(ones);
#pragma unroll
    for (int m = 0; m < NMAP; ++m) {
#pragma unroll
        for (int r = 0; r < 4; ++r) L[m][r] = 0.f;
#pragma unroll
        for (int d = 0; d < 2; ++d)
#pragma unroll
            for (int r = 0; r < 16; ++r) o[m][d][r] = 0.f; }
#pragma unroll
    for (int m = 0; m < NMAP; ++m) { ATT_PIN(L[m]); ATT_PIN(o[m][0]); ATT_PIN(o[m][1]); }
    const unsigned lds0 = (unsigned)(size_t)lds;
    const char* src0; unsigned dst0; int isv0; const bool act0 = wid < NP;
    { const int p = wid; isv0 = p >= NKP; src0 = (isv0 ? Vt + (p - NKP) * 1024 : Kt + p * 1024); dst0 = lds0 + (isv0 ? LV + (p - NKP) * 1024 : p * 1024); }
    const unsigned lane16 = (unsigned)lane * 16u;
    const bool act1 = (NDMA == 2) && wid == 7;
    const char* src1 = nullptr; unsigned dst1 = 0u;
    if (NDMA == 2) { const int p = 8; src1 = Vt + (p - NKP) * 1024; dst1 = lds0 + LV + (p - NKP) * 1024; }
#define ATP_DMA(tk, tv) do { if (ABL & (2 | 32)) break; \
        if (act0) { if (isv0) glds16s(src0 + (size_t)(tv) * 4096, lane16, (unsigned)__builtin_amdgcn_readfirstlane(dst0 + ((tv) & 7) * 4096)); else glds16s(src0 + (size_t)(tk) * KTB, lane16, (unsigned)__builtin_amdgcn_readfirstlane(dst0 + ((tk) & 7) * KTB)); } \
        if (act1) glds16s(src1 + (size_t)(tv) * 4096, lane16, (unsigned)__builtin_amdgcn_readfirstlane(dst1 + ((tv) & 7) * 4096)); } while (0)
#define ATP_SYNCALL() do { if (ABL & 2) break; if (!(ABL & 128)) { if (act1) asm volatile("s_waitcnt vmcnt(4)" ::: "memory"); else asm volatile("s_waitcnt vmcnt(2)" ::: "memory"); } \
        if (!(ABL & 64)) asm volatile("s_barrier" ::: "memory"); } while (0)
    const bool c0 = (DK == 32) && hi, c1 = hi;
    const int ka0 = c0 ? CB + KC_A : ((DK == 32) ? 0 : hi * 1024) + r32 * 16, kb0 = c0 ? CB + KC_B : KC::PB + ((DK == 32) ? 0 : hi * 512) + r32 * 8, km0 = c0 ? 0 : KTB;
    const int dA = (DK == 32 && !hi) ? 1024 : 0, dB = (DK == 32 && !hi) ? 512 : 0;
    const int ka1 = c1 ? CB + KC_A : 2048 + r32 * 16, kb1 = c1 ? CB + KC_B : KC::PB + 1024 + r32 * 8, km1 = c1 ? 0 : KTB;
#define ATP_KP(t, m) (KPtr{lds + ((t) & 7) * km0 + ka0 + (m) * dA, lds + ((t) & 7) * km0 + kb0 + (m) * dB, lds + ((t) & 7) * km1 + ka1, lds + ((t) & 7) * km1 + kb1})
#define ATP_VB(t) (lds + LV + ((t) & 7) * 4096 + klane64)
#define ATP_KLOAD(t, m) do { const KPtr kp_ = ATP_KP(t, m); _Pragma("unroll") for (int k = 0; k < NRD; ++k) kread6<DK>(kf, kp_.a0, kp_.b0, kp_.a1, kp_.b1, k); \
        asm volatile("s_waitcnt lgkmcnt(0)" ::: "memory"); \
        _Pragma("unroll") for (int mt_ = 0; mt_ < 2; ++mt_) _Pragma("unroll") for (int f_ = 0; f_ < NF; ++f_) ATT_PIN(kf[mt_][f_]);     \
        asm volatile("s_nop 3" ::: "memory"); } while (0)
    const int klane64 = hi * 2048 + r32 * 16;
    ATP_DMA(t0, t0); ATP_DMA(t0 + 1, t0 + 1); ATP_DMA(t0 + 2, t0 + 1); if (NMAP == 1) ATP_DMA(t0 + 3, t0 + 1);
    asm volatile("s_waitcnt vmcnt(0) lgkmcnt(0)\n\ts_barrier" ::: "memory");
    if (NMAP == 1) { ATP_DMA(t0 + 4, t0 + 2); ATP_DMA(t0 + 5, t0 + 3); } else { ATP_DMA(t0 + 3, t0 + 2); ATP_DMA(t0 + 4, t0 + 3); }
    i32x6a kf[2][NF]; i32x8a vf[2], pwB;
    f32x16 sA0, sA1, sB0, sB1;
    ATP_KLOAD(t0, 0);
    if (DK == 64) { ATT_MF6_C(sA0, kf[0][0], qf[0][0], cb, sa, sb); ATT_MF6_C(sA1, kf[1][0], qf[0][0], cb, sa, sb); } else { ATT_MF6_Z(sA0, kf[0][0], qf[0][0], sa, sb); ATT_MF6_Z(sA1, kf[1][0], qf[0][0], sa, sb); }
    if (NF == 2) { ATT_MF6_A(sA0, kf[0][1], qf[0][1], sa, sb); ATT_MF6_A(sA1, kf[1][1], qf[0][1], sa, sb); }
    asm volatile("s_nop 15\n\ts_nop 15\n\ts_nop 15\n\ts_nop 15\n\ts_nop 15\n\ts_nop 15" : "+v"(sA0), "+v"(sA1));
    { const KPtr kp_ = (NMAP == 1) ? ATP_KP(t0 + 1, 0) : ATP_KP(t0, 1);
#pragma unroll
      for (int k = 0; k < 2 * NF; ++k) kread6<DK>(kf, kp_.a0, kp_.b0, kp_.a1, kp_.b1, k); }
#pragma unroll
    for (int r = 0; r < 8; ++r) { vf[0][r] = 0; vf[1][r] = 0; pwB[r] = 0; }
    ATT_PIN(vf[0]); ATT_PIN(vf[1]); ATT_PIN(pwB);
    asm volatile("s_nop 3" ::: "memory");
    if (NMAP == 1) {
        for (int t = t0; t < t1; t += 2) {
            att_step9<DK, 1, ABL>(sB0, sB1, sA0, sA1, kf, qf[0], o[0], L[0], pwB, pw, vf, ones, cb, sa, sb, ATP_VB(t), ATP_KP(t + 1, 0), ATP_KP(t + 2, 0), [&]() { ATP_DMA(t + 6, t + 4); ATP_DMA(t + 7, t + 5); });
            att_step9<DK, 1, ABL>(sA0, sA1, sB0, sB1, kf, qf[0], o[0], L[0], pw, pwB, vf, ones, cb, sa, sb, ATP_VB(t + 1), ATP_KP(t + 2, 0), ATP_KP(t + 3, 0), [&]() {});
            ATP_SYNCALL();
        }
    } else {
        for (int t = t0; t < t1; t += 2) {
            att_step9<DK, 1, ABL>(sB0, sB1, sA0, sA1, kf, qf[1], o[1], L[1], pwB, pw, vf, ones, cb, sa, sb, ATP_VB(t), ATP_KP(t, 1), ATP_KP(t + 1, 0), [&]() { ATP_DMA(t + 5, t + 4); });
            att_step9<DK, 0, ABL>(sA0, sA1, sB0, sB1, kf, qf[0], o[0], L[0], pw, pwB, vf, ones, cb, sa, sb, ATP_VB(t), ATP_KP(t + 1, 0), ATP_KP(t + 1, 1), [&]() { ATP_DMA(t + 6, t + 5); });
            att_step9<DK, 1, ABL>(sB0, sB1, sA0, sA1, kf, qf[1], o[1], L[1], pwB, pw, vf, ones, cb, sa, sb, ATP_VB(t + 1), ATP_KP(t + 1, 1), ATP_KP(t + 2, 0), [&]() {});
            att_step9<DK, 0, ABL>(sA0, sA1, sB0, sB1, kf, qf[0], o[0], L[0], pw, pwB, vf, ones, cb, sa, sb, ATP_VB(t + 1), ATP_KP(t + 2, 0), ATP_KP(t + 2, 1), [&]() {});
            ATP_SYNCALL();
        }
    }
    ATT_SBAR();
    ATT_PV8N(o[NMAP - 1][0], vf[0], pwB); ATT_PV8N(o[NMAP - 1][1], vf[1], pwB); ATT_L8N(L[NMAP - 1], ones, pwB);
    asm volatile("s_waitcnt vmcnt(0) lgkmcnt(0)\n\ts_barrier" ::: "memory");
#pragma unroll
    for (int m = 0; m < NMAP; ++m) asm volatile("s_nop 15\n\ts_nop 15\n\ts_nop 15\n\ts_nop 15\n\ts_nop 15" : "+v"(o[m][0]), "+v"(o[m][1]), "+v"(L[m]));
#undef ATP_DMA
#undef ATP_SYNCALL
#undef ATP_KP
#undef ATP_VB
#undef ATP_KLOAD
    float li[NMAP];
#pragma unroll
    for (int m = 0; m < NMAP; ++m) { const float l0 = __shfl(L[m][0], r32 & 15), l1 = __shfl(L[m][1], r32 & 15); li[m] = 1.0f / ((r32 & 16) ? l1 : l0); }
    float val[2][16];
    if (NMAP == 1) {
#pragma unroll
        for (int d = 0; d < 2; ++d)
#pragma unroll
            for (int r = 0; r < 16; ++r) val[d][r] = o[0][d][r] * li[0];
    } else {
        float ss = 0.f; const float l2 = lam * li[NMAP - 1];
#pragma unroll
        for (int d = 0; d < 2; ++d)
#pragma unroll
            for (int r = 0; r < 16; ++r) { const float v = o[0][d][r] * li[0] - o[NMAP - 1][d][r] * l2; val[d][r] = v; ss += v * v; }
        ss += __shfl_xor(ss, 32);
        const float rstd = rsqrtf(ss * (1.0f / 64.0f) + 1e-6f) * oml;
#pragma unroll
        for (int d = 0; d < 2; ++d)
#pragma unroll
            for (int g = 0; g < 4; ++g) { const f32x4 gv = *(const f32x4*)(gout + 32 * d + 8 * g + 4 * hi);
#pragma unroll
                for (int i = 0; i < 4; ++i) val[d][4 * g + i] *= rstd * gv[i]; }
    }
    bf16_t* orow = Ob + (size_t)(wid * 32 + r32) * 1024 + 4 * hi;
#pragma unroll
    for (int d = 0; d < 2; ++d)
#pragma unroll
        for (int g = 0; g < 4; ++g) { u32x2 w; w.x = cvtpk(val[d][4 * g], val[d][4 * g + 1]); w.y = cvtpk(val[d][4 * g + 2], val[d][4 * g + 3]);
            *(u32x2*)(orow + 32 * d + 8 * g) = w; }
}

}
constexpr int NWAVES = 8;
constexpr int DM = 1024, NB = 4, SEQ = 8192, CL = 256, NTOKB = SEQ + CL, LROWS = NB * SEQ, MROWS = LROWS + NB * CL;
constexpr int NLAYER = 2, INC = 1952, ZP = 3072, NE = 16, FFD = 2048, CAPL = 1024, CAPC = 32, NKT = NTOKB / 64;
constexpr int ZQ = 1952, ZKV = 2336, ZEND = 2848;
constexpr float EPSF = 1e-6f, LOG2E = 1.4426950408889634f, HID_SCALE = 4.0f, YE_SCALE = 32.0f;
constexpr int N_PHASES = 22;
enum { I_X = 0, I_C, I_CTX, I_CCTX, I_WADA, I_BADA, I_GN1, I_WIN, I_GCQ, I_GCKV, I_WUQ, I_WUKV, I_GMQ, I_GMK, I_GDQ, I_GDK, I_LQ1, I_LK1, I_LQ2, I_LK2, I_GDO, I_GGQ, I_GGK, I_WO, I_GN2, I_WR, I_WG, I_WU, I_WD, N_IN };
constexpr size_t MiB = 1u << 20;
constexpr size_t WS_CTL = 0, CTL_ZERO_BYTES = 1 * MiB;
constexpr size_t WS_MOD = 1 * MiB;
constexpr size_t WS_LAM = WS_MOD + 256 * 1024;
constexpr size_t WS_TAB = WS_MOD + 320 * 1024;
constexpr size_t TAB_AROW = 0, TAB_ACOL = 128 * 8 * 8, TAB_GROW = TAB_ACOL + 64 * 8 * 8, TAB_GCOL = TAB_GROW + 128 * 16 * 8;
constexpr size_t WS_AFF = 2 * MiB, WS_AFFC = 4 * MiB;
constexpr size_t WS_IDX = 5 * MiB, WS_GATE = 6 * MiB;
constexpr size_t WS_INV = 7 * MiB;
constexpr size_t WS_SA = 10 * MiB, WS_SAE = 11 * MiB, WS_SW = 12 * MiB;
constexpr size_t WS_SSQ = 14 * MiB;
constexpr size_t WS_SWC = 13 * MiB;
constexpr size_t WS_WCAT8 = 72 * MiB;
constexpr size_t WS_WCAT = 16 * MiB;
constexpr size_t WS_WO = 28 * MiB;
constexpr size_t WS_CTXW = 32 * MiB;
constexpr size_t WS_H = 36 * MiB;
constexpr size_t WS_WGU = 102 * MiB, WGU_LAYER = 64 * MiB;
constexpr size_t WS_WD = 230 * MiB, WD_LAYER = 32 * MiB;
constexpr size_t WS_YE = 294 * MiB;
constexpr size_t WS_Z = 430 * MiB;
constexpr size_t WS_QKV = 628 * MiB;
constexpr size_t WS_ATT = 793 * MiB;
constexpr size_t WS_DELTA = 430 * MiB;
constexpr size_t WS_XE = 430 * MiB;
constexpr size_t WS_HID = 566 * MiB;
constexpr size_t WS_XB = 859 * MiB;
constexpr size_t WS_END = 925 * MiB;
constexpr size_t QO_QM = 0, QO_QD = 25952256, QO_QG = 43253760, QO_KM = 77856768, QO_KD = 103809024, QO_KG = 121110528, QO_VM = 129761280, QO_VD = 147062784, QO_VG = 164364288;
static_assert(QO_VG + 8650752 == 173015040 && WS_QKV + 173015040 <= WS_ATT && WS_HID + (size_t)16 * 4352 * 2048 * 2 <= WS_XB, "ws map");
constexpr int CW_BAR = 4096, CW_Q = 16384;
constexpr int RING_BYTES = 131072, LDSCTL_OFF = RING_BYTES, MISC_OFF = LDSCTL_OFF + 320, LDS_BYTES = 163840;

#define GAS __attribute__((address_space(1)))
#define LAS __attribute__((address_space(3)))
typedef unsigned short bf16;
typedef unsigned v4u __attribute__((ext_vector_type(4)));
typedef unsigned v2u __attribute__((ext_vector_type(2)));
typedef float f32x4 __attribute__((ext_vector_type(4)));
typedef float f32x2 __attribute__((ext_vector_type(2)));
typedef GAS unsigned gu32;
#define RLX_AGENT __ATOMIC_RELAXED, __HIP_MEMORY_SCOPE_AGENT
#define LDS_WAIT() asm volatile("s_waitcnt lgkmcnt(0)" ::: "memory")
__device__ __forceinline__ unsigned pk2(float lo, float hi) { return att::cvtpk(lo, hi); }
__device__ __forceinline__ float bflo(unsigned w) { return __uint_as_float(w << 16); }
__device__ __forceinline__ float bfhi(unsigned w) { return __uint_as_float(w & 0xffff0000u); }
#define XB_TMO      128
#define XB_XCNT(j)  (256  + 64 * (j))
#define XB_XSUB(j)  (1280 + 64 * (j))
#define XB_XGEN(j)  (2304 + 64 * (j))
#define XB_TOP      3328
#define XB_TOPGEN   3392
#define XCD_BAR_WORDS 3456
#define XB_SPIN_CAP (1u << 18)

__device__ __forceinline__ unsigned xb_ld(unsigned* p)              { return __hip_atomic_load(p, __ATOMIC_RELAXED, __HIP_MEMORY_SCOPE_AGENT); }
__device__ __forceinline__ unsigned xb_add(unsigned* p, unsigned v) { return __hip_atomic_fetch_add(p, v, __ATOMIC_RELAXED, __HIP_MEMORY_SCOPE_AGENT); }
__device__ __forceinline__ unsigned xb_xcc_id() { return (unsigned)__builtin_amdgcn_s_getreg((3 << 11) | 20) & 0xFu; }
#define XB_SPIN(cond, bar) do { unsigned _sp = 0; while (cond) { __builtin_amdgcn_s_sleep(1); \
    if ((++_sp & 255u) == 0u) { if (xb_ld(&(bar)[XB_TMO])) break; if (_sp > XB_SPIN_CAP) { atomicAdd(&(bar)[XB_TMO], 1u); break; } } } } while (0)

struct XcdBarrier {
    unsigned* bar; unsigned x;
    volatile LAS unsigned* st;
};

__device__ __forceinline__ XcdBarrier xcd_barrier_post(unsigned* bar, volatile LAS unsigned* st) {
    XcdBarrier b; b.bar = bar; b.x = xb_xcc_id(); b.st = st;
    if (threadIdx.x == 0) (void)xb_add(&bar[XB_XCNT(b.x)], 1u);
    return b;
}
__device__ __forceinline__ void xcd_barrier_complete(unsigned* bar, unsigned x, unsigned& nloc, unsigned& nx) {
    const unsigned G = gridDim.x * gridDim.y * gridDim.z;
    unsigned sum, cnt, mine, sp = 0u;
    for (;;) {
        sum = 0u; cnt = 0u; mine = 0u;
        unsigned cv[16];
#pragma unroll
        for (unsigned j = 0; j < 16; ++j) cv[j] = xb_ld(&bar[XB_XCNT(j)]);
#pragma unroll
        for (unsigned j = 0; j < 16; ++j) { const unsigned c = cv[j]; sum += c; cnt += (c > 0u) ? 1u : 0u; mine = (j == x) ? c : mine; }
        if (sum == G) break;
        __builtin_amdgcn_s_sleep(1);
        if ((++sp & 255u) == 0u) { if (xb_ld(&bar[XB_TMO])) break; if (sp > XB_SPIN_CAP) { atomicAdd(&bar[XB_TMO], 1u); break; } }
    }
    nloc = mine > 0u ? mine : 1u; nx = cnt > 0u ? cnt : 1u;
}

__device__ __forceinline__ void xcd_barrier(const XcdBarrier& b) {
    asm volatile("s_waitcnt vmcnt(0)" ::: "memory");
    __syncthreads();
    if (threadIdx.x == 0) {
        unsigned* bar = b.bar;
        __builtin_amdgcn_s_waitcnt(0);
        unsigned nloc = b.st[0], nx = b.st[1];
        if (nloc == 0u) { xcd_barrier_complete(bar, b.x, nloc, nx); b.st[0] = nloc; b.st[1] = nx; }
        const unsigned old = xb_add(&bar[XB_XSUB(b.x)], 1u);
        const unsigned gen = old / nloc;
        if (old + 1u == (gen + 1u) * nloc) {
            __builtin_amdgcn_fence(__ATOMIC_RELEASE, "agent");
            asm volatile("s_waitcnt vmcnt(0)" ::: "memory");
            const unsigned og = xb_add(&bar[XB_TOP], 1u);
            const unsigned tg = og / nx;
            if (og + 1u == (tg + 1u) * nx) xb_add(&bar[XB_TOPGEN], 1u);
            else XB_SPIN(xb_ld(&bar[XB_TOPGEN]) == tg, bar);
            __builtin_amdgcn_fence(__ATOMIC_ACQUIRE, "agent");
            xb_add(&bar[XB_XGEN(b.x)], 1u);
            asm volatile("s_waitcnt vmcnt(0)" ::: "memory");
        } else {
            XB_SPIN(xb_ld(&bar[XB_XGEN(b.x)]) == gen, bar);
            __builtin_amdgcn_fence(__ATOMIC_ACQUIRE, "agent");
            asm volatile("s_waitcnt vmcnt(0)" ::: "memory");
        }
    }
    __syncthreads();
}
struct Args { const float* in[N_IN]; float* out; unsigned char* ws; int ph_lo, ph_hi; };
static_assert(sizeof(Args) == 256, "Args has no padding bytes");
typedef const __attribute__((address_space(4))) Args* KA;
__device__ __forceinline__ KA kargs() { KA p = (KA)__builtin_amdgcn_kernarg_segment_ptr(); asm volatile("" : "+s"(p)); return p; }
struct Frame {
    LAS unsigned char* lds;
    volatile LAS unsigned* MISC;
    gu32* ctl;
    int tid, lane, wave, vcu, G;
};
__device__ __forceinline__ void relane(Frame& F) { int t = threadIdx.x; asm volatile("" : "+v"(t)); F.tid = t; F.lane = t & 63; F.wave = __builtin_amdgcn_readfirstlane(t >> 6); }
#define WDPP(x, ctrl, rmask) __builtin_bit_cast(float, __builtin_amdgcn_update_dpp(0, __builtin_bit_cast(int, (x)), (ctrl), (rmask), 0xF, false))
__device__ __forceinline__ float wave_sum(float v) {
    v += WDPP(v, 0xB1, 0xF); v += WDPP(v, 0x4E, 0xF); v += WDPP(v, 0x141, 0xF); v += WDPP(v, 0x140, 0xF);
    v += WDPP(v, 0x142, 0xA); v += WDPP(v, 0x143, 0xC);
    return __builtin_bit_cast(float, __builtin_amdgcn_readlane(__builtin_bit_cast(int, v), 63));
}
__device__ __forceinline__ float wave_max0(float v) {
    v = fmaxf(v, WDPP(v, 0xB1, 0xF)); v = fmaxf(v, WDPP(v, 0x4E, 0xF)); v = fmaxf(v, WDPP(v, 0x141, 0xF)); v = fmaxf(v, WDPP(v, 0x140, 0xF));
    v = fmaxf(v, WDPP(v, 0x142, 0xA)); v = fmaxf(v, WDPP(v, 0x143, 0xC));
    return __builtin_bit_cast(float, __builtin_amdgcn_readlane(__builtin_bit_cast(int, v), 63));
}
__device__ __forceinline__ float silu_f(float x) { return x / (1.0f + __expf(-x)); }

__device__ __forceinline__ void transpose_item(const float* __restrict__ W, int N, bf16* __restrict__ WT, int ldt, int k0, int n0, int rowbase, LAS float* scr, int lane) {
    float tv[32];
    { const float* wp = W + (size_t)(k0 + (lane >> 5)) * N + n0 + (lane & 31);
#pragma unroll
      for (int i = 0; i < 32; ++i) tv[i] = __builtin_nontemporal_load(wp + (size_t)(2 * i) * N); }
#pragma unroll
    for (int i = 0; i < 32; ++i) scr[(2 * i + (lane >> 5)) * 33 + (lane & 31)] = tv[i];
    LDS_WAIT(); asm volatile("" ::: "memory");
    const int c = lane & 7;
#pragma unroll
    for (int j = 0; j < 4; ++j) { const int n = (lane >> 3) + 8 * j; const LAS float* s = scr + (8 * c) * 33 + n;
        v4u o; o.x = pk2(s[0 * 33], s[1 * 33]); o.y = pk2(s[2 * 33], s[3 * 33]); o.z = pk2(s[4 * 33], s[5 * 33]); o.w = pk2(s[6 * 33], s[7 * 33]);
        *(v4u*)(WT + (size_t)(rowbase + n) * ldt + k0 + 8 * c) = o; }
    LDS_WAIT(); asm volatile("" ::: "memory");
}

__device__ __forceinline__ void transpose_item_i8(const float* __restrict__ W, int N, signed char* __restrict__ WT, int ldt, int k0, int n0, int rowbase, float qs, LAS float* scr, int lane) {
    float tv[32];
    { const float* wp = W + (size_t)(k0 + (lane >> 5)) * N + n0 + (lane & 31);
#pragma unroll
      for (int i = 0; i < 32; ++i) tv[i] = __builtin_nontemporal_load(wp + (size_t)(2 * i) * N); }
#pragma unroll
    for (int i = 0; i < 32; ++i) scr[(2 * i + (lane >> 5)) * 33 + (lane & 31)] = tv[i];
    LDS_WAIT(); asm volatile("" ::: "memory");
    const int c = lane & 3;
#pragma unroll
    for (int j = 0; j < 2; ++j) { const int n = (lane >> 2) + 16 * j; const LAS float* s = scr + (16 * c) * 33 + n; v4u o;
#pragma unroll
        for (int d = 0; d < 4; ++d) { unsigned w = 0u;
#pragma unroll
            for (int i = 0; i < 4; ++i) { const float f = fminf(fmaxf(s[(4 * d + i) * 33] * qs, -127.0f), 127.0f); w |= ((unsigned)((int)__builtin_rintf(f)) & 255u) << (8 * i); }
            o[d] = w; }
        *(v4u*)(WT + (size_t)(rowbase + n) * ldt + k0 + 16 * c) = o; }
    LDS_WAIT(); asm volatile("" ::: "memory");
}

__device__ __forceinline__ void transpose_item_f8(const float* __restrict__ W, int N, unsigned char* __restrict__ WT, int ldt, int k0, int n0, int rowbase, float qs, LAS float* scr, int lane) {
    float tv[32];
    { const float* wp = W + (size_t)(k0 + (lane >> 5)) * N + n0 + (lane & 31);
#pragma unroll
      for (int i = 0; i < 32; ++i) tv[i] = __builtin_nontemporal_load(wp + (size_t)(2 * i) * N); }
#pragma unroll
    for (int i = 0; i < 32; ++i) scr[(2 * i + (lane >> 5)) * 33 + (lane & 31)] = tv[i];
    LDS_WAIT(); asm volatile("" ::: "memory");
    const int c = lane & 3;
#pragma unroll
    for (int j = 0; j < 2; ++j) { const int n = (lane >> 2) + 16 * j; const LAS float* s = scr + (16 * c) * 33 + n; v4u o;
#pragma unroll
        for (int d = 0; d < 4; ++d) { float f[4];
#pragma unroll
            for (int i = 0; i < 4; ++i) f[i] = fminf(fmaxf(s[(4 * d + i) * 33] * qs, -448.0f), 448.0f);
            int w = __builtin_amdgcn_cvt_pk_fp8_f32(f[0], f[1], 0, false); w = __builtin_amdgcn_cvt_pk_fp8_f32(f[2], f[3], w, true); o[d] = (unsigned)w; }
        *(v4u*)(WT + (size_t)(rowbase + n) * ldt + k0 + 16 * c) = o; }
    LDS_WAIT(); asm volatile("" ::: "memory");
}

__device__ __forceinline__ void sincos_d(float af, float& c, float& s) {
    const double a = (double)af;
    const double q = __builtin_rint(a * 0.63661977236758134308);
    double r = __builtin_fma(-q, 1.57079632679489655800e+00, a); r = __builtin_fma(-q, 6.12323399573676603587e-17, r);
    const double r2 = r * r;
    double sp = -7.6471637318198164759e-13; sp = sp * r2 + 1.6059043836821614599e-10; sp = sp * r2 - 2.5052108385441718775e-08; sp = sp * r2 + 2.7557319223985890653e-06;
    sp = sp * r2 - 1.9841269841269841270e-04; sp = sp * r2 + 8.3333333333333333333e-03; sp = sp * r2 - 1.6666666666666666667e-01; const double sn = r + r * r2 * sp;
    double cp = 4.7794773323873852974e-14; cp = cp * r2 - 1.1470745597729724714e-11; cp = cp * r2 + 2.0876756987868098979e-09; cp = cp * r2 - 2.7557319223985890653e-07;
    cp = cp * r2 + 2.4801587301587301587e-05; cp = cp * r2 - 1.3888888888888888889e-03; cp = cp * r2 + 4.1666666666666666667e-02; cp = cp * r2 - 0.5; const double cs = 1.0 + r2 * cp;
    const int qi = (int)q & 3;
    const double cc = (qi == 0) ? cs : (qi == 1) ? -sn : (qi == 2) ? -cs : sn;
    const double ss = (qi == 0) ? sn : (qi == 1) ? cs : (qi == 2) ? -sn : -cs;
    c = (float)cc; s = (float)ss;
}

#define MEMFENCE() asm volatile("" ::: "memory")
__device__ __forceinline__ void p0_prologue(KA a, Frame& F) {
    relane(F);
    unsigned char* ws = a->ws;
    float* MOD = (float*)(ws + WS_MOD);
    if ((int)blockIdx.x < 192) {
        LAS float* sl = (LAS float*)F.lds + 4096;
        { float cvv[10];
#pragma unroll
          for (int j = 0; j < 10; ++j) { const int i = F.tid + j * (NWAVES * 64); const int v = i >> 10, k = i & 1023; cvv[j] = (v < 4) ? a->in[I_C][v * 1024 + k] : a->in[I_CCTX][k]; }
#pragma unroll
          for (int j = 0; j < 10; ++j) sl[F.tid + j * (NWAVES * 64)] = silu_f(cvv[j]); }
        __syncthreads();
        for (int it = blockIdx.x; it < 192; it += F.G) {
            const int l = it / 96, col = (it % 96) * 64 + F.lane;
            const float* W = a->in[I_WADA] + (size_t)l * 1024 * 6144;
            float acc[5] = {0.f, 0.f, 0.f, 0.f, 0.f};
#pragma unroll 1
            for (int kb = 0; kb < 128; kb += 64) {
                float wv[64];
#pragma unroll
                for (int i = 0; i < 64; ++i) wv[i] = W[(size_t)(F.wave * 128 + kb + i) * 6144 + col];
                MEMFENCE();
#pragma unroll
                for (int i = 0; i < 64; ++i) { const int k = F.wave * 128 + kb + i;
#pragma unroll
                    for (int v = 0; v < 5; ++v) acc[v] += sl[v * 1024 + k] * wv[i]; } }
            LAS float* red = (LAS float*)F.lds;
#pragma unroll
            for (int v = 0; v < 5; ++v) red[(F.wave * 5 + v) * 64 + F.lane] = acc[v];
            __syncthreads();
            if (F.wave < 5) { float s2 = a->in[I_BADA][l * 6144 + col];
#pragma unroll
                for (int w = 0; w < 8; ++w) s2 += red[(w * 5 + F.wave) * 64 + F.lane];
                MOD[(l * 5 + F.wave) * 6144 + col] = s2; }
            __syncthreads();
        }
    }
    for (int it = blockIdx.x; it < 96; it += F.G) {
        const int l = it / 48, e = (it % 48) / 3, which = it % 3;
        float ss = 0.f;
        if (which < 2) { const float* W = (which ? a->in[I_WU] : a->in[I_WG]) + ((size_t)l * NE + e) * 1024 * 2048; f32x4 v[32];
#pragma unroll
            for (int i = 0; i < 32; ++i) v[i] = *(const f32x4*)(W + (size_t)(32 * i) * 2048 + 4 * F.tid);
            MEMFENCE();
#pragma unroll
            for (int i = 0; i < 32; ++i) ss += (v[i].x * v[i].x + v[i].y * v[i].y) + (v[i].z * v[i].z + v[i].w * v[i].w); }
        else { const float* W = a->in[I_WD] + ((size_t)l * NE + e) * 2048 * 1024; f32x2 v[64];
#pragma unroll
            for (int i = 0; i < 64; ++i) v[i] = *(const f32x2*)(W + (size_t)(32 * i) * 1024 + 2 * F.tid);
            MEMFENCE();
#pragma unroll
            for (int i = 0; i < 64; ++i) ss += v[i].x * v[i].x + v[i].y * v[i].y; }
        ss = wave_sum(ss);
        LAS float* red = (LAS float*)F.lds;
        if (F.lane == 0) red[F.wave] = ss;
        __syncthreads();
        if (F.tid == 0) { float t = 0.f; for (int w = 0; w < NWAVES; ++w) t += red[w]; const float rms = fmaxf(sqrtf(t * (1.0f / 65536.0f)), 1e-20f);
            ((float*)(ws + WS_SW))[l * 48 + 3 * e + which] = (which < 2) ? 5.0f * rms * (1.0f / 127.0f) : rms * (1.0f / 16.0f); }
        __syncthreads();
    }
    if ((int)blockIdx.x == 192 % F.G && F.wave == 0) {
        float* LAM = (float*)(ws + WS_LAM);
        for (int l = 0; l < NLAYER; ++l) {
            const float p1 = F.lane < 32 ? a->in[I_LQ1][l * 32 + F.lane] * a->in[I_LK1][l * 32 + F.lane] : 0.f;
            const float p2 = F.lane < 32 ? a->in[I_LQ2][l * 32 + F.lane] * a->in[I_LK2][l * 32 + F.lane] : 0.f;
            const float s1 = wave_sum(p1), s2 = wave_sum(p2);
            const float li = 0.8f - 0.6f * expf(-0.3f * (float)l);
            if (F.lane == 0) { LAM[2 * l] = expf(s1) - expf(s2) + li; LAM[2 * l + 1] = li; }
        }
    }
    if ((int)blockIdx.x == 193 % F.G) {
        f32x2* TA_R = (f32x2*)(ws + WS_TAB + TAB_AROW); f32x2* TA_C = (f32x2*)(ws + WS_TAB + TAB_ACOL); f32x2* TG_R = (f32x2*)(ws + WS_TAB + TAB_GROW); f32x2* TG_C = (f32x2*)(ws + WS_TAB + TAB_GCOL);
        const double b8 = 1.0 / __builtin_sqrt(__builtin_sqrt(__builtin_sqrt(10000.0))), b16 = 1.0 / __builtin_sqrt(__builtin_sqrt(__builtin_sqrt(__builtin_sqrt(10000.0))));
        for (int e = F.tid; e < 4608; e += NWAVES * 64) {
            int pos, i, nf; f32x2* dst;
            if (e < 1024) { pos = e >> 3; i = e & 7; nf = 8; dst = TA_R + e; }
            else if (e < 1536) { const int r = e - 1024; pos = r >> 3; i = r & 7; nf = 8; dst = TA_C + r; }
            else if (e < 3584) { const int r = e - 1536; pos = r >> 4; i = r & 15; nf = 16; dst = TG_R + r; }
            else { const int r = e - 3584; pos = r >> 4; i = r & 15; nf = 16; dst = TG_C + r; }
            double inv = 1.0; const double bb = (nf == 8) ? b8 : b16;
            for (int j = 0; j < i; ++j) inv *= bb;
            const float ang = (float)pos * (float)inv;
            float c, s; sincos_d(ang, c, s);
            *dst = (f32x2){c, s};
        }
    }
    for (int it = F.G - 1 - (int)blockIdx.x; it < 896; it += F.G) {
        const int l = it / 448; int r = it % 448;
        int kb, nb, R, roff, ncols, orow0; const float *Wu, *gg;
        if (r < 192) { kb = r / 6; nb = r % 6; R = 256; roff = 0; ncols = 384; orow0 = ZQ + nb * 64; Wu = a->in[I_WUQ] + (size_t)l * 256 * 384; gg = a->in[I_GCQ] + l * 256; }
        else { r -= 192; kb = r / 8; nb = r % 8; R = 128; roff = 256; ncols = 512; orow0 = ZKV + nb * 64; Wu = a->in[I_WUKV] + (size_t)l * 128 * 512; gg = a->in[I_GCKV] + l * 128; }
        const float* Win = a->in[I_WIN] + (size_t)l * 1024 * INC;
        LAS float* As = (LAS float*)F.lds; LAS float* Bs = As + 32 * 257; LAS float* red = Bs + 256 * 64;
        const int Rs = (R == 256) ? 8 : 7;
        { float ta[16], tb[32], tg[32];
#pragma unroll
          for (int i = 0; i < 16; ++i) { const int idx = F.tid + i * (NWAVES * 64); const int idc = idx < 32 * R ? idx : 0; ta[i] = Win[(size_t)(kb * 32 + (idc >> Rs)) * INC + roff + (idc & (R - 1))]; }
#pragma unroll
          for (int i = 0; i < 32; ++i) { const int idx = F.tid + i * (NWAVES * 64); const int idc = idx < R * 64 ? idx : 0; tb[i] = Wu[(size_t)(idc >> 6) * ncols + nb * 64 + (idc & 63)]; tg[i] = gg[idc >> 6]; }
#pragma unroll
          for (int i = 0; i < 16; ++i) { const int idx = F.tid + i * (NWAVES * 64); if (idx < 32 * R) As[(idx >> Rs) * 257 + (idx & (R - 1))] = ta[i]; }
#pragma unroll
          for (int i = 0; i < 32; ++i) { const int idx = F.tid + i * (NWAVES * 64); if (idx < R * 64) Bs[idx] = tg[i] * tb[i]; } }
        __syncthreads();
        { const int nblk = F.wave & 1, rq = F.wave >> 1, R4 = R >> 2;
          att::f32x16 acc;
#pragma unroll
          for (int r_ = 0; r_ < 16; ++r_) acc[r_] = 0.f;
          const LAS float* ap = As + (F.lane & 31) * 257 + rq * R4 + (F.lane >> 5);
          const LAS float* bp = Bs + (rq * R4 + (F.lane >> 5)) * 64 + nblk * 32 + (F.lane & 31);
          for (int s2 = 0; s2 < R4; s2 += 2) acc = __builtin_amdgcn_mfma_f32_32x32x2f32(ap[s2], bp[s2 * 64], acc, 0, 0, 0);
#pragma unroll
          for (int r_ = 0; r_ < 16; ++r_) red[((rq * 2 + nblk) * 16 + r_) * 64 + F.lane] = acc[r_]; }
        __syncthreads();
        bf16* Wc = (bf16*)(ws + WS_WCAT) + (size_t)l * ZP * 1024;
#pragma unroll
        for (int q = 0; q < 4; ++q) { const int o = F.tid + q * (NWAVES * 64); const int n = o >> 5, kk = o & 31;
            const int r_ = ((kk >> 3) << 2) | (kk & 3), ln = ((kk >> 2) & 1) * 32 + (n & 31), nb2 = n >> 5;
            float sum = 0.f;
#pragma unroll
            for (int rq = 0; rq < 4; ++rq) sum += red[((rq * 2 + nb2) * 16 + r_) * 64 + ln];
            Wc[(size_t)(orow0 + n) * 1024 + kb * 32 + kk] = (bf16)(pk2(sum, 0.f) & 0xffffu); }
        __syncthreads();
    }
    {
        LAS float* scr = (LAS float*)(F.lds + F.wave * 16384);
        const int gw = F.vcu * NWAVES + F.wave, NGW = F.G * NWAVES;
        constexpr int I_IN = 16 * 61, I_O = 16 * 32, PER_L = I_IN + I_O;
        for (int it = gw; it < NLAYER * PER_L; it += NGW) {
            const int l = it / PER_L; int r = it % PER_L;
            if (r < I_IN) { const int kb = r / 61, nb = r % 61; transpose_item(a->in[I_WIN] + (size_t)l * 1024 * INC, INC, (bf16*)(ws + WS_WCAT) + (size_t)l * ZP * 1024, 1024, kb * 64, nb * 32, nb * 32, scr, F.lane); }
            else { r -= I_IN; const int kb = r / 32, nb = r % 32; transpose_item(a->in[I_WO] + (size_t)l * 1024 * 1024, 1024, (bf16*)(ws + WS_WO) + (size_t)l * 1024 * 1024, 1024, kb * 64, nb * 32, nb * 32, scr, F.lane); }
        }
        const int gt = F.vcu * (NWAVES * 64) + F.tid, NGT = F.G * NWAVES * 64;
        constexpr int PADV = (ZP - ZEND) * 1024 * 2 / 16;
        for (int i = gt; i < NLAYER * PADV; i += NGT) { const int l = i / PADV, j = i % PADV; ((v4u*)((bf16*)(ws + WS_WCAT) + ((size_t)l * ZP + ZEND) * 1024))[j] = (v4u){0u, 0u, 0u, 0u}; }
    }
}

__device__ __forceinline__ void phase_a(KA a, Frame& F, int l) {
    relane(F);
    unsigned char* ws = a->ws;
    const float* MOD = (const float*)(ws + WS_MOD);
    const int* INV = (const int*)(ws + WS_INV);
    const unsigned char* YE = (const unsigned char*)(ws + WS_YE);
    const bool fin = (l == NLAYER);
    LAS float* lmod = (LAS float*)F.lds;
    { float t[32];
#pragma unroll
      for (int i = 0; i < 32; ++i) { const int j = F.tid + i * (NWAVES * 64); float vv = 0.f;
          const int blk = j >> 10, k = j & 1023; const float* sp = MOD;
          if (blk == 0) sp = fin ? MOD : a->in[I_GN1] + l * 1024 + k;
          else if (blk <= 10) { const int v_ = (blk - 1) >> 1, w_ = (blk - 1) & 1; sp = MOD + ((fin ? 0 : l) * 5 + v_) * 6144 + w_ * 1024 + k; }
          else if (blk <= 15) { const int v_ = blk - 11; sp = MOD + ((l > 0 ? l - 1 : 0) * 5 + v_) * 6144 + 5 * 1024 + k; }
          vv = *sp; t[i] = vv; }
#pragma unroll
      for (int i = 0; i < 32; ++i) lmod[F.tid + i * (NWAVES * 64)] = t[i]; }
    __syncthreads();
    const int nrows = fin ? LROWS : MROWS;
    const int gw = F.vcu * NWAVES + F.wave, NGW = F.G * NWAVES;
#define PA_LOAD(r, XF, XB, IV) do { if (l == 0) { const float* src_ = ((r) >= LROWS) ? a->in[I_CTX] + (size_t)((r) - LROWS) * 1024 : a->in[I_X] + (size_t)(r) * 1024; \
            _Pragma("unroll") for (int j = 0; j < 4; ++j) XF[j] = *(const f32x4*)(src_ + 4 * F.lane + 256 * j); } \
        else { const bf16* xb_ = (const bf16*)(ws + WS_XB) + (size_t)(r) * 1024; _Pragma("unroll") for (int j = 0; j < 4; ++j) XB[j] = *(const v2u*)(xb_ + 4 * F.lane + 256 * j); \
            IV = INV[(size_t)(r) * 16 + (F.lane & 15)]; } } while (0)
    f32x4 cf[4]; v2u cb[4]; int civ = -1;
#pragma unroll
    for (int j = 0; j < 4; ++j) { cf[j] = (f32x4){0.f, 0.f, 0.f, 0.f}; cb[j] = (v2u){0u, 0u}; }
    if (gw < nrows) PA_LOAD(gw, cf, cb, civ);
    for (int row = gw; row < nrows; row += NGW) {
        const bool isc = row >= LROWS; const int v = isc ? 4 : (row >> 13);
        bf16* xb = (bf16*)(ws + WS_XB) + (size_t)row * 1024;
        const int nrow = row + NGW; f32x4 nf[4]; v2u nb[4]; int niv = -1;
#pragma unroll
        for (int j = 0; j < 4; ++j) { nf[j] = cf[j]; nb[j] = cb[j]; }
        if (nrow < nrows) PA_LOAD(nrow, nf, nb, niv);
        f32x4 xv[4];
        if (l == 0) {
#pragma unroll
            for (int j = 0; j < 4; ++j) xv[j] = cf[j]; }
        else {
#pragma unroll
            for (int j = 0; j < 4; ++j) xv[j] = (f32x4){bflo(cb[j].x), bfhi(cb[j].x), bflo(cb[j].y), bfhi(cb[j].y)}; }
        if (l > 0) {
            const LAS float* ga2 = lmod + (11 + v) * 1024;
            f32x4 acc[4];
#pragma unroll
            for (int j = 0; j < 4; ++j) acc[j] = (f32x4){0.f, 0.f, 0.f, 0.f};
            unsigned sel = (unsigned)(__ballot(civ >= 0) & 0xFFFFull);
            while (sel) {
                int sl[4]; float on[4];
#pragma unroll
                for (int k = 0; k < 4; ++k) { if (sel) { const int e = __builtin_ctz(sel); sel &= sel - 1u; sl[k] = __builtin_amdgcn_readlane(civ, e); on[k] = 1.0f; } else { sl[k] = sl[0]; on[k] = 0.0f; } }
                unsigned w[4][4];
#pragma unroll
                for (int k = 0; k < 4; ++k) { const unsigned char* yr = YE + (size_t)sl[k] * 1024 + 4 * F.lane;
#pragma unroll
                    for (int j = 0; j < 4; ++j) w[k][j] = *(const unsigned*)(yr + 256 * j); }
#pragma unroll
                for (int k = 0; k < 4; ++k)
#pragma unroll
                    for (int j = 0; j < 4; ++j) { const f32x2 lo = __builtin_amdgcn_cvt_pk_f32_fp8((int)w[k][j], false), hi = __builtin_amdgcn_cvt_pk_f32_fp8((int)w[k][j], true);
                        acc[j] += on[k] * (f32x4){lo.x, lo.y, hi.x, hi.y}; }
            }
#pragma unroll
            for (int j = 0; j < 4; ++j) { const f32x4 g = *(const LAS f32x4*)(ga2 + 4 * F.lane + 256 * j); xv[j] += g * (acc[j] * (1.0f / YE_SCALE)); }
        }
#pragma unroll
        for (int j = 0; j < 4; ++j) { cf[j] = nf[j]; cb[j] = nb[j]; }
        civ = niv;
        if (fin) {
#pragma unroll
            for (int j = 0; j < 4; ++j) *(f32x4*)(a->out + (size_t)row * 1024 + 4 * F.lane + 256 * j) = xv[j];
            continue; }
#pragma unroll
        for (int j = 0; j < 4; ++j) { v2u w; w.x = pk2(xv[j].x, xv[j].y); w.y = pk2(xv[j].z, xv[j].w); *(v2u*)(xb + 4 * F.lane + 256 * j) = w; }
        float ss = 0.f;
#pragma unroll
        for (int j = 0; j < 4; ++j) ss += (xv[j].x * xv[j].x + xv[j].y * xv[j].y) + (xv[j].z * xv[j].z + xv[j].w * xv[j].w);
        const float rstd = rsqrtf(wave_sum(ss) * (1.0f / 1024.0f) + EPSF);
        const LAS float* g1 = lmod; const LAS float* sh = lmod + (1 + 2 * v) * 1024; const LAS float* sc = sh + 1024;
        float am = 0.f;
#pragma unroll
        for (int j = 0; j < 4; ++j) { const int c0 = 4 * F.lane + 256 * j; const f32x4 g = *(const LAS f32x4*)(g1 + c0), s1 = *(const LAS f32x4*)(sc + c0), b1 = *(const LAS f32x4*)(sh + c0);
            xv[j] = xv[j] * rstd * g * (1.0f + s1) + b1;
            am = fmaxf(fmaxf(am, fmaxf(fabsf(xv[j].x), fabsf(xv[j].y))), fmaxf(fabsf(xv[j].z), fabsf(xv[j].w))); }
        am = wave_max0(am);
        const float qs = am > 0.f ? 127.0f / am : 0.f;
        signed char* h8 = (signed char*)(ws + WS_H) + (size_t)row * 1024;
#pragma unroll
        for (int j = 0; j < 4; ++j) { const int q0 = (int)__builtin_rintf(xv[j].x * qs), q1 = (int)__builtin_rintf(xv[j].y * qs), q2 = (int)__builtin_rintf(xv[j].z * qs), q3 = (int)__builtin_rintf(xv[j].w * qs);
            *(unsigned*)(h8 + 4 * F.lane + 256 * j) = (unsigned)(q0 & 255) | ((unsigned)(q1 & 255) << 8) | ((unsigned)(q2 & 255) << 16) | ((unsigned)(q3 & 255) << 24); }
        if (F.lane == 0) ((float*)(ws + WS_SA))[row] = am * (1.0f / 127.0f);
    }
#undef PA_LOAD
    if (l == 0) {
        const bf16* Wc = (const bf16*)(ws + WS_WCAT); signed char* W8 = (signed char*)(ws + WS_WCAT8); float* SWC = (float*)(ws + WS_SWC);
        for (int r = gw; r < NLAYER * ZP; r += NGW) {
            float wv[16]; float am = 0.f;
#pragma unroll
            for (int j = 0; j < 2; ++j) { const v4u w = *(const v4u*)(Wc + (size_t)r * 1024 + 8 * F.lane + 512 * j);
                wv[8 * j + 0] = bflo(w.x); wv[8 * j + 1] = bfhi(w.x); wv[8 * j + 2] = bflo(w.y); wv[8 * j + 3] = bfhi(w.y); wv[8 * j + 4] = bflo(w.z); wv[8 * j + 5] = bfhi(w.z); wv[8 * j + 6] = bflo(w.w); wv[8 * j + 7] = bfhi(w.w); }
#pragma unroll
            for (int i = 0; i < 16; ++i) am = fmaxf(am, fabsf(wv[i]));
            am = wave_max0(am);
            const float qs = am > 0.f ? 127.0f / am : 0.f;
#pragma unroll
            for (int j = 0; j < 2; ++j) { unsigned w0 = 0u, w1 = 0u;
#pragma unroll
                for (int i = 0; i < 4; ++i) { w0 |= ((unsigned)((int)__builtin_rintf(wv[8 * j + i] * qs)) & 255u) << (8 * i); w1 |= ((unsigned)((int)__builtin_rintf(wv[8 * j + 4 + i] * qs)) & 255u) << (8 * i); }
                v2u o; o.x = w0; o.y = w1; *(v2u*)(W8 + (size_t)r * 1024 + 8 * F.lane + 512 * j) = o; }
            if (F.lane == 0) SWC[r] = am * (1.0f / 127.0f);
        }
    }
}

__device__ __forceinline__ void ld8(const bf16* p, float* f) { const v4u w = *(const v4u*)p; f[0] = bflo(w.x); f[1] = bfhi(w.x); f[2] = bflo(w.y); f[3] = bfhi(w.y); f[4] = bflo(w.z); f[5] = bfhi(w.z); f[6] = bflo(w.w); f[7] = bfhi(w.w); }
__device__ __forceinline__ v4u pk8(const float* f) { v4u w; w.x = pk2(f[0], f[1]); w.y = pk2(f[2], f[3]); w.z = pk2(f[4], f[5]); w.w = pk2(f[6], f[7]); return w; }
template <int N> __device__ __forceinline__ float ssq_row(const bf16* p) { float s = 0.f;
#pragma unroll
    for (int c = 0; c < N / 8; ++c) { float f[8]; ld8(p + 8 * c, f);
#pragma unroll
        for (int i = 0; i < 8; ++i) s += f[i] * f[i];
        if ((c & 7) == 7) MEMFENCE(); }
    return s; }
template <int NP> __device__ __forceinline__ void rope_pairs(float* x, const f32x2* trow, const f32x2* tcol) {
#pragma unroll
    for (int i = 0; i < NP; ++i) { const f32x2 cs = (i < NP / 2) ? trow[i] : tcol[i - NP / 2];
        const float x0 = x[2 * i], x1 = x[2 * i + 1]; x[2 * i] = x0 * cs.x - x1 * cs.y; x[2 * i + 1] = x0 * cs.y + x1 * cs.x; }
}
__device__ __forceinline__ void store_v_tile(char* vt, int lane, const float* v  ) {
    char* p = vt + (lane >> 4) * 1024 + ((lane >> 3) & 1) * 512 + (lane & 7) * 64;
#pragma unroll
    for (int d = 0; d < 2; ++d)
#pragma unroll
        for (int c = 0; c < 4; ++c) *(v4u*)(p + d * 4096 + c * 16) = pk8(v + d * 32 + c * 8);
}
template <bool ROPE> __device__ __forceinline__ v4u proc8(v4u w, float r, const LAS float* g, const LAS f32x2* cs, int cstr, float qs) {
    float f[8] = {bflo(w.x), bfhi(w.x), bflo(w.y), bfhi(w.y), bflo(w.z), bfhi(w.z), bflo(w.w), bfhi(w.w)};
#pragma unroll
    for (int i = 0; i < 8; ++i) f[i] *= r * g[i];
    if (ROPE) {
#pragma unroll
        for (int i = 0; i < 4; ++i) { const f32x2 t = cs[i * cstr]; const float x0 = f[2 * i], x1 = f[2 * i + 1]; f[2 * i] = x0 * t.x - x1 * t.y; f[2 * i + 1] = x0 * t.y + x1 * t.x; }
    }
#pragma unroll
    for (int i = 0; i < 8; ++i) f[i] *= qs;
    return pk8(f);
}
__device__ __forceinline__ v2u pk8_f8(const float* f) { int w0 = __builtin_amdgcn_cvt_pk_fp8_f32(f[0], f[1], 0, false); w0 = __builtin_amdgcn_cvt_pk_fp8_f32(f[2], f[3], w0, true);
    int w1 = __builtin_amdgcn_cvt_pk_fp8_f32(f[4], f[5], 0, false); w1 = __builtin_amdgcn_cvt_pk_fp8_f32(f[6], f[7], w1, true); return (v2u){(unsigned)w0, (unsigned)w1}; }
template <bool ROPE> __device__ __forceinline__ v2u proc8f(v4u w, float r, const float* g, const f32x2* cs, float qs) {
    float f[8] = {bflo(w.x), bfhi(w.x), bflo(w.y), bfhi(w.y), bflo(w.z), bfhi(w.z), bflo(w.w), bfhi(w.w)};
#pragma unroll
    for (int i = 0; i < 8; ++i) f[i] *= r * g[i];
    if (ROPE) {
#pragma unroll
        for (int i = 0; i < 4; ++i) { const f32x2 t = cs[i]; const float x0 = f[2 * i], x1 = f[2 * i + 1]; f[2 * i] = x0 * t.x - x1 * t.y; f[2 * i + 1] = x0 * t.y + x1 * t.x; }
    }
#pragma unroll
    for (int i = 0; i < 8; ++i) f[i] *= qs;
    return pk8_f8(f);
}
__device__ __forceinline__ att::i32x6a fp6_group(const v4u& c0, const v4u& c1, const v4u& c2, const v4u& c3) {
    att::u32x16 w; w[0] = c0.x; w[1] = c0.y; w[2] = c0.z; w[3] = c0.w; w[4] = c1.x; w[5] = c1.y; w[6] = c1.z; w[7] = c1.w; w[8] = c2.x; w[9] = c2.y; w[10] = c2.z; w[11] = c2.w; w[12] = c3.x; w[13] = c3.y; w[14] = c3.z; w[15] = c3.w;
    return att::cvt_fp6x32(w); }
__device__ __forceinline__ void store_qgroup(unsigned char* q, const att::i32x6a& g) { *(v2u*)q = (v2u){(unsigned)g[0], (unsigned)g[1]}; *(v2u*)(q + 8) = (v2u){(unsigned)g[2], (unsigned)g[3]}; *(v2u*)(q + 16) = (v2u){(unsigned)g[4], (unsigned)g[5]}; }
__device__ __forceinline__ void store_kgroup(char* kt, int pb, int j, int lane, const att::i32x6a& g) {
    *(v4u*)(kt + j * 1024 + lane * 16) = (v4u){(unsigned)g[0], (unsigned)g[1], (unsigned)g[2], (unsigned)g[3]}; *(v2u*)(kt + pb + j * 512 + lane * 8) = (v2u){(unsigned)g[4], (unsigned)g[5]}; }
__device__ __forceinline__ v4u ldz8(const unsigned char* p) { const v2u r = *(const v2u*)p;
    const f32x2 a = __builtin_amdgcn_cvt_pk_f32_fp8((int)r.x, false), b = __builtin_amdgcn_cvt_pk_f32_fp8((int)r.x, true), c = __builtin_amdgcn_cvt_pk_f32_fp8((int)r.y, false), d = __builtin_amdgcn_cvt_pk_f32_fp8((int)r.y, true);
    v4u w; w.x = pk2(a.x, a.y); w.y = pk2(b.x, b.y); w.z = pk2(c.x, c.y); w.w = pk2(d.x, d.y); return w; }
__device__ __forceinline__ v4u decz8(v2u r) {
    const f32x2 a = __builtin_amdgcn_cvt_pk_f32_fp8((int)r.x, false), b = __builtin_amdgcn_cvt_pk_f32_fp8((int)r.x, true), c = __builtin_amdgcn_cvt_pk_f32_fp8((int)r.y, false), d = __builtin_amdgcn_cvt_pk_f32_fp8((int)r.y, true);
    v4u w; w.x = pk2(a.x, a.y); w.y = pk2(b.x, b.y); w.z = pk2(c.x, c.y); w.w = pk2(d.x, d.y); return w; }
__device__ __forceinline__ float ssq8(v4u w) { const float f[8] = {bflo(w.x), bfhi(w.x), bflo(w.y), bfhi(w.y), bflo(w.z), bfhi(w.z), bflo(w.w), bfhi(w.w)}; float s = 0.f;
#pragma unroll
    for (int i = 0; i < 8; ++i) s += f[i] * f[i];
    return s; }
__device__ __forceinline__ v4u scale8(v4u w, float r) { float f[8] = {bflo(w.x), bfhi(w.x), bflo(w.y), bfhi(w.y), bflo(w.z), bfhi(w.z), bflo(w.w), bfhi(w.w)};
#pragma unroll
    for (int i = 0; i < 8; ++i) f[i] *= r;
    return pk8(f); }
__device__ __forceinline__ void store_v_tile_pk(char* vt, int lane, const v4u* w) {
    char* p = vt + (lane >> 4) * 1024 + ((lane >> 3) & 1) * 512 + (lane & 7) * 64;
#pragma unroll
    for (int c = 0; c < 8; ++c) *(v4u*)(p + (c >> 2) * 4096 + (c & 3) * 16) = w[c];
}
constexpr int VSEG = 1024 + 64;
__device__ __forceinline__ void store_v_tile_f8(char* vt, int lane, const v4u* w, float sc, LAS unsigned char* scr) {
    const int c_ = lane & 3;
    const unsigned s1 = (c_ & 1) ? 0x03070105u : 0x06020400u, s2 = (c_ & 2) ? 0x03020706u : 0x05040100u;
    LAS unsigned char* p = scr + (2 * ((lane >> 2) & 1) + (lane >> 5)) * VSEG + c_ * 16 + 4 * ((lane >> 3) & 3);
#pragma unroll
    for (int c = 0; c < 8; ++c) { const float f[8] = {bflo(w[c].x), bfhi(w[c].x), bflo(w[c].y), bfhi(w[c].y), bflo(w[c].z), bfhi(w[c].z), bflo(w[c].w), bfhi(w[c].w)};
#pragma unroll
        for (int hlf = 0; hlf < 2; ++hlf) {
            int d = __builtin_amdgcn_cvt_pk_fp8_f32(f[4 * hlf] * sc, f[4 * hlf + 1] * sc, 0, false); d = __builtin_amdgcn_cvt_pk_fp8_f32(f[4 * hlf + 2] * sc, f[4 * hlf + 3] * sc, d, true);
            const int pp = __builtin_amdgcn_mov_dpp(d, 0xB1, 0xF, 0xF, true);
            const unsigned y = __builtin_amdgcn_perm((unsigned)pp, (unsigned)d, s1);
            const int qq = __builtin_amdgcn_mov_dpp((int)y, 0x4E, 0xF, 0xF, true);
            const unsigned z = __builtin_amdgcn_perm((unsigned)qq, y, s2);
            *(LAS unsigned*)(p + 64 * (2 * c + hlf)) = z; } }
    LDS_WAIT(); asm volatile("" ::: "memory");
#pragma unroll
    for (int i = 0; i < 4; ++i) *(v4u*)(vt + i * 1024 + lane * 16) = *(const LAS v4u*)(scr + i * VSEG + lane * 16);
    LDS_WAIT(); asm volatile("" ::: "memory");
}
__device__ __forceinline__ void phase_c(KA a, Frame& F, int l) {
    relane(F);
    unsigned char* ws = a->ws;
    const unsigned char* Z = (const unsigned char*)(ws + WS_Z); const float* SSQ = (const float*)(ws + WS_SSQ);
    unsigned char* qkv = ws + WS_QKV;
    LAS unsigned char* vscr = (LAS unsigned char*)F.lds + F.wave * (4 * VSEG);
    constexpr int LT_OFF = 8 * 4 * VSEG, TABBYTES = (int)(TAB_GCOL + 64 * 16 * 8), LG_OFF = LT_OFF + TABBYTES;
    { const v4u* src = (const v4u*)(ws + WS_TAB); LAS v4u* dst = (LAS v4u*)(F.lds + LT_OFF); v4u t[5];
#pragma unroll
      for (int i = 0; i < 5; ++i) { const int j = F.tid + i * (NWAVES * 64); t[i] = src[j < TABBYTES / 16 ? j : 0]; }
#pragma unroll
      for (int i = 0; i < 5; ++i) { const int j = F.tid + i * (NWAVES * 64); if (j < TABBYTES / 16) { const int off = j * 16;
              if (off >= (int)TAB_ACOL && off < (int)TAB_GROW) { const int rel = off - (int)TAB_ACOL, ln = rel >> 6, p0 = (rel & 63) >> 3; LAS v2u* d2 = (LAS v2u*)(F.lds + LT_OFF + TAB_ACOL);
                  d2[p0 * 64 + ln] = (v2u){t[i].x, t[i].y}; d2[(p0 + 1) * 64 + ln] = (v2u){t[i].z, t[i].w}; }
              else if (off >= (int)TAB_GCOL) { const int rel = off - (int)TAB_GCOL, ln = rel >> 7, p0 = (rel & 127) >> 3; LAS v2u* d2 = (LAS v2u*)(F.lds + LT_OFF + TAB_GCOL);
                  d2[p0 * 64 + ln] = (v2u){t[i].x, t[i].y}; d2[(p0 + 1) * 64 + ln] = (v2u){t[i].z, t[i].w}; }
              else dst[j] = t[i]; } }
      LAS float* lg = (LAS float*)(F.lds + LG_OFF); const int t_ = F.tid;
      if (t_ < 384) { const float* gp = t_ < 96 ? a->in[I_GMQ] + l * 96 + t_ : t_ < 192 ? a->in[I_GMK] + l * 96 + (t_ - 96) : t_ < 224 ? a->in[I_GDQ] + l * 32 + (t_ - 192) : t_ < 256 ? a->in[I_GDK] + l * 32 + (t_ - 224)
                                          : t_ < 320 ? a->in[I_GGQ] + l * 64 + (t_ - 256) : a->in[I_GGK] + l * 64 + (t_ - 320); lg[t_] = *gp; }
      __syncthreads(); }
    const LAS float* LG = (const LAS float*)(F.lds + LG_OFF);
    const LAS f32x2* TA_R = (const LAS f32x2*)(F.lds + LT_OFF + TAB_AROW); const LAS f32x2* TA_C = (const LAS f32x2*)(F.lds + LT_OFF + TAB_ACOL);
    const LAS f32x2* TG_R = (const LAS f32x2*)(F.lds + LT_OFF + TAB_GROW); const LAS f32x2* TG_C = (const LAS f32x2*)(F.lds + LT_OFF + TAB_GCOL);
    const int gw = F.vcu * NWAVES + F.wave, NGW = F.G * NWAVES, lane = F.lane;
    for (int id = gw; id < 528 * 32; id += NGW) {
        const int tile = id % 528, job = id / 528;
        const int b = tile / NKT, tt = tile % NKT; const bool isc = tt >= 128;
        const int zrow = isc ? LROWS + b * CL + (tt - 128) * 64 + lane : b * SEQ + tt * 64 + lane;
        const int tok = tt * 64 + lane;
        const unsigned char* zr = Z + (size_t)(zrow >> 6) * (ZP * 64) + lane * 8;
        const LAS f32x2* tar = TA_R + (isc ? 0 : tt) * 8; const LAS f32x2* tac = TA_C + lane;
        const LAS f32x2* tgr = TG_R + (isc ? 0 : tt) * 16; const LAS f32x2* tgc = TG_C + lane;
        MEMFENCE();
        if (job < 4) {
            const int h = job;
            float r1; { const f32x4 s0 = *(const f32x4*)(SSQ + (size_t)zrow * 12), s1 = *(const f32x4*)(SSQ + (size_t)zrow * 12 + 4); r1 = rsqrtf((((s0.x + s0.y) + (s0.z + s0.w)) + ((s1.x + s1.y) + (s1.z + s1.w))) * (1.0f / 256.0f) + EPSF); }
            v4u w[12]; v2u rw[12]; float ss = 0.f;
#pragma unroll
            for (int c = 0; c < 12; ++c) rw[c] = *(const v2u*)(zr + (ZQ + h * 96 + 8 * c) * 64);
            MEMFENCE();
#pragma unroll
            for (int c = 0; c < 12; ++c) { w[c] = decz8(rw[c]); ss += ssq8(w[c]); }
            MEMFENCE();
            const float r = r1 * rsqrtf(ss * r1 * r1 * (1.0f / 96.0f) + EPSF); const LAS float* g = LG;
            const float qs = att::FQ96;
            unsigned char* q = (unsigned char*)(qkv + QO_QM) + ((size_t)(b * 4 + h) * NTOKB + tok) * 72;
#pragma unroll
            for (int gq = 0; gq < 3; ++gq) { v4u o[4];
#pragma unroll
                for (int cc = 0; cc < 4; ++cc) { const int c = 4 * gq + cc;
                    if (c < 8 || isc) o[cc] = proc8<false>(w[c], r, g + 8 * c, nullptr, 1, qs);
                    else o[cc] = proc8<true>(w[c], r, g + 8 * c, (c < 10) ? tar + 4 * (c - 8) : tac + 4 * (c - 10) * 64, (c < 10) ? 1 : 64, qs); }
                store_qgroup(q + 24 * gq, fp6_group(o[0], o[1], o[2], o[3])); MEMFENCE(); }
        } else if (job < 8) {
            const int h = job - 4;
            float r1; { const f32x4 s2 = *(const f32x4*)(SSQ + (size_t)zrow * 12 + 8); r1 = rsqrtf(((s2.x + s2.y) + (s2.z + s2.w)) * (1.0f / 128.0f) + EPSF); }
            v4u w[12]; v2u rw[12], rv[8]; float ss = 0.f, s2 = 0.f;
#pragma unroll
            for (int c = 0; c < 8; ++c) rw[c] = *(const v2u*)(zr + (ZKV + h * 128 + 8 * c) * 64);
#pragma unroll
            for (int c = 0; c < 4; ++c) rw[8 + c] = *(const v2u*)(zr + (384 + 8 * c) * 64);
#pragma unroll
            for (int c = 0; c < 8; ++c) rv[c] = *(const v2u*)(zr + (ZKV + h * 128 + 64 + 8 * c) * 64);
            MEMFENCE();
#pragma unroll
            for (int c = 0; c < 8; ++c) { w[c] = decz8(rw[c]); ss += ssq8(w[c]); }
#pragma unroll
            for (int c = 0; c < 4; ++c) { w[8 + c] = decz8(rw[8 + c]); s2 += ssq8(w[8 + c]); }
            MEMFENCE();
            const float r2 = rsqrtf((ss * r1 * r1 + s2) * (1.0f / 96.0f) + EPSF); const LAS float* g = LG + 96;
            char* kt = (char*)(qkv + QO_KM) + ((size_t)(b * 4 + h) * NKT + tt) * 5120;
#pragma unroll
            for (int gq = 0; gq < 3; ++gq) { v4u o[4];
#pragma unroll
                for (int cc = 0; cc < 4; ++cc) { const int c = 4 * gq + cc;
                    if (c < 8) o[cc] = proc8<false>(w[c], r1 * r2, g + 8 * c, nullptr, 1, 1.0f);
                    else if (isc) o[cc] = proc8<false>(w[c], r2, g + 8 * c, nullptr, 1, 1.0f);
                    else o[cc] = proc8<true>(w[c], r2, g + 8 * c, (c < 10) ? tar + 4 * (c - 8) : tac + 4 * (c - 10) * 64, (c < 10) ? 1 : 64, 1.0f); }
                store_kgroup(kt, 3072, gq, lane, fp6_group(o[0], o[1], o[2], o[3])); MEMFENCE(); }
            v4u vw[8];
#pragma unroll
            for (int c = 0; c < 8; ++c) vw[c] = decz8(rv[c]);
            store_v_tile_f8((char*)(qkv + QO_VM) + ((size_t)(b * 4 + h) * NKT + tt) * 4096, lane, vw, r1, vscr);
        } else if (job < 16) {
            const bool isk = job >= 12; const int h = (job - 8) & 3;
            const unsigned char* zp = zr + ((isk ? 672 : 416) + h * 64) * 64; const LAS float* g = LG + (isk ? 224 : 192);
            const float qs = isk ? 1.0f : att::FQ32;
            v4u w[8]; v2u rw[8]; float ss[2] = {0.f, 0.f};
#pragma unroll
            for (int c = 0; c < 8; ++c) rw[c] = *(const v2u*)(zp + 512 * c);
            MEMFENCE();
#pragma unroll
            for (int c = 0; c < 8; ++c) { w[c] = decz8(rw[c]); ss[c >> 2] += ssq8(w[c]); }
            MEMFENCE();
            const float r0 = rsqrtf(ss[0] * (1.0f / 32.0f) + EPSF), r1 = rsqrtf(ss[1] * (1.0f / 32.0f) + EPSF);
            char* kt = (char*)(qkv + QO_KD) + ((size_t)(b * 4 + h) * NKT + tt) * 3072;
            unsigned char* q = (unsigned char*)(qkv + QO_QD) + ((size_t)(b * 4 + h) * NTOKB + tok) * 48;
#pragma unroll
            for (int gq = 0; gq < 2; ++gq) { v4u o[4];
#pragma unroll
                for (int cm = 0; cm < 4; ++cm) { const int c = 4 * gq + cm;
                    if (isc) o[cm] = proc8<false>(w[c], gq ? r1 : r0, g + 8 * cm, nullptr, 1, qs);
                    else o[cm] = proc8<true>(w[c], gq ? r1 : r0, g + 8 * cm, (cm < 2) ? tar + 4 * cm : tac + 4 * (cm - 2) * 64, (cm < 2) ? 1 : 64, qs); }
                const att::i32x6a gr = fp6_group(o[0], o[1], o[2], o[3]);
                if (isk) store_kgroup(kt, 2048, gq, lane, gr); else store_qgroup(q + 24 * gq, gr);
                MEMFENCE(); }
        } else if (job < 20) {
            const int h = job - 16; v4u vw[8]; v2u rv[8];
#pragma unroll
            for (int c = 0; c < 8; ++c) rv[c] = *(const v2u*)(zr + (928 + h * 64 + 8 * c) * 64);
            MEMFENCE();
#pragma unroll
            for (int c = 0; c < 8; ++c) vw[c] = decz8(rv[c]);
            store_v_tile_f8((char*)(qkv + QO_VD) + ((size_t)(b * 4 + h) * NKT + tt) * 4096, lane, vw, 1.0f, vscr);
        } else if (job < 30) {
            const bool isk = job >= 28; const int h = isk ? job - 28 : job - 20;
            const unsigned char* zp = zr + ((isk ? 1696 : 1184) + h * 64) * 64; const LAS float* g = LG + (isk ? 320 : 256);
            const float qs = isk ? 1.0f : att::FQ64;
            v4u w[8]; v2u rw[8]; float ss = 0.f;
#pragma unroll
            for (int c = 0; c < 8; ++c) rw[c] = *(const v2u*)(zp + 512 * c);
            MEMFENCE();
#pragma unroll
            for (int c = 0; c < 8; ++c) { w[c] = decz8(rw[c]); ss += ssq8(w[c]); }
            MEMFENCE();
            const float r = rsqrtf(ss * (1.0f / 64.0f) + EPSF);
            char* kt = (char*)(qkv + QO_KG) + ((size_t)(b * 2 + h) * NKT + tt) * 3072;
            unsigned char* q = (unsigned char*)(qkv + QO_QG) + ((size_t)(b * 8 + h) * NTOKB + tok) * 48;
#pragma unroll
            for (int gq = 0; gq < 2; ++gq) { v4u o[4];
#pragma unroll
                for (int cc = 0; cc < 4; ++cc) { const int c = 4 * gq + cc;
                    if (isc) o[cc] = proc8<false>(w[c], r, g + 8 * c, nullptr, 1, qs);
                    else o[cc] = proc8<true>(w[c], r, g + 8 * c, (c < 4) ? tgr + 4 * c : tgc + 4 * (c - 4) * 64, (c < 4) ? 1 : 64, qs); }
                const att::i32x6a gr = fp6_group(o[0], o[1], o[2], o[3]);
                if (isk) store_kgroup(kt, 2048, gq, lane, gr); else store_qgroup(q + 24 * gq, gr);
                MEMFENCE(); }
        } else {
            const int h = job - 30; v4u vw[8]; v2u rv[8];
#pragma unroll
            for (int c = 0; c < 8; ++c) rv[c] = *(const v2u*)(zr + (1824 + h * 64 + 8 * c) * 64);
            MEMFENCE();
#pragma unroll
            for (int c = 0; c < 8; ++c) vw[c] = decz8(rv[c]);
            store_v_tile_f8((char*)(qkv + QO_VG) + ((size_t)(b * 2 + h) * NKT + tt) * 4096, lane, vw, 1.0f, vscr);
        }
        MEMFENCE();
    }
}

#define ATT_UNIT(KD, NM) att::attn_unit_f8<KD, NM, ABL>
#define ATT_DIFF att::attn_unit_f8<32, 2, ABL>
template <int ABL>
__device__ __forceinline__ void phase_d(KA a, Frame& F, int l, bool last) {
    relane(F);
    unsigned char* ws = a->ws; unsigned char* qkv = ws + WS_QKV;
    bf16* ATT = (bf16*)(ws + (ABL ? WS_Z : WS_ATT));
    const float* LAM = (const float*)(ws + WS_LAM);
    const float lam = LAM[2 * l], oml = 1.0f - LAM[2 * l + 1];
    const float* gdo = a->in[I_GDO] + l * 64;
    ALDS char* lds = (ALDS char*)F.lds;
    const int nctx = last ? 0 : 64;
    for (int id = F.vcu; id < 512 + nctx; id += F.G) {
        int b, h, q0, t0, t1; size_t orow;
        if (id < 512) { const int x = (id & 255) >> 5; b = x >> 1; h = 2 * (x & 1) + (id >> 8); q0 = (id & 31) * 256; t0 = 0; t1 = NKT; orow = (size_t)b * SEQ + q0; }
        else { const int c = id - 512; b = c >> 4; h = c & 15; if (h >= 4) continue; q0 = SEQ; t0 = 128; t1 = NKT; orow = (size_t)LROWS + b * CL; }
        ATT_UNIT(96, 1)((const unsigned char*)(qkv + QO_QM) + ((size_t)(b * 4 + h) * NTOKB + q0) * 72, (const char*)(qkv + QO_KM) + (size_t)(b * 4 + h) * NKT * 5120,
                        (const char*)(qkv + QO_VM) + (size_t)(b * 4 + h) * NKT * 4096, t0, t1, ATT + orow * 1024 + h * 64, lds, 0.f, gdo, 0.f);
    }
    for (int id = 512 + F.vcu; id < 1024 + nctx; id += F.G) {
        int b, h, q0, t0, t1; size_t orow;
        if (id < 1024) { const int x = (id & 255) >> 5; b = x >> 1; h = 2 * (x & 1) + ((id >> 8) - 2); q0 = (id & 31) * 256; t0 = 0; t1 = NKT; orow = (size_t)b * SEQ + q0; }
        else { const int c = id - 1024; b = c >> 4; h = (c & 15) - 4; if (h < 0 || h >= 4) continue; q0 = SEQ; t0 = 128; t1 = NKT; orow = (size_t)LROWS + b * CL; }
        ATT_DIFF((const unsigned char*)(qkv + QO_QD) + ((size_t)(b * 4 + h) * NTOKB + q0) * 48, (const char*)(qkv + QO_KD) + (size_t)(b * 4 + h) * NKT * 3072,
                        (const char*)(qkv + QO_VD) + (size_t)(b * 4 + h) * NKT * 4096, t0, t1, ATT + orow * 1024 + 256 + h * 64, lds, lam, gdo, oml);
    }
    for (int id = 1024 + F.vcu; id < 2048 + nctx; id += F.G) {
        int b, h, q0, t0, t1; size_t orow;
        if (id < 2048) { const int x = (id & 255) >> 5; b = x >> 1; h = 4 * (x & 1) + ((id >> 8) - 4); q0 = (id & 31) * 256; t0 = 0; t1 = NKT; orow = (size_t)b * SEQ + q0; }
        else { const int c = id - 2048; b = c >> 4; h = (c & 15) - 8; if (h < 0) continue; q0 = SEQ; t0 = 128; t1 = NKT; orow = (size_t)LROWS + b * CL; }
        const int g = h >> 2;
        ATT_UNIT(64, 1)((const unsigned char*)(qkv + QO_QG) + ((size_t)(b * 8 + h) * NTOKB + q0) * 48, (const char*)(qkv + QO_KG) + (size_t)(b * 2 + g) * NKT * 3072,
                        (const char*)(qkv + QO_VG) + (size_t)(b * 2 + g) * NKT * 4096, t0, t1, ATT + orow * 1024 + 512 + h * 64, lds, 0.f, gdo, 0.f);
    }
}

template <int RB>
__device__ __forceinline__ void pf_rows(KA a, Frame& F, int l, int rbeg, int nrows, LAS float* wrT) {
    unsigned char* ws = a->ws;
    const float* MOD = (const float*)(ws + WS_MOD);
    float* AFF = (float*)(ws + WS_AFF); float* AFFC = (float*)(ws + WS_AFFC); int* INV = (int*)(ws + WS_INV);
    const int gw = F.vcu * NWAVES + F.wave, NGW = F.G * NWAVES;
#define PF_LOAD(r, XW, DW) do { const bf16* xb_ = (const bf16*)(ws + WS_XB) + (size_t)(r) * 1024; const bf16* dl_ = (const bf16*)(ws + WS_DELTA) + (size_t)(r) * 1024; \
        _Pragma("unroll") for (int j = 0; j < 4; ++j) { XW[j] = *(const v2u*)(xb_ + 4 * F.lane + 256 * j); DW[j] = *(const v2u*)(dl_ + 4 * F.lane + 256 * j); } } while (0)
    v2u cxw[RB][4], cdw[RB][4];
#pragma unroll
    for (int u = 0; u < RB; ++u)
#pragma unroll
        for (int j = 0; j < 4; ++j) { cxw[u][j] = (v2u){0u, 0u}; cdw[u][j] = (v2u){0u, 0u}; }
    if (rbeg + gw * RB < nrows) {
#pragma unroll
        for (int u = 0; u < RB; ++u) PF_LOAD(rbeg + gw * RB + u, cxw[u], cdw[u]); }
    for (int grp = gw; rbeg + grp * RB < nrows; grp += NGW) {
        const int row0 = rbeg + grp * RB; const bool isc = row0 >= LROWS; const int v = isc ? 4 : (row0 >> 13);
        f32x4 hv[RB][4]; float ss[RB];
#pragma unroll
        for (int u = 0; u < RB; ++u) { bf16* xb = (bf16*)(ws + WS_XB) + (size_t)(row0 + u) * 1024; ss[u] = 0.f;
#pragma unroll
            for (int j = 0; j < 4; ++j) { const int c0 = 4 * F.lane + 256 * j; const v2u w = cdw[u][j], xw = cxw[u][j];
                hv[u][j] = (f32x4){bflo(xw.x), bfhi(xw.x), bflo(xw.y), bfhi(xw.y)} + (f32x4){bflo(w.x), bfhi(w.x), bflo(w.y), bfhi(w.y)};
                v2u o; o.x = pk2(hv[u][j].x, hv[u][j].y); o.y = pk2(hv[u][j].z, hv[u][j].w); *(v2u*)(xb + c0) = o;
                ss[u] += (hv[u][j].x * hv[u][j].x + hv[u][j].y * hv[u][j].y) + (hv[u][j].z * hv[u][j].z + hv[u][j].w * hv[u][j].w); } }
        { const int ngrp = grp + NGW;
          if (rbeg + ngrp * RB < nrows) {
#pragma unroll
              for (int u = 0; u < RB; ++u) PF_LOAD(rbeg + ngrp * RB + u, cxw[u], cdw[u]); } }
        float rstd[RB];
#pragma unroll
        for (int u = 0; u < RB; ++u) rstd[u] = rsqrtf(wave_sum(ss[u]) * (1.0f / 1024.0f) + EPSF);
        const LAS float* g2 = wrT + 16384; const LAS float* sh = g2 + (1 + 2 * v) * 1024; const LAS float* sc = sh + 1024;
        float am[RB];
#pragma unroll
        for (int u = 0; u < RB; ++u) am[u] = 0.f;
#pragma unroll
        for (int j = 0; j < 4; ++j) { const int c0 = 4 * F.lane + 256 * j; const f32x4 g = *(const LAS f32x4*)(g2 + c0), s1 = *(const LAS f32x4*)(sc + c0), b1 = *(const LAS f32x4*)(sh + c0);
#pragma unroll
            for (int u = 0; u < RB; ++u) { hv[u][j] = hv[u][j] * rstd[u] * g * (1.0f + s1) + b1;
                am[u] = fmaxf(fmaxf(am[u], fmaxf(fabsf(hv[u][j].x), fabsf(hv[u][j].y))), fmaxf(fabsf(hv[u][j].z), fabsf(hv[u][j].w))); } }
#pragma unroll
        for (int u = 0; u < RB; ++u) am[u] = wave_max0(am[u]);
#pragma unroll
        for (int u = 0; u < RB; ++u) { const float qs = am[u] > 0.f ? 127.0f / am[u] : 0.f;
            signed char* h8 = (signed char*)(ws + WS_H) + (size_t)(row0 + u) * 1024;
#pragma unroll
            for (int j = 0; j < 4; ++j) { const int q0 = (int)__builtin_rintf(hv[u][j].x * qs), q1 = (int)__builtin_rintf(hv[u][j].y * qs), q2 = (int)__builtin_rintf(hv[u][j].z * qs), q3 = (int)__builtin_rintf(hv[u][j].w * qs);
                *(unsigned*)(h8 + 4 * F.lane + 256 * j) = (unsigned)(q0 & 255) | ((unsigned)(q1 & 255) << 8) | ((unsigned)(q2 & 255) << 16) | ((unsigned)(q3 & 255) << 24); }
            if (F.lane == 0) ((float*)(ws + WS_SA))[row0 + u] = am[u] * (1.0f / 127.0f); }
        float p[RB][16];
#pragma unroll
        for (int e = 0; e < 16; ++e) { float sacc[RB];
#pragma unroll
            for (int u = 0; u < RB; ++u) sacc[u] = 0.f;
#pragma unroll
            for (int j = 0; j < 4; ++j) { const f32x4 w = *(const LAS f32x4*)(wrT + e * 1024 + 4 * F.lane + 256 * j);
#pragma unroll
                for (int u = 0; u < RB; ++u) sacc[u] += (hv[u][j].x * w.x + hv[u][j].y * w.y) + (hv[u][j].z * w.z + hv[u][j].w * w.w); }
#pragma unroll
            for (int u = 0; u < RB; ++u) p[u][e] = sacc[u];
            if ((e & 3) == 3) MEMFENCE(); }
        float lgt[RB];
#pragma unroll
        for (int u = 0; u < RB; ++u) { float r8[8], r4[4], r2[2];
          { const bool hb = (F.lane & 32) != 0;
#pragma unroll
            for (int j = 0; j < 8; ++j) { const float keep = hb ? p[u][8 + j] : p[u][j], send = hb ? p[u][j] : p[u][8 + j]; r8[j] = keep + __shfl_xor(send, 32); } }
          { const bool hb = (F.lane & 16) != 0;
#pragma unroll
            for (int j = 0; j < 4; ++j) { const float keep = hb ? r8[4 + j] : r8[j], send = hb ? r8[j] : r8[4 + j]; r4[j] = keep + __shfl_xor(send, 16); } }
          { const bool hb = (F.lane & 8) != 0;
#pragma unroll
            for (int j = 0; j < 2; ++j) { const float keep = hb ? r4[2 + j] : r4[j], send = hb ? r4[j] : r4[2 + j]; r2[j] = keep + __shfl_xor(send, 8); } }
          { const bool hb = (F.lane & 4) != 0; const float keep = hb ? r2[1] : r2[0], send = hb ? r2[0] : r2[1]; lgt[u] = keep + __shfl_xor(send, 4); }
          lgt[u] += __shfl_xor(lgt[u], 1); lgt[u] += __shfl_xor(lgt[u], 2); }
        float mx[RB], ex[RB], sum[RB];
#pragma unroll
        for (int u = 0; u < RB; ++u) mx[u] = lgt[u];
#pragma unroll
        for (int o = 4; o < 64; o <<= 1) {
#pragma unroll
            for (int u = 0; u < RB; ++u) mx[u] = fmaxf(mx[u], __shfl_xor(mx[u], o)); }
#pragma unroll
        for (int u = 0; u < RB; ++u) { ex[u] = __builtin_amdgcn_exp2f((lgt[u] - mx[u]) * LOG2E); sum[u] = ex[u]; }
#pragma unroll
        for (int o = 4; o < 64; o <<= 1) {
#pragma unroll
            for (int u = 0; u < RB; ++u) sum[u] += __shfl_xor(sum[u], o); }
        const int ee = ((F.lane >> 5) & 1) * 8 + ((F.lane >> 4) & 1) * 4 + ((F.lane >> 3) & 1) * 2 + ((F.lane >> 2) & 1);
#pragma unroll
        for (int u = 0; u < RB; ++u) { const float mine = ex[u] / sum[u]; const int row = row0 + u;
            if ((F.lane & 3) == 0) {
                if (isc) { const int r = row - LROWS; AFFC[((size_t)((r >> 8) * 16 + ee)) * CL + (r & 255)] = mine; }
                else AFF[((size_t)((row >> 13) * 16 + ee)) * SEQ + (row & 8191)] = mine;
                INV[(size_t)row * 16 + ee] = -1;
            } }
    }
#undef PF_LOAD
}


__device__ __forceinline__ void phase_f(KA a, Frame& F, int l, bool last) {
    relane(F);
    unsigned char* ws = a->ws;
    const float* MOD = (const float*)(ws + WS_MOD);
    float* AFF = (float*)(ws + WS_AFF); float* AFFC = (float*)(ws + WS_AFFC); int* INV = (int*)(ws + WS_INV);
    LAS float* wrT = (LAS float*)F.lds;
    const float* wr = a->in[I_WR] + (size_t)l * 1024 * 16;
    { float t[32];
#pragma unroll
      for (int i = 0; i < 32; ++i) t[i] = wr[F.tid + i * (NWAVES * 64)];
#pragma unroll
      for (int i = 0; i < 32; ++i) { const int idx = F.tid + i * (NWAVES * 64); wrT[(idx & 15) * 1024 + (idx >> 4)] = t[i]; } }
    { float t[22];
#pragma unroll
      for (int i = 0; i < 22; ++i) { const int j = F.tid + i * (NWAVES * 64); const int blk = j >> 10, k = j & 1023;
          const float* sp = (blk == 0) ? a->in[I_GN2] + l * 1024 + k : MOD + (l * 5 + ((blk - 1) >> 1)) * 6144 + (3 + ((blk - 1) & 1)) * 1024 + k;
          t[i] = *sp; }
#pragma unroll
      for (int i = 0; i < 22; ++i) wrT[16384 + F.tid + i * (NWAVES * 64)] = t[i]; }
    __syncthreads();
    pf_rows<4>(a, F, l, 0, LROWS, wrT);
    if (!last) pf_rows<1>(a, F, l, LROWS, MROWS, wrT);
}

__device__ __forceinline__ void topk_set(Frame& F, const float* __restrict__ src, int n, int k, int rowbase, int slotbase, int e, int* IDX, float* GATE, int* INV, const float* SA, float* SAE) {
    LAS unsigned* keys = (LAS unsigned*)F.lds; LAS unsigned* hist = keys + 8192; LAS unsigned* sc = hist + 256;
    const int tid = F.tid;
    { float v[16];
#pragma unroll
      for (int j = 0; j < 16; ++j) { const int i = tid + j * (NWAVES * 64); v[j] = src[i < n ? i : n - 1]; }
#pragma unroll
      for (int j = 0; j < 16; ++j) { const int i = tid + j * (NWAVES * 64); if (i < n) keys[i] = __float_as_uint(v[j]); } }
    if (tid == 0) { unsigned z_ = 0u, k_ = (unsigned)k; asm volatile("" : "+v"(z_), "+v"(k_)); sc[0] = z_; sc[1] = k_; }
    __syncthreads();
    for (int pass = 0; pass < 4; ++pass) {
        const int shift = 24 - 8 * pass; const unsigned mask = (pass == 0) ? 0u : (0xFFFFFFFFu << (shift + 8));
        if (tid < 256) hist[tid] = 0u;
        __syncthreads();
        const unsigned prefix = sc[0];
        for (int i = tid; i < n; i += NWAVES * 64) { const unsigned kv = keys[i]; if ((kv & mask) == prefix) __hip_atomic_fetch_add(&hist[(kv >> shift) & 255u], 1u, __ATOMIC_RELAXED, __HIP_MEMORY_SCOPE_WORKGROUP); }
        __syncthreads();
        if (F.wave == 0) {
            const unsigned need = sc[1]; unsigned h[4]; unsigned tot = 0u;
#pragma unroll
            for (int j = 0; j < 4; ++j) { h[j] = hist[255 - (4 * F.lane + j)]; tot += h[j]; }
            unsigned incl = tot;
#pragma unroll
            for (int d = 1; d < 64; d <<= 1) { const unsigned t = __shfl_up(incl, d); if (F.lane >= d) incl += t; }
            unsigned cum = incl - tot;
#pragma unroll
            for (int j = 0; j < 4; ++j) { if (cum < need && need <= cum + h[j]) { sc[0] = prefix | ((unsigned)(255 - (4 * F.lane + j)) << shift); sc[1] = need - cum; } cum += h[j]; }
        }
        __syncthreads();
    }
    const unsigned T = sc[0], need_eq = sc[1];
    const int per = (n + NWAVES * 64 - 1) / (NWAVES * 64), start = tid * per;
    unsigned cg = 0u, ce = 0u;
    for (int j = 0; j < per; ++j) { const int i = start + j; if (i < n) { const unsigned kv = keys[i]; cg += (kv > T) ? 1u : 0u; ce += (kv == T) ? 1u : 0u; } }
    const unsigned packed = cg | (ce << 16);
    unsigned incl = packed;
#pragma unroll
    for (int d = 1; d < 64; d <<= 1) { const unsigned t = __shfl_up(incl, d); if (F.lane >= d) incl += t; }
    if (F.lane == 63) sc[8 + F.wave] = incl;
    __syncthreads();
    unsigned base = 0u;
    for (int w = 0; w < F.wave; ++w) base += sc[8 + w];
    const unsigned excl = base + incl - packed;
    unsigned gb = excl & 0xFFFFu, eb = excl >> 16;
    float sav[16];
#pragma unroll
    for (int j = 0; j < 16; ++j) { const int i = start + j; sav[j] = SA[rowbase + ((j < per && i < n) ? i : n - 1)]; }
#pragma unroll
    for (int j = 0; j < 16; ++j) { const int i = start + j; if (j < per && i < n) { const unsigned kv = keys[i]; const bool g = kv > T, q = kv == T;
        if (g || (q && eb < need_eq)) { const int slot = slotbase + (int)(gb + (eb < need_eq ? eb : need_eq)); IDX[slot] = rowbase + i; GATE[slot] = __uint_as_float(kv); SAE[slot] = sav[j]; INV[(size_t)(rowbase + i) * 16 + e] = slot; }
        gb += g ? 1u : 0u; eb += q ? 1u : 0u; } }
    __syncthreads();
}
struct CvtItem { const float* wp; int N; unsigned char* wt; int ldt; float qs; int f8; };
__device__ __forceinline__ void cvt_load(const CvtItem& I, float (&tv)[32]) {
#pragma unroll
    for (int i = 0; i < 32; ++i) tv[i] = __builtin_nontemporal_load(I.wp + (size_t)(2 * i) * I.N);
}
__device__ __forceinline__ void cvt_store(const CvtItem& I, const float (&tv)[32], LAS float* scr, int lane) {
#pragma unroll
    for (int i = 0; i < 32; ++i) scr[(2 * i + (lane >> 5)) * 33 + (lane & 31)] = tv[i];
    LDS_WAIT(); asm volatile("" ::: "memory");
    const int c = lane & 3;
    float sv[2][16];
#pragma unroll
    for (int j = 0; j < 2; ++j) { const int n = (lane >> 2) + 16 * j; const LAS float* sp = scr + (16 * c) * 33 + n;
#pragma unroll
        for (int k = 0; k < 16; ++k) sv[j][k] = sp[k * 33]; }
    LDS_WAIT(); asm volatile("" ::: "memory");
#pragma unroll
    for (int j = 0; j < 2; ++j) { const int n = (lane >> 2) + 16 * j; v4u o;
        if (I.f8) {
#pragma unroll
            for (int d = 0; d < 4; ++d) { float f[4];
#pragma unroll
                for (int i = 0; i < 4; ++i) f[i] = fminf(fmaxf(sv[j][4 * d + i] * I.qs, -448.0f), 448.0f);
                int w = __builtin_amdgcn_cvt_pk_fp8_f32(f[0], f[1], 0, false); w = __builtin_amdgcn_cvt_pk_fp8_f32(f[2], f[3], w, true); o[d] = (unsigned)w; }
        } else {
#pragma unroll
            for (int d = 0; d < 4; ++d) { unsigned w = 0u;
#pragma unroll
                for (int i = 0; i < 4; ++i) { const float f = fminf(fmaxf(sv[j][4 * d + i] * I.qs, -127.0f), 127.0f); w |= ((unsigned)((int)__builtin_rintf(f)) & 255u) << (8 * i); }
                o[d] = w; }
        }
        *(v4u*)(I.wt + (size_t)n * I.ldt + 16 * c) = o; }
}
__device__ __forceinline__ void cvt_work(KA a, Frame& F, int l, int rep, int maxchunks) {
    unsigned char* ws = a->ws;
    LAS float* scr = (LAS float*)(F.lds + 40960 + F.wave * 8704);
    gu32* head = F.ctl + CW_Q + 64 * l + 128 * rep;
    constexpr int NIT = NE * 3072;
    const float* wg = a->in[I_WG] + (size_t)l * NE * 1024 * 2048; const float* wu = a->in[I_WU] + (size_t)l * NE * 1024 * 2048; const float* wd = a->in[I_WD] + (size_t)l * NE * 2048 * 1024;
    const float* SWL = (const float*)(ws + WS_SW) + l * 48;
    unsigned char* wgu8 = ws + WS_WGU + (size_t)l * WGU_LAYER; unsigned char* wd8 = ws + WS_WD + (size_t)l * WD_LAYER;
    for (int ch = 0; ch < maxchunks; ++ch) {
        unsigned basev = 0u;
        if (F.lane == 0) basev = __hip_atomic_fetch_add(head, 8u, RLX_AGENT);
        const int base = __builtin_amdgcn_readfirstlane((int)basev);
        if (base >= NIT) break;
#define CVT_SETUP(I, j) do { const int it_ = base + (j); const int e_ = it_ / 3072, r_ = it_ % 3072, which_ = r_ >> 10, ii_ = r_ & 1023; \
            if (which_ < 2) { const int kb_ = ii_ >> 6, n0_ = (ii_ & 63) * 32; const int rowbase_ = (n0_ >> 7) * 256 + (n0_ & 127) + which_ * 128; \
                I.wp = (which_ ? wu : wg) + (size_t)e_ * 1024 * 2048 + (size_t)(kb_ * 64 + (F.lane >> 5)) * 2048 + n0_ + (F.lane & 31); I.N = 2048; \
                I.wt = wgu8 + (size_t)e_ * 4096 * 1024 + (size_t)rowbase_ * 1024 + kb_ * 64; I.ldt = 1024; I.qs = 1.0f / SWL[3 * e_ + which_]; I.f8 = 0; } \
            else { const int kb_ = ii_ >> 5, n0_ = (ii_ & 31) * 32; \
                I.wp = wd + (size_t)e_ * 2048 * 1024 + (size_t)(kb_ * 64 + (F.lane >> 5)) * 1024 + n0_ + (F.lane & 31); I.N = 1024; \
                I.wt = wd8 + (size_t)e_ * 1024 * 2048 + (size_t)n0_ * 2048 + kb_ * 64; I.ldt = 2048; I.qs = 1.0f / SWL[3 * e_ + 2]; I.f8 = 1; } } while (0)
        CvtItem IA, IB; float tvA[32], tvB[32];
        CVT_SETUP(IA, 0); cvt_load(IA, tvA);
#pragma unroll
        for (int jj = 0; jj < 4; ++jj) {
            CVT_SETUP(IB, 2 * jj + 1); cvt_load(IB, tvB);
            cvt_store(IA, tvA, scr, F.lane);
            if (jj < 3) { CVT_SETUP(IA, 2 * jj + 2); cvt_load(IA, tvA); }
            cvt_store(IB, tvB, scr, F.lane);
        }
#undef CVT_SETUP
    }
}
__device__ __forceinline__ void phase_g(KA a, Frame& F, int l, bool last, int rep) {
    relane(F);
    unsigned char* ws = a->ws;
    const float* AFF = (const float*)(ws + WS_AFF); const float* AFFC = (const float*)(ws + WS_AFFC);
    int* IDX = (int*)(ws + WS_IDX); float* GATE = (float*)(ws + WS_GATE); int* INV = (int*)(ws + WS_INV);
    const float* SA = (const float*)(ws + WS_SA); float* SAE = (float*)(ws + WS_SAE);
    const int RPE = last ? 4096 : 4352, nsets = last ? 64 : 128;
    for (int set = blockIdx.x; set < nsets; set += F.G) {
        if (set < 64) { const int b = set >> 4, e = set & 15; topk_set(F, AFF + (size_t)set * SEQ, SEQ, CAPL, b * SEQ, e * RPE + b * CAPL, e, IDX, GATE, INV, SA, SAE); }
        else { const int s2 = set - 64, b = s2 >> 4, e = s2 & 15; topk_set(F, AFFC + (size_t)s2 * CL, CL, CAPC, LROWS + b * CL, e * RPE + 4096 + b * CAPC, e, IDX, GATE, INV, SA, SAE);
            if (b == 0 && F.tid < 128) { IDX[e * RPE + 4224 + F.tid] = -1; GATE[e * RPE + 4224 + F.tid] = 0.f; SAE[e * RPE + 4224 + F.tid] = 0.f; } }
    }
    cvt_work(a, F, l, rep, 1 << 30);
}

__global__ void __launch_bounds__(NWAVES * 64, 2) mk_fwd(Args args) {
    extern __shared__ __attribute__((aligned(16))) unsigned char lds[];
    Frame F;
    F.lds = (LAS unsigned char*)lds;
    F.MISC = (volatile LAS unsigned*)(F.lds + MISC_OFF);
    F.tid = threadIdx.x; F.lane = F.tid & 63; F.wave = __builtin_amdgcn_readfirstlane(F.tid >> 6);
    F.G = gridDim.x; { const int bx = blockIdx.x; F.vcu = (F.G % 8 == 0) ? (bx % 8) * (F.G / 8) + bx / 8 : bx; }
    F.ctl = (gu32*)(args.ws + WS_CTL);
    for (int u = F.tid; u < (LDS_BYTES - LDSCTL_OFF) / 4; u += NWAVES * 64) ((LAS unsigned*)(F.lds + LDSCTL_OFF))[u] = 0u;
    __syncthreads();
    const int lo = args.ph_lo, hi = args.ph_hi;
    const bool multi = (hi - lo) > 1;
    XcdBarrier bar; bar.bar = (unsigned*)(F.ctl + CW_BAR); bar.x = 0; bar.st = nullptr;
    if (multi) bar = xcd_barrier_post((unsigned*)(F.ctl + CW_BAR), F.MISC + 8);
#define IN(k) (lo <= (k) && (k) < hi)
#define SEAM(k) do { if (IN((k) + 1)) xcd_barrier(bar); } while (0)
#define REP(kind) (((MK_REP) >> (kind)) & 1)
#define RUNPH(kind, k, ...) do { if (IN(k)) { for (int rep_ = 0; rep_ <= REP(kind); ++rep_) { __VA_ARGS__; if (rep_ < REP(kind)) xcd_barrier(bar); } SEAM(k); } } while (0)

#define TAIL_CVT(S) do { if (MK_TAILCVT && !last && rep_ == 0) { const int rem_ = (S).nwg % F.G; if (rem_ != 0 && (int)blockIdx.x >= rem_) { __syncthreads(); if (F.wave < MK_TAILWAVES) cvt_work(kargs(), F, l + 1, 0, MK_TAILCVT); } } } while (0)
    RUNPH(0, 0, p0_prologue(kargs(), F));

    for (int l = 0; l < NLAYER; ++l) {
        const bool last = (l == NLAYER - 1);
        const int pb = 1 + 10 * l;
        const int RPE = last ? 4096 : 4352;
        if (IN(pb + 0)) { for (int rep_ = 0; rep_ <= (l == 0 ? REP(1) : 0); ++rep_) { phase_a(kargs(), F, l); if (rep_ < REP(1) && l == 0) xcd_barrier(bar); } SEAM(pb + 0); }
        if (IN(pb + 1)) { for (int rep_ = 0; rep_ <= REP(2); ++rep_) {
            KA ka = kargs(); unsigned char* ws = ka->ws;
            pg8::Gemm g{(const pg8::bf16_t*)(ws + WS_H), (const pg8::bf16_t*)(ws + WS_WCAT8 + (size_t)l * ZP * 1024), MROWS, ZP, DM / 2, 1 << 30, 0};
            pg8::StaticOrder S; S.init(MROWS, ZP, F.G, (int)blockIdx.x);
            pg8::EpiStoreBf16I8 E{(unsigned char*)(ws + WS_Z), ZP, (const float*)(ws + WS_SA), (const float*)(ws + WS_SWC) + (size_t)l * ZP, (float*)(ws + WS_SSQ), 384, ZEND};
            pg8::gemm_phase<pg8::EpiStoreBf16I8, pg8::StaticOrder, true, true, 1>(F.lds, g, S, E);
            TAIL_CVT(S);
            if (rep_ < REP(2)) xcd_barrier(bar); }
            SEAM(pb + 1);
        }
        RUNPH(3, pb + 2, phase_c(kargs(), F, l));
        RUNPH(4, pb + 3, phase_d<0>(kargs(), F, l, last); if (MK_ABL) { xcd_barrier(bar); phase_d<MK_ABL>(kargs(), F, l, last); });
        if (IN(pb + 4)) { for (int rep_ = 0; rep_ <= REP(5); ++rep_) {
            KA ka = kargs(); unsigned char* ws = ka->ws; const float* MODL = (const float*)(ws + WS_MOD) + (size_t)l * 5 * 6144;
            const int M = last ? LROWS : MROWS;
            pg8::Gemm g{(const pg8::bf16_t*)(ws + WS_ATT), (const pg8::bf16_t*)(ws + WS_WO) + (size_t)l * 1024 * 1024, M, DM, DM, 1 << 30, 0};
            pg8::StaticOrder S; S.init(M, DM, F.G, (int)blockIdx.x);
            pg8::EpiColGateBf16 E{(pg8::bf16_t*)(ws + WS_DELTA), DM, MODL, LROWS};
            pg8::gemm_phase<pg8::EpiColGateBf16, pg8::StaticOrder, true, true>(F.lds, g, S, E);
            TAIL_CVT(S);
            if (rep_ < REP(5)) xcd_barrier(bar); }
            SEAM(pb + 4);
        }
        RUNPH(6, pb + 5, phase_f(kargs(), F, l, last));
        RUNPH(7, pb + 6, phase_g(kargs(), F, l, last, rep_));
        if (IN(pb + 8)) { for (int rep_ = 0; rep_ <= REP(9); ++rep_) {
            KA ka = kargs(); unsigned char* ws = ka->ws;
            pg8::Gemm g{(const pg8::bf16_t*)(ws + WS_H), (const pg8::bf16_t*)(ws + WS_WGU + (size_t)l * WGU_LAYER), NE * RPE, 2 * FFD, DM / 2, RPE / 256, (size_t)2 * FFD * DM, (const int*)(ws + WS_IDX)};
            pg8::StaticOrder S; S.init(NE * RPE, 2 * FFD, F.G, (int)blockIdx.x);
            pg8::EpiSwiGLUI8 E{(unsigned char*)(ws + WS_HID), FFD, (const float*)(ws + WS_SAE), (const float*)(ws + WS_SW) + l * 48, RPE / 256, HID_SCALE};
            if (MK_NOEPI && rep_ == 1) { pg8::EpiNullI8 EN{}; pg8::gemm_phase<pg8::EpiNullI8, pg8::StaticOrder, true, true, 1, true>(F.lds, g, S, EN); }
            else pg8::gemm_phase<pg8::EpiSwiGLUI8, pg8::StaticOrder, true, true, 1, true>(F.lds, g, S, E);
            if (rep_ < REP(9)) xcd_barrier(bar); }
            SEAM(pb + 8);
        }
        if (IN(pb + 9)) { for (int rep_ = 0; rep_ <= REP(10); ++rep_) {
            KA ka = kargs(); unsigned char* ws = ka->ws;
            pg8::Gemm g{(const pg8::bf16_t*)(ws + WS_HID), (const pg8::bf16_t*)(ws + WS_WD + (size_t)l * WD_LAYER), NE * RPE, DM, FFD / 2, RPE / 256, (size_t)DM * FFD};
            pg8::StaticOrder S; S.init(NE * RPE, DM, F.G, (int)blockIdx.x);
            pg8::EpiRowScaleBf16 E{(unsigned char*)(ws + WS_YE), DM, (const float*)(ws + WS_GATE), (const float*)(ws + WS_SW) + l * 48, RPE / 256, YE_SCALE / HID_SCALE};
            pg8::gemm_phase<pg8::EpiRowScaleBf16, pg8::StaticOrder, true, true, 2>(F.lds, g, S, E);
            TAIL_CVT(S);
            if (rep_ < REP(10)) xcd_barrier(bar); }
            SEAM(pb + 9);
        }
    }
    if (IN(N_PHASES - 1)) phase_a(kargs(), F, NLAYER);
#undef IN
#undef SEAM
}

extern "C" void kernel_launch(void* const* d_in, const int* in_sizes, int n_in, void* d_out, int out_size, void* d_ws, size_t ws_size, hipStream_t stream) {
    static int grid = 0;
    if (grid == 0) {
        if (n_in != N_IN || out_size != LROWS * DM || ws_size < WS_END) { fprintf(stderr, "kernel_launch: unexpected shapes (n_in %d, out %d, ws %zu); nothing launched\n", n_in, out_size, ws_size); grid = -1; return; }
        int dev = 0, cus = 0, per_cu = 0;
        if (hipGetDevice(&dev) != hipSuccess || hipDeviceGetAttribute(&cus, hipDeviceAttributeMultiprocessorCount, dev) != hipSuccess) { grid = -1; return; }
        if (hipFuncSetAttribute((const void*)mk_fwd, hipFuncAttributeMaxDynamicSharedMemorySize, LDS_BYTES) != hipSuccess) { fprintf(stderr, "kernel_launch: hipFuncSetAttribute failed\n"); grid = -1; return; }
        if (hipOccupancyMaxActiveBlocksPerMultiprocessor(&per_cu, (const void*)mk_fwd, NWAVES * 64, LDS_BYTES) != hipSuccess || per_cu < 1) { fprintf(stderr, "kernel_launch: occupancy query reports %d blocks per CU\n", per_cu); }
        (void)hipGetLastError();
        if (cus < 256) { fprintf(stderr, "kernel_launch: %d compute units; the per-workgroup LDS row tables of the GEMM phases are sized for a grid of at least 256 workgroups; nothing launched\n", cus); grid = -1; return; }
        grid = cus;
    }
    if (grid < 0) return;
    if (hipMemsetAsync((char*)d_ws + WS_CTL, 0, CTL_ZERO_BYTES, stream) != hipSuccess) { fprintf(stderr, "kernel_launch: memset failed\n"); return; }
    Args a{};
    for (int i = 0; i < N_IN; ++i) a.in[i] = (const float*)d_in[i];
    a.out = (float*)d_out; a.ws = (unsigned char*)d_ws;
#if MK_SPLIT
    for (int ph = 0; ph < N_PHASES; ++ph) { a.ph_lo = ph; a.ph_hi = ph + 1; hipLaunchKernelGGL(mk_fwd, dim3(grid), dim3(NWAVES * 64), LDS_BYTES, stream, a); }
#else
    a.ph_lo = 0; a.ph_hi = N_PHASES;
    hipLaunchKernelGGL(mk_fwd, dim3(grid), dim3(NWAVES * 64), LDS_BYTES, stream, a);
#endif
    const hipError_t le = hipPeekAtLastError();
    if (le != hipSuccess) fprintf(stderr, "kernel_launch: launch failed: %s\n", hipGetErrorName(le));
}
```
